# Optimizing an MI355X kernel written in HIP

```python
import jax
import jax.numpy as jnp
from jax import lax
import numpy as np


D_MODEL = 1024
BATCH = 8
SEQ = 8192
DEPTH = 1

HEAD_DIM = 64
DIL_PATTERNS = ((128, 1), (512, 4), (2048, 16))
DIL_HEADS_PER_GROUP = 4
N_DIL_GROUPS = len(DIL_PATTERNS)
DIL_HEADS = N_DIL_GROUPS * DIL_HEADS_PER_GROUP
DIL_WIDTH = DIL_HEADS * HEAD_DIM
DIL_OUT_WIDTH = DIL_HEADS_PER_GROUP * HEAD_DIM
SB_HEADS = 4
SB_WIDTH = SB_HEADS * HEAD_DIM
QKV_WIDTH = 3 * DIL_WIDTH + 3 * SB_WIDTH
QBLOCK = 128
ROPE_THETA = 500000.0
ROPE_DIM = HEAD_DIM // 4
N_GROUPS = 4
EXPERTS_PER_GROUP = 8
N_EXPERTS = N_GROUPS * EXPERTS_PER_GROUP
TOP_K_INNER = 2
D_EXPERT = 512
EXPERT_CHUNK = 256
RMS_EPS = 1e-6

kernel_name = 'hybrid_dilated_stickbreak_hmoe_layer'


def rms_norm(x, g):
    xf = x.astype(jnp.float32)
    y = xf * lax.rsqrt(jnp.mean(xf * xf, axis=-1, keepdims=True) + RMS_EPS)
    return (y * g.astype(jnp.float32)).astype(x.dtype)


def partial_rope(x, cos, sin):
    half = ROPE_DIM // 2
    xr = x[..., :ROPE_DIM].astype(jnp.float32)
    x1, x2 = xr[..., :half], xr[..., half:]
    rot = jnp.concatenate([x1 * cos - x2 * sin, x2 * cos + x1 * sin], axis=-1)
    return jnp.concatenate([rot.astype(x.dtype), x[..., ROPE_DIM:]], axis=-1)


def dilated_attention(q, k, v):
    b, s = q.shape[0], q.shape[1]
    n_blocks = s // QBLOCK
    scale = HEAD_DIM ** -0.5
    hpg = DIL_HEADS_PER_GROUP
    kf = k.astype(jnp.float32)
    vf = v.astype(jnp.float32)
    k_groups = [kf[:, :, g * hpg:(g + 1) * hpg] for g in range(N_DIL_GROUPS)]
    v_groups = [vf[:, :, g * hpg:(g + 1) * hpg] for g in range(N_DIL_GROUPS)]

    def block(i):
        start = i * QBLOCK
        t = start + jnp.arange(QBLOCK, dtype=jnp.int32)
        qb = lax.dynamic_slice_in_dim(q, start, QBLOCK, axis=1).astype(jnp.float32)
        outs, lses = [], []
        for g, (window, dil) in enumerate(DIL_PATTERNS):
            n_keys = window // dil + 1
            idx = t[:, None] - dil * jnp.arange(n_keys, dtype=jnp.int32)[None, :]
            valid = idx >= 0
            idx = jnp.maximum(idx, 0)
            kg = jnp.take(k_groups[g], idx, axis=1)
            vg = jnp.take(v_groups[g], idx, axis=1)
            sc = jnp.einsum('bqhd,bqjhd->bhqj', qb[:, :, g * hpg:(g + 1) * hpg], kg) * scale
            sc = jnp.where(valid[None, None], sc, -jnp.inf)
            lse = jax.nn.logsumexp(sc, axis=-1)
            p = jnp.exp(sc - lse[..., None])
            outs.append(jnp.einsum('bhqj,bqjhd->bqhd', p, vg))
            lses.append(lse)
        w = jax.nn.softmax(jnp.stack(lses, axis=0), axis=0)
        w = jnp.transpose(w, (0, 1, 3, 2))[..., None]
        return jnp.sum(w * jnp.stack(outs, axis=0), axis=0)

    out = lax.map(block, jnp.arange(n_blocks, dtype=jnp.int32))
    out = jnp.transpose(out, (1, 0, 2, 3, 4)).reshape(b, s, DIL_OUT_WIDTH)
    return out.astype(q.dtype)


def stick_breaking_attention(q, k, v):
    b, s = q.shape[0], q.shape[1]
    n_blocks = s // QBLOCK
    scale = HEAD_DIM ** -0.5
    kf = k.astype(jnp.float32)
    vf = v.astype(jnp.float32)
    key_pos = jnp.arange(s, dtype=jnp.int32)

    def block(i):
        start = i * QBLOCK
        t = start + jnp.arange(QBLOCK, dtype=jnp.int32)
        qb = lax.dynamic_slice_in_dim(q, start, QBLOCK, axis=1).astype(jnp.float32)
        z = jnp.einsum('bqhd,bshd->bhqs', qb, kf) * scale
        mask = (key_pos[None, :] < t[:, None])[None, None]
        log_1m = jnp.where(mask, jax.nn.log_sigmoid(-z), 0.0)
        suffix = lax.cumsum(log_1m, axis=3, reverse=True)
        between = jnp.concatenate([suffix[..., 1:], jnp.zeros_like(suffix[..., :1])], axis=-1)
        a = jnp.where(mask, jnp.exp(jax.nn.log_sigmoid(z) + between), 0.0)
        return jnp.einsum('bhqs,bshd->bqhd', a, vf)

    out = lax.map(block, jnp.arange(n_blocks, dtype=jnp.int32))
    out = jnp.transpose(out, (1, 0, 2, 3, 4)).reshape(b, s, SB_WIDTH)
    return out.astype(q.dtype)


def hierarchical_moe(u, w_rg, b_rg, w_re, b_re, w_g, w_u, w_d):
    n_tok, d = u.shape
    uf = u.astype(jnp.float32)
    p_group = jax.nn.softmax(uf @ w_rg.astype(jnp.float32) + b_rg.astype(jnp.float32), axis=-1)
    pg_top, g_sel = lax.top_k(p_group, 1)
    logits_e = (uf @ w_re.astype(jnp.float32) + b_re.astype(jnp.float32)).reshape(n_tok, N_GROUPS, EXPERTS_PER_GROUP)
    logits_sel = jnp.take_along_axis(logits_e, g_sel[:, :, None], axis=1)[:, 0]
    pi_top, e_in = lax.top_k(jax.nn.softmax(logits_sel, axis=-1), TOP_K_INNER)
    weights = pg_top * pi_top / jnp.sum(pi_top, axis=-1, keepdims=True)
    expert_id = g_sel * EXPERTS_PER_GROUP + e_in

    n_assign = n_tok * TOP_K_INNER
    flat_e = expert_id.reshape(-1).astype(jnp.int32)
    flat_w = weights.reshape(-1)
    flat_tok = jnp.repeat(jnp.arange(n_tok, dtype=jnp.int32), TOP_K_INNER)
    order = jnp.argsort(flat_e)
    sorted_e = flat_e[order]
    counts = jnp.bincount(flat_e, length=N_EXPERTS).astype(jnp.int32)
    starts = jnp.cumsum(counts) - counts
    padded = (counts + EXPERT_CHUNK - 1) // EXPERT_CHUNK * EXPERT_CHUNK
    padded_ends = jnp.cumsum(padded)
    padded_starts = padded_ends - padded
    dest = padded_starts[sorted_e] + jnp.arange(n_assign, dtype=jnp.int32) - starts[sorted_e]
    n_chunks = -(-n_assign // EXPERT_CHUNK) + N_EXPERTS
    n_slots = n_chunks * EXPERT_CHUNK
    slot_tok = jnp.full((n_slots,), n_tok, jnp.int32).at[dest].set(flat_tok[order])
    slot_w = jnp.zeros((n_slots,), jnp.float32).at[dest].set(flat_w[order])
    chunk_e = jnp.minimum(
        jnp.searchsorted(padded_ends, jnp.arange(n_chunks, dtype=jnp.int32) * EXPERT_CHUNK, side='right'),
        N_EXPERTS - 1).astype(jnp.int32)
    u_pad = jnp.concatenate([u, jnp.zeros((1, d), u.dtype)], axis=0)
    chunk_x = u_pad[slot_tok].reshape(n_chunks, EXPERT_CHUNK, d)

    def expert_chunk(args):
        xc, e = args
        h = jax.nn.silu(xc @ w_g[e]) * (xc @ w_u[e])
        return h @ w_d[e]

    y = lax.map(expert_chunk, (chunk_x, chunk_e)).reshape(n_slots, d)
    y = y * slot_w[:, None].astype(y.dtype)
    return jnp.zeros((n_tok + 1, d), y.dtype).at[slot_tok].add(y)[:n_tok]


def setup_inputs(seed: int = 0) -> dict:
    key = jax.random.key(seed)
    ks = jax.random.split(key, 24)
    L = DEPTH
    D = D_MODEL

    def nrm(k, shape, fan_in):
        return jax.random.normal(k, shape, jnp.float32) * fan_in ** -0.5

    def gain(k, shape):
        return 1.0 + 0.01 * jax.random.normal(k, shape, jnp.float32)

    x = jax.random.normal(ks[0], (BATCH, SEQ, D), jnp.float32)
    c = jax.random.normal(ks[1], (BATCH, D), jnp.float32)
    positions = (jax.random.randint(ks[2], (BATCH, 1), 0, 4096, dtype=jnp.int32)
                 + jnp.arange(SEQ, dtype=jnp.int32)[None, :])
    return {
        'x': x,
        'c': c,
        'positions': positions,
        'w_ada': nrm(ks[3], (L, D, 6 * D), D) * 0.5,
        'b_ada': 0.01 * jax.random.normal(ks[4], (L, 6 * D), jnp.float32),
        'g_norm_mix': gain(ks[5], (L, D)),
        'g_norm_ffn': gain(ks[6], (L, D)),
        'w_in': nrm(ks[7], (L, D, QKV_WIDTH), D),
        'w_branch_gate': nrm(ks[8], (L, D, 2 * D), D),
        'q_norm_g': gain(ks[9], (L, HEAD_DIM)),
        'k_norm_g': gain(ks[10], (L, HEAD_DIM)),
        'w_branch_dil': nrm(ks[11], (L, DIL_OUT_WIDTH, D), DIL_OUT_WIDTH),
        'w_branch_sb': nrm(ks[12], (L, SB_WIDTH, D), SB_WIDTH),
        'w_out': nrm(ks[13], (L, D, D), D),
        'w_router_group': nrm(ks[14], (L, D, N_GROUPS), D),
        'b_router_group': 0.01 * jax.random.normal(ks[15], (L, N_GROUPS), jnp.float32),
        'w_router_expert': nrm(ks[16], (L, D, N_EXPERTS), D),
        'b_router_expert': 0.01 * jax.random.normal(ks[17], (L, N_EXPERTS), jnp.float32),
        'w_expert_gate': nrm(ks[18], (L, N_EXPERTS, D, D_EXPERT), D),
        'w_expert_up': nrm(ks[19], (L, N_EXPERTS, D, D_EXPERT), D),
        'w_expert_down': nrm(ks[20], (L, N_EXPERTS, D_EXPERT, D), D_EXPERT),
    }


def reference(x, c, positions, w_ada, b_ada, g_norm_mix, g_norm_ffn, w_in, w_branch_gate,
              q_norm_g, k_norm_g, w_branch_dil, w_branch_sb, w_out, w_router_group,
              b_router_group, w_router_expert, b_router_expert, w_expert_gate, w_expert_up,
              w_expert_down):
    b, s, d = x.shape
    inv_freq = ROPE_THETA ** (-jnp.arange(0, ROPE_DIM, 2, dtype=jnp.float32) / ROPE_DIM)
    ang = positions.astype(jnp.float32)[..., None] * inv_freq
    cos = jnp.cos(ang)[:, :, None, :]
    sin = jnp.sin(ang)[:, :, None, :]
    c_act = jax.nn.silu(c.astype(jnp.float32))

    for l in range(DEPTH):
        mod = (c_act @ w_ada[l].astype(jnp.float32) + b_ada[l].astype(jnp.float32)).astype(x.dtype)
        shift1, scale1, gate1, shift2, scale2, gate2 = jnp.split(mod[:, None, :], 6, axis=-1)

        h = rms_norm(x, g_norm_mix[l]) * (1 + scale1) + shift1
        proj = h @ w_in[l]
        cuts = np.cumsum([DIL_WIDTH, DIL_WIDTH, DIL_WIDTH, SB_WIDTH, SB_WIDTH]).tolist()
        qa, ka, va, qb, kb, vb = jnp.split(proj, cuts, axis=-1)
        qa = qa.reshape(b, s, DIL_HEADS, HEAD_DIM)
        ka = ka.reshape(b, s, DIL_HEADS, HEAD_DIM)
        va = va.reshape(b, s, DIL_HEADS, HEAD_DIM)
        qa = partial_rope(rms_norm(qa, q_norm_g[l]), cos, sin)
        ka = partial_rope(rms_norm(ka, k_norm_g[l]), cos, sin)
        o_dil = dilated_attention(qa, ka, va)
        o_sb = stick_breaking_attention(qb.reshape(b, s, SB_HEADS, HEAD_DIM),
                                        kb.reshape(b, s, SB_HEADS, HEAD_DIM),
                                        vb.reshape(b, s, SB_HEADS, HEAD_DIM))
        g_dil, g_sb = jnp.split(jax.nn.sigmoid(h @ w_branch_gate[l]), 2, axis=-1)
        merged = g_dil * (o_dil @ w_branch_dil[l]) + g_sb * (o_sb @ w_branch_sb[l])
        x = x + gate1 * (merged @ w_out[l])

        h2 = rms_norm(x, g_norm_ffn[l]) * (1 + scale2) + shift2
        y = hierarchical_moe(h2.reshape(b * s, d), w_router_group[l], b_router_group[l],
                             w_router_expert[l], b_router_expert[l], w_expert_gate[l],
                             w_expert_up[l], w_expert_down[l])
        x = x + gate2 * y.reshape(b, s, d)
    return x
```

```cpp
#include <hip/hip_runtime.h>
#include <cstdio>
#include <cstdint>

#ifndef MK_N_LAUNCHES
#define MK_N_LAUNCHES 1
#endif
#define DBG_X1_PLAIN 0
#define DBG_SKIP_Y 0
#ifndef PROBE_PH
#define PROBE_PH -1
#endif

#define LAS __attribute__((address_space(3)))
#define DI __device__ __forceinline__
typedef unsigned short bf16_t;
typedef short bf16x8 __attribute__((ext_vector_type(8)));
typedef short s16x4 __attribute__((ext_vector_type(4)));
typedef float f32x2 __attribute__((ext_vector_type(2)));
typedef float f32x4 __attribute__((ext_vector_type(4)));
typedef float f32x16 __attribute__((ext_vector_type(16)));
typedef unsigned u32x2 __attribute__((ext_vector_type(2)));
typedef unsigned u32x4 __attribute__((ext_vector_type(4)));
typedef __bf16 bf16x2n __attribute__((ext_vector_type(2)));
typedef int i32x8 __attribute__((ext_vector_type(8)));

constexpr int NB = 8, S = 8192, D = 1024, T = NB * S;
constexpr int LDP = 3072, LDG = 2048, LDO = 512;
constexpr int NE = 32, DE = 512;
constexpr int MAXSLOT = T * 2 + NE * 256;
constexpr int NPH = 12;
constexpr float LOG2E = 1.4426950408889634f;
constexpr float QSCALE = 0.125f * LOG2E;
constexpr float RMS_EPS = 1e-6f;

constexpr size_t MiB = 1u << 20;
constexpr size_t WS_CTL = 0, CTL_ZERO_BYTES = 64 * 1024;
constexpr int CW_BAR = 1024;
constexpr size_t WS_MODP = 1 * MiB;
constexpr size_t WS_MOD = 3 * MiB;
constexpr size_t WS_ROPE = 4 * MiB;
constexpr size_t WS_LOGIT = 144 * MiB;
constexpr size_t WS_TOKE = 24 * MiB;
constexpr size_t WS_TOKW = 24 * MiB + 512 * 1024;
constexpr size_t WS_TOKS = 25 * MiB;
constexpr size_t WS_SLOTTOK = 25 * MiB + 512 * 1024;
constexpr size_t WS_SLOTW = 26 * MiB + 256 * 1024;
constexpr size_t WS_HIST = 27 * MiB;
constexpr size_t WS_ETAB = 27 * MiB + 256 * 1024;
constexpr size_t WS_WR = 28 * MiB;
constexpr size_t WS_W1D8 = 28 * MiB + 512 * 1024;
constexpr size_t WS_W1 = 32 * MiB;
constexpr size_t WS_WG8 = 38 * MiB;
constexpr size_t WS_WB = 40 * MiB;
constexpr size_t WS_WO = 43 * MiB;
constexpr size_t WS_WGU = 48 * MiB;
constexpr size_t WS_WDN = 80 * MiB;
constexpr size_t WS_H = 144 * MiB;
constexpr size_t WS_OG = 144 * MiB;
constexpr size_t WS_LSE = 240 * MiB;
constexpr size_t WS_PROJ = 272 * MiB;
constexpr size_t WS_GATES = 656 * MiB;
constexpr size_t WS_OCAT = 912 * MiB;
constexpr size_t WS_H8 = 912 * MiB;
constexpr size_t WS_MERGED = 272 * MiB;
constexpr size_t WS_H2 = 400 * MiB;
constexpr size_t WS_H28 = 528 * MiB;
constexpr size_t WS_HMID = 592 * MiB;
constexpr size_t WS_Y = 664 * MiB;
constexpr size_t WS_UPD1 = 144 * MiB;
constexpr size_t WS_END = 976 * MiB;

constexpr int LDS_STAGE = 0, LDS_EPI = 131072, LDS_RW = 0, LDS_RV = 148480, LDS_RS = 148480 + 8192, LDS_CTLO = 148480 + 8192 + 3072, LDS_BYTES = LDS_CTLO + 256;

DI unsigned pk2(float lo, float hi) { f32x2 v = {lo, hi}; bf16x2n r = __builtin_convertvector(v, bf16x2n); return __builtin_bit_cast(unsigned, r); }
DI unsigned pk4_fp8(float a, float b, float c, float d) { int r = __builtin_amdgcn_cvt_pk_fp8_f32(a, b, 0, false); r = __builtin_amdgcn_cvt_pk_fp8_f32(c, d, r, true); return (unsigned)r; }
DI f32x2 fp8_lo2(unsigned u) { return __builtin_amdgcn_cvt_pk_f32_fp8((int)u, false); }
DI f32x2 fp8_hi2(unsigned u) { return __builtin_amdgcn_cvt_pk_f32_fp8((int)u, true); }
DI float bf_lo(unsigned u) { return __builtin_bit_cast(float, u << 16); }
DI float bf_hi(unsigned u) { return __builtin_bit_cast(float, u & 0xffff0000u); }
DI float wave_sum(float v) {
#pragma unroll
    for (int o = 1; o < 64; o <<= 1) v += __shfl_xor(v, o);
    return v;
}
DI float fexp2(float x) { return __builtin_amdgcn_exp2f(x); }
DI float flog2(float x) { return __builtin_amdgcn_logf(x); }
DI float frcp(float x) { return __builtin_amdgcn_rcpf(x); }
DI float sigmoidf(float v) { return frcp(1.0f + fexp2(-v * LOG2E)); }
DI void lds_add(LAS int* p, int v) { (void)__hip_atomic_fetch_add(p, v, __ATOMIC_RELAXED, __HIP_MEMORY_SCOPE_WORKGROUP); }
#define LDS_WAIT() asm volatile("s_waitcnt lgkmcnt(0)" ::: "memory")
#define VM_WAIT() asm volatile("s_waitcnt vmcnt(0)" ::: "memory")
DI int fresh_tid() { int t = threadIdx.x; asm volatile("" : "+v"(t)); return t; }

#define XB_TMO      128
#define XB_XCNT(j)  (256  + 64 * (j))
#define XB_XSUB(j)  (1280 + 64 * (j))
#define XB_XGEN(j)  (2304 + 64 * (j))
#define XB_TOP      3328
#define XB_TOPGEN   3392
#define XCD_BAR_WORDS 3456
#define XB_SPIN_CAP (1u << 18)

__device__ __forceinline__ unsigned xb_ld(unsigned* p)              { return __hip_atomic_load(p, __ATOMIC_RELAXED, __HIP_MEMORY_SCOPE_AGENT); }
__device__ __forceinline__ unsigned xb_add(unsigned* p, unsigned v) { return __hip_atomic_fetch_add(p, v, __ATOMIC_RELAXED, __HIP_MEMORY_SCOPE_AGENT); }
__device__ __forceinline__ unsigned xb_xcc_id() { return (unsigned)__builtin_amdgcn_s_getreg((3 << 11) | 20) & 0xFu; }
#define XB_SPIN(cond, bar) do { unsigned _sp = 0; while (cond) { __builtin_amdgcn_s_sleep(1); \
    if ((++_sp & 255u) == 0u) { if (xb_ld(&(bar)[XB_TMO])) break; if (_sp > XB_SPIN_CAP) { atomicAdd(&(bar)[XB_TMO], 1u); break; } } } } while (0)

struct XcdBarrier {
    unsigned* bar; unsigned x;
    volatile LAS unsigned* st;
};
__device__ __forceinline__ XcdBarrier xcd_barrier_post(unsigned* bar, volatile LAS unsigned* st) {
    XcdBarrier b; b.bar = bar; b.x = xb_xcc_id(); b.st = st;
    if (threadIdx.x == 0) (void)xb_add(&bar[XB_XCNT(b.x)], 1u);
    return b;
}
__device__ __forceinline__ void xcd_barrier_complete(unsigned* bar, unsigned x, unsigned& nloc, unsigned& nx) {
    const unsigned G = gridDim.x * gridDim.y * gridDim.z;
    unsigned sum, cnt, mine, sp = 0u;
    for (;;) {
        sum = 0u; cnt = 0u; mine = 0u;
#pragma unroll
        for (unsigned j = 0; j < 16; ++j) { const unsigned c = xb_ld(&bar[XB_XCNT(j)]); sum += c; cnt += (c > 0u) ? 1u : 0u; mine = (j == x) ? c : mine; }
        if (sum == G) break;
        __builtin_amdgcn_s_sleep(1);
        if ((++sp & 255u) == 0u) { if (xb_ld(&bar[XB_TMO])) break; if (sp > XB_SPIN_CAP) { atomicAdd(&bar[XB_TMO], 1u); break; } }
    }
    nloc = mine > 0u ? mine : 1u; nx = cnt > 0u ? cnt : 1u;
}
__device__ __forceinline__ void xcd_barrier(const XcdBarrier& b) {
    asm volatile("s_waitcnt vmcnt(0)" ::: "memory");
    __syncthreads();
    if (threadIdx.x == 0) {
        unsigned* bar = b.bar;
        __builtin_amdgcn_s_waitcnt(0);
        unsigned nloc = b.st[0], nx = b.st[1];
        if (nloc == 0u) { xcd_barrier_complete(bar, b.x, nloc, nx); b.st[0] = nloc; b.st[1] = nx; }
        const unsigned old = xb_add(&bar[XB_XSUB(b.x)], 1u);
        const unsigned gen = old / nloc;
        if (old + 1u == (gen + 1u) * nloc) {
            __builtin_amdgcn_fence(__ATOMIC_RELEASE, "agent");
            asm volatile("s_waitcnt vmcnt(0)" ::: "memory");
            const unsigned og = xb_add(&bar[XB_TOP], 1u);
            const unsigned tg = og / nx;
            if (og + 1u == (tg + 1u) * nx) xb_add(&bar[XB_TOPGEN], 1u);
            else XB_SPIN(xb_ld(&bar[XB_TOPGEN]) == tg, bar);
            __builtin_amdgcn_fence(__ATOMIC_ACQUIRE, "agent");
            xb_add(&bar[XB_XGEN(b.x)], 1u);
            asm volatile("s_waitcnt vmcnt(0)" ::: "memory");
        } else {
            XB_SPIN(xb_ld(&bar[XB_XGEN(b.x)]) == gen, bar);
            __builtin_amdgcn_fence(__ATOMIC_ACQUIRE, "agent");
            asm volatile("s_waitcnt vmcnt(0)" ::: "memory");
        }
    }
    __syncthreads();
}

namespace pg8 {
constexpr int BM = 256, BK = 64, HALF = 128, HTB = HALF * BK * 2, STAGE_BYTES = 8 * HTB, NXCD = 8, WGM = 8;
__host__ __device__ __forceinline__ int lds_byte(int r, int c) { const int st = (r >> 4) * 2 + (c >> 5), rr = r & 15, cc = c & 31, ob = rr * 64 + cc * 2; return st * 1024 + (ob ^ (((ob >> 9) & 1) << 5)); }
__host__ __device__ __forceinline__ void stage_rc(int b, int& R, int& C) { const int st = b / 1024, sb = b % 1024, swz = sb ^ (((sb >> 9) & 1) << 5); R = (st >> 1) * 16 + swz / 64; C = (st & 1) * 32 + (swz % 64) / 2; }
__host__ __device__ __forceinline__ int perm32(int rho) { const int n = rho >> 4, i = rho & 15; return 8 * (i >> 2) + 4 * n + (i & 3); }

struct Unit { int pm, pn, aux; unsigned a, b; };
typedef int i32x4 __attribute__((ext_vector_type(4)));
__device__ __forceinline__ i32x8 frag8(bf16x8 lo, bf16x8 hi) { return __builtin_shufflevector(__builtin_bit_cast(i32x4, lo), __builtin_bit_cast(i32x4, hi), 0, 1, 2, 3, 4, 5, 6, 7); }

template <class Epi, class Sched, bool FP8 = false>
__device__ __forceinline__ void gemm_phase(LAS unsigned char* lds, const int K, const Sched& S, const Epi& E, const __amdgpu_buffer_rsrc_t rs) {
    const int tid = fresh_tid(), wid = __builtin_amdgcn_readfirstlane(tid >> 6), lane = tid & 63, wr = wid >> 2, wc = wid & 3, fr = lane & 15, fq = lane >> 4;
    const int nt = FP8 ? K / 128 : K / BK;
    int RA[2], CA[2];
    unsigned voffA[4], voffB[2];
#pragma unroll
    for (int i = 0; i < 2; ++i) { int R, C; stage_rc(tid * 16 + i * 8192, R, C); RA[i] = R; CA[i] = C; const int Rb = Epi::PERM ? ((R & ~31) + perm32(R & 31)) : R;
        voffB[i] = (unsigned)(Rb * S.pb + C * 2); }
    const unsigned kstep = (unsigned)(BK * 2);
    const unsigned hstepB = (unsigned)(HALF * S.pb), hstepA = (unsigned)(HALF * S.pa);
    const unsigned ldsw = (unsigned)wid * 1024u;
    const int aoff = lds_byte(wr * 64 + fr, fq * 8), boff = lds_byte(wc * 32 + fr, fq * 8);
    constexpr int kpiece = 1024;
#define PG8_SA(b, h) (((b) * 2 + (h)) * HTB)
#define PG8_SB(b, h) ((4 + (b) * 2 + (h)) * HTB)
#define PG8_STAGE_B(bufoff, gbase) do { _Pragma("unroll") for (int _i = 0; _i < 2; ++_i) \
        __builtin_amdgcn_raw_ptr_buffer_load_lds(rs, (LAS unsigned*)(lds + (bufoff) + ldsw + _i * 8192), 16, (int)voffB[_i], (int)(gbase), 0, 0); } while (0)
#define PG8_STAGE_A(bufoff, gbase, h) do { _Pragma("unroll") for (int _i = 0; _i < 2; ++_i) \
        __builtin_amdgcn_raw_ptr_buffer_load_lds(rs, (LAS unsigned*)(lds + (bufoff) + ldsw + _i * 8192), 16, (int)voffA[Sched::GATHER ? (h) * 2 + _i : _i], (int)((gbase) + (Sched::GATHER ? 0u : (unsigned)(h) * hstepA)), 0, 0); } while (0)
#define PG8_LDA(dst, b, h) do { _Pragma("unroll") for (int m = 0; m < 4; ++m) _Pragma("unroll") for (int k = 0; k < 2; ++k) dst[m][k] = *(const LAS bf16x8*)(lds + PG8_SA(b, h) + aoff + m * 2048 + k * kpiece); } while (0)
#define PG8_LDB(dst, b, h) do { _Pragma("unroll") for (int n = 0; n < 2; ++n) _Pragma("unroll") for (int k = 0; k < 2; ++k) dst[n][k] = *(const LAS bf16x8*)(lds + PG8_SB(b, h) + boff + n * 2048 + k * kpiece); } while (0)
#define PG8_MMA(ai, bj, At, Bt) do { __builtin_amdgcn_s_setprio(1); if constexpr (FP8) { _Pragma("unroll") for (int m = 0; m < 4; ++m) _Pragma("unroll") for (int n = 0; n < 2; ++n) \
        acc[ai][bj][m][n] = __builtin_amdgcn_mfma_scale_f32_16x16x128_f8f6f4(frag8(Bt[n][0], Bt[n][1]), frag8(At[m][0], At[m][1]), acc[ai][bj][m][n], 0, 0, 0, 0x7C7C7C7C, 0, 0x7C7C7C7C); } \
      else { _Pragma("unroll") for (int m = 0; m < 4; ++m) _Pragma("unroll") for (int n = 0; n < 2; ++n) _Pragma("unroll") for (int k = 0; k < 2; ++k) \
        acc[ai][bj][m][n] = __builtin_amdgcn_mfma_f32_16x16x32_bf16(Bt[n][k], At[m][k], acc[ai][bj][m][n], 0, 0, 0); } __builtin_amdgcn_s_setprio(0); } while (0)
#define PG8_MMA2(ai, At) do { if constexpr (Sched::BLOCKDIAG) { if (lo_half) PG8_MMA(ai, 0, At, B0); else PG8_MMA(ai, 1, At, B1); } else { PG8_MMA(ai, 0, At, B0); PG8_MMA(ai, 1, At, B1); } } while (0)
#define PG8_WAIT_V(n) asm volatile("s_waitcnt vmcnt(" #n ")" ::: "memory")
#define PG8_WAIT_L(n) asm volatile("s_waitcnt lgkmcnt(" #n ")" ::: "memory")
#define PG8_BAR __builtin_amdgcn_s_barrier()
#define PG8_SCHED __builtin_amdgcn_sched_barrier(0)
    Unit cur, nxt; int ui = 0;
    if (!S.next(0, cur)) return;
    S.offs(cur, RA, CA, voffA);
    f32x4 acc[2][2][4][2];
#pragma unroll
    for (int a = 0; a < 2; ++a)
#pragma unroll
        for (int b = 0; b < 2; ++b)
#pragma unroll
            for (int m = 0; m < 4; ++m)
#pragma unroll
                for (int n = 0; n < 2; ++n) acc[a][b][m][n] = (f32x4){0.f, 0.f, 0.f, 0.f};
    bf16x8 At[4][2], B0[2][2], B1[2][2];
    unsigned cA = cur.a, cB = cur.b;
    PG8_STAGE_B(PG8_SB(0, 0), cB); PG8_STAGE_B(PG8_SB(0, 1), cB + hstepB); PG8_STAGE_A(PG8_SA(0, 0), cA, 0); PG8_STAGE_A(PG8_SA(0, 1), cA, 1);
    if (wr == 1) PG8_BAR;
    PG8_WAIT_V(2); PG8_BAR;
    PG8_STAGE_B(PG8_SB(1, 0), cB + kstep); PG8_STAGE_A(PG8_SA(1, 0), cA + kstep, 0); PG8_STAGE_B(PG8_SB(1, 1), cB + hstepB + kstep);
    PG8_WAIT_V(6); PG8_BAR;
    for (;;) {
        const bool has_next = S.next(ui + 1, nxt);
        const unsigned nA = has_next ? nxt.a : cA, nB = has_next ? nxt.b : cB;
        unsigned nvoff[4];
        if constexpr (Sched::GATHER) { if (has_next) S.rows(nxt, RA, nvoff); }
#pragma nounroll
        for (int t = 0; t < nt; t += 2) {
            const bool last = (t == nt - 2), lo_half = t < (nt >> 1);
            const unsigned a1 = cA + (unsigned)(t + 1) * kstep;
            const unsigned a2 = last ? nA : cA + (unsigned)(t + 2) * kstep, b2 = last ? nB : cB + (unsigned)(t + 2) * kstep;
            const unsigned a3 = a2 + kstep, b3 = b2 + kstep;
            PG8_LDB(B0, 0, 0); PG8_LDB(B1, 0, 1); PG8_SCHED; PG8_LDA(At, 0, 0); PG8_STAGE_A(PG8_SA(1, 1), a1, 1);
            PG8_WAIT_V(8); PG8_WAIT_L(0); PG8_BAR; PG8_MMA2(0, At); PG8_BAR; PG8_SCHED;
            if constexpr (Sched::GATHER) { if (last && has_next) {
#pragma unroll
                for (int q = 0; q < 4; ++q) voffA[q] = nvoff[q] * (unsigned)S.pa + (unsigned)(CA[q & 1] * 2); } }
            PG8_LDA(At, 0, 1); PG8_STAGE_B(PG8_SB(0, 0), b2); PG8_STAGE_B(PG8_SB(0, 1), b2 + hstepB); PG8_STAGE_A(PG8_SA(0, 0), a2, 0);
            PG8_WAIT_V(8); PG8_WAIT_L(0); PG8_BAR; PG8_MMA2(1, At); PG8_BAR; PG8_SCHED;
            PG8_LDB(B0, 1, 0); PG8_LDB(B1, 1, 1); PG8_SCHED; PG8_LDA(At, 1, 0); PG8_STAGE_A(PG8_SA(0, 1), a2, 1);
            PG8_WAIT_V(8); PG8_WAIT_L(0); PG8_BAR; PG8_MMA2(0, At); PG8_BAR; PG8_SCHED;
            PG8_LDA(At, 1, 1); PG8_STAGE_B(PG8_SB(1, 0), b3); PG8_STAGE_B(PG8_SB(1, 1), b3 + hstepB); PG8_STAGE_A(PG8_SA(1, 0), a3, 0);
            PG8_WAIT_V(8); PG8_WAIT_L(0); PG8_BAR; PG8_MMA2(1, At); PG8_BAR; PG8_SCHED;
        }
        if (wr == 0) PG8_BAR;
        { const int t2 = fresh_tid() & 63; E(acc, cur, wr, wc, t2 & 15, t2 >> 4, lds + LDS_EPI); }
        if (!has_next) break;
#pragma unroll
        for (int a = 0; a < 2; ++a)
#pragma unroll
            for (int b = 0; b < 2; ++b)
#pragma unroll
                for (int m = 0; m < 4; ++m)
#pragma unroll
                    for (int n = 0; n < 2; ++n) acc[a][b][m][n] = (f32x4){0.f, 0.f, 0.f, 0.f};
        cur = nxt; cA = nA; cB = nB; ++ui;
        if (wr == 1) PG8_BAR;
    }
    PG8_WAIT_V(0);
    PG8_BAR;
#undef PG8_SA
#undef PG8_SB
#undef PG8_STAGE_A
#undef PG8_STAGE_B
#undef PG8_LDA
#undef PG8_LDB
#undef PG8_MMA
#undef PG8_MMA2
#undef PG8_WAIT_V
#undef PG8_WAIT_L
#undef PG8_BAR
#undef PG8_SCHED
}

struct DenseSched {
    static constexpr bool GATHER = false, BLOCKDIAG = false;
    int nM, nN, nwg, G, c; int pa, pb; unsigned A, B;
    __device__ void init(int M, int N, int G_, int c_, size_t A_, int pa_, size_t B_, int pb_) { nM = M / BM; nN = N / BM; nwg = nM * nN; G = G_; c = c_; A = (unsigned)A_; B = (unsigned)B_; pa = pa_; pb = pb_; }
    __device__ __forceinline__ bool next(int i, Unit& u) const {
        const long L = (long)i * G + c; if (L >= nwg) return false;
        int wgid = (int)L; { const int q = nwg / NXCD, r = nwg % NXCD, xcd = wgid % NXCD, off = wgid / NXCD; wgid = (xcd < r ? xcd * (q + 1) : r * (q + 1) + (xcd - r) * q) + off; }
        const int nig = WGM * nN, gid = wgid / nig, fm = gid * WGM, gsz = (nM - fm) < WGM ? (nM - fm) : WGM;
        u.pm = fm + ((wgid % nig) % gsz); u.pn = (wgid % nig) / gsz; u.aux = 0;
        u.a = A + (unsigned)(u.pm * BM * pa); u.b = B + (unsigned)(u.pn * BM * pb); return true;
    }
    __device__ __forceinline__ void offs(const Unit&, const int (&RA)[2], const int (&CA)[2], unsigned (&v)[4]) const {
#pragma unroll
        for (int h = 0; h < 2; ++h)
#pragma unroll
            for (int i = 0; i < 2; ++i) v[h * 2 + i] = (unsigned)((h * HALF + RA[i]) * pa + CA[i] * 2);
    }
};
struct DiagSched : DenseSched { static constexpr bool BLOCKDIAG = true; };
template <int NPN, bool DIAG> struct PanelSched {
    static constexpr bool GATHER = false, BLOCKDIAG = DIAG;
    int nM, G, c; int pa, pb; unsigned A, B;
    __device__ void init(int M, int G_, int c_, size_t A_, int pa_, size_t B_, int pb_) { nM = M / BM; G = G_; c = c_; A = (unsigned)A_; B = (unsigned)B_; pa = pa_; pb = pb_; }
    __device__ __forceinline__ bool next(int i, Unit& u) const {
        const int k = i / NPN, pm = c + k * G; if (pm >= nM) return false;
        u.pm = pm; u.pn = i - k * NPN; u.aux = 0; u.a = A + (unsigned)(pm * BM * pa); u.b = B + (unsigned)(u.pn * BM * pb); return true;
    }
    __device__ __forceinline__ void offs(const Unit&, const int (&RA)[2], const int (&CA)[2], unsigned (&v)[4]) const {
#pragma unroll
        for (int h = 0; h < 2; ++h)
#pragma unroll
            for (int i = 0; i < 2; ++i) v[h * 2 + i] = (unsigned)((h * HALF + RA[i]) * pa + CA[i] * 2);
    }
};
}

struct Params { const float* in[21]; float* out; unsigned char* ws; int ph_lo, ph_hi; };
enum { I_X = 0, I_C, I_POS, I_WADA, I_BADA, I_GMIX, I_GFFN, I_WIN, I_WBG, I_QG, I_KG, I_WBD, I_WBS, I_WOUT, I_WRG, I_BRG, I_WRE, I_BRE, I_WEG, I_WEU, I_WED };

struct Frame {
    LAS unsigned char* lds;
    unsigned char* ws;
    int tid, lane, wave, G, bid;
};

template <bool FP8>
DI void p0_transpose_item(const float* W, int N, void* WTv, int ldt, int k0, int n0, int row_base, LAS float* scr, int lane) {
#pragma unroll 8
    for (int i = 0; i < 32; ++i) { const int kk = 2 * i + (lane >> 5); scr[kk * 33 + (lane & 31)] = W[(size_t)(k0 + kk) * N + n0 + (lane & 31)]; }
    LDS_WAIT();
    const int c = lane & 7;
#pragma unroll
    for (int j = 0; j < 4; ++j) { const int n = (lane >> 3) + 8 * j; const LAS float* sp = scr + (8 * c) * 33 + n;
        if (FP8) { u32x2 o; o.x = pk4_fp8(64.f * sp[0 * 33], 64.f * sp[1 * 33], 64.f * sp[2 * 33], 64.f * sp[3 * 33]); o.y = pk4_fp8(64.f * sp[4 * 33], 64.f * sp[5 * 33], 64.f * sp[6 * 33], 64.f * sp[7 * 33]);
            *(u32x2*)((unsigned char*)WTv + (size_t)(row_base + n) * ldt + k0 + 8 * c) = o; }
        else { u32x4 o; o.x = pk2(sp[0 * 33], sp[1 * 33]); o.y = pk2(sp[2 * 33], sp[3 * 33]); o.z = pk2(sp[4 * 33], sp[5 * 33]); o.w = pk2(sp[6 * 33], sp[7 * 33]);
            *(u32x4*)((bf16_t*)WTv + (size_t)(row_base + n) * ldt + k0 + 8 * c) = o; } }
    LDS_WAIT();
}
DI void phase0(const Frame& F, const Params& p) {
    LAS float* scr = (LAS float*)(F.lds + F.wave * 16384);
    const int gw = F.bid * 8 + F.wave, NGW = F.G * 8;
    bf16_t* W1 = (bf16_t*)(F.ws + WS_W1); bf16_t* WB = (bf16_t*)(F.ws + WS_WB); bf16_t* WO = (bf16_t*)(F.ws + WS_WO);
    unsigned char* WG8 = F.ws + WS_WG8; unsigned char* WGU = F.ws + WS_WGU; unsigned char* WDN = F.ws + WS_WDN;
    constexpr int I1 = 16 * 96, I2 = 16 * 64, I3 = 4 * 32, I4 = 4 * 32, I5 = 16 * 32, I6 = 32 * 256, I7 = 32 * 256, I8 = 32 * 256;
    constexpr int NITEMS = I1 + I2 + I3 + I4 + I5 + I6 + I7 + I8;
    for (int it = gw; it < NITEMS; it += NGW) {
        int r = it;
        if (r < I1) { const int kb = r / 96, nb = r % 96; if (nb < 72) p0_transpose_item<true>(p.in[I_WIN], 3072, F.ws + WS_W1D8, 1024, 64 * kb, 32 * nb, 32 * nb, scr, F.lane); else p0_transpose_item<false>(p.in[I_WIN], 3072, W1, 1024, 64 * kb, 32 * nb, 32 * nb, scr, F.lane); continue; } r -= I1;
        if (r < I2) { const int kb = r / 64, nb = r % 64; p0_transpose_item<true>(p.in[I_WBG], 2048, WG8, 1024, 64 * kb, 32 * nb, 32 * nb, scr, F.lane); continue; } r -= I2;
        if (r < I3) { const int kb = r / 32, nb = r % 32, n0 = 32 * nb; p0_transpose_item<false>(p.in[I_WBD], 1024, WB, 512, 64 * kb, n0, (n0 >> 7) * 256 + (n0 & 127), scr, F.lane); continue; } r -= I3;
        if (r < I4) { const int kb = r / 32, nb = r % 32, n0 = 32 * nb; p0_transpose_item<false>(p.in[I_WBS], 1024, WB + 256, 512, 64 * kb, n0, (n0 >> 7) * 256 + 128 + (n0 & 127), scr, F.lane); continue; } r -= I4;
        if (r < I5) { const int kb = r / 32, nb = r % 32; p0_transpose_item<true>(p.in[I_WOUT], 1024, WO, 1024, 64 * kb, 32 * nb, 32 * nb, scr, F.lane); continue; } r -= I5;
        if (r < I6) { const int e = r >> 8, q = r & 255, kb = q >> 4, nb = q & 15, n0 = 32 * nb;
            p0_transpose_item<true>(p.in[I_WEG] + (size_t)e * 1024 * 512, 512, WGU + (size_t)e * 1024 * 1024, 1024, 64 * kb, n0, (n0 >> 7) * 256 + (n0 & 127), scr, F.lane); continue; } r -= I6;
        if (r < I7) { const int e = r >> 8, q = r & 255, kb = q >> 4, nb = q & 15, n0 = 32 * nb;
            p0_transpose_item<true>(p.in[I_WEU] + (size_t)e * 1024 * 512, 512, WGU + (size_t)e * 1024 * 1024, 1024, 64 * kb, n0, (n0 >> 7) * 256 + 128 + (n0 & 127), scr, F.lane); continue; } r -= I7;
        { const int e = r >> 8, q = r & 255, kb = q >> 5, nb = q & 31;
            p0_transpose_item<true>(p.in[I_WED] + (size_t)e * 512 * 1024, 1024, WDN + (size_t)e * 1024 * 512, 512, 64 * kb, 32 * nb, 32 * nb, scr, F.lane); }
    }
    {
        bf16_t* WBz = (bf16_t*)(F.ws + WS_WB);
        for (int idx = F.bid * 512 + F.tid; idx < 2048 * 32; idx += F.G * 512) { const int row = idx >> 5, c = idx & 31; *(u32x4*)(WBz + (size_t)row * 512 + ((row & 128) ? 0 : 256) + c * 8) = (u32x4){0u, 0u, 0u, 0u}; }
    }
    {
        float* modp = (float*)(F.ws + WS_MODP); const float* c = p.in[I_C]; const float* wada = p.in[I_WADA];
        for (int task = gw; task < 96 * 8; task += NGW) {
            const int ct = task % 96, ks = task / 96, k0 = ks * 128;
#pragma unroll
            for (int i = 0; i < 16; ++i) { const int idx = i * 64 + F.lane, b = idx >> 7, k = idx & 127; const float v = c[b * 1024 + k0 + k]; scr[idx] = v * sigmoidf(v); }
            LDS_WAIT();
            float acc[8];
#pragma unroll
            for (int b = 0; b < 8; ++b) acc[b] = 0.f;
            const float* wp = wada + (size_t)k0 * 6144 + ct * 64 + F.lane;
#pragma unroll 8
            for (int k = 0; k < 128; ++k) { const float w = wp[(size_t)k * 6144];
#pragma unroll
                for (int b = 0; b < 8; ++b) acc[b] += scr[b * 128 + k] * w; }
#pragma unroll
            for (int b = 0; b < 8; ++b) modp[((size_t)ks * 8 + b) * 6144 + ct * 64 + F.lane] = acc[b];
            LDS_WAIT();
        }
    }
}

DI float inv_freq_of(int i) {
    return i == 0 ? 1.0f : i == 1 ? 0.1939227432012558f : i == 2 ? 0.03760603070259094f : i == 3 ? 0.007292664609849453f : i == 4 ? 0.0014142135623842478f : i == 5 ? 0.00027424818836152554f : i == 6 ? 5.318296098266728e-05f : 1.0313386155758053e-05f;
}
template <int WHICH>
DI void phase_norm(const Frame& F, const Params& p) {
    LAS float* gs = (LAS float*)(F.lds); LAS float* sh = gs + 1024;
    const float* modp = (const float*)(F.ws + WS_MODP); float* mod = (float*)(F.ws + WS_MOD); const float* bada = p.in[I_BADA];
    const float* xin = p.in[I_X]; const bf16_t* upd = (const bf16_t*)(F.ws + WS_UPD1); bf16_t* hout = (bf16_t*)(F.ws + (WHICH == 0 ? WS_H : WS_H2)); unsigned* h8 = (unsigned*)(F.ws + (WHICH == 0 ? WS_H8 : WS_H28));
    const float* gn = p.in[WHICH == 0 ? I_GMIX : I_GFFN];
    for (int chunk = F.bid; chunk < T / 256; chunk += F.G) {
        const int b = chunk >> 5;
        __syncthreads();
        if (WHICH == 0) {
            if (F.tid < 192) { const int j = (chunk & 31) * 192 + F.tid; float s = bada[j];
#pragma unroll
                for (int ks = 0; ks < 8; ++ks) s += modp[((size_t)ks * 8 + b) * 6144 + j];
                mod[b * 6144 + j] = s; }
            for (int col = F.tid; col < 1024; col += 512) { float s1 = bada[col], s2 = bada[1024 + col];
#pragma unroll
                for (int ks = 0; ks < 8; ++ks) { s1 += modp[((size_t)ks * 8 + b) * 6144 + col]; s2 += modp[((size_t)ks * 8 + b) * 6144 + 1024 + col]; }
                gs[col] = gn[col] * (1.f + s2); sh[col] = s1; }
        } else {
            for (int col = F.tid; col < 1024; col += 512) { gs[col] = gn[col] * (1.f + mod[b * 6144 + 4096 + col]); sh[col] = mod[b * 6144 + 3072 + col]; }
        }
        __syncthreads();
        f32x4 g4[4], s4[4];
#pragma unroll
        for (int j = 0; j < 4; ++j) { g4[j] = *(const LAS f32x4*)(gs + 256 * j + 4 * F.lane); s4[j] = *(const LAS f32x4*)(sh + 256 * j + 4 * F.lane); }
        for (int rr = F.wave; rr < 256; rr += 8) {
            const int row = chunk * 256 + rr;
            const f32x4* xr = (const f32x4*)(xin + (size_t)row * 1024) + F.lane;
            f32x4 v[4]; float ss = 0.f;
#pragma unroll
            for (int j = 0; j < 4; ++j) v[j] = xr[64 * j];
            if (WHICH == 1) { const u32x2* ur = (const u32x2*)(upd + (size_t)row * 1024) + F.lane; u32x2 uu[4];
#pragma unroll
                for (int j = 0; j < 4; ++j) uu[j] = ur[64 * j];
#pragma unroll
                for (int j = 0; j < 4; ++j) { v[j].x += bf_lo(uu[j].x); v[j].y += bf_hi(uu[j].x); v[j].z += bf_lo(uu[j].y); v[j].w += bf_hi(uu[j].y); } }
#pragma unroll
            for (int j = 0; j < 4; ++j) ss += (v[j].x * v[j].x + v[j].y * v[j].y) + (v[j].z * v[j].z + v[j].w * v[j].w);
            const float rinv = __builtin_amdgcn_rsqf(wave_sum(ss) * (1.f / 1024.f) + RMS_EPS);
            u32x2* o8 = (u32x2*)(hout + (size_t)row * 1024) + F.lane;
#pragma unroll
            for (int j = 0; j < 4; ++j) { const f32x4 y = v[j] * rinv * g4[j] + s4[j]; u32x2 o; o.x = pk2(y.x, y.y); o.y = pk2(y.z, y.w); o8[64 * j] = o; h8[(size_t)row * 256 + 64 * j + F.lane] = pk4_fp8(y.x, y.y, y.z, y.w); }
            if (WHICH == 0 && F.lane < 8) {
                const int pos = ((const int*)p.in[I_POS])[row];
                const float angf = (float)pos * inv_freq_of(F.lane);
                double rv = (double)angf * 0.15915494309189535; rv -= __builtin_rint(rv);
                const float fr = (float)rv;
                bf16_t* rp = (bf16_t*)(F.ws + WS_ROPE) + (size_t)row * 16;
                rp[F.lane] = (bf16_t)(pk2(__builtin_amdgcn_cosf(fr), 0.f) & 0xffffu); rp[8 + F.lane] = (bf16_t)(pk2(__builtin_amdgcn_sinf(fr), 0.f) & 0xffffu);
            }
        }
    }
}

template <bool GATES> struct EpiProj {
    static constexpr bool PERM = true;
    bf16_t* proj; bf16_t* gates; const bf16_t* rope; const float* qg; const float* kg; int pn0;
    DI void operator()(const f32x4 (&acc)[2][2][4][2], const pg8::Unit& u, int wr, int wc, int fr, int fq, LAS unsigned char* scr) const {
        asm volatile("" : "+v"(fr), "+v"(fq));
        const int pn = u.pn + pn0, row0 = u.pm * 256 + wr * 64 + fr, cw = wc * 32 + 8 * fq;
        const int typ = pn < 9 ? pn / 3 : pn - 9, grp = pn < 9 ? pn % 3 : 0, l2d = pn < 9 ? 2 * grp : 0, hbase = pn < 9 ? grp * 4 : 12;
        if (GATES) {
            unsigned char* base = (unsigned char*)gates + pn * 256 + cw;
#pragma unroll
            for (int ai = 0; ai < 2; ++ai)
#pragma unroll
                for (int m = 0; m < 4; ++m) { unsigned char* rowp = base + (size_t)(row0 + ai * 128 + m * 16) * LDG;
#pragma unroll
                    for (int bj = 0; bj < 2; ++bj) { const f32x4 v0 = acc[ai][bj][m][0], v1 = acc[ai][bj][m][1];
                        u32x2 w; w.x = pk4_fp8(v0.x, v0.y, v0.z, v0.w); w.y = pk4_fp8(v1.x, v1.y, v1.z, v1.w);
                        *(u32x2*)(rowp + bj * 128) = w; } }
        } else if (pn >= 6) {
            const float sc = pn == 9 ? QSCALE : 1.f;
            const int dim0 = (wc & 1) * 32 + 8 * fq;
#pragma unroll
            for (int ai = 0; ai < 2; ++ai)
#pragma unroll
                for (int m = 0; m < 4; ++m) { const int t = row0 + ai * 128 + m * 16, sq = t & (S - 1); const int rp = (t & ~(S - 1)) + ((sq & ((1 << l2d) - 1)) << (13 - l2d)) + (sq >> l2d);
#pragma unroll
                    for (int bj = 0; bj < 2; ++bj) { const f32x4 v0 = acc[ai][bj][m][0] * sc, v1 = acc[ai][bj][m][1] * sc; const int head = hbase + 2 * bj + (wc >> 1);
                        u32x4 w; w.x = pk2(v0.x, v0.y); w.y = pk2(v0.z, v0.w); w.z = pk2(v1.x, v1.y); w.w = pk2(v1.z, v1.w);
                        *(u32x4*)(proj + ((size_t)(typ * 16 + head) * T + rp) * 64 + dim0) = w; } }
        } else {
            const bool isq = pn < 3; const float* g = isq ? qg : kg; const float sc = isq ? QSCALE : 1.f;
            LAS float* part = (LAS float*)scr;
            const int ch = (wc & 1) * 32 + 8 * fq;
            const f32x4 g0 = *(const f32x4*)(g + ch), g1 = *(const f32x4*)(g + ch + 4);
            const bool ropew = (wc & 1) == 0;
            u32x4 rcs[2][4][2];
            if (ropew) {
#pragma unroll
                for (int ai = 0; ai < 2; ++ai)
#pragma unroll
                    for (int m = 0; m < 4; ++m) { const u32x4* rpt = (const u32x4*)(rope + (size_t)(u.pm * 256 + ai * 128 + wr * 64 + m * 16 + fr) * 16); rcs[ai][m][0] = rpt[0]; rcs[ai][m][1] = rpt[1]; }
            }
#pragma unroll
            for (int ai = 0; ai < 2; ++ai)
#pragma unroll
                for (int m = 0; m < 4; ++m)
#pragma unroll
                    for (int bj = 0; bj < 2; ++bj) { const f32x4 a = acc[ai][bj][m][0], b = acc[ai][bj][m][1];
                        float ss = (a.x * a.x + a.y * a.y) + (a.z * a.z + a.w * a.w) + (b.x * b.x + b.y * b.y) + (b.z * b.z + b.w * b.w);
                        ss += __shfl_xor(ss, 16); ss += __shfl_xor(ss, 32);
                        if (fq == 0) part[((ai * 128 + wr * 64 + m * 16 + fr) * 2 + bj) * 4 + wc] = ss; }
            LDS_WAIT(); __builtin_amdgcn_s_barrier(); asm volatile("" ::: "memory");
#pragma unroll
            for (int ai = 0; ai < 2; ++ai)
#pragma unroll
                for (int m = 0; m < 4; ++m) { const int rl = ai * 128 + wr * 64 + m * 16 + fr, row = u.pm * 256 + rl, sq = row & (S - 1);
                    const int rp = (row & ~(S - 1)) + ((sq & ((1 << l2d) - 1)) << (13 - l2d)) + (sq >> l2d);
                    f32x4 c0 = {0, 0, 0, 0}, c1 = c0, s0 = c0, s1 = c0;
                    if (ropew) { const u32x4 cc = rcs[ai][m][0], sn = rcs[ai][m][1];
                        c0 = (f32x4){bf_lo(cc.x), bf_hi(cc.x), bf_lo(cc.y), bf_hi(cc.y)}; c1 = (f32x4){bf_lo(cc.z), bf_hi(cc.z), bf_lo(cc.w), bf_hi(cc.w)};
                        s0 = (f32x4){bf_lo(sn.x), bf_hi(sn.x), bf_lo(sn.y), bf_hi(sn.y)}; s1 = (f32x4){bf_lo(sn.z), bf_hi(sn.z), bf_lo(sn.w), bf_hi(sn.w)};
                        if (fq == 0) { s0 = -s0; s1 = -s1; } }
#pragma unroll
                    for (int bj = 0; bj < 2; ++bj) {
                        const float tot = part[(rl * 2 + bj) * 4 + wc] + part[(rl * 2 + bj) * 4 + (wc ^ 1)];
                        const float rinv = __builtin_amdgcn_rsqf(tot * (1.f / 64.f) + RMS_EPS);
                        f32x4 v0 = acc[ai][bj][m][0] * rinv * g0, v1 = acc[ai][bj][m][1] * rinv * g1;
                        if (ropew) {
                            f32x4 p0, p1;
                            p0.x = __shfl_xor(v0.x, 16); p0.y = __shfl_xor(v0.y, 16); p0.z = __shfl_xor(v0.z, 16); p0.w = __shfl_xor(v0.w, 16);
                            p1.x = __shfl_xor(v1.x, 16); p1.y = __shfl_xor(v1.y, 16); p1.z = __shfl_xor(v1.z, 16); p1.w = __shfl_xor(v1.w, 16);
                            if (fq < 2) { v0 = v0 * c0 + p0 * s0; v1 = v1 * c1 + p1 * s1; }
                        }
                        v0 = v0 * sc; v1 = v1 * sc; const int head = hbase + 2 * bj + (wc >> 1);
                        u32x4 w; w.x = pk2(v0.x, v0.y); w.y = pk2(v0.z, v0.w); w.z = pk2(v1.x, v1.y); w.w = pk2(v1.z, v1.w);
                        *(u32x4*)(proj + ((size_t)(typ * 16 + head) * T + rp) * 64 + ch) = w; } }
        }
    }
};

struct EpiBranch {
    static constexpr bool PERM = true;
    const unsigned char* gates; unsigned char* merged;
    DI void operator()(const f32x4 (&acc)[2][2][4][2], const pg8::Unit& u, int wr, int wc, int fr, int fq, LAS unsigned char*) const {
        asm volatile("" : "+v"(fr), "+v"(fq));
        const int row0 = u.pm * 256 + wr * 64 + fr, col0 = u.pn * 128 + wc * 32 + 8 * fq;
        u32x2 gd[2][4], gs[2][4];
#pragma unroll
        for (int ai = 0; ai < 2; ++ai)
#pragma unroll
            for (int m = 0; m < 4; ++m) { const size_t row = (size_t)(row0 + ai * 128 + m * 16);
                gd[ai][m] = *(const u32x2*)(gates + row * LDG + col0); gs[ai][m] = *(const u32x2*)(gates + row * LDG + 1024 + col0); }
        __builtin_amdgcn_sched_barrier(0);
#pragma unroll
        for (int ai = 0; ai < 2; ++ai)
#pragma unroll
            for (int m = 0; m < 4; ++m) { const size_t row = (size_t)(row0 + ai * 128 + m * 16);
                const u32x2 g = gd[ai][m], q = gs[ai][m];
                const f32x2 ga = fp8_lo2(g.x), gb = fp8_hi2(g.x), gc = fp8_lo2(g.y), gdd = fp8_hi2(g.y), qa = fp8_lo2(q.x), qb = fp8_hi2(q.x), qc = fp8_lo2(q.y), qd = fp8_hi2(q.y);
                const f32x4 v0 = acc[ai][0][m][0] * (f32x4){sigmoidf(ga.x), sigmoidf(ga.y), sigmoidf(gb.x), sigmoidf(gb.y)} + acc[ai][1][m][0] * (f32x4){sigmoidf(qa.x), sigmoidf(qa.y), sigmoidf(qb.x), sigmoidf(qb.y)};
                const f32x4 v1 = acc[ai][0][m][1] * (f32x4){sigmoidf(gc.x), sigmoidf(gc.y), sigmoidf(gdd.x), sigmoidf(gdd.y)} + acc[ai][1][m][1] * (f32x4){sigmoidf(qc.x), sigmoidf(qc.y), sigmoidf(qd.x), sigmoidf(qd.y)};
                u32x2 w; w.x = pk4_fp8(8.f * v0.x, 8.f * v0.y, 8.f * v0.z, 8.f * v0.w); w.y = pk4_fp8(8.f * v1.x, 8.f * v1.y, 8.f * v1.z, 8.f * v1.w);
                *(u32x2*)(merged + row * 1024 + col0) = w; }
    }
};
struct BranchSched {
    static constexpr bool GATHER = false;
    int G, c; int pa, pb; unsigned A, B;
    DI bool next(int i, pg8::Unit& u) const {
        const int tile = (i >> 1) * G + c; if (tile >= 256 * 4) return false;
        u.pm = tile >> 2; u.pn = tile & 3; u.aux = i & 1;
        u.a = A + (unsigned)(u.pm * 256 * LDO * 2 + u.aux * 256 * 2); u.b = B + (unsigned)(u.aux * 1024 * 256 * 2 + u.pn * 256 * 256 * 2); return true;
    }
    DI void offs(const pg8::Unit&, const int (&RA)[2], const int (&CA)[2], unsigned (&v)[4]) const {
#pragma unroll
        for (int h = 0; h < 2; ++h)
#pragma unroll
            for (int i = 0; i < 2; ++i) v[h * 2 + i] = (unsigned)((h * 128 + RA[i]) * pa + CA[i] * 2);
    }
};

struct EpiOut {
    static constexpr bool PERM = true;
    bf16_t* upd; const float* mod;
    DI void operator()(const f32x4 (&acc)[2][2][4][2], const pg8::Unit& u, int wr, int wc, int fr, int fq, LAS unsigned char*) const {
        asm volatile("" : "+v"(fr), "+v"(fq));
        const int row0 = u.pm * 256 + wr * 64 + fr, col0 = u.pn * 256 + wc * 32 + 8 * fq; const int b = (u.pm * 256) >> 13;
        f32x4 gv[2][2];
#pragma unroll
        for (int bj = 0; bj < 2; ++bj)
#pragma unroll
            for (int n = 0; n < 2; ++n) gv[bj][n] = *(const f32x4*)(mod + b * 6144 + 2048 + col0 + bj * 128 + n * 4) * 0.125f;
#pragma unroll
        for (int ai = 0; ai < 2; ++ai)
#pragma unroll
            for (int m = 0; m < 4; ++m)
#pragma unroll
                for (int bj = 0; bj < 2; ++bj) { const f32x4 v0 = acc[ai][bj][m][0] * gv[bj][0], v1 = acc[ai][bj][m][1] * gv[bj][1];
                    u32x4 w; w.x = pk2(v0.x, v0.y); w.y = pk2(v0.z, v0.w); w.z = pk2(v1.x, v1.y); w.w = pk2(v1.z, v1.w);
                    *(u32x4*)(upd + (size_t)(row0 + ai * 128 + m * 16) * 1024 + col0 + bj * 128) = w; }
    }
};

struct EpiLogit {
    static constexpr bool PERM = false;
    float* logit;
    DI void operator()(const f32x4 (&acc)[2][2][4][2], const pg8::Unit& u, int wr, int wc, int fr, int fq, LAS unsigned char*) const {
        asm volatile("" : "+v"(fr), "+v"(fq));
        const int row0 = u.pm * 256 + wr * 64 + fr, col0 = wc * 32 + 4 * fq;
#pragma unroll
        for (int ai = 0; ai < 2; ++ai)
#pragma unroll
            for (int m = 0; m < 4; ++m)
#pragma unroll
                for (int n = 0; n < 2; ++n) *(f32x4*)(logit + (size_t)(row0 + ai * 128 + m * 16) * 128 + col0 + n * 16) = acc[ai][0][m][n];
    }
};

struct MoeSched {
    static constexpr bool GATHER_ = true;
    int G, c, nc; int pa, pb; unsigned A, B; const LAS int* cstart; const int* slot_tok; unsigned estride, pnstride;
};
struct MoeSchedUp : MoeSched {
    static constexpr bool GATHER = true, BLOCKDIAG = false;
    DI bool next(int i, pg8::Unit& u) const {
        const int L = i * G + c; if (L >= nc * 4) return false;
        const int chunk = L >> 2; int e = 0;
        for (int q = 1; q < 32; ++q) e += (chunk >= cstart[q]) ? 1 : 0;
        u.pm = chunk; u.pn = L & 3; u.aux = e; u.a = A; u.b = B + (unsigned)e * estride + (unsigned)u.pn * pnstride; return true;
    }
    DI void offs(const pg8::Unit& u, const int (&RA)[2], const int (&CA)[2], unsigned (&v)[4]) const {
#pragma unroll
        for (int h = 0; h < 2; ++h)
#pragma unroll
            for (int i = 0; i < 2; ++i) { const int tok = slot_tok[u.pm * 256 + h * 128 + RA[i]]; v[h * 2 + i] = (unsigned)(tok * pa + CA[i] * 2); }
    }
    DI void rows(const pg8::Unit& u, const int (&RA)[2], unsigned (&v)[4]) const {
#pragma unroll
        for (int h = 0; h < 2; ++h)
#pragma unroll
            for (int i = 0; i < 2; ++i) v[h * 2 + i] = (unsigned)slot_tok[u.pm * 256 + h * 128 + RA[i]];
    }
};
struct MoeSchedDn : MoeSched {
    static constexpr bool GATHER = false, BLOCKDIAG = false;
    DI bool next(int i, pg8::Unit& u) const {
        const int L = i * G + c; if (L >= nc * 4) return false;
        const int chunk = L >> 2; int e = 0;
        for (int q = 1; q < 32; ++q) e += (chunk >= cstart[q]) ? 1 : 0;
        u.pm = chunk; u.pn = L & 3; u.aux = e; u.a = A + (unsigned)(chunk * 256 * pa); u.b = B + (unsigned)e * estride + (unsigned)u.pn * pnstride; return true;
    }
    DI void offs(const pg8::Unit&, const int (&RA)[2], const int (&CA)[2], unsigned (&v)[4]) const {
#pragma unroll
        for (int h = 0; h < 2; ++h)
#pragma unroll
            for (int i = 0; i < 2; ++i) v[h * 2 + i] = (unsigned)((h * 128 + RA[i]) * pa + CA[i] * 2);
    }
};
struct EpiSwiglu {
    static constexpr bool PERM = true;
    unsigned char* hmid;
    DI void operator()(const f32x4 (&acc)[2][2][4][2], const pg8::Unit& u, int wr, int wc, int fr, int fq, LAS unsigned char*) const {
        asm volatile("" : "+v"(fr), "+v"(fq));
        const int row0 = u.pm * 256 + wr * 64 + fr, col0 = u.pn * 128 + wc * 32 + 8 * fq;
#pragma unroll
        for (int ai = 0; ai < 2; ++ai)
#pragma unroll
            for (int m = 0; m < 4; ++m) {
                f32x4 h[2];
#pragma unroll
                for (int n = 0; n < 2; ++n) { const f32x4 g = acc[ai][0][m][n], up = acc[ai][1][m][n];
                    h[n] = (f32x4){g.x * sigmoidf(g.x) * up.x, g.y * sigmoidf(g.y) * up.y, g.z * sigmoidf(g.z) * up.z, g.w * sigmoidf(g.w) * up.w}; }
                u32x2 w; w.x = pk4_fp8(h[0].x, h[0].y, h[0].z, h[0].w); w.y = pk4_fp8(h[1].x, h[1].y, h[1].z, h[1].w);
                *(u32x2*)(hmid + (size_t)(row0 + ai * 128 + m * 16) * DE + col0) = w; }
    }
};
struct EpiDown {
    static constexpr bool PERM = true;
    unsigned char* y;
    DI void operator()(const f32x4 (&acc)[2][2][4][2], const pg8::Unit& u, int wr, int wc, int fr, int fq, LAS unsigned char*) const {
        asm volatile("" : "+v"(fr), "+v"(fq));
        const int row0 = u.pm * 256 + wr * 64 + fr, col0 = u.pn * 256 + wc * 32 + 8 * fq;
#pragma unroll
        for (int ai = 0; ai < 2; ++ai)
#pragma unroll
            for (int m = 0; m < 4; ++m) { const int slot = row0 + ai * 128 + m * 16;
#pragma unroll
                for (int bj = 0; bj < 2; ++bj) { const f32x4 v0 = acc[ai][bj][m][0] * 8.f, v1 = acc[ai][bj][m][1] * 8.f;
                    u32x2 o; o.x = pk4_fp8(v0.x, v0.y, v0.z, v0.w); o.y = pk4_fp8(v1.x, v1.y, v1.z, v1.w);
                    *(u32x2*)(y + (size_t)slot * 1024 + col0 + bj * 128) = o; } }
    }
};

constexpr int SLOT_BYTES = 8192;
DI f32x16 mfma32(bf16x8 a, bf16x8 b, f32x16 c) { return __builtin_amdgcn_mfma_f32_32x32x16_bf16(a, b, c, 0, 0, 0); }
DI int swz_f(int r) { return (((r >> 1) & 1) << 2) | ((r >> 2) & 3); }
struct AttnLane { unsigned doff[4]; unsigned ka[4]; unsigned va[2][2]; };
DI void attn_lane_init(AttnLane& L, int lane) {
#pragma unroll
    for (int i = 0; i < 4; ++i) { const int r = 8 * i + (lane >> 3), c = (lane & 7) ^ swz_f(r); L.doff[i] = (unsigned)(r * 128 + c * 16); }
    { const int r = lane & 31, h = lane >> 5; const unsigned a0 = (unsigned)(r * 128 + 16 * ((h ^ swz_f(r)) & 7));
#pragma unroll
      for (int s = 0; s < 4; ++s) L.ka[s] = a0 ^ (unsigned)(32 * s); }
    { const int h = lane >> 5, blk = (lane >> 4) & 1, q = (lane & 15) >> 2, p = lane & 3, fb2 = (q >> 1) & 1;
#pragma unroll
      for (int t = 0; t < 2; ++t) { const int flow = (2 * t + h) & 3;
#pragma unroll
        for (int mt = 0; mt < 2; ++mt) L.va[t][mt] = (unsigned)(4096 + (8 * t + 4 * h + q) * 128 + 16 * (4 * (mt ^ fb2) + ((2 * blk + (p >> 1)) ^ flow)) + 8 * (p & 1)); } }
}
DI void dma_tile(const AttnLane& L, const __amdgpu_buffer_rsrc_t rs, unsigned koff, unsigned voff, LAS unsigned char* slot) {
#pragma unroll
    for (int i = 0; i < 4; ++i) __builtin_amdgcn_raw_ptr_buffer_load_lds(rs, (LAS unsigned*)(slot + 1024 * i), 16, (int)L.doff[i], (int)koff, 0, 0);
#pragma unroll
    for (int i = 0; i < 4; ++i) __builtin_amdgcn_raw_ptr_buffer_load_lds(rs, (LAS unsigned*)(slot + 4096 + 1024 * i), 16, (int)L.doff[i], (int)voff, 0, 0);
}
DI void tr_read8(const AttnLane& L, unsigned sb, bf16x8 (&vf)[2][2]) {
    s16x4 r0, r1, r2, r3, r4, r5, r6, r7;
    const unsigned a00 = sb + L.va[0][0], a10 = sb + L.va[1][0], a01 = sb + L.va[0][1], a11 = sb + L.va[1][1];
    asm volatile("ds_read_b64_tr_b16 %0, %8\n\tds_read_b64_tr_b16 %1, %9\n\tds_read_b64_tr_b16 %2, %8 offset:2048\n\tds_read_b64_tr_b16 %3, %9 offset:2048\n\t"
                 "ds_read_b64_tr_b16 %4, %10\n\tds_read_b64_tr_b16 %5, %11\n\tds_read_b64_tr_b16 %6, %10 offset:2048\n\tds_read_b64_tr_b16 %7, %11 offset:2048\n\ts_waitcnt lgkmcnt(0)"
                 : "=&v"(r0), "=&v"(r1), "=&v"(r2), "=&v"(r3), "=&v"(r4), "=&v"(r5), "=&v"(r6), "=&v"(r7)
                 : "v"(a00), "v"(a10), "v"(a01), "v"(a11) : "memory");
    vf[0][0] = __builtin_shufflevector(r0, r1, 0, 1, 2, 3, 4, 5, 6, 7); vf[0][1] = __builtin_shufflevector(r2, r3, 0, 1, 2, 3, 4, 5, 6, 7);
    vf[1][0] = __builtin_shufflevector(r4, r5, 0, 1, 2, 3, 4, 5, 6, 7); vf[1][1] = __builtin_shufflevector(r6, r7, 0, 1, 2, 3, 4, 5, 6, 7);
}
DI bf16x8 pack8(const f32x16& x, int s) {
    u32x4 p; p.x = pk2(x[8 * s], x[8 * s + 1]); p.y = pk2(x[8 * s + 2], x[8 * s + 3]); p.z = pk2(x[8 * s + 4], x[8 * s + 5]); p.w = pk2(x[8 * s + 6], x[8 * s + 7]);
    return __builtin_bit_cast(bf16x8, p);
}
DI void store_o_row(bf16_t* rowp, const f32x16& O0, const f32x16& O1, float sc, int h) {
#pragma unroll
    for (int mt = 0; mt < 2; ++mt)
#pragma unroll
        for (int kp = 0; kp < 2; ++kp) { const f32x16& O = mt ? O1 : O0; const int g0 = 8 * kp, g1 = 8 * kp + 4;
            u32x2 a, b; a.x = pk2(O[g0] * sc, O[g0 + 1] * sc); a.y = pk2(O[g0 + 2] * sc, O[g0 + 3] * sc); b.x = pk2(O[g1] * sc, O[g1 + 1] * sc); b.y = pk2(O[g1 + 2] * sc, O[g1 + 3] * sc);
            { auto r = __builtin_amdgcn_permlane32_swap(a.x, b.x, false, false); a.x = r[0]; b.x = r[1]; }
            { auto r = __builtin_amdgcn_permlane32_swap(a.y, b.y, false, false); a.y = r[0]; b.y = r[1]; }
            *(u32x4*)(rowp + 32 * mt + 16 * kp + 8 * h) = (u32x4){a.x, a.y, b.x, b.y}; }
}
#define ATTN_WAIT_TILE(more) do { if (more) asm volatile("s_waitcnt vmcnt(8)" ::: "memory"); else asm volatile("s_waitcnt vmcnt(0)" ::: "memory"); } while (0)
DI void dil_tile(const AttnLane& L, const __amdgpu_buffer_rsrc_t rs, const bf16_t* hb, int hd, long row0, int j, LAS unsigned char* ldsW, bf16_t* og, float* lse, int lane) {
    const int qi = lane & 31, h = lane >> 5;
    const bf16_t* qh = hb + (size_t)hd * T * 64;
    const unsigned kh = (unsigned)(WS_PROJ + ((size_t)(16 + hd) * T + row0) * 128), vh = (unsigned)(WS_PROJ + ((size_t)(32 + hd) * T + row0) * 128);
    bf16x8 qf[4];
    { const bf16_t* qp = qh + (size_t)(row0 + 32 * j + qi) * 64 + 8 * h;
#pragma unroll
      for (int s = 0; s < 4; ++s) qf[s] = *(const bf16x8*)(qp + 16 * s); }
    float mrun = -INFINITY, lrun = 0.f;
    f32x16 O0, O1;
#pragma unroll
    for (int i = 0; i < 16; ++i) { O0[i] = 0.f; O1[i] = 0.f; }
    const int kt0 = j >= 4 ? j - 4 : 0;
    dma_tile(L, rs, kh + (unsigned)(4096 * kt0), vh + (unsigned)(4096 * kt0), ldsW);
    unsigned buf = 0;
    for (int kt = kt0; kt <= j; ++kt) {
        const bool more = kt < j;
        if (more) dma_tile(L, rs, kh + (unsigned)(4096 * (kt + 1)), vh + (unsigned)(4096 * (kt + 1)), ldsW + (buf ^ 1u) * SLOT_BYTES);
        ATTN_WAIT_TILE(more);
        LAS unsigned char* slot = ldsW + buf * SLOT_BYTES;
        f32x16 sc;
#pragma unroll
        for (int i = 0; i < 16; ++i) sc[i] = 0.f;
#pragma unroll
        for (int s = 0; s < 4; ++s) { const bf16x8 kf = *(const LAS bf16x8*)(slot + L.ka[s]); sc = mfma32(kf, qf[s], sc); }
        if (kt == j) {
#pragma unroll
            for (int i = 0; i < 16; ++i) { const int key = (i & 3) + 8 * (i >> 2) + 4 * h; if (key > qi) sc[i] = -INFINITY; }
        }
        if (kt == j - 4) {
#pragma unroll
            for (int i = 0; i < 16; ++i) { const int key = (i & 3) + 8 * (i >> 2) + 4 * h; if (key < qi) sc[i] = -INFINITY; }
        }
        float mx = sc[0];
#pragma unroll
        for (int i = 1; i < 16; ++i) mx = fmaxf(mx, sc[i]);
        mx = fmaxf(mx, __shfl_xor(mx, 32));
        const float mnew = fmaxf(mrun, mx), alpha = fexp2(mrun - mnew);
        float ps = 0.f;
#pragma unroll
        for (int i = 0; i < 16; ++i) { sc[i] = fexp2(sc[i] - mnew); ps += sc[i]; }
        lrun = lrun * alpha + ps; mrun = mnew;
#pragma unroll
        for (int i = 0; i < 16; ++i) { O0[i] *= alpha; O1[i] *= alpha; }
        const bf16x8 p0 = pack8(sc, 0), p1 = pack8(sc, 1);
        bf16x8 vf[2][2]; tr_read8(L, (unsigned)(size_t)slot, vf);
        O0 = mfma32(vf[0][0], p0, O0); O0 = mfma32(vf[0][1], p1, O0);
        O1 = mfma32(vf[1][0], p0, O1); O1 = mfma32(vf[1][1], p1, O1);
        buf ^= 1u;
    }
    const float ltot = lrun + __shfl_xor(lrun, 32), inv = frcp(ltot);
    const size_t row = (size_t)(row0 + 32 * j + qi);
    store_o_row(og + row * 64, O0, O1, inv, h);
    if (h == 0) lse[row] = mrun + flog2(ltot);
}
DI void sb_tile(const AttnLane& L, const __amdgpu_buffer_rsrc_t rs, const bf16_t* hb, int b, int h4, int j, LAS unsigned char* ldsW, bf16_t* ocat, int lane) {
    const int qi = lane & 31, h = lane >> 5;
    const long base = (long)b * S;
    const bf16_t* qh = hb + (size_t)(12 + h4) * T * 64;
    const unsigned kh = (unsigned)(WS_PROJ + ((size_t)(16 + 12 + h4) * T + base) * 128), vh = (unsigned)(WS_PROJ + ((size_t)(32 + 12 + h4) * T + base) * 128);
    bf16x8 qf[4];
    { const bf16_t* qp = qh + (size_t)(base + 32 * j + qi) * 64 + 8 * h;
#pragma unroll
      for (int s = 0; s < 4; ++s) qf[s] = *(const bf16x8*)(qp + 16 * s); }
    float carry = 0.f;
    f32x16 O0, O1;
#pragma unroll
    for (int i = 0; i < 16; ++i) { O0[i] = 0.f; O1[i] = 0.f; }
    dma_tile(L, rs, kh + (unsigned)(4096 * j), vh + (unsigned)(4096 * j), ldsW);
    unsigned buf = 0;
    for (int kt = j; kt >= 0; --kt) {
        const bool more = kt > 0;
        if (more) dma_tile(L, rs, kh + (unsigned)(4096 * (kt - 1)), vh + (unsigned)(4096 * (kt - 1)), ldsW + (buf ^ 1u) * SLOT_BYTES);
        ATTN_WAIT_TILE(more);
        LAS unsigned char* slot = ldsW + buf * SLOT_BYTES;
        f32x16 z;
#pragma unroll
        for (int i = 0; i < 16; ++i) z[i] = 0.f;
#pragma unroll
        for (int s = 0; s < 4; ++s) { const bf16x8 kf = *(const LAS bf16x8*)(slot + L.ka[s]); z = mfma32(kf, qf[s], z); }
#pragma unroll
        for (int i = 0; i < 16; ++i) z[i] = fexp2(fminf(z[i], 31.f));
        if (kt == j) {
#pragma unroll
            for (int i = 0; i < 16; ++i) { const int key = (i & 3) + 8 * (i >> 2) + 4 * h; if (key >= qi) z[i] = 0.f; }
        }
        float lg[4], par[4], u0[4], p01[4], p012[4];
#pragma unroll
        for (int g = 0; g < 4; ++g) { const float a0 = 1.f + z[4 * g], a1 = 1.f + z[4 * g + 1], a2 = 1.f + z[4 * g + 2], a3 = 1.f + z[4 * g + 3];
            u0[g] = a0; p01[g] = a0 * a1; p012[g] = p01[g] * a2; lg[g] = -flog2(p012[g] * a3); }
#pragma unroll
        for (int g = 0; g < 4; ++g) par[g] = __shfl_xor(lg[g], 32);
        float tg[4]; tg[3] = carry; tg[2] = tg[3] + (lg[3] + par[3]); tg[1] = tg[2] + (lg[2] + par[2]); tg[0] = tg[1] + (lg[1] + par[1]);
        carry = tg[0] + (lg[0] + par[0]);
#pragma unroll
        for (int g = 0; g < 4; ++g) { const float suf = tg[g] + lg[g] + (h == 0 ? par[g] : 0.f); const float y = fexp2(suf);
            z[4 * g] = z[4 * g] * y; z[4 * g + 1] = z[4 * g + 1] * (y * u0[g]); z[4 * g + 2] = z[4 * g + 2] * (y * p01[g]); z[4 * g + 3] = z[4 * g + 3] * (y * p012[g]); }
        const bf16x8 p0 = pack8(z, 0), p1 = pack8(z, 1);
        bf16x8 vf[2][2]; tr_read8(L, (unsigned)(size_t)slot, vf);
        O0 = mfma32(vf[0][0], p0, O0); O0 = mfma32(vf[0][1], p1, O0);
        O1 = mfma32(vf[1][0], p0, O1); O1 = mfma32(vf[1][1], p1, O1);
        if (__all(carry < -40.f)) break;
        buf ^= 1u;
    }
    store_o_row(ocat + (size_t)(base + 32 * j + qi) * LDO + 256 + h4 * 64, O0, O1, 1.f, h);
}
DI void phase_attn(const Frame& F, const Params& p) {
    const bf16_t* hb = (const bf16_t*)(F.ws + WS_PROJ); bf16_t* ocat = (bf16_t*)(F.ws + WS_OCAT);
    bf16_t* og = (bf16_t*)(F.ws + WS_OG); float* lse = (float*)(F.ws + WS_LSE);
    LAS unsigned char* ldsW = F.lds + F.wave * (2 * SLOT_BYTES);
    AttnLane L; attn_lane_init(L, F.lane);
    const __amdgpu_buffer_rsrc_t rs = __builtin_amdgcn_make_buffer_rsrc(F.ws, 0, (int)WS_END, 0x00020000);
    const int NU = NB * 4 * 16;
    for (int i = 0;; ++i) {
        const int u = (F.G == 256) ? ((F.bid & 7) * 32 + (F.bid >> 3) + 256 * i) : (F.bid + F.G * i);
        if (u >= NU) break;
        const int qb = u & 15, hs = (u >> 4) & 3, b = u >> 6, t0 = qb * 512;
        for (int w = F.wave; w < 16; w += 8) sb_tile(L, rs, hb, b, hs, t0 / 32 + w, ldsW, ocat, F.lane);
        for (int w = F.wave; w < 48; w += 8) {
            const int g = w >> 4, ti = w & 15, l2d = 2 * g, per = 16 >> l2d, r = ti / per, jj = ti % per;
            dil_tile(L, rs, hb, g * 4 + hs, (long)b * S + (long)r * (S >> l2d), ((t0 >> l2d) >> 5) + jj, ldsW, og + (size_t)(g * 4 + hs) * T * 64, lse + (size_t)(g * 4 + hs) * T, F.lane);
        }
        VM_WAIT();
        __syncthreads();
        {
            const int piece = F.tid & 7; const size_t bb = (size_t)b * S;
#pragma unroll 2
            for (int pass = 0; pass < 8; ++pass) {
                const int sq = t0 + pass * 64 + (F.tid >> 3);
                const size_t r0 = bb + sq, r1 = bb + ((size_t)(sq & 3) << 11) + (sq >> 2), r2 = bb + ((size_t)(sq & 15) << 9) + (sq >> 4);
                const float l0 = lse[(size_t)(0 + hs) * T + r0], l1 = lse[(size_t)(4 + hs) * T + r1], l2 = lse[(size_t)(8 + hs) * T + r2];
                const u32x4 x = *((const u32x4*)(og + ((size_t)(0 + hs) * T + r0) * 64) + piece), y = *((const u32x4*)(og + ((size_t)(4 + hs) * T + r1) * 64) + piece), z = *((const u32x4*)(og + ((size_t)(8 + hs) * T + r2) * 64) + piece);
                const float mx = fmaxf(l0, fmaxf(l1, l2)); float w0 = fexp2(l0 - mx), w1 = fexp2(l1 - mx), w2 = fexp2(l2 - mx); const float inv = frcp(w0 + w1 + w2); w0 *= inv; w1 *= inv; w2 *= inv;
                u32x4 r;
                r.x = pk2(w0 * bf_lo(x.x) + w1 * bf_lo(y.x) + w2 * bf_lo(z.x), w0 * bf_hi(x.x) + w1 * bf_hi(y.x) + w2 * bf_hi(z.x));
                r.y = pk2(w0 * bf_lo(x.y) + w1 * bf_lo(y.y) + w2 * bf_lo(z.y), w0 * bf_hi(x.y) + w1 * bf_hi(y.y) + w2 * bf_hi(z.y));
                r.z = pk2(w0 * bf_lo(x.z) + w1 * bf_lo(y.z) + w2 * bf_lo(z.z), w0 * bf_hi(x.z) + w1 * bf_hi(y.z) + w2 * bf_hi(z.z));
                r.w = pk2(w0 * bf_lo(x.w) + w1 * bf_lo(y.w) + w2 * bf_lo(z.w), w0 * bf_hi(x.w) + w1 * bf_hi(y.w) + w2 * bf_hi(z.w));
                *((u32x4*)(ocat + (bb + sq) * LDO + hs * 64) + piece) = r;
            }
        }
        __syncthreads();
    }
}

DI void route_rows(const Frame& F, const Params& p, int pm) {
    LAS int* hist = (LAS int*)(F.lds);
    const int ftid = fresh_tid();
    __syncthreads();
    if (ftid < 32) hist[ftid] = 0;
    __syncthreads();
    if (F.tid < 256) {
        const int row = pm * 256 + F.tid; const float* L = (const float*)(F.ws + WS_LOGIT) + (size_t)row * 128;
        const float* brg = p.in[I_BRG]; const float* bre = p.in[I_BRE];
        float lgp[4];
#pragma unroll
        for (int c = 0; c < 4; ++c) lgp[c] = L[c] + L[36 + c] + brg[c];
        int gsel = 0; float gm = lgp[0];
#pragma unroll
        for (int c = 1; c < 4; ++c) if (lgp[c] > gm) { gm = lgp[c]; gsel = c; }
        float zs = 0.f;
#pragma unroll
        for (int c = 0; c < 4; ++c) zs += fexp2((lgp[c] - gm) * LOG2E);
        const float pg = frcp(zs);
        float l1 = -INFINITY, l2 = -INFINITY; int e1 = 0, e2 = 0;
#pragma unroll
        for (int i = 0; i < 8; ++i) { const int c = 4 + gsel * 8 + i; const float v = L[c] + L[36 + c] + bre[gsel * 8 + i];
            if (v > l1) { l2 = l1; e2 = e1; l1 = v; e1 = i; } else if (v > l2) { l2 = v; e2 = i; } }
        const float ex = fexp2((l2 - l1) * LOG2E), den = frcp(1.f + ex);
        int* te = (int*)(F.ws + WS_TOKE) + (size_t)row * 2; float* tw = (float*)(F.ws + WS_TOKW) + (size_t)row * 2;
        te[0] = gsel * 8 + e1; te[1] = gsel * 8 + e2; tw[0] = pg * den; tw[1] = pg * ex * den;
        lds_add(&hist[gsel * 8 + e1], 1); lds_add(&hist[gsel * 8 + e2], 1);
    }
    __syncthreads();
    if (ftid < 32) ((int*)(F.ws + WS_HIST))[pm * 32 + ftid] = hist[ftid];
}


DI void router_weights_to_lds(const Frame& F, const Params& p) {
    constexpr int WP = 1028;
    LAS float* wt = (LAS float*)(F.lds + LDS_RW); LAS float* bias = (LAS float*)(F.lds + LDS_RS) + 8 * 80 + 32;
    const float* wrg = p.in[I_WRG]; const float* wre = p.in[I_WRE]; const float* brg = p.in[I_BRG]; const float* bre = p.in[I_BRE];
    const int ftid = fresh_tid();
    __syncthreads();
#pragma unroll 8
    for (int i = ftid; i < 1024 * 32; i += 512) wt[(4 + (i & 31)) * WP + (i >> 5)] = wre[i];
#pragma unroll 8
    for (int i = ftid; i < 1024 * 4; i += 512) wt[(i & 3) * WP + (i >> 2)] = wrg[i];
    if (ftid < 36) bias[ftid] = ftid < 4 ? brg[ftid] : bre[ftid - 4];
}

DI void phase_norm2_route(const Frame& F, const Params& p) {
    constexpr int WP = 1028;
    LAS float* wt = (LAS float*)(F.lds + LDS_RW);
    LAS float* gs = (LAS float*)(F.lds + LDS_RV); LAS float* sh = gs + 1024;
    LAS float* scr = (LAS float*)(F.lds + LDS_RS) + F.wave * 80;
    LAS int* hist = (LAS int*)(F.lds + LDS_RS) + 8 * 80;
    LAS float* bias = (LAS float*)(F.lds + LDS_RS) + 8 * 80 + 32;
    const float* mod = (const float*)(F.ws + WS_MOD); const float* gn = p.in[I_GFFN];
    const bf16_t* upd = (const bf16_t*)(F.ws + WS_UPD1); unsigned* h8 = (unsigned*)(F.ws + WS_H28);
    const float* wrg = p.in[I_WRG]; const float* wre = p.in[I_WRE]; const float* brg = p.in[I_BRG]; const float* bre = p.in[I_BRE];
    const int ftid = fresh_tid();
    __syncthreads();
    for (int chunk = F.bid; chunk < T / 256; chunk += F.G) {
        const int b = chunk >> 5;
        __syncthreads();
        for (int col = ftid; col < 1024; col += 512) { gs[col] = gn[col] * (1.f + mod[b * 6144 + 4096 + col]); sh[col] = mod[b * 6144 + 3072 + col]; }
        if (ftid < 32) hist[ftid] = 0;
        __syncthreads();
        f32x4 g4[4], s4[4];
#pragma unroll
        for (int j = 0; j < 4; ++j) { g4[j] = *(const LAS f32x4*)(gs + 256 * j + 4 * F.lane); s4[j] = *(const LAS f32x4*)(sh + 256 * j + 4 * F.lane); }
        f32x4 vn[2][4]; u32x2 un[2][4];
#pragma unroll
        for (int r = 0; r < 2; ++r) { const int row = chunk * 256 + F.wave * 2 + r;
            const f32x4* xr = (const f32x4*)(p.in[I_X] + (size_t)row * 1024) + F.lane; const u32x2* ur = (const u32x2*)(upd + (size_t)row * 1024) + F.lane;
#pragma unroll
            for (int j = 0; j < 4; ++j) { vn[r][j] = xr[64 * j]; un[r][j] = ur[64 * j]; } }
        for (int rr = F.wave * 2; rr < 256; rr += 16) {
            const int row0 = chunk * 256 + rr;
            f32x4 y[2][4]; f32x4 v[2][4]; u32x2 uu[2][4];
#pragma unroll
            for (int r = 0; r < 2; ++r)
#pragma unroll
                for (int j = 0; j < 4; ++j) { v[r][j] = vn[r][j]; uu[r][j] = un[r][j]; }
            if (rr + 16 < 256) {
#pragma unroll
                for (int r = 0; r < 2; ++r) { const int row = row0 + 16 + r;
                    const f32x4* xr = (const f32x4*)(p.in[I_X] + (size_t)row * 1024) + F.lane; const u32x2* ur = (const u32x2*)(upd + (size_t)row * 1024) + F.lane;
#pragma unroll
                    for (int j = 0; j < 4; ++j) { vn[r][j] = xr[64 * j]; un[r][j] = ur[64 * j]; } }
            }
#pragma unroll
            for (int r = 0; r < 2; ++r) {
                const int row = row0 + r; float ss = 0.f;
#pragma unroll
                for (int j = 0; j < 4; ++j) { v[r][j].x += bf_lo(uu[r][j].x); v[r][j].y += bf_hi(uu[r][j].x); v[r][j].z += bf_lo(uu[r][j].y); v[r][j].w += bf_hi(uu[r][j].y);
                    ss += (v[r][j].x * v[r][j].x + v[r][j].y * v[r][j].y) + (v[r][j].z * v[r][j].z + v[r][j].w * v[r][j].w); }
                const float rinv = __builtin_amdgcn_rsqf(wave_sum(ss) * (1.f / 1024.f) + RMS_EPS);
#pragma unroll
                for (int j = 0; j < 4; ++j) { y[r][j] = v[r][j] * rinv * g4[j] + s4[j]; h8[(size_t)row * 256 + 64 * j + F.lane] = pk4_fp8(y[r][j].x, y[r][j].y, y[r][j].z, y[r][j].w); }
            }
            f32x2 yp[4][4];
#pragma unroll
            for (int j = 0; j < 4; ++j) { yp[j][0] = (f32x2){y[0][j].x, y[1][j].x}; yp[j][1] = (f32x2){y[0][j].y, y[1][j].y}; yp[j][2] = (f32x2){y[0][j].z, y[1][j].z}; yp[j][3] = (f32x2){y[0][j].w, y[1][j].w}; }
            { const bool up32 = (F.lane & 32) != 0, up16 = (F.lane & 16) != 0, up8 = (F.lane & 8) != 0;
#pragma unroll 3
              for (int cg = 0; cg < 9; ++cg) {
                float k4[4];
#pragma unroll
                for (int ci = 0; ci < 4; ++ci) { const LAS float* wc_ = wt + (cg * 4 + ci) * WP + 4 * F.lane; f32x2 a01 = {0.f, 0.f};
#pragma unroll
                    for (int j = 0; j < 4; ++j) { const f32x4 w = *(const LAS f32x4*)(wc_ + 256 * j);
                        a01 = __builtin_elementwise_fma(yp[j][0], (f32x2){w.x, w.x}, a01); a01 = __builtin_elementwise_fma(yp[j][1], (f32x2){w.y, w.y}, a01);
                        a01 = __builtin_elementwise_fma(yp[j][2], (f32x2){w.z, w.z}, a01); a01 = __builtin_elementwise_fma(yp[j][3], (f32x2){w.w, w.w}, a01); }
                    const float a0 = a01.x, a1 = a01.y;
                    k4[ci] = (up32 ? a1 : a0) + __shfl_xor(up32 ? a0 : a1, 32); }
                float k2[2];
#pragma unroll
                for (int i = 0; i < 2; ++i) k2[i] = (up16 ? k4[2 + i] : k4[i]) + __shfl_xor(up16 ? k4[i] : k4[2 + i], 16);
                float k1 = (up8 ? k2[1] : k2[0]) + __shfl_xor(up8 ? k2[0] : k2[1], 8);
                k1 += __shfl_xor(k1, 4); k1 += __shfl_xor(k1, 2); k1 += __shfl_xor(k1, 1);
                if ((F.lane & 7) == 0) scr[(F.lane >> 5) * 36 + cg * 4 + ((F.lane >> 4) & 1) * 2 + ((F.lane >> 3) & 1)] = k1;
              } }
            LDS_WAIT();
            if (F.lane < 2) {
                const LAS float* L = scr + F.lane * 36; const int row = row0 + F.lane;
                float lgp[4];
#pragma unroll
                for (int c = 0; c < 4; ++c) lgp[c] = L[c] + bias[c];
                int gsel = 0; float gm = lgp[0];
#pragma unroll
                for (int c = 1; c < 4; ++c) if (lgp[c] > gm) { gm = lgp[c]; gsel = c; }
                float zs = 0.f;
#pragma unroll
                for (int c = 0; c < 4; ++c) zs += fexp2((lgp[c] - gm) * LOG2E);
                const float pg = frcp(zs);
                float l1 = -INFINITY, l2 = -INFINITY; int e1 = 0, e2 = 0;
#pragma unroll
                for (int i = 0; i < 8; ++i) { const float v = L[4 + gsel * 8 + i] + bias[4 + gsel * 8 + i];
                    if (v > l1) { l2 = l1; e2 = e1; l1 = v; e1 = i; } else if (v > l2) { l2 = v; e2 = i; } }
                const float ex = fexp2((l2 - l1) * LOG2E), den = frcp(1.f + ex);
                int* te = (int*)(F.ws + WS_TOKE) + (size_t)row * 2; float* tw = (float*)(F.ws + WS_TOKW) + (size_t)row * 2;
                te[0] = gsel * 8 + e1; te[1] = gsel * 8 + e2; tw[0] = pg * den; tw[1] = pg * ex * den;
                lds_add(&hist[gsel * 8 + e1], 1); lds_add(&hist[gsel * 8 + e2], 1);
            }
            LDS_WAIT();
        }
        __syncthreads();
        if (ftid < 32) ((int*)(F.ws + WS_HIST))[chunk * 32 + ftid] = hist[ftid];
    }
}

DI void phase_slots(const Frame& F, const Params& p) {
    LAS int* tot = (LAS int*)(F.lds); LAS int* bas = tot + 32; LAS int* pst = tot + 64; LAS int* wcnt = tot + 128;
    const int* hist = (const int*)(F.ws + WS_HIST);
    for (int pm = F.bid; pm < T / 256; pm += F.G) {
        const int ftid = fresh_tid();
        __syncthreads();
        if (ftid < 64) tot[ftid] = 0;
        __syncthreads();
        { const int e = F.tid & 31, part = F.tid >> 5; int t = 0, bs = 0;
          for (int q = part; q < T / 256; q += 16) { const int v = hist[q * 32 + e]; t += v; if (q < pm) bs += v; }
          lds_add(&tot[e], t); lds_add(&bas[e], bs); }
        __syncthreads();
        if (F.tid == 0) { int run = 0; for (int e = 0; e < 32; ++e) { pst[e] = run; run += (tot[e] + 255) / 256 * 256; } pst[32] = run; }
        const int my_e = ((const int*)(F.ws + WS_TOKE))[(size_t)pm * 512 + F.tid];
        int rank = 0;
        for (int e = 0; e < 32; ++e) { const unsigned long long mask = __ballot(my_e == e); if (my_e == e) rank = __popcll(mask & ((1ull << F.lane) - 1ull)); if (F.lane == 0) wcnt[F.wave * 32 + e] = __popcll(mask); }
        __syncthreads();
        int woff = 0;
        for (int w = 0; w < F.wave; ++w) woff += wcnt[w * 32 + my_e];
        const int slot = pst[my_e] + bas[my_e] + woff + rank;
        ((int*)(F.ws + WS_SLOTTOK))[slot] = pm * 256 + (F.tid >> 1);
        ((float*)(F.ws + WS_SLOTW))[slot] = ((const float*)(F.ws + WS_TOKW))[(size_t)pm * 512 + F.tid];
        ((int*)(F.ws + WS_TOKS))[(size_t)pm * 512 + F.tid] = slot;
        if (pm < 32) { const int e = pm; for (int s = pst[e] + tot[e] + F.tid; s < pst[e + 1]; s += 512) { ((int*)(F.ws + WS_SLOTTOK))[s] = 0; ((float*)(F.ws + WS_SLOTW))[s] = 0.f; } }
        if (pm == 0 && F.tid < 34) { int* et = (int*)(F.ws + WS_ETAB); if (F.tid < 33) et[64 + F.tid] = pst[F.tid] >> 8; if (F.tid < 32) { et[F.tid] = tot[F.tid]; et[32 + F.tid] = pst[F.tid]; } if (F.tid == 33) et[97] = pst[32] >> 8; }
    }
}

DI void phase_combine(const Frame& F, const Params& p) {
    const unsigned* y = (const unsigned*)(F.ws + WS_Y); const int* ts = (const int*)(F.ws + WS_TOKS); const float* tw = (const float*)(F.ws + WS_TOKW); const float* mod = (const float*)(F.ws + WS_MOD);
    const int gw = F.bid * 8 + F.wave, NGW = F.G * 8;
    for (int row = gw; row < T; row += NGW) {
        const int s0 = ts[(size_t)row * 2], s1 = ts[(size_t)row * 2 + 1]; const float w0 = tw[(size_t)row * 2] * 0.125f, w1 = tw[(size_t)row * 2 + 1] * 0.125f;
        const f32x4* xr = (const f32x4*)(p.in[I_X] + (size_t)row * 1024) + F.lane; f32x4* orow = (f32x4*)(p.out + (size_t)row * 1024) + F.lane;
        const u32x2* ur = (const u32x2*)((const bf16_t*)(F.ws + WS_UPD1) + (size_t)row * 1024) + F.lane;
        const unsigned* y0 = y + (size_t)s0 * 256 + F.lane; const unsigned* y1 = y + (size_t)s1 * 256 + F.lane;
        const f32x4* g2 = (const f32x4*)(mod + (row >> 13) * 6144 + 5120) + F.lane;
        f32x4 v[4], g[4]; unsigned a[4], c[4]; u32x2 uu[4];
#pragma unroll
        for (int j = 0; j < 4; ++j) { v[j] = xr[64 * j]; uu[j] = ur[64 * j]; a[j] = y0[64 * j]; c[j] = y1[64 * j]; g[j] = g2[64 * j]; }
#pragma unroll
        for (int j = 0; j < 4; ++j) { if (!DBG_X1_PLAIN) { v[j].x += bf_lo(uu[j].x); v[j].y += bf_hi(uu[j].x); v[j].z += bf_lo(uu[j].y); v[j].w += bf_hi(uu[j].y); }
            if (!DBG_SKIP_Y) { const f32x2 al = fp8_lo2(a[j]), ah = fp8_hi2(a[j]), cl = fp8_lo2(c[j]), ch = fp8_hi2(c[j]);
                v[j].x += g[j].x * (w0 * al.x + w1 * cl.x); v[j].y += g[j].y * (w0 * al.y + w1 * cl.y); v[j].z += g[j].z * (w0 * ah.x + w1 * ch.x); v[j].w += g[j].w * (w0 * ah.y + w1 * ch.y); } orow[64 * j] = v[j]; }
    }
}

__global__ void __launch_bounds__(512, 2) fwd(Params p) {
    extern __shared__ __attribute__((aligned(16))) unsigned char lds_raw[];
    Frame F;
    F.lds = (LAS unsigned char*)lds_raw; F.ws = p.ws;
    F.tid = threadIdx.x; F.lane = F.tid & 63; F.wave = __builtin_amdgcn_readfirstlane(F.tid >> 6); F.G = gridDim.x; F.bid = blockIdx.x;
    volatile LAS unsigned* ctl = (volatile LAS unsigned*)(F.lds + LDS_CTLO);
    { const int ftid = fresh_tid(); if (ftid < 64) ctl[ftid] = 0u; }
    __syncthreads();
    XcdBarrier bar; bar.bar = (unsigned*)(p.ws + WS_CTL) + CW_BAR; bar.x = 0; bar.st = ctl;
    if (MK_N_LAUNCHES == 1) bar = xcd_barrier_post((unsigned*)(p.ws + WS_CTL) + CW_BAR, ctl);
    const int lo = p.ph_lo, hi = p.ph_hi;
    const __amdgpu_buffer_rsrc_t rsw = __builtin_amdgcn_make_buffer_rsrc(p.ws, 0, (int)WS_END, 0x00020000);
#define IN(k) (lo <= (k) && (k) < hi)
#define REP(k) for (int rep_ = 0; rep_ < ((PROBE_PH) == (k) ? 2 : 1); ++rep_)
#define SEAM(k) do { if (IN(k) && IN((k) + 1)) xcd_barrier(bar); } while (0)

    if (IN(0)) REP(0) { phase0(F, p); } SEAM(0);
    if (IN(1)) REP(1) { phase_norm<0>(F, p); } SEAM(1);
    if (IN(2)) REP(2) {
        REP(20) {
            pg8::DenseSched Sd; Sd.init(T, 2304, F.G, F.bid, WS_H8, 1024, WS_W1D8, 1024);
            EpiProj<false> E{(bf16_t*)(F.ws + WS_PROJ), (bf16_t*)(F.ws + WS_GATES), (const bf16_t*)(F.ws + WS_ROPE), p.in[I_QG], p.in[I_KG], 0};
            pg8::gemm_phase<EpiProj<false>, pg8::DenseSched, true>(F.lds, 1024, Sd, E, rsw);
        }
        REP(21) {
            pg8::DenseSched Sd; Sd.init(T, 768, F.G, F.bid, WS_H, 2048, WS_W1 + (size_t)2304 * 2048, 2048);
            EpiProj<false> E{(bf16_t*)(F.ws + WS_PROJ), (bf16_t*)(F.ws + WS_GATES), (const bf16_t*)(F.ws + WS_ROPE), p.in[I_QG], p.in[I_KG], 9};
            pg8::gemm_phase<EpiProj<false>, pg8::DenseSched, false>(F.lds, 1024, Sd, E, rsw);
        }
        REP(22) {
            pg8::DenseSched Sd; Sd.init(T, 2048, F.G, F.bid, WS_H8, 1024, WS_WG8, 1024);
            EpiProj<true> E{(bf16_t*)(F.ws + WS_PROJ), (bf16_t*)(F.ws + WS_GATES), (const bf16_t*)(F.ws + WS_ROPE), p.in[I_QG], p.in[I_KG], 0};
            pg8::gemm_phase<EpiProj<true>, pg8::DenseSched, true>(F.lds, 1024, Sd, E, rsw);
        }
    } SEAM(2);
    if (IN(3)) REP(3) { phase_attn(F, p); } SEAM(3);
    if (IN(4)) REP(4) {
        pg8::PanelSched<8, true> Sd; Sd.init(T, F.G, F.bid, WS_OCAT, 1024, WS_WB, 1024);
        EpiBranch E{(const unsigned char*)(F.ws + WS_GATES), F.ws + WS_MERGED};
        pg8::gemm_phase<EpiBranch, pg8::PanelSched<8, true>, false>(F.lds, 512, Sd, E, rsw);
    }
    if (IN(5)) REP(5) {
        pg8::PanelSched<4, false> Sd; Sd.init(T, F.G, F.bid, WS_MERGED, 1024, WS_WO, 1024);
        EpiOut E{(bf16_t*)(F.ws + WS_UPD1), (const float*)(F.ws + WS_MOD)};
        pg8::gemm_phase<EpiOut, pg8::PanelSched<4, false>, true>(F.lds, 1024, Sd, E, rsw);
        if (rep_ + 1 == ((PROBE_PH) == 5 ? 2 : 1)) router_weights_to_lds(F, p);
    }
    if (IN(6)) REP(6) { phase_norm2_route(F, p); }
    if (IN(6) && IN(8)) xcd_barrier(bar);
    if (IN(8)) REP(8) { phase_slots(F, p); } SEAM(8);
    if (IN(9) || IN(10)) {
        LAS int* cst = (LAS int*)(F.lds + LDS_CTLO) + 16;
        __syncthreads();
        { const int ftid = fresh_tid(); if (ftid < 34) cst[ftid] = ((const int*)(F.ws + WS_ETAB))[64 + ftid]; }
        __syncthreads();
    }
    if (IN(9)) REP(9) {
        const LAS int* cst = (const LAS int*)(F.lds + LDS_CTLO) + 16;
        MoeSchedUp Sm; Sm.G = F.G; Sm.c = (F.G == 256) ? ((F.bid & 7) * 32 + (F.bid >> 3)) : F.bid; Sm.nc = cst[33]; Sm.pa = 1024; Sm.pb = 1024; Sm.A = (unsigned)WS_H28; Sm.B = (unsigned)WS_WGU; Sm.cstart = cst;
        Sm.slot_tok = (const int*)(F.ws + WS_SLOTTOK); Sm.estride = 1024u * 1024u; Sm.pnstride = 256u * 1024u;
        EpiSwiglu E{F.ws + WS_HMID};
        pg8::gemm_phase<EpiSwiglu, MoeSchedUp, true>(F.lds, 1024, Sm, E, rsw);
    } SEAM(9);
    if (IN(10)) REP(10) {
        const LAS int* cst = (const LAS int*)(F.lds + LDS_CTLO) + 16;
        MoeSchedDn Sm; Sm.G = F.G; Sm.c = (F.G == 256) ? ((F.bid & 7) * 32 + (F.bid >> 3)) : F.bid; Sm.nc = cst[33]; Sm.pa = 512; Sm.pb = 512; Sm.A = (unsigned)WS_HMID; Sm.B = (unsigned)WS_WDN; Sm.cstart = cst;
        Sm.slot_tok = (const int*)(F.ws + WS_SLOTTOK); Sm.estride = 1024u * 512u; Sm.pnstride = 256u * 512u;
        EpiDown E{F.ws + WS_Y};
        pg8::gemm_phase<EpiDown, MoeSchedDn, true>(F.lds, 512, Sm, E, rsw);
    } SEAM(10);
    if (IN(11)) { phase_combine(F, p); }
#undef IN
#undef SEAM
}

extern "C" void kernel_launch(void* const* d_in, const int* in_sizes, int n_in, void* d_out, int out_size, void* d_ws, size_t ws_size, hipStream_t stream) {
    static int grid = 0;
    if (grid == 0) {
        if (n_in != 21 || in_sizes[0] != T * D || out_size != T * D || ws_size < WS_END) { fprintf(stderr, "kernel_launch: unexpected problem (n_in %d, ws %zu)\n", n_in, ws_size); grid = -1; return; }
        int dev = 0, cus = 0, per_cu = 0;
        if (hipGetDevice(&dev) != hipSuccess || hipDeviceGetAttribute(&cus, hipDeviceAttributeMultiprocessorCount, dev) != hipSuccess) { grid = -1; return; }
        if (hipFuncSetAttribute((const void*)fwd, hipFuncAttributeMaxDynamicSharedMemorySize, LDS_BYTES) != hipSuccess) { fprintf(stderr, "kernel_launch: hipFuncSetAttribute failed\n"); grid = -1; return; }
        if (hipOccupancyMaxActiveBlocksPerMultiprocessor(&per_cu, (const void*)fwd, 512, LDS_BYTES) != hipSuccess || per_cu < 1) { fprintf(stderr, "kernel_launch: occupancy query says %d\n", per_cu); (void)hipGetLastError(); grid = -1; return; }
        grid = cus;
    }
    if (grid < 0) return;
    (void)hipMemsetAsync((char*)d_ws + WS_CTL, 0, CTL_ZERO_BYTES, stream);
    Params p{};
    for (int i = 0; i < 21; ++i) p.in[i] = (const float*)d_in[i];
    p.out = (float*)d_out; p.ws = (unsigned char*)d_ws;
    if (MK_N_LAUNCHES == 1) { p.ph_lo = 0; p.ph_hi = NPH; hipLaunchKernelGGL(fwd, dim3(grid), dim3(512), LDS_BYTES, stream, p); }
    else { for (int k = 0; k < NPH; ++k) { p.ph_lo = k; p.ph_hi = k + 1; hipLaunchKernelGGL(fwd, dim3(grid), dim3(512), LDS_BYTES, stream, p); } }
}
```

```cpp
#include <hip/hip_runtime.h>
#include <cstdio>
#include <cstdint>

#ifndef MK_N_LAUNCHES
#define MK_N_LAUNCHES 1
#endif
#define DBG_X1_PLAIN 0
#define DBG_SKIP_Y 0
#ifndef PROBE_PH
#define PROBE_PH -1
#endif

#define LAS __attribute__((address_space(3)))
#define DI __device__ __forceinline__
typedef unsigned short bf16_t;
typedef short bf16x8 __attribute__((ext_vector_type(8)));
typedef short s16x4 __attribute__((ext_vector_type(4)));
typedef float f32x2 __attribute__((ext_vector_type(2)));
typedef float f32x4 __attribute__((ext_vector_type(4)));
typedef float f32x16 __attribute__((ext_vector_type(16)));
typedef unsigned u32x2 __attribute__((ext_vector_type(2)));
typedef unsigned u32x4 __attribute__((ext_vector_type(4)));
typedef __bf16 bf16x2n __attribute__((ext_vector_type(2)));
typedef int i32x8 __attribute__((ext_vector_type(8)));

constexpr int NB = 8, S = 8192, D = 1024, T = NB * S;
constexpr int LDP = 3072, LDG = 2048, LDO = 512;
constexpr int NE = 32, DE = 512;
constexpr int MAXSLOT = T * 2 + NE * 256;
constexpr int NPH = 12;
constexpr float LOG2E = 1.4426950408889634f;
constexpr float QSCALE = 0.125f * LOG2E;
constexpr float RMS_EPS = 1e-6f;

constexpr size_t MiB = 1u << 20;
constexpr size_t WS_CTL = 0, CTL_ZERO_BYTES = 64 * 1024;
constexpr int CW_BAR = 1024;
constexpr size_t WS_MODP = 1 * MiB;
constexpr size_t WS_MOD = 3 * MiB;
constexpr size_t WS_ROPE = 4 * MiB;
constexpr size_t WS_LOGIT = 144 * MiB;
constexpr size_t WS_TOKE = 24 * MiB;
constexpr size_t WS_TOKW = 24 * MiB + 512 * 1024;
constexpr size_t WS_TOKS = 25 * MiB;
constexpr size_t WS_SLOTTOK = 25 * MiB + 512 * 1024;
constexpr size_t WS_SLOTW = 26 * MiB + 256 * 1024;
constexpr size_t WS_HIST = 27 * MiB;
constexpr size_t WS_ETAB = 27 * MiB + 256 * 1024;
constexpr size_t WS_WR = 28 * MiB;
constexpr size_t WS_W1D8 = 28 * MiB + 512 * 1024;
constexpr size_t WS_W1 = 32 * MiB;
constexpr size_t WS_WG8 = 38 * MiB;
constexpr size_t WS_WB = 40 * MiB;
constexpr size_t WS_WO = 43 * MiB;
constexpr size_t WS_WGU = 48 * MiB;
constexpr size_t WS_WDN = 80 * MiB;
constexpr size_t WS_H = 144 * MiB;
constexpr size_t WS_OG = 144 * MiB;
constexpr size_t WS_LSE = 240 * MiB;
constexpr size_t WS_PROJ = 272 * MiB;
constexpr size_t WS_GATES = 656 * MiB;
constexpr size_t WS_OCAT = 912 * MiB;
constexpr size_t WS_H8 = 912 * MiB;
constexpr size_t WS_MERGED = 272 * MiB;
constexpr size_t WS_H2 = 400 * MiB;
constexpr size_t WS_H28 = 528 * MiB;
constexpr size_t WS_HMID = 592 * MiB;
constexpr size_t WS_Y = 664 * MiB;
constexpr size_t WS_UPD1 = 800 * MiB;
constexpr size_t WS_END = 976 * MiB;

constexpr int LDS_STAGE = 0, LDS_EPI = 131072, LDS_RW = 0, LDS_RV = 148480, LDS_RS = 148480 + 8192, LDS_CTLO = 148480 + 8192 + 3072, LDS_BYTES = LDS_CTLO + 256;

DI unsigned pk2(float lo, float hi) { f32x2 v = {lo, hi}; bf16x2n r = __builtin_convertvector(v, bf16x2n); return __builtin_bit_cast(unsigned, r); }
DI unsigned pk4_fp8(float a, float b, float c, float d) { int r = __builtin_amdgcn_cvt_pk_fp8_f32(a, b, 0, false); r = __builtin_amdgcn_cvt_pk_fp8_f32(c, d, r, true); return (unsigned)r; }
DI f32x2 fp8_lo2(unsigned u) { return __builtin_amdgcn_cvt_pk_f32_fp8((int)u, false); }
DI f32x2 fp8_hi2(unsigned u) { return __builtin_amdgcn_cvt_pk_f32_fp8((int)u, true); }
DI float bf_lo(unsigned u) { return __builtin_bit_cast(float, u << 16); }
DI float bf_hi(unsigned u) { return __builtin_bit_cast(float, u & 0xffff0000u); }
DI float wave_sum(float v) {
#pragma unroll
    for (int o = 1; o < 64; o <<= 1) v += __shfl_xor(v, o);
    return v;
}
DI float fexp2(float x) { return __builtin_amdgcn_exp2f(x); }
DI float flog2(float x) { return __builtin_amdgcn_logf(x); }
DI float frcp(float x) { return __builtin_amdgcn_rcpf(x); }
DI float sigmoidf(float v) { return frcp(1.0f + fexp2(-v * LOG2E)); }
DI void lds_add(LAS int* p, int v) { (void)__hip_atomic_fetch_add(p, v, __ATOMIC_RELAXED, __HIP_MEMORY_SCOPE_WORKGROUP); }
#define LDS_WAIT() asm volatile("s_waitcnt lgkmcnt(0)" ::: "memory")
#define VM_WAIT() asm volatile("s_waitcnt vmcnt(0)" ::: "memory")
DI int fresh_tid() { int t = threadIdx.x; asm volatile("" : "+v"(t)); return t; }

#define XB_TMO      128
#define XB_XCNT(j)  (256  + 64 * (j))
#define XB_XSUB(j)  (1280 + 64 * (j))
#define XB_XGEN(j)  (2304 + 64 * (j))
#define XB_TOP      3328
#define XB_TOPGEN   3392
#define XCD_BAR_WORDS 3456
#define XB_SPIN_CAP (1u << 18)

__device__ __forceinline__ unsigned xb_ld(unsigned* p)              { return __hip_atomic_load(p, __ATOMIC_RELAXED, __HIP_MEMORY_SCOPE_AGENT); }
__device__ __forceinline__ unsigned xb_add(unsigned* p, unsigned v) { return __hip_atomic_fetch_add(p, v, __ATOMIC_RELAXED, __HIP_MEMORY_SCOPE_AGENT); }
__device__ __forceinline__ unsigned xb_xcc_id() { return (unsigned)__builtin_amdgcn_s_getreg((3 << 11) | 20) & 0xFu; }
#define XB_SPIN(cond, bar) do { unsigned _sp = 0; while (cond) { __builtin_amdgcn_s_sleep(1); \
    if ((++_sp & 255u) == 0u) { if (xb_ld(&(bar)[XB_TMO])) break; if (_sp > XB_SPIN_CAP) { atomicAdd(&(bar)[XB_TMO], 1u); break; } } } } while (0)

struct XcdBarrier {
    unsigned* bar; unsigned x;
    volatile LAS unsigned* st;
};
__device__ __forceinline__ XcdBarrier xcd_barrier_post(unsigned* bar, volatile LAS unsigned* st) {
    XcdBarrier b; b.bar = bar; b.x = xb_xcc_id(); b.st = st;
    if (threadIdx.x == 0) (void)xb_add(&bar[XB_XCNT(b.x)], 1u);
    return b;
}
__device__ __forceinline__ void xcd_barrier_complete(unsigned* bar, unsigned x, unsigned& nloc, unsigned& nx) {
    const unsigned G = gridDim.x * gridDim.y * gridDim.z;
    unsigned sum, cnt, mine, sp = 0u;
    for (;;) {
        sum = 0u; cnt = 0u; mine = 0u;
#pragma unroll
        for (unsigned j = 0; j < 16; ++j) { const unsigned c = xb_ld(&bar[XB_XCNT(j)]); sum += c; cnt += (c > 0u) ? 1u : 0u; mine = (j == x) ? c : mine; }
        if (sum == G) break;
        __builtin_amdgcn_s_sleep(1);
        if ((++sp & 255u) == 0u) { if (xb_ld(&bar[XB_TMO])) break; if (sp > XB_SPIN_CAP) { atomicAdd(&bar[XB_TMO], 1u); break; } }
    }
    nloc = mine > 0u ? mine : 1u; nx = cnt > 0u ? cnt : 1u;
}
__device__ __forceinline__ void xcd_barrier(const XcdBarrier& b) {
    asm volatile("s_waitcnt vmcnt(0)" ::: "memory");
    __syncthreads();
    if (threadIdx.x == 0) {
        unsigned* bar = b.bar;
        __builtin_amdgcn_s_waitcnt(0);
        unsigned nloc = b.st[0], nx = b.st[1];
        if (nloc == 0u) { xcd_barrier_complete(bar, b.x, nloc, nx); b.st[0] = nloc; b.st[1] = nx; }
        const unsigned old = xb_add(&bar[XB_XSUB(b.x)], 1u);
        const unsigned gen = old / nloc;
        if (old + 1u == (gen + 1u) * nloc) {
            __builtin_amdgcn_fence(__ATOMIC_RELEASE, "agent");
            asm volatile("s_waitcnt vmcnt(0)" ::: "memory");
            const unsigned og = xb_add(&bar[XB_TOP], 1u);
            const unsigned tg = og / nx;
            if (og + 1u == (tg + 1u) * nx) xb_add(&bar[XB_TOPGEN], 1u);
            else XB_SPIN(xb_ld(&bar[XB_TOPGEN]) == tg, bar);
            __builtin_amdgcn_fence(__ATOMIC_ACQUIRE, "agent");
            xb_add(&bar[XB_XGEN(b.x)], 1u);
            asm volatile("s_waitcnt vmcnt(0)" ::: "memory");
        } else {
            XB_SPIN(xb_ld(&bar[XB_XGEN(b.x)]) == gen, bar);
            __builtin_amdgcn_fence(__ATOMIC_ACQUIRE, "agent");
            asm volatile("s_waitcnt vmcnt(0)" ::: "memory");
        }
    }
    __syncthreads();
}

namespace pg8 {
constexpr int BM = 256, BK = 64, HALF = 128, HTB = HALF * BK * 2, STAGE_BYTES = 8 * HTB, NXCD = 8, WGM = 8;
__host__ __device__ __forceinline__ int lds_byte(int r, int c) { const int st = (r >> 4) * 2 + (c >> 5), rr = r & 15, cc = c & 31, ob = rr * 64 + cc * 2; return st * 1024 + (ob ^ (((ob >> 9) & 1) << 5)); }
__host__ __device__ __forceinline__ void stage_rc(int b, int& R, int& C) { const int st = b / 1024, sb = b % 1024, swz = sb ^ (((sb >> 9) & 1) << 5); R = (st >> 1) * 16 + swz / 64; C = (st & 1) * 32 + (swz % 64) / 2; }
__host__ __device__ __forceinline__ int perm32(int rho) { const int n = rho >> 4, i = rho & 15; return 8 * (i >> 2) + 4 * n + (i & 3); }

struct Unit { int pm, pn, aux; unsigned a, b; };
typedef int i32x4 __attribute__((ext_vector_type(4)));
__device__ __forceinline__ i32x8 frag8(bf16x8 lo, bf16x8 hi) { return __builtin_shufflevector(__builtin_bit_cast(i32x4, lo), __builtin_bit_cast(i32x4, hi), 0, 1, 2, 3, 4, 5, 6, 7); }

template <class Epi, class Sched, bool FP8 = false>
__device__ __forceinline__ void gemm_phase(LAS unsigned char* lds, const int K, const Sched& S, const Epi& E, const __amdgpu_buffer_rsrc_t rs) {
    const int tid = fresh_tid(), wid = __builtin_amdgcn_readfirstlane(tid >> 6), lane = tid & 63, wr = wid >> 2, wc = wid & 3, fr = lane & 15, fq = lane >> 4;
    const int nt = FP8 ? K / 128 : K / BK;
    int RA[2], CA[2];
    unsigned voffA[4], voffB[2];
#pragma unroll
    for (int i = 0; i < 2; ++i) { int R, C; stage_rc(tid * 16 + i * 8192, R, C); RA[i] = R; CA[i] = C; const int Rb = Epi::PERM ? ((R & ~31) + perm32(R & 31)) : R;
        voffB[i] = (unsigned)(Rb * S.pb + C * 2); }
    const unsigned kstep = (unsigned)(BK * 2);
    const unsigned hstepB = (unsigned)(HALF * S.pb), hstepA = (unsigned)(HALF * S.pa);
    const unsigned ldsw = (unsigned)wid * 1024u;
    const int aoff = lds_byte(wr * 64 + fr, fq * 8), boff = lds_byte(wc * 32 + fr, fq * 8);
    constexpr int kpiece = 1024;
#define PG8_SA(b, h) (((b) * 2 + (h)) * HTB)
#define PG8_SB(b, h) ((4 + (b) * 2 + (h)) * HTB)
#define PG8_STAGE_B(bufoff, gbase) do { _Pragma("unroll") for (int _i = 0; _i < 2; ++_i) \
        __builtin_amdgcn_raw_ptr_buffer_load_lds(rs, (LAS unsigned*)(lds + (bufoff) + ldsw + _i * 8192), 16, (int)voffB[_i], (int)(gbase), 0, 0); } while (0)
#define PG8_STAGE_A(bufoff, gbase, h) do { _Pragma("unroll") for (int _i = 0; _i < 2; ++_i) \
        __builtin_amdgcn_raw_ptr_buffer_load_lds(rs, (LAS unsigned*)(lds + (bufoff) + ldsw + _i * 8192), 16, (int)voffA[Sched::GATHER ? (h) * 2 + _i : _i], (int)((gbase) + (Sched::GATHER ? 0u : (unsigned)(h) * hstepA)), 0, 0); } while (0)
#define PG8_LDA(dst, b, h) do { _Pragma("unroll") for (int m = 0; m < 4; ++m) _Pragma("unroll") for (int k = 0; k < 2; ++k) dst[m][k] = *(const LAS bf16x8*)(lds + PG8_SA(b, h) + aoff + m * 2048 + k * kpiece); } while (0)
#define PG8_LDB(dst, b, h) do { _Pragma("unroll") for (int n = 0; n < 2; ++n) _Pragma("unroll") for (int k = 0; k < 2; ++k) dst[n][k] = *(const LAS bf16x8*)(lds + PG8_SB(b, h) + boff + n * 2048 + k * kpiece); } while (0)
#define PG8_MMA(ai, bj, At, Bt) do { __builtin_amdgcn_s_setprio(1); if constexpr (FP8) { _Pragma("unroll") for (int m = 0; m < 4; ++m) _Pragma("unroll") for (int n = 0; n < 2; ++n) \
        acc[ai][bj][m][n] = __builtin_amdgcn_mfma_scale_f32_16x16x128_f8f6f4(frag8(Bt[n][0], Bt[n][1]), frag8(At[m][0], At[m][1]), acc[ai][bj][m][n], 0, 0, 0, 0x7C7C7C7C, 0, 0x7C7C7C7C); } \
      else { _Pragma("unroll") for (int m = 0; m < 4; ++m) _Pragma("unroll") for (int n = 0; n < 2; ++n) _Pragma("unroll") for (int k = 0; k < 2; ++k) \
        acc[ai][bj][m][n] = __builtin_amdgcn_mfma_f32_16x16x32_bf16(Bt[n][k], At[m][k], acc[ai][bj][m][n], 0, 0, 0); } __builtin_amdgcn_s_setprio(0); } while (0)
#define PG8_MMA2(ai, At) do { if constexpr (Sched::BLOCKDIAG) { if (lo_half) PG8_MMA(ai, 0, At, B0); else PG8_MMA(ai, 1, At, B1); } else { PG8_MMA(ai, 0, At, B0); PG8_MMA(ai, 1, At, B1); } } while (0)
#define PG8_WAIT_V(n) asm volatile("s_waitcnt vmcnt(" #n ")" ::: "memory")
#define PG8_WAIT_L(n) asm volatile("s_waitcnt lgkmcnt(" #n ")" ::: "memory")
#define PG8_BAR __builtin_amdgcn_s_barrier()
#define PG8_SCHED __builtin_amdgcn_sched_barrier(0)
    Unit cur, nxt; int ui = 0;
    if (!S.next(0, cur)) return;
    S.offs(cur, RA, CA, voffA);
    f32x4 acc[2][2][4][2];
#pragma unroll
    for (int a = 0; a < 2; ++a)
#pragma unroll
        for (int b = 0; b < 2; ++b)
#pragma unroll
            for (int m = 0; m < 4; ++m)
#pragma unroll
                for (int n = 0; n < 2; ++n) acc[a][b][m][n] = (f32x4){0.f, 0.f, 0.f, 0.f};
    bf16x8 At[4][2], B0[2][2], B1[2][2];
    unsigned cA = cur.a, cB = cur.b;
    PG8_STAGE_B(PG8_SB(0, 0), cB); PG8_STAGE_B(PG8_SB(0, 1), cB + hstepB); PG8_STAGE_A(PG8_SA(0, 0), cA, 0); PG8_STAGE_A(PG8_SA(0, 1), cA, 1);
    if (wr == 1) PG8_BAR;
    PG8_WAIT_V(2); PG8_BAR;
    PG8_STAGE_B(PG8_SB(1, 0), cB + kstep); PG8_STAGE_A(PG8_SA(1, 0), cA + kstep, 0); PG8_STAGE_B(PG8_SB(1, 1), cB + hstepB + kstep);
    PG8_WAIT_V(6); PG8_BAR;
    for (;;) {
        const bool has_next = S.next(ui + 1, nxt);
        const unsigned nA = has_next ? nxt.a : cA, nB = has_next ? nxt.b : cB;
        unsigned nvoff[4];
        if constexpr (Sched::GATHER) { if (has_next) S.rows(nxt, RA, nvoff); }
#pragma nounroll
        for (int t = 0; t < nt; t += 2) {
            const bool last = (t == nt - 2), lo_half = t < (nt >> 1);
            const unsigned a1 = cA + (unsigned)(t + 1) * kstep;
            const unsigned a2 = last ? nA : cA + (unsigned)(t + 2) * kstep, b2 = last ? nB : cB + (unsigned)(t + 2) * kstep;
            const unsigned a3 = a2 + kstep, b3 = b2 + kstep;
            PG8_LDB(B0, 0, 0); PG8_LDB(B1, 0, 1); PG8_SCHED; PG8_LDA(At, 0, 0); PG8_STAGE_A(PG8_SA(1, 1), a1, 1);
            PG8_WAIT_V(8); PG8_WAIT_L(0); PG8_BAR; PG8_MMA2(0, At); PG8_BAR; PG8_SCHED;
            if constexpr (Sched::GATHER) { if (last && has_next) {
#pragma unroll
                for (int q = 0; q < 4; ++q) voffA[q] = nvoff[q] * (unsigned)S.pa + (unsigned)(CA[q & 1] * 2); } }
            PG8_LDA(At, 0, 1); PG8_STAGE_B(PG8_SB(0, 0), b2); PG8_STAGE_B(PG8_SB(0, 1), b2 + hstepB); PG8_STAGE_A(PG8_SA(0, 0), a2, 0);
            PG8_WAIT_V(8); PG8_WAIT_L(0); PG8_BAR; PG8_MMA2(1, At); PG8_BAR; PG8_SCHED;
            PG8_LDB(B0, 1, 0); PG8_LDB(B1, 1, 1); PG8_SCHED; PG8_LDA(At, 1, 0); PG8_STAGE_A(PG8_SA(0, 1), a2, 1);
            PG8_WAIT_V(8); PG8_WAIT_L(0); PG8_BAR; PG8_MMA2(0, At); PG8_BAR; PG8_SCHED;
            PG8_LDA(At, 1, 1); PG8_STAGE_B(PG8_SB(1, 0), b3); PG8_STAGE_B(PG8_SB(1, 1), b3 + hstepB); PG8_STAGE_A(PG8_SA(1, 0), a3, 0);
            PG8_WAIT_V(8); PG8_WAIT_L(0); PG8_BAR; PG8_MMA2(1, At); PG8_BAR; PG8_SCHED;
        }
        if (wr == 0) PG8_BAR;
        { const int t2 = fresh_tid() & 63; E(acc, cur, wr, wc, t2 & 15, t2 >> 4, lds + LDS_EPI); }
        if (!has_next) break;
#pragma unroll
        for (int a = 0; a < 2; ++a)
#pragma unroll
            for (int b = 0; b < 2; ++b)
#pragma unroll
                for (int m = 0; m < 4; ++m)
#pragma unroll
                    for (int n = 0; n < 2; ++n) acc[a][b][m][n] = (f32x4){0.f, 0.f, 0.f, 0.f};
        cur = nxt; cA = nA; cB = nB; ++ui;
        if (wr == 1) PG8_BAR;
    }
    PG8_WAIT_V(0);
    PG8_BAR;
#undef PG8_SA
#undef PG8_SB
#undef PG8_STAGE_A
#undef PG8_STAGE_B
#undef PG8_LDA
#undef PG8_LDB
#undef PG8_MMA
#undef PG8_MMA2
#undef PG8_WAIT_V
#undef PG8_WAIT_L
#undef PG8_BAR
#undef PG8_SCHED
}

struct DenseSched {
    static constexpr bool GATHER = false, BLOCKDIAG = false;
    int nM, nN, nwg, G, c; int pa, pb; unsigned A, B;
    __device__ void init(int M, int N, int G_, int c_, size_t A_, int pa_, size_t B_, int pb_) { nM = M / BM; nN = N / BM; nwg = nM * nN; G = G_; c = c_; A = (unsigned)A_; B = (unsigned)B_; pa = pa_; pb = pb_; }
    __device__ __forceinline__ bool next(int i, Unit& u) const {
        const long L = (long)i * G + c; if (L >= nwg) return false;
        int wgid = (int)L; { const int q = nwg / NXCD, r = nwg % NXCD, xcd = wgid % NXCD, off = wgid / NXCD; wgid = (xcd < r ? xcd * (q + 1) : r * (q + 1) + (xcd - r) * q) + off; }
        const int nig = WGM * nN, gid = wgid / nig, fm = gid * WGM, gsz = (nM - fm) < WGM ? (nM - fm) : WGM;
        u.pm = fm + ((wgid % nig) % gsz); u.pn = (wgid % nig) / gsz; u.aux = 0;
        u.a = A + (unsigned)(u.pm * BM * pa); u.b = B + (unsigned)(u.pn * BM * pb); return true;
    }
    __device__ __forceinline__ void offs(const Unit&, const int (&RA)[2], const int (&CA)[2], unsigned (&v)[4]) const {
#pragma unroll
        for (int h = 0; h < 2; ++h)
#pragma unroll
            for (int i = 0; i < 2; ++i) v[h * 2 + i] = (unsigned)((h * HALF + RA[i]) * pa + CA[i] * 2);
    }
};
struct DiagSched : DenseSched { static constexpr bool BLOCKDIAG = true; };
}

struct Params { const float* in[21]; float* out; unsigned char* ws; int ph_lo, ph_hi; };
enum { I_X = 0, I_C, I_POS, I_WADA, I_BADA, I_GMIX, I_GFFN, I_WIN, I_WBG, I_QG, I_KG, I_WBD, I_WBS, I_WOUT, I_WRG, I_BRG, I_WRE, I_BRE, I_WEG, I_WEU, I_WED };

struct Frame {
    LAS unsigned char* lds;
    unsigned char* ws;
    int wave, G, bid;
};

template <bool FP8>
DI void p0_transpose_item(const float* W, int N, void* WTv, int ldt, int k0, int n0, int row_base, LAS float* scr, int lane) {
#pragma unroll 8
    for (int i = 0; i < 32; ++i) { const int kk = 2 * i + (lane >> 5); scr[kk * 33 + (lane & 31)] = W[(size_t)(k0 + kk) * N + n0 + (lane & 31)]; }
    LDS_WAIT();
    const int c = lane & 7;
#pragma unroll
    for (int j = 0; j < 4; ++j) { const int n = (lane >> 3) + 8 * j; const LAS float* sp = scr + (8 * c) * 33 + n;
        if (FP8) { u32x2 o; o.x = pk4_fp8(64.f * sp[0 * 33], 64.f * sp[1 * 33], 64.f * sp[2 * 33], 64.f * sp[3 * 33]); o.y = pk4_fp8(64.f * sp[4 * 33], 64.f * sp[5 * 33], 64.f * sp[6 * 33], 64.f * sp[7 * 33]);
            *(u32x2*)((unsigned char*)WTv + (size_t)(row_base + n) * ldt + k0 + 8 * c) = o; }
        else { u32x4 o; o.x = pk2(sp[0 * 33], sp[1 * 33]); o.y = pk2(sp[2 * 33], sp[3 * 33]); o.z = pk2(sp[4 * 33], sp[5 * 33]); o.w = pk2(sp[6 * 33], sp[7 * 33]);
            *(u32x4*)((bf16_t*)WTv + (size_t)(row_base + n) * ldt + k0 + 8 * c) = o; } }
    LDS_WAIT();
}
DI void phase0(const Frame& F, const Params& p) {
    const int tid_ = fresh_tid(), lane_ = tid_ & 63;
    LAS float* scr = (LAS float*)(F.lds + F.wave * 16384);
    const int gw = F.bid * 8 + F.wave, NGW = F.G * 8;
    bf16_t* W1 = (bf16_t*)(F.ws + WS_W1); bf16_t* WB = (bf16_t*)(F.ws + WS_WB); bf16_t* WO = (bf16_t*)(F.ws + WS_WO);
    unsigned char* WG8 = F.ws + WS_WG8; unsigned char* WGU = F.ws + WS_WGU; unsigned char* WDN = F.ws + WS_WDN;
    constexpr int I1 = 16 * 96, I2 = 16 * 64, I3 = 4 * 32, I4 = 4 * 32, I5 = 16 * 32, I6 = 32 * 256, I7 = 32 * 256, I8 = 32 * 256;
    constexpr int NITEMS = I1 + I2 + I3 + I4 + I5 + I6 + I7 + I8;
    for (int it = gw; it < NITEMS; it += NGW) {
        int r = it;
        if (r < I1) { const int kb = r / 96, nb = r % 96; if (nb < 72) p0_transpose_item<true>(p.in[I_WIN], 3072, F.ws + WS_W1D8, 1024, 64 * kb, 32 * nb, 32 * nb, scr, lane_); else p0_transpose_item<false>(p.in[I_WIN], 3072, W1, 1024, 64 * kb, 32 * nb, 32 * nb, scr, lane_); continue; } r -= I1;
        if (r < I2) { const int kb = r / 64, nb = r % 64; p0_transpose_item<true>(p.in[I_WBG], 2048, WG8, 1024, 64 * kb, 32 * nb, 32 * nb, scr, lane_); continue; } r -= I2;
        if (r < I3) { const int kb = r / 32, nb = r % 32, n0 = 32 * nb; p0_transpose_item<false>(p.in[I_WBD], 1024, WB, 512, 64 * kb, n0, (n0 >> 7) * 256 + (n0 & 127), scr, lane_); continue; } r -= I3;
        if (r < I4) { const int kb = r / 32, nb = r % 32, n0 = 32 * nb; p0_transpose_item<false>(p.in[I_WBS], 1024, WB + 256, 512, 64 * kb, n0, (n0 >> 7) * 256 + 128 + (n0 & 127), scr, lane_); continue; } r -= I4;
        if (r < I5) { const int kb = r / 32, nb = r % 32; p0_transpose_item<true>(p.in[I_WOUT], 1024, WO, 1024, 64 * kb, 32 * nb, 32 * nb, scr, lane_); continue; } r -= I5;
        if (r < I6) { const int e = r >> 8, q = r & 255, kb = q >> 4, nb = q & 15, n0 = 32 * nb;
            p0_transpose_item<true>(p.in[I_WEG] + (size_t)e * 1024 * 512, 512, WGU + (size_t)e * 1024 * 1024, 1024, 64 * kb, n0, (n0 >> 7) * 256 + (n0 & 127), scr, lane_); continue; } r -= I6;
        if (r < I7) { const int e = r >> 8, q = r & 255, kb = q >> 4, nb = q & 15, n0 = 32 * nb;
            p0_transpose_item<true>(p.in[I_WEU] + (size_t)e * 1024 * 512, 512, WGU + (size_t)e * 1024 * 1024, 1024, 64 * kb, n0, (n0 >> 7) * 256 + 128 + (n0 & 127), scr, lane_); continue; } r -= I7;
        { const int e = r >> 8, q = r & 255, kb = q >> 5, nb = q & 31;
            p0_transpose_item<true>(p.in[I_WED] + (size_t)e * 512 * 1024, 1024, WDN + (size_t)e * 1024 * 512, 512, 64 * kb, 32 * nb, 32 * nb, scr, lane_); }
    }
    {
        bf16_t* WBz = (bf16_t*)(F.ws + WS_WB);
        for (int idx = F.bid * 512 + tid_; idx < 2048 * 32; idx += F.G * 512) { const int row = idx >> 5, c = idx & 31; *(u32x4*)(WBz + (size_t)row * 512 + ((row & 128) ? 0 : 256) + c * 8) = (u32x4){0u, 0u, 0u, 0u}; }
    }
    {
        float* modp = (float*)(F.ws + WS_MODP); const float* c = p.in[I_C]; const float* wada = p.in[I_WADA];
        for (int task = gw; task < 96 * 8; task += NGW) {
            const int ct = task % 96, ks = task / 96, k0 = ks * 128;
#pragma unroll
            for (int i = 0; i < 16; ++i) { const int idx = i * 64 + lane_, b = idx >> 7, k = idx & 127; const float v = c[b * 1024 + k0 + k]; scr[idx] = v * sigmoidf(v); }
            LDS_WAIT();
            float acc[8];
#pragma unroll
            for (int b = 0; b < 8; ++b) acc[b] = 0.f;
            const float* wp = wada + (size_t)k0 * 6144 + ct * 64 + lane_;
#pragma unroll 8
            for (int k = 0; k < 128; ++k) { const float w = wp[(size_t)k * 6144];
#pragma unroll
                for (int b = 0; b < 8; ++b) acc[b] += scr[b * 128 + k] * w; }
#pragma unroll
            for (int b = 0; b < 8; ++b) modp[((size_t)ks * 8 + b) * 6144 + ct * 64 + lane_] = acc[b];
            LDS_WAIT();
        }
    }
}

DI float inv_freq_of(int i) {
    return i == 0 ? 1.0f : i == 1 ? 0.1939227432012558f : i == 2 ? 0.03760603070259094f : i == 3 ? 0.007292664609849453f : i == 4 ? 0.0014142135623842478f : i == 5 ? 0.00027424818836152554f : i == 6 ? 5.318296098266728e-05f : 1.0313386155758053e-05f;
}
template <int WHICH>
DI void phase_norm(const Frame& F, const Params& p) {
    const int tid_ = fresh_tid(), lane_ = tid_ & 63;
    LAS float* gs = (LAS float*)(F.lds); LAS float* sh = gs + 1024;
    const float* modp = (const float*)(F.ws + WS_MODP); float* mod = (float*)(F.ws + WS_MOD); const float* bada = p.in[I_BADA];
    const float* xin = p.in[I_X]; const bf16_t* upd = (const bf16_t*)(F.ws + WS_UPD1); bf16_t* hout = (bf16_t*)(F.ws + (WHICH == 0 ? WS_H : WS_H2)); unsigned* h8 = (unsigned*)(F.ws + (WHICH == 0 ? WS_H8 : WS_H28));
    const float* gn = p.in[WHICH == 0 ? I_GMIX : I_GFFN];
    for (int chunk = F.bid; chunk < T / 256; chunk += F.G) {
        const int b = chunk >> 5;
        __syncthreads();
        if (WHICH == 0) {
            if (tid_ < 192) { const int j = (chunk & 31) * 192 + tid_; float s = bada[j];
#pragma unroll
                for (int ks = 0; ks < 8; ++ks) s += modp[((size_t)ks * 8 + b) * 6144 + j];
                mod[b * 6144 + j] = s; }
            for (int col = tid_; col < 1024; col += 512) { float s1 = bada[col], s2 = bada[1024 + col];
#pragma unroll
                for (int ks = 0; ks < 8; ++ks) { s1 += modp[((size_t)ks * 8 + b) * 6144 + col]; s2 += modp[((size_t)ks * 8 + b) * 6144 + 1024 + col]; }
                gs[col] = gn[col] * (1.f + s2); sh[col] = s1; }
        } else {
            for (int col = tid_; col < 1024; col += 512) { gs[col] = gn[col] * (1.f + mod[b * 6144 + 4096 + col]); sh[col] = mod[b * 6144 + 3072 + col]; }
        }
        __syncthreads();
        f32x4 g4[4], s4[4];
#pragma unroll
        for (int j = 0; j < 4; ++j) { g4[j] = *(const LAS f32x4*)(gs + 256 * j + 4 * lane_); s4[j] = *(const LAS f32x4*)(sh + 256 * j + 4 * lane_); }
        for (int rr = F.wave; rr < 256; rr += 8) {
            const int row = chunk * 256 + rr;
            const f32x4* xr = (const f32x4*)(xin + (size_t)row * 1024) + lane_;
            f32x4 v[4]; float ss = 0.f;
#pragma unroll
            for (int j = 0; j < 4; ++j) v[j] = xr[64 * j];
            if (WHICH == 1) { const u32x2* ur = (const u32x2*)(upd + (size_t)row * 1024) + lane_; u32x2 uu[4];
#pragma unroll
                for (int j = 0; j < 4; ++j) uu[j] = ur[64 * j];
#pragma unroll
                for (int j = 0; j < 4; ++j) { v[j].x += bf_lo(uu[j].x); v[j].y += bf_hi(uu[j].x); v[j].z += bf_lo(uu[j].y); v[j].w += bf_hi(uu[j].y); } }
#pragma unroll
            for (int j = 0; j < 4; ++j) ss += (v[j].x * v[j].x + v[j].y * v[j].y) + (v[j].z * v[j].z + v[j].w * v[j].w);
            const float rinv = __builtin_amdgcn_rsqf(wave_sum(ss) * (1.f / 1024.f) + RMS_EPS);
            u32x2* o8 = (u32x2*)(hout + (size_t)row * 1024) + lane_;
#pragma unroll
            for (int j = 0; j < 4; ++j) { const f32x4 y = v[j] * rinv * g4[j] + s4[j]; u32x2 o; o.x = pk2(y.x, y.y); o.y = pk2(y.z, y.w); o8[64 * j] = o; h8[(size_t)row * 256 + 64 * j + lane_] = pk4_fp8(y.x, y.y, y.z, y.w); }
            if (WHICH == 0 && lane_ < 8) {
                const int pos = ((const int*)p.in[I_POS])[row];
                const float angf = (float)pos * inv_freq_of(lane_);
                double rv = (double)angf * 0.15915494309189535; rv -= __builtin_rint(rv);
                const float fr = (float)rv;
                bf16_t* rp = (bf16_t*)(F.ws + WS_ROPE) + (size_t)row * 16;
                rp[lane_] = (bf16_t)(pk2(__builtin_amdgcn_cosf(fr), 0.f) & 0xffffu); rp[8 + lane_] = (bf16_t)(pk2(__builtin_amdgcn_sinf(fr), 0.f) & 0xffffu);
            }
        }
    }
}

template <bool GATES> struct EpiProj {
    static constexpr bool PERM = true;
    bf16_t* proj; bf16_t* gates; const bf16_t* rope; const float* qg; const float* kg; int pn0;
    DI void operator()(const f32x4 (&acc)[2][2][4][2], const pg8::Unit& u, int wr, int wc, int fr, int fq, LAS unsigned char* scr) const {
        asm volatile("" : "+v"(fr), "+v"(fq));
        const int pn = u.pn + pn0, row0 = u.pm * 256 + wr * 64 + fr, cw = wc * 32 + 8 * fq;
        const int typ = pn < 9 ? pn / 3 : pn - 9, grp = pn < 9 ? pn % 3 : 0, l2d = pn < 9 ? 2 * grp : 0, hbase = pn < 9 ? grp * 4 : 12;
        if (GATES) {
            unsigned char* base = (unsigned char*)gates + pn * 256 + cw;
#pragma unroll
            for (int ai = 0; ai < 2; ++ai)
#pragma unroll
                for (int m = 0; m < 4; ++m) { unsigned char* rowp = base + (size_t)(row0 + ai * 128 + m * 16) * LDG;
#pragma unroll
                    for (int bj = 0; bj < 2; ++bj) { const f32x4 v0 = acc[ai][bj][m][0], v1 = acc[ai][bj][m][1];
                        u32x2 w; w.x = pk4_fp8(v0.x, v0.y, v0.z, v0.w); w.y = pk4_fp8(v1.x, v1.y, v1.z, v1.w);
                        *(u32x2*)(rowp + bj * 128) = w; } }
        } else if (pn >= 6) {
            const float sc = pn == 9 ? QSCALE : 1.f;
            const int dim0 = (wc & 1) * 32 + 8 * fq;
#pragma unroll
            for (int ai = 0; ai < 2; ++ai)
#pragma unroll
                for (int m = 0; m < 4; ++m) { const int t = row0 + ai * 128 + m * 16, sq = t & (S - 1); const int rp = (t & ~(S - 1)) + ((sq & ((1 << l2d) - 1)) << (13 - l2d)) + (sq >> l2d);
#pragma unroll
                    for (int bj = 0; bj < 2; ++bj) { const f32x4 v0 = acc[ai][bj][m][0] * sc, v1 = acc[ai][bj][m][1] * sc; const int head = hbase + 2 * bj + (wc >> 1);
                        u32x4 w; w.x = pk2(v0.x, v0.y); w.y = pk2(v0.z, v0.w); w.z = pk2(v1.x, v1.y); w.w = pk2(v1.z, v1.w);
                        *(u32x4*)(proj + ((size_t)(typ * 16 + head) * T + rp) * 64 + dim0) = w; } }
        } else {
            const bool isq = pn < 3; const float* g = isq ? qg : kg; const float sc = isq ? QSCALE : 1.f;
            LAS float* part = (LAS float*)scr;
            const int ch = (wc & 1) * 32 + 8 * fq;
            const f32x4 g0 = *(const f32x4*)(g + ch), g1 = *(const f32x4*)(g + ch + 4);
            const bool ropew = (wc & 1) == 0;
            u32x4 rcs[2][4][2];
            if (ropew) {
#pragma unroll
                for (int ai = 0; ai < 2; ++ai)
#pragma unroll
                    for (int m = 0; m < 4; ++m) { const u32x4* rpt = (const u32x4*)(rope + (size_t)(u.pm * 256 + ai * 128 + wr * 64 + m * 16 + fr) * 16); rcs[ai][m][0] = rpt[0]; rcs[ai][m][1] = rpt[1]; }
            }
#pragma unroll
            for (int ai = 0; ai < 2; ++ai)
#pragma unroll
                for (int m = 0; m < 4; ++m)
#pragma unroll
                    for (int bj = 0; bj < 2; ++bj) { const f32x4 a = acc[ai][bj][m][0], b = acc[ai][bj][m][1];
                        float ss = (a.x * a.x + a.y * a.y) + (a.z * a.z + a.w * a.w) + (b.x * b.x + b.y * b.y) + (b.z * b.z + b.w * b.w);
                        ss += __shfl_xor(ss, 16); ss += __shfl_xor(ss, 32);
                        if (fq == 0) part[((ai * 128 + wr * 64 + m * 16 + fr) * 2 + bj) * 4 + wc] = ss; }
            LDS_WAIT(); __builtin_amdgcn_s_barrier(); asm volatile("" ::: "memory");
#pragma unroll
            for (int ai = 0; ai < 2; ++ai)
#pragma unroll
                for (int m = 0; m < 4; ++m) { const int rl = ai * 128 + wr * 64 + m * 16 + fr, row = u.pm * 256 + rl, sq = row & (S - 1);
                    const int rp = (row & ~(S - 1)) + ((sq & ((1 << l2d) - 1)) << (13 - l2d)) + (sq >> l2d);
                    f32x4 c0 = {0, 0, 0, 0}, c1 = c0, s0 = c0, s1 = c0;
                    if (ropew) { const u32x4 cc = rcs[ai][m][0], sn = rcs[ai][m][1];
                        c0 = (f32x4){bf_lo(cc.x), bf_hi(cc.x), bf_lo(cc.y), bf_hi(cc.y)}; c1 = (f32x4){bf_lo(cc.z), bf_hi(cc.z), bf_lo(cc.w), bf_hi(cc.w)};
                        s0 = (f32x4){bf_lo(sn.x), bf_hi(sn.x), bf_lo(sn.y), bf_hi(sn.y)}; s1 = (f32x4){bf_lo(sn.z), bf_hi(sn.z), bf_lo(sn.w), bf_hi(sn.w)};
                        if (fq == 0) { s0 = -s0; s1 = -s1; } }
#pragma unroll
                    for (int bj = 0; bj < 2; ++bj) {
                        const float tot = part[(rl * 2 + bj) * 4 + wc] + part[(rl * 2 + bj) * 4 + (wc ^ 1)];
                        const float rinv = __builtin_amdgcn_rsqf(tot * (1.f / 64.f) + RMS_EPS);
                        f32x4 v0 = acc[ai][bj][m][0] * rinv * g0, v1 = acc[ai][bj][m][1] * rinv * g1;
                        if (ropew) {
                            f32x4 p0, p1;
                            p0.x = __shfl_xor(v0.x, 16); p0.y = __shfl_xor(v0.y, 16); p0.z = __shfl_xor(v0.z, 16); p0.w = __shfl_xor(v0.w, 16);
                            p1.x = __shfl_xor(v1.x, 16); p1.y = __shfl_xor(v1.y, 16); p1.z = __shfl_xor(v1.z, 16); p1.w = __shfl_xor(v1.w, 16);
                            if (fq < 2) { v0 = v0 * c0 + p0 * s0; v1 = v1 * c1 + p1 * s1; }
                        }
                        v0 = v0 * sc; v1 = v1 * sc; const int head = hbase + 2 * bj + (wc >> 1);
                        u32x4 w; w.x = pk2(v0.x, v0.y); w.y = pk2(v0.z, v0.w); w.z = pk2(v1.x, v1.y); w.w = pk2(v1.z, v1.w);
                        *(u32x4*)(proj + ((size_t)(typ * 16 + head) * T + rp) * 64 + ch) = w; } }
        }
    }
};

struct EpiBranch {
    static constexpr bool PERM = true;
    const unsigned char* gates; unsigned char* merged;
    DI void operator()(const f32x4 (&acc)[2][2][4][2], const pg8::Unit& u, int wr, int wc, int fr, int fq, LAS unsigned char*) const {
        asm volatile("" : "+v"(fr), "+v"(fq));
        const int row0 = u.pm * 256 + wr * 64 + fr, col0 = u.pn * 128 + wc * 32 + 8 * fq;
        u32x2 gd[2][4], gs[2][4];
#pragma unroll
        for (int ai = 0; ai < 2; ++ai)
#pragma unroll
            for (int m = 0; m < 4; ++m) { const size_t row = (size_t)(row0 + ai * 128 + m * 16);
                gd[ai][m] = *(const u32x2*)(gates + row * LDG + col0); gs[ai][m] = *(const u32x2*)(gates + row * LDG + 1024 + col0); }
        __builtin_amdgcn_sched_barrier(0);
#pragma unroll
        for (int ai = 0; ai < 2; ++ai)
#pragma unroll
            for (int m = 0; m < 4; ++m) { const size_t row = (size_t)(row0 + ai * 128 + m * 16);
                const u32x2 g = gd[ai][m], q = gs[ai][m];
                const f32x2 ga = fp8_lo2(g.x), gb = fp8_hi2(g.x), gc = fp8_lo2(g.y), gdd = fp8_hi2(g.y), qa = fp8_lo2(q.x), qb = fp8_hi2(q.x), qc = fp8_lo2(q.y), qd = fp8_hi2(q.y);
                const f32x4 v0 = acc[ai][0][m][0] * (f32x4){sigmoidf(ga.x), sigmoidf(ga.y), sigmoidf(gb.x), sigmoidf(gb.y)} + acc[ai][1][m][0] * (f32x4){sigmoidf(qa.x), sigmoidf(qa.y), sigmoidf(qb.x), sigmoidf(qb.y)};
                const f32x4 v1 = acc[ai][0][m][1] * (f32x4){sigmoidf(gc.x), sigmoidf(gc.y), sigmoidf(gdd.x), sigmoidf(gdd.y)} + acc[ai][1][m][1] * (f32x4){sigmoidf(qc.x), sigmoidf(qc.y), sigmoidf(qd.x), sigmoidf(qd.y)};
                u32x2 w; w.x = pk4_fp8(8.f * v0.x, 8.f * v0.y, 8.f * v0.z, 8.f * v0.w); w.y = pk4_fp8(8.f * v1.x, 8.f * v1.y, 8.f * v1.z, 8.f * v1.w);
                *(u32x2*)(merged + row * 1024 + col0) = w; }
    }
};
struct BranchSched {
    static constexpr bool GATHER = false;
    int G, c; int pa, pb; unsigned A, B;
    DI bool next(int i, pg8::Unit& u) const {
        const int tile = (i >> 1) * G + c; if (tile >= 256 * 4) return false;
        u.pm = tile >> 2; u.pn = tile & 3; u.aux = i & 1;
        u.a = A + (unsigned)(u.pm * 256 * LDO * 2 + u.aux * 256 * 2); u.b = B + (unsigned)(u.aux * 1024 * 256 * 2 + u.pn * 256 * 256 * 2); return true;
    }
    DI void offs(const pg8::Unit&, const int (&RA)[2], const int (&CA)[2], unsigned (&v)[4]) const {
#pragma unroll
        for (int h = 0; h < 2; ++h)
#pragma unroll
            for (int i = 0; i < 2; ++i) v[h * 2 + i] = (unsigned)((h * 128 + RA[i]) * pa + CA[i] * 2);
    }
};

struct EpiOut {
    static constexpr bool PERM = true;
    bf16_t* upd; const float* mod;
    DI void operator()(const f32x4 (&acc)[2][2][4][2], const pg8::Unit& u, int wr, int wc, int fr, int fq, LAS unsigned char*) const {
        asm volatile("" : "+v"(fr), "+v"(fq));
        const int row0 = u.pm * 256 + wr * 64 + fr, col0 = u.pn * 256 + wc * 32 + 8 * fq; const int b = (u.pm * 256) >> 13;
        f32x4 gv[2][2];
#pragma unroll
        for (int bj = 0; bj < 2; ++bj)
#pragma unroll
            for (int n = 0; n < 2; ++n) gv[bj][n] = *(const f32x4*)(mod + b * 6144 + 2048 + col0 + bj * 128 + n * 4) * 0.125f;
#pragma unroll
        for (int ai = 0; ai < 2; ++ai)
#pragma unroll
            for (int m = 0; m < 4; ++m)
#pragma unroll
                for (int bj = 0; bj < 2; ++bj) { const f32x4 v0 = acc[ai][bj][m][0] * gv[bj][0], v1 = acc[ai][bj][m][1] * gv[bj][1];
                    u32x4 w; w.x = pk2(v0.x, v0.y); w.y = pk2(v0.z, v0.w); w.z = pk2(v1.x, v1.y); w.w = pk2(v1.z, v1.w);
                    *(u32x4*)(upd + (size_t)(row0 + ai * 128 + m * 16) * 1024 + col0 + bj * 128) = w; }
    }
};

struct EpiLogit {
    static constexpr bool PERM = false;
    float* logit;
    DI void operator()(const f32x4 (&acc)[2][2][4][2], const pg8::Unit& u, int wr, int wc, int fr, int fq, LAS unsigned char*) const {
        asm volatile("" : "+v"(fr), "+v"(fq));
        const int row0 = u.pm * 256 + wr * 64 + fr, col0 = wc * 32 + 4 * fq;
#pragma unroll
        for (int ai = 0; ai < 2; ++ai)
#pragma unroll
            for (int m = 0; m < 4; ++m)
#pragma unroll
                for (int n = 0; n < 2; ++n) *(f32x4*)(logit + (size_t)(row0 + ai * 128 + m * 16) * 128 + col0 + n * 16) = acc[ai][0][m][n];
    }
};

struct MoeSched {
    static constexpr bool GATHER_ = true;
    int G, c, nc; int pa, pb; unsigned A, B; const LAS int* cstart; const int* slot_tok; unsigned estride, pnstride;
};
struct MoeSchedUp : MoeSched {
    static constexpr bool GATHER = true, BLOCKDIAG = false;
    DI bool next(int i, pg8::Unit& u) const {
        const int L = i * G + c; if (L >= nc * 4) return false;
        const int chunk = L >> 2; int e = 0;
        for (int q = 1; q < 32; ++q) e += (chunk >= cstart[q]) ? 1 : 0;
        u.pm = chunk; u.pn = L & 3; u.aux = e; u.a = A; u.b = B + (unsigned)e * estride + (unsigned)u.pn * pnstride; return true;
    }
    DI void offs(const pg8::Unit& u, const int (&RA)[2], const int (&CA)[2], unsigned (&v)[4]) const {
#pragma unroll
        for (int h = 0; h < 2; ++h)
#pragma unroll
            for (int i = 0; i < 2; ++i) { const int tok = slot_tok[u.pm * 256 + h * 128 + RA[i]]; v[h * 2 + i] = (unsigned)(tok * pa + CA[i] * 2); }
    }
    DI void rows(const pg8::Unit& u, const int (&RA)[2], unsigned (&v)[4]) const {
#pragma unroll
        for (int h = 0; h < 2; ++h)
#pragma unroll
            for (int i = 0; i < 2; ++i) v[h * 2 + i] = (unsigned)slot_tok[u.pm * 256 + h * 128 + RA[i]];
    }
};
struct MoeSchedDn : MoeSched {
    static constexpr bool GATHER = false, BLOCKDIAG = false;
    DI bool next(int i, pg8::Unit& u) const {
        const int L = i * G + c; if (L >= nc * 4) return false;
        const int chunk = L >> 2; int e = 0;
        for (int q = 1; q < 32; ++q) e += (chunk >= cstart[q]) ? 1 : 0;
        u.pm = chunk; u.pn = L & 3; u.aux = e; u.a = A + (unsigned)(chunk * 256 * pa); u.b = B + (unsigned)e * estride + (unsigned)u.pn * pnstride; return true;
    }
    DI void offs(const pg8::Unit&, const int (&RA)[2], const int (&CA)[2], unsigned (&v)[4]) const {
#pragma unroll
        for (int h = 0; h < 2; ++h)
#pragma unroll
            for (int i = 0; i < 2; ++i) v[h * 2 + i] = (unsigned)((h * 128 + RA[i]) * pa + CA[i] * 2);
    }
};
struct EpiSwiglu {
    static constexpr bool PERM = true;
    unsigned char* hmid;
    DI void operator()(const f32x4 (&acc)[2][2][4][2], const pg8::Unit& u, int wr, int wc, int fr, int fq, LAS unsigned char*) const {
        asm volatile("" : "+v"(fr), "+v"(fq));
        const int row0 = u.pm * 256 + wr * 64 + fr, col0 = u.pn * 128 + wc * 32 + 8 * fq;
#pragma unroll
        for (int ai = 0; ai < 2; ++ai)
#pragma unroll
            for (int m = 0; m < 4; ++m) {
                f32x4 h[2];
#pragma unroll
                for (int n = 0; n < 2; ++n) { const f32x4 g = acc[ai][0][m][n], up = acc[ai][1][m][n];
                    h[n] = (f32x4){g.x * sigmoidf(g.x) * up.x, g.y * sigmoidf(g.y) * up.y, g.z * sigmoidf(g.z) * up.z, g.w * sigmoidf(g.w) * up.w}; }
                u32x2 w; w.x = pk4_fp8(h[0].x, h[0].y, h[0].z, h[0].w); w.y = pk4_fp8(h[1].x, h[1].y, h[1].z, h[1].w);
                *(u32x2*)(hmid + (size_t)(row0 + ai * 128 + m * 16) * DE + col0) = w; }
    }
};
struct EpiDown {
    static constexpr bool PERM = true;
    unsigned char* y;
    DI void operator()(const f32x4 (&acc)[2][2][4][2], const pg8::Unit& u, int wr, int wc, int fr, int fq, LAS unsigned char*) const {
        asm volatile("" : "+v"(fr), "+v"(fq));
        const int row0 = u.pm * 256 + wr * 64 + fr, col0 = u.pn * 256 + wc * 32 + 8 * fq;
#pragma unroll
        for (int ai = 0; ai < 2; ++ai)
#pragma unroll
            for (int m = 0; m < 4; ++m) { const int slot = row0 + ai * 128 + m * 16;
#pragma unroll
                for (int bj = 0; bj < 2; ++bj) { const f32x4 v0 = acc[ai][bj][m][0] * 8.f, v1 = acc[ai][bj][m][1] * 8.f;
                    u32x2 o; o.x = pk4_fp8(v0.x, v0.y, v0.z, v0.w); o.y = pk4_fp8(v1.x, v1.y, v1.z, v1.w);
                    *(u32x2*)(y + (size_t)slot * 1024 + col0 + bj * 128) = o; } }
    }
};

constexpr int SLOT_BYTES = 8192;
DI f32x16 mfma32(bf16x8 a, bf16x8 b, f32x16 c) { return __builtin_amdgcn_mfma_f32_32x32x16_bf16(a, b, c, 0, 0, 0); }
DI int swz_f(int r) { return (((r >> 1) & 1) << 2) | ((r >> 2) & 3); }
struct AttnLane { unsigned doff[4]; unsigned ka[4]; unsigned va[2][2]; };
DI void attn_lane_init(AttnLane& L, int lane) {
#pragma unroll
    for (int i = 0; i < 4; ++i) { const int r = 8 * i + (lane >> 3), c = (lane & 7) ^ swz_f(r); L.doff[i] = (unsigned)(r * 128 + c * 16); }
    { const int r = lane & 31, h = lane >> 5; const unsigned a0 = (unsigned)(r * 128 + 16 * ((h ^ swz_f(r)) & 7));
#pragma unroll
      for (int s = 0; s < 4; ++s) L.ka[s] = a0 ^ (unsigned)(32 * s); }
    { const int h = lane >> 5, blk = (lane >> 4) & 1, q = (lane & 15) >> 2, p = lane & 3, fb2 = (q >> 1) & 1;
#pragma unroll
      for (int t = 0; t < 2; ++t) { const int flow = (2 * t + h) & 3;
#pragma unroll
        for (int mt = 0; mt < 2; ++mt) L.va[t][mt] = (unsigned)(4096 + (8 * t + 4 * h + q) * 128 + 16 * (4 * (mt ^ fb2) + ((2 * blk + (p >> 1)) ^ flow)) + 8 * (p & 1)); } }
}
DI void dma_tile(const AttnLane& L, const __amdgpu_buffer_rsrc_t rs, unsigned koff, unsigned voff, LAS unsigned char* slot) {
#pragma unroll
    for (int i = 0; i < 4; ++i) __builtin_amdgcn_raw_ptr_buffer_load_lds(rs, (LAS unsigned*)(slot + 1024 * i), 16, (int)L.doff[i], (int)koff, 0, 0);
#pragma unroll
    for (int i = 0; i < 4; ++i) __builtin_amdgcn_raw_ptr_buffer_load_lds(rs, (LAS unsigned*)(slot + 4096 + 1024 * i), 16, (int)L.doff[i], (int)voff, 0, 0);
}
DI void tr_read8(const AttnLane& L, unsigned sb, bf16x8 (&vf)[2][2]) {
    s16x4 r0, r1, r2, r3, r4, r5, r6, r7;
    const unsigned a00 = sb + L.va[0][0], a10 = sb + L.va[1][0], a01 = sb + L.va[0][1], a11 = sb + L.va[1][1];
    asm volatile("ds_read_b64_tr_b16 %0, %8\n\tds_read_b64_tr_b16 %1, %9\n\tds_read_b64_tr_b16 %2, %8 offset:2048\n\tds_read_b64_tr_b16 %3, %9 offset:2048\n\t"
                 "ds_read_b64_tr_b16 %4, %10\n\tds_read_b64_tr_b16 %5, %11\n\tds_read_b64_tr_b16 %6, %10 offset:2048\n\tds_read_b64_tr_b16 %7, %11 offset:2048\n\ts_waitcnt lgkmcnt(0)"
                 : "=&v"(r0), "=&v"(r1), "=&v"(r2), "=&v"(r3), "=&v"(r4), "=&v"(r5), "=&v"(r6), "=&v"(r7)
                 : "v"(a00), "v"(a10), "v"(a01), "v"(a11) : "memory");
    vf[0][0] = __builtin_shufflevector(r0, r1, 0, 1, 2, 3, 4, 5, 6, 7); vf[0][1] = __builtin_shufflevector(r2, r3, 0, 1, 2, 3, 4, 5, 6, 7);
    vf[1][0] = __builtin_shufflevector(r4, r5, 0, 1, 2, 3, 4, 5, 6, 7); vf[1][1] = __builtin_shufflevector(r6, r7, 0, 1, 2, 3, 4, 5, 6, 7);
}
DI bf16x8 pack8(const f32x16& x, int s) {
    u32x4 p; p.x = pk2(x[8 * s], x[8 * s + 1]); p.y = pk2(x[8 * s + 2], x[8 * s + 3]); p.z = pk2(x[8 * s + 4], x[8 * s + 5]); p.w = pk2(x[8 * s + 6], x[8 * s + 7]);
    return __builtin_bit_cast(bf16x8, p);
}
DI void store_o_row(bf16_t* rowp, const f32x16& O0, const f32x16& O1, float sc, int h) {
#pragma unroll
    for (int mt = 0; mt < 2; ++mt)
#pragma unroll
        for (int kp = 0; kp < 2; ++kp) { const f32x16& O = mt ? O1 : O0; const int g0 = 8 * kp, g1 = 8 * kp + 4;
            u32x2 a, b; a.x = pk2(O[g0] * sc, O[g0 + 1] * sc); a.y = pk2(O[g0 + 2] * sc, O[g0 + 3] * sc); b.x = pk2(O[g1] * sc, O[g1 + 1] * sc); b.y = pk2(O[g1 + 2] * sc, O[g1 + 3] * sc);
            { auto r = __builtin_amdgcn_permlane32_swap(a.x, b.x, false, false); a.x = r[0]; b.x = r[1]; }
            { auto r = __builtin_amdgcn_permlane32_swap(a.y, b.y, false, false); a.y = r[0]; b.y = r[1]; }
            *(u32x4*)(rowp + 32 * mt + 16 * kp + 8 * h) = (u32x4){a.x, a.y, b.x, b.y}; }
}
#define ATTN_WAIT_TILE(more) do { if (more) asm volatile("s_waitcnt vmcnt(8)" ::: "memory"); else asm volatile("s_waitcnt vmcnt(0)" ::: "memory"); } while (0)
DI void dil_tile(const AttnLane& L, const __amdgpu_buffer_rsrc_t rs, const bf16_t* hb, int hd, long row0, int j, LAS unsigned char* ldsW, bf16_t* og, float* lse, int lane) {
    const int qi = lane & 31, h = lane >> 5;
    const bf16_t* qh = hb + (size_t)hd * T * 64;
    const unsigned kh = (unsigned)(WS_PROJ + ((size_t)(16 + hd) * T + row0) * 128), vh = (unsigned)(WS_PROJ + ((size_t)(32 + hd) * T + row0) * 128);
    bf16x8 qf[4];
    { const bf16_t* qp = qh + (size_t)(row0 + 32 * j + qi) * 64 + 8 * h;
#pragma unroll
      for (int s = 0; s < 4; ++s) qf[s] = *(const bf16x8*)(qp + 16 * s); }
    float mrun = -INFINITY, lrun = 0.f;
    f32x16 O0, O1;
#pragma unroll
    for (int i = 0; i < 16; ++i) { O0[i] = 0.f; O1[i] = 0.f; }
    const int kt0 = j >= 4 ? j - 4 : 0;
    dma_tile(L, rs, kh + (unsigned)(4096 * kt0), vh + (unsigned)(4096 * kt0), ldsW);
    unsigned buf = 0;
    for (int kt = kt0; kt <= j; ++kt) {
        const bool more = kt < j;
        if (more) dma_tile(L, rs, kh + (unsigned)(4096 * (kt + 1)), vh + (unsigned)(4096 * (kt + 1)), ldsW + (buf ^ 1u) * SLOT_BYTES);
        ATTN_WAIT_TILE(more);
        LAS unsigned char* slot = ldsW + buf * SLOT_BYTES;
        f32x16 sc;
#pragma unroll
        for (int i = 0; i < 16; ++i) sc[i] = 0.f;
#pragma unroll
        for (int s = 0; s < 4; ++s) { const bf16x8 kf = *(const LAS bf16x8*)(slot + L.ka[s]); sc = mfma32(kf, qf[s], sc); }
        if (kt == j) {
#pragma unroll
            for (int i = 0; i < 16; ++i) { const int key = (i & 3) + 8 * (i >> 2) + 4 * h; if (key > qi) sc[i] = -INFINITY; }
        }
        if (kt == j - 4) {
#pragma unroll
            for (int i = 0; i < 16; ++i) { const int key = (i & 3) + 8 * (i >> 2) + 4 * h; if (key < qi) sc[i] = -INFINITY; }
        }
        float mx = sc[0];
#pragma unroll
        for (int i = 1; i < 16; ++i) mx = fmaxf(mx, sc[i]);
        mx = fmaxf(mx, __shfl_xor(mx, 32));
        const float mnew = fmaxf(mrun, mx), alpha = fexp2(mrun - mnew);
        float ps = 0.f;
#pragma unroll
        for (int i = 0; i < 16; ++i) { sc[i] = fexp2(sc[i] - mnew); ps += sc[i]; }
        lrun = lrun * alpha + ps; mrun = mnew;
#pragma unroll
        for (int i = 0; i < 16; ++i) { O0[i] *= alpha; O1[i] *= alpha; }
        const bf16x8 p0 = pack8(sc, 0), p1 = pack8(sc, 1);
        bf16x8 vf[2][2]; tr_read8(L, (unsigned)(size_t)slot, vf);
        O0 = mfma32(vf[0][0], p0, O0); O0 = mfma32(vf[0][1], p1, O0);
        O1 = mfma32(vf[1][0], p0, O1); O1 = mfma32(vf[1][1], p1, O1);
        buf ^= 1u;
    }
    const float ltot = lrun + __shfl_xor(lrun, 32), inv = frcp(ltot);
    const size_t row = (size_t)(row0 + 32 * j + qi);
    store_o_row(og + row * 64, O0, O1, inv, h);
    if (h == 0) lse[row] = mrun + flog2(ltot);
}
DI void sb_tile(const AttnLane& L, const __amdgpu_buffer_rsrc_t rs, const bf16_t* hb, int b, int h4, int j, LAS unsigned char* ldsW, bf16_t* ocat, int lane) {
    const int qi = lane & 31, h = lane >> 5;
    const long base = (long)b * S;
    const bf16_t* qh = hb + (size_t)(12 + h4) * T * 64;
    const unsigned kh = (unsigned)(WS_PROJ + ((size_t)(16 + 12 + h4) * T + base) * 128), vh = (unsigned)(WS_PROJ + ((size_t)(32 + 12 + h4) * T + base) * 128);
    bf16x8 qf[4];
    { const bf16_t* qp = qh + (size_t)(base + 32 * j + qi) * 64 + 8 * h;
#pragma unroll
      for (int s = 0; s < 4; ++s) qf[s] = *(const bf16x8*)(qp + 16 * s); }
    float carry = 0.f;
    f32x16 O0, O1;
#pragma unroll
    for (int i = 0; i < 16; ++i) { O0[i] = 0.f; O1[i] = 0.f; }
    dma_tile(L, rs, kh + (unsigned)(4096 * j), vh + (unsigned)(4096 * j), ldsW);
    unsigned buf = 0;
    for (int kt = j; kt >= 0; --kt) {
        const bool more = kt > 0;
        if (more) dma_tile(L, rs, kh + (unsigned)(4096 * (kt - 1)), vh + (unsigned)(4096 * (kt - 1)), ldsW + (buf ^ 1u) * SLOT_BYTES);
        ATTN_WAIT_TILE(more);
        LAS unsigned char* slot = ldsW + buf * SLOT_BYTES;
        f32x16 z;
#pragma unroll
        for (int i = 0; i < 16; ++i) z[i] = 0.f;
#pragma unroll
        for (int s = 0; s < 4; ++s) { const bf16x8 kf = *(const LAS bf16x8*)(slot + L.ka[s]); z = mfma32(kf, qf[s], z); }
#pragma unroll
        for (int i = 0; i < 16; ++i) z[i] = fexp2(fminf(z[i], 31.f));
        if (kt == j) {
#pragma unroll
            for (int i = 0; i < 16; ++i) { const int key = (i & 3) + 8 * (i >> 2) + 4 * h; if (key >= qi) z[i] = 0.f; }
        }
        float lg[4], par[4], u0[4], p01[4], p012[4];
#pragma unroll
        for (int g = 0; g < 4; ++g) { const float a0 = 1.f + z[4 * g], a1 = 1.f + z[4 * g + 1], a2 = 1.f + z[4 * g + 2], a3 = 1.f + z[4 * g + 3];
            u0[g] = a0; p01[g] = a0 * a1; p012[g] = p01[g] * a2; lg[g] = -flog2(p012[g] * a3); }
#pragma unroll
        for (int g = 0; g < 4; ++g) par[g] = __shfl_xor(lg[g], 32);
        float tg[4]; tg[3] = carry; tg[2] = tg[3] + (lg[3] + par[3]); tg[1] = tg[2] + (lg[2] + par[2]); tg[0] = tg[1] + (lg[1] + par[1]);
        carry = tg[0] + (lg[0] + par[0]);
#pragma unroll
        for (int g = 0; g < 4; ++g) { const float suf = tg[g] + lg[g] + (h == 0 ? par[g] : 0.f); const float y = fexp2(suf);
            z[4 * g] = z[4 * g] * y; z[4 * g + 1] = z[4 * g + 1] * (y * u0[g]); z[4 * g + 2] = z[4 * g + 2] * (y * p01[g]); z[4 * g + 3] = z[4 * g + 3] * (y * p012[g]); }
        const bf16x8 p0 = pack8(z, 0), p1 = pack8(z, 1);
        bf16x8 vf[2][2]; tr_read8(L, (unsigned)(size_t)slot, vf);
        O0 = mfma32(vf[0][0], p0, O0); O0 = mfma32(vf[0][1], p1, O0);
        O1 = mfma32(vf[1][0], p0, O1); O1 = mfma32(vf[1][1], p1, O1);
        if (__all(carry < -40.f)) break;
        buf ^= 1u;
    }
    store_o_row(ocat + (size_t)(base + 32 * j + qi) * LDO + 256 + h4 * 64, O0, O1, 1.f, h);
}
DI void phase_attn(const Frame& F, const Params& p) {
    const int tid_ = fresh_tid(), lane_ = tid_ & 63;
    const bf16_t* hb = (const bf16_t*)(F.ws + WS_PROJ); bf16_t* ocat = (bf16_t*)(F.ws + WS_OCAT);
    bf16_t* og = (bf16_t*)(F.ws + WS_OG); float* lse = (float*)(F.ws + WS_LSE);
    LAS unsigned char* ldsW = F.lds + F.wave * (2 * SLOT_BYTES);
    AttnLane L; attn_lane_init(L, lane_);
    const __amdgpu_buffer_rsrc_t rs = __builtin_amdgcn_make_buffer_rsrc(F.ws, 0, (int)WS_END, 0x00020000);
    const int NU = NB * 4 * 16;
    for (int i = 0;; ++i) {
        const int u = (F.G == 256) ? ((F.bid & 7) * 32 + (F.bid >> 3) + 256 * i) : (F.bid + F.G * i);
        if (u >= NU) break;
        const int qb = u & 15, hs = (u >> 4) & 3, b = u >> 6, t0 = qb * 512;
        for (int w = F.wave; w < 16; w += 8) sb_tile(L, rs, hb, b, hs, t0 / 32 + w, ldsW, ocat, lane_);
        for (int w = F.wave; w < 48; w += 8) {
            const int g = w >> 4, ti = w & 15, l2d = 2 * g, per = 16 >> l2d, r = ti / per, jj = ti % per;
            dil_tile(L, rs, hb, g * 4 + hs, (long)b * S + (long)r * (S >> l2d), ((t0 >> l2d) >> 5) + jj, ldsW, og + (size_t)(g * 4 + hs) * T * 64, lse + (size_t)(g * 4 + hs) * T, lane_);
        }
        VM_WAIT();
        __syncthreads();
        {
            const int piece = tid_ & 7; const size_t bb = (size_t)b * S;
#pragma unroll 2
            for (int pass = 0; pass < 8; ++pass) {
                const int sq = t0 + pass * 64 + (tid_ >> 3);
                const size_t r0 = bb + sq, r1 = bb + ((size_t)(sq & 3) << 11) + (sq >> 2), r2 = bb + ((size_t)(sq & 15) << 9) + (sq >> 4);
                const float l0 = lse[(size_t)(0 + hs) * T + r0], l1 = lse[(size_t)(4 + hs) * T + r1], l2 = lse[(size_t)(8 + hs) * T + r2];
                const u32x4 x = *((const u32x4*)(og + ((size_t)(0 + hs) * T + r0) * 64) + piece), y = *((const u32x4*)(og + ((size_t)(4 + hs) * T + r1) * 64) + piece), z = *((const u32x4*)(og + ((size_t)(8 + hs) * T + r2) * 64) + piece);
                const float mx = fmaxf(l0, fmaxf(l1, l2)); float w0 = fexp2(l0 - mx), w1 = fexp2(l1 - mx), w2 = fexp2(l2 - mx); const float inv = frcp(w0 + w1 + w2); w0 *= inv; w1 *= inv; w2 *= inv;
                u32x4 r;
                r.x = pk2(w0 * bf_lo(x.x) + w1 * bf_lo(y.x) + w2 * bf_lo(z.x), w0 * bf_hi(x.x) + w1 * bf_hi(y.x) + w2 * bf_hi(z.x));
                r.y = pk2(w0 * bf_lo(x.y) + w1 * bf_lo(y.y) + w2 * bf_lo(z.y), w0 * bf_hi(x.y) + w1 * bf_hi(y.y) + w2 * bf_hi(z.y));
                r.z = pk2(w0 * bf_lo(x.z) + w1 * bf_lo(y.z) + w2 * bf_lo(z.z), w0 * bf_hi(x.z) + w1 * bf_hi(y.z) + w2 * bf_hi(z.z));
                r.w = pk2(w0 * bf_lo(x.w) + w1 * bf_lo(y.w) + w2 * bf_lo(z.w), w0 * bf_hi(x.w) + w1 * bf_hi(y.w) + w2 * bf_hi(z.w));
                *((u32x4*)(ocat + (bb + sq) * LDO + hs * 64) + piece) = r;
            }
        }
        __syncthreads();
    }
}

DI void route_rows(const Frame& F, const Params& p, int pm) {
    const int tid_ = fresh_tid(), lane_ = tid_ & 63;
    LAS int* hist = (LAS int*)(F.lds);
    const int ftid = fresh_tid();
    __syncthreads();
    if (ftid < 32) hist[ftid] = 0;
    __syncthreads();
    if (tid_ < 256) {
        const int row = pm * 256 + tid_; const float* L = (const float*)(F.ws + WS_LOGIT) + (size_t)row * 128;
        const float* brg = p.in[I_BRG]; const float* bre = p.in[I_BRE];
        float lgp[4];
#pragma unroll
        for (int c = 0; c < 4; ++c) lgp[c] = L[c] + L[36 + c] + brg[c];
        int gsel = 0; float gm = lgp[0];
#pragma unroll
        for (int c = 1; c < 4; ++c) if (lgp[c] > gm) { gm = lgp[c]; gsel = c; }
        float zs = 0.f;
#pragma unroll
        for (int c = 0; c < 4; ++c) zs += fexp2((lgp[c] - gm) * LOG2E);
        const float pg = frcp(zs);
        float l1 = -INFINITY, l2 = -INFINITY; int e1 = 0, e2 = 0;
#pragma unroll
        for (int i = 0; i < 8; ++i) { const int c = 4 + gsel * 8 + i; const float v = L[c] + L[36 + c] + bre[gsel * 8 + i];
            if (v > l1) { l2 = l1; e2 = e1; l1 = v; e1 = i; } else if (v > l2) { l2 = v; e2 = i; } }
        const float ex = fexp2((l2 - l1) * LOG2E), den = frcp(1.f + ex);
        int* te = (int*)(F.ws + WS_TOKE) + (size_t)row * 2; float* tw = (float*)(F.ws + WS_TOKW) + (size_t)row * 2;
        te[0] = gsel * 8 + e1; te[1] = gsel * 8 + e2; tw[0] = pg * den; tw[1] = pg * ex * den;
        lds_add(&hist[gsel * 8 + e1], 1); lds_add(&hist[gsel * 8 + e2], 1);
    }
    __syncthreads();
    if (ftid < 32) ((int*)(F.ws + WS_HIST))[pm * 32 + ftid] = hist[ftid];
}


DI void router_weights_to_lds(const Frame& F, const Params& p) {
    const int tid_ = fresh_tid(), lane_ = tid_ & 63;
    constexpr int WP = 1028;
    LAS float* wt = (LAS float*)(F.lds + LDS_RW); LAS float* bias = (LAS float*)(F.lds + LDS_RS) + 8 * 80 + 32;
    const float* wrg = p.in[I_WRG]; const float* wre = p.in[I_WRE]; const float* brg = p.in[I_BRG]; const float* bre = p.in[I_BRE];
    const int ftid = fresh_tid();
    __syncthreads();
#pragma unroll 8
    for (int i = ftid; i < 1024 * 32; i += 512) wt[(4 + (i & 31)) * WP + (i >> 5)] = wre[i];
#pragma unroll 8
    for (int i = ftid; i < 1024 * 4; i += 512) wt[(i & 3) * WP + (i >> 2)] = wrg[i];
    if (ftid < 36) bias[ftid] = ftid < 4 ? brg[ftid] : bre[ftid - 4];
}

DI void phase_norm2_route(const Frame& F, const Params& p) {
    const int tid_ = fresh_tid(), lane_ = tid_ & 63;
    constexpr int WP = 1028;
    LAS float* wt = (LAS float*)(F.lds + LDS_RW);
    LAS float* gs = (LAS float*)(F.lds + LDS_RV); LAS float* sh = gs + 1024;
    LAS float* scr = (LAS float*)(F.lds + LDS_RS) + F.wave * 80;
    LAS int* hist = (LAS int*)(F.lds + LDS_RS) + 8 * 80;
    LAS float* bias = (LAS float*)(F.lds + LDS_RS) + 8 * 80 + 32;
    const float* mod = (const float*)(F.ws + WS_MOD); const float* gn = p.in[I_GFFN];
    const bf16_t* upd = (const bf16_t*)(F.ws + WS_UPD1); unsigned* h8 = (unsigned*)(F.ws + WS_H28);
    const float* wrg = p.in[I_WRG]; const float* wre = p.in[I_WRE]; const float* brg = p.in[I_BRG]; const float* bre = p.in[I_BRE];
    const int ftid = fresh_tid();
    __syncthreads();
    for (int chunk = F.bid; chunk < T / 256; chunk += F.G) {
        const int b = chunk >> 5;
        __syncthreads();
        for (int col = ftid; col < 1024; col += 512) { gs[col] = gn[col] * (1.f + mod[b * 6144 + 4096 + col]); sh[col] = mod[b * 6144 + 3072 + col]; }
        if (ftid < 32) hist[ftid] = 0;
        __syncthreads();
        f32x4 vn[2][4]; u32x2 un[2][4];
#pragma unroll
        for (int r = 0; r < 2; ++r) { const int row = chunk * 256 + F.wave * 2 + r;
            const f32x4* xr = (const f32x4*)(p.in[I_X] + (size_t)row * 1024) + lane_; const u32x2* ur = (const u32x2*)(upd + (size_t)row * 1024) + lane_;
#pragma unroll
            for (int j = 0; j < 4; ++j) { vn[r][j] = xr[64 * j]; un[r][j] = ur[64 * j]; } }
        for (int rr = F.wave * 2; rr < 256; rr += 16) {
            const int row0 = chunk * 256 + rr;
            f32x2 yp[4][4];
            {
                f32x4 y[2][4];
#pragma unroll
                for (int r = 0; r < 2; ++r) {
                    const int row = row0 + r; float ss = 0.f;
#pragma unroll
                    for (int j = 0; j < 4; ++j) { vn[r][j].x += bf_lo(un[r][j].x); vn[r][j].y += bf_hi(un[r][j].x); vn[r][j].z += bf_lo(un[r][j].y); vn[r][j].w += bf_hi(un[r][j].y);
                        ss += (vn[r][j].x * vn[r][j].x + vn[r][j].y * vn[r][j].y) + (vn[r][j].z * vn[r][j].z + vn[r][j].w * vn[r][j].w); }
                    const float rinv = __builtin_amdgcn_rsqf(wave_sum(ss) * (1.f / 1024.f) + RMS_EPS);
#pragma unroll
                    for (int j = 0; j < 4; ++j) { const f32x4 gj = *(const LAS f32x4*)(gs + 256 * j + 4 * lane_), sj = *(const LAS f32x4*)(sh + 256 * j + 4 * lane_);
                        y[r][j] = vn[r][j] * rinv * gj + sj; h8[(size_t)row * 256 + 64 * j + lane_] = pk4_fp8(y[r][j].x, y[r][j].y, y[r][j].z, y[r][j].w); }
                }
#pragma unroll
                for (int j = 0; j < 4; ++j) { yp[j][0] = (f32x2){y[0][j].x, y[1][j].x}; yp[j][1] = (f32x2){y[0][j].y, y[1][j].y}; yp[j][2] = (f32x2){y[0][j].z, y[1][j].z}; yp[j][3] = (f32x2){y[0][j].w, y[1][j].w}; }
            }
            if (rr + 16 < 256) {
#pragma unroll
                for (int r = 0; r < 2; ++r) { const int row = row0 + 16 + r;
                    const f32x4* xr = (const f32x4*)(p.in[I_X] + (size_t)row * 1024) + lane_; const u32x2* ur = (const u32x2*)(upd + (size_t)row * 1024) + lane_;
#pragma unroll
                    for (int j = 0; j < 4; ++j) { vn[r][j] = xr[64 * j]; un[r][j] = ur[64 * j]; } }
            }
            { const bool up32 = (lane_ & 32) != 0, up16 = (lane_ & 16) != 0, up8 = (lane_ & 8) != 0;
              float r36[36];
#pragma unroll
              for (int sg = 0; sg < 3; ++sg) {
                f32x2 a12[12];
#pragma unroll
                for (int g = 0; g < 3; ++g)
#pragma unroll
                  for (int hh = 0; hh < 2; ++hh) {
                    f32x4 w[2][4];
#pragma unroll
                    for (int ci = 0; ci < 2; ++ci)
#pragma unroll
                        for (int j = 0; j < 4; ++j) w[ci][j] = *(const LAS f32x4*)(wt + ((sg * 3 + g) * 4 + hh * 2 + ci) * WP + 4 * lane_ + 256 * j);
#pragma unroll
                    for (int ci = 0; ci < 2; ++ci) { f32x2 ax = {0.f, 0.f}, ay = ax, az = ax, aw = ax;
#pragma unroll
                        for (int j = 0; j < 4; ++j) { const f32x4 ww = w[ci][j];
                            ax = __builtin_elementwise_fma(yp[j][0], (f32x2){ww.x, ww.x}, ax); ay = __builtin_elementwise_fma(yp[j][1], (f32x2){ww.y, ww.y}, ay);
                            az = __builtin_elementwise_fma(yp[j][2], (f32x2){ww.z, ww.z}, az); aw = __builtin_elementwise_fma(yp[j][3], (f32x2){ww.w, ww.w}, aw); }
                        a12[g * 4 + hh * 2 + ci] = (ax + ay) + (az + aw); }
                    __builtin_amdgcn_sched_barrier(0);
                  }
                float got[12];
#pragma unroll
                for (int i = 0; i < 12; ++i) got[i] = __shfl_xor(up32 ? a12[i].x : a12[i].y, 32);
#pragma unroll
                for (int i = 0; i < 12; ++i) r36[sg * 12 + i] = (up32 ? a12[i].y : a12[i].x) + got[i];
                __builtin_amdgcn_sched_barrier(0);
              }
              float r18[18], g18[18];
#pragma unroll
              for (int i = 0; i < 18; ++i) g18[i] = __shfl_xor(up16 ? r36[i] : r36[18 + i], 16);
#pragma unroll
              for (int i = 0; i < 18; ++i) r18[i] = (up16 ? r36[18 + i] : r36[i]) + g18[i];
              float r9[9], g9[9];
#pragma unroll
              for (int i = 0; i < 9; ++i) g9[i] = __shfl_xor(up8 ? r18[i] : r18[9 + i], 8);
#pragma unroll
              for (int i = 0; i < 9; ++i) r9[i] = (up8 ? r18[9 + i] : r18[i]) + g9[i];
#pragma unroll
              for (int m = 4; m >= 1; m >>= 1) {
#pragma unroll
                for (int i = 0; i < 9; ++i) g9[i] = __shfl_xor(r9[i], m);
#pragma unroll
                for (int i = 0; i < 9; ++i) r9[i] += g9[i];
              }
              if ((lane_ & 7) == 0) { const int o = (lane_ >> 5) * 36 + ((lane_ >> 4) & 1) * 18 + ((lane_ >> 3) & 1) * 9;
#pragma unroll
                for (int i = 0; i < 9; ++i) scr[o + i] = r9[i]; }
            }
            LDS_WAIT();
            if (lane_ < 2) {
                const LAS float* L = scr + lane_ * 36; const int row = row0 + lane_;
                float lgp[4];
#pragma unroll
                for (int c = 0; c < 4; ++c) lgp[c] = L[c] + bias[c];
                int gsel = 0; float gm = lgp[0];
#pragma unroll
                for (int c = 1; c < 4; ++c) if (lgp[c] > gm) { gm = lgp[c]; gsel = c; }
                float zs = 0.f;
#pragma unroll
                for (int c = 0; c < 4; ++c) zs += fexp2((lgp[c] - gm) * LOG2E);
                const float pg = frcp(zs);
                float l1 = -INFINITY, l2 = -INFINITY; int e1 = 0, e2 = 0;
#pragma unroll
                for (int i = 0; i < 8; ++i) { const float v = L[4 + gsel * 8 + i] + bias[4 + gsel * 8 + i];
                    if (v > l1) { l2 = l1; e2 = e1; l1 = v; e1 = i; } else if (v > l2) { l2 = v; e2 = i; } }
                const float ex = fexp2((l2 - l1) * LOG2E), den = frcp(1.f + ex);
                int* te = (int*)(F.ws + WS_TOKE) + (size_t)row * 2; float* tw = (float*)(F.ws + WS_TOKW) + (size_t)row * 2;
                te[0] = gsel * 8 + e1; te[1] = gsel * 8 + e2; tw[0] = pg * den; tw[1] = pg * ex * den;
                lds_add(&hist[gsel * 8 + e1], 1); lds_add(&hist[gsel * 8 + e2], 1);
            }
            LDS_WAIT();
        }
        __syncthreads();
        if (ftid < 32) ((int*)(F.ws + WS_HIST))[chunk * 32 + ftid] = hist[ftid];
    }
}

DI void phase_slots(const Frame& F, const Params& p) {
    const int tid_ = fresh_tid(), lane_ = tid_ & 63;
    LAS int* tot = (LAS int*)(F.lds); LAS int* bas = tot + 32; LAS int* pst = tot + 64; LAS int* wcnt = tot + 128;
    const int* hist = (const int*)(F.ws + WS_HIST);
    for (int pm = F.bid; pm < T / 256; pm += F.G) {
        const int ftid = fresh_tid();
        __syncthreads();
        if (ftid < 64) tot[ftid] = 0;
        __syncthreads();
        { const int e = tid_ & 31, part = tid_ >> 5; int t = 0, bs = 0;
          for (int q = part; q < T / 256; q += 16) { const int v = hist[q * 32 + e]; t += v; if (q < pm) bs += v; }
          lds_add(&tot[e], t); lds_add(&bas[e], bs); }
        __syncthreads();
        if (tid_ == 0) { int run = 0; for (int e = 0; e < 32; ++e) { pst[e] = run; run += (tot[e] + 255) / 256 * 256; } pst[32] = run; }
        const int my_e = ((const int*)(F.ws + WS_TOKE))[(size_t)pm * 512 + tid_];
        int rank = 0;
        for (int e = 0; e < 32; ++e) { const unsigned long long mask = __ballot(my_e == e); if (my_e == e) rank = __popcll(mask & ((1ull << lane_) - 1ull)); if (lane_ == 0) wcnt[F.wave * 32 + e] = __popcll(mask); }
        __syncthreads();
        int woff = 0;
        for (int w = 0; w < F.wave; ++w) woff += wcnt[w * 32 + my_e];
        const int slot = pst[my_e] + bas[my_e] + woff + rank;
        ((int*)(F.ws + WS_SLOTTOK))[slot] = pm * 256 + (tid_ >> 1);
        ((float*)(F.ws + WS_SLOTW))[slot] = ((const float*)(F.ws + WS_TOKW))[(size_t)pm * 512 + tid_];
        ((int*)(F.ws + WS_TOKS))[(size_t)pm * 512 + tid_] = slot;
        if (pm < 32) { const int e = pm; for (int s = pst[e] + tot[e] + tid_; s < pst[e + 1]; s += 512) { ((int*)(F.ws + WS_SLOTTOK))[s] = 0; ((float*)(F.ws + WS_SLOTW))[s] = 0.f; } }
        if (pm == 0 && tid_ < 34) { int* et = (int*)(F.ws + WS_ETAB); if (tid_ < 33) et[64 + tid_] = pst[tid_] >> 8; if (tid_ < 32) { et[tid_] = tot[tid_]; et[32 + tid_] = pst[tid_]; } if (tid_ == 33) et[97] = pst[32] >> 8; }
    }
}

DI void phase_combine(const Frame& F, const Params& p) {
    const int tid_ = fresh_tid(), lane_ = tid_ & 63;
    const unsigned* y = (const unsigned*)(F.ws + WS_Y); const int* ts = (const int*)(F.ws + WS_TOKS); const float* tw = (const float*)(F.ws + WS_TOKW); const float* mod = (const float*)(F.ws + WS_MOD);
    const int gw = F.bid * 8 + F.wave, NGW = F.G * 8;
    for (int row = gw; row < T; row += NGW) {
        const int s0 = ts[(size_t)row * 2], s1 = ts[(size_t)row * 2 + 1]; const float w0 = tw[(size_t)row * 2] * 0.125f, w1 = tw[(size_t)row * 2 + 1] * 0.125f;
        const f32x4* xr = (const f32x4*)(p.in[I_X] + (size_t)row * 1024) + lane_; f32x4* orow = (f32x4*)(p.out + (size_t)row * 1024) + lane_;
        const u32x2* ur = (const u32x2*)((const bf16_t*)(F.ws + WS_UPD1) + (size_t)row * 1024) + lane_;
        const unsigned* y0 = y + (size_t)s0 * 256 + lane_; const unsigned* y1 = y + (size_t)s1 * 256 + lane_;
        const f32x4* g2 = (const f32x4*)(mod + (row >> 13) * 6144 + 5120) + lane_;
        f32x4 v[4], g[4]; unsigned a[4], c[4]; u32x2 uu[4];
#pragma unroll
        for (int j = 0; j < 4; ++j) { v[j] = xr[64 * j]; uu[j] = ur[64 * j]; a[j] = y0[64 * j]; c[j] = y1[64 * j]; g[j] = g2[64 * j]; }
#pragma unroll
        for (int j = 0; j < 4; ++j) { if (!DBG_X1_PLAIN) { v[j].x += bf_lo(uu[j].x); v[j].y += bf_hi(uu[j].x); v[j].z += bf_lo(uu[j].y); v[j].w += bf_hi(uu[j].y); }
            if (!DBG_SKIP_Y) { const f32x2 al = fp8_lo2(a[j]), ah = fp8_hi2(a[j]), cl = fp8_lo2(c[j]), ch = fp8_hi2(c[j]);
                v[j].x += g[j].x * (w0 * al.x + w1 * cl.x); v[j].y += g[j].y * (w0 * al.y + w1 * cl.y); v[j].z += g[j].z * (w0 * ah.x + w1 * ch.x); v[j].w += g[j].w * (w0 * ah.y + w1 * ch.y); } orow[64 * j] = v[j]; }
    }
}

__global__ void __launch_bounds__(512, 2) fwd(Params p) {
    extern __shared__ __attribute__((aligned(16))) unsigned char lds_raw[];
    Frame F;
    F.lds = (LAS unsigned char*)lds_raw; F.ws = p.ws;
    F.wave = __builtin_amdgcn_readfirstlane((int)threadIdx.x >> 6); F.G = gridDim.x; F.bid = blockIdx.x;
    volatile LAS unsigned* ctl = (volatile LAS unsigned*)(F.lds + LDS_CTLO);
    { const int ftid = fresh_tid(); if (ftid < 64) ctl[ftid] = 0u; }
    __syncthreads();
    XcdBarrier bar; bar.bar = (unsigned*)(p.ws + WS_CTL) + CW_BAR; bar.x = 0; bar.st = ctl;
    if (MK_N_LAUNCHES == 1) bar = xcd_barrier_post((unsigned*)(p.ws + WS_CTL) + CW_BAR, ctl);
    const int lo = p.ph_lo, hi = p.ph_hi;
    const __amdgpu_buffer_rsrc_t rsw = __builtin_amdgcn_make_buffer_rsrc(p.ws, 0, (int)WS_END, 0x00020000);
#define IN(k) (lo <= (k) && (k) < hi)
#define REP(k) for (int rep_ = 0; rep_ < ((PROBE_PH) == (k) ? 2 : 1); ++rep_)
#define SEAM(k) do { if (IN(k) && IN((k) + 1)) xcd_barrier(bar); } while (0)

    if (IN(0)) REP(0) { phase0(F, p); } SEAM(0);
    if (IN(1)) REP(1) { phase_norm<0>(F, p); } SEAM(1);
    if (IN(2)) REP(2) {
        REP(20) {
            pg8::DenseSched Sd; Sd.init(T, 2304, F.G, F.bid, WS_H8, 1024, WS_W1D8, 1024);
            EpiProj<false> E{(bf16_t*)(F.ws + WS_PROJ), (bf16_t*)(F.ws + WS_GATES), (const bf16_t*)(F.ws + WS_ROPE), p.in[I_QG], p.in[I_KG], 0};
            pg8::gemm_phase<EpiProj<false>, pg8::DenseSched, true>(F.lds, 1024, Sd, E, rsw);
        }
        REP(21) {
            pg8::DenseSched Sd; Sd.init(T, 768, F.G, F.bid, WS_H, 2048, WS_W1 + (size_t)2304 * 2048, 2048);
            EpiProj<false> E{(bf16_t*)(F.ws + WS_PROJ), (bf16_t*)(F.ws + WS_GATES), (const bf16_t*)(F.ws + WS_ROPE), p.in[I_QG], p.in[I_KG], 9};
            pg8::gemm_phase<EpiProj<false>, pg8::DenseSched, false>(F.lds, 1024, Sd, E, rsw);
        }
        REP(22) {
            pg8::DenseSched Sd; Sd.init(T, 2048, F.G, F.bid, WS_H8, 1024, WS_WG8, 1024);
            EpiProj<true> E{(bf16_t*)(F.ws + WS_PROJ), (bf16_t*)(F.ws + WS_GATES), (const bf16_t*)(F.ws + WS_ROPE), p.in[I_QG], p.in[I_KG], 0};
            pg8::gemm_phase<EpiProj<true>, pg8::DenseSched, true>(F.lds, 1024, Sd, E, rsw);
        }
    } SEAM(2);
    if (IN(3)) REP(3) { phase_attn(F, p); } SEAM(3);
    if (IN(4)) REP(4) {
        pg8::DiagSched Sd; Sd.init(T, 2048, F.G, F.bid, WS_OCAT, 1024, WS_WB, 1024);
        EpiBranch E{(const unsigned char*)(F.ws + WS_GATES), F.ws + WS_MERGED};
        pg8::gemm_phase<EpiBranch, pg8::DiagSched, false>(F.lds, 512, Sd, E, rsw);
    } SEAM(4);
    if (IN(5)) REP(5) {
        pg8::DenseSched Sd; Sd.init(T, 1024, F.G, F.bid, WS_MERGED, 1024, WS_WO, 1024);
        EpiOut E{(bf16_t*)(F.ws + WS_UPD1), (const float*)(F.ws + WS_MOD)};
        pg8::gemm_phase<EpiOut, pg8::DenseSched, true>(F.lds, 1024, Sd, E, rsw);
        if (rep_ + 1 == ((PROBE_PH) == 5 ? 2 : 1)) router_weights_to_lds(F, p);
    } SEAM(5);
    if (IN(6)) REP(6) { phase_norm2_route(F, p); }
    if (IN(6) && IN(8)) xcd_barrier(bar);
    if (IN(8)) REP(8) { phase_slots(F, p); } SEAM(8);
    if (IN(9) || IN(10)) {
        LAS int* cst = (LAS int*)(F.lds + LDS_CTLO) + 16;
        __syncthreads();
        { const int ftid = fresh_tid(); if (ftid < 34) cst[ftid] = ((const int*)(F.ws + WS_ETAB))[64 + ftid]; }
        __syncthreads();
    }
    if (IN(9)) REP(9) {
        const LAS int* cst = (const LAS int*)(F.lds + LDS_CTLO) + 16;
        MoeSchedUp Sm; Sm.G = F.G; Sm.c = (F.G == 256) ? ((F.bid & 7) * 32 + (F.bid >> 3)) : F.bid; Sm.nc = cst[33]; Sm.pa = 1024; Sm.pb = 1024; Sm.A = (unsigned)WS_H28; Sm.B = (unsigned)WS_WGU; Sm.cstart = cst;
        Sm.slot_tok = (const int*)(F.ws + WS_SLOTTOK); Sm.estride = 1024u * 1024u; Sm.pnstride = 256u * 1024u;
        EpiSwiglu E{F.ws + WS_HMID};
        pg8::gemm_phase<EpiSwiglu, MoeSchedUp, true>(F.lds, 1024, Sm, E, rsw);
    } SEAM(9);
    if (IN(10)) REP(10) {
        const LAS int* cst = (const LAS int*)(F.lds + LDS_CTLO) + 16;
        MoeSchedDn Sm; Sm.G = F.G; Sm.c = (F.G == 256) ? ((F.bid & 7) * 32 + (F.bid >> 3)) : F.bid; Sm.nc = cst[33]; Sm.pa = 512; Sm.pb = 512; Sm.A = (unsigned)WS_HMID; Sm.B = (unsigned)WS_WDN; Sm.cstart = cst;
        Sm.slot_tok = (const int*)(F.ws + WS_SLOTTOK); Sm.estride = 1024u * 512u; Sm.pnstride = 256u * 512u;
        EpiDown E{F.ws + WS_Y};
        pg8::gemm_phase<EpiDown, MoeSchedDn, true>(F.lds, 512, Sm, E, rsw);
    } SEAM(10);
    if (IN(11)) { phase_combine(F, p); }
#undef IN
#undef SEAM
}

extern "C" void kernel_launch(void* const* d_in, const int* in_sizes, int n_in, void* d_out, int out_size, void* d_ws, size_t ws_size, hipStream_t stream) {
    static int grid = 0;
    if (grid == 0) {
        if (n_in != 21 || in_sizes[0] != T * D || out_size != T * D || ws_size < WS_END) { fprintf(stderr, "kernel_launch: unexpected problem (n_in %d, ws %zu)\n", n_in, ws_size); grid = -1; return; }
        int dev = 0, cus = 0, per_cu = 0;
        if (hipGetDevice(&dev) != hipSuccess || hipDeviceGetAttribute(&cus, hipDeviceAttributeMultiprocessorCount, dev) != hipSuccess) { grid = -1; return; }
        if (hipFuncSetAttribute((const void*)fwd, hipFuncAttributeMaxDynamicSharedMemorySize, LDS_BYTES) != hipSuccess) { fprintf(stderr, "kernel_launch: hipFuncSetAttribute failed\n"); grid = -1; return; }
        if (hipOccupancyMaxActiveBlocksPerMultiprocessor(&per_cu, (const void*)fwd, 512, LDS_BYTES) != hipSuccess || per_cu < 1) { fprintf(stderr, "kernel_launch: occupancy query says %d\n", per_cu); (void)hipGetLastError(); grid = -1; return; }
        grid = cus;
    }
    if (grid < 0) return;
    (void)hipMemsetAsync((char*)d_ws + WS_CTL, 0, CTL_ZERO_BYTES, stream);
    Params p{};
    for (int i = 0; i < 21; ++i) p.in[i] = (const float*)d_in[i];
    p.out = (float*)d_out; p.ws = (unsigned char*)d_ws;
    if (MK_N_LAUNCHES == 1) { p.ph_lo = 0; p.ph_hi = NPH; hipLaunchKernelGGL(fwd, dim3(grid), dim3(512), LDS_BYTES, stream, p); }
    else { for (int k = 0; k < NPH; ++k) { p.ph_lo = k; p.ph_hi = k + 1; hipLaunchKernelGGL(fwd, dim3(grid), dim3(512), LDS_BYTES, stream, p); } }
}
```

```cpp
#include <hip/hip_runtime.h>
#include <cstdio>
#include <cstdint>

#ifndef MK_N_LAUNCHES
#define MK_N_LAUNCHES 1
#endif
#define DBG_X1_PLAIN 0
#define DBG_SKIP_Y 0
#ifndef PROBE_PH
#define PROBE_PH -1
#endif

#define LAS __attribute__((address_space(3)))
#define DI __device__ __forceinline__
typedef unsigned short bf16_t;
typedef short bf16x8 __attribute__((ext_vector_type(8)));
typedef short s16x4 __attribute__((ext_vector_type(4)));
typedef float f32x2 __attribute__((ext_vector_type(2)));
typedef float f32x4 __attribute__((ext_vector_type(4)));
typedef float f32x16 __attribute__((ext_vector_type(16)));
typedef unsigned u32x2 __attribute__((ext_vector_type(2)));
typedef unsigned u32x4 __attribute__((ext_vector_type(4)));
typedef __bf16 bf16x2n __attribute__((ext_vector_type(2)));
typedef int i32x8 __attribute__((ext_vector_type(8)));

constexpr int NB = 8, S = 8192, D = 1024, T = NB * S;
constexpr int LDP = 3072, LDG = 2048, LDO = 512;
constexpr int NE = 32, DE = 512;
constexpr int MAXSLOT = T * 2 + NE * 256;
constexpr int NPH = 12;
constexpr float LOG2E = 1.4426950408889634f;
constexpr float QSCALE = 0.125f * LOG2E;
constexpr float RMS_EPS = 1e-6f;

constexpr size_t MiB = 1u << 20;
constexpr size_t WS_CTL = 0, CTL_ZERO_BYTES = 64 * 1024;
constexpr int CW_BAR = 1024;
constexpr size_t WS_MODP = 1 * MiB;
constexpr size_t WS_MOD = 3 * MiB;
constexpr size_t WS_ROPE = 4 * MiB;
constexpr size_t WS_LOGIT = 144 * MiB;
constexpr size_t WS_TOKE = 24 * MiB;
constexpr size_t WS_TOKW = 24 * MiB + 512 * 1024;
constexpr size_t WS_TOKS = 25 * MiB;
constexpr size_t WS_SLOTTOK = 25 * MiB + 512 * 1024;
constexpr size_t WS_SLOTW = 26 * MiB + 256 * 1024;
constexpr size_t WS_HIST = 27 * MiB;
constexpr size_t WS_ETAB = 27 * MiB + 256 * 1024;
constexpr size_t WS_WR = 28 * MiB;
constexpr size_t WS_W1D8 = 28 * MiB + 512 * 1024;
constexpr size_t WS_W1 = 32 * MiB;
constexpr size_t WS_WG8 = 38 * MiB;
constexpr size_t WS_WB = 40 * MiB;
constexpr size_t WS_WO = 43 * MiB;
constexpr size_t WS_WGU = 48 * MiB;
constexpr size_t WS_WDN = 80 * MiB;
constexpr size_t WS_H = 144 * MiB;
constexpr size_t WS_OG = 144 * MiB;
constexpr size_t WS_LSE = 240 * MiB;
constexpr size_t WS_PROJ = 272 * MiB;
constexpr size_t WS_GATES = 656 * MiB;
constexpr size_t WS_OCAT = 912 * MiB;
constexpr size_t WS_H8 = 912 * MiB;
constexpr size_t WS_MERGED = 272 * MiB;
constexpr size_t WS_H2 = 400 * MiB;
constexpr size_t WS_H28 = 528 * MiB;
constexpr size_t WS_HMID = 592 * MiB;
constexpr size_t WS_Y = 664 * MiB;
constexpr size_t WS_UPD1 = 800 * MiB;
constexpr size_t WS_END = 976 * MiB;

constexpr int LDS_STAGE = 0, LDS_EPI = 131072, LDS_RW = 0, LDS_RV = 148480, LDS_RS = 148480 + 8192, LDS_CTLO = 148480 + 8192 + 3072, LDS_BYTES = LDS_CTLO + 256;

DI unsigned pk2(float lo, float hi) { f32x2 v = {lo, hi}; bf16x2n r = __builtin_convertvector(v, bf16x2n); return __builtin_bit_cast(unsigned, r); }
DI unsigned pk4_fp8(float a, float b, float c, float d) { int r = __builtin_amdgcn_cvt_pk_fp8_f32(a, b, 0, false); r = __builtin_amdgcn_cvt_pk_fp8_f32(c, d, r, true); return (unsigned)r; }
DI f32x2 fp8_lo2(unsigned u) { return __builtin_amdgcn_cvt_pk_f32_fp8((int)u, false); }
DI f32x2 fp8_hi2(unsigned u) { return __builtin_amdgcn_cvt_pk_f32_fp8((int)u, true); }
DI float bf_lo(unsigned u) { return __builtin_bit_cast(float, u << 16); }
DI float bf_hi(unsigned u) { return __builtin_bit_cast(float, u & 0xffff0000u); }
DI float wave_sum(float v) {
#pragma unroll
    for (int o = 1; o < 64; o <<= 1) v += __shfl_xor(v, o);
    return v;
}
DI float fexp2(float x) { return __builtin_amdgcn_exp2f(x); }
DI float flog2(float x) { return __builtin_amdgcn_logf(x); }
DI float frcp(float x) { return __builtin_amdgcn_rcpf(x); }
DI float sigmoidf(float v) { return frcp(1.0f + fexp2(-v * LOG2E)); }
DI void lds_add(LAS int* p, int v) { (void)__hip_atomic_fetch_add(p, v, __ATOMIC_RELAXED, __HIP_MEMORY_SCOPE_WORKGROUP); }
#define LDS_WAIT() asm volatile("s_waitcnt lgkmcnt(0)" ::: "memory")
#define VM_WAIT() asm volatile("s_waitcnt vmcnt(0)" ::: "memory")
DI int fresh_tid() { int t = threadIdx.x; asm volatile("" : "+v"(t)); return t; }

#define XB_TMO      128
#define XB_XCNT(j)  (256  + 64 * (j))
#define XB_XSUB(j)  (1280 + 64 * (j))
#define XB_XGEN(j)  (2304 + 64 * (j))
#define XB_TOP      3328
#define XB_TOPGEN   3392
#define XCD_BAR_WORDS 3456
#define XB_SPIN_CAP (1u << 18)

__device__ __forceinline__ unsigned xb_ld(unsigned* p)              { return __hip_atomic_load(p, __ATOMIC_RELAXED, __HIP_MEMORY_SCOPE_AGENT); }
__device__ __forceinline__ unsigned xb_add(unsigned* p, unsigned v) { return __hip_atomic_fetch_add(p, v, __ATOMIC_RELAXED, __HIP_MEMORY_SCOPE_AGENT); }
__device__ __forceinline__ unsigned xb_xcc_id() { return (unsigned)__builtin_amdgcn_s_getreg((3 << 11) | 20) & 0xFu; }
#define XB_SPIN(cond, bar) do { unsigned _sp = 0; while (cond) { __builtin_amdgcn_s_sleep(1); \
    if ((++_sp & 255u) == 0u) { if (xb_ld(&(bar)[XB_TMO])) break; if (_sp > XB_SPIN_CAP) { atomicAdd(&(bar)[XB_TMO], 1u); break; } } } } while (0)

struct XcdBarrier {
    unsigned* bar; unsigned x;
    volatile LAS unsigned* st;
};
__device__ __forceinline__ XcdBarrier xcd_barrier_post(unsigned* bar, volatile LAS unsigned* st) {
    XcdBarrier b; b.bar = bar; b.x = xb_xcc_id(); b.st = st;
    if (threadIdx.x == 0) (void)xb_add(&bar[XB_XCNT(b.x)], 1u);
    return b;
}
__device__ __forceinline__ void xcd_barrier_complete(unsigned* bar, unsigned x, unsigned& nloc, unsigned& nx) {
    const unsigned G = gridDim.x * gridDim.y * gridDim.z;
    unsigned sum, cnt, mine, sp = 0u;
    for (;;) {
        sum = 0u; cnt = 0u; mine = 0u;
#pragma unroll
        for (unsigned j = 0; j < 16; ++j) { const unsigned c = xb_ld(&bar[XB_XCNT(j)]); sum += c; cnt += (c > 0u) ? 1u : 0u; mine = (j == x) ? c : mine; }
        if (sum == G) break;
        __builtin_amdgcn_s_sleep(1);
        if ((++sp & 255u) == 0u) { if (xb_ld(&bar[XB_TMO])) break; if (sp > XB_SPIN_CAP) { atomicAdd(&bar[XB_TMO], 1u); break; } }
    }
    nloc = mine > 0u ? mine : 1u; nx = cnt > 0u ? cnt : 1u;
}
__device__ __forceinline__ void xcd_barrier(const XcdBarrier& b) {
    asm volatile("s_waitcnt vmcnt(0)" ::: "memory");
    __syncthreads();
    if (threadIdx.x == 0) {
        unsigned* bar = b.bar;
        __builtin_amdgcn_s_waitcnt(0);
        unsigned nloc = b.st[0], nx = b.st[1];
        if (nloc == 0u) { xcd_barrier_complete(bar, b.x, nloc, nx); b.st[0] = nloc; b.st[1] = nx; }
        const unsigned old = xb_add(&bar[XB_XSUB(b.x)], 1u);
        const unsigned gen = old / nloc;
        if (old + 1u == (gen + 1u) * nloc) {
            __builtin_amdgcn_fence(__ATOMIC_RELEASE, "agent");
            asm volatile("s_waitcnt vmcnt(0)" ::: "memory");
            const unsigned og = xb_add(&bar[XB_TOP], 1u);
            const unsigned tg = og / nx;
            if (og + 1u == (tg + 1u) * nx) xb_add(&bar[XB_TOPGEN], 1u);
            else XB_SPIN(xb_ld(&bar[XB_TOPGEN]) == tg, bar);
            __builtin_amdgcn_fence(__ATOMIC_ACQUIRE, "agent");
            xb_add(&bar[XB_XGEN(b.x)], 1u);
            asm volatile("s_waitcnt vmcnt(0)" ::: "memory");
        } else {
            XB_SPIN(xb_ld(&bar[XB_XGEN(b.x)]) == gen, bar);
            __builtin_amdgcn_fence(__ATOMIC_ACQUIRE, "agent");
            asm volatile("s_waitcnt vmcnt(0)" ::: "memory");
        }
    }
    __syncthreads();
}

namespace pg8 {
constexpr int BM = 256, BK = 64, HALF = 128, HTB = HALF * BK * 2, STAGE_BYTES = 8 * HTB, NXCD = 8, WGM = 8;
__host__ __device__ __forceinline__ int lds_byte(int r, int c) { const int st = (r >> 4) * 2 + (c >> 5), rr = r & 15, cc = c & 31, ob = rr * 64 + cc * 2; return st * 1024 + (ob ^ (((ob >> 9) & 1) << 5)); }
__host__ __device__ __forceinline__ void stage_rc(int b, int& R, int& C) { const int st = b / 1024, sb = b % 1024, swz = sb ^ (((sb >> 9) & 1) << 5); R = (st >> 1) * 16 + swz / 64; C = (st & 1) * 32 + (swz % 64) / 2; }
__host__ __device__ __forceinline__ int perm32(int rho) { const int n = rho >> 4, i = rho & 15; return 8 * (i >> 2) + 4 * n + (i & 3); }

struct Unit { int pm, pn, aux; unsigned a, b; };
typedef int i32x4 __attribute__((ext_vector_type(4)));
__device__ __forceinline__ i32x8 frag8(bf16x8 lo, bf16x8 hi) { return __builtin_shufflevector(__builtin_bit_cast(i32x4, lo), __builtin_bit_cast(i32x4, hi), 0, 1, 2, 3, 4, 5, 6, 7); }

template <class Epi, class Sched, bool FP8 = false>
__device__ __forceinline__ void gemm_phase(LAS unsigned char* lds, const int K, const Sched& S, const Epi& E, const __amdgpu_buffer_rsrc_t rs) {
    const int tid = fresh_tid(), wid = __builtin_amdgcn_readfirstlane(tid >> 6), lane = tid & 63, wr = wid >> 2, wc = wid & 3, fr = lane & 15, fq = lane >> 4;
    const int nt = FP8 ? K / 128 : K / BK;
    int RA[2], CA[2];
    unsigned voffA[4], voffB[2];
#pragma unroll
    for (int i = 0; i < 2; ++i) { int R, C; stage_rc(tid * 16 + i * 8192, R, C); RA[i] = R; CA[i] = C; const int Rb = Epi::PERM ? ((R & ~31) + perm32(R & 31)) : R;
        voffB[i] = (unsigned)(Rb * S.pb + C * 2); }
    const unsigned kstep = (unsigned)(BK * 2);
    const unsigned hstepB = (unsigned)(HALF * S.pb), hstepA = (unsigned)(HALF * S.pa);
    const unsigned ldsw = (unsigned)wid * 1024u;
    const int aoff = lds_byte(wr * 64 + fr, fq * 8), boff = lds_byte(wc * 32 + fr, fq * 8);
    constexpr int kpiece = 1024;
#define PG8_SA(b, h) (((b) * 2 + (h)) * HTB)
#define PG8_SB(b, h) ((4 + (b) * 2 + (h)) * HTB)
#define PG8_STAGE_B(bufoff, gbase) do { _Pragma("unroll") for (int _i = 0; _i < 2; ++_i) \
        __builtin_amdgcn_raw_ptr_buffer_load_lds(rs, (LAS unsigned*)(lds + (bufoff) + ldsw + _i * 8192), 16, (int)voffB[_i], (int)(gbase), 0, 0); } while (0)
#define PG8_STAGE_A(bufoff, gbase, h) do { _Pragma("unroll") for (int _i = 0; _i < 2; ++_i) \
        __builtin_amdgcn_raw_ptr_buffer_load_lds(rs, (LAS unsigned*)(lds + (bufoff) + ldsw + _i * 8192), 16, (int)voffA[Sched::GATHER ? (h) * 2 + _i : _i], (int)((gbase) + (Sched::GATHER ? 0u : (unsigned)(h) * hstepA)), 0, 0); } while (0)
#define PG8_LDA(dst, b, h) do { _Pragma("unroll") for (int m = 0; m < 4; ++m) _Pragma("unroll") for (int k = 0; k < 2; ++k) dst[m][k] = *(const LAS bf16x8*)(lds + PG8_SA(b, h) + aoff + m * 2048 + k * kpiece); } while (0)
#define PG8_LDB(dst, b, h) do { _Pragma("unroll") for (int n = 0; n < 2; ++n) _Pragma("unroll") for (int k = 0; k < 2; ++k) dst[n][k] = *(const LAS bf16x8*)(lds + PG8_SB(b, h) + boff + n * 2048 + k * kpiece); } while (0)
#define PG8_MMA(ai, bj, At, Bt) do { __builtin_amdgcn_s_setprio(1); if constexpr (FP8) { _Pragma("unroll") for (int m = 0; m < 4; ++m) _Pragma("unroll") for (int n = 0; n < 2; ++n) \
        acc[ai][bj][m][n] = __builtin_amdgcn_mfma_scale_f32_16x16x128_f8f6f4(frag8(Bt[n][0], Bt[n][1]), frag8(At[m][0], At[m][1]), acc[ai][bj][m][n], 0, 0, 0, 0x7C7C7C7C, 0, 0x7C7C7C7C); } \
      else { _Pragma("unroll") for (int m = 0; m < 4; ++m) _Pragma("unroll") for (int n = 0; n < 2; ++n) _Pragma("unroll") for (int k = 0; k < 2; ++k) \
        acc[ai][bj][m][n] = __builtin_amdgcn_mfma_f32_16x16x32_bf16(Bt[n][k], At[m][k], acc[ai][bj][m][n], 0, 0, 0); } __builtin_amdgcn_s_setprio(0); } while (0)
#define PG8_MMA2(ai, At) do { if constexpr (Sched::BLOCKDIAG) { if (lo_half) PG8_MMA(ai, 0, At, B0); else PG8_MMA(ai, 1, At, B1); } else { PG8_MMA(ai, 0, At, B0); PG8_MMA(ai, 1, At, B1); } } while (0)
#define PG8_WAIT_V(n) asm volatile("s_waitcnt vmcnt(" #n ")" ::: "memory")
#define PG8_WAIT_L(n) asm volatile("s_waitcnt lgkmcnt(" #n ")" ::: "memory")
#define PG8_BAR __builtin_amdgcn_s_barrier()
#define PG8_SCHED __builtin_amdgcn_sched_barrier(0)
    Unit cur, nxt; int ui = 0;
    if (!S.next(0, cur)) return;
    S.offs(cur, RA, CA, voffA);
    f32x4 acc[2][2][4][2];
#pragma unroll
    for (int a = 0; a < 2; ++a)
#pragma unroll
        for (int b = 0; b < 2; ++b)
#pragma unroll
            for (int m = 0; m < 4; ++m)
#pragma unroll
                for (int n = 0; n < 2; ++n) acc[a][b][m][n] = (f32x4){0.f, 0.f, 0.f, 0.f};
    bf16x8 At[4][2], B0[2][2], B1[2][2];
    unsigned cA = cur.a, cB = cur.b;
    PG8_STAGE_B(PG8_SB(0, 0), cB); PG8_STAGE_B(PG8_SB(0, 1), cB + hstepB); PG8_STAGE_A(PG8_SA(0, 0), cA, 0); PG8_STAGE_A(PG8_SA(0, 1), cA, 1);
    if (wr == 1) PG8_BAR;
    PG8_WAIT_V(2); PG8_BAR;
    PG8_STAGE_B(PG8_SB(1, 0), cB + kstep); PG8_STAGE_A(PG8_SA(1, 0), cA + kstep, 0); PG8_STAGE_B(PG8_SB(1, 1), cB + hstepB + kstep);
    PG8_WAIT_V(6); PG8_BAR;
    for (;;) {
        const bool has_next = S.next(ui + 1, nxt);
        const unsigned nA = has_next ? nxt.a : cA, nB = has_next ? nxt.b : cB;
        unsigned nvoff[4];
        if constexpr (Sched::GATHER) { if (has_next) S.rows(nxt, RA, nvoff); }
#pragma nounroll
        for (int t = 0; t < nt; t += 2) {
            const bool last = (t == nt - 2), lo_half = t < (nt >> 1);
            const unsigned a1 = cA + (unsigned)(t + 1) * kstep;
            const unsigned a2 = last ? nA : cA + (unsigned)(t + 2) * kstep, b2 = last ? nB : cB + (unsigned)(t + 2) * kstep;
            const unsigned a3 = a2 + kstep, b3 = b2 + kstep;
            PG8_LDB(B0, 0, 0); PG8_LDB(B1, 0, 1); PG8_SCHED; PG8_LDA(At, 0, 0); PG8_STAGE_A(PG8_SA(1, 1), a1, 1);
            PG8_WAIT_V(8); PG8_WAIT_L(0); PG8_BAR; PG8_MMA2(0, At); PG8_BAR; PG8_SCHED;
            if constexpr (Sched::GATHER) { if (last && has_next) {
#pragma unroll
                for (int q = 0; q < 4; ++q) voffA[q] = nvoff[q] * (unsigned)S.pa + (unsigned)(CA[q & 1] * 2); } }
            PG8_LDA(At, 0, 1); PG8_STAGE_B(PG8_SB(0, 0), b2); PG8_STAGE_B(PG8_SB(0, 1), b2 + hstepB); PG8_STAGE_A(PG8_SA(0, 0), a2, 0);
            PG8_WAIT_V(8); PG8_WAIT_L(0); PG8_BAR; PG8_MMA2(1, At); PG8_BAR; PG8_SCHED;
            PG8_LDB(B0, 1, 0); PG8_LDB(B1, 1, 1); PG8_SCHED; PG8_LDA(At, 1, 0); PG8_STAGE_A(PG8_SA(0, 1), a2, 1);
            PG8_WAIT_V(8); PG8_WAIT_L(0); PG8_BAR; PG8_MMA2(0, At); PG8_BAR; PG8_SCHED;
            PG8_LDA(At, 1, 1); PG8_STAGE_B(PG8_SB(1, 0), b3); PG8_STAGE_B(PG8_SB(1, 1), b3 + hstepB); PG8_STAGE_A(PG8_SA(1, 0), a3, 0);
            PG8_WAIT_V(8); PG8_WAIT_L(0); PG8_BAR; PG8_MMA2(1, At); PG8_BAR; PG8_SCHED;
        }
        if (wr == 0) PG8_BAR;
        { const int t2 = fresh_tid() & 63; E(acc, cur, wr, wc, t2 & 15, t2 >> 4, lds + LDS_EPI); }
        if (!has_next) break;
#pragma unroll
        for (int a = 0; a < 2; ++a)
#pragma unroll
            for (int b = 0; b < 2; ++b)
#pragma unroll
                for (int m = 0; m < 4; ++m)
#pragma unroll
                    for (int n = 0; n < 2; ++n) acc[a][b][m][n] = (f32x4){0.f, 0.f, 0.f, 0.f};
        cur = nxt; cA = nA; cB = nB; ++ui;
        if (wr == 1) PG8_BAR;
    }
    PG8_WAIT_V(0);
    PG8_BAR;
#undef PG8_SA
#undef PG8_SB
#undef PG8_STAGE_A
#undef PG8_STAGE_B
#undef PG8_LDA
#undef PG8_LDB
#undef PG8_MMA
#undef PG8_MMA2
#undef PG8_WAIT_V
#undef PG8_WAIT_L
#undef PG8_BAR
#undef PG8_SCHED
}

struct DenseSched {
    static constexpr bool GATHER = false, BLOCKDIAG = false;
    int nM, nN, nwg, G, c; int pa, pb; unsigned A, B;
    __device__ void init(int M, int N, int G_, int c_, size_t A_, int pa_, size_t B_, int pb_) { nM = M / BM; nN = N / BM; nwg = nM * nN; G = G_; c = c_; A = (unsigned)A_; B = (unsigned)B_; pa = pa_; pb = pb_; }
    __device__ __forceinline__ bool next(int i, Unit& u) const {
        const long L = (long)i * G + c; if (L >= nwg) return false;
        int wgid = (int)L; { const int q = nwg / NXCD, r = nwg % NXCD, xcd = wgid % NXCD, off = wgid / NXCD; wgid = (xcd < r ? xcd * (q + 1) : r * (q + 1) + (xcd - r) * q) + off; }
        const int nig = WGM * nN, gid = wgid / nig, fm = gid * WGM, gsz = (nM - fm) < WGM ? (nM - fm) : WGM;
        u.pm = fm + ((wgid % nig) % gsz); u.pn = (wgid % nig) / gsz; u.aux = 0;
        u.a = A + (unsigned)(u.pm * BM * pa); u.b = B + (unsigned)(u.pn * BM * pb); return true;
    }
    __device__ __forceinline__ void offs(const Unit&, const int (&RA)[2], const int (&CA)[2], unsigned (&v)[4]) const {
#pragma unroll
        for (int h = 0; h < 2; ++h)
#pragma unroll
            for (int i = 0; i < 2; ++i) v[h * 2 + i] = (unsigned)((h * HALF + RA[i]) * pa + CA[i] * 2);
    }
};
struct DiagSched : DenseSched { static constexpr bool BLOCKDIAG = true; };
}

struct Params { const float* in[21]; float* out; unsigned char* ws; int ph_lo, ph_hi; };
enum { I_X = 0, I_C, I_POS, I_WADA, I_BADA, I_GMIX, I_GFFN, I_WIN, I_WBG, I_QG, I_KG, I_WBD, I_WBS, I_WOUT, I_WRG, I_BRG, I_WRE, I_BRE, I_WEG, I_WEU, I_WED };

struct Frame {
    LAS unsigned char* lds;
    unsigned char* ws;
    int wave, G, bid;
};

template <bool FP8>
DI void p0_transpose_item(const float* W, int N, void* WTv, int ldt, int k0, int n0, int row_base, LAS float* scr, int lane) {
#pragma unroll 8
    for (int i = 0; i < 32; ++i) { const int kk = 2 * i + (lane >> 5); scr[kk * 33 + (lane & 31)] = W[(size_t)(k0 + kk) * N + n0 + (lane & 31)]; }
    LDS_WAIT();
    const int c = lane & 7;
#pragma unroll
    for (int j = 0; j < 4; ++j) { const int n = (lane >> 3) + 8 * j; const LAS float* sp = scr + (8 * c) * 33 + n;
        if (FP8) { u32x2 o; o.x = pk4_fp8(64.f * sp[0 * 33], 64.f * sp[1 * 33], 64.f * sp[2 * 33], 64.f * sp[3 * 33]); o.y = pk4_fp8(64.f * sp[4 * 33], 64.f * sp[5 * 33], 64.f * sp[6 * 33], 64.f * sp[7 * 33]);
            *(u32x2*)((unsigned char*)WTv + (size_t)(row_base + n) * ldt + k0 + 8 * c) = o; }
        else { u32x4 o; o.x = pk2(sp[0 * 33], sp[1 * 33]); o.y = pk2(sp[2 * 33], sp[3 * 33]); o.z = pk2(sp[4 * 33], sp[5 * 33]); o.w = pk2(sp[6 * 33], sp[7 * 33]);
            *(u32x4*)((bf16_t*)WTv + (size_t)(row_base + n) * ldt + k0 + 8 * c) = o; } }
    LDS_WAIT();
}
DI void phase0(const Frame& F, const Params& p) {
    const int tid_ = fresh_tid(), lane_ = tid_ & 63;
    LAS float* scr = (LAS float*)(F.lds + F.wave * 16384);
    const int gw = F.bid * 8 + F.wave, NGW = F.G * 8;
    bf16_t* W1 = (bf16_t*)(F.ws + WS_W1); bf16_t* WB = (bf16_t*)(F.ws + WS_WB); bf16_t* WO = (bf16_t*)(F.ws + WS_WO);
    unsigned char* WG8 = F.ws + WS_WG8; unsigned char* WGU = F.ws + WS_WGU; unsigned char* WDN = F.ws + WS_WDN;
    constexpr int I1 = 16 * 96, I2 = 16 * 64, I3 = 4 * 32, I4 = 4 * 32, I5 = 16 * 32, I6 = 32 * 256, I7 = 32 * 256, I8 = 32 * 256;
    constexpr int NITEMS = I1 + I2 + I3 + I4 + I5 + I6 + I7 + I8;
    for (int it = gw; it < NITEMS; it += NGW) {
        int r = it;
        if (r < I1) { const int kb = r / 96, nb = r % 96; if (nb < 72) p0_transpose_item<true>(p.in[I_WIN], 3072, F.ws + WS_W1D8, 1024, 64 * kb, 32 * nb, 32 * nb, scr, lane_); else p0_transpose_item<false>(p.in[I_WIN], 3072, W1, 1024, 64 * kb, 32 * nb, 32 * nb, scr, lane_); continue; } r -= I1;
        if (r < I2) { const int kb = r / 64, nb = r % 64; p0_transpose_item<true>(p.in[I_WBG], 2048, WG8, 1024, 64 * kb, 32 * nb, 32 * nb, scr, lane_); continue; } r -= I2;
        if (r < I3) { const int kb = r / 32, nb = r % 32, n0 = 32 * nb; p0_transpose_item<true>(p.in[I_WBD], 1024, (unsigned char*)WB, 512, 64 * kb, n0, (n0 >> 7) * 256 + (n0 & 127), scr, lane_); continue; } r -= I3;
        if (r < I4) { const int kb = r / 32, nb = r % 32, n0 = 32 * nb; p0_transpose_item<true>(p.in[I_WBS], 1024, (unsigned char*)WB + 256, 512, 64 * kb, n0, (n0 >> 7) * 256 + 128 + (n0 & 127), scr, lane_); continue; } r -= I4;
        if (r < I5) { const int kb = r / 32, nb = r % 32; p0_transpose_item<true>(p.in[I_WOUT], 1024, WO, 1024, 64 * kb, 32 * nb, 32 * nb, scr, lane_); continue; } r -= I5;
        if (r < I6) { const int e = r >> 8, q = r & 255, kb = q >> 4, nb = q & 15, n0 = 32 * nb;
            p0_transpose_item<true>(p.in[I_WEG] + (size_t)e * 1024 * 512, 512, WGU + (size_t)e * 1024 * 1024, 1024, 64 * kb, n0, (n0 >> 7) * 256 + (n0 & 127), scr, lane_); continue; } r -= I6;
        if (r < I7) { const int e = r >> 8, q = r & 255, kb = q >> 4, nb = q & 15, n0 = 32 * nb;
            p0_transpose_item<true>(p.in[I_WEU] + (size_t)e * 1024 * 512, 512, WGU + (size_t)e * 1024 * 1024, 1024, 64 * kb, n0, (n0 >> 7) * 256 + 128 + (n0 & 127), scr, lane_); continue; } r -= I7;
        { const int e = r >> 8, q = r & 255, kb = q >> 5, nb = q & 31;
            p0_transpose_item<true>(p.in[I_WED] + (size_t)e * 512 * 1024, 1024, WDN + (size_t)e * 1024 * 512, 512, 64 * kb, 32 * nb, 32 * nb, scr, lane_); }
    }
    {
        unsigned char* WBz = F.ws + WS_WB;
        for (int idx = F.bid * 512 + tid_; idx < 2048 * 16; idx += F.G * 512) { const int row = idx >> 4, c = idx & 15; *(u32x4*)(WBz + (size_t)row * 512 + ((row & 128) ? 0 : 256) + c * 16) = (u32x4){0u, 0u, 0u, 0u}; }
    }
    {
        float* modp = (float*)(F.ws + WS_MODP); const float* c = p.in[I_C]; const float* wada = p.in[I_WADA];
        for (int task = gw; task < 96 * 8; task += NGW) {
            const int ct = task % 96, ks = task / 96, k0 = ks * 128;
#pragma unroll
            for (int i = 0; i < 16; ++i) { const int idx = i * 64 + lane_, b = idx >> 7, k = idx & 127; const float v = c[b * 1024 + k0 + k]; scr[idx] = v * sigmoidf(v); }
            LDS_WAIT();
            float acc[8];
#pragma unroll
            for (int b = 0; b < 8; ++b) acc[b] = 0.f;
            const float* wp = wada + (size_t)k0 * 6144 + ct * 64 + lane_;
#pragma unroll 8
            for (int k = 0; k < 128; ++k) { const float w = wp[(size_t)k * 6144];
#pragma unroll
                for (int b = 0; b < 8; ++b) acc[b] += scr[b * 128 + k] * w; }
#pragma unroll
            for (int b = 0; b < 8; ++b) modp[((size_t)ks * 8 + b) * 6144 + ct * 64 + lane_] = acc[b];
            LDS_WAIT();
        }
    }
}

DI float inv_freq_of(int i) {
    return i == 0 ? 1.0f : i == 1 ? 0.1939227432012558f : i == 2 ? 0.03760603070259094f : i == 3 ? 0.007292664609849453f : i == 4 ? 0.0014142135623842478f : i == 5 ? 0.00027424818836152554f : i == 6 ? 5.318296098266728e-05f : 1.0313386155758053e-05f;
}
template <int WHICH>
DI void phase_norm(const Frame& F, const Params& p) {
    const int tid_ = fresh_tid(), lane_ = tid_ & 63;
    LAS float* gs = (LAS float*)(F.lds); LAS float* sh = gs + 1024;
    const float* modp = (const float*)(F.ws + WS_MODP); float* mod = (float*)(F.ws + WS_MOD); const float* bada = p.in[I_BADA];
    const float* xin = p.in[I_X]; const bf16_t* upd = (const bf16_t*)(F.ws + WS_UPD1); bf16_t* hout = (bf16_t*)(F.ws + (WHICH == 0 ? WS_H : WS_H2)); unsigned* h8 = (unsigned*)(F.ws + (WHICH == 0 ? WS_H8 : WS_H28));
    const float* gn = p.in[WHICH == 0 ? I_GMIX : I_GFFN];
    for (int chunk = F.bid; chunk < T / 256; chunk += F.G) {
        const int b = chunk >> 5;
        __syncthreads();
        if (WHICH == 0) {
            if (tid_ < 192) { const int j = (chunk & 31) * 192 + tid_; float s = bada[j];
#pragma unroll
                for (int ks = 0; ks < 8; ++ks) s += modp[((size_t)ks * 8 + b) * 6144 + j];
                mod[b * 6144 + j] = s; }
            for (int col = tid_; col < 1024; col += 512) { float s1 = bada[col], s2 = bada[1024 + col];
#pragma unroll
                for (int ks = 0; ks < 8; ++ks) { s1 += modp[((size_t)ks * 8 + b) * 6144 + col]; s2 += modp[((size_t)ks * 8 + b) * 6144 + 1024 + col]; }
                gs[col] = gn[col] * (1.f + s2); sh[col] = s1; }
        } else {
            for (int col = tid_; col < 1024; col += 512) { gs[col] = gn[col] * (1.f + mod[b * 6144 + 4096 + col]); sh[col] = mod[b * 6144 + 3072 + col]; }
        }
        __syncthreads();
        f32x4 g4[4], s4[4];
#pragma unroll
        for (int j = 0; j < 4; ++j) { g4[j] = *(const LAS f32x4*)(gs + 256 * j + 4 * lane_); s4[j] = *(const LAS f32x4*)(sh + 256 * j + 4 * lane_); }
        for (int rr = F.wave; rr < 256; rr += 8) {
            const int row = chunk * 256 + rr;
            const f32x4* xr = (const f32x4*)(xin + (size_t)row * 1024) + lane_;
            f32x4 v[4]; float ss = 0.f;
#pragma unroll
            for (int j = 0; j < 4; ++j) v[j] = xr[64 * j];
            if (WHICH == 1) { const u32x2* ur = (const u32x2*)(upd + (size_t)row * 1024) + lane_; u32x2 uu[4];
#pragma unroll
                for (int j = 0; j < 4; ++j) uu[j] = ur[64 * j];
#pragma unroll
                for (int j = 0; j < 4; ++j) { v[j].x += bf_lo(uu[j].x); v[j].y += bf_hi(uu[j].x); v[j].z += bf_lo(uu[j].y); v[j].w += bf_hi(uu[j].y); } }
#pragma unroll
            for (int j = 0; j < 4; ++j) ss += (v[j].x * v[j].x + v[j].y * v[j].y) + (v[j].z * v[j].z + v[j].w * v[j].w);
            const float rinv = __builtin_amdgcn_rsqf(wave_sum(ss) * (1.f / 1024.f) + RMS_EPS);
            u32x2* o8 = (u32x2*)(hout + (size_t)row * 1024) + lane_;
#pragma unroll
            for (int j = 0; j < 4; ++j) { const f32x4 y = v[j] * rinv * g4[j] + s4[j]; u32x2 o; o.x = pk2(y.x, y.y); o.y = pk2(y.z, y.w); o8[64 * j] = o; h8[(size_t)row * 256 + 64 * j + lane_] = pk4_fp8(y.x, y.y, y.z, y.w); }
            if (WHICH == 0 && lane_ < 8) {
                const int pos = ((const int*)p.in[I_POS])[row];
                const float angf = (float)pos * inv_freq_of(lane_);
                double rv = (double)angf * 0.15915494309189535; rv -= __builtin_rint(rv);
                const float fr = (float)rv;
                bf16_t* rp = (bf16_t*)(F.ws + WS_ROPE) + (size_t)row * 16;
                rp[lane_] = (bf16_t)(pk2(__builtin_amdgcn_cosf(fr), 0.f) & 0xffffu); rp[8 + lane_] = (bf16_t)(pk2(__builtin_amdgcn_sinf(fr), 0.f) & 0xffffu);
            }
        }
    }
}

template <bool GATES> struct EpiProj {
    static constexpr bool PERM = true;
    bf16_t* proj; bf16_t* gates; const bf16_t* rope; const float* qg; const float* kg; int pn0;
    DI void operator()(const f32x4 (&acc)[2][2][4][2], const pg8::Unit& u, int wr, int wc, int fr, int fq, LAS unsigned char* scr) const {
        asm volatile("" : "+v"(fr), "+v"(fq));
        const int pn = u.pn + pn0, row0 = u.pm * 256 + wr * 64 + fr, cw = wc * 32 + 8 * fq;
        const int typ = pn < 9 ? pn / 3 : pn - 9, grp = pn < 9 ? pn % 3 : 0, l2d = pn < 9 ? 2 * grp : 0, hbase = pn < 9 ? grp * 4 : 12;
        if (GATES) {
            unsigned char* base = (unsigned char*)gates + pn * 256 + cw;
#pragma unroll
            for (int ai = 0; ai < 2; ++ai)
#pragma unroll
                for (int m = 0; m < 4; ++m) { unsigned char* rowp = base + (size_t)(row0 + ai * 128 + m * 16) * LDG;
#pragma unroll
                    for (int bj = 0; bj < 2; ++bj) { const f32x4 v0 = acc[ai][bj][m][0], v1 = acc[ai][bj][m][1];
                        u32x2 w; w.x = pk4_fp8(v0.x, v0.y, v0.z, v0.w); w.y = pk4_fp8(v1.x, v1.y, v1.z, v1.w);
                        *(u32x2*)(rowp + bj * 128) = w; } }
        } else if (pn >= 6) {
            const float sc = pn == 9 ? QSCALE : 1.f;
            const int dim0 = (wc & 1) * 32 + 8 * fq;
#pragma unroll
            for (int ai = 0; ai < 2; ++ai)
#pragma unroll
                for (int m = 0; m < 4; ++m) { const int t = row0 + ai * 128 + m * 16, sq = t & (S - 1); const int rp = (t & ~(S - 1)) + ((sq & ((1 << l2d) - 1)) << (13 - l2d)) + (sq >> l2d);
#pragma unroll
                    for (int bj = 0; bj < 2; ++bj) { const f32x4 v0 = acc[ai][bj][m][0] * sc, v1 = acc[ai][bj][m][1] * sc; const int head = hbase + 2 * bj + (wc >> 1);
                        u32x4 w; w.x = pk2(v0.x, v0.y); w.y = pk2(v0.z, v0.w); w.z = pk2(v1.x, v1.y); w.w = pk2(v1.z, v1.w);
                        *(u32x4*)(proj + ((size_t)(typ * 16 + head) * T + rp) * 64 + dim0) = w; } }
        } else {
            const bool isq = pn < 3; const float* g = isq ? qg : kg; const float sc = isq ? QSCALE : 1.f;
            LAS float* part = (LAS float*)scr;
            const int ch = (wc & 1) * 32 + 8 * fq;
            const f32x4 g0 = *(const f32x4*)(g + ch), g1 = *(const f32x4*)(g + ch + 4);
            const bool ropew = (wc & 1) == 0;
            u32x4 rcs[2][4][2];
            if (ropew) {
#pragma unroll
                for (int ai = 0; ai < 2; ++ai)
#pragma unroll
                    for (int m = 0; m < 4; ++m) { const u32x4* rpt = (const u32x4*)(rope + (size_t)(u.pm * 256 + ai * 128 + wr * 64 + m * 16 + fr) * 16); rcs[ai][m][0] = rpt[0]; rcs[ai][m][1] = rpt[1]; }
            }
#pragma unroll
            for (int ai = 0; ai < 2; ++ai)
#pragma unroll
                for (int m = 0; m < 4; ++m)
#pragma unroll
                    for (int bj = 0; bj < 2; ++bj) { const f32x4 a = acc[ai][bj][m][0], b = acc[ai][bj][m][1];
                        float ss = (a.x * a.x + a.y * a.y) + (a.z * a.z + a.w * a.w) + (b.x * b.x + b.y * b.y) + (b.z * b.z + b.w * b.w);
                        ss += __shfl_xor(ss, 16); ss += __shfl_xor(ss, 32);
                        if (fq == 0) part[((ai * 128 + wr * 64 + m * 16 + fr) * 2 + bj) * 4 + wc] = ss; }
            LDS_WAIT(); __builtin_amdgcn_s_barrier(); asm volatile("" ::: "memory");
#pragma unroll
            for (int ai = 0; ai < 2; ++ai)
#pragma unroll
                for (int m = 0; m < 4; ++m) { const int rl = ai * 128 + wr * 64 + m * 16 + fr, row = u.pm * 256 + rl, sq = row & (S - 1);
                    const int rp = (row & ~(S - 1)) + ((sq & ((1 << l2d) - 1)) << (13 - l2d)) + (sq >> l2d);
                    f32x4 c0 = {0, 0, 0, 0}, c1 = c0, s0 = c0, s1 = c0;
                    if (ropew) { const u32x4 cc = rcs[ai][m][0], sn = rcs[ai][m][1];
                        c0 = (f32x4){bf_lo(cc.x), bf_hi(cc.x), bf_lo(cc.y), bf_hi(cc.y)}; c1 = (f32x4){bf_lo(cc.z), bf_hi(cc.z), bf_lo(cc.w), bf_hi(cc.w)};
                        s0 = (f32x4){bf_lo(sn.x), bf_hi(sn.x), bf_lo(sn.y), bf_hi(sn.y)}; s1 = (f32x4){bf_lo(sn.z), bf_hi(sn.z), bf_lo(sn.w), bf_hi(sn.w)};
                        if (fq == 0) { s0 = -s0; s1 = -s1; } }
#pragma unroll
                    for (int bj = 0; bj < 2; ++bj) {
                        const float tot = part[(rl * 2 + bj) * 4 + wc] + part[(rl * 2 + bj) * 4 + (wc ^ 1)];
                        const float rinv = __builtin_amdgcn_rsqf(tot * (1.f / 64.f) + RMS_EPS);
                        f32x4 v0 = acc[ai][bj][m][0] * rinv * g0, v1 = acc[ai][bj][m][1] * rinv * g1;
                        if (ropew) {
                            f32x4 p0, p1;
                            p0.x = __shfl_xor(v0.x, 16); p0.y = __shfl_xor(v0.y, 16); p0.z = __shfl_xor(v0.z, 16); p0.w = __shfl_xor(v0.w, 16);
                            p1.x = __shfl_xor(v1.x, 16); p1.y = __shfl_xor(v1.y, 16); p1.z = __shfl_xor(v1.z, 16); p1.w = __shfl_xor(v1.w, 16);
                            if (fq < 2) { v0 = v0 * c0 + p0 * s0; v1 = v1 * c1 + p1 * s1; }
                        }
                        v0 = v0 * sc; v1 = v1 * sc; const int head = hbase + 2 * bj + (wc >> 1);
                        u32x4 w; w.x = pk2(v0.x, v0.y); w.y = pk2(v0.z, v0.w); w.z = pk2(v1.x, v1.y); w.w = pk2(v1.z, v1.w);
                        *(u32x4*)(proj + ((size_t)(typ * 16 + head) * T + rp) * 64 + ch) = w; } }
        }
    }
};

struct EpiBranch {
    static constexpr bool PERM = true;
    const unsigned char* gates; unsigned char* merged;
    DI void operator()(const f32x4 (&acc)[2][2][4][2], const pg8::Unit& u, int wr, int wc, int fr, int fq, LAS unsigned char*) const {
        asm volatile("" : "+v"(fr), "+v"(fq));
        const int row0 = u.pm * 256 + wr * 64 + fr, col0 = u.pn * 128 + wc * 32 + 8 * fq;
        u32x2 gd[2][4], gs[2][4];
#pragma unroll
        for (int ai = 0; ai < 2; ++ai)
#pragma unroll
            for (int m = 0; m < 4; ++m) { const size_t row = (size_t)(row0 + ai * 128 + m * 16);
                gd[ai][m] = *(const u32x2*)(gates + row * LDG + col0); gs[ai][m] = *(const u32x2*)(gates + row * LDG + 1024 + col0); }
        __builtin_amdgcn_sched_barrier(0);
#pragma unroll
        for (int ai = 0; ai < 2; ++ai)
#pragma unroll
            for (int m = 0; m < 4; ++m) { const size_t row = (size_t)(row0 + ai * 128 + m * 16);
                const u32x2 g = gd[ai][m], q = gs[ai][m];
                const f32x2 ga = fp8_lo2(g.x), gb = fp8_hi2(g.x), gc = fp8_lo2(g.y), gdd = fp8_hi2(g.y), qa = fp8_lo2(q.x), qb = fp8_hi2(q.x), qc = fp8_lo2(q.y), qd = fp8_hi2(q.y);
                const f32x4 v0 = acc[ai][0][m][0] * (f32x4){sigmoidf(ga.x), sigmoidf(ga.y), sigmoidf(gb.x), sigmoidf(gb.y)} + acc[ai][1][m][0] * (f32x4){sigmoidf(qa.x), sigmoidf(qa.y), sigmoidf(qb.x), sigmoidf(qb.y)};
                const f32x4 v1 = acc[ai][0][m][1] * (f32x4){sigmoidf(gc.x), sigmoidf(gc.y), sigmoidf(gdd.x), sigmoidf(gdd.y)} + acc[ai][1][m][1] * (f32x4){sigmoidf(qc.x), sigmoidf(qc.y), sigmoidf(qd.x), sigmoidf(qd.y)};
                u32x2 w; w.x = pk4_fp8(8.f * v0.x, 8.f * v0.y, 8.f * v0.z, 8.f * v0.w); w.y = pk4_fp8(8.f * v1.x, 8.f * v1.y, 8.f * v1.z, 8.f * v1.w);
                *(u32x2*)(merged + row * 1024 + col0) = w; }
    }
};
struct BranchSched {
    static constexpr bool GATHER = false;
    int G, c; int pa, pb; unsigned A, B;
    DI bool next(int i, pg8::Unit& u) const {
        const int tile = (i >> 1) * G + c; if (tile >= 256 * 4) return false;
        u.pm = tile >> 2; u.pn = tile & 3; u.aux = i & 1;
        u.a = A + (unsigned)(u.pm * 256 * LDO * 2 + u.aux * 256 * 2); u.b = B + (unsigned)(u.aux * 1024 * 256 * 2 + u.pn * 256 * 256 * 2); return true;
    }
    DI void offs(const pg8::Unit&, const int (&RA)[2], const int (&CA)[2], unsigned (&v)[4]) const {
#pragma unroll
        for (int h = 0; h < 2; ++h)
#pragma unroll
            for (int i = 0; i < 2; ++i) v[h * 2 + i] = (unsigned)((h * 128 + RA[i]) * pa + CA[i] * 2);
    }
};

struct EpiOut {
    static constexpr bool PERM = true;
    bf16_t* upd; const float* mod;
    DI void operator()(const f32x4 (&acc)[2][2][4][2], const pg8::Unit& u, int wr, int wc, int fr, int fq, LAS unsigned char*) const {
        asm volatile("" : "+v"(fr), "+v"(fq));
        const int row0 = u.pm * 256 + wr * 64 + fr, col0 = u.pn * 256 + wc * 32 + 8 * fq; const int b = (u.pm * 256) >> 13;
        f32x4 gv[2][2];
#pragma unroll
        for (int bj = 0; bj < 2; ++bj)
#pragma unroll
            for (int n = 0; n < 2; ++n) gv[bj][n] = *(const f32x4*)(mod + b * 6144 + 2048 + col0 + bj * 128 + n * 4) * 0.125f;
#pragma unroll
        for (int ai = 0; ai < 2; ++ai)
#pragma unroll
            for (int m = 0; m < 4; ++m)
#pragma unroll
                for (int bj = 0; bj < 2; ++bj) { const f32x4 v0 = acc[ai][bj][m][0] * gv[bj][0], v1 = acc[ai][bj][m][1] * gv[bj][1];
                    u32x4 w; w.x = pk2(v0.x, v0.y); w.y = pk2(v0.z, v0.w); w.z = pk2(v1.x, v1.y); w.w = pk2(v1.z, v1.w);
                    *(u32x4*)(upd + (size_t)(row0 + ai * 128 + m * 16) * 1024 + col0 + bj * 128) = w; }
    }
};

struct EpiLogit {
    static constexpr bool PERM = false;
    float* logit;
    DI void operator()(const f32x4 (&acc)[2][2][4][2], const pg8::Unit& u, int wr, int wc, int fr, int fq, LAS unsigned char*) const {
        asm volatile("" : "+v"(fr), "+v"(fq));
        const int row0 = u.pm * 256 + wr * 64 + fr, col0 = wc * 32 + 4 * fq;
#pragma unroll
        for (int ai = 0; ai < 2; ++ai)
#pragma unroll
            for (int m = 0; m < 4; ++m)
#pragma unroll
                for (int n = 0; n < 2; ++n) *(f32x4*)(logit + (size_t)(row0 + ai * 128 + m * 16) * 128 + col0 + n * 16) = acc[ai][0][m][n];
    }
};

struct MoeSched {
    static constexpr bool GATHER_ = true;
    int G, c, nc; int pa, pb; unsigned A, B; const LAS int* cstart; const int* slot_tok; unsigned estride, pnstride;
};
struct MoeSchedUp : MoeSched {
    static constexpr bool GATHER = true, BLOCKDIAG = false;
    DI bool next(int i, pg8::Unit& u) const {
        const int L = i * G + c; if (L >= nc * 4) return false;
        const int chunk = L >> 2; int e = 0;
        for (int q = 1; q < 32; ++q) e += (chunk >= cstart[q]) ? 1 : 0;
        e = __builtin_amdgcn_readfirstlane(e);
        u.pm = chunk; u.pn = L & 3; u.aux = e; u.a = A; u.b = B + (unsigned)e * estride + (unsigned)u.pn * pnstride; return true;
    }
    DI void offs(const pg8::Unit& u, const int (&RA)[2], const int (&CA)[2], unsigned (&v)[4]) const {
#pragma unroll
        for (int h = 0; h < 2; ++h)
#pragma unroll
            for (int i = 0; i < 2; ++i) { const int tok = slot_tok[u.pm * 256 + h * 128 + RA[i]]; v[h * 2 + i] = (unsigned)(tok * pa + CA[i] * 2); }
    }
    DI void rows(const pg8::Unit& u, const int (&RA)[2], unsigned (&v)[4]) const {
#pragma unroll
        for (int h = 0; h < 2; ++h)
#pragma unroll
            for (int i = 0; i < 2; ++i) v[h * 2 + i] = (unsigned)slot_tok[u.pm * 256 + h * 128 + RA[i]];
    }
};
struct MoeSchedDn : MoeSched {
    static constexpr bool GATHER = false, BLOCKDIAG = false;
    DI bool next(int i, pg8::Unit& u) const {
        const int L = i * G + c; if (L >= nc * 4) return false;
        const int chunk = L >> 2; int e = 0;
        for (int q = 1; q < 32; ++q) e += (chunk >= cstart[q]) ? 1 : 0;
        e = __builtin_amdgcn_readfirstlane(e);
        u.pm = chunk; u.pn = L & 3; u.aux = e; u.a = A + (unsigned)(chunk * 256 * pa); u.b = B + (unsigned)e * estride + (unsigned)u.pn * pnstride; return true;
    }
    DI void offs(const pg8::Unit&, const int (&RA)[2], const int (&CA)[2], unsigned (&v)[4]) const {
#pragma unroll
        for (int h = 0; h < 2; ++h)
#pragma unroll
            for (int i = 0; i < 2; ++i) v[h * 2 + i] = (unsigned)((h * 128 + RA[i]) * pa + CA[i] * 2);
    }
};
struct EpiSwiglu {
    static constexpr bool PERM = true;
    unsigned char* hmid;
    DI void operator()(const f32x4 (&acc)[2][2][4][2], const pg8::Unit& u, int wr, int wc, int fr, int fq, LAS unsigned char*) const {
        asm volatile("" : "+v"(fr), "+v"(fq));
        const int row0 = u.pm * 256 + wr * 64 + fr, col0 = u.pn * 128 + wc * 32 + 8 * fq;
#pragma unroll
        for (int ai = 0; ai < 2; ++ai)
#pragma unroll
            for (int m = 0; m < 4; ++m) {
                f32x4 h[2];
#pragma unroll
                for (int n = 0; n < 2; ++n) { const f32x4 g = acc[ai][0][m][n], up = acc[ai][1][m][n];
                    h[n] = (f32x4){g.x * sigmoidf(g.x) * up.x, g.y * sigmoidf(g.y) * up.y, g.z * sigmoidf(g.z) * up.z, g.w * sigmoidf(g.w) * up.w}; }
                u32x2 w; w.x = pk4_fp8(h[0].x, h[0].y, h[0].z, h[0].w); w.y = pk4_fp8(h[1].x, h[1].y, h[1].z, h[1].w);
                *(u32x2*)(hmid + (size_t)(row0 + ai * 128 + m * 16) * DE + col0) = w; }
    }
};
struct EpiDown {
    static constexpr bool PERM = true;
    unsigned char* y;
    DI void operator()(const f32x4 (&acc)[2][2][4][2], const pg8::Unit& u, int wr, int wc, int fr, int fq, LAS unsigned char*) const {
        asm volatile("" : "+v"(fr), "+v"(fq));
        const int row0 = u.pm * 256 + wr * 64 + fr, col0 = u.pn * 256 + wc * 32 + 8 * fq;
#pragma unroll
        for (int ai = 0; ai < 2; ++ai)
#pragma unroll
            for (int m = 0; m < 4; ++m) { const int slot = row0 + ai * 128 + m * 16;
#pragma unroll
                for (int bj = 0; bj < 2; ++bj) { const f32x4 v0 = acc[ai][bj][m][0] * 8.f, v1 = acc[ai][bj][m][1] * 8.f;
                    u32x2 o; o.x = pk4_fp8(v0.x, v0.y, v0.z, v0.w); o.y = pk4_fp8(v1.x, v1.y, v1.z, v1.w);
                    *(u32x2*)(y + (size_t)slot * 1024 + col0 + bj * 128) = o; } }
    }
};

constexpr int SLOT_BYTES = 8192;
DI f32x16 mfma32(bf16x8 a, bf16x8 b, f32x16 c) { return __builtin_amdgcn_mfma_f32_32x32x16_bf16(a, b, c, 0, 0, 0); }
DI int swz_f(int r) { return (((r >> 1) & 1) << 2) | ((r >> 2) & 3); }
struct AttnLane { unsigned doff[4]; unsigned ka[4]; unsigned va[2][2]; };
DI void attn_lane_init(AttnLane& L, int lane) {
#pragma unroll
    for (int i = 0; i < 4; ++i) { const int r = 8 * i + (lane >> 3), c = (lane & 7) ^ swz_f(r); L.doff[i] = (unsigned)(r * 128 + c * 16); }
    { const int r = lane & 31, h = lane >> 5; const unsigned a0 = (unsigned)(r * 128 + 16 * ((h ^ swz_f(r)) & 7));
#pragma unroll
      for (int s = 0; s < 4; ++s) L.ka[s] = a0 ^ (unsigned)(32 * s); }
    { const int h = lane >> 5, blk = (lane >> 4) & 1, q = (lane & 15) >> 2, p = lane & 3, fb2 = (q >> 1) & 1;
#pragma unroll
      for (int t = 0; t < 2; ++t) { const int flow = (2 * t + h) & 3;
#pragma unroll
        for (int mt = 0; mt < 2; ++mt) L.va[t][mt] = (unsigned)(4096 + (8 * t + 4 * h + q) * 128 + 16 * (4 * (mt ^ fb2) + ((2 * blk + (p >> 1)) ^ flow)) + 8 * (p & 1)); } }
}
DI void dma_tile(const AttnLane& L, const __amdgpu_buffer_rsrc_t rs, unsigned koff, unsigned voff, LAS unsigned char* slot) {
#pragma unroll
    for (int i = 0; i < 4; ++i) __builtin_amdgcn_raw_ptr_buffer_load_lds(rs, (LAS unsigned*)(slot + 1024 * i), 16, (int)L.doff[i], (int)koff, 0, 0);
#pragma unroll
    for (int i = 0; i < 4; ++i) __builtin_amdgcn_raw_ptr_buffer_load_lds(rs, (LAS unsigned*)(slot + 4096 + 1024 * i), 16, (int)L.doff[i], (int)voff, 0, 0);
}
DI void tr_read8(const AttnLane& L, unsigned sb, bf16x8 (&vf)[2][2]) {
    s16x4 r0, r1, r2, r3, r4, r5, r6, r7;
    const unsigned a00 = sb + L.va[0][0], a10 = sb + L.va[1][0], a01 = sb + L.va[0][1], a11 = sb + L.va[1][1];
    asm volatile("ds_read_b64_tr_b16 %0, %8\n\tds_read_b64_tr_b16 %1, %9\n\tds_read_b64_tr_b16 %2, %8 offset:2048\n\tds_read_b64_tr_b16 %3, %9 offset:2048\n\t"
                 "ds_read_b64_tr_b16 %4, %10\n\tds_read_b64_tr_b16 %5, %11\n\tds_read_b64_tr_b16 %6, %10 offset:2048\n\tds_read_b64_tr_b16 %7, %11 offset:2048\n\ts_waitcnt lgkmcnt(0)"
                 : "=&v"(r0), "=&v"(r1), "=&v"(r2), "=&v"(r3), "=&v"(r4), "=&v"(r5), "=&v"(r6), "=&v"(r7)
                 : "v"(a00), "v"(a10), "v"(a01), "v"(a11) : "memory");
    vf[0][0] = __builtin_shufflevector(r0, r1, 0, 1, 2, 3, 4, 5, 6, 7); vf[0][1] = __builtin_shufflevector(r2, r3, 0, 1, 2, 3, 4, 5, 6, 7);
    vf[1][0] = __builtin_shufflevector(r4, r5, 0, 1, 2, 3, 4, 5, 6, 7); vf[1][1] = __builtin_shufflevector(r6, r7, 0, 1, 2, 3, 4, 5, 6, 7);
}
DI bf16x8 pack8(const f32x16& x, int s) {
    u32x4 p; p.x = pk2(x[8 * s], x[8 * s + 1]); p.y = pk2(x[8 * s + 2], x[8 * s + 3]); p.z = pk2(x[8 * s + 4], x[8 * s + 5]); p.w = pk2(x[8 * s + 6], x[8 * s + 7]);
    return __builtin_bit_cast(bf16x8, p);
}
DI void store_o_row(bf16_t* rowp, const f32x16& O0, const f32x16& O1, float sc, int h) {
#pragma unroll
    for (int mt = 0; mt < 2; ++mt)
#pragma unroll
        for (int kp = 0; kp < 2; ++kp) { const f32x16& O = mt ? O1 : O0; const int g0 = 8 * kp, g1 = 8 * kp + 4;
            u32x2 a, b; a.x = pk2(O[g0] * sc, O[g0 + 1] * sc); a.y = pk2(O[g0 + 2] * sc, O[g0 + 3] * sc); b.x = pk2(O[g1] * sc, O[g1 + 1] * sc); b.y = pk2(O[g1 + 2] * sc, O[g1 + 3] * sc);
            { auto r = __builtin_amdgcn_permlane32_swap(a.x, b.x, false, false); a.x = r[0]; b.x = r[1]; }
            { auto r = __builtin_amdgcn_permlane32_swap(a.y, b.y, false, false); a.y = r[0]; b.y = r[1]; }
            *(u32x4*)(rowp + 32 * mt + 16 * kp + 8 * h) = (u32x4){a.x, a.y, b.x, b.y}; }
}
DI void store_o_row_fp8(unsigned char* rowp, const f32x16& O0, const f32x16& O1, int h) {
#pragma unroll
    for (int mt = 0; mt < 2; ++mt)
#pragma unroll
        for (int kp = 0; kp < 2; ++kp) { const f32x16& O = mt ? O1 : O0; const int g0 = 8 * kp, g1 = 8 * kp + 4;
            unsigned a = pk4_fp8(O[g0], O[g0 + 1], O[g0 + 2], O[g0 + 3]), b = pk4_fp8(O[g1], O[g1 + 1], O[g1 + 2], O[g1 + 3]);
            { auto r = __builtin_amdgcn_permlane32_swap(a, b, false, false); a = r[0]; b = r[1]; }
            *(u32x2*)(rowp + 32 * mt + 16 * kp + 8 * h) = (u32x2){a, b}; }
}
#define ATTN_WAIT_TILE(more) do { if (more) asm volatile("s_waitcnt vmcnt(8)" ::: "memory"); else asm volatile("s_waitcnt vmcnt(0)" ::: "memory"); } while (0)
DI void dil_tile(const AttnLane& L, const __amdgpu_buffer_rsrc_t rs, const bf16_t* hb, int hd, long row0, int j, LAS unsigned char* ldsW, bf16_t* og, float* lse, int lane) {
    const int qi = lane & 31, h = lane >> 5;
    const bf16_t* qh = hb + (size_t)hd * T * 64;
    const unsigned kh = (unsigned)(WS_PROJ + ((size_t)(16 + hd) * T + row0) * 128), vh = (unsigned)(WS_PROJ + ((size_t)(32 + hd) * T + row0) * 128);
    bf16x8 qf[4];
    { const bf16_t* qp = qh + (size_t)(row0 + 32 * j + qi) * 64 + 8 * h;
#pragma unroll
      for (int s = 0; s < 4; ++s) qf[s] = *(const bf16x8*)(qp + 16 * s); }
    float mrun = -INFINITY, lrun = 0.f;
    f32x16 O0, O1;
#pragma unroll
    for (int i = 0; i < 16; ++i) { O0[i] = 0.f; O1[i] = 0.f; }
    const int kt0 = j >= 4 ? j - 4 : 0;
    dma_tile(L, rs, kh + (unsigned)(4096 * kt0), vh + (unsigned)(4096 * kt0), ldsW);
    unsigned buf = 0;
    for (int kt = kt0; kt <= j; ++kt) {
        const bool more = kt < j;
        if (more) dma_tile(L, rs, kh + (unsigned)(4096 * (kt + 1)), vh + (unsigned)(4096 * (kt + 1)), ldsW + (buf ^ 1u) * SLOT_BYTES);
        ATTN_WAIT_TILE(more);
        LAS unsigned char* slot = ldsW + buf * SLOT_BYTES;
        f32x16 sc;
#pragma unroll
        for (int i = 0; i < 16; ++i) sc[i] = 0.f;
#pragma unroll
        for (int s = 0; s < 4; ++s) { const bf16x8 kf = *(const LAS bf16x8*)(slot + L.ka[s]); sc = mfma32(kf, qf[s], sc); }
        if (kt == j) {
#pragma unroll
            for (int i = 0; i < 16; ++i) { const int key = (i & 3) + 8 * (i >> 2) + 4 * h; if (key > qi) sc[i] = -INFINITY; }
        }
        if (kt == j - 4) {
#pragma unroll
            for (int i = 0; i < 16; ++i) { const int key = (i & 3) + 8 * (i >> 2) + 4 * h; if (key < qi) sc[i] = -INFINITY; }
        }
        float mx = sc[0];
#pragma unroll
        for (int i = 1; i < 16; ++i) mx = fmaxf(mx, sc[i]);
        mx = fmaxf(mx, __shfl_xor(mx, 32));
        const float mnew = fmaxf(mrun, mx), alpha = fexp2(mrun - mnew);
        float ps = 0.f;
#pragma unroll
        for (int i = 0; i < 16; ++i) { sc[i] = fexp2(sc[i] - mnew); ps += sc[i]; }
        lrun = lrun * alpha + ps; mrun = mnew;
#pragma unroll
        for (int i = 0; i < 16; ++i) { O0[i] *= alpha; O1[i] *= alpha; }
        const bf16x8 p0 = pack8(sc, 0), p1 = pack8(sc, 1);
        bf16x8 vf[2][2]; tr_read8(L, (unsigned)(size_t)slot, vf);
        O0 = mfma32(vf[0][0], p0, O0); O0 = mfma32(vf[0][1], p1, O0);
        O1 = mfma32(vf[1][0], p0, O1); O1 = mfma32(vf[1][1], p1, O1);
        buf ^= 1u;
    }
    const float ltot = lrun + __shfl_xor(lrun, 32), inv = frcp(ltot);
    const size_t row = (size_t)(row0 + 32 * j + qi);
    store_o_row(og + row * 64, O0, O1, inv, h);
    if (h == 0) lse[row] = mrun + flog2(ltot);
}
DI void sb_tile(const AttnLane& L, const __amdgpu_buffer_rsrc_t rs, const bf16_t* hb, int b, int h4, int j, LAS unsigned char* ldsW, unsigned char* ocat, int lane) {
    const int qi = lane & 31, h = lane >> 5;
    const long base = (long)b * S;
    const bf16_t* qh = hb + (size_t)(12 + h4) * T * 64;
    const unsigned kh = (unsigned)(WS_PROJ + ((size_t)(16 + 12 + h4) * T + base) * 128), vh = (unsigned)(WS_PROJ + ((size_t)(32 + 12 + h4) * T + base) * 128);
    bf16x8 qf[4];
    { const bf16_t* qp = qh + (size_t)(base + 32 * j + qi) * 64 + 8 * h;
#pragma unroll
      for (int s = 0; s < 4; ++s) qf[s] = *(const bf16x8*)(qp + 16 * s); }
    float carry = 0.f;
    f32x16 O0, O1;
#pragma unroll
    for (int i = 0; i < 16; ++i) { O0[i] = 0.f; O1[i] = 0.f; }
    dma_tile(L, rs, kh + (unsigned)(4096 * j), vh + (unsigned)(4096 * j), ldsW);
    unsigned buf = 0;
    for (int kt = j; kt >= 0; --kt) {
        const bool more = kt > 0;
        if (more) dma_tile(L, rs, kh + (unsigned)(4096 * (kt - 1)), vh + (unsigned)(4096 * (kt - 1)), ldsW + (buf ^ 1u) * SLOT_BYTES);
        ATTN_WAIT_TILE(more);
        LAS unsigned char* slot = ldsW + buf * SLOT_BYTES;
        f32x16 z;
#pragma unroll
        for (int i = 0; i < 16; ++i) z[i] = 0.f;
#pragma unroll
        for (int s = 0; s < 4; ++s) { const bf16x8 kf = *(const LAS bf16x8*)(slot + L.ka[s]); z = mfma32(kf, qf[s], z); }
#pragma unroll
        for (int i = 0; i < 16; ++i) z[i] = fexp2(fminf(z[i], 31.f));
        if (kt == j) {
#pragma unroll
            for (int i = 0; i < 16; ++i) { const int key = (i & 3) + 8 * (i >> 2) + 4 * h; if (key >= qi) z[i] = 0.f; }
        }
        float lg[4], par[4], u0[4], p01[4], p012[4];
#pragma unroll
        for (int g = 0; g < 4; ++g) { const float a0 = 1.f + z[4 * g], a1 = 1.f + z[4 * g + 1], a2 = 1.f + z[4 * g + 2], a3 = 1.f + z[4 * g + 3];
            u0[g] = a0; p01[g] = a0 * a1; p012[g] = p01[g] * a2; lg[g] = -flog2(p012[g] * a3); }
#pragma unroll
        for (int g = 0; g < 4; ++g) par[g] = __shfl_xor(lg[g], 32);
        float tg[4]; tg[3] = carry; tg[2] = tg[3] + (lg[3] + par[3]); tg[1] = tg[2] + (lg[2] + par[2]); tg[0] = tg[1] + (lg[1] + par[1]);
        carry = tg[0] + (lg[0] + par[0]);
#pragma unroll
        for (int g = 0; g < 4; ++g) { const float suf = tg[g] + lg[g] + (h == 0 ? par[g] : 0.f); const float y = fexp2(suf);
            z[4 * g] = z[4 * g] * y; z[4 * g + 1] = z[4 * g + 1] * (y * u0[g]); z[4 * g + 2] = z[4 * g + 2] * (y * p01[g]); z[4 * g + 3] = z[4 * g + 3] * (y * p012[g]); }
        const bf16x8 p0 = pack8(z, 0), p1 = pack8(z, 1);
        bf16x8 vf[2][2]; tr_read8(L, (unsigned)(size_t)slot, vf);
        O0 = mfma32(vf[0][0], p0, O0); O0 = mfma32(vf[0][1], p1, O0);
        O1 = mfma32(vf[1][0], p0, O1); O1 = mfma32(vf[1][1], p1, O1);
        if (__all(carry < -40.f)) break;
        buf ^= 1u;
    }
    store_o_row_fp8(ocat + (size_t)(base + 32 * j + qi) * LDO + 256 + h4 * 64, O0, O1, h);
}
DI void phase_attn(const Frame& F, const Params& p) {
    const int tid_ = fresh_tid(), lane_ = tid_ & 63;
    const bf16_t* hb = (const bf16_t*)(F.ws + WS_PROJ); unsigned char* ocat = F.ws + WS_OCAT;
    bf16_t* og = (bf16_t*)(F.ws + WS_OG); float* lse = (float*)(F.ws + WS_LSE);
    LAS unsigned char* ldsW = F.lds + F.wave * (2 * SLOT_BYTES);
    AttnLane L; attn_lane_init(L, lane_);
    const __amdgpu_buffer_rsrc_t rs = __builtin_amdgcn_make_buffer_rsrc(F.ws, 0, (int)WS_END, 0x00020000);
    const int NU = NB * 4 * 16;
    for (int i = 0;; ++i) {
        const int u = (F.G == 256) ? ((F.bid & 7) * 32 + (F.bid >> 3) + 256 * i) : (F.bid + F.G * i);
        if (u >= NU) break;
        const int qb = u & 15, hs = (u >> 4) & 3, b = u >> 6, t0 = qb * 512;
        for (int w = F.wave; w < 16; w += 8) sb_tile(L, rs, hb, b, hs, t0 / 32 + w, ldsW, ocat, lane_);
        for (int w = F.wave; w < 48; w += 8) {
            const int g = w >> 4, ti = w & 15, l2d = 2 * g, per = 16 >> l2d, r = ti / per, jj = ti % per;
            dil_tile(L, rs, hb, g * 4 + hs, (long)b * S + (long)r * (S >> l2d), ((t0 >> l2d) >> 5) + jj, ldsW, og + (size_t)(g * 4 + hs) * T * 64, lse + (size_t)(g * 4 + hs) * T, lane_);
        }
        VM_WAIT();
        __syncthreads();
        {
            const int piece = tid_ & 7; const size_t bb = (size_t)b * S;
#pragma unroll 2
            for (int pass = 0; pass < 8; ++pass) {
                const int sq = t0 + pass * 64 + (tid_ >> 3);
                const size_t r0 = bb + sq, r1 = bb + ((size_t)(sq & 3) << 11) + (sq >> 2), r2 = bb + ((size_t)(sq & 15) << 9) + (sq >> 4);
                const float l0 = lse[(size_t)(0 + hs) * T + r0], l1 = lse[(size_t)(4 + hs) * T + r1], l2 = lse[(size_t)(8 + hs) * T + r2];
                const u32x4 x = *((const u32x4*)(og + ((size_t)(0 + hs) * T + r0) * 64) + piece), y = *((const u32x4*)(og + ((size_t)(4 + hs) * T + r1) * 64) + piece), z = *((const u32x4*)(og + ((size_t)(8 + hs) * T + r2) * 64) + piece);
                const float mx = fmaxf(l0, fmaxf(l1, l2)); float w0 = fexp2(l0 - mx), w1 = fexp2(l1 - mx), w2 = fexp2(l2 - mx); const float inv = frcp(w0 + w1 + w2); w0 *= inv; w1 *= inv; w2 *= inv;
                u32x2 r;
                r.x = pk4_fp8(w0 * bf_lo(x.x) + w1 * bf_lo(y.x) + w2 * bf_lo(z.x), w0 * bf_hi(x.x) + w1 * bf_hi(y.x) + w2 * bf_hi(z.x), w0 * bf_lo(x.y) + w1 * bf_lo(y.y) + w2 * bf_lo(z.y), w0 * bf_hi(x.y) + w1 * bf_hi(y.y) + w2 * bf_hi(z.y));
                r.y = pk4_fp8(w0 * bf_lo(x.z) + w1 * bf_lo(y.z) + w2 * bf_lo(z.z), w0 * bf_hi(x.z) + w1 * bf_hi(y.z) + w2 * bf_hi(z.z), w0 * bf_lo(x.w) + w1 * bf_lo(y.w) + w2 * bf_lo(z.w), w0 * bf_hi(x.w) + w1 * bf_hi(y.w) + w2 * bf_hi(z.w));
                *((u32x2*)(ocat + (bb + sq) * LDO + hs * 64) + piece) = r;
            }
        }
        __syncthreads();
    }
}

DI void route_rows(const Frame& F, const Params& p, int pm) {
    const int tid_ = fresh_tid(), lane_ = tid_ & 63;
    LAS int* hist = (LAS int*)(F.lds);
    const int ftid = fresh_tid();
    __syncthreads();
    if (ftid < 32) hist[ftid] = 0;
    __syncthreads();
    if (tid_ < 256) {
        const int row = pm * 256 + tid_; const float* L = (const float*)(F.ws + WS_LOGIT) + (size_t)row * 128;
        const float* brg = p.in[I_BRG]; const float* bre = p.in[I_BRE];
        float lgp[4];
#pragma unroll
        for (int c = 0; c < 4; ++c) lgp[c] = L[c] + L[36 + c] + brg[c];
        int gsel = 0; float gm = lgp[0];
#pragma unroll
        for (int c = 1; c < 4; ++c) if (lgp[c] > gm) { gm = lgp[c]; gsel = c; }
        float zs = 0.f;
#pragma unroll
        for (int c = 0; c < 4; ++c) zs += fexp2((lgp[c] - gm) * LOG2E);
        const float pg = frcp(zs);
        float l1 = -INFINITY, l2 = -INFINITY; int e1 = 0, e2 = 0;
#pragma unroll
        for (int i = 0; i < 8; ++i) { const int c = 4 + gsel * 8 + i; const float v = L[c] + L[36 + c] + bre[gsel * 8 + i];
            if (v > l1) { l2 = l1; e2 = e1; l1 = v; e1 = i; } else if (v > l2) { l2 = v; e2 = i; } }
        const float ex = fexp2((l2 - l1) * LOG2E), den = frcp(1.f + ex);
        int* te = (int*)(F.ws + WS_TOKE) + (size_t)row * 2; float* tw = (float*)(F.ws + WS_TOKW) + (size_t)row * 2;
        te[0] = gsel * 8 + e1; te[1] = gsel * 8 + e2; tw[0] = pg * den; tw[1] = pg * ex * den;
        lds_add(&hist[gsel * 8 + e1], 1); lds_add(&hist[gsel * 8 + e2], 1);
    }
    __syncthreads();
    if (ftid < 32) ((int*)(F.ws + WS_HIST))[pm * 32 + ftid] = hist[ftid];
}


DI void router_weights_to_lds(const Frame& F, const Params& p) {
    const int tid_ = fresh_tid(), lane_ = tid_ & 63;
    constexpr int WP = 1028;
    LAS float* wt = (LAS float*)(F.lds + LDS_RW); LAS float* bias = (LAS float*)(F.lds + LDS_RS) + 8 * 80 + 32;
    const float* wrg = p.in[I_WRG]; const float* wre = p.in[I_WRE]; const float* brg = p.in[I_BRG]; const float* bre = p.in[I_BRE];
    const int ftid = fresh_tid();
    __syncthreads();
#pragma unroll 8
    for (int i = ftid; i < 1024 * 32; i += 512) wt[(4 + (i & 31)) * WP + (i >> 5)] = wre[i];
#pragma unroll 8
    for (int i = ftid; i < 1024 * 4; i += 512) wt[(i & 3) * WP + (i >> 2)] = wrg[i];
    if (ftid < 36) bias[ftid] = ftid < 4 ? brg[ftid] : bre[ftid - 4];
}

DI void phase_norm2_route(const Frame& F, const Params& p) {
    const int tid_ = fresh_tid(), lane_ = tid_ & 63;
    constexpr int WP = 1028;
    LAS float* wt = (LAS float*)(F.lds + LDS_RW);
    LAS float* gs = (LAS float*)(F.lds + LDS_RV); LAS float* sh = gs + 1024;
    LAS float* scr = (LAS float*)(F.lds + LDS_RS) + F.wave * 80;
    LAS int* hist = (LAS int*)(F.lds + LDS_RS) + 8 * 80;
    LAS float* bias = (LAS float*)(F.lds + LDS_RS) + 8 * 80 + 32;
    const float* mod = (const float*)(F.ws + WS_MOD); const float* gn = p.in[I_GFFN];
    const bf16_t* upd = (const bf16_t*)(F.ws + WS_UPD1); unsigned* h8 = (unsigned*)(F.ws + WS_H28);
    const float* wrg = p.in[I_WRG]; const float* wre = p.in[I_WRE]; const float* brg = p.in[I_BRG]; const float* bre = p.in[I_BRE];
    const int ftid = fresh_tid();
    __syncthreads();
    for (int chunk = F.bid; chunk < T / 256; chunk += F.G) {
        const int b = chunk >> 5;
        __syncthreads();
        for (int col = ftid; col < 1024; col += 512) { gs[col] = gn[col] * (1.f + mod[b * 6144 + 4096 + col]); sh[col] = mod[b * 6144 + 3072 + col]; }
        if (ftid < 32) hist[ftid] = 0;
        __syncthreads();
        f32x4 vn[2][4]; u32x2 un[2][4];
#pragma unroll
        for (int r = 0; r < 2; ++r) { const int row = chunk * 256 + F.wave * 2 + r;
            const f32x4* xr = (const f32x4*)(p.in[I_X] + (size_t)row * 1024) + lane_; const u32x2* ur = (const u32x2*)(upd + (size_t)row * 1024) + lane_;
#pragma unroll
            for (int j = 0; j < 4; ++j) { vn[r][j] = xr[64 * j]; un[r][j] = ur[64 * j]; } }
        for (int rr = F.wave * 2; rr < 256; rr += 16) {
            const int row0 = chunk * 256 + rr;
            f32x2 yp[4][4];
            {
                f32x4 y[2][4];
#pragma unroll
                for (int r = 0; r < 2; ++r) {
                    const int row = row0 + r; float ss = 0.f;
#pragma unroll
                    for (int j = 0; j < 4; ++j) { vn[r][j].x += bf_lo(un[r][j].x); vn[r][j].y += bf_hi(un[r][j].x); vn[r][j].z += bf_lo(un[r][j].y); vn[r][j].w += bf_hi(un[r][j].y);
                        ss += (vn[r][j].x * vn[r][j].x + vn[r][j].y * vn[r][j].y) + (vn[r][j].z * vn[r][j].z + vn[r][j].w * vn[r][j].w); }
                    const float rinv = __builtin_amdgcn_rsqf(wave_sum(ss) * (1.f / 1024.f) + RMS_EPS);
#pragma unroll
                    for (int j = 0; j < 4; ++j) { const f32x4 gj = *(const LAS f32x4*)(gs + 256 * j + 4 * lane_), sj = *(const LAS f32x4*)(sh + 256 * j + 4 * lane_);
                        y[r][j] = vn[r][j] * rinv * gj + sj; h8[(size_t)row * 256 + 64 * j + lane_] = pk4_fp8(y[r][j].x, y[r][j].y, y[r][j].z, y[r][j].w); }
                }
#pragma unroll
                for (int j = 0; j < 4; ++j) { yp[j][0] = (f32x2){y[0][j].x, y[1][j].x}; yp[j][1] = (f32x2){y[0][j].y, y[1][j].y}; yp[j][2] = (f32x2){y[0][j].z, y[1][j].z}; yp[j][3] = (f32x2){y[0][j].w, y[1][j].w}; }
            }
            if (rr + 16 < 256) {
#pragma unroll
                for (int r = 0; r < 2; ++r) { const int row = row0 + 16 + r;
                    const f32x4* xr = (const f32x4*)(p.in[I_X] + (size_t)row * 1024) + lane_; const u32x2* ur = (const u32x2*)(upd + (size_t)row * 1024) + lane_;
#pragma unroll
                    for (int j = 0; j < 4; ++j) { vn[r][j] = xr[64 * j]; un[r][j] = ur[64 * j]; } }
            }
            { const bool up32 = (lane_ & 32) != 0, up16 = (lane_ & 16) != 0, up8 = (lane_ & 8) != 0;
              float r36[36];
#pragma unroll
              for (int sg = 0; sg < 3; ++sg) {
                f32x2 a12[12];
#pragma unroll
                for (int g = 0; g < 3; ++g)
#pragma unroll
                  for (int hh = 0; hh < 2; ++hh) {
                    f32x4 w[2][4];
#pragma unroll
                    for (int ci = 0; ci < 2; ++ci)
#pragma unroll
                        for (int j = 0; j < 4; ++j) w[ci][j] = *(const LAS f32x4*)(wt + ((sg * 3 + g) * 4 + hh * 2 + ci) * WP + 4 * lane_ + 256 * j);
#pragma unroll
                    for (int ci = 0; ci < 2; ++ci) { f32x2 ax = {0.f, 0.f}, ay = ax, az = ax, aw = ax;
#pragma unroll
                        for (int j = 0; j < 4; ++j) { const f32x4 ww = w[ci][j];
                            ax = __builtin_elementwise_fma(yp[j][0], (f32x2){ww.x, ww.x}, ax); ay = __builtin_elementwise_fma(yp[j][1], (f32x2){ww.y, ww.y}, ay);
                            az = __builtin_elementwise_fma(yp[j][2], (f32x2){ww.z, ww.z}, az); aw = __builtin_elementwise_fma(yp[j][3], (f32x2){ww.w, ww.w}, aw); }
                        a12[g * 4 + hh * 2 + ci] = (ax + ay) + (az + aw); }
                    __builtin_amdgcn_sched_barrier(0);
                  }
                float got[12];
#pragma unroll
                for (int i = 0; i < 12; ++i) got[i] = __shfl_xor(up32 ? a12[i].x : a12[i].y, 32);
#pragma unroll
                for (int i = 0; i < 12; ++i) r36[sg * 12 + i] = (up32 ? a12[i].y : a12[i].x) + got[i];
                __builtin_amdgcn_sched_barrier(0);
              }
              float r18[18], g18[18];
#pragma unroll
              for (int i = 0; i < 18; ++i) g18[i] = __shfl_xor(up16 ? r36[i] : r36[18 + i], 16);
#pragma unroll
              for (int i = 0; i < 18; ++i) r18[i] = (up16 ? r36[18 + i] : r36[i]) + g18[i];
              float r9[9], g9[9];
#pragma unroll
              for (int i = 0; i < 9; ++i) g9[i] = __shfl_xor(up8 ? r18[i] : r18[9 + i], 8);
#pragma unroll
              for (int i = 0; i < 9; ++i) r9[i] = (up8 ? r18[9 + i] : r18[i]) + g9[i];
#pragma unroll
              for (int m = 4; m >= 1; m >>= 1) {
#pragma unroll
                for (int i = 0; i < 9; ++i) g9[i] = __shfl_xor(r9[i], m);
#pragma unroll
                for (int i = 0; i < 9; ++i) r9[i] += g9[i];
              }
              if ((lane_ & 7) == 0) { const int o = (lane_ >> 5) * 36 + ((lane_ >> 4) & 1) * 18 + ((lane_ >> 3) & 1) * 9;
#pragma unroll
                for (int i = 0; i < 9; ++i) scr[o + i] = r9[i]; }
            }
            LDS_WAIT();
            if (lane_ < 2) {
                const LAS float* L = scr + lane_ * 36; const int row = row0 + lane_;
                float lgp[4];
#pragma unroll
                for (int c = 0; c < 4; ++c) lgp[c] = L[c] + bias[c];
                int gsel = 0; float gm = lgp[0];
#pragma unroll
                for (int c = 1; c < 4; ++c) if (lgp[c] > gm) { gm = lgp[c]; gsel = c; }
                float zs = 0.f;
#pragma unroll
                for (int c = 0; c < 4; ++c) zs += fexp2((lgp[c] - gm) * LOG2E);
                const float pg = frcp(zs);
                float l1 = -INFINITY, l2 = -INFINITY; int e1 = 0, e2 = 0;
#pragma unroll
                for (int i = 0; i < 8; ++i) { const float v = L[4 + gsel * 8 + i] + bias[4 + gsel * 8 + i];
                    if (v > l1) { l2 = l1; e2 = e1; l1 = v; e1 = i; } else if (v > l2) { l2 = v; e2 = i; } }
                const float ex = fexp2((l2 - l1) * LOG2E), den = frcp(1.f + ex);
                int* te = (int*)(F.ws + WS_TOKE) + (size_t)row * 2; float* tw = (float*)(F.ws + WS_TOKW) + (size_t)row * 2;
                te[0] = gsel * 8 + e1; te[1] = gsel * 8 + e2; tw[0] = pg * den; tw[1] = pg * ex * den;
                lds_add(&hist[gsel * 8 + e1], 1); lds_add(&hist[gsel * 8 + e2], 1);
            }
            LDS_WAIT();
        }
        __syncthreads();
        if (ftid < 32) ((int*)(F.ws + WS_HIST))[chunk * 32 + ftid] = hist[ftid];
    }
}

DI void phase_slots(const Frame& F, const Params& p) {
    const int tid_ = fresh_tid(), lane_ = tid_ & 63;
    LAS int* tot = (LAS int*)(F.lds); LAS int* bas = tot + 32; LAS int* pst = tot + 64; LAS int* wcnt = tot + 128;
    const int* hist = (const int*)(F.ws + WS_HIST);
    for (int pm = F.bid; pm < T / 256; pm += F.G) {
        const int ftid = fresh_tid();
        __syncthreads();
        if (ftid < 64) tot[ftid] = 0;
        __syncthreads();
        { const int e = tid_ & 31, part = tid_ >> 5; int t = 0, bs = 0;
          for (int q = part; q < T / 256; q += 16) { const int v = hist[q * 32 + e]; t += v; if (q < pm) bs += v; }
          lds_add(&tot[e], t); lds_add(&bas[e], bs); }
        __syncthreads();
        if (tid_ == 0) { int run = 0; for (int e = 0; e < 32; ++e) { pst[e] = run; run += (tot[e] + 255) / 256 * 256; } pst[32] = run; }
        const int my_e = ((const int*)(F.ws + WS_TOKE))[(size_t)pm * 512 + tid_];
        int rank = 0;
        for (int e = 0; e < 32; ++e) { const unsigned long long mask = __ballot(my_e == e); if (my_e == e) rank = __popcll(mask & ((1ull << lane_) - 1ull)); if (lane_ == 0) wcnt[F.wave * 32 + e] = __popcll(mask); }
        __syncthreads();
        int woff = 0;
        for (int w = 0; w < F.wave; ++w) woff += wcnt[w * 32 + my_e];
        const int slot = pst[my_e] + bas[my_e] + woff + rank;
        ((int*)(F.ws + WS_SLOTTOK))[slot] = pm * 256 + (tid_ >> 1);
        ((float*)(F.ws + WS_SLOTW))[slot] = ((const float*)(F.ws + WS_TOKW))[(size_t)pm * 512 + tid_];
        ((int*)(F.ws + WS_TOKS))[(size_t)pm * 512 + tid_] = slot;
        if (pm < 32) { const int e = pm; for (int s = pst[e] + tot[e] + tid_; s < pst[e + 1]; s += 512) { ((int*)(F.ws + WS_SLOTTOK))[s] = 0; ((float*)(F.ws + WS_SLOTW))[s] = 0.f; } }
        if (pm == 0 && tid_ < 34) { int* et = (int*)(F.ws + WS_ETAB); if (tid_ < 33) et[64 + tid_] = pst[tid_] >> 8; if (tid_ < 32) { et[tid_] = tot[tid_]; et[32 + tid_] = pst[tid_]; } if (tid_ == 33) et[97] = pst[32] >> 8; }
    }
}

DI void phase_combine(const Frame& F, const Params& p) {
    const int tid_ = fresh_tid(), lane_ = tid_ & 63;
    const unsigned* y = (const unsigned*)(F.ws + WS_Y); const int* ts = (const int*)(F.ws + WS_TOKS); const float* tw = (const float*)(F.ws + WS_TOKW); const float* mod = (const float*)(F.ws + WS_MOD);
    const int gw = F.bid * 8 + F.wave, NGW = F.G * 8;
    for (int row = gw; row < T; row += NGW) {
        const int s0 = ts[(size_t)row * 2], s1 = ts[(size_t)row * 2 + 1]; const float w0 = tw[(size_t)row * 2] * 0.125f, w1 = tw[(size_t)row * 2 + 1] * 0.125f;
        const f32x4* xr = (const f32x4*)(p.in[I_X] + (size_t)row * 1024) + lane_; f32x4* orow = (f32x4*)(p.out + (size_t)row * 1024) + lane_;
        const u32x2* ur = (const u32x2*)((const bf16_t*)(F.ws + WS_UPD1) + (size_t)row * 1024) + lane_;
        const unsigned* y0 = y + (size_t)s0 * 256 + lane_; const unsigned* y1 = y + (size_t)s1 * 256 + lane_;
        const f32x4* g2 = (const f32x4*)(mod + (row >> 13) * 6144 + 5120) + lane_;
        f32x4 v[4], g[4]; unsigned a[4], c[4]; u32x2 uu[4];
#pragma unroll
        for (int j = 0; j < 4; ++j) { v[j] = xr[64 * j]; uu[j] = ur[64 * j]; a[j] = y0[64 * j]; c[j] = y1[64 * j]; g[j] = g2[64 * j]; }
#pragma unroll
        for (int j = 0; j < 4; ++j) { if (!DBG_X1_PLAIN) { v[j].x += bf_lo(uu[j].x); v[j].y += bf_hi(uu[j].x); v[j].z += bf_lo(uu[j].y); v[j].w += bf_hi(uu[j].y); }
            if (!DBG_SKIP_Y) { const f32x2 al = fp8_lo2(a[j]), ah = fp8_hi2(a[j]), cl = fp8_lo2(c[j]), ch = fp8_hi2(c[j]);
                v[j].x += g[j].x * (w0 * al.x + w1 * cl.x); v[j].y += g[j].y * (w0 * al.y + w1 * cl.y); v[j].z += g[j].z * (w0 * ah.x + w1 * ch.x); v[j].w += g[j].w * (w0 * ah.y + w1 * ch.y); } orow[64 * j] = v[j]; }
    }
}

__global__ void __launch_bounds__(512, 2) fwd(Params p) {
    extern __shared__ __attribute__((aligned(16))) unsigned char lds_raw[];
    Frame F;
    F.lds = (LAS unsigned char*)lds_raw; F.ws = p.ws;
    F.wave = __builtin_amdgcn_readfirstlane((int)threadIdx.x >> 6); F.G = gridDim.x; F.bid = blockIdx.x;
    volatile LAS unsigned* ctl = (volatile LAS unsigned*)(F.lds + LDS_CTLO);
    { const int ftid = fresh_tid(); if (ftid < 64) ctl[ftid] = 0u; }
    __syncthreads();
    XcdBarrier bar; bar.bar = (unsigned*)(p.ws + WS_CTL) + CW_BAR; bar.x = 0; bar.st = ctl;
    if (MK_N_LAUNCHES == 1) bar = xcd_barrier_post((unsigned*)(p.ws + WS_CTL) + CW_BAR, ctl);
    const int lo = p.ph_lo, hi = p.ph_hi;
    const __amdgpu_buffer_rsrc_t rsw = __builtin_amdgcn_make_buffer_rsrc(p.ws, 0, (int)WS_END, 0x00020000);
#define IN(k) (lo <= (k) && (k) < hi)
#define REP(k) for (int rep_ = 0; rep_ < ((PROBE_PH) == (k) ? 2 : 1); ++rep_)
#define SEAM(k) do { if (IN(k) && IN((k) + 1)) xcd_barrier(bar); } while (0)

    if (IN(0)) REP(0) { phase0(F, p); } SEAM(0);
    if (IN(1)) REP(1) { phase_norm<0>(F, p); } SEAM(1);
    if (IN(2)) REP(2) {
        REP(20) {
            pg8::DenseSched Sd; Sd.init(T, 2304, F.G, F.bid, WS_H8, 1024, WS_W1D8, 1024);
            EpiProj<false> E{(bf16_t*)(F.ws + WS_PROJ), (bf16_t*)(F.ws + WS_GATES), (const bf16_t*)(F.ws + WS_ROPE), p.in[I_QG], p.in[I_KG], 0};
            pg8::gemm_phase<EpiProj<false>, pg8::DenseSched, true>(F.lds, 1024, Sd, E, rsw);
        }
        REP(21) {
            pg8::DenseSched Sd; Sd.init(T, 768, F.G, F.bid, WS_H, 2048, WS_W1 + (size_t)2304 * 2048, 2048);
            EpiProj<false> E{(bf16_t*)(F.ws + WS_PROJ), (bf16_t*)(F.ws + WS_GATES), (const bf16_t*)(F.ws + WS_ROPE), p.in[I_QG], p.in[I_KG], 9};
            pg8::gemm_phase<EpiProj<false>, pg8::DenseSched, false>(F.lds, 1024, Sd, E, rsw);
        }
        REP(22) {
            pg8::DenseSched Sd; Sd.init(T, 2048, F.G, F.bid, WS_H8, 1024, WS_WG8, 1024);
            EpiProj<true> E{(bf16_t*)(F.ws + WS_PROJ), (bf16_t*)(F.ws + WS_GATES), (const bf16_t*)(F.ws + WS_ROPE), p.in[I_QG], p.in[I_KG], 0};
            pg8::gemm_phase<EpiProj<true>, pg8::DenseSched, true>(F.lds, 1024, Sd, E, rsw);
        }
    } SEAM(2);
    if (IN(3)) REP(3) { phase_attn(F, p); } SEAM(3);
    if (IN(4)) REP(4) {
        pg8::DiagSched Sd; Sd.init(T, 2048, F.G, F.bid, WS_OCAT, 512, WS_WB, 512);
        EpiBranch E{(const unsigned char*)(F.ws + WS_GATES), F.ws + WS_MERGED};
        pg8::gemm_phase<EpiBranch, pg8::DiagSched, true>(F.lds, 512, Sd, E, rsw);
    } SEAM(4);
    if (IN(5)) REP(5) {
        pg8::DenseSched Sd; Sd.init(T, 1024, F.G, F.bid, WS_MERGED, 1024, WS_WO, 1024);
        EpiOut E{(bf16_t*)(F.ws + WS_UPD1), (const float*)(F.ws + WS_MOD)};
        pg8::gemm_phase<EpiOut, pg8::DenseSched, true>(F.lds, 1024, Sd, E, rsw);
        if (rep_ + 1 == ((PROBE_PH) == 5 ? 2 : 1)) router_weights_to_lds(F, p);
    } SEAM(5);
    if (IN(6)) REP(6) { phase_norm2_route(F, p); }
    if (IN(6) && IN(8)) xcd_barrier(bar);
    if (IN(8)) REP(8) { phase_slots(F, p); } SEAM(8);
    if (IN(9) || IN(10)) {
        LAS int* cst = (LAS int*)(F.lds + LDS_CTLO) + 16;
        __syncthreads();
        { const int ftid = fresh_tid(); if (ftid < 34) cst[ftid] = ((const int*)(F.ws + WS_ETAB))[64 + ftid]; }
        __syncthreads();
    }
    if (IN(9)) REP(9) {
        const LAS int* cst = (const LAS int*)(F.lds + LDS_CTLO) + 16;
        MoeSchedUp Sm; Sm.G = F.G; Sm.c = (F.G == 256) ? ((F.bid & 7) * 32 + (F.bid >> 3)) : F.bid; Sm.nc = __builtin_amdgcn_readfirstlane(cst[33]); Sm.pa = 1024; Sm.pb = 1024; Sm.A = (unsigned)WS_H28; Sm.B = (unsigned)WS_WGU; Sm.cstart = cst;
        Sm.slot_tok = (const int*)(F.ws + WS_SLOTTOK); Sm.estride = 1024u * 1024u; Sm.pnstride = 256u * 1024u;
        EpiSwiglu E{F.ws + WS_HMID};
        pg8::gemm_phase<EpiSwiglu, MoeSchedUp, true>(F.lds, 1024, Sm, E, rsw);
    } SEAM(9);
    if (IN(10)) REP(10) {
        const LAS int* cst = (const LAS int*)(F.lds + LDS_CTLO) + 16;
        MoeSchedDn Sm; Sm.G = F.G; Sm.c = (F.G == 256) ? ((F.bid & 7) * 32 + (F.bid >> 3)) : F.bid; Sm.nc = __builtin_amdgcn_readfirstlane(cst[33]); Sm.pa = 512; Sm.pb = 512; Sm.A = (unsigned)WS_HMID; Sm.B = (unsigned)WS_WDN; Sm.cstart = cst;
        Sm.slot_tok = (const int*)(F.ws + WS_SLOTTOK); Sm.estride = 1024u * 512u; Sm.pnstride = 256u * 512u;
        EpiDown E{F.ws + WS_Y};
        pg8::gemm_phase<EpiDown, MoeSchedDn, true>(F.lds, 512, Sm, E, rsw);
    } SEAM(10);
    if (IN(11)) { phase_combine(F, p); }
#undef IN
#undef SEAM
}

extern "C" void kernel_launch(void* const* d_in, const int* in_sizes, int n_in, void* d_out, int out_size, void* d_ws, size_t ws_size, hipStream_t stream) {
    static int grid = 0;
    if (grid == 0) {
        if (n_in != 21 || in_sizes[0] != T * D || out_size != T * D || ws_size < WS_END) { fprintf(stderr, "kernel_launch: unexpected problem (n_in %d, ws %zu)\n", n_in, ws_size); grid = -1; return; }
        int dev = 0, cus = 0, per_cu = 0;
        if (hipGetDevice(&dev) != hipSuccess || hipDeviceGetAttribute(&cus, hipDeviceAttributeMultiprocessorCount, dev) != hipSuccess) { grid = -1; return; }
        if (hipFuncSetAttribute((const void*)fwd, hipFuncAttributeMaxDynamicSharedMemorySize, LDS_BYTES) != hipSuccess) { fprintf(stderr, "kernel_launch: hipFuncSetAttribute failed\n"); grid = -1; return; }
        if (hipOccupancyMaxActiveBlocksPerMultiprocessor(&per_cu, (const void*)fwd, 512, LDS_BYTES) != hipSuccess || per_cu < 1) { fprintf(stderr, "kernel_launch: occupancy query says %d\n", per_cu); (void)hipGetLastError(); grid = -1; return; }
        grid = cus;
    }
    if (grid < 0) return;
    (void)hipMemsetAsync((char*)d_ws + WS_CTL, 0, CTL_ZERO_BYTES, stream);
    Params p{};
    for (int i = 0; i < 21; ++i) p.in[i] = (const float*)d_in[i];
    p.out = (float*)d_out; p.ws = (unsigned char*)d_ws;
    if (MK_N_LAUNCHES == 1) { p.ph_lo = 0; p.ph_hi = NPH; hipLaunchKernelGGL(fwd, dim3(grid), dim3(512), LDS_BYTES, stream, p); }
    else { for (int k = 0; k < NPH; ++k) { p.ph_lo = k; p.ph_hi = k + 1; hipLaunchKernelGGL(fwd, dim3(grid), dim3(512), LDS_BYTES, stream, p); } }
}
```

```cpp
#include <hip/hip_runtime.h>
#include <cstdio>
#include <cstdint>

#ifndef MK_N_LAUNCHES
#define MK_N_LAUNCHES 1
#endif
#define DBG_X1_PLAIN 0
#define DBG_SKIP_Y 0
#ifndef PROBE_PH
#define PROBE_PH -1
#endif

#define LAS __attribute__((address_space(3)))
#define DI __device__ __forceinline__
typedef unsigned short bf16_t;
typedef short bf16x8 __attribute__((ext_vector_type(8)));
typedef short s16x4 __attribute__((ext_vector_type(4)));
typedef float f32x2 __attribute__((ext_vector_type(2)));
typedef float f32x4 __attribute__((ext_vector_type(4)));
typedef float f32x16 __attribute__((ext_vector_type(16)));
typedef unsigned u32x2 __attribute__((ext_vector_type(2)));
typedef unsigned u32x4 __attribute__((ext_vector_type(4)));
typedef __bf16 bf16x2n __attribute__((ext_vector_type(2)));
typedef int i32x8 __attribute__((ext_vector_type(8)));

constexpr int NB = 8, S = 8192, D = 1024, T = NB * S;
constexpr int LDP = 3072, LDG = 2048, LDO = 512;
constexpr int NE = 32, DE = 512;
constexpr int MAXSLOT = T * 2 + NE * 256;
constexpr int NPH = 12;
constexpr float LOG2E = 1.4426950408889634f;
constexpr float QSCALE = 0.125f * LOG2E;
constexpr float RMS_EPS = 1e-6f;

constexpr size_t MiB = 1u << 20;
constexpr size_t WS_CTL = 0, CTL_ZERO_BYTES = 64 * 1024;
constexpr int CW_BAR = 1024;
constexpr size_t WS_MODP = 1 * MiB;
constexpr size_t WS_MOD = 3 * MiB;
constexpr size_t WS_ROPE = 4 * MiB;
constexpr size_t WS_LOGIT = 144 * MiB;
constexpr size_t WS_TOKE = 24 * MiB;
constexpr size_t WS_TOKW = 24 * MiB + 512 * 1024;
constexpr size_t WS_TOKS = 25 * MiB;
constexpr size_t WS_SLOTTOK = 25 * MiB + 512 * 1024;
constexpr size_t WS_SLOTW = 26 * MiB + 256 * 1024;
constexpr size_t WS_HIST = 27 * MiB;
constexpr size_t WS_ETAB = 27 * MiB + 256 * 1024;
constexpr size_t WS_WR = 28 * MiB;
constexpr size_t WS_W1D8 = 28 * MiB + 512 * 1024;
constexpr size_t WS_W1 = 32 * MiB;
constexpr size_t WS_WG8 = 38 * MiB;
constexpr size_t WS_WB = 40 * MiB;
constexpr size_t WS_WO = 43 * MiB;
constexpr size_t WS_WGU = 48 * MiB;
constexpr size_t WS_WDN = 80 * MiB;
constexpr size_t WS_H = 144 * MiB;
constexpr size_t WS_OG = 144 * MiB;
constexpr size_t WS_LSE = 240 * MiB;
constexpr size_t WS_PROJ = 272 * MiB;
constexpr size_t WS_GATES = 656 * MiB;
constexpr size_t WS_OCAT = 912 * MiB;
constexpr size_t WS_H8 = 912 * MiB;
constexpr size_t WS_MERGED = 272 * MiB;
constexpr size_t WS_H2 = 400 * MiB;
constexpr size_t WS_H28 = 528 * MiB;
constexpr size_t WS_HMID = 592 * MiB;
constexpr size_t WS_Y = 664 * MiB;
constexpr size_t WS_UPD1 = 800 * MiB;
constexpr size_t WS_END = 976 * MiB;

constexpr int LDS_STAGE = 0, LDS_EPI = 131072, LDS_RW = 0, LDS_RV = 148480, LDS_RS = 148480 + 8192, LDS_CTLO = 148480 + 8192 + 3072, LDS_BYTES = LDS_CTLO + 256;

DI unsigned pk2(float lo, float hi) { f32x2 v = {lo, hi}; bf16x2n r = __builtin_convertvector(v, bf16x2n); return __builtin_bit_cast(unsigned, r); }
DI unsigned pk4_fp8(float a, float b, float c, float d) { int r = __builtin_amdgcn_cvt_pk_fp8_f32(a, b, 0, false); r = __builtin_amdgcn_cvt_pk_fp8_f32(c, d, r, true); return (unsigned)r; }
DI f32x2 fp8_lo2(unsigned u) { return __builtin_amdgcn_cvt_pk_f32_fp8((int)u, false); }
DI f32x2 fp8_hi2(unsigned u) { return __builtin_amdgcn_cvt_pk_f32_fp8((int)u, true); }
DI float bf_lo(unsigned u) { return __builtin_bit_cast(float, u << 16); }
DI float bf_hi(unsigned u) { return __builtin_bit_cast(float, u & 0xffff0000u); }
DI float wave_sum(float v) {
#pragma unroll
    for (int o = 1; o < 64; o <<= 1) v += __shfl_xor(v, o);
    return v;
}
DI float fexp2(float x) { return __builtin_amdgcn_exp2f(x); }
DI float flog2(float x) { return __builtin_amdgcn_logf(x); }
DI float frcp(float x) { return __builtin_amdgcn_rcpf(x); }
DI float sigmoidf(float v) { return frcp(1.0f + fexp2(-v * LOG2E)); }
DI void lds_add(LAS int* p, int v) { (void)__hip_atomic_fetch_add(p, v, __ATOMIC_RELAXED, __HIP_MEMORY_SCOPE_WORKGROUP); }
#define LDS_WAIT() asm volatile("s_waitcnt lgkmcnt(0)" ::: "memory")
#define VM_WAIT() asm volatile("s_waitcnt vmcnt(0)" ::: "memory")
DI int fresh_tid() { int t = threadIdx.x; asm volatile("" : "+v"(t)); return t; }

#define XB_TMO      128
#define XB_XCNT(j)  (256  + 64 * (j))
#define XB_XSUB(j)  (1280 + 64 * (j))
#define XB_XGEN(j)  (2304 + 64 * (j))
#define XB_TOP      3328
#define XB_TOPGEN   3392
#define XCD_BAR_WORDS 3456
#define XB_SPIN_CAP (1u << 18)

__device__ __forceinline__ unsigned xb_ld(unsigned* p)              { return __hip_atomic_load(p, __ATOMIC_RELAXED, __HIP_MEMORY_SCOPE_AGENT); }
__device__ __forceinline__ unsigned xb_add(unsigned* p, unsigned v) { return __hip_atomic_fetch_add(p, v, __ATOMIC_RELAXED, __HIP_MEMORY_SCOPE_AGENT); }
__device__ __forceinline__ unsigned xb_xcc_id() { return (unsigned)__builtin_amdgcn_s_getreg((3 << 11) | 20) & 0xFu; }
#define XB_SPIN(cond, bar) do { unsigned _sp = 0; while (cond) { __builtin_amdgcn_s_sleep(1); \
    if ((++_sp & 255u) == 0u) { if (xb_ld(&(bar)[XB_TMO])) break; if (_sp > XB_SPIN_CAP) { atomicAdd(&(bar)[XB_TMO], 1u); break; } } } } while (0)

struct XcdBarrier {
    unsigned* bar; unsigned x;
    volatile LAS unsigned* st;
};
__device__ __forceinline__ XcdBarrier xcd_barrier_post(unsigned* bar, volatile LAS unsigned* st) {
    XcdBarrier b; b.bar = bar; b.x = xb_xcc_id(); b.st = st;
    if (threadIdx.x == 0) (void)xb_add(&bar[XB_XCNT(b.x)], 1u);
    return b;
}
__device__ __forceinline__ void xcd_barrier_complete(unsigned* bar, unsigned x, unsigned& nloc, unsigned& nx) {
    const unsigned G = gridDim.x * gridDim.y * gridDim.z;
    unsigned sum, cnt, mine, sp = 0u;
    for (;;) {
        sum = 0u; cnt = 0u; mine = 0u;
#pragma unroll
        for (unsigned j = 0; j < 16; ++j) { const unsigned c = xb_ld(&bar[XB_XCNT(j)]); sum += c; cnt += (c > 0u) ? 1u : 0u; mine = (j == x) ? c : mine; }
        if (sum == G) break;
        __builtin_amdgcn_s_sleep(1);
        if ((++sp & 255u) == 0u) { if (xb_ld(&bar[XB_TMO])) break; if (sp > XB_SPIN_CAP) { atomicAdd(&bar[XB_TMO], 1u); break; } }
    }
    nloc = mine > 0u ? mine : 1u; nx = cnt > 0u ? cnt : 1u;
}
__device__ __forceinline__ void xcd_barrier(const XcdBarrier& b) {
    asm volatile("s_waitcnt vmcnt(0)" ::: "memory");
    __syncthreads();
    if (threadIdx.x == 0) {
        unsigned* bar = b.bar;
        __builtin_amdgcn_s_waitcnt(0);
        unsigned nloc = b.st[0], nx = b.st[1];
        if (nloc == 0u) { xcd_barrier_complete(bar, b.x, nloc, nx); b.st[0] = nloc; b.st[1] = nx; }
        const unsigned old = xb_add(&bar[XB_XSUB(b.x)], 1u);
        const unsigned gen = old / nloc;
        if (old + 1u == (gen + 1u) * nloc) {
            __builtin_amdgcn_fence(__ATOMIC_RELEASE, "agent");
            asm volatile("s_waitcnt vmcnt(0)" ::: "memory");
            const unsigned og = xb_add(&bar[XB_TOP], 1u);
            const unsigned tg = og / nx;
            if (og + 1u == (tg + 1u) * nx) xb_add(&bar[XB_TOPGEN], 1u);
            else XB_SPIN(xb_ld(&bar[XB_TOPGEN]) == tg, bar);
            __builtin_amdgcn_fence(__ATOMIC_ACQUIRE, "agent");
            xb_add(&bar[XB_XGEN(b.x)], 1u);
            asm volatile("s_waitcnt vmcnt(0)" ::: "memory");
        } else {
            XB_SPIN(xb_ld(&bar[XB_XGEN(b.x)]) == gen, bar);
            __builtin_amdgcn_fence(__ATOMIC_ACQUIRE, "agent");
            asm volatile("s_waitcnt vmcnt(0)" ::: "memory");
        }
    }
    __syncthreads();
}

namespace pg8 {
constexpr int BM = 256, BK = 64, HALF = 128, HTB = HALF * BK * 2, STAGE_BYTES = 8 * HTB, NXCD = 8, WGM = 8;
__host__ __device__ __forceinline__ int lds_byte(int r, int c) { const int st = (r >> 4) * 2 + (c >> 5), rr = r & 15, cc = c & 31, ob = rr * 64 + cc * 2; return st * 1024 + (ob ^ (((ob >> 9) & 1) << 5)); }
__host__ __device__ __forceinline__ void stage_rc(int b, int& R, int& C) { const int st = b / 1024, sb = b % 1024, swz = sb ^ (((sb >> 9) & 1) << 5); R = (st >> 1) * 16 + swz / 64; C = (st & 1) * 32 + (swz % 64) / 2; }
__host__ __device__ __forceinline__ int perm32(int rho) { const int n = rho >> 4, i = rho & 15; return 8 * (i >> 2) + 4 * n + (i & 3); }

struct Unit { int pm, pn, aux; unsigned a, b; };
typedef int i32x4 __attribute__((ext_vector_type(4)));
__device__ __forceinline__ i32x8 frag8(bf16x8 lo, bf16x8 hi) { return __builtin_shufflevector(__builtin_bit_cast(i32x4, lo), __builtin_bit_cast(i32x4, hi), 0, 1, 2, 3, 4, 5, 6, 7); }

template <class Epi, class Sched, bool FP8 = false>
__device__ __forceinline__ void gemm_phase(LAS unsigned char* lds, const int K, const Sched& S, const Epi& E, const __amdgpu_buffer_rsrc_t rs) {
    const int tid = fresh_tid(), wid = __builtin_amdgcn_readfirstlane(tid >> 6), lane = tid & 63, wr = wid >> 2, wc = wid & 3, fr = lane & 15, fq = lane >> 4;
    const int nt = FP8 ? K / 128 : K / BK;
    int RA[2], CA[2];
    unsigned voffA[4], voffB[2];
#pragma unroll
    for (int i = 0; i < 2; ++i) { int R, C; stage_rc(tid * 16 + i * 8192, R, C); RA[i] = R; CA[i] = C; const int Rb = Epi::PERM ? ((R & ~31) + perm32(R & 31)) : R;
        voffB[i] = (unsigned)(Rb * S.pb + C * 2); }
    const unsigned kstep = (unsigned)(BK * 2);
    const unsigned hstepB = (unsigned)(HALF * S.pb), hstepA = (unsigned)(HALF * S.pa);
    const unsigned ldsw = (unsigned)wid * 1024u;
    const int aoff = lds_byte(wr * 64 + fr, fq * 8), boff = lds_byte(wc * 32 + fr, fq * 8);
    constexpr int kpiece = 1024;
#define PG8_SA(b, h) (((b) * 2 + (h)) * HTB)
#define PG8_SB(b, h) ((4 + (b) * 2 + (h)) * HTB)
#define PG8_STAGE_B(bufoff, gbase) do { _Pragma("unroll") for (int _i = 0; _i < 2; ++_i) \
        __builtin_amdgcn_raw_ptr_buffer_load_lds(rs, (LAS unsigned*)(lds + (bufoff) + ldsw + _i * 8192), 16, (int)voffB[_i], (int)(gbase), 0, 0); } while (0)
#define PG8_STAGE_A(bufoff, gbase, h) do { _Pragma("unroll") for (int _i = 0; _i < 2; ++_i) \
        __builtin_amdgcn_raw_ptr_buffer_load_lds(rs, (LAS unsigned*)(lds + (bufoff) + ldsw + _i * 8192), 16, (int)voffA[Sched::GATHER ? (h) * 2 + _i : _i], (int)((gbase) + (Sched::GATHER ? 0u : (unsigned)(h) * hstepA)), 0, 0); } while (0)
#define PG8_LDA(dst, b, h) do { _Pragma("unroll") for (int m = 0; m < 4; ++m) _Pragma("unroll") for (int k = 0; k < 2; ++k) dst[m][k] = *(const LAS bf16x8*)(lds + PG8_SA(b, h) + aoff + m * 2048 + k * kpiece); } while (0)
#define PG8_LDB(dst, b, h) do { _Pragma("unroll") for (int n = 0; n < 2; ++n) _Pragma("unroll") for (int k = 0; k < 2; ++k) dst[n][k] = *(const LAS bf16x8*)(lds + PG8_SB(b, h) + boff + n * 2048 + k * kpiece); } while (0)
#define PG8_MMA(ai, bj, At, Bt) do { __builtin_amdgcn_s_setprio(1); if constexpr (FP8) { _Pragma("unroll") for (int m = 0; m < 4; ++m) _Pragma("unroll") for (int n = 0; n < 2; ++n) \
        acc[ai][bj][m][n] = __builtin_amdgcn_mfma_scale_f32_16x16x128_f8f6f4(frag8(Bt[n][0], Bt[n][1]), frag8(At[m][0], At[m][1]), acc[ai][bj][m][n], 0, 0, 0, 0x7C7C7C7C, 0, 0x7C7C7C7C); } \
      else { _Pragma("unroll") for (int m = 0; m < 4; ++m) _Pragma("unroll") for (int n = 0; n < 2; ++n) _Pragma("unroll") for (int k = 0; k < 2; ++k) \
        acc[ai][bj][m][n] = __builtin_amdgcn_mfma_f32_16x16x32_bf16(Bt[n][k], At[m][k], acc[ai][bj][m][n], 0, 0, 0); } __builtin_amdgcn_s_setprio(0); } while (0)
#define PG8_MMA2(ai, At) do { if constexpr (Sched::BLOCKDIAG) { if (lo_half) PG8_MMA(ai, 0, At, B0); else PG8_MMA(ai, 1, At, B1); } else { PG8_MMA(ai, 0, At, B0); PG8_MMA(ai, 1, At, B1); } } while (0)
#define PG8_WAIT_V(n) asm volatile("s_waitcnt vmcnt(" #n ")" ::: "memory")
#define PG8_WAIT_L(n) asm volatile("s_waitcnt lgkmcnt(" #n ")" ::: "memory")
#define PG8_BAR __builtin_amdgcn_s_barrier()
#define PG8_SCHED __builtin_amdgcn_sched_barrier(0)
    Unit cur, nxt; int ui = 0;
    if (!S.next(0, cur)) return;
    S.offs(cur, RA, CA, voffA);
    f32x4 acc[2][2][4][2];
#pragma unroll
    for (int a = 0; a < 2; ++a)
#pragma unroll
        for (int b = 0; b < 2; ++b)
#pragma unroll
            for (int m = 0; m < 4; ++m)
#pragma unroll
                for (int n = 0; n < 2; ++n) acc[a][b][m][n] = (f32x4){0.f, 0.f, 0.f, 0.f};
    bf16x8 At[4][2], B0[2][2], B1[2][2];
    unsigned cA = cur.a, cB = cur.b;
    PG8_STAGE_B(PG8_SB(0, 0), cB); PG8_STAGE_B(PG8_SB(0, 1), cB + hstepB); PG8_STAGE_A(PG8_SA(0, 0), cA, 0); PG8_STAGE_A(PG8_SA(0, 1), cA, 1);
    if (wr == 1) PG8_BAR;
    PG8_WAIT_V(2); PG8_BAR;
    PG8_STAGE_B(PG8_SB(1, 0), cB + kstep); PG8_STAGE_A(PG8_SA(1, 0), cA + kstep, 0); PG8_STAGE_B(PG8_SB(1, 1), cB + hstepB + kstep);
    PG8_WAIT_V(6); PG8_BAR;
    for (;;) {
        const bool has_next = S.next(ui + 1, nxt);
        const unsigned nA = has_next ? nxt.a : cA, nB = has_next ? nxt.b : cB;
        unsigned nvoff[4];
        if constexpr (Sched::GATHER) { if (has_next) S.rows(nxt, RA, nvoff); }
#pragma nounroll
        for (int t = 0; t < nt; t += 2) {
            const bool last = (t == nt - 2), lo_half = t < (nt >> 1);
            const unsigned a1 = cA + (unsigned)(t + 1) * kstep;
            const unsigned a2 = last ? nA : cA + (unsigned)(t + 2) * kstep, b2 = last ? nB : cB + (unsigned)(t + 2) * kstep;
            const unsigned a3 = a2 + kstep, b3 = b2 + kstep;
            PG8_LDB(B0, 0, 0); PG8_LDB(B1, 0, 1); PG8_SCHED; PG8_LDA(At, 0, 0); PG8_STAGE_A(PG8_SA(1, 1), a1, 1);
            PG8_WAIT_V(8); PG8_WAIT_L(0); PG8_BAR; PG8_MMA2(0, At); PG8_BAR; PG8_SCHED;
            if constexpr (Sched::GATHER) { if (last && has_next) {
#pragma unroll
                for (int q = 0; q < 4; ++q) voffA[q] = nvoff[q] * (unsigned)S.pa + (unsigned)(CA[q & 1] * 2); } }
            PG8_LDA(At, 0, 1); PG8_STAGE_B(PG8_SB(0, 0), b2); PG8_STAGE_B(PG8_SB(0, 1), b2 + hstepB); PG8_STAGE_A(PG8_SA(0, 0), a2, 0);
            PG8_WAIT_V(8); PG8_WAIT_L(0); PG8_BAR; PG8_MMA2(1, At); PG8_BAR; PG8_SCHED;
            PG8_LDB(B0, 1, 0); PG8_LDB(B1, 1, 1); PG8_SCHED; PG8_LDA(At, 1, 0); PG8_STAGE_A(PG8_SA(0, 1), a2, 1);
            PG8_WAIT_V(8); PG8_WAIT_L(0); PG8_BAR; PG8_MMA2(0, At); PG8_BAR; PG8_SCHED;
            PG8_LDA(At, 1, 1); PG8_STAGE_B(PG8_SB(1, 0), b3); PG8_STAGE_B(PG8_SB(1, 1), b3 + hstepB); PG8_STAGE_A(PG8_SA(1, 0), a3, 0);
            PG8_WAIT_V(8); PG8_WAIT_L(0); PG8_BAR; PG8_MMA2(1, At); PG8_BAR; PG8_SCHED;
        }
        if (wr == 0) PG8_BAR;
        { const int t2 = fresh_tid() & 63; E(acc, cur, wr, wc, t2 & 15, t2 >> 4, lds + LDS_EPI); }
        if (!has_next) break;
#pragma unroll
        for (int a = 0; a < 2; ++a)
#pragma unroll
            for (int b = 0; b < 2; ++b)
#pragma unroll
                for (int m = 0; m < 4; ++m)
#pragma unroll
                    for (int n = 0; n < 2; ++n) acc[a][b][m][n] = (f32x4){0.f, 0.f, 0.f, 0.f};
        cur = nxt; cA = nA; cB = nB; ++ui;
        if (wr == 1) PG8_BAR;
    }
    PG8_WAIT_V(0);
    PG8_BAR;
#undef PG8_SA
#undef PG8_SB
#undef PG8_STAGE_A
#undef PG8_STAGE_B
#undef PG8_LDA
#undef PG8_LDB
#undef PG8_MMA
#undef PG8_MMA2
#undef PG8_WAIT_V
#undef PG8_WAIT_L
#undef PG8_BAR
#undef PG8_SCHED
}

struct DenseSched {
    static constexpr bool GATHER = false, BLOCKDIAG = false;
    int nM, nN, nwg, G, c; int pa, pb; unsigned A, B;
    __device__ void init(int M, int N, int G_, int c_, size_t A_, int pa_, size_t B_, int pb_) { nM = M / BM; nN = N / BM; nwg = nM * nN; G = G_; c = c_; A = (unsigned)A_; B = (unsigned)B_; pa = pa_; pb = pb_; }
    __device__ __forceinline__ bool next(int i, Unit& u) const {
        const long L = (long)i * G + c; if (L >= nwg) return false;
        int wgid = (int)L; { const int q = nwg / NXCD, r = nwg % NXCD, xcd = wgid % NXCD, off = wgid / NXCD; wgid = (xcd < r ? xcd * (q + 1) : r * (q + 1) + (xcd - r) * q) + off; }
        const int nig = WGM * nN, gid = wgid / nig, fm = gid * WGM, gsz = (nM - fm) < WGM ? (nM - fm) : WGM;
        u.pm = fm + ((wgid % nig) % gsz); u.pn = (wgid % nig) / gsz; u.aux = 0;
        u.a = A + (unsigned)(u.pm * BM * pa); u.b = B + (unsigned)(u.pn * BM * pb); return true;
    }
    __device__ __forceinline__ void offs(const Unit&, const int (&RA)[2], const int (&CA)[2], unsigned (&v)[4]) const {
#pragma unroll
        for (int h = 0; h < 2; ++h)
#pragma unroll
            for (int i = 0; i < 2; ++i) v[h * 2 + i] = (unsigned)((h * HALF + RA[i]) * pa + CA[i] * 2);
    }
};
struct DiagSched : DenseSched { static constexpr bool BLOCKDIAG = true; };
}

struct Params { const float* in[21]; float* out; unsigned char* ws; int ph_lo, ph_hi; };
enum { I_X = 0, I_C, I_POS, I_WADA, I_BADA, I_GMIX, I_GFFN, I_WIN, I_WBG, I_QG, I_KG, I_WBD, I_WBS, I_WOUT, I_WRG, I_BRG, I_WRE, I_BRE, I_WEG, I_WEU, I_WED };

struct Frame {
    LAS unsigned char* lds;
    unsigned char* ws;
    int wave, G, bid;
};

template <bool FP8>
DI void p0_transpose_item(const float* W, int N, void* WTv, int ldt, int k0, int n0, int row_base, LAS float* scr, int lane) {
#pragma unroll 8
    for (int i = 0; i < 32; ++i) { const int kk = 2 * i + (lane >> 5); scr[kk * 33 + (lane & 31)] = W[(size_t)(k0 + kk) * N + n0 + (lane & 31)]; }
    LDS_WAIT();
    const int c = lane & 7;
#pragma unroll
    for (int j = 0; j < 4; ++j) { const int n = (lane >> 3) + 8 * j; const LAS float* sp = scr + (8 * c) * 33 + n;
        if (FP8) { u32x2 o; o.x = pk4_fp8(64.f * sp[0 * 33], 64.f * sp[1 * 33], 64.f * sp[2 * 33], 64.f * sp[3 * 33]); o.y = pk4_fp8(64.f * sp[4 * 33], 64.f * sp[5 * 33], 64.f * sp[6 * 33], 64.f * sp[7 * 33]);
            *(u32x2*)((unsigned char*)WTv + (size_t)(row_base + n) * ldt + k0 + 8 * c) = o; }
        else { u32x4 o; o.x = pk2(sp[0 * 33], sp[1 * 33]); o.y = pk2(sp[2 * 33], sp[3 * 33]); o.z = pk2(sp[4 * 33], sp[5 * 33]); o.w = pk2(sp[6 * 33], sp[7 * 33]);
            *(u32x4*)((bf16_t*)WTv + (size_t)(row_base + n) * ldt + k0 + 8 * c) = o; } }
    LDS_WAIT();
}
DI void phase0(const Frame& F, const Params& p) {
    const int tid_ = fresh_tid(), lane_ = tid_ & 63;
    LAS float* scr = (LAS float*)(F.lds + F.wave * 16384);
    const int gw = F.bid * 8 + F.wave, NGW = F.G * 8;
    bf16_t* W1 = (bf16_t*)(F.ws + WS_W1); bf16_t* WB = (bf16_t*)(F.ws + WS_WB); bf16_t* WO = (bf16_t*)(F.ws + WS_WO);
    unsigned char* WG8 = F.ws + WS_WG8; unsigned char* WGU = F.ws + WS_WGU; unsigned char* WDN = F.ws + WS_WDN;
    constexpr int I1 = 16 * 96, I2 = 16 * 64, I3 = 4 * 32, I4 = 4 * 32, I5 = 16 * 32, I6 = 32 * 256, I7 = 32 * 256, I8 = 32 * 256;
    constexpr int NITEMS = I1 + I2 + I3 + I4 + I5 + I6 + I7 + I8;
    for (int it = gw; it < NITEMS; it += NGW) {
        int r = it;
        if (r < I1) { const int kb = r / 96, nb = r % 96; if (nb < 72) p0_transpose_item<true>(p.in[I_WIN], 3072, F.ws + WS_W1D8, 1024, 64 * kb, 32 * nb, 32 * nb, scr, lane_); else p0_transpose_item<false>(p.in[I_WIN], 3072, W1, 1024, 64 * kb, 32 * nb, 32 * nb, scr, lane_); continue; } r -= I1;
        if (r < I2) { const int kb = r / 64, nb = r % 64; p0_transpose_item<true>(p.in[I_WBG], 2048, WG8, 1024, 64 * kb, 32 * nb, 32 * nb, scr, lane_); continue; } r -= I2;
        if (r < I3) { const int kb = r / 32, nb = r % 32, n0 = 32 * nb; p0_transpose_item<true>(p.in[I_WBD], 1024, (unsigned char*)WB, 512, 64 * kb, n0, (n0 >> 7) * 256 + (n0 & 127), scr, lane_); continue; } r -= I3;
        if (r < I4) { const int kb = r / 32, nb = r % 32, n0 = 32 * nb; p0_transpose_item<true>(p.in[I_WBS], 1024, (unsigned char*)WB + 256, 512, 64 * kb, n0, (n0 >> 7) * 256 + 128 + (n0 & 127), scr, lane_); continue; } r -= I4;
        if (r < I5) { const int kb = r / 32, nb = r % 32; p0_transpose_item<true>(p.in[I_WOUT], 1024, WO, 1024, 64 * kb, 32 * nb, 32 * nb, scr, lane_); continue; } r -= I5;
        if (r < I6) { const int e = r >> 8, q = r & 255, kb = q >> 4, nb = q & 15, n0 = 32 * nb;
            p0_transpose_item<true>(p.in[I_WEG] + (size_t)e * 1024 * 512, 512, WGU + (size_t)e * 1024 * 1024, 1024, 64 * kb, n0, (n0 >> 7) * 256 + (n0 & 127), scr, lane_); continue; } r -= I6;
        if (r < I7) { const int e = r >> 8, q = r & 255, kb = q >> 4, nb = q & 15, n0 = 32 * nb;
            p0_transpose_item<true>(p.in[I_WEU] + (size_t)e * 1024 * 512, 512, WGU + (size_t)e * 1024 * 1024, 1024, 64 * kb, n0, (n0 >> 7) * 256 + 128 + (n0 & 127), scr, lane_); continue; } r -= I7;
        { const int e = r >> 8, q = r & 255, kb = q >> 5, nb = q & 31;
            p0_transpose_item<true>(p.in[I_WED] + (size_t)e * 512 * 1024, 1024, WDN + (size_t)e * 1024 * 512, 512, 64 * kb, 32 * nb, 32 * nb, scr, lane_); }
    }
    {
        unsigned char* WBz = F.ws + WS_WB;
        for (int idx = F.bid * 512 + tid_; idx < 2048 * 16; idx += F.G * 512) { const int row = idx >> 4, c = idx & 15; *(u32x4*)(WBz + (size_t)row * 512 + ((row & 128) ? 0 : 256) + c * 16) = (u32x4){0u, 0u, 0u, 0u}; }
    }
    {
        float* modp = (float*)(F.ws + WS_MODP); const float* c = p.in[I_C]; const float* wada = p.in[I_WADA];
        for (int task = gw; task < 96 * 8; task += NGW) {
            const int ct = task % 96, ks = task / 96, k0 = ks * 128;
#pragma unroll
            for (int i = 0; i < 16; ++i) { const int idx = i * 64 + lane_, b = idx >> 7, k = idx & 127; const float v = c[b * 1024 + k0 + k]; scr[idx] = v * sigmoidf(v); }
            LDS_WAIT();
            float acc[8];
#pragma unroll
            for (int b = 0; b < 8; ++b) acc[b] = 0.f;
            const float* wp = wada + (size_t)k0 * 6144 + ct * 64 + lane_;
#pragma unroll 8
            for (int k = 0; k < 128; ++k) { const float w = wp[(size_t)k * 6144];
#pragma unroll
                for (int b = 0; b < 8; ++b) acc[b] += scr[b * 128 + k] * w; }
#pragma unroll
            for (int b = 0; b < 8; ++b) modp[((size_t)ks * 8 + b) * 6144 + ct * 64 + lane_] = acc[b];
            LDS_WAIT();
        }
    }
}

DI float inv_freq_of(int i) {
    return i == 0 ? 1.0f : i == 1 ? 0.1939227432012558f : i == 2 ? 0.03760603070259094f : i == 3 ? 0.007292664609849453f : i == 4 ? 0.0014142135623842478f : i == 5 ? 0.00027424818836152554f : i == 6 ? 5.318296098266728e-05f : 1.0313386155758053e-05f;
}
template <int WHICH>
DI void phase_norm(const Frame& F, const Params& p) {
    const int tid_ = fresh_tid(), lane_ = tid_ & 63;
    LAS float* gs = (LAS float*)(F.lds); LAS float* sh = gs + 1024;
    const float* modp = (const float*)(F.ws + WS_MODP); float* mod = (float*)(F.ws + WS_MOD); const float* bada = p.in[I_BADA];
    const float* xin = p.in[I_X]; const bf16_t* upd = (const bf16_t*)(F.ws + WS_UPD1); bf16_t* hout = (bf16_t*)(F.ws + (WHICH == 0 ? WS_H : WS_H2)); unsigned* h8 = (unsigned*)(F.ws + (WHICH == 0 ? WS_H8 : WS_H28));
    const float* gn = p.in[WHICH == 0 ? I_GMIX : I_GFFN];
    for (int chunk = F.bid; chunk < T / 256; chunk += F.G) {
        const int b = chunk >> 5;
        __syncthreads();
        if (WHICH == 0) {
            if (tid_ < 192) { const int j = (chunk & 31) * 192 + tid_; float s = bada[j];
#pragma unroll
                for (int ks = 0; ks < 8; ++ks) s += modp[((size_t)ks * 8 + b) * 6144 + j];
                mod[b * 6144 + j] = s; }
            for (int col = tid_; col < 1024; col += 512) { float s1 = bada[col], s2 = bada[1024 + col];
#pragma unroll
                for (int ks = 0; ks < 8; ++ks) { s1 += modp[((size_t)ks * 8 + b) * 6144 + col]; s2 += modp[((size_t)ks * 8 + b) * 6144 + 1024 + col]; }
                gs[col] = gn[col] * (1.f + s2); sh[col] = s1; }
        } else {
            for (int col = tid_; col < 1024; col += 512) { gs[col] = gn[col] * (1.f + mod[b * 6144 + 4096 + col]); sh[col] = mod[b * 6144 + 3072 + col]; }
        }
        __syncthreads();
        f32x4 g4[4], s4[4];
#pragma unroll
        for (int j = 0; j < 4; ++j) { g4[j] = *(const LAS f32x4*)(gs + 256 * j + 4 * lane_); s4[j] = *(const LAS f32x4*)(sh + 256 * j + 4 * lane_); }
        for (int rr = F.wave; rr < 256; rr += 8) {
            const int row = chunk * 256 + rr;
            const f32x4* xr = (const f32x4*)(xin + (size_t)row * 1024) + lane_;
            f32x4 v[4]; float ss = 0.f;
#pragma unroll
            for (int j = 0; j < 4; ++j) v[j] = xr[64 * j];
            if (WHICH == 1) { const u32x2* ur = (const u32x2*)(upd + (size_t)row * 1024) + lane_; u32x2 uu[4];
#pragma unroll
                for (int j = 0; j < 4; ++j) uu[j] = ur[64 * j];
#pragma unroll
                for (int j = 0; j < 4; ++j) { v[j].x += bf_lo(uu[j].x); v[j].y += bf_hi(uu[j].x); v[j].z += bf_lo(uu[j].y); v[j].w += bf_hi(uu[j].y); } }
#pragma unroll
            for (int j = 0; j < 4; ++j) ss += (v[j].x * v[j].x + v[j].y * v[j].y) + (v[j].z * v[j].z + v[j].w * v[j].w);
            const float rinv = __builtin_amdgcn_rsqf(wave_sum(ss) * (1.f / 1024.f) + RMS_EPS);
            u32x2* o8 = (u32x2*)(hout + (size_t)row * 1024) + lane_;
#pragma unroll
            for (int j = 0; j < 4; ++j) { const f32x4 y = v[j] * rinv * g4[j] + s4[j]; u32x2 o; o.x = pk2(y.x, y.y); o.y = pk2(y.z, y.w); o8[64 * j] = o; h8[(size_t)row * 256 + 64 * j + lane_] = pk4_fp8(y.x, y.y, y.z, y.w); }
            if (WHICH == 0 && lane_ < 8) {
                const int pos = ((const int*)p.in[I_POS])[row];
                const float angf = (float)pos * inv_freq_of(lane_);
                double rv = (double)angf * 0.15915494309189535; rv -= __builtin_rint(rv);
                const float fr = (float)rv;
                bf16_t* rp = (bf16_t*)(F.ws + WS_ROPE) + (size_t)row * 16;
                rp[lane_] = (bf16_t)(pk2(__builtin_amdgcn_cosf(fr), 0.f) & 0xffffu); rp[8 + lane_] = (bf16_t)(pk2(__builtin_amdgcn_sinf(fr), 0.f) & 0xffffu);
            }
        }
    }
}

template <bool GATES> struct EpiProj {
    static constexpr bool PERM = true;
    bf16_t* proj; bf16_t* gates; const bf16_t* rope; const float* qg; const float* kg; int pn0;
    DI void operator()(const f32x4 (&acc)[2][2][4][2], const pg8::Unit& u, int wr, int wc, int fr, int fq, LAS unsigned char* scr) const {
        asm volatile("" : "+v"(fr), "+v"(fq));
        const int pn = u.pn + pn0, row0 = u.pm * 256 + wr * 64 + fr, cw = wc * 32 + 8 * fq;
        const int typ = pn < 9 ? pn / 3 : pn - 9, grp = pn < 9 ? pn % 3 : 0, l2d = pn < 9 ? 2 * grp : 0, hbase = pn < 9 ? grp * 4 : 12;
        if (GATES) {
            unsigned char* base = (unsigned char*)gates + pn * 256 + cw;
#pragma unroll
            for (int ai = 0; ai < 2; ++ai)
#pragma unroll
                for (int m = 0; m < 4; ++m) { unsigned char* rowp = base + (size_t)(row0 + ai * 128 + m * 16) * LDG;
#pragma unroll
                    for (int bj = 0; bj < 2; ++bj) { const f32x4 v0 = acc[ai][bj][m][0], v1 = acc[ai][bj][m][1];
                        u32x2 w; w.x = pk4_fp8(v0.x, v0.y, v0.z, v0.w); w.y = pk4_fp8(v1.x, v1.y, v1.z, v1.w);
                        *(u32x2*)(rowp + bj * 128) = w; } }
        } else if (pn >= 6) {
            const float sc = pn == 9 ? QSCALE : 1.f;
            const int dim0 = (wc & 1) * 32 + 8 * fq;
#pragma unroll
            for (int ai = 0; ai < 2; ++ai)
#pragma unroll
                for (int m = 0; m < 4; ++m) { const int t = row0 + ai * 128 + m * 16, sq = t & (S - 1); const int rp = (t & ~(S - 1)) + ((sq & ((1 << l2d) - 1)) << (13 - l2d)) + (sq >> l2d);
#pragma unroll
                    for (int bj = 0; bj < 2; ++bj) { const f32x4 v0 = acc[ai][bj][m][0] * sc, v1 = acc[ai][bj][m][1] * sc; const int head = hbase + 2 * bj + (wc >> 1);
                        u32x4 w; w.x = pk2(v0.x, v0.y); w.y = pk2(v0.z, v0.w); w.z = pk2(v1.x, v1.y); w.w = pk2(v1.z, v1.w);
                        *(u32x4*)(proj + ((size_t)(typ * 16 + head) * T + rp) * 64 + dim0) = w; } }
        } else {
            const bool isq = pn < 3; const float* g = isq ? qg : kg; const float sc = isq ? QSCALE : 1.f;
            LAS float* part = (LAS float*)scr;
            const int ch = (wc & 1) * 32 + 8 * fq;
            const f32x4 g0 = *(const f32x4*)(g + ch), g1 = *(const f32x4*)(g + ch + 4);
            const bool ropew = (wc & 1) == 0;
            u32x4 rcs[2][4][2];
            if (ropew) {
#pragma unroll
                for (int ai = 0; ai < 2; ++ai)
#pragma unroll
                    for (int m = 0; m < 4; ++m) { const u32x4* rpt = (const u32x4*)(rope + (size_t)(u.pm * 256 + ai * 128 + wr * 64 + m * 16 + fr) * 16); rcs[ai][m][0] = rpt[0]; rcs[ai][m][1] = rpt[1]; }
            }
#pragma unroll
            for (int ai = 0; ai < 2; ++ai)
#pragma unroll
                for (int m = 0; m < 4; ++m)
#pragma unroll
                    for (int bj = 0; bj < 2; ++bj) { const f32x4 a = acc[ai][bj][m][0], b = acc[ai][bj][m][1];
                        float ss = (a.x * a.x + a.y * a.y) + (a.z * a.z + a.w * a.w) + (b.x * b.x + b.y * b.y) + (b.z * b.z + b.w * b.w);
                        ss += __shfl_xor(ss, 16); ss += __shfl_xor(ss, 32);
                        if (fq == 0) part[((ai * 128 + wr * 64 + m * 16 + fr) * 2 + bj) * 4 + wc] = ss; }
            LDS_WAIT(); __builtin_amdgcn_s_barrier(); asm volatile("" ::: "memory");
#pragma unroll
            for (int ai = 0; ai < 2; ++ai)
#pragma unroll
                for (int m = 0; m < 4; ++m) { const int rl = ai * 128 + wr * 64 + m * 16 + fr, row = u.pm * 256 + rl, sq = row & (S - 1);
                    const int rp = (row & ~(S - 1)) + ((sq & ((1 << l2d) - 1)) << (13 - l2d)) + (sq >> l2d);
                    f32x4 c0 = {0, 0, 0, 0}, c1 = c0, s0 = c0, s1 = c0;
                    if (ropew) { const u32x4 cc = rcs[ai][m][0], sn = rcs[ai][m][1];
                        c0 = (f32x4){bf_lo(cc.x), bf_hi(cc.x), bf_lo(cc.y), bf_hi(cc.y)}; c1 = (f32x4){bf_lo(cc.z), bf_hi(cc.z), bf_lo(cc.w), bf_hi(cc.w)};
                        s0 = (f32x4){bf_lo(sn.x), bf_hi(sn.x), bf_lo(sn.y), bf_hi(sn.y)}; s1 = (f32x4){bf_lo(sn.z), bf_hi(sn.z), bf_lo(sn.w), bf_hi(sn.w)};
                        if (fq == 0) { s0 = -s0; s1 = -s1; } }
#pragma unroll
                    for (int bj = 0; bj < 2; ++bj) {
                        const float tot = part[(rl * 2 + bj) * 4 + wc] + part[(rl * 2 + bj) * 4 + (wc ^ 1)];
                        const float rinv = __builtin_amdgcn_rsqf(tot * (1.f / 64.f) + RMS_EPS);
                        f32x4 v0 = acc[ai][bj][m][0] * rinv * g0, v1 = acc[ai][bj][m][1] * rinv * g1;
                        if (ropew) {
                            f32x4 p0, p1;
                            p0.x = __shfl_xor(v0.x, 16); p0.y = __shfl_xor(v0.y, 16); p0.z = __shfl_xor(v0.z, 16); p0.w = __shfl_xor(v0.w, 16);
                            p1.x = __shfl_xor(v1.x, 16); p1.y = __shfl_xor(v1.y, 16); p1.z = __shfl_xor(v1.z, 16); p1.w = __shfl_xor(v1.w, 16);
                            if (fq < 2) { v0 = v0 * c0 + p0 * s0; v1 = v1 * c1 + p1 * s1; }
                        }
                        v0 = v0 * sc; v1 = v1 * sc; const int head = hbase + 2 * bj + (wc >> 1);
                        u32x4 w; w.x = pk2(v0.x, v0.y); w.y = pk2(v0.z, v0.w); w.z = pk2(v1.x, v1.y); w.w = pk2(v1.z, v1.w);
                        *(u32x4*)(proj + ((size_t)(typ * 16 + head) * T + rp) * 64 + ch) = w; } }
        }
    }
};

struct EpiBranch {
    static constexpr bool PERM = true;
    const unsigned char* gates; unsigned char* merged;
    DI void operator()(const f32x4 (&acc)[2][2][4][2], const pg8::Unit& u, int wr, int wc, int fr, int fq, LAS unsigned char*) const {
        asm volatile("" : "+v"(fr), "+v"(fq));
        const int row0 = u.pm * 256 + wr * 64 + fr, col0 = u.pn * 128 + wc * 32 + 8 * fq;
        u32x2 gd[2][4], gs[2][4];
#pragma unroll
        for (int ai = 0; ai < 2; ++ai)
#pragma unroll
            for (int m = 0; m < 4; ++m) { const size_t row = (size_t)(row0 + ai * 128 + m * 16);
                gd[ai][m] = *(const u32x2*)(gates + row * LDG + col0); gs[ai][m] = *(const u32x2*)(gates + row * LDG + 1024 + col0); }
        __builtin_amdgcn_sched_barrier(0);
#pragma unroll
        for (int ai = 0; ai < 2; ++ai)
#pragma unroll
            for (int m = 0; m < 4; ++m) { const size_t row = (size_t)(row0 + ai * 128 + m * 16);
                const u32x2 g = gd[ai][m], q = gs[ai][m];
                const f32x2 ga = fp8_lo2(g.x), gb = fp8_hi2(g.x), gc = fp8_lo2(g.y), gdd = fp8_hi2(g.y), qa = fp8_lo2(q.x), qb = fp8_hi2(q.x), qc = fp8_lo2(q.y), qd = fp8_hi2(q.y);
                const f32x4 v0 = acc[ai][0][m][0] * (f32x4){sigmoidf(ga.x), sigmoidf(ga.y), sigmoidf(gb.x), sigmoidf(gb.y)} + acc[ai][1][m][0] * (f32x4){sigmoidf(qa.x), sigmoidf(qa.y), sigmoidf(qb.x), sigmoidf(qb.y)};
                const f32x4 v1 = acc[ai][0][m][1] * (f32x4){sigmoidf(gc.x), sigmoidf(gc.y), sigmoidf(gdd.x), sigmoidf(gdd.y)} + acc[ai][1][m][1] * (f32x4){sigmoidf(qc.x), sigmoidf(qc.y), sigmoidf(qd.x), sigmoidf(qd.y)};
                u32x2 w; w.x = pk4_fp8(8.f * v0.x, 8.f * v0.y, 8.f * v0.z, 8.f * v0.w); w.y = pk4_fp8(8.f * v1.x, 8.f * v1.y, 8.f * v1.z, 8.f * v1.w);
                *(u32x2*)(merged + row * 1024 + col0) = w; }
    }
};
struct BranchSched {
    static constexpr bool GATHER = false;
    int G, c; int pa, pb; unsigned A, B;
    DI bool next(int i, pg8::Unit& u) const {
        const int tile = (i >> 1) * G + c; if (tile >= 256 * 4) return false;
        u.pm = tile >> 2; u.pn = tile & 3; u.aux = i & 1;
        u.a = A + (unsigned)(u.pm * 256 * LDO * 2 + u.aux * 256 * 2); u.b = B + (unsigned)(u.aux * 1024 * 256 * 2 + u.pn * 256 * 256 * 2); return true;
    }
    DI void offs(const pg8::Unit&, const int (&RA)[2], const int (&CA)[2], unsigned (&v)[4]) const {
#pragma unroll
        for (int h = 0; h < 2; ++h)
#pragma unroll
            for (int i = 0; i < 2; ++i) v[h * 2 + i] = (unsigned)((h * 128 + RA[i]) * pa + CA[i] * 2);
    }
};

struct EpiOut {
    static constexpr bool PERM = true;
    bf16_t* upd; const float* mod;
    DI void operator()(const f32x4 (&acc)[2][2][4][2], const pg8::Unit& u, int wr, int wc, int fr, int fq, LAS unsigned char*) const {
        asm volatile("" : "+v"(fr), "+v"(fq));
        const int row0 = u.pm * 256 + wr * 64 + fr, col0 = u.pn * 256 + wc * 32 + 8 * fq; const int b = (u.pm * 256) >> 13;
        f32x4 gv[2][2];
#pragma unroll
        for (int bj = 0; bj < 2; ++bj)
#pragma unroll
            for (int n = 0; n < 2; ++n) gv[bj][n] = *(const f32x4*)(mod + b * 6144 + 2048 + col0 + bj * 128 + n * 4) * 0.125f;
#pragma unroll
        for (int ai = 0; ai < 2; ++ai)
#pragma unroll
            for (int m = 0; m < 4; ++m)
#pragma unroll
                for (int bj = 0; bj < 2; ++bj) { const f32x4 v0 = acc[ai][bj][m][0] * gv[bj][0], v1 = acc[ai][bj][m][1] * gv[bj][1];
                    u32x4 w; w.x = pk2(v0.x, v0.y); w.y = pk2(v0.z, v0.w); w.z = pk2(v1.x, v1.y); w.w = pk2(v1.z, v1.w);
                    *(u32x4*)(upd + (size_t)(row0 + ai * 128 + m * 16) * 1024 + col0 + bj * 128) = w; }
    }
};

struct EpiLogit {
    static constexpr bool PERM = false;
    float* logit;
    DI void operator()(const f32x4 (&acc)[2][2][4][2], const pg8::Unit& u, int wr, int wc, int fr, int fq, LAS unsigned char*) const {
        asm volatile("" : "+v"(fr), "+v"(fq));
        const int row0 = u.pm * 256 + wr * 64 + fr, col0 = wc * 32 + 4 * fq;
#pragma unroll
        for (int ai = 0; ai < 2; ++ai)
#pragma unroll
            for (int m = 0; m < 4; ++m)
#pragma unroll
                for (int n = 0; n < 2; ++n) *(f32x4*)(logit + (size_t)(row0 + ai * 128 + m * 16) * 128 + col0 + n * 16) = acc[ai][0][m][n];
    }
};

struct MoeSched {
    static constexpr bool GATHER_ = true;
    int G, c, nc; int pa, pb; unsigned A, B; const LAS int* cstart; const int* slot_tok; unsigned estride, pnstride;
};
struct MoeSchedUp : MoeSched {
    static constexpr bool GATHER = true, BLOCKDIAG = false;
    DI bool next(int i, pg8::Unit& u) const {
        const int L = i * G + c; if (L >= nc * 4) return false;
        const int chunk = L >> 2; int e = 0;
        for (int q = 1; q < 32; ++q) e += (chunk >= cstart[q]) ? 1 : 0;
        e = __builtin_amdgcn_readfirstlane(e);
        u.pm = chunk; u.pn = L & 3; u.aux = e; u.a = A; u.b = B + (unsigned)e * estride + (unsigned)u.pn * pnstride; return true;
    }
    DI void offs(const pg8::Unit& u, const int (&RA)[2], const int (&CA)[2], unsigned (&v)[4]) const {
#pragma unroll
        for (int h = 0; h < 2; ++h)
#pragma unroll
            for (int i = 0; i < 2; ++i) { const int tok = slot_tok[u.pm * 256 + h * 128 + RA[i]]; v[h * 2 + i] = (unsigned)(tok * pa + CA[i] * 2); }
    }
    DI void rows(const pg8::Unit& u, const int (&RA)[2], unsigned (&v)[4]) const {
#pragma unroll
        for (int h = 0; h < 2; ++h)
#pragma unroll
            for (int i = 0; i < 2; ++i) v[h * 2 + i] = (unsigned)slot_tok[u.pm * 256 + h * 128 + RA[i]];
    }
};
struct MoeSchedDn : MoeSched {
    static constexpr bool GATHER = false, BLOCKDIAG = false;
    DI bool next(int i, pg8::Unit& u) const {
        const int L = i * G + c; if (L >= nc * 4) return false;
        const int chunk = L >> 2; int e = 0;
        for (int q = 1; q < 32; ++q) e += (chunk >= cstart[q]) ? 1 : 0;
        e = __builtin_amdgcn_readfirstlane(e);
        u.pm = chunk; u.pn = L & 3; u.aux = e; u.a = A + (unsigned)(chunk * 256 * pa); u.b = B + (unsigned)e * estride + (unsigned)u.pn * pnstride; return true;
    }
    DI void offs(const pg8::Unit&, const int (&RA)[2], const int (&CA)[2], unsigned (&v)[4]) const {
#pragma unroll
        for (int h = 0; h < 2; ++h)
#pragma unroll
            for (int i = 0; i < 2; ++i) v[h * 2 + i] = (unsigned)((h * 128 + RA[i]) * pa + CA[i] * 2);
    }
};
struct EpiSwiglu {
    static constexpr bool PERM = true;
    unsigned char* hmid;
    DI void operator()(const f32x4 (&acc)[2][2][4][2], const pg8::Unit& u, int wr, int wc, int fr, int fq, LAS unsigned char*) const {
        asm volatile("" : "+v"(fr), "+v"(fq));
        const int row0 = u.pm * 256 + wr * 64 + fr, col0 = u.pn * 128 + wc * 32 + 8 * fq;
#pragma unroll
        for (int ai = 0; ai < 2; ++ai)
#pragma unroll
            for (int m = 0; m < 4; ++m) {
                f32x4 h[2];
#pragma unroll
                for (int n = 0; n < 2; ++n) { const f32x4 g = acc[ai][0][m][n], up = acc[ai][1][m][n];
                    h[n] = (f32x4){g.x * sigmoidf(g.x) * up.x, g.y * sigmoidf(g.y) * up.y, g.z * sigmoidf(g.z) * up.z, g.w * sigmoidf(g.w) * up.w}; }
                u32x2 w; w.x = pk4_fp8(h[0].x, h[0].y, h[0].z, h[0].w); w.y = pk4_fp8(h[1].x, h[1].y, h[1].z, h[1].w);
                *(u32x2*)(hmid + (size_t)(row0 + ai * 128 + m * 16) * DE + col0) = w; }
    }
};
struct EpiDown {
    static constexpr bool PERM = true;
    unsigned char* y;
    DI void operator()(const f32x4 (&acc)[2][2][4][2], const pg8::Unit& u, int wr, int wc, int fr, int fq, LAS unsigned char*) const {
        asm volatile("" : "+v"(fr), "+v"(fq));
        const int row0 = u.pm * 256 + wr * 64 + fr, col0 = u.pn * 256 + wc * 32 + 8 * fq;
#pragma unroll
        for (int ai = 0; ai < 2; ++ai)
#pragma unroll
            for (int m = 0; m < 4; ++m) { const int slot = row0 + ai * 128 + m * 16;
#pragma unroll
                for (int bj = 0; bj < 2; ++bj) { const f32x4 v0 = acc[ai][bj][m][0] * 8.f, v1 = acc[ai][bj][m][1] * 8.f;
                    u32x2 o; o.x = pk4_fp8(v0.x, v0.y, v0.z, v0.w); o.y = pk4_fp8(v1.x, v1.y, v1.z, v1.w);
                    *(u32x2*)(y + (size_t)slot * 1024 + col0 + bj * 128) = o; } }
    }
};

constexpr int SLOT_BYTES = 8192;
DI f32x16 mfma32(bf16x8 a, bf16x8 b, f32x16 c) { return __builtin_amdgcn_mfma_f32_32x32x16_bf16(a, b, c, 0, 0, 0); }
DI int swz_f(int r) { return (((r >> 1) & 1) << 2) | ((r >> 2) & 3); }
struct AttnLane { unsigned doff[4]; unsigned ka[4]; unsigned va[2][2]; };
DI void attn_lane_init(AttnLane& L, int lane) {
#pragma unroll
    for (int i = 0; i < 4; ++i) { const int r = 8 * i + (lane >> 3), c = (lane & 7) ^ swz_f(r); L.doff[i] = (unsigned)(r * 128 + c * 16); }
    { const int r = lane & 31, h = lane >> 5; const unsigned a0 = (unsigned)(r * 128 + 16 * ((h ^ swz_f(r)) & 7));
#pragma unroll
      for (int s = 0; s < 4; ++s) L.ka[s] = a0 ^ (unsigned)(32 * s); }
    { const int h = lane >> 5, blk = (lane >> 4) & 1, q = (lane & 15) >> 2, p = lane & 3, fb2 = (q >> 1) & 1;
#pragma unroll
      for (int t = 0; t < 2; ++t) { const int flow = (2 * t + h) & 3;
#pragma unroll
        for (int mt = 0; mt < 2; ++mt) L.va[t][mt] = (unsigned)(4096 + (8 * t + 4 * h + q) * 128 + 16 * (4 * (mt ^ fb2) + ((2 * blk + (p >> 1)) ^ flow)) + 8 * (p & 1)); } }
}
DI void dma_tile(const AttnLane& L, const __amdgpu_buffer_rsrc_t rs, unsigned koff, unsigned voff, LAS unsigned char* slot) {
#pragma unroll
    for (int i = 0; i < 4; ++i) __builtin_amdgcn_raw_ptr_buffer_load_lds(rs, (LAS unsigned*)(slot + 1024 * i), 16, (int)L.doff[i], (int)koff, 0, 0);
#pragma unroll
    for (int i = 0; i < 4; ++i) __builtin_amdgcn_raw_ptr_buffer_load_lds(rs, (LAS unsigned*)(slot + 4096 + 1024 * i), 16, (int)L.doff[i], (int)voff, 0, 0);
}
DI void tr_read8(const AttnLane& L, unsigned sb, bf16x8 (&vf)[2][2]) {
    s16x4 r0, r1, r2, r3, r4, r5, r6, r7;
    const unsigned a00 = sb + L.va[0][0], a10 = sb + L.va[1][0], a01 = sb + L.va[0][1], a11 = sb + L.va[1][1];
    asm volatile("ds_read_b64_tr_b16 %0, %8\n\tds_read_b64_tr_b16 %1, %9\n\tds_read_b64_tr_b16 %2, %8 offset:2048\n\tds_read_b64_tr_b16 %3, %9 offset:2048\n\t"
                 "ds_read_b64_tr_b16 %4, %10\n\tds_read_b64_tr_b16 %5, %11\n\tds_read_b64_tr_b16 %6, %10 offset:2048\n\tds_read_b64_tr_b16 %7, %11 offset:2048\n\ts_waitcnt lgkmcnt(0)"
                 : "=&v"(r0), "=&v"(r1), "=&v"(r2), "=&v"(r3), "=&v"(r4), "=&v"(r5), "=&v"(r6), "=&v"(r7)
                 : "v"(a00), "v"(a10), "v"(a01), "v"(a11) : "memory");
    vf[0][0] = __builtin_shufflevector(r0, r1, 0, 1, 2, 3, 4, 5, 6, 7); vf[0][1] = __builtin_shufflevector(r2, r3, 0, 1, 2, 3, 4, 5, 6, 7);
    vf[1][0] = __builtin_shufflevector(r4, r5, 0, 1, 2, 3, 4, 5, 6, 7); vf[1][1] = __builtin_shufflevector(r6, r7, 0, 1, 2, 3, 4, 5, 6, 7);
}
DI bf16x8 pack8(const f32x16& x, int s) {
    u32x4 p; p.x = pk2(x[8 * s], x[8 * s + 1]); p.y = pk2(x[8 * s + 2], x[8 * s + 3]); p.z = pk2(x[8 * s + 4], x[8 * s + 5]); p.w = pk2(x[8 * s + 6], x[8 * s + 7]);
    return __builtin_bit_cast(bf16x8, p);
}
DI void store_o_row(bf16_t* rowp, const f32x16& O0, const f32x16& O1, float sc, int h) {
#pragma unroll
    for (int mt = 0; mt < 2; ++mt)
#pragma unroll
        for (int kp = 0; kp < 2; ++kp) { const f32x16& O = mt ? O1 : O0; const int g0 = 8 * kp, g1 = 8 * kp + 4;
            u32x2 a, b; a.x = pk2(O[g0] * sc, O[g0 + 1] * sc); a.y = pk2(O[g0 + 2] * sc, O[g0 + 3] * sc); b.x = pk2(O[g1] * sc, O[g1 + 1] * sc); b.y = pk2(O[g1 + 2] * sc, O[g1 + 3] * sc);
            { auto r = __builtin_amdgcn_permlane32_swap(a.x, b.x, false, false); a.x = r[0]; b.x = r[1]; }
            { auto r = __builtin_amdgcn_permlane32_swap(a.y, b.y, false, false); a.y = r[0]; b.y = r[1]; }
            *(u32x4*)(rowp + 32 * mt + 16 * kp + 8 * h) = (u32x4){a.x, a.y, b.x, b.y}; }
}
DI void store_o_row_fp8(unsigned char* rowp, const f32x16& O0, const f32x16& O1, int h) {
#pragma unroll
    for (int mt = 0; mt < 2; ++mt)
#pragma unroll
        for (int kp = 0; kp < 2; ++kp) { const f32x16& O = mt ? O1 : O0; const int g0 = 8 * kp, g1 = 8 * kp + 4;
            unsigned a = pk4_fp8(O[g0], O[g0 + 1], O[g0 + 2], O[g0 + 3]), b = pk4_fp8(O[g1], O[g1 + 1], O[g1 + 2], O[g1 + 3]);
            { auto r = __builtin_amdgcn_permlane32_swap(a, b, false, false); a = r[0]; b = r[1]; }
            *(u32x2*)(rowp + 32 * mt + 16 * kp + 8 * h) = (u32x2){a, b}; }
}
#define ATTN_WAIT_TILE(more) do { if (more) asm volatile("s_waitcnt vmcnt(8)" ::: "memory"); else asm volatile("s_waitcnt vmcnt(0)" ::: "memory"); } while (0)
DI void dil_tile(const AttnLane& L, const __amdgpu_buffer_rsrc_t rs, const bf16_t* hb, int hd, long row0, int j, LAS unsigned char* ldsW, bf16_t* og, float* lse, int lane) {
    const int qi = lane & 31, h = lane >> 5;
    const bf16_t* qh = hb + (size_t)hd * T * 64;
    const unsigned kh = (unsigned)(WS_PROJ + ((size_t)(16 + hd) * T + row0) * 128), vh = (unsigned)(WS_PROJ + ((size_t)(32 + hd) * T + row0) * 128);
    bf16x8 qf[4];
    { const bf16_t* qp = qh + (size_t)(row0 + 32 * j + qi) * 64 + 8 * h;
#pragma unroll
      for (int s = 0; s < 4; ++s) qf[s] = *(const bf16x8*)(qp + 16 * s); }
    float mrun = -INFINITY, lrun = 0.f;
    f32x16 O0, O1;
#pragma unroll
    for (int i = 0; i < 16; ++i) { O0[i] = 0.f; O1[i] = 0.f; }
    const int kt0 = j >= 4 ? j - 4 : 0;
    dma_tile(L, rs, kh + (unsigned)(4096 * kt0), vh + (unsigned)(4096 * kt0), ldsW);
    unsigned buf = 0;
    for (int kt = kt0; kt <= j; ++kt) {
        const bool more = kt < j;
        if (more) dma_tile(L, rs, kh + (unsigned)(4096 * (kt + 1)), vh + (unsigned)(4096 * (kt + 1)), ldsW + (buf ^ 1u) * SLOT_BYTES);
        ATTN_WAIT_TILE(more);
        LAS unsigned char* slot = ldsW + buf * SLOT_BYTES;
        f32x16 sc;
#pragma unroll
        for (int i = 0; i < 16; ++i) sc[i] = 0.f;
#pragma unroll
        for (int s = 0; s < 4; ++s) { const bf16x8 kf = *(const LAS bf16x8*)(slot + L.ka[s]); sc = mfma32(kf, qf[s], sc); }
        if (kt == j) {
#pragma unroll
            for (int i = 0; i < 16; ++i) { const int key = (i & 3) + 8 * (i >> 2) + 4 * h; if (key > qi) sc[i] = -INFINITY; }
        }
        if (kt == j - 4) {
#pragma unroll
            for (int i = 0; i < 16; ++i) { const int key = (i & 3) + 8 * (i >> 2) + 4 * h; if (key < qi) sc[i] = -INFINITY; }
        }
        float mx = sc[0];
#pragma unroll
        for (int i = 1; i < 16; ++i) mx = fmaxf(mx, sc[i]);
        mx = fmaxf(mx, __shfl_xor(mx, 32));
        const float mnew = fmaxf(mrun, mx), alpha = fexp2(mrun - mnew);
        float ps = 0.f;
#pragma unroll
        for (int i = 0; i < 16; ++i) { sc[i] = fexp2(sc[i] - mnew); ps += sc[i]; }
        lrun = lrun * alpha + ps; mrun = mnew;
#pragma unroll
        for (int i = 0; i < 16; ++i) { O0[i] *= alpha; O1[i] *= alpha; }
        const bf16x8 p0 = pack8(sc, 0), p1 = pack8(sc, 1);
        bf16x8 vf[2][2]; tr_read8(L, (unsigned)(size_t)slot, vf);
        O0 = mfma32(vf[0][0], p0, O0); O0 = mfma32(vf[0][1], p1, O0);
        O1 = mfma32(vf[1][0], p0, O1); O1 = mfma32(vf[1][1], p1, O1);
        buf ^= 1u;
    }
    const float ltot = lrun + __shfl_xor(lrun, 32), inv = frcp(ltot);
    const size_t row = (size_t)(row0 + 32 * j + qi);
    store_o_row(og + row * 64, O0, O1, inv, h);
    if (h == 0) lse[row] = mrun + flog2(ltot);
}
DI void sb_tile(const AttnLane& L, const __amdgpu_buffer_rsrc_t rs, const bf16_t* hb, int b, int h4, int j, LAS unsigned char* ldsW, unsigned char* ocat, int lane) {
    const int qi = lane & 31, h = lane >> 5;
    const long base = (long)b * S;
    const bf16_t* qh = hb + (size_t)(12 + h4) * T * 64;
    const unsigned kh = (unsigned)(WS_PROJ + ((size_t)(16 + 12 + h4) * T + base) * 128), vh = (unsigned)(WS_PROJ + ((size_t)(32 + 12 + h4) * T + base) * 128);
    bf16x8 qf[4];
    { const bf16_t* qp = qh + (size_t)(base + 32 * j + qi) * 64 + 8 * h;
#pragma unroll
      for (int s = 0; s < 4; ++s) qf[s] = *(const bf16x8*)(qp + 16 * s); }
    float carry = 0.f;
    f32x16 O0, O1;
#pragma unroll
    for (int i = 0; i < 16; ++i) { O0[i] = 0.f; O1[i] = 0.f; }
    dma_tile(L, rs, kh + (unsigned)(4096 * j), vh + (unsigned)(4096 * j), ldsW);
    unsigned buf = 0;
    for (int kt = j; kt >= 0; --kt) {
        const bool more = kt > 0;
        if (more) dma_tile(L, rs, kh + (unsigned)(4096 * (kt - 1)), vh + (unsigned)(4096 * (kt - 1)), ldsW + (buf ^ 1u) * SLOT_BYTES);
        ATTN_WAIT_TILE(more);
        LAS unsigned char* slot = ldsW + buf * SLOT_BYTES;
        f32x16 z;
#pragma unroll
        for (int i = 0; i < 16; ++i) z[i] = 0.f;
#pragma unroll
        for (int s = 0; s < 4; ++s) { const bf16x8 kf = *(const LAS bf16x8*)(slot + L.ka[s]); z = mfma32(kf, qf[s], z); }
#pragma unroll
        for (int i = 0; i < 16; ++i) z[i] = fexp2(fminf(z[i], 31.f));
        if (kt == j) {
#pragma unroll
            for (int i = 0; i < 16; ++i) { const int key = (i & 3) + 8 * (i >> 2) + 4 * h; if (key >= qi) z[i] = 0.f; }
        }
        float lg[4], par[4], u0[4], p01[4], p012[4];
#pragma unroll
        for (int g = 0; g < 4; ++g) { const float a0 = 1.f + z[4 * g], a1 = 1.f + z[4 * g + 1], a2 = 1.f + z[4 * g + 2], a3 = 1.f + z[4 * g + 3];
            u0[g] = a0; p01[g] = a0 * a1; p012[g] = p01[g] * a2; lg[g] = -flog2(p012[g] * a3); }
#pragma unroll
        for (int g = 0; g < 4; ++g) par[g] = __shfl_xor(lg[g], 32);
        float tg[4]; tg[3] = carry; tg[2] = tg[3] + (lg[3] + par[3]); tg[1] = tg[2] + (lg[2] + par[2]); tg[0] = tg[1] + (lg[1] + par[1]);
        carry = tg[0] + (lg[0] + par[0]);
#pragma unroll
        for (int g = 0; g < 4; ++g) { const float suf = tg[g] + lg[g] + (h == 0 ? par[g] : 0.f); const float y = fexp2(suf);
            z[4 * g] = z[4 * g] * y; z[4 * g + 1] = z[4 * g + 1] * (y * u0[g]); z[4 * g + 2] = z[4 * g + 2] * (y * p01[g]); z[4 * g + 3] = z[4 * g + 3] * (y * p012[g]); }
        const bf16x8 p0 = pack8(z, 0), p1 = pack8(z, 1);
        bf16x8 vf[2][2]; tr_read8(L, (unsigned)(size_t)slot, vf);
        O0 = mfma32(vf[0][0], p0, O0); O0 = mfma32(vf[0][1], p1, O0);
        O1 = mfma32(vf[1][0], p0, O1); O1 = mfma32(vf[1][1], p1, O1);
        if (__all(carry < -40.f)) break;
        buf ^= 1u;
    }
    store_o_row_fp8(ocat + (size_t)(base + 32 * j + qi) * LDO + 256 + h4 * 64, O0, O1, h);
}
DI void phase_attn(const Frame& F, const Params& p) {
    const int tid_ = fresh_tid(), lane_ = tid_ & 63;
    const bf16_t* hb = (const bf16_t*)(F.ws + WS_PROJ); unsigned char* ocat = F.ws + WS_OCAT;
    bf16_t* og = (bf16_t*)(F.ws + WS_OG); float* lse = (float*)(F.ws + WS_LSE);
    LAS unsigned char* ldsW = F.lds + F.wave * (2 * SLOT_BYTES);
    AttnLane L; attn_lane_init(L, lane_);
    const __amdgpu_buffer_rsrc_t rs = __builtin_amdgcn_make_buffer_rsrc(F.ws, 0, (int)WS_END, 0x00020000);
    const int NU = NB * 4 * 16;
    for (int i = 0;; ++i) {
        const int u = (F.G == 256) ? ((F.bid & 7) * 32 + (F.bid >> 3) + 256 * i) : (F.bid + F.G * i);
        if (u >= NU) break;
        const int qb = u & 15, hs = (u >> 4) & 3, b = u >> 6, t0 = qb * 512;
        for (int w = F.wave; w < 16; w += 8) sb_tile(L, rs, hb, b, hs, t0 / 32 + w, ldsW, ocat, lane_);
        for (int w = F.wave; w < 48; w += 8) {
            const int g = w >> 4, ti = w & 15, l2d = 2 * g, per = 16 >> l2d, r = ti / per, jj = ti % per;
            dil_tile(L, rs, hb, g * 4 + hs, (long)b * S + (long)r * (S >> l2d), ((t0 >> l2d) >> 5) + jj, ldsW, og + (size_t)(g * 4 + hs) * T * 64, lse + (size_t)(g * 4 + hs) * T, lane_);
        }
        VM_WAIT();
        __syncthreads();
        {
            const int piece = tid_ & 7; const size_t bb = (size_t)b * S;
#pragma unroll 2
            for (int pass = 0; pass < 8; ++pass) {
                const int sq = t0 + pass * 64 + (tid_ >> 3);
                const size_t r0 = bb + sq, r1 = bb + ((size_t)(sq & 3) << 11) + (sq >> 2), r2 = bb + ((size_t)(sq & 15) << 9) + (sq >> 4);
                const float l0 = lse[(size_t)(0 + hs) * T + r0], l1 = lse[(size_t)(4 + hs) * T + r1], l2 = lse[(size_t)(8 + hs) * T + r2];
                const u32x4 x = *((const u32x4*)(og + ((size_t)(0 + hs) * T + r0) * 64) + piece), y = *((const u32x4*)(og + ((size_t)(4 + hs) * T + r1) * 64) + piece), z = *((const u32x4*)(og + ((size_t)(8 + hs) * T + r2) * 64) + piece);
                const float mx = fmaxf(l0, fmaxf(l1, l2)); float w0 = fexp2(l0 - mx), w1 = fexp2(l1 - mx), w2 = fexp2(l2 - mx); const float inv = frcp(w0 + w1 + w2); w0 *= inv; w1 *= inv; w2 *= inv;
                u32x2 r;
                r.x = pk4_fp8(w0 * bf_lo(x.x) + w1 * bf_lo(y.x) + w2 * bf_lo(z.x), w0 * bf_hi(x.x) + w1 * bf_hi(y.x) + w2 * bf_hi(z.x), w0 * bf_lo(x.y) + w1 * bf_lo(y.y) + w2 * bf_lo(z.y), w0 * bf_hi(x.y) + w1 * bf_hi(y.y) + w2 * bf_hi(z.y));
                r.y = pk4_fp8(w0 * bf_lo(x.z) + w1 * bf_lo(y.z) + w2 * bf_lo(z.z), w0 * bf_hi(x.z) + w1 * bf_hi(y.z) + w2 * bf_hi(z.z), w0 * bf_lo(x.w) + w1 * bf_lo(y.w) + w2 * bf_lo(z.w), w0 * bf_hi(x.w) + w1 * bf_hi(y.w) + w2 * bf_hi(z.w));
                *((u32x2*)(ocat + (bb + sq) * LDO + hs * 64) + piece) = r;
            }
        }
        __syncthreads();
    }
}

DI void route_rows(const Frame& F, const Params& p, int pm) {
    const int tid_ = fresh_tid(), lane_ = tid_ & 63;
    LAS int* hist = (LAS int*)(F.lds);
    const int ftid = fresh_tid();
    __syncthreads();
    if (ftid < 32) hist[ftid] = 0;
    __syncthreads();
    if (tid_ < 256) {
        const int row = pm * 256 + tid_; const float* L = (const float*)(F.ws + WS_LOGIT) + (size_t)row * 128;
        const float* brg = p.in[I_BRG]; const float* bre = p.in[I_BRE];
        float lgp[4];
#pragma unroll
        for (int c = 0; c < 4; ++c) lgp[c] = L[c] + L[36 + c] + brg[c];
        int gsel = 0; float gm = lgp[0];
#pragma unroll
        for (int c = 1; c < 4; ++c) if (lgp[c] > gm) { gm = lgp[c]; gsel = c; }
        float zs = 0.f;
#pragma unroll
        for (int c = 0; c < 4; ++c) zs += fexp2((lgp[c] - gm) * LOG2E);
        const float pg = frcp(zs);
        float l1 = -INFINITY, l2 = -INFINITY; int e1 = 0, e2 = 0;
#pragma unroll
        for (int i = 0; i < 8; ++i) { const int c = 4 + gsel * 8 + i; const float v = L[c] + L[36 + c] + bre[gsel * 8 + i];
            if (v > l1) { l2 = l1; e2 = e1; l1 = v; e1 = i; } else if (v > l2) { l2 = v; e2 = i; } }
        const float ex = fexp2((l2 - l1) * LOG2E), den = frcp(1.f + ex);
        int* te = (int*)(F.ws + WS_TOKE) + (size_t)row * 2; float* tw = (float*)(F.ws + WS_TOKW) + (size_t)row * 2;
        te[0] = gsel * 8 + e1; te[1] = gsel * 8 + e2; tw[0] = pg * den; tw[1] = pg * ex * den;
        lds_add(&hist[gsel * 8 + e1], 1); lds_add(&hist[gsel * 8 + e2], 1);
    }
    __syncthreads();
    if (ftid < 32) ((int*)(F.ws + WS_HIST))[pm * 32 + ftid] = hist[ftid];
}


DI void router_weights_to_lds(const Frame& F, const Params& p) {
    const int tid_ = fresh_tid(), lane_ = tid_ & 63;
    constexpr int WP = 1028;
    LAS float* wt = (LAS float*)(F.lds + LDS_RW); LAS float* bias = (LAS float*)(F.lds + LDS_RS) + 8 * 80 + 32;
    const float* wrg = p.in[I_WRG]; const float* wre = p.in[I_WRE]; const float* brg = p.in[I_BRG]; const float* bre = p.in[I_BRE];
    const int ftid = fresh_tid();
    __syncthreads();
#pragma unroll 8
    for (int i = ftid; i < 1024 * 32; i += 512) wt[(4 + (i & 31)) * WP + (i >> 5)] = wre[i];
#pragma unroll 8
    for (int i = ftid; i < 1024 * 4; i += 512) wt[(i & 3) * WP + (i >> 2)] = wrg[i];
    if (ftid < 36) bias[ftid] = ftid < 4 ? brg[ftid] : bre[ftid - 4];
}

DI void phase_norm2_route(const Frame& F, const Params& p) {
    const int tid_ = fresh_tid(), lane_ = tid_ & 63;
    constexpr int WP = 1028;
    LAS float* wt = (LAS float*)(F.lds + LDS_RW);
    LAS float* gs = (LAS float*)(F.lds + LDS_RV); LAS float* sh = gs + 1024;
    LAS float* scr = (LAS float*)(F.lds + LDS_RS) + F.wave * 80;
    LAS int* hist = (LAS int*)(F.lds + LDS_RS) + 8 * 80;
    LAS float* bias = (LAS float*)(F.lds + LDS_RS) + 8 * 80 + 32;
    const float* mod = (const float*)(F.ws + WS_MOD); const float* gn = p.in[I_GFFN];
    const bf16_t* upd = (const bf16_t*)(F.ws + WS_UPD1); unsigned* h8 = (unsigned*)(F.ws + WS_H28);
    const float* wrg = p.in[I_WRG]; const float* wre = p.in[I_WRE]; const float* brg = p.in[I_BRG]; const float* bre = p.in[I_BRE];
    const int ftid = fresh_tid();
    __syncthreads();
    for (int chunk = F.bid; chunk < T / 256; chunk += F.G) {
        const int b = chunk >> 5;
        __syncthreads();
        for (int col = ftid; col < 1024; col += 512) { gs[col] = gn[col] * (1.f + mod[b * 6144 + 4096 + col]); sh[col] = mod[b * 6144 + 3072 + col]; }
        if (ftid < 32) hist[ftid] = 0;
        __syncthreads();
        f32x4 vn[2][4]; u32x2 un[2][4];
#pragma unroll
        for (int r = 0; r < 2; ++r) { const int row = chunk * 256 + F.wave * 2 + r;
            const f32x4* xr = (const f32x4*)(p.in[I_X] + (size_t)row * 1024) + lane_; const u32x2* ur = (const u32x2*)(upd + (size_t)row * 1024) + lane_;
#pragma unroll
            for (int j = 0; j < 4; ++j) { vn[r][j] = xr[64 * j]; un[r][j] = ur[64 * j]; } }
        for (int rr = F.wave * 2; rr < 256; rr += 16) {
            const int row0 = chunk * 256 + rr;
            f32x4 y[2][4];
#pragma unroll
            for (int r = 0; r < 2; ++r) {
                const int row = row0 + r; float ss = 0.f;
#pragma unroll
                for (int j = 0; j < 4; ++j) { vn[r][j].x += bf_lo(un[r][j].x); vn[r][j].y += bf_hi(un[r][j].x); vn[r][j].z += bf_lo(un[r][j].y); vn[r][j].w += bf_hi(un[r][j].y);
                    ss += (vn[r][j].x * vn[r][j].x + vn[r][j].y * vn[r][j].y) + (vn[r][j].z * vn[r][j].z + vn[r][j].w * vn[r][j].w); }
                const float rinv = __builtin_amdgcn_rsqf(wave_sum(ss) * (1.f / 1024.f) + RMS_EPS);
#pragma unroll
                for (int j = 0; j < 4; ++j) { const f32x4 gj = *(const LAS f32x4*)(gs + 256 * j + 4 * lane_), sj = *(const LAS f32x4*)(sh + 256 * j + 4 * lane_);
                    y[r][j] = vn[r][j] * rinv * gj + sj; h8[(size_t)row * 256 + 64 * j + lane_] = pk4_fp8(y[r][j].x, y[r][j].y, y[r][j].z, y[r][j].w); }
            }
            if (rr + 16 < 256) {
#pragma unroll
                for (int r = 0; r < 2; ++r) { const int row = row0 + 16 + r;
                    const f32x4* xr = (const f32x4*)(p.in[I_X] + (size_t)row * 1024) + lane_; const u32x2* ur = (const u32x2*)(upd + (size_t)row * 1024) + lane_;
#pragma unroll
                    for (int j = 0; j < 4; ++j) { vn[r][j] = xr[64 * j]; un[r][j] = ur[64 * j]; } }
            }
            const bool up32 = (lane_ & 32) != 0, up16 = (lane_ & 16) != 0, up8 = (lane_ & 8) != 0, up4 = (lane_ & 4) != 0;
            {
                f32x2 ga[2][4], gb[2][4];
#pragma unroll
                for (int r = 0; r < 2; ++r)
#pragma unroll
                    for (int c = 0; c < 4; ++c) { ga[r][c] = (f32x2){0.f, 0.f}; gb[r][c] = ga[r][c]; }
#pragma unroll
                for (int c = 0; c < 4; ++c)
#pragma unroll
                    for (int j = 0; j < 4; ++j) { const f32x4 w = *(const LAS f32x4*)(wt + c * WP + 4 * lane_ + 256 * j); const f32x2 wl = {w.x, w.y}, wh = {w.z, w.w};
#pragma unroll
                        for (int r = 0; r < 2; ++r) { ga[r][c] = __builtin_elementwise_fma((f32x2){y[r][j].x, y[r][j].y}, wl, ga[r][c]); gb[r][c] = __builtin_elementwise_fma((f32x2){y[r][j].z, y[r][j].w}, wh, gb[r][c]); } }
                float k4[4];
#pragma unroll
                for (int c = 0; c < 4; ++c) { const f32x2 t0 = ga[0][c] + gb[0][c], t1 = ga[1][c] + gb[1][c]; const float p0 = t0.x + t0.y, p1 = t1.x + t1.y;
                    k4[c] = up32 ? p0 : p1; ga[0][c].x = up32 ? p1 : p0; }
#pragma unroll
                for (int c = 0; c < 4; ++c) k4[c] = ga[0][c].x + __shfl_xor(k4[c], 32);
                float k2[2];
#pragma unroll
                for (int i = 0; i < 2; ++i) k2[i] = (up16 ? k4[2 + i] : k4[i]) + __shfl_xor(up16 ? k4[i] : k4[2 + i], 16);
                float k1 = (up8 ? k2[1] : k2[0]) + __shfl_xor(up8 ? k2[0] : k2[1], 8);
                k1 += __shfl_xor(k1, 4); k1 += __shfl_xor(k1, 2); k1 += __shfl_xor(k1, 1);
                if ((lane_ & 7) == 0) scr[(lane_ >> 5) * 36 + ((lane_ >> 4) & 1) * 2 + ((lane_ >> 3) & 1)] = k1;
            }
            LDS_WAIT();
            int gsel[2];
#pragma unroll
            for (int r = 0; r < 2; ++r) { int gi = 0; float gm = scr[r * 36] + bias[0];
#pragma unroll
                for (int c = 1; c < 4; ++c) { const float v = scr[r * 36 + c] + bias[c]; if (v > gm) { gm = v; gi = c; } }
                gsel[r] = __builtin_amdgcn_readfirstlane(gi); }
            {
                float pe[2][8];
#pragma unroll
                for (int r = 0; r < 2; ++r) {
                    const LAS float* wb = wt + (4 + gsel[r] * 8) * WP + 4 * lane_;
#pragma unroll
                    for (int hh = 0; hh < 2; ++hh) {
                        f32x2 ea[4], eb[4];
#pragma unroll
                        for (int i = 0; i < 4; ++i) { ea[i] = (f32x2){0.f, 0.f}; eb[i] = ea[i]; }
#pragma unroll
                        for (int i = 0; i < 4; ++i)
#pragma unroll
                            for (int j = 0; j < 4; ++j) { const f32x4 w = *(const LAS f32x4*)(wb + (hh * 4 + i) * WP + 256 * j);
                                ea[i] = __builtin_elementwise_fma((f32x2){y[r][j].x, y[r][j].y}, (f32x2){w.x, w.y}, ea[i]); eb[i] = __builtin_elementwise_fma((f32x2){y[r][j].z, y[r][j].w}, (f32x2){w.z, w.w}, eb[i]); }
#pragma unroll
                        for (int i = 0; i < 4; ++i) { const f32x2 t = ea[i] + eb[i]; pe[r][hh * 4 + i] = t.x + t.y; }
                        __builtin_amdgcn_sched_barrier(0);
                    }
                }
                float e8[8], e4[4], e2[2];
#pragma unroll
                for (int i = 0; i < 8; ++i) e8[i] = (up32 ? pe[1][i] : pe[0][i]) + __shfl_xor(up32 ? pe[0][i] : pe[1][i], 32);
#pragma unroll
                for (int i = 0; i < 4; ++i) e4[i] = (up16 ? e8[4 + i] : e8[i]) + __shfl_xor(up16 ? e8[i] : e8[4 + i], 16);
#pragma unroll
                for (int i = 0; i < 2; ++i) e2[i] = (up8 ? e4[2 + i] : e4[i]) + __shfl_xor(up8 ? e4[i] : e4[2 + i], 8);
                float e1 = (up4 ? e2[1] : e2[0]) + __shfl_xor(up4 ? e2[0] : e2[1], 4);
                e1 += __shfl_xor(e1, 2); e1 += __shfl_xor(e1, 1);
                if ((lane_ & 3) == 0) scr[(lane_ >> 5) * 36 + 4 + ((lane_ >> 4) & 1) * 4 + ((lane_ >> 3) & 1) * 2 + ((lane_ >> 2) & 1)] = e1;
            }
            LDS_WAIT();
            if (lane_ < 2) {
                const LAS float* L = scr + lane_ * 36; const int row = row0 + lane_;
                float lgp[4];
#pragma unroll
                for (int c = 0; c < 4; ++c) lgp[c] = L[c] + bias[c];
                int gsel = 0; float gm = lgp[0];
#pragma unroll
                for (int c = 1; c < 4; ++c) if (lgp[c] > gm) { gm = lgp[c]; gsel = c; }
                float zs = 0.f;
#pragma unroll
                for (int c = 0; c < 4; ++c) zs += fexp2((lgp[c] - gm) * LOG2E);
                const float pg = frcp(zs);
                float l1 = -INFINITY, l2 = -INFINITY; int e1 = 0, e2 = 0;
#pragma unroll
                for (int i = 0; i < 8; ++i) { const float v = L[4 + i] + bias[4 + gsel * 8 + i];
                    if (v > l1) { l2 = l1; e2 = e1; l1 = v; e1 = i; } else if (v > l2) { l2 = v; e2 = i; } }
                const float ex = fexp2((l2 - l1) * LOG2E), den = frcp(1.f + ex);
                int* te = (int*)(F.ws + WS_TOKE) + (size_t)row * 2; float* tw = (float*)(F.ws + WS_TOKW) + (size_t)row * 2;
                te[0] = gsel * 8 + e1; te[1] = gsel * 8 + e2; tw[0] = pg * den; tw[1] = pg * ex * den;
                lds_add(&hist[gsel * 8 + e1], 1); lds_add(&hist[gsel * 8 + e2], 1);
            }
            LDS_WAIT();
        }
        __syncthreads();
        if (ftid < 32) ((int*)(F.ws + WS_HIST))[chunk * 32 + ftid] = hist[ftid];
    }
}

DI void phase_slots(const Frame& F, const Params& p) {
    const int tid_ = fresh_tid(), lane_ = tid_ & 63;
    LAS int* tot = (LAS int*)(F.lds); LAS int* bas = tot + 32; LAS int* pst = tot + 64; LAS int* wcnt = tot + 128;
    const int* hist = (const int*)(F.ws + WS_HIST);
    for (int pm = F.bid; pm < T / 256; pm += F.G) {
        const int ftid = fresh_tid();
        __syncthreads();
        if (ftid < 64) tot[ftid] = 0;
        __syncthreads();
        { const int e = tid_ & 31, part = tid_ >> 5; int t = 0, bs = 0;
          for (int q = part; q < T / 256; q += 16) { const int v = hist[q * 32 + e]; t += v; if (q < pm) bs += v; }
          lds_add(&tot[e], t); lds_add(&bas[e], bs); }
        __syncthreads();
        if (tid_ == 0) { int run = 0; for (int e = 0; e < 32; ++e) { pst[e] = run; run += (tot[e] + 255) / 256 * 256; } pst[32] = run; }
        const int my_e = ((const int*)(F.ws + WS_TOKE))[(size_t)pm * 512 + tid_];
        int rank = 0;
        for (int e = 0; e < 32; ++e) { const unsigned long long mask = __ballot(my_e == e); if (my_e == e) rank = __popcll(mask & ((1ull << lane_) - 1ull)); if (lane_ == 0) wcnt[F.wave * 32 + e] = __popcll(mask); }
        __syncthreads();
        int woff = 0;
        for (int w = 0; w < F.wave; ++w) woff += wcnt[w * 32 + my_e];
        const int slot = pst[my_e] + bas[my_e] + woff + rank;
        ((int*)(F.ws + WS_SLOTTOK))[slot] = pm * 256 + (tid_ >> 1);
        ((float*)(F.ws + WS_SLOTW))[slot] = ((const float*)(F.ws + WS_TOKW))[(size_t)pm * 512 + tid_];
        ((int*)(F.ws + WS_TOKS))[(size_t)pm * 512 + tid_] = slot;
        if (pm < 32) { const int e = pm; for (int s = pst[e] + tot[e] + tid_; s < pst[e + 1]; s += 512) { ((int*)(F.ws + WS_SLOTTOK))[s] = 0; ((float*)(F.ws + WS_SLOTW))[s] = 0.f; } }
        if (pm == 0 && tid_ < 34) { int* et = (int*)(F.ws + WS_ETAB); if (tid_ < 33) et[64 + tid_] = pst[tid_] >> 8; if (tid_ < 32) { et[tid_] = tot[tid_]; et[32 + tid_] = pst[tid_]; } if (tid_ == 33) et[97] = pst[32] >> 8; }
    }
}

DI void phase_combine(const Frame& F, const Params& p) {
    const int tid_ = fresh_tid(), lane_ = tid_ & 63;
    const unsigned* y = (const unsigned*)(F.ws + WS_Y); const int* ts = (const int*)(F.ws + WS_TOKS); const float* tw = (const float*)(F.ws + WS_TOKW); const float* mod = (const float*)(F.ws + WS_MOD);
    const int gw = F.bid * 8 + F.wave, NGW = F.G * 8;
    for (int row = gw; row < T; row += NGW) {
        const int s0 = ts[(size_t)row * 2], s1 = ts[(size_t)row * 2 + 1]; const float w0 = tw[(size_t)row * 2] * 0.125f, w1 = tw[(size_t)row * 2 + 1] * 0.125f;
        const f32x4* xr = (const f32x4*)(p.in[I_X] + (size_t)row * 1024) + lane_; f32x4* orow = (f32x4*)(p.out + (size_t)row * 1024) + lane_;
        const u32x2* ur = (const u32x2*)((const bf16_t*)(F.ws + WS_UPD1) + (size_t)row * 1024) + lane_;
        const unsigned* y0 = y + (size_t)s0 * 256 + lane_; const unsigned* y1 = y + (size_t)s1 * 256 + lane_;
        const f32x4* g2 = (const f32x4*)(mod + (row >> 13) * 6144 + 5120) + lane_;
        f32x4 v[4], g[4]; unsigned a[4], c[4]; u32x2 uu[4];
#pragma unroll
        for (int j = 0; j < 4; ++j) { v[j] = xr[64 * j]; uu[j] = ur[64 * j]; a[j] = y0[64 * j]; c[j] = y1[64 * j]; g[j] = g2[64 * j]; }
#pragma unroll
        for (int j = 0; j < 4; ++j) { if (!DBG_X1_PLAIN) { v[j].x += bf_lo(uu[j].x); v[j].y += bf_hi(uu[j].x); v[j].z += bf_lo(uu[j].y); v[j].w += bf_hi(uu[j].y); }
            if (!DBG_SKIP_Y) { const f32x2 al = fp8_lo2(a[j]), ah = fp8_hi2(a[j]), cl = fp8_lo2(c[j]), ch = fp8_hi2(c[j]);
                v[j].x += g[j].x * (w0 * al.x + w1 * cl.x); v[j].y += g[j].y * (w0 * al.y + w1 * cl.y); v[j].z += g[j].z * (w0 * ah.x + w1 * ch.x); v[j].w += g[j].w * (w0 * ah.y + w1 * ch.y); } orow[64 * j] = v[j]; }
    }
}

__global__ void __launch_bounds__(512, 2) fwd(Params p) {
    extern __shared__ __attribute__((aligned(16))) unsigned char lds_raw[];
    Frame F;
    F.lds = (LAS unsigned char*)lds_raw; F.ws = p.ws;
    F.wave = __builtin_amdgcn_readfirstlane((int)threadIdx.x >> 6); F.G = gridDim.x; F.bid = blockIdx.x;
    volatile LAS unsigned* ctl = (volatile LAS unsigned*)(F.lds + LDS_CTLO);
    { const int ftid = fresh_tid(); if (ftid < 64) ctl[ftid] = 0u; }
    __syncthreads();
    XcdBarrier bar; bar.bar = (unsigned*)(p.ws + WS_CTL) + CW_BAR; bar.x = 0; bar.st = ctl;
    if (MK_N_LAUNCHES == 1) bar = xcd_barrier_post((unsigned*)(p.ws + WS_CTL) + CW_BAR, ctl);
    const int lo = p.ph_lo, hi = p.ph_hi;
    const __amdgpu_buffer_rsrc_t rsw = __builtin_amdgcn_make_buffer_rsrc(p.ws, 0, (int)WS_END, 0x00020000);
#define IN(k) (lo <= (k) && (k) < hi)
#define REP(k) for (int rep_ = 0; rep_ < ((PROBE_PH) == (k) ? 2 : 1); ++rep_)
#define SEAM(k) do { if (IN(k) && IN((k) + 1)) xcd_barrier(bar); } while (0)

    if (IN(0)) REP(0) { phase0(F, p); } SEAM(0);
    if (IN(1)) REP(1) { phase_norm<0>(F, p); } SEAM(1);
    if (IN(2)) REP(2) {
        REP(20) {
            pg8::DenseSched Sd; Sd.init(T, 2304, F.G, F.bid, WS_H8, 1024, WS_W1D8, 1024);
            EpiProj<false> E{(bf16_t*)(F.ws + WS_PROJ), (bf16_t*)(F.ws + WS_GATES), (const bf16_t*)(F.ws + WS_ROPE), p.in[I_QG], p.in[I_KG], 0};
            pg8::gemm_phase<EpiProj<false>, pg8::DenseSched, true>(F.lds, 1024, Sd, E, rsw);
        }
        REP(21) {
            pg8::DenseSched Sd; Sd.init(T, 768, F.G, F.bid, WS_H, 2048, WS_W1 + (size_t)2304 * 2048, 2048);
            EpiProj<false> E{(bf16_t*)(F.ws + WS_PROJ), (bf16_t*)(F.ws + WS_GATES), (const bf16_t*)(F.ws + WS_ROPE), p.in[I_QG], p.in[I_KG], 9};
            pg8::gemm_phase<EpiProj<false>, pg8::DenseSched, false>(F.lds, 1024, Sd, E, rsw);
        }
        REP(22) {
            pg8::DenseSched Sd; Sd.init(T, 2048, F.G, F.bid, WS_H8, 1024, WS_WG8, 1024);
            EpiProj<true> E{(bf16_t*)(F.ws + WS_PROJ), (bf16_t*)(F.ws + WS_GATES), (const bf16_t*)(F.ws + WS_ROPE), p.in[I_QG], p.in[I_KG], 0};
            pg8::gemm_phase<EpiProj<true>, pg8::DenseSched, true>(F.lds, 1024, Sd, E, rsw);
        }
    } SEAM(2);
    if (IN(3)) REP(3) { phase_attn(F, p); } SEAM(3);
    if (IN(4)) REP(4) {
        pg8::DiagSched Sd; Sd.init(T, 2048, F.G, F.bid, WS_OCAT, 512, WS_WB, 512);
        EpiBranch E{(const unsigned char*)(F.ws + WS_GATES), F.ws + WS_MERGED};
        pg8::gemm_phase<EpiBranch, pg8::DiagSched, true>(F.lds, 512, Sd, E, rsw);
    } SEAM(4);
    if (IN(5)) REP(5) {
        pg8::DenseSched Sd; Sd.init(T, 1024, F.G, F.bid, WS_MERGED, 1024, WS_WO, 1024);
        EpiOut E{(bf16_t*)(F.ws + WS_UPD1), (const float*)(F.ws + WS_MOD)};
        pg8::gemm_phase<EpiOut, pg8::DenseSched, true>(F.lds, 1024, Sd, E, rsw);
        if (rep_ + 1 == ((PROBE_PH) == 5 ? 2 : 1)) router_weights_to_lds(F, p);
    } SEAM(5);
    if (IN(6)) REP(6) { phase_norm2_route(F, p); }
    if (IN(6) && IN(8)) xcd_barrier(bar);
    if (IN(8)) REP(8) { phase_slots(F, p); } SEAM(8);
    if (IN(9) || IN(10)) {
        LAS int* cst = (LAS int*)(F.lds + LDS_CTLO) + 16;
        __syncthreads();
        { const int ftid = fresh_tid(); if (ftid < 34) cst[ftid] = ((const int*)(F.ws + WS_ETAB))[64 + ftid]; }
        __syncthreads();
    }
    if (IN(9)) REP(9) {
        const LAS int* cst = (const LAS int*)(F.lds + LDS_CTLO) + 16;
        MoeSchedUp Sm; Sm.G = F.G; Sm.c = (F.G == 256) ? ((F.bid & 7) * 32 + (F.bid >> 3)) : F.bid; Sm.nc = __builtin_amdgcn_readfirstlane(cst[33]); Sm.pa = 1024; Sm.pb = 1024; Sm.A = (unsigned)WS_H28; Sm.B = (unsigned)WS_WGU; Sm.cstart = cst;
        Sm.slot_tok = (const int*)(F.ws + WS_SLOTTOK); Sm.estride = 1024u * 1024u; Sm.pnstride = 256u * 1024u;
        EpiSwiglu E{F.ws + WS_HMID};
        pg8::gemm_phase<EpiSwiglu, MoeSchedUp, true>(F.lds, 1024, Sm, E, rsw);
    } SEAM(9);
    if (IN(10)) REP(10) {
        const LAS int* cst = (const LAS int*)(F.lds + LDS_CTLO) + 16;
        MoeSchedDn Sm; Sm.G = F.G; Sm.c = (F.G == 256) ? ((F.bid & 7) * 32 + (F.bid >> 3)) : F.bid; Sm.nc = __builtin_amdgcn_readfirstlane(cst[33]); Sm.pa = 512; Sm.pb = 512; Sm.A = (unsigned)WS_HMID; Sm.B = (unsigned)WS_WDN; Sm.cstart = cst;
        Sm.slot_tok = (const int*)(F.ws + WS_SLOTTOK); Sm.estride = 1024u * 512u; Sm.pnstride = 256u * 512u;
        EpiDown E{F.ws + WS_Y};
        pg8::gemm_phase<EpiDown, MoeSchedDn, true>(F.lds, 512, Sm, E, rsw);
    } SEAM(10);
    if (IN(11)) { phase_combine(F, p); }
#undef IN
#undef SEAM
}

extern "C" void kernel_launch(void* const* d_in, const int* in_sizes, int n_in, void* d_out, int out_size, void* d_ws, size_t ws_size, hipStream_t stream) {
    static int grid = 0;
    if (grid == 0) {
        if (n_in != 21 || in_sizes[0] != T * D || out_size != T * D || ws_size < WS_END) { fprintf(stderr, "kernel_launch: unexpected problem (n_in %d, ws %zu)\n", n_in, ws_size); grid = -1; return; }
        int dev = 0, cus = 0, per_cu = 0;
        if (hipGetDevice(&dev) != hipSuccess || hipDeviceGetAttribute(&cus, hipDeviceAttributeMultiprocessorCount, dev) != hipSuccess) { grid = -1; return; }
        if (hipFuncSetAttribute((const void*)fwd, hipFuncAttributeMaxDynamicSharedMemorySize, LDS_BYTES) != hipSuccess) { fprintf(stderr, "kernel_launch: hipFuncSetAttribute failed\n"); grid = -1; return; }
        if (hipOccupancyMaxActiveBlocksPerMultiprocessor(&per_cu, (const void*)fwd, 512, LDS_BYTES) != hipSuccess || per_cu < 1) { fprintf(stderr, "kernel_launch: occupancy query says %d\n", per_cu); (void)hipGetLastError(); grid = -1; return; }
        grid = cus;
    }
    if (grid < 0) return;
    (void)hipMemsetAsync((char*)d_ws + WS_CTL, 0, CTL_ZERO_BYTES, stream);
    Params p{};
    for (int i = 0; i < 21; ++i) p.in[i] = (const float*)d_in[i];
    p.out = (float*)d_out; p.ws = (unsigned char*)d_ws;
    if (MK_N_LAUNCHES == 1) { p.ph_lo = 0; p.ph_hi = NPH; hipLaunchKernelGGL(fwd, dim3(grid), dim3(512), LDS_BYTES, stream, p); }
    else { for (int k = 0; k < NPH; ++k) { p.ph_lo = k; p.ph_hi = k + 1; hipLaunchKernelGGL(fwd, dim3(grid), dim3(512), LDS_BYTES, stream, p); } }
}
```

```cpp
#include <hip/hip_runtime.h>
#include <cstdio>
#include <cstdint>

#ifndef MK_N_LAUNCHES
#define MK_N_LAUNCHES 1
#endif
#define DBG_X1_PLAIN 0
#define DBG_SKIP_Y 0
#ifndef PROBE_PH
#define PROBE_PH -1
#endif

#define LAS __attribute__((address_space(3)))
#define DI __device__ __forceinline__
typedef unsigned short bf16_t;
typedef short bf16x8 __attribute__((ext_vector_type(8)));
typedef short s16x4 __attribute__((ext_vector_type(4)));
typedef float f32x2 __attribute__((ext_vector_type(2)));
typedef float f32x4 __attribute__((ext_vector_type(4)));
typedef float f32x16 __attribute__((ext_vector_type(16)));
typedef unsigned u32x2 __attribute__((ext_vector_type(2)));
typedef unsigned u32x4 __attribute__((ext_vector_type(4)));
typedef __bf16 bf16x2n __attribute__((ext_vector_type(2)));
typedef int i32x8 __attribute__((ext_vector_type(8)));

constexpr int NB = 8, S = 8192, D = 1024, T = NB * S;
constexpr int LDP = 3072, LDG = 2048, LDO = 512;
constexpr int NE = 32, DE = 512;
constexpr int MAXSLOT = T * 2 + NE * 256;
constexpr int NPH = 12;
constexpr float LOG2E = 1.4426950408889634f;
constexpr float QSCALE = 0.125f * LOG2E;
constexpr float RMS_EPS = 1e-6f;

constexpr size_t MiB = 1u << 20;
constexpr size_t WS_CTL = 0, CTL_ZERO_BYTES = 64 * 1024;
constexpr int CW_BAR = 1024;
constexpr size_t WS_MODP = 1 * MiB;
constexpr size_t WS_MOD = 3 * MiB;
constexpr size_t WS_ROPE = 4 * MiB;
constexpr size_t WS_LOGIT = 144 * MiB;
constexpr size_t WS_TOKE = 24 * MiB;
constexpr size_t WS_TOKW = 24 * MiB + 512 * 1024;
constexpr size_t WS_TOKS = 25 * MiB;
constexpr size_t WS_SLOTTOK = 25 * MiB + 512 * 1024;
constexpr size_t WS_SLOTW = 26 * MiB + 256 * 1024;
constexpr size_t WS_HIST = 27 * MiB;
constexpr size_t WS_ETAB = 27 * MiB + 256 * 1024;
constexpr size_t WS_WR = 28 * MiB;
constexpr size_t WS_W1D8 = 28 * MiB + 512 * 1024;
constexpr size_t WS_W1 = 32 * MiB;
constexpr size_t WS_WG8 = 38 * MiB;
constexpr size_t WS_WB = 40 * MiB;
constexpr size_t WS_WO = 43 * MiB;
constexpr size_t WS_WGU = 48 * MiB;
constexpr size_t WS_WDN = 80 * MiB;
constexpr size_t WS_H = 144 * MiB;
constexpr size_t WS_OG = 144 * MiB;
constexpr size_t WS_LSE = 240 * MiB;
constexpr size_t WS_PROJ = 272 * MiB;
constexpr size_t WS_GATES = 656 * MiB;
constexpr size_t WS_OCAT = 912 * MiB;
constexpr size_t WS_H8 = 912 * MiB;
constexpr size_t WS_MERGED = 272 * MiB;
constexpr size_t WS_H2 = 400 * MiB;
constexpr size_t WS_H28 = 528 * MiB;
constexpr size_t WS_HMID = 592 * MiB;
constexpr size_t WS_Y = 664 * MiB;
constexpr size_t WS_UPD1 = 800 * MiB;
constexpr size_t WS_END = 976 * MiB;

constexpr int LDS_STAGE = 0, LDS_EPI = 131072, LDS_RW = 0, LDS_RV = 148480, LDS_RS = 148480 + 8192, LDS_CTLO = 148480 + 8192 + 3072, LDS_BYTES = LDS_CTLO + 256;

DI unsigned pk2(float lo, float hi) { f32x2 v = {lo, hi}; bf16x2n r = __builtin_convertvector(v, bf16x2n); return __builtin_bit_cast(unsigned, r); }
DI unsigned pk4_fp8(float a, float b, float c, float d) { int r = __builtin_amdgcn_cvt_pk_fp8_f32(a, b, 0, false); r = __builtin_amdgcn_cvt_pk_fp8_f32(c, d, r, true); return (unsigned)r; }
DI f32x2 fp8_lo2(unsigned u) { return __builtin_amdgcn_cvt_pk_f32_fp8((int)u, false); }
DI f32x2 fp8_hi2(unsigned u) { return __builtin_amdgcn_cvt_pk_f32_fp8((int)u, true); }
DI float bf_lo(unsigned u) { return __builtin_bit_cast(float, u << 16); }
DI float bf_hi(unsigned u) { return __builtin_bit_cast(float, u & 0xffff0000u); }
DI float wave_sum(float v) {
#pragma unroll
    for (int o = 1; o < 64; o <<= 1) v += __shfl_xor(v, o);
    return v;
}
DI float fexp2(float x) { return __builtin_amdgcn_exp2f(x); }
DI float flog2(float x) { return __builtin_amdgcn_logf(x); }
DI float frcp(float x) { return __builtin_amdgcn_rcpf(x); }
DI float sigmoidf(float v) { return frcp(1.0f + fexp2(-v * LOG2E)); }
DI void lds_add(LAS int* p, int v) { (void)__hip_atomic_fetch_add(p, v, __ATOMIC_RELAXED, __HIP_MEMORY_SCOPE_WORKGROUP); }
#define LDS_WAIT() asm volatile("s_waitcnt lgkmcnt(0)" ::: "memory")
#define VM_WAIT() asm volatile("s_waitcnt vmcnt(0)" ::: "memory")
DI int fresh_tid() { int t = threadIdx.x; asm volatile("" : "+v"(t)); return t; }

#define XB_TMO      128
#define XB_XCNT(j)  (256  + 64 * (j))
#define XB_XSUB(j)  (1280 + 64 * (j))
#define XB_XGEN(j)  (2304 + 64 * (j))
#define XB_TOP      3328
#define XB_TOPGEN   3392
#define XCD_BAR_WORDS 3456
#define XB_SPIN_CAP (1u << 18)

__device__ __forceinline__ unsigned xb_ld(unsigned* p)              { return __hip_atomic_load(p, __ATOMIC_RELAXED, __HIP_MEMORY_SCOPE_AGENT); }
__device__ __forceinline__ unsigned xb_add(unsigned* p, unsigned v) { return __hip_atomic_fetch_add(p, v, __ATOMIC_RELAXED, __HIP_MEMORY_SCOPE_AGENT); }
__device__ __forceinline__ unsigned xb_xcc_id() { return (unsigned)__builtin_amdgcn_s_getreg((3 << 11) | 20) & 0xFu; }
#define XB_SPIN(cond, bar) do { unsigned _sp = 0; while (cond) { __builtin_amdgcn_s_sleep(1); \
    if ((++_sp & 255u) == 0u) { if (xb_ld(&(bar)[XB_TMO])) break; if (_sp > XB_SPIN_CAP) { atomicAdd(&(bar)[XB_TMO], 1u); break; } } } } while (0)

struct XcdBarrier {
    unsigned* bar; unsigned x;
    volatile LAS unsigned* st;
};
__device__ __forceinline__ XcdBarrier xcd_barrier_post(unsigned* bar, volatile LAS unsigned* st) {
    XcdBarrier b; b.bar = bar; b.x = xb_xcc_id(); b.st = st;
    if (threadIdx.x == 0) (void)xb_add(&bar[XB_XCNT(b.x)], 1u);
    return b;
}
__device__ __forceinline__ void xcd_barrier_complete(unsigned* bar, unsigned x, unsigned& nloc, unsigned& nx) {
    const unsigned G = gridDim.x * gridDim.y * gridDim.z;
    unsigned sum, cnt, mine, sp = 0u;
    for (;;) {
        sum = 0u; cnt = 0u; mine = 0u;
#pragma unroll
        for (unsigned j = 0; j < 16; ++j) { const unsigned c = xb_ld(&bar[XB_XCNT(j)]); sum += c; cnt += (c > 0u) ? 1u : 0u; mine = (j == x) ? c : mine; }
        if (sum == G) break;
        __builtin_amdgcn_s_sleep(1);
        if ((++sp & 255u) == 0u) { if (xb_ld(&bar[XB_TMO])) break; if (sp > XB_SPIN_CAP) { atomicAdd(&bar[XB_TMO], 1u); break; } }
    }
    nloc = mine > 0u ? mine : 1u; nx = cnt > 0u ? cnt : 1u;
}
__device__ __forceinline__ void xcd_barrier(const XcdBarrier& b) {
    asm volatile("s_waitcnt vmcnt(0)" ::: "memory");
    __syncthreads();
    if (threadIdx.x == 0) {
        unsigned* bar = b.bar;
        __builtin_amdgcn_s_waitcnt(0);
        unsigned nloc = b.st[0], nx = b.st[1];
        if (nloc == 0u) { xcd_barrier_complete(bar, b.x, nloc, nx); b.st[0] = nloc; b.st[1] = nx; }
        const unsigned old = xb_add(&bar[XB_XSUB(b.x)], 1u);
        const unsigned gen = old / nloc;
        if (old + 1u == (gen + 1u) * nloc) {
            __builtin_amdgcn_fence(__ATOMIC_RELEASE, "agent");
            asm volatile("s_waitcnt vmcnt(0)" ::: "memory");
            const unsigned og = xb_add(&bar[XB_TOP], 1u);
            const unsigned tg = og / nx;
            if (og + 1u == (tg + 1u) * nx) xb_add(&bar[XB_TOPGEN], 1u);
            else XB_SPIN(xb_ld(&bar[XB_TOPGEN]) == tg, bar);
            __builtin_amdgcn_fence(__ATOMIC_ACQUIRE, "agent");
            xb_add(&bar[XB_XGEN(b.x)], 1u);
            asm volatile("s_waitcnt vmcnt(0)" ::: "memory");
        } else {
            XB_SPIN(xb_ld(&bar[XB_XGEN(b.x)]) == gen, bar);
            __builtin_amdgcn_fence(__ATOMIC_ACQUIRE, "agent");
            asm volatile("s_waitcnt vmcnt(0)" ::: "memory");
        }
    }
    __syncthreads();
}

namespace pg8 {
constexpr int BM = 256, BK = 64, HALF = 128, HTB = HALF * BK * 2, STAGE_BYTES = 8 * HTB, NXCD = 8, WGM = 8;
__host__ __device__ __forceinline__ int lds_byte(int r, int c) { const int st = (r >> 4) * 2 + (c >> 5), rr = r & 15, cc = c & 31, ob = rr * 64 + cc * 2; return st * 1024 + (ob ^ (((ob >> 9) & 1) << 5)); }
__host__ __device__ __forceinline__ void stage_rc(int b, int& R, int& C) { const int st = b / 1024, sb = b % 1024, swz = sb ^ (((sb >> 9) & 1) << 5); R = (st >> 1) * 16 + swz / 64; C = (st & 1) * 32 + (swz % 64) / 2; }
__host__ __device__ __forceinline__ int perm32(int rho) { const int n = rho >> 4, i = rho & 15; return 8 * (i >> 2) + 4 * n + (i & 3); }

struct Unit { int pm, pn, aux; unsigned a, b; };
typedef int i32x4 __attribute__((ext_vector_type(4)));
__device__ __forceinline__ i32x8 frag8(bf16x8 lo, bf16x8 hi) { return __builtin_shufflevector(__builtin_bit_cast(i32x4, lo), __builtin_bit_cast(i32x4, hi), 0, 1, 2, 3, 4, 5, 6, 7); }

template <class Epi, class Sched, bool FP8 = false>
__device__ __forceinline__ void gemm_phase(LAS unsigned char* lds, const int K, const Sched& S, const Epi& E, const __amdgpu_buffer_rsrc_t rs) {
    const int tid = fresh_tid(), wid = __builtin_amdgcn_readfirstlane(tid >> 6), lane = tid & 63, wr = wid >> 2, wc = wid & 3, fr = lane & 15, fq = lane >> 4;
    const int nt = FP8 ? K / 128 : K / BK;
    int RA[2], CA[2];
    unsigned voffA[4], voffB[2];
#pragma unroll
    for (int i = 0; i < 2; ++i) { int R, C; stage_rc(tid * 16 + i * 8192, R, C); RA[i] = R; CA[i] = C; const int Rb = Epi::PERM ? ((R & ~31) + perm32(R & 31)) : R;
        voffB[i] = (unsigned)(Rb * S.pb + C * 2); }
    const unsigned kstep = (unsigned)(BK * 2);
    const unsigned hstepB = (unsigned)(HALF * S.pb), hstepA = (unsigned)(HALF * S.pa);
    const unsigned ldsw = (unsigned)wid * 1024u;
    const int aoff = lds_byte(wr * 64 + fr, fq * 8), boff = lds_byte(wc * 32 + fr, fq * 8);
    constexpr int kpiece = 1024;
#define PG8_SA(b, h) (((b) * 2 + (h)) * HTB)
#define PG8_SB(b, h) ((4 + (b) * 2 + (h)) * HTB)
#define PG8_STAGE_B(bufoff, gbase) do { _Pragma("unroll") for (int _i = 0; _i < 2; ++_i) \
        __builtin_amdgcn_raw_ptr_buffer_load_lds(rs, (LAS unsigned*)(lds + (bufoff) + ldsw + _i * 8192), 16, (int)voffB[_i], (int)(gbase), 0, 0); } while (0)
#define PG8_STAGE_A(bufoff, gbase, h) do { _Pragma("unroll") for (int _i = 0; _i < 2; ++_i) \
        __builtin_amdgcn_raw_ptr_buffer_load_lds(rs, (LAS unsigned*)(lds + (bufoff) + ldsw + _i * 8192), 16, (int)voffA[Sched::GATHER ? (h) * 2 + _i : _i], (int)((gbase) + (Sched::GATHER ? 0u : (unsigned)(h) * hstepA)), 0, 0); } while (0)
#define PG8_LDA(dst, b, h) do { _Pragma("unroll") for (int m = 0; m < 4; ++m) _Pragma("unroll") for (int k = 0; k < 2; ++k) dst[m][k] = *(const LAS bf16x8*)(lds + PG8_SA(b, h) + aoff + m * 2048 + k * kpiece); } while (0)
#define PG8_LDB(dst, b, h) do { _Pragma("unroll") for (int n = 0; n < 2; ++n) _Pragma("unroll") for (int k = 0; k < 2; ++k) dst[n][k] = *(const LAS bf16x8*)(lds + PG8_SB(b, h) + boff + n * 2048 + k * kpiece); } while (0)
#define PG8_MMA(ai, bj, At, Bt) do { __builtin_amdgcn_s_setprio(1); if constexpr (FP8) { _Pragma("unroll") for (int m = 0; m < 4; ++m) _Pragma("unroll") for (int n = 0; n < 2; ++n) \
        acc[ai][bj][m][n] = __builtin_amdgcn_mfma_scale_f32_16x16x128_f8f6f4(frag8(Bt[n][0], Bt[n][1]), frag8(At[m][0], At[m][1]), acc[ai][bj][m][n], 0, 0, 0, 0x7C7C7C7C, 0, 0x7C7C7C7C); } \
      else { _Pragma("unroll") for (int m = 0; m < 4; ++m) _Pragma("unroll") for (int n = 0; n < 2; ++n) _Pragma("unroll") for (int k = 0; k < 2; ++k) \
        acc[ai][bj][m][n] = __builtin_amdgcn_mfma_f32_16x16x32_bf16(Bt[n][k], At[m][k], acc[ai][bj][m][n], 0, 0, 0); } __builtin_amdgcn_s_setprio(0); } while (0)
#define PG8_MMA2(ai, At) do { if constexpr (Sched::BLOCKDIAG) { if (lo_half) PG8_MMA(ai, 0, At, B0); else PG8_MMA(ai, 1, At, B1); } else { PG8_MMA(ai, 0, At, B0); PG8_MMA(ai, 1, At, B1); } } while (0)
#define PG8_WAIT_V(n) asm volatile("s_waitcnt vmcnt(" #n ")" ::: "memory")
#define PG8_WAIT_L(n) asm volatile("s_waitcnt lgkmcnt(" #n ")" ::: "memory")
#define PG8_BAR __builtin_amdgcn_s_barrier()
#define PG8_SCHED __builtin_amdgcn_sched_barrier(0)
    Unit cur, nxt; int ui = 0;
    if (!S.next(0, cur)) return;
    S.offs(cur, RA, CA, voffA);
    f32x4 acc[2][2][4][2];
#pragma unroll
    for (int a = 0; a < 2; ++a)
#pragma unroll
        for (int b = 0; b < 2; ++b)
#pragma unroll
            for (int m = 0; m < 4; ++m)
#pragma unroll
                for (int n = 0; n < 2; ++n) acc[a][b][m][n] = (f32x4){0.f, 0.f, 0.f, 0.f};
    bf16x8 At[4][2], B0[2][2], B1[2][2];
    unsigned cA = cur.a, cB = cur.b;
    PG8_STAGE_B(PG8_SB(0, 0), cB); PG8_STAGE_B(PG8_SB(0, 1), cB + hstepB); PG8_STAGE_A(PG8_SA(0, 0), cA, 0); PG8_STAGE_A(PG8_SA(0, 1), cA, 1);
    if (wr == 1) PG8_BAR;
    PG8_WAIT_V(2); PG8_BAR;
    PG8_STAGE_B(PG8_SB(1, 0), cB + kstep); PG8_STAGE_A(PG8_SA(1, 0), cA + kstep, 0); PG8_STAGE_B(PG8_SB(1, 1), cB + hstepB + kstep);
    PG8_WAIT_V(6); PG8_BAR;
    for (;;) {
        const bool has_next = S.next(ui + 1, nxt);
        const unsigned nA = has_next ? nxt.a : cA, nB = has_next ? nxt.b : cB;
        unsigned nvoff[4];
        if constexpr (Sched::GATHER) { if (has_next) S.rows(nxt, RA, nvoff); }
#pragma nounroll
        for (int t = 0; t < nt; t += 2) {
            const bool last = (t == nt - 2), lo_half = t < (nt >> 1);
            const unsigned a1 = cA + (unsigned)(t + 1) * kstep;
            const unsigned a2 = last ? nA : cA + (unsigned)(t + 2) * kstep, b2 = last ? nB : cB + (unsigned)(t + 2) * kstep;
            const unsigned a3 = a2 + kstep, b3 = b2 + kstep;
            PG8_LDB(B0, 0, 0); PG8_LDB(B1, 0, 1); PG8_SCHED; PG8_LDA(At, 0, 0); PG8_STAGE_A(PG8_SA(1, 1), a1, 1);
            PG8_WAIT_V(8); PG8_WAIT_L(0); PG8_BAR; PG8_MMA2(0, At); PG8_BAR; PG8_SCHED;
            if constexpr (Sched::GATHER) { if (last && has_next) {
#pragma unroll
                for (int q = 0; q < 4; ++q) voffA[q] = nvoff[q] * (unsigned)S.pa + (unsigned)(CA[q & 1] * 2); } }
            PG8_LDA(At, 0, 1); PG8_STAGE_B(PG8_SB(0, 0), b2); PG8_STAGE_B(PG8_SB(0, 1), b2 + hstepB); PG8_STAGE_A(PG8_SA(0, 0), a2, 0);
            PG8_WAIT_V(8); PG8_WAIT_L(0); PG8_BAR; PG8_MMA2(1, At); PG8_BAR; PG8_SCHED;
            PG8_LDB(B0, 1, 0); PG8_LDB(B1, 1, 1); PG8_SCHED; PG8_LDA(At, 1, 0); PG8_STAGE_A(PG8_SA(0, 1), a2, 1);
            PG8_WAIT_V(8); PG8_WAIT_L(0); PG8_BAR; PG8_MMA2(0, At); PG8_BAR; PG8_SCHED;
            PG8_LDA(At, 1, 1); PG8_STAGE_B(PG8_SB(1, 0), b3); PG8_STAGE_B(PG8_SB(1, 1), b3 + hstepB); PG8_STAGE_A(PG8_SA(1, 0), a3, 0);
            PG8_WAIT_V(8); PG8_WAIT_L(0); PG8_BAR; PG8_MMA2(1, At); PG8_BAR; PG8_SCHED;
        }
        if (wr == 0) PG8_BAR;
        { const int t2 = fresh_tid() & 63; E(acc, cur, wr, wc, t2 & 15, t2 >> 4, lds + LDS_EPI); }
        if (!has_next) break;
#pragma unroll
        for (int a = 0; a < 2; ++a)
#pragma unroll
            for (int b = 0; b < 2; ++b)
#pragma unroll
                for (int m = 0; m < 4; ++m)
#pragma unroll
                    for (int n = 0; n < 2; ++n) acc[a][b][m][n] = (f32x4){0.f, 0.f, 0.f, 0.f};
        cur = nxt; cA = nA; cB = nB; ++ui;
        if (wr == 1) PG8_BAR;
    }
    PG8_WAIT_V(0);
    PG8_BAR;
#undef PG8_SA
#undef PG8_SB
#undef PG8_STAGE_A
#undef PG8_STAGE_B
#undef PG8_LDA
#undef PG8_LDB
#undef PG8_MMA
#undef PG8_MMA2
#undef PG8_WAIT_V
#undef PG8_WAIT_L
#undef PG8_BAR
#undef PG8_SCHED
}

struct DenseSched {
    static constexpr bool GATHER = false, BLOCKDIAG = false;
    int nM, nN, nwg, G, c; int pa, pb; unsigned A, B;
    __device__ void init(int M, int N, int G_, int c_, size_t A_, int pa_, size_t B_, int pb_) { nM = M / BM; nN = N / BM; nwg = nM * nN; G = G_; c = c_; A = (unsigned)A_; B = (unsigned)B_; pa = pa_; pb = pb_; }
    __device__ __forceinline__ bool next(int i, Unit& u) const {
        const long L = (long)i * G + c; if (L >= nwg) return false;
        int wgid = (int)L; { const int q = nwg / NXCD, r = nwg % NXCD, xcd = wgid % NXCD, off = wgid / NXCD; wgid = (xcd < r ? xcd * (q + 1) : r * (q + 1) + (xcd - r) * q) + off; }
        const int nig = WGM * nN, gid = wgid / nig, fm = gid * WGM, gsz = (nM - fm) < WGM ? (nM - fm) : WGM;
        u.pm = fm + ((wgid % nig) % gsz); u.pn = (wgid % nig) / gsz; u.aux = 0;
        u.a = A + (unsigned)(u.pm * BM * pa); u.b = B + (unsigned)(u.pn * BM * pb); return true;
    }
    __device__ __forceinline__ void offs(const Unit&, const int (&RA)[2], const int (&CA)[2], unsigned (&v)[4]) const {
#pragma unroll
        for (int h = 0; h < 2; ++h)
#pragma unroll
            for (int i = 0; i < 2; ++i) v[h * 2 + i] = (unsigned)((h * HALF + RA[i]) * pa + CA[i] * 2);
    }
};
struct DiagSched : DenseSched { static constexpr bool BLOCKDIAG = true; };
}

struct Params { const float* in[21]; float* out; unsigned char* ws; int ph_lo, ph_hi; };
enum { I_X = 0, I_C, I_POS, I_WADA, I_BADA, I_GMIX, I_GFFN, I_WIN, I_WBG, I_QG, I_KG, I_WBD, I_WBS, I_WOUT, I_WRG, I_BRG, I_WRE, I_BRE, I_WEG, I_WEU, I_WED };

struct Frame {
    LAS unsigned char* lds;
    unsigned char* ws;
    int wave, G, bid;
};

template <bool FP8>
DI void p0_transpose_item(const float* W, int N, void* WTv, int ldt, int k0, int n0, int row_base, LAS float* scr, int lane) {
#pragma unroll 8
    for (int i = 0; i < 32; ++i) { const int kk = 2 * i + (lane >> 5); scr[kk * 33 + (lane & 31)] = W[(size_t)(k0 + kk) * N + n0 + (lane & 31)]; }
    LDS_WAIT();
    const int c = lane & 7;
#pragma unroll
    for (int j = 0; j < 4; ++j) { const int n = (lane >> 3) + 8 * j; const LAS float* sp = scr + (8 * c) * 33 + n;
        if (FP8) { u32x2 o; o.x = pk4_fp8(64.f * sp[0 * 33], 64.f * sp[1 * 33], 64.f * sp[2 * 33], 64.f * sp[3 * 33]); o.y = pk4_fp8(64.f * sp[4 * 33], 64.f * sp[5 * 33], 64.f * sp[6 * 33], 64.f * sp[7 * 33]);
            *(u32x2*)((unsigned char*)WTv + (size_t)(row_base + n) * ldt + k0 + 8 * c) = o; }
        else { u32x4 o; o.x = pk2(sp[0 * 33], sp[1 * 33]); o.y = pk2(sp[2 * 33], sp[3 * 33]); o.z = pk2(sp[4 * 33], sp[5 * 33]); o.w = pk2(sp[6 * 33], sp[7 * 33]);
            *(u32x4*)((bf16_t*)WTv + (size_t)(row_base + n) * ldt + k0 + 8 * c) = o; } }
    LDS_WAIT();
}
DI void phase0(const Frame& F, const Params& p) {
    const int tid_ = fresh_tid(), lane_ = tid_ & 63;
    LAS float* scr = (LAS float*)(F.lds + F.wave * 16384);
    const int gw = F.bid * 8 + F.wave, NGW = F.G * 8;
    bf16_t* W1 = (bf16_t*)(F.ws + WS_W1); bf16_t* WB = (bf16_t*)(F.ws + WS_WB); bf16_t* WO = (bf16_t*)(F.ws + WS_WO);
    unsigned char* WG8 = F.ws + WS_WG8; unsigned char* WGU = F.ws + WS_WGU; unsigned char* WDN = F.ws + WS_WDN;
    constexpr int I1 = 16 * 96, I2 = 16 * 64, I3 = 4 * 32, I4 = 4 * 32, I5 = 16 * 32, I6 = 32 * 256, I7 = 32 * 256, I8 = 32 * 256;
    constexpr int NITEMS = I1 + I2 + I3 + I4 + I5 + I6 + I7 + I8;
    for (int it = gw; it < NITEMS; it += NGW) {
        int r = it;
        if (r < I1) { const int kb = r / 96, nb = r % 96; if (nb < 72) p0_transpose_item<true>(p.in[I_WIN], 3072, F.ws + WS_W1D8, 1024, 64 * kb, 32 * nb, 32 * nb, scr, lane_); else p0_transpose_item<false>(p.in[I_WIN], 3072, W1, 1024, 64 * kb, 32 * nb, 32 * nb, scr, lane_); continue; } r -= I1;
        if (r < I2) { const int kb = r / 64, nb = r % 64; p0_transpose_item<true>(p.in[I_WBG], 2048, WG8, 1024, 64 * kb, 32 * nb, 32 * nb, scr, lane_); continue; } r -= I2;
        if (r < I3) { const int kb = r / 32, nb = r % 32, n0 = 32 * nb; p0_transpose_item<true>(p.in[I_WBD], 1024, (unsigned char*)WB, 512, 64 * kb, n0, (n0 >> 7) * 256 + (n0 & 127), scr, lane_); continue; } r -= I3;
        if (r < I4) { const int kb = r / 32, nb = r % 32, n0 = 32 * nb; p0_transpose_item<true>(p.in[I_WBS], 1024, (unsigned char*)WB + 256, 512, 64 * kb, n0, (n0 >> 7) * 256 + 128 + (n0 & 127), scr, lane_); continue; } r -= I4;
        if (r < I5) { const int kb = r / 32, nb = r % 32; p0_transpose_item<true>(p.in[I_WOUT], 1024, WO, 1024, 64 * kb, 32 * nb, 32 * nb, scr, lane_); continue; } r -= I5;
        if (r < I6) { const int e = r >> 8, q = r & 255, kb = q >> 4, nb = q & 15, n0 = 32 * nb;
            p0_transpose_item<true>(p.in[I_WEG] + (size_t)e * 1024 * 512, 512, WGU + (size_t)e * 1024 * 1024, 1024, 64 * kb, n0, (n0 >> 7) * 256 + (n0 & 127), scr, lane_); continue; } r -= I6;
        if (r < I7) { const int e = r >> 8, q = r & 255, kb = q >> 4, nb = q & 15, n0 = 32 * nb;
            p0_transpose_item<true>(p.in[I_WEU] + (size_t)e * 1024 * 512, 512, WGU + (size_t)e * 1024 * 1024, 1024, 64 * kb, n0, (n0 >> 7) * 256 + 128 + (n0 & 127), scr, lane_); continue; } r -= I7;
        { const int e = r >> 8, q = r & 255, kb = q >> 5, nb = q & 31;
            p0_transpose_item<true>(p.in[I_WED] + (size_t)e * 512 * 1024, 1024, WDN + (size_t)e * 1024 * 512, 512, 64 * kb, 32 * nb, 32 * nb, scr, lane_); }
    }
    {
        unsigned char* WBz = F.ws + WS_WB;
        for (int idx = F.bid * 512 + tid_; idx < 2048 * 16; idx += F.G * 512) { const int row = idx >> 4, c = idx & 15; *(u32x4*)(WBz + (size_t)row * 512 + ((row & 128) ? 0 : 256) + c * 16) = (u32x4){0u, 0u, 0u, 0u}; }
    }
    {
        float* modp = (float*)(F.ws + WS_MODP); const float* c = p.in[I_C]; const float* wada = p.in[I_WADA];
        for (int task = gw; task < 96 * 8; task += NGW) {
            const int ct = task % 96, ks = task / 96, k0 = ks * 128;
#pragma unroll
            for (int i = 0; i < 16; ++i) { const int idx = i * 64 + lane_, b = idx >> 7, k = idx & 127; const float v = c[b * 1024 + k0 + k]; scr[idx] = v * sigmoidf(v); }
            LDS_WAIT();
            float acc[8];
#pragma unroll
            for (int b = 0; b < 8; ++b) acc[b] = 0.f;
            const float* wp = wada + (size_t)k0 * 6144 + ct * 64 + lane_;
#pragma unroll 8
            for (int k = 0; k < 128; ++k) { const float w = wp[(size_t)k * 6144];
#pragma unroll
                for (int b = 0; b < 8; ++b) acc[b] += scr[b * 128 + k] * w; }
#pragma unroll
            for (int b = 0; b < 8; ++b) modp[((size_t)ks * 8 + b) * 6144 + ct * 64 + lane_] = acc[b];
            LDS_WAIT();
        }
    }
}

DI float inv_freq_of(int i) {
    return i == 0 ? 1.0f : i == 1 ? 0.1939227432012558f : i == 2 ? 0.03760603070259094f : i == 3 ? 0.007292664609849453f : i == 4 ? 0.0014142135623842478f : i == 5 ? 0.00027424818836152554f : i == 6 ? 5.318296098266728e-05f : 1.0313386155758053e-05f;
}
template <int WHICH>
DI void phase_norm(const Frame& F, const Params& p) {
    const int tid_ = fresh_tid(), lane_ = tid_ & 63;
    LAS float* gs = (LAS float*)(F.lds); LAS float* sh = gs + 1024;
    const float* modp = (const float*)(F.ws + WS_MODP); float* mod = (float*)(F.ws + WS_MOD); const float* bada = p.in[I_BADA];
    const float* xin = p.in[I_X]; const bf16_t* upd = (const bf16_t*)(F.ws + WS_UPD1); bf16_t* hout = (bf16_t*)(F.ws + (WHICH == 0 ? WS_H : WS_H2)); unsigned* h8 = (unsigned*)(F.ws + (WHICH == 0 ? WS_H8 : WS_H28));
    const float* gn = p.in[WHICH == 0 ? I_GMIX : I_GFFN];
    for (int chunk = F.bid; chunk < T / 256; chunk += F.G) {
        const int b = chunk >> 5;
        __syncthreads();
        if (WHICH == 0) {
            if (tid_ < 192) { const int j = (chunk & 31) * 192 + tid_; float s = bada[j];
#pragma unroll
                for (int ks = 0; ks < 8; ++ks) s += modp[((size_t)ks * 8 + b) * 6144 + j];
                mod[b * 6144 + j] = s; }
            for (int col = tid_; col < 1024; col += 512) { float s1 = bada[col], s2 = bada[1024 + col];
#pragma unroll
                for (int ks = 0; ks < 8; ++ks) { s1 += modp[((size_t)ks * 8 + b) * 6144 + col]; s2 += modp[((size_t)ks * 8 + b) * 6144 + 1024 + col]; }
                gs[col] = gn[col] * (1.f + s2); sh[col] = s1; }
        } else {
            for (int col = tid_; col < 1024; col += 512) { gs[col] = gn[col] * (1.f + mod[b * 6144 + 4096 + col]); sh[col] = mod[b * 6144 + 3072 + col]; }
        }
        __syncthreads();
        f32x4 g4[4], s4[4];
#pragma unroll
        for (int j = 0; j < 4; ++j) { g4[j] = *(const LAS f32x4*)(gs + 256 * j + 4 * lane_); s4[j] = *(const LAS f32x4*)(sh + 256 * j + 4 * lane_); }
        for (int rr = F.wave; rr < 256; rr += 8) {
            const int row = chunk * 256 + rr;
            const f32x4* xr = (const f32x4*)(xin + (size_t)row * 1024) + lane_;
            f32x4 v[4]; float ss = 0.f;
#pragma unroll
            for (int j = 0; j < 4; ++j) v[j] = xr[64 * j];
            if (WHICH == 1) { const u32x2* ur = (const u32x2*)(upd + (size_t)row * 1024) + lane_; u32x2 uu[4];
#pragma unroll
                for (int j = 0; j < 4; ++j) uu[j] = ur[64 * j];
#pragma unroll
                for (int j = 0; j < 4; ++j) { v[j].x += bf_lo(uu[j].x); v[j].y += bf_hi(uu[j].x); v[j].z += bf_lo(uu[j].y); v[j].w += bf_hi(uu[j].y); } }
#pragma unroll
            for (int j = 0; j < 4; ++j) ss += (v[j].x * v[j].x + v[j].y * v[j].y) + (v[j].z * v[j].z + v[j].w * v[j].w);
            const float rinv = __builtin_amdgcn_rsqf(wave_sum(ss) * (1.f / 1024.f) + RMS_EPS);
            u32x2* o8 = (u32x2*)(hout + (size_t)row * 1024) + lane_;
#pragma unroll
            for (int j = 0; j < 4; ++j) { const f32x4 y = v[j] * rinv * g4[j] + s4[j]; u32x2 o; o.x = pk2(y.x, y.y); o.y = pk2(y.z, y.w); o8[64 * j] = o; h8[(size_t)row * 256 + 64 * j + lane_] = pk4_fp8(y.x, y.y, y.z, y.w); }
            if (WHICH == 0 && lane_ < 8) {
                const int pos = ((const int*)p.in[I_POS])[row];
                const float angf = (float)pos * inv_freq_of(lane_);
                double rv = (double)angf * 0.15915494309189535; rv -= __builtin_rint(rv);
                const float fr = (float)rv;
                bf16_t* rp = (bf16_t*)(F.ws + WS_ROPE) + (size_t)row * 16;
                rp[lane_] = (bf16_t)(pk2(__builtin_amdgcn_cosf(fr), 0.f) & 0xffffu); rp[8 + lane_] = (bf16_t)(pk2(__builtin_amdgcn_sinf(fr), 0.f) & 0xffffu);
            }
        }
    }
}

template <bool GATES> struct EpiProj {
    static constexpr bool PERM = true;
    bf16_t* proj; bf16_t* gates; const bf16_t* rope; const float* qg; const float* kg; int pn0;
    DI void operator()(const f32x4 (&acc)[2][2][4][2], const pg8::Unit& u, int wr, int wc, int fr, int fq, LAS unsigned char* scr) const {
        asm volatile("" : "+v"(fr), "+v"(fq));
        const int pn = u.pn + pn0, row0 = u.pm * 256 + wr * 64 + fr, cw = wc * 32 + 8 * fq;
        const int typ = pn < 9 ? pn / 3 : pn - 9, grp = pn < 9 ? pn % 3 : 0, l2d = pn < 9 ? 2 * grp : 0, hbase = pn < 9 ? grp * 4 : 12;
        if (GATES) {
            unsigned char* base = (unsigned char*)gates + pn * 256 + cw;
#pragma unroll
            for (int ai = 0; ai < 2; ++ai)
#pragma unroll
                for (int m = 0; m < 4; ++m) { unsigned char* rowp = base + (size_t)(row0 + ai * 128 + m * 16) * LDG;
#pragma unroll
                    for (int bj = 0; bj < 2; ++bj) { const f32x4 v0 = acc[ai][bj][m][0], v1 = acc[ai][bj][m][1];
                        u32x2 w; w.x = pk4_fp8(v0.x, v0.y, v0.z, v0.w); w.y = pk4_fp8(v1.x, v1.y, v1.z, v1.w);
                        *(u32x2*)(rowp + bj * 128) = w; } }
        } else if (pn >= 6 || pn < 3) {
            const float sc = pn == 9 ? QSCALE : 1.f;
            const int dim0 = (wc & 1) * 32 + 8 * fq;
#pragma unroll
            for (int ai = 0; ai < 2; ++ai)
#pragma unroll
                for (int m = 0; m < 4; ++m) { const int t = row0 + ai * 128 + m * 16, sq = t & (S - 1); const int rp = (t & ~(S - 1)) + ((sq & ((1 << l2d) - 1)) << (13 - l2d)) + (sq >> l2d);
#pragma unroll
                    for (int bj = 0; bj < 2; ++bj) { const f32x4 v0 = acc[ai][bj][m][0] * sc, v1 = acc[ai][bj][m][1] * sc; const int head = hbase + 2 * bj + (wc >> 1);
                        u32x4 w; w.x = pk2(v0.x, v0.y); w.y = pk2(v0.z, v0.w); w.z = pk2(v1.x, v1.y); w.w = pk2(v1.z, v1.w);
                        *(u32x4*)(proj + ((size_t)(typ * 16 + head) * T + rp) * 64 + dim0) = w; } }
        } else {
            const float* g = kg; const float sc = 1.f;
            LAS float* part = (LAS float*)scr;
            const int ch = (wc & 1) * 32 + 8 * fq;
            const f32x4 g0 = *(const f32x4*)(g + ch), g1 = *(const f32x4*)(g + ch + 4);
            const bool ropew = (wc & 1) == 0;
            u32x4 rcs[2][4][2];
            if (ropew) {
#pragma unroll
                for (int ai = 0; ai < 2; ++ai)
#pragma unroll
                    for (int m = 0; m < 4; ++m) { const u32x4* rpt = (const u32x4*)(rope + (size_t)(u.pm * 256 + ai * 128 + wr * 64 + m * 16 + fr) * 16); rcs[ai][m][0] = rpt[0]; rcs[ai][m][1] = rpt[1]; }
            }
#pragma unroll
            for (int ai = 0; ai < 2; ++ai)
#pragma unroll
                for (int m = 0; m < 4; ++m)
#pragma unroll
                    for (int bj = 0; bj < 2; ++bj) { const f32x4 a = acc[ai][bj][m][0], b = acc[ai][bj][m][1];
                        float ss = (a.x * a.x + a.y * a.y) + (a.z * a.z + a.w * a.w) + (b.x * b.x + b.y * b.y) + (b.z * b.z + b.w * b.w);
                        ss += __shfl_xor(ss, 16); ss += __shfl_xor(ss, 32);
                        if (fq == 0) part[((ai * 128 + wr * 64 + m * 16 + fr) * 2 + bj) * 4 + wc] = ss; }
            LDS_WAIT(); __builtin_amdgcn_s_barrier(); asm volatile("" ::: "memory");
#pragma unroll
            for (int ai = 0; ai < 2; ++ai)
#pragma unroll
                for (int m = 0; m < 4; ++m) { const int rl = ai * 128 + wr * 64 + m * 16 + fr, row = u.pm * 256 + rl, sq = row & (S - 1);
                    const int rp = (row & ~(S - 1)) + ((sq & ((1 << l2d) - 1)) << (13 - l2d)) + (sq >> l2d);
                    f32x4 c0 = {0, 0, 0, 0}, c1 = c0, s0 = c0, s1 = c0;
                    if (ropew) { const u32x4 cc = rcs[ai][m][0], sn = rcs[ai][m][1];
                        c0 = (f32x4){bf_lo(cc.x), bf_hi(cc.x), bf_lo(cc.y), bf_hi(cc.y)}; c1 = (f32x4){bf_lo(cc.z), bf_hi(cc.z), bf_lo(cc.w), bf_hi(cc.w)};
                        s0 = (f32x4){bf_lo(sn.x), bf_hi(sn.x), bf_lo(sn.y), bf_hi(sn.y)}; s1 = (f32x4){bf_lo(sn.z), bf_hi(sn.z), bf_lo(sn.w), bf_hi(sn.w)};
                        if (fq == 0) { s0 = -s0; s1 = -s1; } }
#pragma unroll
                    for (int bj = 0; bj < 2; ++bj) {
                        const float tot = part[(rl * 2 + bj) * 4 + wc] + part[(rl * 2 + bj) * 4 + (wc ^ 1)];
                        const float rinv = __builtin_amdgcn_rsqf(tot * (1.f / 64.f) + RMS_EPS);
                        f32x4 v0 = acc[ai][bj][m][0] * rinv * g0, v1 = acc[ai][bj][m][1] * rinv * g1;
                        if (ropew) {
                            f32x4 p0, p1;
                            p0.x = __shfl_xor(v0.x, 16); p0.y = __shfl_xor(v0.y, 16); p0.z = __shfl_xor(v0.z, 16); p0.w = __shfl_xor(v0.w, 16);
                            p1.x = __shfl_xor(v1.x, 16); p1.y = __shfl_xor(v1.y, 16); p1.z = __shfl_xor(v1.z, 16); p1.w = __shfl_xor(v1.w, 16);
                            if (fq < 2) { v0 = v0 * c0 + p0 * s0; v1 = v1 * c1 + p1 * s1; }
                        }
                        v0 = v0 * sc; v1 = v1 * sc; const int head = hbase + 2 * bj + (wc >> 1);
                        u32x4 w; w.x = pk2(v0.x, v0.y); w.y = pk2(v0.z, v0.w); w.z = pk2(v1.x, v1.y); w.w = pk2(v1.z, v1.w);
                        *(u32x4*)(proj + ((size_t)(typ * 16 + head) * T + rp) * 64 + ch) = w; } }
        }
    }
};

struct EpiBranch {
    static constexpr bool PERM = true;
    const unsigned char* gates; unsigned char* merged;
    DI void operator()(const f32x4 (&acc)[2][2][4][2], const pg8::Unit& u, int wr, int wc, int fr, int fq, LAS unsigned char*) const {
        asm volatile("" : "+v"(fr), "+v"(fq));
        const int row0 = u.pm * 256 + wr * 64 + fr, col0 = u.pn * 128 + wc * 32 + 8 * fq;
        u32x2 gd[2][4], gs[2][4];
#pragma unroll
        for (int ai = 0; ai < 2; ++ai)
#pragma unroll
            for (int m = 0; m < 4; ++m) { const size_t row = (size_t)(row0 + ai * 128 + m * 16);
                gd[ai][m] = *(const u32x2*)(gates + row * LDG + col0); gs[ai][m] = *(const u32x2*)(gates + row * LDG + 1024 + col0); }
        __builtin_amdgcn_sched_barrier(0);
#pragma unroll
        for (int ai = 0; ai < 2; ++ai)
#pragma unroll
            for (int m = 0; m < 4; ++m) { const size_t row = (size_t)(row0 + ai * 128 + m * 16);
                const u32x2 g = gd[ai][m], q = gs[ai][m];
                const f32x2 ga = fp8_lo2(g.x), gb = fp8_hi2(g.x), gc = fp8_lo2(g.y), gdd = fp8_hi2(g.y), qa = fp8_lo2(q.x), qb = fp8_hi2(q.x), qc = fp8_lo2(q.y), qd = fp8_hi2(q.y);
                const f32x4 v0 = acc[ai][0][m][0] * (f32x4){sigmoidf(ga.x), sigmoidf(ga.y), sigmoidf(gb.x), sigmoidf(gb.y)} + acc[ai][1][m][0] * (f32x4){sigmoidf(qa.x), sigmoidf(qa.y), sigmoidf(qb.x), sigmoidf(qb.y)};
                const f32x4 v1 = acc[ai][0][m][1] * (f32x4){sigmoidf(gc.x), sigmoidf(gc.y), sigmoidf(gdd.x), sigmoidf(gdd.y)} + acc[ai][1][m][1] * (f32x4){sigmoidf(qc.x), sigmoidf(qc.y), sigmoidf(qd.x), sigmoidf(qd.y)};
                u32x2 w; w.x = pk4_fp8(8.f * v0.x, 8.f * v0.y, 8.f * v0.z, 8.f * v0.w); w.y = pk4_fp8(8.f * v1.x, 8.f * v1.y, 8.f * v1.z, 8.f * v1.w);
                *(u32x2*)(merged + row * 1024 + col0) = w; }
    }
};
struct BranchSched {
    static constexpr bool GATHER = false;
    int G, c; int pa, pb; unsigned A, B;
    DI bool next(int i, pg8::Unit& u) const {
        const int tile = (i >> 1) * G + c; if (tile >= 256 * 4) return false;
        u.pm = tile >> 2; u.pn = tile & 3; u.aux = i & 1;
        u.a = A + (unsigned)(u.pm * 256 * LDO * 2 + u.aux * 256 * 2); u.b = B + (unsigned)(u.aux * 1024 * 256 * 2 + u.pn * 256 * 256 * 2); return true;
    }
    DI void offs(const pg8::Unit&, const int (&RA)[2], const int (&CA)[2], unsigned (&v)[4]) const {
#pragma unroll
        for (int h = 0; h < 2; ++h)
#pragma unroll
            for (int i = 0; i < 2; ++i) v[h * 2 + i] = (unsigned)((h * 128 + RA[i]) * pa + CA[i] * 2);
    }
};

struct EpiOut {
    static constexpr bool PERM = true;
    bf16_t* upd; const float* mod;
    DI void operator()(const f32x4 (&acc)[2][2][4][2], const pg8::Unit& u, int wr, int wc, int fr, int fq, LAS unsigned char*) const {
        asm volatile("" : "+v"(fr), "+v"(fq));
        const int row0 = u.pm * 256 + wr * 64 + fr, col0 = u.pn * 256 + wc * 32 + 8 * fq; const int b = (u.pm * 256) >> 13;
        f32x4 gv[2][2];
#pragma unroll
        for (int bj = 0; bj < 2; ++bj)
#pragma unroll
            for (int n = 0; n < 2; ++n) gv[bj][n] = *(const f32x4*)(mod + b * 6144 + 2048 + col0 + bj * 128 + n * 4) * 0.125f;
#pragma unroll
        for (int ai = 0; ai < 2; ++ai)
#pragma unroll
            for (int m = 0; m < 4; ++m)
#pragma unroll
                for (int bj = 0; bj < 2; ++bj) { const f32x4 v0 = acc[ai][bj][m][0] * gv[bj][0], v1 = acc[ai][bj][m][1] * gv[bj][1];
                    u32x4 w; w.x = pk2(v0.x, v0.y); w.y = pk2(v0.z, v0.w); w.z = pk2(v1.x, v1.y); w.w = pk2(v1.z, v1.w);
                    *(u32x4*)(upd + (size_t)(row0 + ai * 128 + m * 16) * 1024 + col0 + bj * 128) = w; }
    }
};

struct EpiLogit {
    static constexpr bool PERM = false;
    float* logit;
    DI void operator()(const f32x4 (&acc)[2][2][4][2], const pg8::Unit& u, int wr, int wc, int fr, int fq, LAS unsigned char*) const {
        asm volatile("" : "+v"(fr), "+v"(fq));
        const int row0 = u.pm * 256 + wr * 64 + fr, col0 = wc * 32 + 4 * fq;
#pragma unroll
        for (int ai = 0; ai < 2; ++ai)
#pragma unroll
            for (int m = 0; m < 4; ++m)
#pragma unroll
                for (int n = 0; n < 2; ++n) *(f32x4*)(logit + (size_t)(row0 + ai * 128 + m * 16) * 128 + col0 + n * 16) = acc[ai][0][m][n];
    }
};

struct MoeSched {
    static constexpr bool GATHER_ = true;
    int G, c, nc; int pa, pb; unsigned A, B; const LAS int* cstart; const int* slot_tok; unsigned estride, pnstride;
};
struct MoeSchedUp : MoeSched {
    static constexpr bool GATHER = true, BLOCKDIAG = false;
    DI bool next(int i, pg8::Unit& u) const {
        const int L = i * G + c; if (L >= nc * 4) return false;
        const int chunk = L >> 2; int e = 0;
        for (int q = 1; q < 32; ++q) e += (chunk >= cstart[q]) ? 1 : 0;
        e = __builtin_amdgcn_readfirstlane(e);
        u.pm = chunk; u.pn = L & 3; u.aux = e; u.a = A; u.b = B + (unsigned)e * estride + (unsigned)u.pn * pnstride; return true;
    }
    DI void offs(const pg8::Unit& u, const int (&RA)[2], const int (&CA)[2], unsigned (&v)[4]) const {
#pragma unroll
        for (int h = 0; h < 2; ++h)
#pragma unroll
            for (int i = 0; i < 2; ++i) { const int tok = slot_tok[u.pm * 256 + h * 128 + RA[i]]; v[h * 2 + i] = (unsigned)(tok * pa + CA[i] * 2); }
    }
    DI void rows(const pg8::Unit& u, const int (&RA)[2], unsigned (&v)[4]) const {
#pragma unroll
        for (int h = 0; h < 2; ++h)
#pragma unroll
            for (int i = 0; i < 2; ++i) v[h * 2 + i] = (unsigned)slot_tok[u.pm * 256 + h * 128 + RA[i]];
    }
};
struct MoeSchedDn : MoeSched {
    static constexpr bool GATHER = false, BLOCKDIAG = false;
    DI bool next(int i, pg8::Unit& u) const {
        const int L = i * G + c; if (L >= nc * 4) return false;
        const int chunk = L >> 2; int e = 0;
        for (int q = 1; q < 32; ++q) e += (chunk >= cstart[q]) ? 1 : 0;
        e = __builtin_amdgcn_readfirstlane(e);
        u.pm = chunk; u.pn = L & 3; u.aux = e; u.a = A + (unsigned)(chunk * 256 * pa); u.b = B + (unsigned)e * estride + (unsigned)u.pn * pnstride; return true;
    }
    DI void offs(const pg8::Unit&, const int (&RA)[2], const int (&CA)[2], unsigned (&v)[4]) const {
#pragma unroll
        for (int h = 0; h < 2; ++h)
#pragma unroll
            for (int i = 0; i < 2; ++i) v[h * 2 + i] = (unsigned)((h * 128 + RA[i]) * pa + CA[i] * 2);
    }
};
struct EpiSwiglu {
    static constexpr bool PERM = true;
    unsigned char* hmid;
    DI void operator()(const f32x4 (&acc)[2][2][4][2], const pg8::Unit& u, int wr, int wc, int fr, int fq, LAS unsigned char*) const {
        asm volatile("" : "+v"(fr), "+v"(fq));
        const int row0 = u.pm * 256 + wr * 64 + fr, col0 = u.pn * 128 + wc * 32 + 8 * fq;
#pragma unroll
        for (int ai = 0; ai < 2; ++ai)
#pragma unroll
            for (int m = 0; m < 4; ++m) {
                f32x4 h[2];
#pragma unroll
                for (int n = 0; n < 2; ++n) { const f32x4 g = acc[ai][0][m][n], up = acc[ai][1][m][n];
                    h[n] = (f32x4){g.x * sigmoidf(g.x) * up.x, g.y * sigmoidf(g.y) * up.y, g.z * sigmoidf(g.z) * up.z, g.w * sigmoidf(g.w) * up.w}; }
                u32x2 w; w.x = pk4_fp8(h[0].x, h[0].y, h[0].z, h[0].w); w.y = pk4_fp8(h[1].x, h[1].y, h[1].z, h[1].w);
                *(u32x2*)(hmid + (size_t)(row0 + ai * 128 + m * 16) * DE + col0) = w; }
    }
};
struct EpiDown {
    static constexpr bool PERM = true;
    unsigned char* y;
    DI void operator()(const f32x4 (&acc)[2][2][4][2], const pg8::Unit& u, int wr, int wc, int fr, int fq, LAS unsigned char*) const {
        asm volatile("" : "+v"(fr), "+v"(fq));
        const int row0 = u.pm * 256 + wr * 64 + fr, col0 = u.pn * 256 + wc * 32 + 8 * fq;
#pragma unroll
        for (int ai = 0; ai < 2; ++ai)
#pragma unroll
            for (int m = 0; m < 4; ++m) { const int slot = row0 + ai * 128 + m * 16;
#pragma unroll
                for (int bj = 0; bj < 2; ++bj) { const f32x4 v0 = acc[ai][bj][m][0] * 8.f, v1 = acc[ai][bj][m][1] * 8.f;
                    u32x2 o; o.x = pk4_fp8(v0.x, v0.y, v0.z, v0.w); o.y = pk4_fp8(v1.x, v1.y, v1.z, v1.w);
                    *(u32x2*)(y + (size_t)slot * 1024 + col0 + bj * 128) = o; } }
    }
};

constexpr int SLOT_BYTES = 8192;
DI f32x16 mfma32(bf16x8 a, bf16x8 b, f32x16 c) { return __builtin_amdgcn_mfma_f32_32x32x16_bf16(a, b, c, 0, 0, 0); }
DI int swz_f(int r) { return (((r >> 1) & 1) << 2) | ((r >> 2) & 3); }
struct AttnLane { unsigned doff[4]; unsigned ka[4]; unsigned va[2][2]; };
DI void attn_lane_init(AttnLane& L, int lane) {
#pragma unroll
    for (int i = 0; i < 4; ++i) { const int r = 8 * i + (lane >> 3), c = (lane & 7) ^ swz_f(r); L.doff[i] = (unsigned)(r * 128 + c * 16); }
    { const int r = lane & 31, h = lane >> 5; const unsigned a0 = (unsigned)(r * 128 + 16 * ((h ^ swz_f(r)) & 7));
#pragma unroll
      for (int s = 0; s < 4; ++s) L.ka[s] = a0 ^ (unsigned)(32 * s); }
    { const int h = lane >> 5, blk = (lane >> 4) & 1, q = (lane & 15) >> 2, p = lane & 3, fb2 = (q >> 1) & 1;
#pragma unroll
      for (int t = 0; t < 2; ++t) { const int flow = (2 * t + h) & 3;
#pragma unroll
        for (int mt = 0; mt < 2; ++mt) L.va[t][mt] = (unsigned)(4096 + (8 * t + 4 * h + q) * 128 + 16 * (4 * (mt ^ fb2) + ((2 * blk + (p >> 1)) ^ flow)) + 8 * (p & 1)); } }
}
DI void dma_tile(const AttnLane& L, const __amdgpu_buffer_rsrc_t rs, unsigned koff, unsigned voff, LAS unsigned char* slot) {
#pragma unroll
    for (int i = 0; i < 4; ++i) __builtin_amdgcn_raw_ptr_buffer_load_lds(rs, (LAS unsigned*)(slot + 1024 * i), 16, (int)L.doff[i], (int)koff, 0, 0);
#pragma unroll
    for (int i = 0; i < 4; ++i) __builtin_amdgcn_raw_ptr_buffer_load_lds(rs, (LAS unsigned*)(slot + 4096 + 1024 * i), 16, (int)L.doff[i], (int)voff, 0, 0);
}
DI void tr_read8(const AttnLane& L, unsigned sb, bf16x8 (&vf)[2][2]) {
    s16x4 r0, r1, r2, r3, r4, r5, r6, r7;
    const unsigned a00 = sb + L.va[0][0], a10 = sb + L.va[1][0], a01 = sb + L.va[0][1], a11 = sb + L.va[1][1];
    asm volatile("ds_read_b64_tr_b16 %0, %8\n\tds_read_b64_tr_b16 %1, %9\n\tds_read_b64_tr_b16 %2, %8 offset:2048\n\tds_read_b64_tr_b16 %3, %9 offset:2048\n\t"
                 "ds_read_b64_tr_b16 %4, %10\n\tds_read_b64_tr_b16 %5, %11\n\tds_read_b64_tr_b16 %6, %10 offset:2048\n\tds_read_b64_tr_b16 %7, %11 offset:2048\n\ts_waitcnt lgkmcnt(0)"
                 : "=&v"(r0), "=&v"(r1), "=&v"(r2), "=&v"(r3), "=&v"(r4), "=&v"(r5), "=&v"(r6), "=&v"(r7)
                 : "v"(a00), "v"(a10), "v"(a01), "v"(a11) : "memory");
    vf[0][0] = __builtin_shufflevector(r0, r1, 0, 1, 2, 3, 4, 5, 6, 7); vf[0][1] = __builtin_shufflevector(r2, r3, 0, 1, 2, 3, 4, 5, 6, 7);
    vf[1][0] = __builtin_shufflevector(r4, r5, 0, 1, 2, 3, 4, 5, 6, 7); vf[1][1] = __builtin_shufflevector(r6, r7, 0, 1, 2, 3, 4, 5, 6, 7);
}
DI bf16x8 pack8(const f32x16& x, int s) {
    u32x4 p; p.x = pk2(x[8 * s], x[8 * s + 1]); p.y = pk2(x[8 * s + 2], x[8 * s + 3]); p.z = pk2(x[8 * s + 4], x[8 * s + 5]); p.w = pk2(x[8 * s + 6], x[8 * s + 7]);
    return __builtin_bit_cast(bf16x8, p);
}
DI void store_o_row(bf16_t* rowp, const f32x16& O0, const f32x16& O1, float sc, int h) {
#pragma unroll
    for (int mt = 0; mt < 2; ++mt)
#pragma unroll
        for (int kp = 0; kp < 2; ++kp) { const f32x16& O = mt ? O1 : O0; const int g0 = 8 * kp, g1 = 8 * kp + 4;
            u32x2 a, b; a.x = pk2(O[g0] * sc, O[g0 + 1] * sc); a.y = pk2(O[g0 + 2] * sc, O[g0 + 3] * sc); b.x = pk2(O[g1] * sc, O[g1 + 1] * sc); b.y = pk2(O[g1 + 2] * sc, O[g1 + 3] * sc);
            { auto r = __builtin_amdgcn_permlane32_swap(a.x, b.x, false, false); a.x = r[0]; b.x = r[1]; }
            { auto r = __builtin_amdgcn_permlane32_swap(a.y, b.y, false, false); a.y = r[0]; b.y = r[1]; }
            *(u32x4*)(rowp + 32 * mt + 16 * kp + 8 * h) = (u32x4){a.x, a.y, b.x, b.y}; }
}
DI void store_o_row_fp8(unsigned char* rowp, const f32x16& O0, const f32x16& O1, int h) {
#pragma unroll
    for (int mt = 0; mt < 2; ++mt)
#pragma unroll
        for (int kp = 0; kp < 2; ++kp) { const f32x16& O = mt ? O1 : O0; const int g0 = 8 * kp, g1 = 8 * kp + 4;
            unsigned a = pk4_fp8(O[g0], O[g0 + 1], O[g0 + 2], O[g0 + 3]), b = pk4_fp8(O[g1], O[g1 + 1], O[g1 + 2], O[g1 + 3]);
            { auto r = __builtin_amdgcn_permlane32_swap(a, b, false, false); a = r[0]; b = r[1]; }
            *(u32x2*)(rowp + 32 * mt + 16 * kp + 8 * h) = (u32x2){a, b}; }
}
#define ATTN_WAIT_TILE(more) do { if (more) asm volatile("s_waitcnt vmcnt(8)" ::: "memory"); else asm volatile("s_waitcnt vmcnt(0)" ::: "memory"); } while (0)
DI void dil_tile(const AttnLane& L, const __amdgpu_buffer_rsrc_t rs, const bf16_t* hb, int hd, long row0, int j, LAS unsigned char* ldsW, bf16_t* og, float* lse, int lane, const float (&gq)[32], const bf16_t* ropet, long tok0, int dil) {
    const int qi = lane & 31, h = lane >> 5;
    const bf16_t* qh = hb + (size_t)hd * T * 64;
    const unsigned kh = (unsigned)(WS_PROJ + ((size_t)(16 + hd) * T + row0) * 128), vh = (unsigned)(WS_PROJ + ((size_t)(32 + hd) * T + row0) * 128);
    bf16x8 qf[4];
    {
        const bf16_t* qp = qh + (size_t)(row0 + 32 * j + qi) * 64 + 8 * h;
        u32x4 qr[4];
#pragma unroll
        for (int s = 0; s < 4; ++s) qr[s] = *(const u32x4*)(qp + 16 * s);
        const u32x4* rpt = (const u32x4*)(ropet + (size_t)(tok0 + (long)dil * (32 * j + qi)) * 16); const u32x4 cc = rpt[0], sn = rpt[1];
        float qv[4][8]; float ss = 0.f;
#pragma unroll
        for (int s = 0; s < 4; ++s) { const u32x4 u = qr[s]; qv[s][0] = bf_lo(u.x); qv[s][1] = bf_hi(u.x); qv[s][2] = bf_lo(u.y); qv[s][3] = bf_hi(u.y); qv[s][4] = bf_lo(u.z); qv[s][5] = bf_hi(u.z); qv[s][6] = bf_lo(u.w); qv[s][7] = bf_hi(u.w);
#pragma unroll
            for (int e = 0; e < 8; ++e) ss += qv[s][e] * qv[s][e]; }
        ss += __shfl_xor(ss, 32);
        const float rinv = __builtin_amdgcn_rsqf(ss * (1.f / 64.f) + RMS_EPS) * QSCALE;
#pragma unroll
        for (int s = 0; s < 4; ++s)
#pragma unroll
            for (int e = 0; e < 8; ++e) qv[s][e] *= rinv * gq[s * 8 + e];
        { const float cs[8] = {bf_lo(cc.x), bf_hi(cc.x), bf_lo(cc.y), bf_hi(cc.y), bf_lo(cc.z), bf_hi(cc.z), bf_lo(cc.w), bf_hi(cc.w)};
          const float sv[8] = {bf_lo(sn.x), bf_hi(sn.x), bf_lo(sn.y), bf_hi(sn.y), bf_lo(sn.z), bf_hi(sn.z), bf_lo(sn.w), bf_hi(sn.w)};
#pragma unroll
          for (int e = 0; e < 8; ++e) { const float other = __shfl_xor(qv[0][e], 32); qv[0][e] = qv[0][e] * cs[e] + other * (h ? sv[e] : -sv[e]); } }
#pragma unroll
        for (int s = 0; s < 4; ++s) { u32x4 o; o.x = pk2(qv[s][0], qv[s][1]); o.y = pk2(qv[s][2], qv[s][3]); o.z = pk2(qv[s][4], qv[s][5]); o.w = pk2(qv[s][6], qv[s][7]); qf[s] = __builtin_bit_cast(bf16x8, o); }
    }
    float mrun = -INFINITY, lrun = 0.f;
    f32x16 O0, O1;
#pragma unroll
    for (int i = 0; i < 16; ++i) { O0[i] = 0.f; O1[i] = 0.f; }
    const int kt0 = j >= 4 ? j - 4 : 0;
    dma_tile(L, rs, kh + (unsigned)(4096 * kt0), vh + (unsigned)(4096 * kt0), ldsW);
    unsigned buf = 0;
    for (int kt = kt0; kt <= j; ++kt) {
        const bool more = kt < j;
        if (more) dma_tile(L, rs, kh + (unsigned)(4096 * (kt + 1)), vh + (unsigned)(4096 * (kt + 1)), ldsW + (buf ^ 1u) * SLOT_BYTES);
        ATTN_WAIT_TILE(more);
        LAS unsigned char* slot = ldsW + buf * SLOT_BYTES;
        f32x16 sc;
#pragma unroll
        for (int i = 0; i < 16; ++i) sc[i] = 0.f;
#pragma unroll
        for (int s = 0; s < 4; ++s) { const bf16x8 kf = *(const LAS bf16x8*)(slot + L.ka[s]); sc = mfma32(kf, qf[s], sc); }
        if (kt == j) {
#pragma unroll
            for (int i = 0; i < 16; ++i) { const int key = (i & 3) + 8 * (i >> 2) + 4 * h; if (key > qi) sc[i] = -INFINITY; }
        }
        if (kt == j - 4) {
#pragma unroll
            for (int i = 0; i < 16; ++i) { const int key = (i & 3) + 8 * (i >> 2) + 4 * h; if (key < qi) sc[i] = -INFINITY; }
        }
        float mx = sc[0];
#pragma unroll
        for (int i = 1; i < 16; ++i) mx = fmaxf(mx, sc[i]);
        mx = fmaxf(mx, __shfl_xor(mx, 32));
        const float mnew = fmaxf(mrun, mx), alpha = fexp2(mrun - mnew);
        float ps = 0.f;
#pragma unroll
        for (int i = 0; i < 16; ++i) { sc[i] = fexp2(sc[i] - mnew); ps += sc[i]; }
        lrun = lrun * alpha + ps; mrun = mnew;
#pragma unroll
        for (int i = 0; i < 16; ++i) { O0[i] *= alpha; O1[i] *= alpha; }
        const bf16x8 p0 = pack8(sc, 0), p1 = pack8(sc, 1);
        bf16x8 vf[2][2]; tr_read8(L, (unsigned)(size_t)slot, vf);
        O0 = mfma32(vf[0][0], p0, O0); O0 = mfma32(vf[0][1], p1, O0);
        O1 = mfma32(vf[1][0], p0, O1); O1 = mfma32(vf[1][1], p1, O1);
        buf ^= 1u;
    }
    const float ltot = lrun + __shfl_xor(lrun, 32), inv = frcp(ltot);
    const size_t row = (size_t)(row0 + 32 * j + qi);
    store_o_row(og + row * 64, O0, O1, inv, h);
    if (h == 0) lse[row] = mrun + flog2(ltot);
}
DI void sb_tile(const AttnLane& L, const __amdgpu_buffer_rsrc_t rs, const bf16_t* hb, int b, int h4, int j, LAS unsigned char* ldsW, unsigned char* ocat, int lane) {
    const int qi = lane & 31, h = lane >> 5;
    const long base = (long)b * S;
    const bf16_t* qh = hb + (size_t)(12 + h4) * T * 64;
    const unsigned kh = (unsigned)(WS_PROJ + ((size_t)(16 + 12 + h4) * T + base) * 128), vh = (unsigned)(WS_PROJ + ((size_t)(32 + 12 + h4) * T + base) * 128);
    bf16x8 qf[4];
    { const bf16_t* qp = qh + (size_t)(base + 32 * j + qi) * 64 + 8 * h;
#pragma unroll
      for (int s = 0; s < 4; ++s) qf[s] = *(const bf16x8*)(qp + 16 * s); }
    float carry = 0.f;
    f32x16 O0, O1;
#pragma unroll
    for (int i = 0; i < 16; ++i) { O0[i] = 0.f; O1[i] = 0.f; }
    dma_tile(L, rs, kh + (unsigned)(4096 * j), vh + (unsigned)(4096 * j), ldsW);
    unsigned buf = 0;
    for (int kt = j; kt >= 0; --kt) {
        const bool more = kt > 0;
        if (more) dma_tile(L, rs, kh + (unsigned)(4096 * (kt - 1)), vh + (unsigned)(4096 * (kt - 1)), ldsW + (buf ^ 1u) * SLOT_BYTES);
        ATTN_WAIT_TILE(more);
        LAS unsigned char* slot = ldsW + buf * SLOT_BYTES;
        f32x16 z;
#pragma unroll
        for (int i = 0; i < 16; ++i) z[i] = 0.f;
#pragma unroll
        for (int s = 0; s < 4; ++s) { const bf16x8 kf = *(const LAS bf16x8*)(slot + L.ka[s]); z = mfma32(kf, qf[s], z); }
#pragma unroll
        for (int i = 0; i < 16; ++i) z[i] = fexp2(fminf(z[i], 31.f));
        if (kt == j) {
#pragma unroll
            for (int i = 0; i < 16; ++i) { const int key = (i & 3) + 8 * (i >> 2) + 4 * h; if (key >= qi) z[i] = 0.f; }
        }
        float lg[4], par[4], u0[4], p01[4], p012[4];
#pragma unroll
        for (int g = 0; g < 4; ++g) { const float a0 = 1.f + z[4 * g], a1 = 1.f + z[4 * g + 1], a2 = 1.f + z[4 * g + 2], a3 = 1.f + z[4 * g + 3];
            u0[g] = a0; p01[g] = a0 * a1; p012[g] = p01[g] * a2; lg[g] = -flog2(p012[g] * a3); }
#pragma unroll
        for (int g = 0; g < 4; ++g) par[g] = __shfl_xor(lg[g], 32);
        float tg[4]; tg[3] = carry; tg[2] = tg[3] + (lg[3] + par[3]); tg[1] = tg[2] + (lg[2] + par[2]); tg[0] = tg[1] + (lg[1] + par[1]);
        carry = tg[0] + (lg[0] + par[0]);
#pragma unroll
        for (int g = 0; g < 4; ++g) { const float suf = tg[g] + lg[g] + (h == 0 ? par[g] : 0.f); const float y = fexp2(suf);
            z[4 * g] = z[4 * g] * y; z[4 * g + 1] = z[4 * g + 1] * (y * u0[g]); z[4 * g + 2] = z[4 * g + 2] * (y * p01[g]); z[4 * g + 3] = z[4 * g + 3] * (y * p012[g]); }
        const bf16x8 p0 = pack8(z, 0), p1 = pack8(z, 1);
        bf16x8 vf[2][2]; tr_read8(L, (unsigned)(size_t)slot, vf);
        O0 = mfma32(vf[0][0], p0, O0); O0 = mfma32(vf[0][1], p1, O0);
        O1 = mfma32(vf[1][0], p0, O1); O1 = mfma32(vf[1][1], p1, O1);
        if (__all(carry < -40.f)) break;
        buf ^= 1u;
    }
    store_o_row_fp8(ocat + (size_t)(base + 32 * j + qi) * LDO + 256 + h4 * 64, O0, O1, h);
}
DI void phase_attn(const Frame& F, const Params& p) {
    const int tid_ = fresh_tid(), lane_ = tid_ & 63;
    const bf16_t* hb = (const bf16_t*)(F.ws + WS_PROJ); unsigned char* ocat = F.ws + WS_OCAT;
    bf16_t* og = (bf16_t*)(F.ws + WS_OG); float* lse = (float*)(F.ws + WS_LSE);
    LAS unsigned char* ldsW = F.lds + F.wave * (2 * SLOT_BYTES);
    AttnLane L; attn_lane_init(L, lane_);
    float gq[32];
#pragma unroll
    for (int s4 = 0; s4 < 4; ++s4)
#pragma unroll
        for (int e = 0; e < 8; ++e) gq[s4 * 8 + e] = p.in[I_QG][16 * s4 + 8 * (lane_ >> 5) + e];
    const __amdgpu_buffer_rsrc_t rs = __builtin_amdgcn_make_buffer_rsrc(F.ws, 0, (int)WS_END, 0x00020000);
    const int NU = NB * 4 * 16;
    for (int i = 0;; ++i) {
        const int u = (F.G == 256) ? ((F.bid & 7) * 32 + (F.bid >> 3) + 256 * i) : (F.bid + F.G * i);
        if (u >= NU) break;
        const int qb = u & 15, hs = (u >> 4) & 3, b = u >> 6, t0 = qb * 512;
        for (int w = F.wave; w < 16; w += 8) sb_tile(L, rs, hb, b, hs, t0 / 32 + w, ldsW, ocat, lane_);
        for (int w = F.wave; w < 48; w += 8) {
            const int g = w >> 4, ti = w & 15, l2d = 2 * g, per = 16 >> l2d, r = ti / per, jj = ti % per;
            dil_tile(L, rs, hb, g * 4 + hs, (long)b * S + (long)r * (S >> l2d), ((t0 >> l2d) >> 5) + jj, ldsW, og + (size_t)(g * 4 + hs) * T * 64, lse + (size_t)(g * 4 + hs) * T, lane_, gq, (const bf16_t*)(F.ws + WS_ROPE), (long)b * S + r, 1 << l2d);
        }
        VM_WAIT();
        __syncthreads();
        {
            const int piece = tid_ & 7; const size_t bb = (size_t)b * S;
#pragma unroll 2
            for (int pass = 0; pass < 8; ++pass) {
                const int sq = t0 + pass * 64 + (tid_ >> 3);
                const size_t r0 = bb + sq, r1 = bb + ((size_t)(sq & 3) << 11) + (sq >> 2), r2 = bb + ((size_t)(sq & 15) << 9) + (sq >> 4);
                const float l0 = lse[(size_t)(0 + hs) * T + r0], l1 = lse[(size_t)(4 + hs) * T + r1], l2 = lse[(size_t)(8 + hs) * T + r2];
                const u32x4 x = *((const u32x4*)(og + ((size_t)(0 + hs) * T + r0) * 64) + piece), y = *((const u32x4*)(og + ((size_t)(4 + hs) * T + r1) * 64) + piece), z = *((const u32x4*)(og + ((size_t)(8 + hs) * T + r2) * 64) + piece);
                const float mx = fmaxf(l0, fmaxf(l1, l2)); float w0 = fexp2(l0 - mx), w1 = fexp2(l1 - mx), w2 = fexp2(l2 - mx); const float inv = frcp(w0 + w1 + w2); w0 *= inv; w1 *= inv; w2 *= inv;
                u32x2 r;
                r.x = pk4_fp8(w0 * bf_lo(x.x) + w1 * bf_lo(y.x) + w2 * bf_lo(z.x), w0 * bf_hi(x.x) + w1 * bf_hi(y.x) + w2 * bf_hi(z.x), w0 * bf_lo(x.y) + w1 * bf_lo(y.y) + w2 * bf_lo(z.y), w0 * bf_hi(x.y) + w1 * bf_hi(y.y) + w2 * bf_hi(z.y));
                r.y = pk4_fp8(w0 * bf_lo(x.z) + w1 * bf_lo(y.z) + w2 * bf_lo(z.z), w0 * bf_hi(x.z) + w1 * bf_hi(y.z) + w2 * bf_hi(z.z), w0 * bf_lo(x.w) + w1 * bf_lo(y.w) + w2 * bf_lo(z.w), w0 * bf_hi(x.w) + w1 * bf_hi(y.w) + w2 * bf_hi(z.w));
                *((u32x2*)(ocat + (bb + sq) * LDO + hs * 64) + piece) = r;
            }
        }
        __syncthreads();
    }
}

DI void route_rows(const Frame& F, const Params& p, int pm) {
    const int tid_ = fresh_tid(), lane_ = tid_ & 63;
    LAS int* hist = (LAS int*)(F.lds);
    const int ftid = fresh_tid();
    __syncthreads();
    if (ftid < 32) hist[ftid] = 0;
    __syncthreads();
    if (tid_ < 256) {
        const int row = pm * 256 + tid_; const float* L = (const float*)(F.ws + WS_LOGIT) + (size_t)row * 128;
        const float* brg = p.in[I_BRG]; const float* bre = p.in[I_BRE];
        float lgp[4];
#pragma unroll
        for (int c = 0; c < 4; ++c) lgp[c] = L[c] + L[36 + c] + brg[c];
        int gsel = 0; float gm = lgp[0];
#pragma unroll
        for (int c = 1; c < 4; ++c) if (lgp[c] > gm) { gm = lgp[c]; gsel = c; }
        float zs = 0.f;
#pragma unroll
        for (int c = 0; c < 4; ++c) zs += fexp2((lgp[c] - gm) * LOG2E);
        const float pg = frcp(zs);
        float l1 = -INFINITY, l2 = -INFINITY; int e1 = 0, e2 = 0;
#pragma unroll
        for (int i = 0; i < 8; ++i) { const int c = 4 + gsel * 8 + i; const float v = L[c] + L[36 + c] + bre[gsel * 8 + i];
            if (v > l1) { l2 = l1; e2 = e1; l1 = v; e1 = i; } else if (v > l2) { l2 = v; e2 = i; } }
        const float ex = fexp2((l2 - l1) * LOG2E), den = frcp(1.f + ex);
        int* te = (int*)(F.ws + WS_TOKE) + (size_t)row * 2; float* tw = (float*)(F.ws + WS_TOKW) + (size_t)row * 2;
        te[0] = gsel * 8 + e1; te[1] = gsel * 8 + e2; tw[0] = pg * den; tw[1] = pg * ex * den;
        lds_add(&hist[gsel * 8 + e1], 1); lds_add(&hist[gsel * 8 + e2], 1);
    }
    __syncthreads();
    if (ftid < 32) ((int*)(F.ws + WS_HIST))[pm * 32 + ftid] = hist[ftid];
}


DI void router_weights_to_lds(const Frame& F, const Params& p) {
    const int tid_ = fresh_tid(), lane_ = tid_ & 63;
    constexpr int WP = 1028;
    LAS float* wt = (LAS float*)(F.lds + LDS_RW); LAS float* bias = (LAS float*)(F.lds + LDS_RS) + 8 * 80 + 32;
    const float* wrg = p.in[I_WRG]; const float* wre = p.in[I_WRE]; const float* brg = p.in[I_BRG]; const float* bre = p.in[I_BRE];
    const int ftid = fresh_tid();
    __syncthreads();
#pragma unroll 8
    for (int i = ftid; i < 1024 * 32; i += 512) wt[(4 + (i & 31)) * WP + (i >> 5)] = wre[i];
#pragma unroll 8
    for (int i = ftid; i < 1024 * 4; i += 512) wt[(i & 3) * WP + (i >> 2)] = wrg[i];
    if (ftid < 36) bias[ftid] = ftid < 4 ? brg[ftid] : bre[ftid - 4];
}

DI void phase_norm2_route(const Frame& F, const Params& p) {
    const int tid_ = fresh_tid(), lane_ = tid_ & 63;
    constexpr int WP = 1028;
    LAS float* wt = (LAS float*)(F.lds + LDS_RW);
    LAS float* gs = (LAS float*)(F.lds + LDS_RV); LAS float* sh = gs + 1024;
    LAS float* scr = (LAS float*)(F.lds + LDS_RS) + F.wave * 80;
    LAS int* hist = (LAS int*)(F.lds + LDS_RS) + 8 * 80;
    LAS float* bias = (LAS float*)(F.lds + LDS_RS) + 8 * 80 + 32;
    const float* mod = (const float*)(F.ws + WS_MOD); const float* gn = p.in[I_GFFN];
    const bf16_t* upd = (const bf16_t*)(F.ws + WS_UPD1); unsigned* h8 = (unsigned*)(F.ws + WS_H28);
    const float* wrg = p.in[I_WRG]; const float* wre = p.in[I_WRE]; const float* brg = p.in[I_BRG]; const float* bre = p.in[I_BRE];
    const int ftid = fresh_tid();
    __syncthreads();
    for (int chunk = F.bid; chunk < T / 256; chunk += F.G) {
        const int b = chunk >> 5;
        __syncthreads();
        for (int col = ftid; col < 1024; col += 512) { gs[col] = gn[col] * (1.f + mod[b * 6144 + 4096 + col]); sh[col] = mod[b * 6144 + 3072 + col]; }
        if (ftid < 32) hist[ftid] = 0;
        __syncthreads();
        f32x4 vn[2][4]; u32x2 un[2][4];
#pragma unroll
        for (int r = 0; r < 2; ++r) { const int row = chunk * 256 + F.wave * 2 + r;
            const f32x4* xr = (const f32x4*)(p.in[I_X] + (size_t)row * 1024) + lane_; const u32x2* ur = (const u32x2*)(upd + (size_t)row * 1024) + lane_;
#pragma unroll
            for (int j = 0; j < 4; ++j) { vn[r][j] = xr[64 * j]; un[r][j] = ur[64 * j]; } }
        for (int rr = F.wave * 2; rr < 256; rr += 16) {
            const int row0 = chunk * 256 + rr;
            f32x4 y[2][4];
#pragma unroll
            for (int r = 0; r < 2; ++r) {
                const int row = row0 + r; float ss = 0.f;
#pragma unroll
                for (int j = 0; j < 4; ++j) { vn[r][j].x += bf_lo(un[r][j].x); vn[r][j].y += bf_hi(un[r][j].x); vn[r][j].z += bf_lo(un[r][j].y); vn[r][j].w += bf_hi(un[r][j].y);
                    ss += (vn[r][j].x * vn[r][j].x + vn[r][j].y * vn[r][j].y) + (vn[r][j].z * vn[r][j].z + vn[r][j].w * vn[r][j].w); }
                const float rinv = __builtin_amdgcn_rsqf(wave_sum(ss) * (1.f / 1024.f) + RMS_EPS);
#pragma unroll
                for (int j = 0; j < 4; ++j) { const f32x4 gj = *(const LAS f32x4*)(gs + 256 * j + 4 * lane_), sj = *(const LAS f32x4*)(sh + 256 * j + 4 * lane_);
                    y[r][j] = vn[r][j] * rinv * gj + sj; h8[(size_t)row * 256 + 64 * j + lane_] = pk4_fp8(y[r][j].x, y[r][j].y, y[r][j].z, y[r][j].w); }
            }
            if (rr + 16 < 256) {
#pragma unroll
                for (int r = 0; r < 2; ++r) { const int row = row0 + 16 + r;
                    const f32x4* xr = (const f32x4*)(p.in[I_X] + (size_t)row * 1024) + lane_; const u32x2* ur = (const u32x2*)(upd + (size_t)row * 1024) + lane_;
#pragma unroll
                    for (int j = 0; j < 4; ++j) { vn[r][j] = xr[64 * j]; un[r][j] = ur[64 * j]; } }
            }
            const bool up32 = (lane_ & 32) != 0, up16 = (lane_ & 16) != 0, up8 = (lane_ & 8) != 0, up4 = (lane_ & 4) != 0;
            {
                f32x2 ga[2][4], gb[2][4];
#pragma unroll
                for (int r = 0; r < 2; ++r)
#pragma unroll
                    for (int c = 0; c < 4; ++c) { ga[r][c] = (f32x2){0.f, 0.f}; gb[r][c] = ga[r][c]; }
#pragma unroll
                for (int c = 0; c < 4; ++c)
#pragma unroll
                    for (int j = 0; j < 4; ++j) { const f32x4 w = *(const LAS f32x4*)(wt + c * WP + 4 * lane_ + 256 * j); const f32x2 wl = {w.x, w.y}, wh = {w.z, w.w};
#pragma unroll
                        for (int r = 0; r < 2; ++r) { ga[r][c] = __builtin_elementwise_fma((f32x2){y[r][j].x, y[r][j].y}, wl, ga[r][c]); gb[r][c] = __builtin_elementwise_fma((f32x2){y[r][j].z, y[r][j].w}, wh, gb[r][c]); } }
                float k4[4];
#pragma unroll
                for (int c = 0; c < 4; ++c) { const f32x2 t0 = ga[0][c] + gb[0][c], t1 = ga[1][c] + gb[1][c]; const float p0 = t0.x + t0.y, p1 = t1.x + t1.y;
                    k4[c] = up32 ? p0 : p1; ga[0][c].x = up32 ? p1 : p0; }
#pragma unroll
                for (int c = 0; c < 4; ++c) k4[c] = ga[0][c].x + __shfl_xor(k4[c], 32);
                float k2[2];
#pragma unroll
                for (int i = 0; i < 2; ++i) k2[i] = (up16 ? k4[2 + i] : k4[i]) + __shfl_xor(up16 ? k4[i] : k4[2 + i], 16);
                float k1 = (up8 ? k2[1] : k2[0]) + __shfl_xor(up8 ? k2[0] : k2[1], 8);
                k1 += __shfl_xor(k1, 4); k1 += __shfl_xor(k1, 2); k1 += __shfl_xor(k1, 1);
                if ((lane_ & 7) == 0) scr[(lane_ >> 5) * 36 + ((lane_ >> 4) & 1) * 2 + ((lane_ >> 3) & 1)] = k1;
            }
            LDS_WAIT();
            int gsel[2];
#pragma unroll
            for (int r = 0; r < 2; ++r) { int gi = 0; float gm = scr[r * 36] + bias[0];
#pragma unroll
                for (int c = 1; c < 4; ++c) { const float v = scr[r * 36 + c] + bias[c]; if (v > gm) { gm = v; gi = c; } }
                gsel[r] = __builtin_amdgcn_readfirstlane(gi); }
            {
                float pe[2][8];
#pragma unroll
                for (int r = 0; r < 2; ++r) {
                    const LAS float* wb = wt + (4 + gsel[r] * 8) * WP + 4 * lane_;
#pragma unroll
                    for (int hh = 0; hh < 2; ++hh) {
                        f32x2 ea[4], eb[4];
#pragma unroll
                        for (int i = 0; i < 4; ++i) { ea[i] = (f32x2){0.f, 0.f}; eb[i] = ea[i]; }
#pragma unroll
                        for (int i = 0; i < 4; ++i)
#pragma unroll
                            for (int j = 0; j < 4; ++j) { const f32x4 w = *(const LAS f32x4*)(wb + (hh * 4 + i) * WP + 256 * j);
                                ea[i] = __builtin_elementwise_fma((f32x2){y[r][j].x, y[r][j].y}, (f32x2){w.x, w.y}, ea[i]); eb[i] = __builtin_elementwise_fma((f32x2){y[r][j].z, y[r][j].w}, (f32x2){w.z, w.w}, eb[i]); }
#pragma unroll
                        for (int i = 0; i < 4; ++i) { const f32x2 t = ea[i] + eb[i]; pe[r][hh * 4 + i] = t.x + t.y; }
                        __builtin_amdgcn_sched_barrier(0);
                    }
                }
                float e8[8], e4[4], e2[2];
#pragma unroll
                for (int i = 0; i < 8; ++i) e8[i] = (up32 ? pe[1][i] : pe[0][i]) + __shfl_xor(up32 ? pe[0][i] : pe[1][i], 32);
#pragma unroll
                for (int i = 0; i < 4; ++i) e4[i] = (up16 ? e8[4 + i] : e8[i]) + __shfl_xor(up16 ? e8[i] : e8[4 + i], 16);
#pragma unroll
                for (int i = 0; i < 2; ++i) e2[i] = (up8 ? e4[2 + i] : e4[i]) + __shfl_xor(up8 ? e4[i] : e4[2 + i], 8);
                float e1 = (up4 ? e2[1] : e2[0]) + __shfl_xor(up4 ? e2[0] : e2[1], 4);
                e1 += __shfl_xor(e1, 2); e1 += __shfl_xor(e1, 1);
                if ((lane_ & 3) == 0) scr[(lane_ >> 5) * 36 + 4 + ((lane_ >> 4) & 1) * 4 + ((lane_ >> 3) & 1) * 2 + ((lane_ >> 2) & 1)] = e1;
            }
            LDS_WAIT();
            if (lane_ < 2) {
                const LAS float* L = scr + lane_ * 36; const int row = row0 + lane_;
                float lgp[4];
#pragma unroll
                for (int c = 0; c < 4; ++c) lgp[c] = L[c] + bias[c];
                int gsel = 0; float gm = lgp[0];
#pragma unroll
                for (int c = 1; c < 4; ++c) if (lgp[c] > gm) { gm = lgp[c]; gsel = c; }
                float zs = 0.f;
#pragma unroll
                for (int c = 0; c < 4; ++c) zs += fexp2((lgp[c] - gm) * LOG2E);
                const float pg = frcp(zs);
                float l1 = -INFINITY, l2 = -INFINITY; int e1 = 0, e2 = 0;
#pragma unroll
                for (int i = 0; i < 8; ++i) { const float v = L[4 + i] + bias[4 + gsel * 8 + i];
                    if (v > l1) { l2 = l1; e2 = e1; l1 = v; e1 = i; } else if (v > l2) { l2 = v; e2 = i; } }
                const float ex = fexp2((l2 - l1) * LOG2E), den = frcp(1.f + ex);
                int* te = (int*)(F.ws + WS_TOKE) + (size_t)row * 2; float* tw = (float*)(F.ws + WS_TOKW) + (size_t)row * 2;
                te[0] = gsel * 8 + e1; te[1] = gsel * 8 + e2; tw[0] = pg * den; tw[1] = pg * ex * den;
                lds_add(&hist[gsel * 8 + e1], 1); lds_add(&hist[gsel * 8 + e2], 1);
            }
            LDS_WAIT();
        }
        __syncthreads();
        if (ftid < 32) ((int*)(F.ws + WS_HIST))[chunk * 32 + ftid] = hist[ftid];
    }
}

DI void phase_slots(const Frame& F, const Params& p) {
    const int tid_ = fresh_tid(), lane_ = tid_ & 63;
    LAS int* tot = (LAS int*)(F.lds); LAS int* bas = tot + 32; LAS int* pst = tot + 64; LAS int* wcnt = tot + 128;
    const int* hist = (const int*)(F.ws + WS_HIST);
    for (int pm = F.bid; pm < T / 256; pm += F.G) {
        const int ftid = fresh_tid();
        __syncthreads();
        if (ftid < 64) tot[ftid] = 0;
        __syncthreads();
        { const int e = tid_ & 31, part = tid_ >> 5; int t = 0, bs = 0;
          for (int q = part; q < T / 256; q += 16) { const int v = hist[q * 32 + e]; t += v; if (q < pm) bs += v; }
          lds_add(&tot[e], t); lds_add(&bas[e], bs); }
        __syncthreads();
        if (tid_ == 0) { int run = 0; for (int e = 0; e < 32; ++e) { pst[e] = run; run += (tot[e] + 255) / 256 * 256; } pst[32] = run; }
        const int my_e = ((const int*)(F.ws + WS_TOKE))[(size_t)pm * 512 + tid_];
        int rank = 0;
        for (int e = 0; e < 32; ++e) { const unsigned long long mask = __ballot(my_e == e); if (my_e == e) rank = __popcll(mask & ((1ull << lane_) - 1ull)); if (lane_ == 0) wcnt[F.wave * 32 + e] = __popcll(mask); }
        __syncthreads();
        int woff = 0;
        for (int w = 0; w < F.wave; ++w) woff += wcnt[w * 32 + my_e];
        const int slot = pst[my_e] + bas[my_e] + woff + rank;
        ((int*)(F.ws + WS_SLOTTOK))[slot] = pm * 256 + (tid_ >> 1);
        ((float*)(F.ws + WS_SLOTW))[slot] = ((const float*)(F.ws + WS_TOKW))[(size_t)pm * 512 + tid_];
        ((int*)(F.ws + WS_TOKS))[(size_t)pm * 512 + tid_] = slot;
        if (pm < 32) { const int e = pm; for (int s = pst[e] + tot[e] + tid_; s < pst[e + 1]; s += 512) { ((int*)(F.ws + WS_SLOTTOK))[s] = 0; ((float*)(F.ws + WS_SLOTW))[s] = 0.f; } }
        if (pm == 0 && tid_ < 34) { int* et = (int*)(F.ws + WS_ETAB); if (tid_ < 33) et[64 + tid_] = pst[tid_] >> 8; if (tid_ < 32) { et[tid_] = tot[tid_]; et[32 + tid_] = pst[tid_]; } if (tid_ == 33) et[97] = pst[32] >> 8; }
    }
}

DI void phase_combine(const Frame& F, const Params& p) {
    const int tid_ = fresh_tid(), lane_ = tid_ & 63;
    const unsigned* y = (const unsigned*)(F.ws + WS_Y); const int* ts = (const int*)(F.ws + WS_TOKS); const float* tw = (const float*)(F.ws + WS_TOKW); const float* mod = (const float*)(F.ws + WS_MOD);
    const int gw = F.bid * 8 + F.wave, NGW = F.G * 8;
    for (int row = gw; row < T; row += NGW) {
        const int s0 = ts[(size_t)row * 2], s1 = ts[(size_t)row * 2 + 1]; const float w0 = tw[(size_t)row * 2] * 0.125f, w1 = tw[(size_t)row * 2 + 1] * 0.125f;
        const f32x4* xr = (const f32x4*)(p.in[I_X] + (size_t)row * 1024) + lane_; f32x4* orow = (f32x4*)(p.out + (size_t)row * 1024) + lane_;
        const u32x2* ur = (const u32x2*)((const bf16_t*)(F.ws + WS_UPD1) + (size_t)row * 1024) + lane_;
        const unsigned* y0 = y + (size_t)s0 * 256 + lane_; const unsigned* y1 = y + (size_t)s1 * 256 + lane_;
        const f32x4* g2 = (const f32x4*)(mod + (row >> 13) * 6144 + 5120) + lane_;
        f32x4 v[4], g[4]; unsigned a[4], c[4]; u32x2 uu[4];
#pragma unroll
        for (int j = 0; j < 4; ++j) { v[j] = xr[64 * j]; uu[j] = ur[64 * j]; a[j] = y0[64 * j]; c[j] = y1[64 * j]; g[j] = g2[64 * j]; }
#pragma unroll
        for (int j = 0; j < 4; ++j) { if (!DBG_X1_PLAIN) { v[j].x += bf_lo(uu[j].x); v[j].y += bf_hi(uu[j].x); v[j].z += bf_lo(uu[j].y); v[j].w += bf_hi(uu[j].y); }
            if (!DBG_SKIP_Y) { const f32x2 al = fp8_lo2(a[j]), ah = fp8_hi2(a[j]), cl = fp8_lo2(c[j]), ch = fp8_hi2(c[j]);
                v[j].x += g[j].x * (w0 * al.x + w1 * cl.x); v[j].y += g[j].y * (w0 * al.y + w1 * cl.y); v[j].z += g[j].z * (w0 * ah.x + w1 * ch.x); v[j].w += g[j].w * (w0 * ah.y + w1 * ch.y); } orow[64 * j] = v[j]; }
    }
}

__global__ void __launch_bounds__(512, 2) fwd(Params p) {
    extern __shared__ __attribute__((aligned(16))) unsigned char lds_raw[];
    Frame F;
    F.lds = (LAS unsigned char*)lds_raw; F.ws = p.ws;
    F.wave = __builtin_amdgcn_readfirstlane((int)threadIdx.x >> 6); F.G = gridDim.x; F.bid = blockIdx.x;
    volatile LAS unsigned* ctl = (volatile LAS unsigned*)(F.lds + LDS_CTLO);
    { const int ftid = fresh_tid(); if (ftid < 64) ctl[ftid] = 0u; }
    __syncthreads();
    XcdBarrier bar; bar.bar = (unsigned*)(p.ws + WS_CTL) + CW_BAR; bar.x = 0; bar.st = ctl;
    if (MK_N_LAUNCHES == 1) bar = xcd_barrier_post((unsigned*)(p.ws + WS_CTL) + CW_BAR, ctl);
    const int lo = p.ph_lo, hi = p.ph_hi;
    const __amdgpu_buffer_rsrc_t rsw = __builtin_amdgcn_make_buffer_rsrc(p.ws, 0, (int)WS_END, 0x00020000);
#define IN(k) (lo <= (k) && (k) < hi)
#define REP(k) for (int rep_ = 0; rep_ < ((PROBE_PH) == (k) ? 2 : 1); ++rep_)
#define SEAM(k) do { if (IN(k) && IN((k) + 1)) xcd_barrier(bar); } while (0)

    if (IN(0)) REP(0) { phase0(F, p); } SEAM(0);
    if (IN(1)) REP(1) { phase_norm<0>(F, p); } SEAM(1);
    if (IN(2)) REP(2) {
        REP(20) {
            pg8::DenseSched Sd; Sd.init(T, 2304, F.G, F.bid, WS_H8, 1024, WS_W1D8, 1024);
            EpiProj<false> E{(bf16_t*)(F.ws + WS_PROJ), (bf16_t*)(F.ws + WS_GATES), (const bf16_t*)(F.ws + WS_ROPE), p.in[I_QG], p.in[I_KG], 0};
            pg8::gemm_phase<EpiProj<false>, pg8::DenseSched, true>(F.lds, 1024, Sd, E, rsw);
        }
        REP(21) {
            pg8::DenseSched Sd; Sd.init(T, 768, F.G, F.bid, WS_H, 2048, WS_W1 + (size_t)2304 * 2048, 2048);
            EpiProj<false> E{(bf16_t*)(F.ws + WS_PROJ), (bf16_t*)(F.ws + WS_GATES), (const bf16_t*)(F.ws + WS_ROPE), p.in[I_QG], p.in[I_KG], 9};
            pg8::gemm_phase<EpiProj<false>, pg8::DenseSched, false>(F.lds, 1024, Sd, E, rsw);
        }
        REP(22) {
            pg8::DenseSched Sd; Sd.init(T, 2048, F.G, F.bid, WS_H8, 1024, WS_WG8, 1024);
            EpiProj<true> E{(bf16_t*)(F.ws + WS_PROJ), (bf16_t*)(F.ws + WS_GATES), (const bf16_t*)(F.ws + WS_ROPE), p.in[I_QG], p.in[I_KG], 0};
            pg8::gemm_phase<EpiProj<true>, pg8::DenseSched, true>(F.lds, 1024, Sd, E, rsw);
        }
    } SEAM(2);
    if (IN(3)) REP(3) { phase_attn(F, p); } SEAM(3);
    if (IN(4)) REP(4) {
        pg8::DiagSched Sd; Sd.init(T, 2048, F.G, F.bid, WS_OCAT, 512, WS_WB, 512);
        EpiBranch E{(const unsigned char*)(F.ws + WS_GATES), F.ws + WS_MERGED};
        pg8::gemm_phase<EpiBranch, pg8::DiagSched, true>(F.lds, 512, Sd, E, rsw);
    } SEAM(4);
    if (IN(5)) REP(5) {
        pg8::DenseSched Sd; Sd.init(T, 1024, F.G, F.bid, WS_MERGED, 1024, WS_WO, 1024);
        EpiOut E{(bf16_t*)(F.ws + WS_UPD1), (const float*)(F.ws + WS_MOD)};
        pg8::gemm_phase<EpiOut, pg8::DenseSched, true>(F.lds, 1024, Sd, E, rsw);
        if (rep_ + 1 == ((PROBE_PH) == 5 ? 2 : 1)) router_weights_to_lds(F, p);
    } SEAM(5);
    if (IN(6)) REP(6) { phase_norm2_route(F, p); }
    if (IN(6) && IN(8)) xcd_barrier(bar);
    if (IN(8)) REP(8) { phase_slots(F, p); } SEAM(8);
    if (IN(9) || IN(10)) {
        LAS int* cst = (LAS int*)(F.lds + LDS_CTLO) + 16;
        __syncthreads();
        { const int ftid = fresh_tid(); if (ftid < 34) cst[ftid] = ((const int*)(F.ws + WS_ETAB))[64 + ftid]; }
        __syncthreads();
    }
    if (IN(9)) REP(9) {
        const LAS int* cst = (const LAS int*)(F.lds + LDS_CTLO) + 16;
        MoeSchedUp Sm; Sm.G = F.G; Sm.c = (F.G == 256) ? ((F.bid & 7) * 32 + (F.bid >> 3)) : F.bid; Sm.nc = __builtin_amdgcn_readfirstlane(cst[33]); Sm.pa = 1024; Sm.pb = 1024; Sm.A = (unsigned)WS_H28; Sm.B = (unsigned)WS_WGU; Sm.cstart = cst;
        Sm.slot_tok = (const int*)(F.ws + WS_SLOTTOK); Sm.estride = 1024u * 1024u; Sm.pnstride = 256u * 1024u;
        EpiSwiglu E{F.ws + WS_HMID};
        pg8::gemm_phase<EpiSwiglu, MoeSchedUp, true>(F.lds, 1024, Sm, E, rsw);
    } SEAM(9);
    if (IN(10)) REP(10) {
        const LAS int* cst = (const LAS int*)(F.lds + LDS_CTLO) + 16;
        MoeSchedDn Sm; Sm.G = F.G; Sm.c = (F.G == 256) ? ((F.bid & 7) * 32 + (F.bid >> 3)) : F.bid; Sm.nc = __builtin_amdgcn_readfirstlane(cst[33]); Sm.pa = 512; Sm.pb = 512; Sm.A = (unsigned)WS_HMID; Sm.B = (unsigned)WS_WDN; Sm.cstart = cst;
        Sm.slot_tok = (const int*)(F.ws + WS_SLOTTOK); Sm.estride = 1024u * 512u; Sm.pnstride = 256u * 512u;
        EpiDown E{F.ws + WS_Y};
        pg8::gemm_phase<EpiDown, MoeSchedDn, true>(F.lds, 512, Sm, E, rsw);
    } SEAM(10);
    if (IN(11)) { phase_combine(F, p); }
#undef IN
#undef SEAM
}

extern "C" void kernel_launch(void* const* d_in, const int* in_sizes, int n_in, void* d_out, int out_size, void* d_ws, size_t ws_size, hipStream_t stream) {
    static int grid = 0;
    if (grid == 0) {
        if (n_in != 21 || in_sizes[0] != T * D || out_size != T * D || ws_size < WS_END) { fprintf(stderr, "kernel_launch: unexpected problem (n_in %d, ws %zu)\n", n_in, ws_size); grid = -1; return; }
        int dev = 0, cus = 0, per_cu = 0;
        if (hipGetDevice(&dev) != hipSuccess || hipDeviceGetAttribute(&cus, hipDeviceAttributeMultiprocessorCount, dev) != hipSuccess) { grid = -1; return; }
        if (hipFuncSetAttribute((const void*)fwd, hipFuncAttributeMaxDynamicSharedMemorySize, LDS_BYTES) != hipSuccess) { fprintf(stderr, "kernel_launch: hipFuncSetAttribute failed\n"); grid = -1; return; }
        if (hipOccupancyMaxActiveBlocksPerMultiprocessor(&per_cu, (const void*)fwd, 512, LDS_BYTES) != hipSuccess || per_cu < 1) { fprintf(stderr, "kernel_launch: occupancy query says %d\n", per_cu); (void)hipGetLastError(); grid = -1; return; }
        grid = cus;
    }
    if (grid < 0) return;
    (void)hipMemsetAsync((char*)d_ws + WS_CTL, 0, CTL_ZERO_BYTES, stream);
    Params p{};
    for (int i = 0; i < 21; ++i) p.in[i] = (const float*)d_in[i];
    p.out = (float*)d_out; p.ws = (unsigned char*)d_ws;
    if (MK_N_LAUNCHES == 1) { p.ph_lo = 0; p.ph_hi = NPH; hipLaunchKernelGGL(fwd, dim3(grid), dim3(512), LDS_BYTES, stream, p); }
    else { for (int k = 0; k < NPH; ++k) { p.ph_lo = k; p.ph_hi = k + 1; hipLaunchKernelGGL(fwd, dim3(grid), dim3(512), LDS_BYTES, stream, p); } }
}
```

```cpp
#include <hip/hip_runtime.h>
#include <cstdio>
#include <cstdint>

#ifndef MK_N_LAUNCHES
#define MK_N_LAUNCHES 1
#endif
#define DBG_X1_PLAIN 0
#define DBG_SKIP_Y 0
#ifndef PROBE_PH
#define PROBE_PH -1
#endif

#define LAS __attribute__((address_space(3)))
#define DI __device__ __forceinline__
typedef unsigned short bf16_t;
typedef short bf16x8 __attribute__((ext_vector_type(8)));
typedef short s16x4 __attribute__((ext_vector_type(4)));
typedef float f32x2 __attribute__((ext_vector_type(2)));
typedef float f32x4 __attribute__((ext_vector_type(4)));
typedef float f32x16 __attribute__((ext_vector_type(16)));
typedef unsigned u32x2 __attribute__((ext_vector_type(2)));
typedef unsigned u32x4 __attribute__((ext_vector_type(4)));
typedef __bf16 bf16x2n __attribute__((ext_vector_type(2)));
typedef int i32x8 __attribute__((ext_vector_type(8)));

constexpr int NB = 8, S = 8192, D = 1024, T = NB * S;
constexpr int LDP = 3072, LDG = 2048, LDO = 512;
constexpr int NE = 32, DE = 512;
constexpr int MAXSLOT = T * 2 + NE * 256;
constexpr int NPH = 12;
constexpr float LOG2E = 1.4426950408889634f;
constexpr float QSCALE = 0.125f * LOG2E;
constexpr float RMS_EPS = 1e-6f;

constexpr size_t MiB = 1u << 20;
constexpr size_t WS_CTL = 0, CTL_ZERO_BYTES = 64 * 1024;
constexpr int CW_BAR = 1024;
constexpr size_t WS_MODP = 1 * MiB;
constexpr size_t WS_MOD = 3 * MiB;
constexpr size_t WS_ROPE = 4 * MiB;
constexpr size_t WS_LOGIT = 144 * MiB;
constexpr size_t WS_TOKE = 24 * MiB;
constexpr size_t WS_TOKW = 24 * MiB + 512 * 1024;
constexpr size_t WS_TOKS = 25 * MiB;
constexpr size_t WS_SLOTTOK = 25 * MiB + 512 * 1024;
constexpr size_t WS_SLOTW = 26 * MiB + 256 * 1024;
constexpr size_t WS_HIST = 27 * MiB;
constexpr size_t WS_ETAB = 27 * MiB + 256 * 1024;
constexpr size_t WS_WR = 28 * MiB;
constexpr size_t WS_W1D8 = 28 * MiB + 512 * 1024;
constexpr size_t WS_W1 = 32 * MiB;
constexpr size_t WS_WG8 = 38 * MiB;
constexpr size_t WS_WB = 40 * MiB;
constexpr size_t WS_WO = 43 * MiB;
constexpr size_t WS_WGU = 48 * MiB;
constexpr size_t WS_WDN = 80 * MiB;
constexpr size_t WS_H = 144 * MiB;
constexpr size_t WS_OG = 144 * MiB;
constexpr size_t WS_LSE = 240 * MiB;
constexpr size_t WS_PROJ = 272 * MiB;
constexpr size_t WS_GATES = 656 * MiB;
constexpr size_t WS_OCAT = 912 * MiB;
constexpr size_t WS_H8 = 912 * MiB;
constexpr size_t WS_MERGED = 272 * MiB;
constexpr size_t WS_H2 = 400 * MiB;
constexpr size_t WS_H28 = 528 * MiB;
constexpr size_t WS_HMID = 592 * MiB;
constexpr size_t WS_Y = 664 * MiB;
constexpr size_t WS_UPD1 = 800 * MiB;
constexpr size_t WS_END = 976 * MiB;

constexpr int LDS_STAGE = 0, LDS_EPI = 131072, LDS_RW = 0, LDS_RV = 148480, LDS_RS = 148480 + 8192, LDS_CTLO = 148480 + 8192 + 3072, LDS_BYTES = LDS_CTLO + 256;

DI unsigned pk2(float lo, float hi) { f32x2 v = {lo, hi}; bf16x2n r = __builtin_convertvector(v, bf16x2n); return __builtin_bit_cast(unsigned, r); }
DI unsigned pk4_fp8(float a, float b, float c, float d) { int r = __builtin_amdgcn_cvt_pk_fp8_f32(a, b, 0, false); r = __builtin_amdgcn_cvt_pk_fp8_f32(c, d, r, true); return (unsigned)r; }
DI f32x2 fp8_lo2(unsigned u) { return __builtin_amdgcn_cvt_pk_f32_fp8((int)u, false); }
DI f32x2 fp8_hi2(unsigned u) { return __builtin_amdgcn_cvt_pk_f32_fp8((int)u, true); }
DI float bf_lo(unsigned u) { return __builtin_bit_cast(float, u << 16); }
DI float bf_hi(unsigned u) { return __builtin_bit_cast(float, u & 0xffff0000u); }
DI float wave_sum(float v) {
#pragma unroll
    for (int o = 1; o < 64; o <<= 1) v += __shfl_xor(v, o);
    return v;
}
DI float fexp2(float x) { return __builtin_amdgcn_exp2f(x); }
DI float flog2(float x) { return __builtin_amdgcn_logf(x); }
DI float frcp(float x) { return __builtin_amdgcn_rcpf(x); }
DI float sigmoidf(float v) { return frcp(1.0f + fexp2(-v * LOG2E)); }
DI void lds_add(LAS int* p, int v) { (void)__hip_atomic_fetch_add(p, v, __ATOMIC_RELAXED, __HIP_MEMORY_SCOPE_WORKGROUP); }
#define LDS_WAIT() asm volatile("s_waitcnt lgkmcnt(0)" ::: "memory")
#define VM_WAIT() asm volatile("s_waitcnt vmcnt(0)" ::: "memory")
DI int fresh_tid() { int t = threadIdx.x; asm volatile("" : "+v"(t)); return t; }

#define XB_TMO      128
#define XB_XCNT(j)  (256  + 64 * (j))
#define XB_XSUB(j)  (1280 + 64 * (j))
#define XB_XGEN(j)  (2304 + 64 * (j))
#define XB_TOP      3328
#define XB_TOPGEN   3392
#define XCD_BAR_WORDS 3456
#define XB_SPIN_CAP (1u << 18)

__device__ __forceinline__ unsigned xb_ld(unsigned* p)              { return __hip_atomic_load(p, __ATOMIC_RELAXED, __HIP_MEMORY_SCOPE_AGENT); }
__device__ __forceinline__ unsigned xb_add(unsigned* p, unsigned v) { return __hip_atomic_fetch_add(p, v, __ATOMIC_RELAXED, __HIP_MEMORY_SCOPE_AGENT); }
__device__ __forceinline__ unsigned xb_xcc_id() { return (unsigned)__builtin_amdgcn_s_getreg((3 << 11) | 20) & 0xFu; }
#define XB_SPIN(cond, bar) do { unsigned _sp = 0; while (cond) { __builtin_amdgcn_s_sleep(1); \
    if ((++_sp & 255u) == 0u) { if (xb_ld(&(bar)[XB_TMO])) break; if (_sp > XB_SPIN_CAP) { atomicAdd(&(bar)[XB_TMO], 1u); break; } } } } while (0)

struct XcdBarrier {
    unsigned* bar; unsigned x;
    volatile LAS unsigned* st;
};
__device__ __forceinline__ XcdBarrier xcd_barrier_post(unsigned* bar, volatile LAS unsigned* st) {
    XcdBarrier b; b.bar = bar; b.x = xb_xcc_id(); b.st = st;
    if (threadIdx.x == 0) (void)xb_add(&bar[XB_XCNT(b.x)], 1u);
    return b;
}
__device__ __forceinline__ void xcd_barrier_complete(unsigned* bar, unsigned x, unsigned& nloc, unsigned& nx) {
    const unsigned G = gridDim.x * gridDim.y * gridDim.z;
    unsigned sum, cnt, mine, sp = 0u;
    for (;;) {
        sum = 0u; cnt = 0u; mine = 0u;
#pragma unroll
        for (unsigned j = 0; j < 16; ++j) { const unsigned c = xb_ld(&bar[XB_XCNT(j)]); sum += c; cnt += (c > 0u) ? 1u : 0u; mine = (j == x) ? c : mine; }
        if (sum == G) break;
        __builtin_amdgcn_s_sleep(1);
        if ((++sp & 255u) == 0u) { if (xb_ld(&bar[XB_TMO])) break; if (sp > XB_SPIN_CAP) { atomicAdd(&bar[XB_TMO], 1u); break; } }
    }
    nloc = mine > 0u ? mine : 1u; nx = cnt > 0u ? cnt : 1u;
}
__device__ __forceinline__ void xcd_barrier(const XcdBarrier& b) {
    asm volatile("s_waitcnt vmcnt(0)" ::: "memory");
    __syncthreads();
    if (threadIdx.x == 0) {
        unsigned* bar = b.bar;
        __builtin_amdgcn_s_waitcnt(0);
        unsigned nloc = b.st[0], nx = b.st[1];
        if (nloc == 0u) { xcd_barrier_complete(bar, b.x, nloc, nx); b.st[0] = nloc; b.st[1] = nx; }
        const unsigned old = xb_add(&bar[XB_XSUB(b.x)], 1u);
        const unsigned gen = old / nloc;
        if (old + 1u == (gen + 1u) * nloc) {
            __builtin_amdgcn_fence(__ATOMIC_RELEASE, "agent");
            asm volatile("s_waitcnt vmcnt(0)" ::: "memory");
            const unsigned og = xb_add(&bar[XB_TOP], 1u);
            const unsigned tg = og / nx;
            if (og + 1u == (tg + 1u) * nx) xb_add(&bar[XB_TOPGEN], 1u);
            else XB_SPIN(xb_ld(&bar[XB_TOPGEN]) == tg, bar);
            __builtin_amdgcn_fence(__ATOMIC_ACQUIRE, "agent");
            xb_add(&bar[XB_XGEN(b.x)], 1u);
            asm volatile("s_waitcnt vmcnt(0)" ::: "memory");
        } else {
            XB_SPIN(xb_ld(&bar[XB_XGEN(b.x)]) == gen, bar);
            __builtin_amdgcn_fence(__ATOMIC_ACQUIRE, "agent");
            asm volatile("s_waitcnt vmcnt(0)" ::: "memory");
        }
    }
    __syncthreads();
}

namespace pg8 {
constexpr int BM = 256, BK = 64, HALF = 128, HTB = HALF * BK * 2, STAGE_BYTES = 8 * HTB, NXCD = 8, WGM = 8;
__host__ __device__ __forceinline__ int lds_byte(int r, int c) { const int st = (r >> 4) * 2 + (c >> 5), rr = r & 15, cc = c & 31, ob = rr * 64 + cc * 2; return st * 1024 + (ob ^ (((ob >> 9) & 1) << 5)); }
__host__ __device__ __forceinline__ void stage_rc(int b, int& R, int& C) { const int st = b / 1024, sb = b % 1024, swz = sb ^ (((sb >> 9) & 1) << 5); R = (st >> 1) * 16 + swz / 64; C = (st & 1) * 32 + (swz % 64) / 2; }
__host__ __device__ __forceinline__ int perm32(int rho) { const int n = rho >> 4, i = rho & 15; return 8 * (i >> 2) + 4 * n + (i & 3); }

struct Unit { int pm, pn, aux; unsigned a, b; };
typedef int i32x4 __attribute__((ext_vector_type(4)));
__device__ __forceinline__ i32x8 frag8(bf16x8 lo, bf16x8 hi) { return __builtin_shufflevector(__builtin_bit_cast(i32x4, lo), __builtin_bit_cast(i32x4, hi), 0, 1, 2, 3, 4, 5, 6, 7); }

template <class Epi, class Sched, bool FP8 = false>
__device__ __forceinline__ void gemm_phase(LAS unsigned char* lds, const int K, const Sched& S, const Epi& E, const __amdgpu_buffer_rsrc_t rs) {
    const int tid = fresh_tid(), wid = __builtin_amdgcn_readfirstlane(tid >> 6), lane = tid & 63, wr = wid >> 2, wc = wid & 3, fr = lane & 15, fq = lane >> 4;
    const int nt = FP8 ? K / 128 : K / BK;
    int RA[2], CA[2];
    unsigned voffA[4], voffB[2];
#pragma unroll
    for (int i = 0; i < 2; ++i) { int R, C; stage_rc(tid * 16 + i * 8192, R, C); RA[i] = R; CA[i] = C; const int Rb = Epi::PERM ? ((R & ~31) + perm32(R & 31)) : R;
        voffB[i] = (unsigned)(Rb * S.pb + C * 2); }
    const unsigned kstep = (unsigned)(BK * 2);
    const unsigned hstepB = (unsigned)(HALF * S.pb), hstepA = (unsigned)(HALF * S.pa);
    const unsigned ldsw = (unsigned)wid * 1024u;
    const int aoff = lds_byte(wr * 64 + fr, fq * 8), boff = lds_byte(wc * 32 + fr, fq * 8);
    constexpr int kpiece = 1024;
#define PG8_SA(b, h) (((b) * 2 + (h)) * HTB)
#define PG8_SB(b, h) ((4 + (b) * 2 + (h)) * HTB)
#define PG8_STAGE_B(bufoff, gbase) do { _Pragma("unroll") for (int _i = 0; _i < 2; ++_i) \
        __builtin_amdgcn_raw_ptr_buffer_load_lds(rs, (LAS unsigned*)(lds + (bufoff) + ldsw + _i * 8192), 16, (int)voffB[_i], (int)(gbase), 0, 0); } while (0)
#define PG8_STAGE_A(bufoff, gbase, h) do { _Pragma("unroll") for (int _i = 0; _i < 2; ++_i) \
        __builtin_amdgcn_raw_ptr_buffer_load_lds(rs, (LAS unsigned*)(lds + (bufoff) + ldsw + _i * 8192), 16, (int)voffA[Sched::GATHER ? (h) * 2 + _i : _i], (int)((gbase) + (Sched::GATHER ? 0u : (unsigned)(h) * hstepA)), 0, 0); } while (0)
#define PG8_LDA(dst, b, h) do { _Pragma("unroll") for (int m = 0; m < 4; ++m) _Pragma("unroll") for (int k = 0; k < 2; ++k) dst[m][k] = *(const LAS bf16x8*)(lds + PG8_SA(b, h) + aoff + m * 2048 + k * kpiece); } while (0)
#define PG8_LDB(dst, b, h) do { _Pragma("unroll") for (int n = 0; n < 2; ++n) _Pragma("unroll") for (int k = 0; k < 2; ++k) dst[n][k] = *(const LAS bf16x8*)(lds + PG8_SB(b, h) + boff + n * 2048 + k * kpiece); } while (0)
#define PG8_MMA(ai, bj, At, Bt) do { __builtin_amdgcn_s_setprio(1); if constexpr (FP8) { _Pragma("unroll") for (int m = 0; m < 4; ++m) _Pragma("unroll") for (int n = 0; n < 2; ++n) \
        acc[ai][bj][m][n] = __builtin_amdgcn_mfma_scale_f32_16x16x128_f8f6f4(frag8(Bt[n][0], Bt[n][1]), frag8(At[m][0], At[m][1]), acc[ai][bj][m][n], 0, 0, 0, 0x7C7C7C7C, 0, 0x7C7C7C7C); } \
      else { _Pragma("unroll") for (int m = 0; m < 4; ++m) _Pragma("unroll") for (int n = 0; n < 2; ++n) _Pragma("unroll") for (int k = 0; k < 2; ++k) \
        acc[ai][bj][m][n] = __builtin_amdgcn_mfma_f32_16x16x32_bf16(Bt[n][k], At[m][k], acc[ai][bj][m][n], 0, 0, 0); } __builtin_amdgcn_s_setprio(0); } while (0)
#define PG8_MMA2(ai, At) do { if constexpr (Sched::BLOCKDIAG) { if (lo_half) PG8_MMA(ai, 0, At, B0); else PG8_MMA(ai, 1, At, B1); } else { PG8_MMA(ai, 0, At, B0); PG8_MMA(ai, 1, At, B1); } } while (0)
#define PG8_WAIT_V(n) asm volatile("s_waitcnt vmcnt(" #n ")" ::: "memory")
#define PG8_WAIT_L(n) asm volatile("s_waitcnt lgkmcnt(" #n ")" ::: "memory")
#define PG8_BAR __builtin_amdgcn_s_barrier()
#define PG8_SCHED __builtin_amdgcn_sched_barrier(0)
    Unit cur, nxt; int ui = 0;
    if (!S.next(0, cur)) return;
    S.offs(cur, RA, CA, voffA);
    f32x4 acc[2][2][4][2];
#pragma unroll
    for (int a = 0; a < 2; ++a)
#pragma unroll
        for (int b = 0; b < 2; ++b)
#pragma unroll
            for (int m = 0; m < 4; ++m)
#pragma unroll
                for (int n = 0; n < 2; ++n) acc[a][b][m][n] = (f32x4){0.f, 0.f, 0.f, 0.f};
    bf16x8 At[4][2], B0[2][2], B1[2][2];
    unsigned cA = cur.a, cB = cur.b;
    PG8_STAGE_B(PG8_SB(0, 0), cB); PG8_STAGE_B(PG8_SB(0, 1), cB + hstepB); PG8_STAGE_A(PG8_SA(0, 0), cA, 0); PG8_STAGE_A(PG8_SA(0, 1), cA, 1);
    if (wr == 1) PG8_BAR;
    PG8_WAIT_V(2); PG8_BAR;
    PG8_STAGE_B(PG8_SB(1, 0), cB + kstep); PG8_STAGE_A(PG8_SA(1, 0), cA + kstep, 0); PG8_STAGE_B(PG8_SB(1, 1), cB + hstepB + kstep);
    PG8_WAIT_V(6); PG8_BAR;
    for (;;) {
        const bool has_next = S.next(ui + 1, nxt);
        const unsigned nA = has_next ? nxt.a : cA, nB = has_next ? nxt.b : cB;
        unsigned nvoff[4];
        if constexpr (Sched::GATHER) { if (has_next) S.rows(nxt, RA, nvoff); }
#pragma nounroll
        for (int t = 0; t < nt; t += 2) {
            const bool last = (t == nt - 2), lo_half = t < (nt >> 1);
            const unsigned a1 = cA + (unsigned)(t + 1) * kstep;
            const unsigned a2 = last ? nA : cA + (unsigned)(t + 2) * kstep, b2 = last ? nB : cB + (unsigned)(t + 2) * kstep;
            const unsigned a3 = a2 + kstep, b3 = b2 + kstep;
            PG8_LDB(B0, 0, 0); PG8_LDB(B1, 0, 1); PG8_SCHED; PG8_LDA(At, 0, 0); PG8_STAGE_A(PG8_SA(1, 1), a1, 1);
            PG8_WAIT_V(8); PG8_WAIT_L(0); PG8_BAR; PG8_MMA2(0, At); PG8_BAR; PG8_SCHED;
            if constexpr (Sched::GATHER) { if (last && has_next) {
#pragma unroll
                for (int q = 0; q < 4; ++q) voffA[q] = nvoff[q] * (unsigned)S.pa + (unsigned)(CA[q & 1] * 2); } }
            PG8_LDA(At, 0, 1); PG8_STAGE_B(PG8_SB(0, 0), b2); PG8_STAGE_B(PG8_SB(0, 1), b2 + hstepB); PG8_STAGE_A(PG8_SA(0, 0), a2, 0);
            PG8_WAIT_V(8); PG8_WAIT_L(0); PG8_BAR; PG8_MMA2(1, At); PG8_BAR; PG8_SCHED;
            PG8_LDB(B0, 1, 0); PG8_LDB(B1, 1, 1); PG8_SCHED; PG8_LDA(At, 1, 0); PG8_STAGE_A(PG8_SA(0, 1), a2, 1);
            PG8_WAIT_V(8); PG8_WAIT_L(0); PG8_BAR; PG8_MMA2(0, At); PG8_BAR; PG8_SCHED;
            PG8_LDA(At, 1, 1); PG8_STAGE_B(PG8_SB(1, 0), b3); PG8_STAGE_B(PG8_SB(1, 1), b3 + hstepB); PG8_STAGE_A(PG8_SA(1, 0), a3, 0);
            PG8_WAIT_V(8); PG8_WAIT_L(0); PG8_BAR; PG8_MMA2(1, At); PG8_BAR; PG8_SCHED;
        }
        if (wr == 0) PG8_BAR;
        { const int t2 = fresh_tid() & 63; E(acc, cur, wr, wc, t2 & 15, t2 >> 4, lds + LDS_EPI); }
        if (!has_next) break;
#pragma unroll
        for (int a = 0; a < 2; ++a)
#pragma unroll
            for (int b = 0; b < 2; ++b)
#pragma unroll
                for (int m = 0; m < 4; ++m)
#pragma unroll
                    for (int n = 0; n < 2; ++n) acc[a][b][m][n] = (f32x4){0.f, 0.f, 0.f, 0.f};
        cur = nxt; cA = nA; cB = nB; ++ui;
        if (wr == 1) PG8_BAR;
    }
    PG8_WAIT_V(0);
    PG8_BAR;
#undef PG8_SA
#undef PG8_SB
#undef PG8_STAGE_A
#undef PG8_STAGE_B
#undef PG8_LDA
#undef PG8_LDB
#undef PG8_MMA
#undef PG8_MMA2
#undef PG8_WAIT_V
#undef PG8_WAIT_L
#undef PG8_BAR
#undef PG8_SCHED
}

struct DenseSched {
    static constexpr bool GATHER = false, BLOCKDIAG = false;
    int nM, nN, nwg, G, c; int pa, pb; unsigned A, B;
    __device__ void init(int M, int N, int G_, int c_, size_t A_, int pa_, size_t B_, int pb_) { nM = M / BM; nN = N / BM; nwg = nM * nN; G = G_; c = c_; A = (unsigned)A_; B = (unsigned)B_; pa = pa_; pb = pb_; }
    __device__ __forceinline__ bool next(int i, Unit& u) const {
        const long L = (long)i * G + c; if (L >= nwg) return false;
        int wgid = (int)L; { const int q = nwg / NXCD, r = nwg % NXCD, xcd = wgid % NXCD, off = wgid / NXCD; wgid = (xcd < r ? xcd * (q + 1) : r * (q + 1) + (xcd - r) * q) + off; }
        const int nig = WGM * nN, gid = wgid / nig, fm = gid * WGM, gsz = (nM - fm) < WGM ? (nM - fm) : WGM;
        u.pm = fm + ((wgid % nig) % gsz); u.pn = (wgid % nig) / gsz; u.aux = 0;
        u.a = A + (unsigned)(u.pm * BM * pa); u.b = B + (unsigned)(u.pn * BM * pb); return true;
    }
    __device__ __forceinline__ void offs(const Unit&, const int (&RA)[2], const int (&CA)[2], unsigned (&v)[4]) const {
#pragma unroll
        for (int h = 0; h < 2; ++h)
#pragma unroll
            for (int i = 0; i < 2; ++i) v[h * 2 + i] = (unsigned)((h * HALF + RA[i]) * pa + CA[i] * 2);
    }
};
struct DiagSched : DenseSched { static constexpr bool BLOCKDIAG = true; };
}

struct Params { const float* in[21]; float* out; unsigned char* ws; int ph_lo, ph_hi; };
enum { I_X = 0, I_C, I_POS, I_WADA, I_BADA, I_GMIX, I_GFFN, I_WIN, I_WBG, I_QG, I_KG, I_WBD, I_WBS, I_WOUT, I_WRG, I_BRG, I_WRE, I_BRE, I_WEG, I_WEU, I_WED };

struct Frame {
    LAS unsigned char* lds;
    unsigned char* ws;
    int wave, G, bid;
};

template <bool FP8>
DI void p0_transpose_item(const float* W, int N, void* WTv, int ldt, int k0, int n0, int row_base, LAS float* scr, int lane) {
#pragma unroll 8
    for (int i = 0; i < 32; ++i) { const int kk = 2 * i + (lane >> 5); scr[kk * 33 + (lane & 31)] = W[(size_t)(k0 + kk) * N + n0 + (lane & 31)]; }
    LDS_WAIT();
    const int c = lane & 7;
#pragma unroll
    for (int j = 0; j < 4; ++j) { const int n = (lane >> 3) + 8 * j; const LAS float* sp = scr + (8 * c) * 33 + n;
        if (FP8) { u32x2 o; o.x = pk4_fp8(64.f * sp[0 * 33], 64.f * sp[1 * 33], 64.f * sp[2 * 33], 64.f * sp[3 * 33]); o.y = pk4_fp8(64.f * sp[4 * 33], 64.f * sp[5 * 33], 64.f * sp[6 * 33], 64.f * sp[7 * 33]);
            *(u32x2*)((unsigned char*)WTv + (size_t)(row_base + n) * ldt + k0 + 8 * c) = o; }
        else { u32x4 o; o.x = pk2(sp[0 * 33], sp[1 * 33]); o.y = pk2(sp[2 * 33], sp[3 * 33]); o.z = pk2(sp[4 * 33], sp[5 * 33]); o.w = pk2(sp[6 * 33], sp[7 * 33]);
            *(u32x4*)((bf16_t*)WTv + (size_t)(row_base + n) * ldt + k0 + 8 * c) = o; } }
    LDS_WAIT();
}
DI void phase0(const Frame& F, const Params& p) {
    const int tid_ = fresh_tid(), lane_ = tid_ & 63;
    LAS float* scr = (LAS float*)(F.lds + F.wave * 16384);
    const int gw = F.bid * 8 + F.wave, NGW = F.G * 8;
    bf16_t* W1 = (bf16_t*)(F.ws + WS_W1); bf16_t* WB = (bf16_t*)(F.ws + WS_WB); bf16_t* WO = (bf16_t*)(F.ws + WS_WO);
    unsigned char* WG8 = F.ws + WS_WG8; unsigned char* WGU = F.ws + WS_WGU; unsigned char* WDN = F.ws + WS_WDN;
    constexpr int I1 = 16 * 96, I2 = 16 * 64, I3 = 4 * 32, I4 = 4 * 32, I5 = 16 * 32, I6 = 32 * 256, I7 = 32 * 256, I8 = 32 * 256;
    constexpr int NITEMS = I1 + I2 + I3 + I4 + I5 + I6 + I7 + I8;
    for (int it = gw; it < NITEMS; it += NGW) {
        int r = it;
        if (r < I1) { const int kb = r / 96, nb = r % 96, n0 = 32 * nb, o0 = n0 & 255, rb = (n0 & ~255) + 128 * ((o0 >> 5) & 1) + 32 * (o0 >> 6);
            if (nb < 72) p0_transpose_item<true>(p.in[I_WIN], 3072, F.ws + WS_W1D8, 1024, 64 * kb, n0, rb, scr, lane_); else p0_transpose_item<false>(p.in[I_WIN], 3072, W1, 1024, 64 * kb, n0, rb, scr, lane_); continue; } r -= I1;
        if (r < I2) { const int kb = r / 64, nb = r % 64; p0_transpose_item<true>(p.in[I_WBG], 2048, WG8, 1024, 64 * kb, 32 * nb, 32 * nb, scr, lane_); continue; } r -= I2;
        if (r < I3) { const int kb = r / 32, nb = r % 32, n0 = 32 * nb; p0_transpose_item<true>(p.in[I_WBD], 1024, (unsigned char*)WB, 512, 64 * kb, n0, (n0 >> 7) * 256 + (n0 & 127), scr, lane_); continue; } r -= I3;
        if (r < I4) { const int kb = r / 32, nb = r % 32, n0 = 32 * nb; p0_transpose_item<true>(p.in[I_WBS], 1024, (unsigned char*)WB + 256, 512, 64 * kb, n0, (n0 >> 7) * 256 + 128 + (n0 & 127), scr, lane_); continue; } r -= I4;
        if (r < I5) { const int kb = r / 32, nb = r % 32; p0_transpose_item<true>(p.in[I_WOUT], 1024, WO, 1024, 64 * kb, 32 * nb, 32 * nb, scr, lane_); continue; } r -= I5;
        if (r < I6) { const int e = r >> 8, q = r & 255, kb = q >> 4, nb = q & 15, n0 = 32 * nb;
            p0_transpose_item<true>(p.in[I_WEG] + (size_t)e * 1024 * 512, 512, WGU + (size_t)e * 1024 * 1024, 1024, 64 * kb, n0, (n0 >> 7) * 256 + (n0 & 127), scr, lane_); continue; } r -= I6;
        if (r < I7) { const int e = r >> 8, q = r & 255, kb = q >> 4, nb = q & 15, n0 = 32 * nb;
            p0_transpose_item<true>(p.in[I_WEU] + (size_t)e * 1024 * 512, 512, WGU + (size_t)e * 1024 * 1024, 1024, 64 * kb, n0, (n0 >> 7) * 256 + 128 + (n0 & 127), scr, lane_); continue; } r -= I7;
        { const int e = r >> 8, q = r & 255, kb = q >> 5, nb = q & 31;
            p0_transpose_item<true>(p.in[I_WED] + (size_t)e * 512 * 1024, 1024, WDN + (size_t)e * 1024 * 512, 512, 64 * kb, 32 * nb, 32 * nb, scr, lane_); }
    }
    {
        unsigned char* WBz = F.ws + WS_WB;
        for (int idx = F.bid * 512 + tid_; idx < 2048 * 16; idx += F.G * 512) { const int row = idx >> 4, c = idx & 15; *(u32x4*)(WBz + (size_t)row * 512 + ((row & 128) ? 0 : 256) + c * 16) = (u32x4){0u, 0u, 0u, 0u}; }
    }
    {
        float* modp = (float*)(F.ws + WS_MODP); const float* c = p.in[I_C]; const float* wada = p.in[I_WADA];
        for (int task = gw; task < 96 * 8; task += NGW) {
            const int ct = task % 96, ks = task / 96, k0 = ks * 128;
#pragma unroll
            for (int i = 0; i < 16; ++i) { const int idx = i * 64 + lane_, b = idx >> 7, k = idx & 127; const float v = c[b * 1024 + k0 + k]; scr[idx] = v * sigmoidf(v); }
            LDS_WAIT();
            float acc[8];
#pragma unroll
            for (int b = 0; b < 8; ++b) acc[b] = 0.f;
            const float* wp = wada + (size_t)k0 * 6144 + ct * 64 + lane_;
#pragma unroll 8
            for (int k = 0; k < 128; ++k) { const float w = wp[(size_t)k * 6144];
#pragma unroll
                for (int b = 0; b < 8; ++b) acc[b] += scr[b * 128 + k] * w; }
#pragma unroll
            for (int b = 0; b < 8; ++b) modp[((size_t)ks * 8 + b) * 6144 + ct * 64 + lane_] = acc[b];
            LDS_WAIT();
        }
    }
}

DI float inv_freq_of(int i) {
    return i == 0 ? 1.0f : i == 1 ? 0.1939227432012558f : i == 2 ? 0.03760603070259094f : i == 3 ? 0.007292664609849453f : i == 4 ? 0.0014142135623842478f : i == 5 ? 0.00027424818836152554f : i == 6 ? 5.318296098266728e-05f : 1.0313386155758053e-05f;
}
template <int WHICH>
DI void phase_norm(const Frame& F, const Params& p) {
    const int tid_ = fresh_tid(), lane_ = tid_ & 63;
    LAS float* gs = (LAS float*)(F.lds); LAS float* sh = gs + 1024;
    const float* modp = (const float*)(F.ws + WS_MODP); float* mod = (float*)(F.ws + WS_MOD); const float* bada = p.in[I_BADA];
    const float* xin = p.in[I_X]; const bf16_t* upd = (const bf16_t*)(F.ws + WS_UPD1); bf16_t* hout = (bf16_t*)(F.ws + (WHICH == 0 ? WS_H : WS_H2)); unsigned* h8 = (unsigned*)(F.ws + (WHICH == 0 ? WS_H8 : WS_H28));
    const float* gn = p.in[WHICH == 0 ? I_GMIX : I_GFFN];
    for (int chunk = F.bid; chunk < T / 256; chunk += F.G) {
        const int b = chunk >> 5;
        __syncthreads();
        if (WHICH == 0) {
            if (tid_ < 192) { const int j = (chunk & 31) * 192 + tid_; float s = bada[j];
#pragma unroll
                for (int ks = 0; ks < 8; ++ks) s += modp[((size_t)ks * 8 + b) * 6144 + j];
                mod[b * 6144 + j] = s; }
            for (int col = tid_; col < 1024; col += 512) { float s1 = bada[col], s2 = bada[1024 + col];
#pragma unroll
                for (int ks = 0; ks < 8; ++ks) { s1 += modp[((size_t)ks * 8 + b) * 6144 + col]; s2 += modp[((size_t)ks * 8 + b) * 6144 + 1024 + col]; }
                gs[col] = gn[col] * (1.f + s2); sh[col] = s1; }
        } else {
            for (int col = tid_; col < 1024; col += 512) { gs[col] = gn[col] * (1.f + mod[b * 6144 + 4096 + col]); sh[col] = mod[b * 6144 + 3072 + col]; }
        }
        __syncthreads();
        f32x4 g4[4], s4[4];
#pragma unroll
        for (int j = 0; j < 4; ++j) { g4[j] = *(const LAS f32x4*)(gs + 256 * j + 4 * lane_); s4[j] = *(const LAS f32x4*)(sh + 256 * j + 4 * lane_); }
        for (int rr = F.wave; rr < 256; rr += 8) {
            const int row = chunk * 256 + rr;
            const f32x4* xr = (const f32x4*)(xin + (size_t)row * 1024) + lane_;
            f32x4 v[4]; float ss = 0.f;
#pragma unroll
            for (int j = 0; j < 4; ++j) v[j] = xr[64 * j];
            if (WHICH == 1) { const u32x2* ur = (const u32x2*)(upd + (size_t)row * 1024) + lane_; u32x2 uu[4];
#pragma unroll
                for (int j = 0; j < 4; ++j) uu[j] = ur[64 * j];
#pragma unroll
                for (int j = 0; j < 4; ++j) { v[j].x += bf_lo(uu[j].x); v[j].y += bf_hi(uu[j].x); v[j].z += bf_lo(uu[j].y); v[j].w += bf_hi(uu[j].y); } }
#pragma unroll
            for (int j = 0; j < 4; ++j) ss += (v[j].x * v[j].x + v[j].y * v[j].y) + (v[j].z * v[j].z + v[j].w * v[j].w);
            const float rinv = __builtin_amdgcn_rsqf(wave_sum(ss) * (1.f / 1024.f) + RMS_EPS);
            u32x2* o8 = (u32x2*)(hout + (size_t)row * 1024) + lane_;
#pragma unroll
            for (int j = 0; j < 4; ++j) { const f32x4 y = v[j] * rinv * g4[j] + s4[j]; u32x2 o; o.x = pk2(y.x, y.y); o.y = pk2(y.z, y.w); o8[64 * j] = o; h8[(size_t)row * 256 + 64 * j + lane_] = pk4_fp8(y.x, y.y, y.z, y.w); }
            if (WHICH == 0 && lane_ < 8) {
                const int pos = ((const int*)p.in[I_POS])[row];
                const float angf = (float)pos * inv_freq_of(lane_);
                double rv = (double)angf * 0.15915494309189535; rv -= __builtin_rint(rv);
                const float fr = (float)rv;
                bf16_t* rp = (bf16_t*)(F.ws + WS_ROPE) + (size_t)row * 16;
                rp[lane_] = (bf16_t)(pk2(__builtin_amdgcn_cosf(fr), 0.f) & 0xffffu); rp[8 + lane_] = (bf16_t)(pk2(__builtin_amdgcn_sinf(fr), 0.f) & 0xffffu);
            }
        }
    }
}

template <bool GATES> struct EpiProj {
    static constexpr bool PERM = true;
    bf16_t* proj; bf16_t* gates; const bf16_t* rope; const float* qg; const float* kg; int pn0;
    DI void operator()(const f32x4 (&acc)[2][2][4][2], const pg8::Unit& u, int wr, int wc, int fr, int fq, LAS unsigned char* scr) const {
        asm volatile("" : "+v"(fr), "+v"(fq));
        const int pn = u.pn + pn0, row0 = u.pm * 256 + wr * 64 + fr, cw = wc * 32 + 8 * fq;
        const int typ = pn < 9 ? pn / 3 : pn - 9, grp = pn < 9 ? pn % 3 : 0, l2d = pn < 9 ? 2 * grp : 0, hbase = pn < 9 ? grp * 4 : 12;
        if (GATES) {
            unsigned char* base = (unsigned char*)gates + pn * 256 + cw;
#pragma unroll
            for (int ai = 0; ai < 2; ++ai)
#pragma unroll
                for (int m = 0; m < 4; ++m) { unsigned char* rowp = base + (size_t)(row0 + ai * 128 + m * 16) * LDG;
#pragma unroll
                    for (int bj = 0; bj < 2; ++bj) { const f32x4 v0 = acc[ai][bj][m][0], v1 = acc[ai][bj][m][1];
                        u32x2 w; w.x = pk4_fp8(v0.x, v0.y, v0.z, v0.w); w.y = pk4_fp8(v1.x, v1.y, v1.z, v1.w);
                        *(u32x2*)(rowp + bj * 128) = w; } }
        } else if (pn >= 6 || pn < 3) {
            const float sc = pn == 9 ? QSCALE : 1.f;
            const int head = hbase + wc;
#pragma unroll
            for (int ai = 0; ai < 2; ++ai)
#pragma unroll
                for (int m = 0; m < 4; ++m) { const int t = row0 + ai * 128 + m * 16, sq = t & (S - 1); const int rp = (t & ~(S - 1)) + ((sq & ((1 << l2d) - 1)) << (13 - l2d)) + (sq >> l2d);
                    bf16_t* rowp = proj + ((size_t)(typ * 16 + head) * T + rp) * 64 + 8 * fq;
#pragma unroll
                    for (int bj = 0; bj < 2; ++bj) { const f32x4 v0 = acc[ai][bj][m][0] * sc, v1 = acc[ai][bj][m][1] * sc;
                        u32x4 w; w.x = pk2(v0.x, v0.y); w.y = pk2(v0.z, v0.w); w.z = pk2(v1.x, v1.y); w.w = pk2(v1.z, v1.w);
                        *(u32x4*)(rowp + 32 * bj) = w; } }
        } else {
            const int head = hbase + wc;
            const f32x4 g0 = *(const f32x4*)(kg + 8 * fq), g1 = *(const f32x4*)(kg + 8 * fq + 4), g2 = *(const f32x4*)(kg + 32 + 8 * fq), g3 = *(const f32x4*)(kg + 32 + 8 * fq + 4);
#pragma unroll
            for (int ai = 0; ai < 2; ++ai) {
                u32x4 rcs[4][2];
#pragma unroll
                for (int m = 0; m < 4; ++m) { const u32x4* rpt = (const u32x4*)(rope + (size_t)(u.pm * 256 + ai * 128 + wr * 64 + m * 16 + fr) * 16); rcs[m][0] = rpt[0]; rcs[m][1] = rpt[1]; }
                __builtin_amdgcn_sched_barrier(0);
#pragma unroll
                for (int m = 0; m < 4; ++m) { const int row = u.pm * 256 + ai * 128 + wr * 64 + m * 16 + fr, sq = row & (S - 1);
                    const int rp = (row & ~(S - 1)) + ((sq & ((1 << l2d) - 1)) << (13 - l2d)) + (sq >> l2d);
                    const f32x4 a0 = acc[ai][0][m][0], a1 = acc[ai][0][m][1], b0 = acc[ai][1][m][0], b1 = acc[ai][1][m][1];
                    float ss = ((a0.x * a0.x + a0.y * a0.y) + (a0.z * a0.z + a0.w * a0.w)) + ((a1.x * a1.x + a1.y * a1.y) + (a1.z * a1.z + a1.w * a1.w))
                             + ((b0.x * b0.x + b0.y * b0.y) + (b0.z * b0.z + b0.w * b0.w)) + ((b1.x * b1.x + b1.y * b1.y) + (b1.z * b1.z + b1.w * b1.w));
                    ss += __shfl_xor(ss, 16); ss += __shfl_xor(ss, 32);
                    const float rinv = __builtin_amdgcn_rsqf(ss * (1.f / 64.f) + RMS_EPS);
                    f32x4 v0 = a0 * (g0 * rinv), v1 = a1 * (g1 * rinv); const f32x4 v2 = b0 * (g2 * rinv), v3 = b1 * (g3 * rinv);
                    f32x4 c0 = {1.f, 1.f, 1.f, 1.f}, c1 = c0, s0 = {0.f, 0.f, 0.f, 0.f}, s1 = s0;
                    if (fq < 2) { const u32x4 cc = rcs[m][0], sn = rcs[m][1];
                        c0 = (f32x4){bf_lo(cc.x), bf_hi(cc.x), bf_lo(cc.y), bf_hi(cc.y)}; c1 = (f32x4){bf_lo(cc.z), bf_hi(cc.z), bf_lo(cc.w), bf_hi(cc.w)};
                        s0 = (f32x4){bf_lo(sn.x), bf_hi(sn.x), bf_lo(sn.y), bf_hi(sn.y)}; s1 = (f32x4){bf_lo(sn.z), bf_hi(sn.z), bf_lo(sn.w), bf_hi(sn.w)};
                        if (fq == 0) { s0 = -s0; s1 = -s1; } }
                    f32x4 p0, p1;
                    p0.x = __shfl_xor(v0.x, 16); p0.y = __shfl_xor(v0.y, 16); p0.z = __shfl_xor(v0.z, 16); p0.w = __shfl_xor(v0.w, 16);
                    p1.x = __shfl_xor(v1.x, 16); p1.y = __shfl_xor(v1.y, 16); p1.z = __shfl_xor(v1.z, 16); p1.w = __shfl_xor(v1.w, 16);
                    v0 = v0 * c0 + p0 * s0; v1 = v1 * c1 + p1 * s1;
                    bf16_t* rowp = proj + ((size_t)(typ * 16 + head) * T + rp) * 64 + 8 * fq;
                    u32x4 w; w.x = pk2(v0.x, v0.y); w.y = pk2(v0.z, v0.w); w.z = pk2(v1.x, v1.y); w.w = pk2(v1.z, v1.w);
                    *(u32x4*)rowp = w;
                    w.x = pk2(v2.x, v2.y); w.y = pk2(v2.z, v2.w); w.z = pk2(v3.x, v3.y); w.w = pk2(v3.z, v3.w);
                    *(u32x4*)(rowp + 32) = w; }
            }
        }
    }
};

struct EpiBranch {
    static constexpr bool PERM = true;
    const unsigned char* gates; unsigned char* merged;
    DI void operator()(const f32x4 (&acc)[2][2][4][2], const pg8::Unit& u, int wr, int wc, int fr, int fq, LAS unsigned char*) const {
        asm volatile("" : "+v"(fr), "+v"(fq));
        const int row0 = u.pm * 256 + wr * 64 + fr, col0 = u.pn * 128 + wc * 32 + 8 * fq;
        u32x2 gd[2][4], gs[2][4];
#pragma unroll
        for (int ai = 0; ai < 2; ++ai)
#pragma unroll
            for (int m = 0; m < 4; ++m) { const size_t row = (size_t)(row0 + ai * 128 + m * 16);
                gd[ai][m] = *(const u32x2*)(gates + row * LDG + col0); gs[ai][m] = *(const u32x2*)(gates + row * LDG + 1024 + col0); }
        __builtin_amdgcn_sched_barrier(0);
#pragma unroll
        for (int ai = 0; ai < 2; ++ai)
#pragma unroll
            for (int m = 0; m < 4; ++m) { const size_t row = (size_t)(row0 + ai * 128 + m * 16);
                const u32x2 g = gd[ai][m], q = gs[ai][m];
                const f32x2 ga = fp8_lo2(g.x), gb = fp8_hi2(g.x), gc = fp8_lo2(g.y), gdd = fp8_hi2(g.y), qa = fp8_lo2(q.x), qb = fp8_hi2(q.x), qc = fp8_lo2(q.y), qd = fp8_hi2(q.y);
                const f32x4 v0 = acc[ai][0][m][0] * (f32x4){sigmoidf(ga.x), sigmoidf(ga.y), sigmoidf(gb.x), sigmoidf(gb.y)} + acc[ai][1][m][0] * (f32x4){sigmoidf(qa.x), sigmoidf(qa.y), sigmoidf(qb.x), sigmoidf(qb.y)};
                const f32x4 v1 = acc[ai][0][m][1] * (f32x4){sigmoidf(gc.x), sigmoidf(gc.y), sigmoidf(gdd.x), sigmoidf(gdd.y)} + acc[ai][1][m][1] * (f32x4){sigmoidf(qc.x), sigmoidf(qc.y), sigmoidf(qd.x), sigmoidf(qd.y)};
                u32x2 w; w.x = pk4_fp8(8.f * v0.x, 8.f * v0.y, 8.f * v0.z, 8.f * v0.w); w.y = pk4_fp8(8.f * v1.x, 8.f * v1.y, 8.f * v1.z, 8.f * v1.w);
                *(u32x2*)(merged + row * 1024 + col0) = w; }
    }
};
struct BranchSched {
    static constexpr bool GATHER = false;
    int G, c; int pa, pb; unsigned A, B;
    DI bool next(int i, pg8::Unit& u) const {
        const int tile = (i >> 1) * G + c; if (tile >= 256 * 4) return false;
        u.pm = tile >> 2; u.pn = tile & 3; u.aux = i & 1;
        u.a = A + (unsigned)(u.pm * 256 * LDO * 2 + u.aux * 256 * 2); u.b = B + (unsigned)(u.aux * 1024 * 256 * 2 + u.pn * 256 * 256 * 2); return true;
    }
    DI void offs(const pg8::Unit&, const int (&RA)[2], const int (&CA)[2], unsigned (&v)[4]) const {
#pragma unroll
        for (int h = 0; h < 2; ++h)
#pragma unroll
            for (int i = 0; i < 2; ++i) v[h * 2 + i] = (unsigned)((h * 128 + RA[i]) * pa + CA[i] * 2);
    }
};

struct EpiOut {
    static constexpr bool PERM = true;
    bf16_t* upd; const float* mod;
    DI void operator()(const f32x4 (&acc)[2][2][4][2], const pg8::Unit& u, int wr, int wc, int fr, int fq, LAS unsigned char*) const {
        asm volatile("" : "+v"(fr), "+v"(fq));
        const int row0 = u.pm * 256 + wr * 64 + fr, col0 = u.pn * 256 + wc * 32 + 8 * fq; const int b = (u.pm * 256) >> 13;
        f32x4 gv[2][2];
#pragma unroll
        for (int bj = 0; bj < 2; ++bj)
#pragma unroll
            for (int n = 0; n < 2; ++n) gv[bj][n] = *(const f32x4*)(mod + b * 6144 + 2048 + col0 + bj * 128 + n * 4) * 0.125f;
#pragma unroll
        for (int ai = 0; ai < 2; ++ai)
#pragma unroll
            for (int m = 0; m < 4; ++m)
#pragma unroll
                for (int bj = 0; bj < 2; ++bj) { const f32x4 v0 = acc[ai][bj][m][0] * gv[bj][0], v1 = acc[ai][bj][m][1] * gv[bj][1];
                    u32x4 w; w.x = pk2(v0.x, v0.y); w.y = pk2(v0.z, v0.w); w.z = pk2(v1.x, v1.y); w.w = pk2(v1.z, v1.w);
                    *(u32x4*)(upd + (size_t)(row0 + ai * 128 + m * 16) * 1024 + col0 + bj * 128) = w; }
    }
};

struct EpiLogit {
    static constexpr bool PERM = false;
    float* logit;
    DI void operator()(const f32x4 (&acc)[2][2][4][2], const pg8::Unit& u, int wr, int wc, int fr, int fq, LAS unsigned char*) const {
        asm volatile("" : "+v"(fr), "+v"(fq));
        const int row0 = u.pm * 256 + wr * 64 + fr, col0 = wc * 32 + 4 * fq;
#pragma unroll
        for (int ai = 0; ai < 2; ++ai)
#pragma unroll
            for (int m = 0; m < 4; ++m)
#pragma unroll
                for (int n = 0; n < 2; ++n) *(f32x4*)(logit + (size_t)(row0 + ai * 128 + m * 16) * 128 + col0 + n * 16) = acc[ai][0][m][n];
    }
};

struct MoeSched {
    static constexpr bool GATHER_ = true;
    int G, c, nc; int pa, pb; unsigned A, B; const LAS int* cstart; const int* slot_tok; unsigned estride, pnstride;
};
struct MoeSchedUp : MoeSched {
    static constexpr bool GATHER = true, BLOCKDIAG = false;
    DI bool next(int i, pg8::Unit& u) const {
        const int L = i * G + c; if (L >= nc * 4) return false;
        const int chunk = L >> 2; int e = 0;
        for (int q = 1; q < 32; ++q) e += (chunk >= cstart[q]) ? 1 : 0;
        e = __builtin_amdgcn_readfirstlane(e);
        u.pm = chunk; u.pn = L & 3; u.aux = e; u.a = A; u.b = B + (unsigned)e * estride + (unsigned)u.pn * pnstride; return true;
    }
    DI void offs(const pg8::Unit& u, const int (&RA)[2], const int (&CA)[2], unsigned (&v)[4]) const {
#pragma unroll
        for (int h = 0; h < 2; ++h)
#pragma unroll
            for (int i = 0; i < 2; ++i) { const int tok = slot_tok[u.pm * 256 + h * 128 + RA[i]]; v[h * 2 + i] = (unsigned)(tok * pa + CA[i] * 2); }
    }
    DI void rows(const pg8::Unit& u, const int (&RA)[2], unsigned (&v)[4]) const {
#pragma unroll
        for (int h = 0; h < 2; ++h)
#pragma unroll
            for (int i = 0; i < 2; ++i) v[h * 2 + i] = (unsigned)slot_tok[u.pm * 256 + h * 128 + RA[i]];
    }
};
struct MoeSchedDn : MoeSched {
    static constexpr bool GATHER = false, BLOCKDIAG = false;
    DI bool next(int i, pg8::Unit& u) const {
        const int L = i * G + c; if (L >= nc * 4) return false;
        const int chunk = L >> 2; int e = 0;
        for (int q = 1; q < 32; ++q) e += (chunk >= cstart[q]) ? 1 : 0;
        e = __builtin_amdgcn_readfirstlane(e);
        u.pm = chunk; u.pn = L & 3; u.aux = e; u.a = A + (unsigned)(chunk * 256 * pa); u.b = B + (unsigned)e * estride + (unsigned)u.pn * pnstride; return true;
    }
    DI void offs(const pg8::Unit&, const int (&RA)[2], const int (&CA)[2], unsigned (&v)[4]) const {
#pragma unroll
        for (int h = 0; h < 2; ++h)
#pragma unroll
            for (int i = 0; i < 2; ++i) v[h * 2 + i] = (unsigned)((h * 128 + RA[i]) * pa + CA[i] * 2);
    }
};
struct EpiSwiglu {
    static constexpr bool PERM = true;
    unsigned char* hmid;
    DI void operator()(const f32x4 (&acc)[2][2][4][2], const pg8::Unit& u, int wr, int wc, int fr, int fq, LAS unsigned char*) const {
        asm volatile("" : "+v"(fr), "+v"(fq));
        const int row0 = u.pm * 256 + wr * 64 + fr, col0 = u.pn * 128 + wc * 32 + 8 * fq;
#pragma unroll
        for (int ai = 0; ai < 2; ++ai)
#pragma unroll
            for (int m = 0; m < 4; ++m) {
                f32x4 h[2];
#pragma unroll
                for (int n = 0; n < 2; ++n) { const f32x4 g = acc[ai][0][m][n], up = acc[ai][1][m][n];
                    h[n] = (f32x4){g.x * sigmoidf(g.x) * up.x, g.y * sigmoidf(g.y) * up.y, g.z * sigmoidf(g.z) * up.z, g.w * sigmoidf(g.w) * up.w}; }
                u32x2 w; w.x = pk4_fp8(h[0].x, h[0].y, h[0].z, h[0].w); w.y = pk4_fp8(h[1].x, h[1].y, h[1].z, h[1].w);
                *(u32x2*)(hmid + (size_t)(row0 + ai * 128 + m * 16) * DE + col0) = w; }
    }
};
struct EpiDown {
    static constexpr bool PERM = true;
    unsigned char* y;
    DI void operator()(const f32x4 (&acc)[2][2][4][2], const pg8::Unit& u, int wr, int wc, int fr, int fq, LAS unsigned char*) const {
        asm volatile("" : "+v"(fr), "+v"(fq));
        const int row0 = u.pm * 256 + wr * 64 + fr, col0 = u.pn * 256 + wc * 32 + 8 * fq;
#pragma unroll
        for (int ai = 0; ai < 2; ++ai)
#pragma unroll
            for (int m = 0; m < 4; ++m) { const int slot = row0 + ai * 128 + m * 16;
#pragma unroll
                for (int bj = 0; bj < 2; ++bj) { const f32x4 v0 = acc[ai][bj][m][0] * 8.f, v1 = acc[ai][bj][m][1] * 8.f;
                    u32x2 o; o.x = pk4_fp8(v0.x, v0.y, v0.z, v0.w); o.y = pk4_fp8(v1.x, v1.y, v1.z, v1.w);
                    *(u32x2*)(y + (size_t)slot * 1024 + col0 + bj * 128) = o; } }
    }
};

constexpr int SLOT_BYTES = 8192;
DI f32x16 mfma32(bf16x8 a, bf16x8 b, f32x16 c) { return __builtin_amdgcn_mfma_f32_32x32x16_bf16(a, b, c, 0, 0, 0); }
DI int swz_f(int r) { return (((r >> 1) & 1) << 2) | ((r >> 2) & 3); }
struct AttnLane { unsigned doff[4]; unsigned ka[4]; unsigned va[2][2]; };
DI void attn_lane_init(AttnLane& L, int lane) {
#pragma unroll
    for (int i = 0; i < 4; ++i) { const int r = 8 * i + (lane >> 3), c = (lane & 7) ^ swz_f(r); L.doff[i] = (unsigned)(r * 128 + c * 16); }
    { const int r = lane & 31, h = lane >> 5; const unsigned a0 = (unsigned)(r * 128 + 16 * ((h ^ swz_f(r)) & 7));
#pragma unroll
      for (int s = 0; s < 4; ++s) L.ka[s] = a0 ^ (unsigned)(32 * s); }
    { const int h = lane >> 5, blk = (lane >> 4) & 1, q = (lane & 15) >> 2, p = lane & 3, fb2 = (q >> 1) & 1;
#pragma unroll
      for (int t = 0; t < 2; ++t) { const int flow = (2 * t + h) & 3;
#pragma unroll
        for (int mt = 0; mt < 2; ++mt) L.va[t][mt] = (unsigned)(4096 + (8 * t + 4 * h + q) * 128 + 16 * (4 * (mt ^ fb2) + ((2 * blk + (p >> 1)) ^ flow)) + 8 * (p & 1)); } }
}
DI void dma_tile(const AttnLane& L, const __amdgpu_buffer_rsrc_t rs, unsigned koff, unsigned voff, LAS unsigned char* slot) {
#pragma unroll
    for (int i = 0; i < 4; ++i) __builtin_amdgcn_raw_ptr_buffer_load_lds(rs, (LAS unsigned*)(slot + 1024 * i), 16, (int)L.doff[i], (int)koff, 0, 0);
#pragma unroll
    for (int i = 0; i < 4; ++i) __builtin_amdgcn_raw_ptr_buffer_load_lds(rs, (LAS unsigned*)(slot + 4096 + 1024 * i), 16, (int)L.doff[i], (int)voff, 0, 0);
}
DI void tr_read8(const AttnLane& L, unsigned sb, bf16x8 (&vf)[2][2]) {
    s16x4 r0, r1, r2, r3, r4, r5, r6, r7;
    const unsigned a00 = sb + L.va[0][0], a10 = sb + L.va[1][0], a01 = sb + L.va[0][1], a11 = sb + L.va[1][1];
    asm volatile("ds_read_b64_tr_b16 %0, %8\n\tds_read_b64_tr_b16 %1, %9\n\tds_read_b64_tr_b16 %2, %8 offset:2048\n\tds_read_b64_tr_b16 %3, %9 offset:2048\n\t"
                 "ds_read_b64_tr_b16 %4, %10\n\tds_read_b64_tr_b16 %5, %11\n\tds_read_b64_tr_b16 %6, %10 offset:2048\n\tds_read_b64_tr_b16 %7, %11 offset:2048\n\ts_waitcnt lgkmcnt(0)"
                 : "=&v"(r0), "=&v"(r1), "=&v"(r2), "=&v"(r3), "=&v"(r4), "=&v"(r5), "=&v"(r6), "=&v"(r7)
                 : "v"(a00), "v"(a10), "v"(a01), "v"(a11) : "memory");
    vf[0][0] = __builtin_shufflevector(r0, r1, 0, 1, 2, 3, 4, 5, 6, 7); vf[0][1] = __builtin_shufflevector(r2, r3, 0, 1, 2, 3, 4, 5, 6, 7);
    vf[1][0] = __builtin_shufflevector(r4, r5, 0, 1, 2, 3, 4, 5, 6, 7); vf[1][1] = __builtin_shufflevector(r6, r7, 0, 1, 2, 3, 4, 5, 6, 7);
}
DI bf16x8 pack8(const f32x16& x, int s) {
    u32x4 p; p.x = pk2(x[8 * s], x[8 * s + 1]); p.y = pk2(x[8 * s + 2], x[8 * s + 3]); p.z = pk2(x[8 * s + 4], x[8 * s + 5]); p.w = pk2(x[8 * s + 6], x[8 * s + 7]);
    return __builtin_bit_cast(bf16x8, p);
}
DI void store_o_row(bf16_t* rowp, const f32x16& O0, const f32x16& O1, float sc, int h) {
#pragma unroll
    for (int mt = 0; mt < 2; ++mt)
#pragma unroll
        for (int kp = 0; kp < 2; ++kp) { const f32x16& O = mt ? O1 : O0; const int g0 = 8 * kp, g1 = 8 * kp + 4;
            u32x2 a, b; a.x = pk2(O[g0] * sc, O[g0 + 1] * sc); a.y = pk2(O[g0 + 2] * sc, O[g0 + 3] * sc); b.x = pk2(O[g1] * sc, O[g1 + 1] * sc); b.y = pk2(O[g1 + 2] * sc, O[g1 + 3] * sc);
            { auto r = __builtin_amdgcn_permlane32_swap(a.x, b.x, false, false); a.x = r[0]; b.x = r[1]; }
            { auto r = __builtin_amdgcn_permlane32_swap(a.y, b.y, false, false); a.y = r[0]; b.y = r[1]; }
            *(u32x4*)(rowp + 32 * mt + 16 * kp + 8 * h) = (u32x4){a.x, a.y, b.x, b.y}; }
}
DI void store_o_row_fp8(unsigned char* rowp, const f32x16& O0, const f32x16& O1, int h) {
#pragma unroll
    for (int mt = 0; mt < 2; ++mt)
#pragma unroll
        for (int kp = 0; kp < 2; ++kp) { const f32x16& O = mt ? O1 : O0; const int g0 = 8 * kp, g1 = 8 * kp + 4;
            unsigned a = pk4_fp8(O[g0], O[g0 + 1], O[g0 + 2], O[g0 + 3]), b = pk4_fp8(O[g1], O[g1 + 1], O[g1 + 2], O[g1 + 3]);
            { auto r = __builtin_amdgcn_permlane32_swap(a, b, false, false); a = r[0]; b = r[1]; }
            *(u32x2*)(rowp + 32 * mt + 16 * kp + 8 * h) = (u32x2){a, b}; }
}
#define ATTN_WAIT_TILE(more) do { if (more) asm volatile("s_waitcnt vmcnt(8)" ::: "memory"); else asm volatile("s_waitcnt vmcnt(0)" ::: "memory"); } while (0)
DI void dil_tile(const AttnLane& L, const __amdgpu_buffer_rsrc_t rs, const bf16_t* hb, int hd, long row0, int j, LAS unsigned char* ldsW, bf16_t* og, float* lse, int lane, const float (&gq)[32], const bf16_t* ropet, long tok0, int dil) {
    const int qi = lane & 31, h = lane >> 5;
    const bf16_t* qh = hb + (size_t)hd * T * 64;
    const unsigned kh = (unsigned)(WS_PROJ + ((size_t)(16 + hd) * T + row0) * 128), vh = (unsigned)(WS_PROJ + ((size_t)(32 + hd) * T + row0) * 128);
    bf16x8 qf[4];
    {
        const bf16_t* qp = qh + (size_t)(row0 + 32 * j + qi) * 64 + 8 * h;
        u32x4 qr[4];
#pragma unroll
        for (int s = 0; s < 4; ++s) qr[s] = *(const u32x4*)(qp + 16 * s);
        const u32x4* rpt = (const u32x4*)(ropet + (size_t)(tok0 + (long)dil * (32 * j + qi)) * 16); const u32x4 cc = rpt[0], sn = rpt[1];
        float qv[4][8]; float ss = 0.f;
#pragma unroll
        for (int s = 0; s < 4; ++s) { const u32x4 u = qr[s]; qv[s][0] = bf_lo(u.x); qv[s][1] = bf_hi(u.x); qv[s][2] = bf_lo(u.y); qv[s][3] = bf_hi(u.y); qv[s][4] = bf_lo(u.z); qv[s][5] = bf_hi(u.z); qv[s][6] = bf_lo(u.w); qv[s][7] = bf_hi(u.w);
#pragma unroll
            for (int e = 0; e < 8; ++e) ss += qv[s][e] * qv[s][e]; }
        ss += __shfl_xor(ss, 32);
        const float rinv = __builtin_amdgcn_rsqf(ss * (1.f / 64.f) + RMS_EPS) * QSCALE;
#pragma unroll
        for (int s = 0; s < 4; ++s)
#pragma unroll
            for (int e = 0; e < 8; ++e) qv[s][e] *= rinv * gq[s * 8 + e];
        { const float cs[8] = {bf_lo(cc.x), bf_hi(cc.x), bf_lo(cc.y), bf_hi(cc.y), bf_lo(cc.z), bf_hi(cc.z), bf_lo(cc.w), bf_hi(cc.w)};
          const float sv[8] = {bf_lo(sn.x), bf_hi(sn.x), bf_lo(sn.y), bf_hi(sn.y), bf_lo(sn.z), bf_hi(sn.z), bf_lo(sn.w), bf_hi(sn.w)};
#pragma unroll
          for (int e = 0; e < 8; ++e) { const float other = __shfl_xor(qv[0][e], 32); qv[0][e] = qv[0][e] * cs[e] + other * (h ? sv[e] : -sv[e]); } }
#pragma unroll
        for (int s = 0; s < 4; ++s) { u32x4 o; o.x = pk2(qv[s][0], qv[s][1]); o.y = pk2(qv[s][2], qv[s][3]); o.z = pk2(qv[s][4], qv[s][5]); o.w = pk2(qv[s][6], qv[s][7]); qf[s] = __builtin_bit_cast(bf16x8, o); }
    }
    float mrun = -INFINITY, lrun = 0.f;
    f32x16 O0, O1;
#pragma unroll
    for (int i = 0; i < 16; ++i) { O0[i] = 0.f; O1[i] = 0.f; }
    const int kt0 = j >= 4 ? j - 4 : 0;
    dma_tile(L, rs, kh + (unsigned)(4096 * kt0), vh + (unsigned)(4096 * kt0), ldsW);
    unsigned buf = 0;
    for (int kt = kt0; kt <= j; ++kt) {
        const bool more = kt < j;
        if (more) dma_tile(L, rs, kh + (unsigned)(4096 * (kt + 1)), vh + (unsigned)(4096 * (kt + 1)), ldsW + (buf ^ 1u) * SLOT_BYTES);
        ATTN_WAIT_TILE(more);
        LAS unsigned char* slot = ldsW + buf * SLOT_BYTES;
        f32x16 sc;
#pragma unroll
        for (int i = 0; i < 16; ++i) sc[i] = 0.f;
#pragma unroll
        for (int s = 0; s < 4; ++s) { const bf16x8 kf = *(const LAS bf16x8*)(slot + L.ka[s]); sc = mfma32(kf, qf[s], sc); }
        if (kt == j) {
#pragma unroll
            for (int i = 0; i < 16; ++i) { const int key = (i & 3) + 8 * (i >> 2) + 4 * h; if (key > qi) sc[i] = -INFINITY; }
        }
        if (kt == j - 4) {
#pragma unroll
            for (int i = 0; i < 16; ++i) { const int key = (i & 3) + 8 * (i >> 2) + 4 * h; if (key < qi) sc[i] = -INFINITY; }
        }
        float mx = sc[0];
#pragma unroll
        for (int i = 1; i < 16; ++i) mx = fmaxf(mx, sc[i]);
        mx = fmaxf(mx, __shfl_xor(mx, 32));
        const float mnew = fmaxf(mrun, mx), alpha = fexp2(mrun - mnew);
        float ps = 0.f;
#pragma unroll
        for (int i = 0; i < 16; ++i) { sc[i] = fexp2(sc[i] - mnew); ps += sc[i]; }
        lrun = lrun * alpha + ps; mrun = mnew;
#pragma unroll
        for (int i = 0; i < 16; ++i) { O0[i] *= alpha; O1[i] *= alpha; }
        const bf16x8 p0 = pack8(sc, 0), p1 = pack8(sc, 1);
        bf16x8 vf[2][2]; tr_read8(L, (unsigned)(size_t)slot, vf);
        O0 = mfma32(vf[0][0], p0, O0); O0 = mfma32(vf[0][1], p1, O0);
        O1 = mfma32(vf[1][0], p0, O1); O1 = mfma32(vf[1][1], p1, O1);
        buf ^= 1u;
    }
    const float ltot = lrun + __shfl_xor(lrun, 32), inv = frcp(ltot);
    const size_t row = (size_t)(row0 + 32 * j + qi);
    store_o_row(og + row * 64, O0, O1, inv, h);
    if (h == 0) lse[row] = mrun + flog2(ltot);
}
DI void sb_tile(const AttnLane& L, const __amdgpu_buffer_rsrc_t rs, const bf16_t* hb, int b, int h4, int j, LAS unsigned char* ldsW, unsigned char* ocat, int lane) {
    const int qi = lane & 31, h = lane >> 5;
    const long base = (long)b * S;
    const bf16_t* qh = hb + (size_t)(12 + h4) * T * 64;
    const unsigned kh = (unsigned)(WS_PROJ + ((size_t)(16 + 12 + h4) * T + base) * 128), vh = (unsigned)(WS_PROJ + ((size_t)(32 + 12 + h4) * T + base) * 128);
    bf16x8 qf[4];
    { const bf16_t* qp = qh + (size_t)(base + 32 * j + qi) * 64 + 8 * h;
#pragma unroll
      for (int s = 0; s < 4; ++s) qf[s] = *(const bf16x8*)(qp + 16 * s); }
    float carry = 0.f;
    f32x16 O0, O1;
#pragma unroll
    for (int i = 0; i < 16; ++i) { O0[i] = 0.f; O1[i] = 0.f; }
    dma_tile(L, rs, kh + (unsigned)(4096 * j), vh + (unsigned)(4096 * j), ldsW);
    unsigned buf = 0;
    for (int kt = j; kt >= 0; --kt) {
        const bool more = kt > 0;
        if (more) dma_tile(L, rs, kh + (unsigned)(4096 * (kt - 1)), vh + (unsigned)(4096 * (kt - 1)), ldsW + (buf ^ 1u) * SLOT_BYTES);
        ATTN_WAIT_TILE(more);
        LAS unsigned char* slot = ldsW + buf * SLOT_BYTES;
        f32x16 z;
#pragma unroll
        for (int i = 0; i < 16; ++i) z[i] = 0.f;
#pragma unroll
        for (int s = 0; s < 4; ++s) { const bf16x8 kf = *(const LAS bf16x8*)(slot + L.ka[s]); z = mfma32(kf, qf[s], z); }
#pragma unroll
        for (int i = 0; i < 16; ++i) z[i] = fexp2(fminf(z[i], 31.f));
        if (kt == j) {
#pragma unroll
            for (int i = 0; i < 16; ++i) { const int key = (i & 3) + 8 * (i >> 2) + 4 * h; if (key >= qi) z[i] = 0.f; }
        }
        float lg[4], par[4], u0[4], p01[4], p012[4];
#pragma unroll
        for (int g = 0; g < 4; ++g) { const float a0 = 1.f + z[4 * g], a1 = 1.f + z[4 * g + 1], a2 = 1.f + z[4 * g + 2], a3 = 1.f + z[4 * g + 3];
            u0[g] = a0; p01[g] = a0 * a1; p012[g] = p01[g] * a2; lg[g] = -flog2(p012[g] * a3); }
#pragma unroll
        for (int g = 0; g < 4; ++g) par[g] = __shfl_xor(lg[g], 32);
        float tg[4]; tg[3] = carry; tg[2] = tg[3] + (lg[3] + par[3]); tg[1] = tg[2] + (lg[2] + par[2]); tg[0] = tg[1] + (lg[1] + par[1]);
        carry = tg[0] + (lg[0] + par[0]);
#pragma unroll
        for (int g = 0; g < 4; ++g) { const float suf = tg[g] + lg[g] + (h == 0 ? par[g] : 0.f); const float y = fexp2(suf);
            z[4 * g] = z[4 * g] * y; z[4 * g + 1] = z[4 * g + 1] * (y * u0[g]); z[4 * g + 2] = z[4 * g + 2] * (y * p01[g]); z[4 * g + 3] = z[4 * g + 3] * (y * p012[g]); }
        const bf16x8 p0 = pack8(z, 0), p1 = pack8(z, 1);
        bf16x8 vf[2][2]; tr_read8(L, (unsigned)(size_t)slot, vf);
        O0 = mfma32(vf[0][0], p0, O0); O0 = mfma32(vf[0][1], p1, O0);
        O1 = mfma32(vf[1][0], p0, O1); O1 = mfma32(vf[1][1], p1, O1);
        if (__all(carry < -40.f)) break;
        buf ^= 1u;
    }
    store_o_row_fp8(ocat + (size_t)(base + 32 * j + qi) * LDO + 256 + h4 * 64, O0, O1, h);
}
DI void phase_attn(const Frame& F, const Params& p) {
    const int tid_ = fresh_tid(), lane_ = tid_ & 63;
    const bf16_t* hb = (const bf16_t*)(F.ws + WS_PROJ); unsigned char* ocat = F.ws + WS_OCAT;
    bf16_t* og = (bf16_t*)(F.ws + WS_OG); float* lse = (float*)(F.ws + WS_LSE);
    LAS unsigned char* ldsW = F.lds + F.wave * (2 * SLOT_BYTES);
    AttnLane L; attn_lane_init(L, lane_);
    float gq[32];
#pragma unroll
    for (int s4 = 0; s4 < 4; ++s4)
#pragma unroll
        for (int e = 0; e < 8; ++e) gq[s4 * 8 + e] = p.in[I_QG][16 * s4 + 8 * (lane_ >> 5) + e];
    const __amdgpu_buffer_rsrc_t rs = __builtin_amdgcn_make_buffer_rsrc(F.ws, 0, (int)WS_END, 0x00020000);
    const int NU = NB * 4 * 16;
    for (int i = 0;; ++i) {
        const int u = (F.G == 256) ? ((F.bid & 7) * 32 + (F.bid >> 3) + 256 * i) : (F.bid + F.G * i);
        if (u >= NU) break;
        const int qb = u & 15, hs = (u >> 4) & 3, b = u >> 6, t0 = qb * 512;
        for (int w = F.wave; w < 16; w += 8) sb_tile(L, rs, hb, b, hs, t0 / 32 + w, ldsW, ocat, lane_);
        for (int w = F.wave; w < 48; w += 8) {
            const int g = w >> 4, ti = w & 15, l2d = 2 * g, per = 16 >> l2d, r = ti / per, jj = ti % per;
            dil_tile(L, rs, hb, g * 4 + hs, (long)b * S + (long)r * (S >> l2d), ((t0 >> l2d) >> 5) + jj, ldsW, og + (size_t)(g * 4 + hs) * T * 64, lse + (size_t)(g * 4 + hs) * T, lane_, gq, (const bf16_t*)(F.ws + WS_ROPE), (long)b * S + r, 1 << l2d);
        }
        VM_WAIT();
        __syncthreads();
        {
            const int piece = tid_ & 7; const size_t bb = (size_t)b * S;
#pragma unroll 2
            for (int pass = 0; pass < 8; ++pass) {
                const int sq = t0 + pass * 64 + (tid_ >> 3);
                const size_t r0 = bb + sq, r1 = bb + ((size_t)(sq & 3) << 11) + (sq >> 2), r2 = bb + ((size_t)(sq & 15) << 9) + (sq >> 4);
                const float l0 = lse[(size_t)(0 + hs) * T + r0], l1 = lse[(size_t)(4 + hs) * T + r1], l2 = lse[(size_t)(8 + hs) * T + r2];
                const u32x4 x = *((const u32x4*)(og + ((size_t)(0 + hs) * T + r0) * 64) + piece), y = *((const u32x4*)(og + ((size_t)(4 + hs) * T + r1) * 64) + piece), z = *((const u32x4*)(og + ((size_t)(8 + hs) * T + r2) * 64) + piece);
                const float mx = fmaxf(l0, fmaxf(l1, l2)); float w0 = fexp2(l0 - mx), w1 = fexp2(l1 - mx), w2 = fexp2(l2 - mx); const float inv = frcp(w0 + w1 + w2); w0 *= inv; w1 *= inv; w2 *= inv;
                u32x2 r;
                r.x = pk4_fp8(w0 * bf_lo(x.x) + w1 * bf_lo(y.x) + w2 * bf_lo(z.x), w0 * bf_hi(x.x) + w1 * bf_hi(y.x) + w2 * bf_hi(z.x), w0 * bf_lo(x.y) + w1 * bf_lo(y.y) + w2 * bf_lo(z.y), w0 * bf_hi(x.y) + w1 * bf_hi(y.y) + w2 * bf_hi(z.y));
                r.y = pk4_fp8(w0 * bf_lo(x.z) + w1 * bf_lo(y.z) + w2 * bf_lo(z.z), w0 * bf_hi(x.z) + w1 * bf_hi(y.z) + w2 * bf_hi(z.z), w0 * bf_lo(x.w) + w1 * bf_lo(y.w) + w2 * bf_lo(z.w), w0 * bf_hi(x.w) + w1 * bf_hi(y.w) + w2 * bf_hi(z.w));
                *((u32x2*)(ocat + (bb + sq) * LDO + hs * 64) + piece) = r;
            }
        }
        __syncthreads();
    }
}

DI void route_rows(const Frame& F, const Params& p, int pm) {
    const int tid_ = fresh_tid(), lane_ = tid_ & 63;
    LAS int* hist = (LAS int*)(F.lds);
    const int ftid = fresh_tid();
    __syncthreads();
    if (ftid < 32) hist[ftid] = 0;
    __syncthreads();
    if (tid_ < 256) {
        const int row = pm * 256 + tid_; const float* L = (const float*)(F.ws + WS_LOGIT) + (size_t)row * 128;
        const float* brg = p.in[I_BRG]; const float* bre = p.in[I_BRE];
        float lgp[4];
#pragma unroll
        for (int c = 0; c < 4; ++c) lgp[c] = L[c] + L[36 + c] + brg[c];
        int gsel = 0; float gm = lgp[0];
#pragma unroll
        for (int c = 1; c < 4; ++c) if (lgp[c] > gm) { gm = lgp[c]; gsel = c; }
        float zs = 0.f;
#pragma unroll
        for (int c = 0; c < 4; ++c) zs += fexp2((lgp[c] - gm) * LOG2E);
        const float pg = frcp(zs);
        float l1 = -INFINITY, l2 = -INFINITY; int e1 = 0, e2 = 0;
#pragma unroll
        for (int i = 0; i < 8; ++i) { const int c = 4 + gsel * 8 + i; const float v = L[c] + L[36 + c] + bre[gsel * 8 + i];
            if (v > l1) { l2 = l1; e2 = e1; l1 = v; e1 = i; } else if (v > l2) { l2 = v; e2 = i; } }
        const float ex = fexp2((l2 - l1) * LOG2E), den = frcp(1.f + ex);
        int* te = (int*)(F.ws + WS_TOKE) + (size_t)row * 2; float* tw = (float*)(F.ws + WS_TOKW) + (size_t)row * 2;
        te[0] = gsel * 8 + e1; te[1] = gsel * 8 + e2; tw[0] = pg * den; tw[1] = pg * ex * den;
        lds_add(&hist[gsel * 8 + e1], 1); lds_add(&hist[gsel * 8 + e2], 1);
    }
    __syncthreads();
    if (ftid < 32) ((int*)(F.ws + WS_HIST))[pm * 32 + ftid] = hist[ftid];
}


DI void router_weights_to_lds(const Frame& F, const Params& p) {
    const int tid_ = fresh_tid(), lane_ = tid_ & 63;
    constexpr int WP = 1028;
    LAS float* wt = (LAS float*)(F.lds + LDS_RW); LAS float* bias = (LAS float*)(F.lds + LDS_RS) + 8 * 80 + 32;
    const float* wrg = p.in[I_WRG]; const float* wre = p.in[I_WRE]; const float* brg = p.in[I_BRG]; const float* bre = p.in[I_BRE];
    const int ftid = fresh_tid();
    __syncthreads();
#pragma unroll 8
    for (int i = ftid; i < 1024 * 32; i += 512) wt[(4 + (i & 31)) * WP + (i >> 5)] = wre[i];
#pragma unroll 8
    for (int i = ftid; i < 1024 * 4; i += 512) wt[(i & 3) * WP + (i >> 2)] = wrg[i];
    if (ftid < 36) bias[ftid] = ftid < 4 ? brg[ftid] : bre[ftid - 4];
}

DI void phase_norm2_route(const Frame& F, const Params& p) {
    const int tid_ = fresh_tid(), lane_ = tid_ & 63;
    constexpr int WP = 1028;
    LAS float* wt = (LAS float*)(F.lds + LDS_RW);
    LAS float* gs = (LAS float*)(F.lds + LDS_RV); LAS float* sh = gs + 1024;
    LAS float* scr = (LAS float*)(F.lds + LDS_RS) + F.wave * 80;
    LAS int* hist = (LAS int*)(F.lds + LDS_RS) + 8 * 80;
    LAS float* bias = (LAS float*)(F.lds + LDS_RS) + 8 * 80 + 32;
    const float* mod = (const float*)(F.ws + WS_MOD); const float* gn = p.in[I_GFFN];
    const bf16_t* upd = (const bf16_t*)(F.ws + WS_UPD1); unsigned* h8 = (unsigned*)(F.ws + WS_H28);
    const float* wrg = p.in[I_WRG]; const float* wre = p.in[I_WRE]; const float* brg = p.in[I_BRG]; const float* bre = p.in[I_BRE];
    const int ftid = fresh_tid();
    __syncthreads();
    for (int chunk = F.bid; chunk < T / 256; chunk += F.G) {
        const int b = chunk >> 5;
        __syncthreads();
        for (int col = ftid; col < 1024; col += 512) { gs[col] = gn[col] * (1.f + mod[b * 6144 + 4096 + col]); sh[col] = mod[b * 6144 + 3072 + col]; }
        if (ftid < 32) hist[ftid] = 0;
        __syncthreads();
        f32x4 vn[2][4]; u32x2 un[2][4];
#pragma unroll
        for (int r = 0; r < 2; ++r) { const int row = chunk * 256 + F.wave * 2 + r;
            const f32x4* xr = (const f32x4*)(p.in[I_X] + (size_t)row * 1024) + lane_; const u32x2* ur = (const u32x2*)(upd + (size_t)row * 1024) + lane_;
#pragma unroll
            for (int j = 0; j < 4; ++j) { vn[r][j] = xr[64 * j]; un[r][j] = ur[64 * j]; } }
        for (int rr = F.wave * 2; rr < 256; rr += 16) {
            const int row0 = chunk * 256 + rr;
            f32x4 y[2][4];
#pragma unroll
            for (int r = 0; r < 2; ++r) {
                const int row = row0 + r; float ss = 0.f;
#pragma unroll
                for (int j = 0; j < 4; ++j) { vn[r][j].x += bf_lo(un[r][j].x); vn[r][j].y += bf_hi(un[r][j].x); vn[r][j].z += bf_lo(un[r][j].y); vn[r][j].w += bf_hi(un[r][j].y);
                    ss += (vn[r][j].x * vn[r][j].x + vn[r][j].y * vn[r][j].y) + (vn[r][j].z * vn[r][j].z + vn[r][j].w * vn[r][j].w); }
                const float rinv = __builtin_amdgcn_rsqf(wave_sum(ss) * (1.f / 1024.f) + RMS_EPS);
#pragma unroll
                for (int j = 0; j < 4; ++j) { const f32x4 gj = *(const LAS f32x4*)(gs + 256 * j + 4 * lane_), sj = *(const LAS f32x4*)(sh + 256 * j + 4 * lane_);
                    y[r][j] = vn[r][j] * rinv * gj + sj; h8[(size_t)row * 256 + 64 * j + lane_] = pk4_fp8(y[r][j].x, y[r][j].y, y[r][j].z, y[r][j].w); }
            }
            if (rr + 16 < 256) {
#pragma unroll
                for (int r = 0; r < 2; ++r) { const int row = row0 + 16 + r;
                    const f32x4* xr = (const f32x4*)(p.in[I_X] + (size_t)row * 1024) + lane_; const u32x2* ur = (const u32x2*)(upd + (size_t)row * 1024) + lane_;
#pragma unroll
                    for (int j = 0; j < 4; ++j) { vn[r][j] = xr[64 * j]; un[r][j] = ur[64 * j]; } }
            }
            const bool up32 = (lane_ & 32) != 0, up16 = (lane_ & 16) != 0, up8 = (lane_ & 8) != 0, up4 = (lane_ & 4) != 0;
            {
                f32x2 ga[2][4], gb[2][4];
#pragma unroll
                for (int r = 0; r < 2; ++r)
#pragma unroll
                    for (int c = 0; c < 4; ++c) { ga[r][c] = (f32x2){0.f, 0.f}; gb[r][c] = ga[r][c]; }
#pragma unroll
                for (int c = 0; c < 4; ++c)
#pragma unroll
                    for (int j = 0; j < 4; ++j) { const f32x4 w = *(const LAS f32x4*)(wt + c * WP + 4 * lane_ + 256 * j); const f32x2 wl = {w.x, w.y}, wh = {w.z, w.w};
#pragma unroll
                        for (int r = 0; r < 2; ++r) { ga[r][c] = __builtin_elementwise_fma((f32x2){y[r][j].x, y[r][j].y}, wl, ga[r][c]); gb[r][c] = __builtin_elementwise_fma((f32x2){y[r][j].z, y[r][j].w}, wh, gb[r][c]); } }
                float k4[4];
#pragma unroll
                for (int c = 0; c < 4; ++c) { const f32x2 t0 = ga[0][c] + gb[0][c], t1 = ga[1][c] + gb[1][c]; const float p0 = t0.x + t0.y, p1 = t1.x + t1.y;
                    k4[c] = up32 ? p0 : p1; ga[0][c].x = up32 ? p1 : p0; }
#pragma unroll
                for (int c = 0; c < 4; ++c) k4[c] = ga[0][c].x + __shfl_xor(k4[c], 32);
                float k2[2];
#pragma unroll
                for (int i = 0; i < 2; ++i) k2[i] = (up16 ? k4[2 + i] : k4[i]) + __shfl_xor(up16 ? k4[i] : k4[2 + i], 16);
                float k1 = (up8 ? k2[1] : k2[0]) + __shfl_xor(up8 ? k2[0] : k2[1], 8);
                k1 += __shfl_xor(k1, 4); k1 += __shfl_xor(k1, 2); k1 += __shfl_xor(k1, 1);
                if ((lane_ & 7) == 0) scr[(lane_ >> 5) * 36 + ((lane_ >> 4) & 1) * 2 + ((lane_ >> 3) & 1)] = k1;
            }
            LDS_WAIT();
            int gsel[2];
#pragma unroll
            for (int r = 0; r < 2; ++r) { int gi = 0; float gm = scr[r * 36] + bias[0];
#pragma unroll
                for (int c = 1; c < 4; ++c) { const float v = scr[r * 36 + c] + bias[c]; if (v > gm) { gm = v; gi = c; } }
                gsel[r] = __builtin_amdgcn_readfirstlane(gi); }
            {
                float pe[2][8];
#pragma unroll
                for (int r = 0; r < 2; ++r) {
                    const LAS float* wb = wt + (4 + gsel[r] * 8) * WP + 4 * lane_;
#pragma unroll
                    for (int hh = 0; hh < 2; ++hh) {
                        f32x2 ea[4], eb[4];
#pragma unroll
                        for (int i = 0; i < 4; ++i) { ea[i] = (f32x2){0.f, 0.f}; eb[i] = ea[i]; }
#pragma unroll
                        for (int i = 0; i < 4; ++i)
#pragma unroll
                            for (int j = 0; j < 4; ++j) { const f32x4 w = *(const LAS f32x4*)(wb + (hh * 4 + i) * WP + 256 * j);
                                ea[i] = __builtin_elementwise_fma((f32x2){y[r][j].x, y[r][j].y}, (f32x2){w.x, w.y}, ea[i]); eb[i] = __builtin_elementwise_fma((f32x2){y[r][j].z, y[r][j].w}, (f32x2){w.z, w.w}, eb[i]); }
#pragma unroll
                        for (int i = 0; i < 4; ++i) { const f32x2 t = ea[i] + eb[i]; pe[r][hh * 4 + i] = t.x + t.y; }
                        __builtin_amdgcn_sched_barrier(0);
                    }
                }
                float e8[8], e4[4], e2[2];
#pragma unroll
                for (int i = 0; i < 8; ++i) e8[i] = (up32 ? pe[1][i] : pe[0][i]) + __shfl_xor(up32 ? pe[0][i] : pe[1][i], 32);
#pragma unroll
                for (int i = 0; i < 4; ++i) e4[i] = (up16 ? e8[4 + i] : e8[i]) + __shfl_xor(up16 ? e8[i] : e8[4 + i], 16);
#pragma unroll
                for (int i = 0; i < 2; ++i) e2[i] = (up8 ? e4[2 + i] : e4[i]) + __shfl_xor(up8 ? e4[i] : e4[2 + i], 8);
                float e1 = (up4 ? e2[1] : e2[0]) + __shfl_xor(up4 ? e2[0] : e2[1], 4);
                e1 += __shfl_xor(e1, 2); e1 += __shfl_xor(e1, 1);
                if ((lane_ & 3) == 0) scr[(lane_ >> 5) * 36 + 4 + ((lane_ >> 4) & 1) * 4 + ((lane_ >> 3) & 1) * 2 + ((lane_ >> 2) & 1)] = e1;
            }
            LDS_WAIT();
            if (lane_ < 2) {
                const LAS float* L = scr + lane_ * 36; const int row = row0 + lane_;
                float lgp[4];
#pragma unroll
                for (int c = 0; c < 4; ++c) lgp[c] = L[c] + bias[c];
                int gsel = 0; float gm = lgp[0];
#pragma unroll
                for (int c = 1; c < 4; ++c) if (lgp[c] > gm) { gm = lgp[c]; gsel = c; }
                float zs = 0.f;
#pragma unroll
                for (int c = 0; c < 4; ++c) zs += fexp2((lgp[c] - gm) * LOG2E);
                const float pg = frcp(zs);
                float l1 = -INFINITY, l2 = -INFINITY; int e1 = 0, e2 = 0;
#pragma unroll
                for (int i = 0; i < 8; ++i) { const float v = L[4 + i] + bias[4 + gsel * 8 + i];
                    if (v > l1) { l2 = l1; e2 = e1; l1 = v; e1 = i; } else if (v > l2) { l2 = v; e2 = i; } }
                const float ex = fexp2((l2 - l1) * LOG2E), den = frcp(1.f + ex);
                int* te = (int*)(F.ws + WS_TOKE) + (size_t)row * 2; float* tw = (float*)(F.ws + WS_TOKW) + (size_t)row * 2;
                te[0] = gsel * 8 + e1; te[1] = gsel * 8 + e2; tw[0] = pg * den; tw[1] = pg * ex * den;
                lds_add(&hist[gsel * 8 + e1], 1); lds_add(&hist[gsel * 8 + e2], 1);
            }
            LDS_WAIT();
        }
        __syncthreads();
        if (ftid < 32) ((int*)(F.ws + WS_HIST))[chunk * 32 + ftid] = hist[ftid];
    }
}

DI void phase_slots(const Frame& F, const Params& p) {
    const int tid_ = fresh_tid(), lane_ = tid_ & 63;
    LAS int* tot = (LAS int*)(F.lds); LAS int* bas = tot + 32; LAS int* pst = tot + 64; LAS int* wcnt = tot + 128;
    const int* hist = (const int*)(F.ws + WS_HIST);
    for (int pm = F.bid; pm < T / 256; pm += F.G) {
        const int ftid = fresh_tid();
        __syncthreads();
        if (ftid < 64) tot[ftid] = 0;
        __syncthreads();
        { const int e = tid_ & 31, part = tid_ >> 5; int t = 0, bs = 0;
          for (int q = part; q < T / 256; q += 16) { const int v = hist[q * 32 + e]; t += v; if (q < pm) bs += v; }
          lds_add(&tot[e], t); lds_add(&bas[e], bs); }
        __syncthreads();
        if (tid_ == 0) { int run = 0; for (int e = 0; e < 32; ++e) { pst[e] = run; run += (tot[e] + 255) / 256 * 256; } pst[32] = run; }
        const int my_e = ((const int*)(F.ws + WS_TOKE))[(size_t)pm * 512 + tid_];
        int rank = 0;
        for (int e = 0; e < 32; ++e) { const unsigned long long mask = __ballot(my_e == e); if (my_e == e) rank = __popcll(mask & ((1ull << lane_) - 1ull)); if (lane_ == 0) wcnt[F.wave * 32 + e] = __popcll(mask); }
        __syncthreads();
        int woff = 0;
        for (int w = 0; w < F.wave; ++w) woff += wcnt[w * 32 + my_e];
        const int slot = pst[my_e] + bas[my_e] + woff + rank;
        ((int*)(F.ws + WS_SLOTTOK))[slot] = pm * 256 + (tid_ >> 1);
        ((float*)(F.ws + WS_SLOTW))[slot] = ((const float*)(F.ws + WS_TOKW))[(size_t)pm * 512 + tid_];
        ((int*)(F.ws + WS_TOKS))[(size_t)pm * 512 + tid_] = slot;
        if (pm < 32) { const int e = pm; for (int s = pst[e] + tot[e] + tid_; s < pst[e + 1]; s += 512) { ((int*)(F.ws + WS_SLOTTOK))[s] = 0; ((float*)(F.ws + WS_SLOTW))[s] = 0.f; } }
        if (pm == 0 && tid_ < 34) { int* et = (int*)(F.ws + WS_ETAB); if (tid_ < 33) et[64 + tid_] = pst[tid_] >> 8; if (tid_ < 32) { et[tid_] = tot[tid_]; et[32 + tid_] = pst[tid_]; } if (tid_ == 33) et[97] = pst[32] >> 8; }
    }
}

DI void phase_combine(const Frame& F, const Params& p) {
    const int tid_ = fresh_tid(), lane_ = tid_ & 63;
    const unsigned* y = (const unsigned*)(F.ws + WS_Y); const int* ts = (const int*)(F.ws + WS_TOKS); const float* tw = (const float*)(F.ws + WS_TOKW); const float* mod = (const float*)(F.ws + WS_MOD);
    const int gw = F.bid * 8 + F.wave, NGW = F.G * 8;
    for (int row = gw; row < T; row += NGW) {
        const int s0 = ts[(size_t)row * 2], s1 = ts[(size_t)row * 2 + 1]; const float w0 = tw[(size_t)row * 2] * 0.125f, w1 = tw[(size_t)row * 2 + 1] * 0.125f;
        const f32x4* xr = (const f32x4*)(p.in[I_X] + (size_t)row * 1024) + lane_; f32x4* orow = (f32x4*)(p.out + (size_t)row * 1024) + lane_;
        const u32x2* ur = (const u32x2*)((const bf16_t*)(F.ws + WS_UPD1) + (size_t)row * 1024) + lane_;
        const unsigned* y0 = y + (size_t)s0 * 256 + lane_; const unsigned* y1 = y + (size_t)s1 * 256 + lane_;
        const f32x4* g2 = (const f32x4*)(mod + (row >> 13) * 6144 + 5120) + lane_;
        f32x4 v[4], g[4]; unsigned a[4], c[4]; u32x2 uu[4];
#pragma unroll
        for (int j = 0; j < 4; ++j) { v[j] = xr[64 * j]; uu[j] = ur[64 * j]; a[j] = y0[64 * j]; c[j] = y1[64 * j]; g[j] = g2[64 * j]; }
#pragma unroll
        for (int j = 0; j < 4; ++j) { if (!DBG_X1_PLAIN) { v[j].x += bf_lo(uu[j].x); v[j].y += bf_hi(uu[j].x); v[j].z += bf_lo(uu[j].y); v[j].w += bf_hi(uu[j].y); }
            if (!DBG_SKIP_Y) { const f32x2 al = fp8_lo2(a[j]), ah = fp8_hi2(a[j]), cl = fp8_lo2(c[j]), ch = fp8_hi2(c[j]);
                v[j].x += g[j].x * (w0 * al.x + w1 * cl.x); v[j].y += g[j].y * (w0 * al.y + w1 * cl.y); v[j].z += g[j].z * (w0 * ah.x + w1 * ch.x); v[j].w += g[j].w * (w0 * ah.y + w1 * ch.y); } orow[64 * j] = v[j]; }
    }
}

__global__ void __launch_bounds__(512, 2) fwd(Params p) {
    extern __shared__ __attribute__((aligned(16))) unsigned char lds_raw[];
    Frame F;
    F.lds = (LAS unsigned char*)lds_raw; F.ws = p.ws;
    F.wave = __builtin_amdgcn_readfirstlane((int)threadIdx.x >> 6); F.G = gridDim.x; F.bid = blockIdx.x;
    volatile LAS unsigned* ctl = (volatile LAS unsigned*)(F.lds + LDS_CTLO);
    { const int ftid = fresh_tid(); if (ftid < 64) ctl[ftid] = 0u; }
    __syncthreads();
    XcdBarrier bar; bar.bar = (unsigned*)(p.ws + WS_CTL) + CW_BAR; bar.x = 0; bar.st = ctl;
    if (MK_N_LAUNCHES == 1) bar = xcd_barrier_post((unsigned*)(p.ws + WS_CTL) + CW_BAR, ctl);
    const int lo = p.ph_lo, hi = p.ph_hi;
    const __amdgpu_buffer_rsrc_t rsw = __builtin_amdgcn_make_buffer_rsrc(p.ws, 0, (int)WS_END, 0x00020000);
#define IN(k) (lo <= (k) && (k) < hi)
#define REP(k) for (int rep_ = 0; rep_ < ((PROBE_PH) == (k) ? 2 : 1); ++rep_)
#define SEAM(k) do { if (IN(k) && IN((k) + 1)) xcd_barrier(bar); } while (0)

    if (IN(0)) REP(0) { phase0(F, p); } SEAM(0);
    if (IN(1)) REP(1) { phase_norm<0>(F, p); } SEAM(1);
    if (IN(2)) REP(2) {
        REP(20) {
            pg8::DenseSched Sd; Sd.init(T, 2304, F.G, F.bid, WS_H8, 1024, WS_W1D8, 1024);
            EpiProj<false> E{(bf16_t*)(F.ws + WS_PROJ), (bf16_t*)(F.ws + WS_GATES), (const bf16_t*)(F.ws + WS_ROPE), p.in[I_QG], p.in[I_KG], 0};
            pg8::gemm_phase<EpiProj<false>, pg8::DenseSched, true>(F.lds, 1024, Sd, E, rsw);
        }
        REP(21) {
            pg8::DenseSched Sd; Sd.init(T, 768, F.G, F.bid, WS_H, 2048, WS_W1 + (size_t)2304 * 2048, 2048);
            EpiProj<false> E{(bf16_t*)(F.ws + WS_PROJ), (bf16_t*)(F.ws + WS_GATES), (const bf16_t*)(F.ws + WS_ROPE), p.in[I_QG], p.in[I_KG], 9};
            pg8::gemm_phase<EpiProj<false>, pg8::DenseSched, false>(F.lds, 1024, Sd, E, rsw);
        }
        REP(22) {
            pg8::DenseSched Sd; Sd.init(T, 2048, F.G, F.bid, WS_H8, 1024, WS_WG8, 1024);
            EpiProj<true> E{(bf16_t*)(F.ws + WS_PROJ), (bf16_t*)(F.ws + WS_GATES), (const bf16_t*)(F.ws + WS_ROPE), p.in[I_QG], p.in[I_KG], 0};
            pg8::gemm_phase<EpiProj<true>, pg8::DenseSched, true>(F.lds, 1024, Sd, E, rsw);
        }
    } SEAM(2);
    if (IN(3)) REP(3) { phase_attn(F, p); } SEAM(3);
    if (IN(4)) REP(4) {
        pg8::DiagSched Sd; Sd.init(T, 2048, F.G, F.bid, WS_OCAT, 512, WS_WB, 512);
        EpiBranch E{(const unsigned char*)(F.ws + WS_GATES), F.ws + WS_MERGED};
        pg8::gemm_phase<EpiBranch, pg8::DiagSched, true>(F.lds, 512, Sd, E, rsw);
    } SEAM(4);
    if (IN(5)) REP(5) {
        pg8::DenseSched Sd; Sd.init(T, 1024, F.G, F.bid, WS_MERGED, 1024, WS_WO, 1024);
        EpiOut E{(bf16_t*)(F.ws + WS_UPD1), (const float*)(F.ws + WS_MOD)};
        pg8::gemm_phase<EpiOut, pg8::DenseSched, true>(F.lds, 1024, Sd, E, rsw);
        if (rep_ + 1 == ((PROBE_PH) == 5 ? 2 : 1)) router_weights_to_lds(F, p);
    } SEAM(5);
    if (IN(6)) REP(6) { phase_norm2_route(F, p); }
    if (IN(6) && IN(8)) xcd_barrier(bar);
    if (IN(8)) REP(8) { phase_slots(F, p); } SEAM(8);
    if (IN(9) || IN(10)) {
        LAS int* cst = (LAS int*)(F.lds + LDS_CTLO) + 16;
        __syncthreads();
        { const int ftid = fresh_tid(); if (ftid < 34) cst[ftid] = ((const int*)(F.ws + WS_ETAB))[64 + ftid]; }
        __syncthreads();
    }
    if (IN(9)) REP(9) {
        const LAS int* cst = (const LAS int*)(F.lds + LDS_CTLO) + 16;
        MoeSchedUp Sm; Sm.G = F.G; Sm.c = (F.G == 256) ? ((F.bid & 7) * 32 + (F.bid >> 3)) : F.bid; Sm.nc = __builtin_amdgcn_readfirstlane(cst[33]); Sm.pa = 1024; Sm.pb = 1024; Sm.A = (unsigned)WS_H28; Sm.B = (unsigned)WS_WGU; Sm.cstart = cst;
        Sm.slot_tok = (const int*)(F.ws + WS_SLOTTOK); Sm.estride = 1024u * 1024u; Sm.pnstride = 256u * 1024u;
        EpiSwiglu E{F.ws + WS_HMID};
        pg8::gemm_phase<EpiSwiglu, MoeSchedUp, true>(F.lds, 1024, Sm, E, rsw);
    } SEAM(9);
    if (IN(10)) REP(10) {
        const LAS int* cst = (const LAS int*)(F.lds + LDS_CTLO) + 16;
        MoeSchedDn Sm; Sm.G = F.G; Sm.c = (F.G == 256) ? ((F.bid & 7) * 32 + (F.bid >> 3)) : F.bid; Sm.nc = __builtin_amdgcn_readfirstlane(cst[33]); Sm.pa = 512; Sm.pb = 512; Sm.A = (unsigned)WS_HMID; Sm.B = (unsigned)WS_WDN; Sm.cstart = cst;
        Sm.slot_tok = (const int*)(F.ws + WS_SLOTTOK); Sm.estride = 1024u * 512u; Sm.pnstride = 256u * 512u;
        EpiDown E{F.ws + WS_Y};
        pg8::gemm_phase<EpiDown, MoeSchedDn, true>(F.lds, 512, Sm, E, rsw);
    } SEAM(10);
    if (IN(11)) { phase_combine(F, p); }
#undef IN
#undef SEAM
}

extern "C" void kernel_launch(void* const* d_in, const int* in_sizes, int n_in, void* d_out, int out_size, void* d_ws, size_t ws_size, hipStream_t stream) {
    static int grid = 0;
    if (grid == 0) {
        if (n_in != 21 || in_sizes[0] != T * D || out_size != T * D || ws_size < WS_END) { fprintf(stderr, "kernel_launch: unexpected problem (n_in %d, ws %zu)\n", n_in, ws_size); grid = -1; return; }
        int dev = 0, cus = 0, per_cu = 0;
        if (hipGetDevice(&dev) != hipSuccess || hipDeviceGetAttribute(&cus, hipDeviceAttributeMultiprocessorCount, dev) != hipSuccess) { grid = -1; return; }
        if (hipFuncSetAttribute((const void*)fwd, hipFuncAttributeMaxDynamicSharedMemorySize, LDS_BYTES) != hipSuccess) { fprintf(stderr, "kernel_launch: hipFuncSetAttribute failed\n"); grid = -1; return; }
        if (hipOccupancyMaxActiveBlocksPerMultiprocessor(&per_cu, (const void*)fwd, 512, LDS_BYTES) != hipSuccess || per_cu < 1) { fprintf(stderr, "kernel_launch: occupancy query says %d\n", per_cu); (void)hipGetLastError(); grid = -1; return; }
        grid = cus;
    }
    if (grid < 0) return;
    (void)hipMemsetAsync((char*)d_ws + WS_CTL, 0, CTL_ZERO_BYTES, stream);
    Params p{};
    for (int i = 0; i < 21; ++i) p.in[i] = (const float*)d_in[i];
    p.out = (float*)d_out; p.ws = (unsigned char*)d_ws;
    if (MK_N_LAUNCHES == 1) { p.ph_lo = 0; p.ph_hi = NPH; hipLaunchKernelGGL(fwd, dim3(grid), dim3(512), LDS_BYTES, stream, p); }
    else { for (int k = 0; k < NPH; ++k) { p.ph_lo = k; p.ph_hi = k + 1; hipLaunchKernelGGL(fwd, dim3(grid), dim3(512), LDS_BYTES, stream, p); } }
}
```

```cpp
#include <hip/hip_runtime.h>
#include <cstdio>
#include <cstdint>

#ifndef MK_N_LAUNCHES
#define MK_N_LAUNCHES 1
#endif
#define DBG_X1_PLAIN 0
#define DBG_SKIP_Y 0
#ifndef PROBE_PH
#define PROBE_PH -1
#endif

#define LAS __attribute__((address_space(3)))
#define DI __device__ __forceinline__
typedef unsigned short bf16_t;
typedef short bf16x8 __attribute__((ext_vector_type(8)));
typedef short s16x4 __attribute__((ext_vector_type(4)));
typedef float f32x2 __attribute__((ext_vector_type(2)));
typedef float f32x4 __attribute__((ext_vector_type(4)));
typedef float f32x16 __attribute__((ext_vector_type(16)));
typedef unsigned u32x2 __attribute__((ext_vector_type(2)));
typedef unsigned u32x4 __attribute__((ext_vector_type(4)));
typedef __bf16 bf16x2n __attribute__((ext_vector_type(2)));
typedef int i32x8 __attribute__((ext_vector_type(8)));

constexpr int NB = 8, S = 8192, D = 1024, T = NB * S;
constexpr int LDP = 3072, LDG = 2048, LDO = 512;
constexpr int NE = 32, DE = 512;
constexpr int MAXSLOT = T * 2 + NE * 256;
constexpr int NPH = 12;
constexpr float LOG2E = 1.4426950408889634f;
constexpr float QSCALE = 0.125f * LOG2E;
constexpr float RMS_EPS = 1e-6f;

constexpr size_t MiB = 1u << 20;
constexpr size_t WS_CTL = 0, CTL_ZERO_BYTES = 64 * 1024;
constexpr int CW_BAR = 1024;
constexpr size_t WS_MODP = 1 * MiB;
constexpr size_t WS_MOD = 3 * MiB;
constexpr size_t WS_ROPE = 4 * MiB;
constexpr size_t WS_LOGIT = 144 * MiB;
constexpr size_t WS_TOKE = 24 * MiB;
constexpr size_t WS_TOKW = 24 * MiB + 512 * 1024;
constexpr size_t WS_TOKS = 25 * MiB;
constexpr size_t WS_SLOTTOK = 25 * MiB + 512 * 1024;
constexpr size_t WS_SLOTW = 26 * MiB + 256 * 1024;
constexpr size_t WS_HIST = 27 * MiB;
constexpr size_t WS_ETAB = 27 * MiB + 256 * 1024;
constexpr size_t WS_WR = 28 * MiB;
constexpr size_t WS_W1D8 = 28 * MiB + 512 * 1024;
constexpr size_t WS_W1 = 32 * MiB;
constexpr size_t WS_WG8 = 38 * MiB;
constexpr size_t WS_WB = 40 * MiB;
constexpr size_t WS_WO = 43 * MiB;
constexpr size_t WS_WGU = 48 * MiB;
constexpr size_t WS_WDN = 80 * MiB;
constexpr size_t WS_H = 144 * MiB;
constexpr size_t WS_OG = 144 * MiB;
constexpr size_t WS_LSE = 240 * MiB;
constexpr size_t WS_PROJ = 272 * MiB;
constexpr size_t WS_GATES = 656 * MiB;
constexpr size_t WS_OCAT = 912 * MiB;
constexpr size_t WS_H8 = 912 * MiB;
constexpr size_t WS_MERGED = 272 * MiB;
constexpr size_t WS_H2 = 400 * MiB;
constexpr size_t WS_H28 = 528 * MiB;
constexpr size_t WS_HMID = 592 * MiB;
constexpr size_t WS_Y = 664 * MiB;
constexpr size_t WS_UPD1 = 800 * MiB;
constexpr size_t WS_END = 976 * MiB;

constexpr int LDS_STAGE = 0, LDS_EPI = 131072, LDS_RW = 0, LDS_RV = 148480, LDS_RS = 148480 + 8192, LDS_CTLO = 148480 + 8192 + 3072, LDS_BYTES = LDS_CTLO + 256;

DI unsigned pk2(float lo, float hi) { f32x2 v = {lo, hi}; bf16x2n r = __builtin_convertvector(v, bf16x2n); return __builtin_bit_cast(unsigned, r); }
DI unsigned pk4_fp8(float a, float b, float c, float d) { int r = __builtin_amdgcn_cvt_pk_fp8_f32(a, b, 0, false); r = __builtin_amdgcn_cvt_pk_fp8_f32(c, d, r, true); return (unsigned)r; }
DI f32x2 fp8_lo2(unsigned u) { return __builtin_amdgcn_cvt_pk_f32_fp8((int)u, false); }
DI f32x2 fp8_hi2(unsigned u) { return __builtin_amdgcn_cvt_pk_f32_fp8((int)u, true); }
DI float bf_lo(unsigned u) { return __builtin_bit_cast(float, u << 16); }
DI float bf_hi(unsigned u) { return __builtin_bit_cast(float, u & 0xffff0000u); }
DI float wave_sum(float v) {
#pragma unroll
    for (int o = 1; o < 64; o <<= 1) v += __shfl_xor(v, o);
    return v;
}
DI float fexp2(float x) { return __builtin_amdgcn_exp2f(x); }
DI float flog2(float x) { return __builtin_amdgcn_logf(x); }
DI float frcp(float x) { return __builtin_amdgcn_rcpf(x); }
DI float sigmoidf(float v) { return frcp(1.0f + fexp2(-v * LOG2E)); }
DI void lds_add(LAS int* p, int v) { (void)__hip_atomic_fetch_add(p, v, __ATOMIC_RELAXED, __HIP_MEMORY_SCOPE_WORKGROUP); }
#define LDS_WAIT() asm volatile("s_waitcnt lgkmcnt(0)" ::: "memory")
#define VM_WAIT() asm volatile("s_waitcnt vmcnt(0)" ::: "memory")
DI int fresh_tid() { int t = threadIdx.x; asm volatile("" : "+v"(t)); return t; }

#define XB_TMO      128
#define XB_XCNT(j)  (256  + 64 * (j))
#define XB_XSUB(j)  (1280 + 64 * (j))
#define XB_XGEN(j)  (2304 + 64 * (j))
#define XB_TOP      3328
#define XB_TOPGEN   3392
#define XCD_BAR_WORDS 3456
#define XB_SPIN_CAP (1u << 18)

__device__ __forceinline__ unsigned xb_ld(unsigned* p)              { return __hip_atomic_load(p, __ATOMIC_RELAXED, __HIP_MEMORY_SCOPE_AGENT); }
__device__ __forceinline__ unsigned xb_add(unsigned* p, unsigned v) { return __hip_atomic_fetch_add(p, v, __ATOMIC_RELAXED, __HIP_MEMORY_SCOPE_AGENT); }
__device__ __forceinline__ unsigned xb_xcc_id() { return (unsigned)__builtin_amdgcn_s_getreg((3 << 11) | 20) & 0xFu; }
#define XB_SPIN(cond, bar) do { unsigned _sp = 0; while (cond) { __builtin_amdgcn_s_sleep(1); \
    if ((++_sp & 255u) == 0u) { if (xb_ld(&(bar)[XB_TMO])) break; if (_sp > XB_SPIN_CAP) { atomicAdd(&(bar)[XB_TMO], 1u); break; } } } } while (0)

struct XcdBarrier {
    unsigned* bar; unsigned x;
    volatile LAS unsigned* st;
};
__device__ __forceinline__ XcdBarrier xcd_barrier_post(unsigned* bar, volatile LAS unsigned* st) {
    XcdBarrier b; b.bar = bar; b.x = xb_xcc_id(); b.st = st;
    if (threadIdx.x == 0) (void)xb_add(&bar[XB_XCNT(b.x)], 1u);
    return b;
}
__device__ __forceinline__ void xcd_barrier_complete(unsigned* bar, unsigned x, unsigned& nloc, unsigned& nx) {
    const unsigned G = gridDim.x * gridDim.y * gridDim.z;
    unsigned sum, cnt, mine, sp = 0u;
    for (;;) {
        sum = 0u; cnt = 0u; mine = 0u;
#pragma unroll
        for (unsigned j = 0; j < 16; ++j) { const unsigned c = xb_ld(&bar[XB_XCNT(j)]); sum += c; cnt += (c > 0u) ? 1u : 0u; mine = (j == x) ? c : mine; }
        if (sum == G) break;
        __builtin_amdgcn_s_sleep(1);
        if ((++sp & 255u) == 0u) { if (xb_ld(&bar[XB_TMO])) break; if (sp > XB_SPIN_CAP) { atomicAdd(&bar[XB_TMO], 1u); break; } }
    }
    nloc = mine > 0u ? mine : 1u; nx = cnt > 0u ? cnt : 1u;
}
__device__ __forceinline__ void xcd_barrier(const XcdBarrier& b) {
    asm volatile("s_waitcnt vmcnt(0)" ::: "memory");
    __syncthreads();
    if (threadIdx.x == 0) {
        unsigned* bar = b.bar;
        __builtin_amdgcn_s_waitcnt(0);
        unsigned nloc = b.st[0], nx = b.st[1];
        if (nloc == 0u) { xcd_barrier_complete(bar, b.x, nloc, nx); b.st[0] = nloc; b.st[1] = nx; }
        const unsigned old = xb_add(&bar[XB_XSUB(b.x)], 1u);
        const unsigned gen = old / nloc;
        if (old + 1u == (gen + 1u) * nloc) {
            __builtin_amdgcn_fence(__ATOMIC_RELEASE, "agent");
            asm volatile("s_waitcnt vmcnt(0)" ::: "memory");
            const unsigned og = xb_add(&bar[XB_TOP], 1u);
            const unsigned tg = og / nx;
            if (og + 1u == (tg + 1u) * nx) xb_add(&bar[XB_TOPGEN], 1u);
            else XB_SPIN(xb_ld(&bar[XB_TOPGEN]) == tg, bar);
            __builtin_amdgcn_fence(__ATOMIC_ACQUIRE, "agent");
            xb_add(&bar[XB_XGEN(b.x)], 1u);
            asm volatile("s_waitcnt vmcnt(0)" ::: "memory");
        } else {
            XB_SPIN(xb_ld(&bar[XB_XGEN(b.x)]) == gen, bar);
            __builtin_amdgcn_fence(__ATOMIC_ACQUIRE, "agent");
            asm volatile("s_waitcnt vmcnt(0)" ::: "memory");
        }
    }
    __syncthreads();
}

namespace pg8 {
constexpr int BM = 256, BK = 64, HALF = 128, HTB = HALF * BK * 2, STAGE_BYTES = 8 * HTB, NXCD = 8, WGM = 8;
__host__ __device__ __forceinline__ int lds_byte(int r, int c) { const int st = (r >> 4) * 2 + (c >> 5), rr = r & 15, cc = c & 31, ob = rr * 64 + cc * 2; return st * 1024 + (ob ^ (((ob >> 9) & 1) << 5)); }
__host__ __device__ __forceinline__ void stage_rc(int b, int& R, int& C) { const int st = b / 1024, sb = b % 1024, swz = sb ^ (((sb >> 9) & 1) << 5); R = (st >> 1) * 16 + swz / 64; C = (st & 1) * 32 + (swz % 64) / 2; }
__host__ __device__ __forceinline__ int perm32(int rho) { const int n = rho >> 4, i = rho & 15; return 8 * (i >> 2) + 4 * n + (i & 3); }

struct Unit { int pm, pn, aux; unsigned a, b; };
typedef int i32x4 __attribute__((ext_vector_type(4)));
__device__ __forceinline__ i32x8 frag8(bf16x8 lo, bf16x8 hi) { return __builtin_shufflevector(__builtin_bit_cast(i32x4, lo), __builtin_bit_cast(i32x4, hi), 0, 1, 2, 3, 4, 5, 6, 7); }

template <class Epi, class Sched, bool FP8 = false>
__device__ __forceinline__ void gemm_phase(LAS unsigned char* lds, const int K, const Sched& S, const Epi& E, const __amdgpu_buffer_rsrc_t rs) {
    const int tid = fresh_tid(), wid = __builtin_amdgcn_readfirstlane(tid >> 6), lane = tid & 63, wr = wid >> 2, wc = wid & 3, fr = lane & 15, fq = lane >> 4;
    const int nt = FP8 ? K / 128 : K / BK;
    int RA[2], CA[2];
    unsigned voffA[4], voffB[2];
#pragma unroll
    for (int i = 0; i < 2; ++i) { int R, C; stage_rc(tid * 16 + i * 8192, R, C); RA[i] = R; CA[i] = C; const int Rb = Epi::PERM ? ((R & ~31) + perm32(R & 31)) : R;
        voffB[i] = (unsigned)(Rb * S.pb + C * 2); }
    const unsigned kstep = (unsigned)(BK * 2);
    const unsigned hstepB = (unsigned)(HALF * S.pb), hstepA = (unsigned)(HALF * S.pa);
    const unsigned ldsw = (unsigned)wid * 1024u;
    const int aoff = lds_byte(wr * 64 + fr, fq * 8), boff = lds_byte(wc * 32 + fr, fq * 8);
    constexpr int kpiece = 1024;
#define PG8_SA(b, h) (((b) * 2 + (h)) * HTB)
#define PG8_SB(b, h) ((4 + (b) * 2 + (h)) * HTB)
#define PG8_STAGE_B(bufoff, gbase) do { _Pragma("unroll") for (int _i = 0; _i < 2; ++_i) \
        __builtin_amdgcn_raw_ptr_buffer_load_lds(rs, (LAS unsigned*)(lds + (bufoff) + ldsw + _i * 8192), 16, (int)voffB[_i], (int)(gbase), 0, 0); } while (0)
#define PG8_STAGE_A(bufoff, gbase, h) do { _Pragma("unroll") for (int _i = 0; _i < 2; ++_i) \
        __builtin_amdgcn_raw_ptr_buffer_load_lds(rs, (LAS unsigned*)(lds + (bufoff) + ldsw + _i * 8192), 16, (int)voffA[Sched::GATHER ? (h) * 2 + _i : _i], (int)((gbase) + (Sched::GATHER ? 0u : (unsigned)(h) * hstepA)), 0, 0); } while (0)
#define PG8_LDA(dst, b, h) do { _Pragma("unroll") for (int m = 0; m < 4; ++m) _Pragma("unroll") for (int k = 0; k < 2; ++k) dst[m][k] = *(const LAS bf16x8*)(lds + PG8_SA(b, h) + aoff + m * 2048 + k * kpiece); } while (0)
#define PG8_LDB(dst, b, h) do { _Pragma("unroll") for (int n = 0; n < 2; ++n) _Pragma("unroll") for (int k = 0; k < 2; ++k) dst[n][k] = *(const LAS bf16x8*)(lds + PG8_SB(b, h) + boff + n * 2048 + k * kpiece); } while (0)
#define PG8_MMA(ai, bj, At, Bt) do { __builtin_amdgcn_s_setprio(1); if constexpr (FP8) { _Pragma("unroll") for (int m = 0; m < 4; ++m) _Pragma("unroll") for (int n = 0; n < 2; ++n) \
        acc[ai][bj][m][n] = __builtin_amdgcn_mfma_scale_f32_16x16x128_f8f6f4(frag8(Bt[n][0], Bt[n][1]), frag8(At[m][0], At[m][1]), acc[ai][bj][m][n], 0, 0, 0, 0x7C7C7C7C, 0, 0x7C7C7C7C); } \
      else { _Pragma("unroll") for (int m = 0; m < 4; ++m) _Pragma("unroll") for (int n = 0; n < 2; ++n) _Pragma("unroll") for (int k = 0; k < 2; ++k) \
        acc[ai][bj][m][n] = __builtin_amdgcn_mfma_f32_16x16x32_bf16(Bt[n][k], At[m][k], acc[ai][bj][m][n], 0, 0, 0); } __builtin_amdgcn_s_setprio(0); } while (0)
#define PG8_MMA2(ai, At) do { if constexpr (Sched::BLOCKDIAG) { if (lo_half) PG8_MMA(ai, 0, At, B0); else PG8_MMA(ai, 1, At, B1); } else { PG8_MMA(ai, 0, At, B0); PG8_MMA(ai, 1, At, B1); } } while (0)
#define PG8_WAIT_V(n) asm volatile("s_waitcnt vmcnt(" #n ")" ::: "memory")
#define PG8_WAIT_L(n) asm volatile("s_waitcnt lgkmcnt(" #n ")" ::: "memory")
#define PG8_BAR __builtin_amdgcn_s_barrier()
#define PG8_SCHED __builtin_amdgcn_sched_barrier(0)
    Unit cur, nxt; int ui = 0;
    if (!S.next(0, cur)) return;
    S.offs(cur, RA, CA, voffA);
    f32x4 acc[2][2][4][2];
#pragma unroll
    for (int a = 0; a < 2; ++a)
#pragma unroll
        for (int b = 0; b < 2; ++b)
#pragma unroll
            for (int m = 0; m < 4; ++m)
#pragma unroll
                for (int n = 0; n < 2; ++n) acc[a][b][m][n] = (f32x4){0.f, 0.f, 0.f, 0.f};
    bf16x8 At[4][2], B0[2][2], B1[2][2];
    unsigned cA = cur.a, cB = cur.b;
    PG8_STAGE_B(PG8_SB(0, 0), cB); PG8_STAGE_B(PG8_SB(0, 1), cB + hstepB); PG8_STAGE_A(PG8_SA(0, 0), cA, 0); PG8_STAGE_A(PG8_SA(0, 1), cA, 1);
    if (wr == 1) PG8_BAR;
    PG8_WAIT_V(2); PG8_BAR;
    PG8_STAGE_B(PG8_SB(1, 0), cB + kstep); PG8_STAGE_A(PG8_SA(1, 0), cA + kstep, 0); PG8_STAGE_B(PG8_SB(1, 1), cB + hstepB + kstep);
    PG8_WAIT_V(6); PG8_BAR;
    for (;;) {
        const bool has_next = S.next(ui + 1, nxt);
        const unsigned nA = has_next ? nxt.a : cA, nB = has_next ? nxt.b : cB;
        unsigned nvoff[4];
        if constexpr (Sched::GATHER) { if (has_next) S.rows(nxt, RA, nvoff); }
#pragma nounroll
        for (int t = 0; t < nt; t += 2) {
            const bool last = (t == nt - 2), lo_half = t < (nt >> 1);
            const unsigned a1 = cA + (unsigned)(t + 1) * kstep;
            const unsigned a2 = last ? nA : cA + (unsigned)(t + 2) * kstep, b2 = last ? nB : cB + (unsigned)(t + 2) * kstep;
            const unsigned a3 = a2 + kstep, b3 = b2 + kstep;
            PG8_LDB(B0, 0, 0); PG8_LDB(B1, 0, 1); PG8_SCHED; PG8_LDA(At, 0, 0); PG8_STAGE_A(PG8_SA(1, 1), a1, 1);
            PG8_WAIT_V(8); PG8_WAIT_L(0); PG8_BAR; PG8_MMA2(0, At); PG8_BAR; PG8_SCHED;
            if constexpr (Sched::GATHER) { if (last && has_next) {
#pragma unroll
                for (int q = 0; q < 4; ++q) voffA[q] = nvoff[q] * (unsigned)S.pa + (unsigned)(CA[q & 1] * 2); } }
            PG8_LDA(At, 0, 1); PG8_STAGE_B(PG8_SB(0, 0), b2); PG8_STAGE_B(PG8_SB(0, 1), b2 + hstepB); PG8_STAGE_A(PG8_SA(0, 0), a2, 0);
            PG8_WAIT_V(8); PG8_WAIT_L(0); PG8_BAR; PG8_MMA2(1, At); PG8_BAR; PG8_SCHED;
            PG8_LDB(B0, 1, 0); PG8_LDB(B1, 1, 1); PG8_SCHED; PG8_LDA(At, 1, 0); PG8_STAGE_A(PG8_SA(0, 1), a2, 1);
            PG8_WAIT_V(8); PG8_WAIT_L(0); PG8_BAR; PG8_MMA2(0, At); PG8_BAR; PG8_SCHED;
            PG8_LDA(At, 1, 1); PG8_STAGE_B(PG8_SB(1, 0), b3); PG8_STAGE_B(PG8_SB(1, 1), b3 + hstepB); PG8_STAGE_A(PG8_SA(1, 0), a3, 0);
            PG8_WAIT_V(8); PG8_WAIT_L(0); PG8_BAR; PG8_MMA2(1, At); PG8_BAR; PG8_SCHED;
        }
        if (wr == 0) PG8_BAR;
        { const int t2 = fresh_tid() & 63; E(acc, cur, wr, wc, t2 & 15, t2 >> 4, lds + LDS_EPI); }
        if (!has_next) break;
#pragma unroll
        for (int a = 0; a < 2; ++a)
#pragma unroll
            for (int b = 0; b < 2; ++b)
#pragma unroll
                for (int m = 0; m < 4; ++m)
#pragma unroll
                    for (int n = 0; n < 2; ++n) acc[a][b][m][n] = (f32x4){0.f, 0.f, 0.f, 0.f};
        cur = nxt; cA = nA; cB = nB; ++ui;
        if (wr == 1) PG8_BAR;
    }
    PG8_WAIT_V(0);
    PG8_BAR;
#undef PG8_SA
#undef PG8_SB
#undef PG8_STAGE_A
#undef PG8_STAGE_B
#undef PG8_LDA
#undef PG8_LDB
#undef PG8_MMA
#undef PG8_MMA2
#undef PG8_WAIT_V
#undef PG8_WAIT_L
#undef PG8_BAR
#undef PG8_SCHED
}

struct DenseSched {
    static constexpr bool GATHER = false, BLOCKDIAG = false;
    int nM, nN, nwg, G, c; int pa, pb; unsigned A, B;
    __device__ void init(int M, int N, int G_, int c_, size_t A_, int pa_, size_t B_, int pb_) { nM = M / BM; nN = N / BM; nwg = nM * nN; G = G_; c = c_; A = (unsigned)A_; B = (unsigned)B_; pa = pa_; pb = pb_; }
    __device__ __forceinline__ bool next(int i, Unit& u) const {
        const long L = (long)i * G + c; if (L >= nwg) return false;
        int wgid = (int)L; { const int q = nwg / NXCD, r = nwg % NXCD, xcd = wgid % NXCD, off = wgid / NXCD; wgid = (xcd < r ? xcd * (q + 1) : r * (q + 1) + (xcd - r) * q) + off; }
        const int nig = WGM * nN, gid = wgid / nig, fm = gid * WGM, gsz = (nM - fm) < WGM ? (nM - fm) : WGM;
        u.pm = fm + ((wgid % nig) % gsz); u.pn = (wgid % nig) / gsz; u.aux = 0;
        u.a = A + (unsigned)(u.pm * BM * pa); u.b = B + (unsigned)(u.pn * BM * pb); return true;
    }
    __device__ __forceinline__ void offs(const Unit&, const int (&RA)[2], const int (&CA)[2], unsigned (&v)[4]) const {
#pragma unroll
        for (int h = 0; h < 2; ++h)
#pragma unroll
            for (int i = 0; i < 2; ++i) v[h * 2 + i] = (unsigned)((h * HALF + RA[i]) * pa + CA[i] * 2);
    }
};
struct DiagSched : DenseSched { static constexpr bool BLOCKDIAG = true; };
}

struct Params { const float* in[21]; float* out; unsigned char* ws; int ph_lo, ph_hi; };
enum { I_X = 0, I_C, I_POS, I_WADA, I_BADA, I_GMIX, I_GFFN, I_WIN, I_WBG, I_QG, I_KG, I_WBD, I_WBS, I_WOUT, I_WRG, I_BRG, I_WRE, I_BRE, I_WEG, I_WEU, I_WED };

struct Frame {
    LAS unsigned char* lds;
    unsigned char* ws;
    int wave, G, bid;
};

template <bool FP8>
DI void p0_transpose_item(const float* W, int N, void* WTv, int ldt, int k0, int n0, int row_base, LAS float* scr, int lane) {
#pragma unroll 8
    for (int i = 0; i < 32; ++i) { const int kk = 2 * i + (lane >> 5); scr[kk * 33 + (lane & 31)] = W[(size_t)(k0 + kk) * N + n0 + (lane & 31)]; }
    LDS_WAIT();
    const int c = lane & 7;
#pragma unroll
    for (int j = 0; j < 4; ++j) { const int n = (lane >> 3) + 8 * j; const LAS float* sp = scr + (8 * c) * 33 + n;
        if (FP8) { u32x2 o; o.x = pk4_fp8(64.f * sp[0 * 33], 64.f * sp[1 * 33], 64.f * sp[2 * 33], 64.f * sp[3 * 33]); o.y = pk4_fp8(64.f * sp[4 * 33], 64.f * sp[5 * 33], 64.f * sp[6 * 33], 64.f * sp[7 * 33]);
            *(u32x2*)((unsigned char*)WTv + (size_t)(row_base + n) * ldt + k0 + 8 * c) = o; }
        else { u32x4 o; o.x = pk2(sp[0 * 33], sp[1 * 33]); o.y = pk2(sp[2 * 33], sp[3 * 33]); o.z = pk2(sp[4 * 33], sp[5 * 33]); o.w = pk2(sp[6 * 33], sp[7 * 33]);
            *(u32x4*)((bf16_t*)WTv + (size_t)(row_base + n) * ldt + k0 + 8 * c) = o; } }
    LDS_WAIT();
}
DI void phase0(const Frame& F, const Params& p) {
    const int tid_ = fresh_tid(), lane_ = tid_ & 63;
    LAS float* scr = (LAS float*)(F.lds + F.wave * 16384);
    const int gw = F.bid * 8 + F.wave, NGW = F.G * 8;
    bf16_t* W1 = (bf16_t*)(F.ws + WS_W1); bf16_t* WB = (bf16_t*)(F.ws + WS_WB); bf16_t* WO = (bf16_t*)(F.ws + WS_WO);
    unsigned char* WG8 = F.ws + WS_WG8; unsigned char* WGU = F.ws + WS_WGU; unsigned char* WDN = F.ws + WS_WDN;
    constexpr int I1 = 16 * 96, I2 = 16 * 64, I3 = 4 * 32, I4 = 4 * 32, I5 = 16 * 32, I6 = 32 * 256, I7 = 32 * 256, I8 = 32 * 256;
    constexpr int NITEMS = I1 + I2 + I3 + I4 + I5 + I6 + I7 + I8;
    for (int it = gw; it < NITEMS; it += NGW) {
        int r = it;
        if (r < I1) { const int kb = r / 96, nb = r % 96, n0 = 32 * nb, o0 = n0 & 255, rb = (n0 & ~255) + 128 * ((o0 >> 5) & 1) + 32 * (o0 >> 6);
            if (nb < 72) p0_transpose_item<true>(p.in[I_WIN], 3072, F.ws + WS_W1D8, 1024, 64 * kb, n0, rb, scr, lane_); else p0_transpose_item<false>(p.in[I_WIN], 3072, W1, 1024, 64 * kb, n0, rb, scr, lane_); continue; } r -= I1;
        if (r < I2) { const int kb = r / 64, nb = r % 64; p0_transpose_item<true>(p.in[I_WBG], 2048, WG8, 1024, 64 * kb, 32 * nb, 32 * nb, scr, lane_); continue; } r -= I2;
        if (r < I3) { const int kb = r / 32, nb = r % 32, n0 = 32 * nb; p0_transpose_item<true>(p.in[I_WBD], 1024, (unsigned char*)WB, 512, 64 * kb, n0, (n0 >> 7) * 256 + (n0 & 127), scr, lane_); continue; } r -= I3;
        if (r < I4) { const int kb = r / 32, nb = r % 32, n0 = 32 * nb; p0_transpose_item<true>(p.in[I_WBS], 1024, (unsigned char*)WB + 256, 512, 64 * kb, n0, (n0 >> 7) * 256 + 128 + (n0 & 127), scr, lane_); continue; } r -= I4;
        if (r < I5) { const int kb = r / 32, nb = r % 32; p0_transpose_item<true>(p.in[I_WOUT], 1024, WO, 1024, 64 * kb, 32 * nb, 32 * nb, scr, lane_); continue; } r -= I5;
        if (r < I6) { const int e = r >> 8, q = r & 255, kb = q >> 4, nb = q & 15, n0 = 32 * nb;
            p0_transpose_item<true>(p.in[I_WEG] + (size_t)e * 1024 * 512, 512, WGU + (size_t)e * 1024 * 1024, 1024, 64 * kb, n0, (n0 >> 7) * 256 + (n0 & 127), scr, lane_); continue; } r -= I6;
        if (r < I7) { const int e = r >> 8, q = r & 255, kb = q >> 4, nb = q & 15, n0 = 32 * nb;
            p0_transpose_item<true>(p.in[I_WEU] + (size_t)e * 1024 * 512, 512, WGU + (size_t)e * 1024 * 1024, 1024, 64 * kb, n0, (n0 >> 7) * 256 + 128 + (n0 & 127), scr, lane_); continue; } r -= I7;
        { const int e = r >> 8, q = r & 255, kb = q >> 5, nb = q & 31;
            p0_transpose_item<true>(p.in[I_WED] + (size_t)e * 512 * 1024, 1024, WDN + (size_t)e * 1024 * 512, 512, 64 * kb, 32 * nb, 32 * nb, scr, lane_); }
    }
    {
        unsigned char* WBz = F.ws + WS_WB;
        for (int idx = F.bid * 512 + tid_; idx < 2048 * 16; idx += F.G * 512) { const int row = idx >> 4, c = idx & 15; *(u32x4*)(WBz + (size_t)row * 512 + ((row & 128) ? 0 : 256) + c * 16) = (u32x4){0u, 0u, 0u, 0u}; }
    }
    {
        float* modp = (float*)(F.ws + WS_MODP); const float* c = p.in[I_C]; const float* wada = p.in[I_WADA];
        for (int task = gw; task < 96 * 8; task += NGW) {
            const int ct = task % 96, ks = task / 96, k0 = ks * 128;
#pragma unroll
            for (int i = 0; i < 16; ++i) { const int idx = i * 64 + lane_, b = idx >> 7, k = idx & 127; const float v = c[b * 1024 + k0 + k]; scr[idx] = v * sigmoidf(v); }
            LDS_WAIT();
            float acc[8];
#pragma unroll
            for (int b = 0; b < 8; ++b) acc[b] = 0.f;
            const float* wp = wada + (size_t)k0 * 6144 + ct * 64 + lane_;
#pragma unroll 8
            for (int k = 0; k < 128; ++k) { const float w = wp[(size_t)k * 6144];
#pragma unroll
                for (int b = 0; b < 8; ++b) acc[b] += scr[b * 128 + k] * w; }
#pragma unroll
            for (int b = 0; b < 8; ++b) modp[((size_t)ks * 8 + b) * 6144 + ct * 64 + lane_] = acc[b];
            LDS_WAIT();
        }
    }
}

DI float inv_freq_of(int i) {
    return i == 0 ? 1.0f : i == 1 ? 0.1939227432012558f : i == 2 ? 0.03760603070259094f : i == 3 ? 0.007292664609849453f : i == 4 ? 0.0014142135623842478f : i == 5 ? 0.00027424818836152554f : i == 6 ? 5.318296098266728e-05f : 1.0313386155758053e-05f;
}
template <int WHICH>
DI void phase_norm(const Frame& F, const Params& p) {
    const int tid_ = fresh_tid(), lane_ = tid_ & 63;
    LAS float* gs = (LAS float*)(F.lds); LAS float* sh = gs + 1024;
    const float* modp = (const float*)(F.ws + WS_MODP); float* mod = (float*)(F.ws + WS_MOD); const float* bada = p.in[I_BADA];
    const float* xin = p.in[I_X]; const bf16_t* upd = (const bf16_t*)(F.ws + WS_UPD1); bf16_t* hout = (bf16_t*)(F.ws + (WHICH == 0 ? WS_H : WS_H2)); unsigned* h8 = (unsigned*)(F.ws + (WHICH == 0 ? WS_H8 : WS_H28));
    const float* gn = p.in[WHICH == 0 ? I_GMIX : I_GFFN];
    for (int chunk = F.bid; chunk < T / 256; chunk += F.G) {
        const int b = chunk >> 5;
        __syncthreads();
        if (WHICH == 0) {
            if (tid_ < 192) { const int j = (chunk & 31) * 192 + tid_; float s = bada[j];
#pragma unroll
                for (int ks = 0; ks < 8; ++ks) s += modp[((size_t)ks * 8 + b) * 6144 + j];
                mod[b * 6144 + j] = s; }
            for (int col = tid_; col < 1024; col += 512) { float s1 = bada[col], s2 = bada[1024 + col];
#pragma unroll
                for (int ks = 0; ks < 8; ++ks) { s1 += modp[((size_t)ks * 8 + b) * 6144 + col]; s2 += modp[((size_t)ks * 8 + b) * 6144 + 1024 + col]; }
                gs[col] = gn[col] * (1.f + s2); sh[col] = s1; }
        } else {
            for (int col = tid_; col < 1024; col += 512) { gs[col] = gn[col] * (1.f + mod[b * 6144 + 4096 + col]); sh[col] = mod[b * 6144 + 3072 + col]; }
        }
        __syncthreads();
        f32x4 g4[4], s4[4];
#pragma unroll
        for (int j = 0; j < 4; ++j) { g4[j] = *(const LAS f32x4*)(gs + 256 * j + 4 * lane_); s4[j] = *(const LAS f32x4*)(sh + 256 * j + 4 * lane_); }
        for (int rr = F.wave; rr < 256; rr += 8) {
            const int row = chunk * 256 + rr;
            const f32x4* xr = (const f32x4*)(xin + (size_t)row * 1024) + lane_;
            f32x4 v[4]; float ss = 0.f;
#pragma unroll
            for (int j = 0; j < 4; ++j) v[j] = xr[64 * j];
            if (WHICH == 1) { const u32x2* ur = (const u32x2*)(upd + (size_t)row * 1024) + lane_; u32x2 uu[4];
#pragma unroll
                for (int j = 0; j < 4; ++j) uu[j] = ur[64 * j];
#pragma unroll
                for (int j = 0; j < 4; ++j) { v[j].x += bf_lo(uu[j].x); v[j].y += bf_hi(uu[j].x); v[j].z += bf_lo(uu[j].y); v[j].w += bf_hi(uu[j].y); } }
#pragma unroll
            for (int j = 0; j < 4; ++j) ss += (v[j].x * v[j].x + v[j].y * v[j].y) + (v[j].z * v[j].z + v[j].w * v[j].w);
            const float rinv = __builtin_amdgcn_rsqf(wave_sum(ss) * (1.f / 1024.f) + RMS_EPS);
            u32x2* o8 = (u32x2*)(hout + (size_t)row * 1024) + lane_;
#pragma unroll
            for (int j = 0; j < 4; ++j) { const f32x4 y = v[j] * rinv * g4[j] + s4[j]; u32x2 o; o.x = pk2(y.x, y.y); o.y = pk2(y.z, y.w); o8[64 * j] = o; h8[(size_t)row * 256 + 64 * j + lane_] = pk4_fp8(y.x, y.y, y.z, y.w); }
            if (WHICH == 0 && lane_ < 8) {
                const int pos = ((const int*)p.in[I_POS])[row];
                const float angf = (float)pos * inv_freq_of(lane_);
                double rv = (double)angf * 0.15915494309189535; rv -= __builtin_rint(rv);
                const float fr = (float)rv;
                bf16_t* rp = (bf16_t*)(F.ws + WS_ROPE) + (size_t)row * 16;
                rp[lane_] = (bf16_t)(pk2(__builtin_amdgcn_cosf(fr), 0.f) & 0xffffu); rp[8 + lane_] = (bf16_t)(pk2(__builtin_amdgcn_sinf(fr), 0.f) & 0xffffu);
            }
        }
    }
}

template <bool GATES> struct EpiProj {
    static constexpr bool PERM = true;
    bf16_t* proj; bf16_t* gates; const bf16_t* rope; const float* qg; const float* kg; int pn0;
    DI void operator()(const f32x4 (&acc)[2][2][4][2], const pg8::Unit& u, int wr, int wc, int fr, int fq, LAS unsigned char* scr) const {
        asm volatile("" : "+v"(fr), "+v"(fq));
        const int pn = u.pn + pn0, row0 = u.pm * 256 + wr * 64 + fr, cw = wc * 32 + 8 * fq;
        const int typ = pn < 9 ? pn / 3 : pn - 9, grp = pn < 9 ? pn % 3 : 0, l2d = pn < 9 ? 2 * grp : 0, hbase = pn < 9 ? grp * 4 : 12;
        if (GATES) {
            unsigned char* base = (unsigned char*)gates + (size_t)(u.pm * 8 + pn) * 65536 + (size_t)(((wr * 4 + wc) * 64 + fq * 16 + fr) * 8);
#pragma unroll
            for (int ai = 0; ai < 2; ++ai)
#pragma unroll
                for (int m = 0; m < 4; ++m)
#pragma unroll
                    for (int bj = 0; bj < 2; ++bj) { const f32x4 v0 = acc[ai][bj][m][0], v1 = acc[ai][bj][m][1];
                        u32x2 w; w.x = pk4_fp8(v0.x, v0.y, v0.z, v0.w); w.y = pk4_fp8(v1.x, v1.y, v1.z, v1.w);
                        *(u32x2*)(base + ((ai * 4 + m) * 2 + bj) * 4096) = w; }
        } else if (pn >= 6 || pn < 3) {
            const float sc = pn == 9 ? QSCALE : 1.f;
            const int head = hbase + wc;
#pragma unroll
            for (int ai = 0; ai < 2; ++ai)
#pragma unroll
                for (int m = 0; m < 4; ++m) { const int t = row0 + ai * 128 + m * 16, sq = t & (S - 1); const int rp = (t & ~(S - 1)) + ((sq & ((1 << l2d) - 1)) << (13 - l2d)) + (sq >> l2d);
                    bf16_t* rowp = proj + ((size_t)(typ * 16 + head) * T + rp) * 64 + 8 * fq;
#pragma unroll
                    for (int bj = 0; bj < 2; ++bj) { const f32x4 v0 = acc[ai][bj][m][0] * sc, v1 = acc[ai][bj][m][1] * sc;
                        u32x4 w; w.x = pk2(v0.x, v0.y); w.y = pk2(v0.z, v0.w); w.z = pk2(v1.x, v1.y); w.w = pk2(v1.z, v1.w);
                        *(u32x4*)(rowp + 32 * bj) = w; } }
        } else {
            const int head = hbase + wc;
            const f32x4 g0 = *(const f32x4*)(kg + 8 * fq), g1 = *(const f32x4*)(kg + 8 * fq + 4), g2 = *(const f32x4*)(kg + 32 + 8 * fq), g3 = *(const f32x4*)(kg + 32 + 8 * fq + 4);
#pragma unroll
            for (int ai = 0; ai < 2; ++ai) {
                u32x4 rcs[4][2];
#pragma unroll
                for (int m = 0; m < 4; ++m) { const u32x4* rpt = (const u32x4*)(rope + (size_t)(u.pm * 256 + ai * 128 + wr * 64 + m * 16 + fr) * 16); rcs[m][0] = rpt[0]; rcs[m][1] = rpt[1]; }
                __builtin_amdgcn_sched_barrier(0);
#pragma unroll
                for (int m = 0; m < 4; ++m) { const int row = u.pm * 256 + ai * 128 + wr * 64 + m * 16 + fr, sq = row & (S - 1);
                    const int rp = (row & ~(S - 1)) + ((sq & ((1 << l2d) - 1)) << (13 - l2d)) + (sq >> l2d);
                    const f32x4 a0 = acc[ai][0][m][0], a1 = acc[ai][0][m][1], b0 = acc[ai][1][m][0], b1 = acc[ai][1][m][1];
                    float ss = ((a0.x * a0.x + a0.y * a0.y) + (a0.z * a0.z + a0.w * a0.w)) + ((a1.x * a1.x + a1.y * a1.y) + (a1.z * a1.z + a1.w * a1.w))
                             + ((b0.x * b0.x + b0.y * b0.y) + (b0.z * b0.z + b0.w * b0.w)) + ((b1.x * b1.x + b1.y * b1.y) + (b1.z * b1.z + b1.w * b1.w));
                    ss += __shfl_xor(ss, 16); ss += __shfl_xor(ss, 32);
                    const float rinv = __builtin_amdgcn_rsqf(ss * (1.f / 64.f) + RMS_EPS);
                    f32x4 v0 = a0 * (g0 * rinv), v1 = a1 * (g1 * rinv); const f32x4 v2 = b0 * (g2 * rinv), v3 = b1 * (g3 * rinv);
                    f32x4 c0 = {1.f, 1.f, 1.f, 1.f}, c1 = c0, s0 = {0.f, 0.f, 0.f, 0.f}, s1 = s0;
                    if (fq < 2) { const u32x4 cc = rcs[m][0], sn = rcs[m][1];
                        c0 = (f32x4){bf_lo(cc.x), bf_hi(cc.x), bf_lo(cc.y), bf_hi(cc.y)}; c1 = (f32x4){bf_lo(cc.z), bf_hi(cc.z), bf_lo(cc.w), bf_hi(cc.w)};
                        s0 = (f32x4){bf_lo(sn.x), bf_hi(sn.x), bf_lo(sn.y), bf_hi(sn.y)}; s1 = (f32x4){bf_lo(sn.z), bf_hi(sn.z), bf_lo(sn.w), bf_hi(sn.w)};
                        if (fq == 0) { s0 = -s0; s1 = -s1; } }
                    f32x4 p0, p1;
                    p0.x = __shfl_xor(v0.x, 16); p0.y = __shfl_xor(v0.y, 16); p0.z = __shfl_xor(v0.z, 16); p0.w = __shfl_xor(v0.w, 16);
                    p1.x = __shfl_xor(v1.x, 16); p1.y = __shfl_xor(v1.y, 16); p1.z = __shfl_xor(v1.z, 16); p1.w = __shfl_xor(v1.w, 16);
                    v0 = v0 * c0 + p0 * s0; v1 = v1 * c1 + p1 * s1;
                    bf16_t* rowp = proj + ((size_t)(typ * 16 + head) * T + rp) * 64 + 8 * fq;
                    u32x4 w; w.x = pk2(v0.x, v0.y); w.y = pk2(v0.z, v0.w); w.z = pk2(v1.x, v1.y); w.w = pk2(v1.z, v1.w);
                    *(u32x4*)rowp = w;
                    w.x = pk2(v2.x, v2.y); w.y = pk2(v2.z, v2.w); w.z = pk2(v3.x, v3.y); w.w = pk2(v3.z, v3.w);
                    *(u32x4*)(rowp + 32) = w; }
            }
        }
    }
};

struct EpiBranch {
    static constexpr bool PERM = true;
    const unsigned char* gates; unsigned char* merged;
    DI void operator()(const f32x4 (&acc)[2][2][4][2], const pg8::Unit& u, int wr, int wc, int fr, int fq, LAS unsigned char*) const {
        asm volatile("" : "+v"(fr), "+v"(fq));
        const int row0 = u.pm * 256 + wr * 64 + fr, col0 = u.pn * 128 + wc * 32 + 8 * fq;
        const unsigned char* gbase = gates + (size_t)(u.pm * 8 + (u.pn >> 1)) * 65536 + (size_t)((u.pn & 1) * 4096) + (size_t)(((wr * 4 + wc) * 64 + fq * 16 + fr) * 8);
        u32x2 gd[2][4], gs[2][4];
#pragma unroll
        for (int ai = 0; ai < 2; ++ai)
#pragma unroll
            for (int m = 0; m < 4; ++m) { const unsigned char* gp = gbase + ((ai * 4 + m) * 2) * 4096;
                gd[ai][m] = *(const u32x2*)gp; gs[ai][m] = *(const u32x2*)(gp + 4 * 65536); }
        __builtin_amdgcn_sched_barrier(0);
#pragma unroll
        for (int ai = 0; ai < 2; ++ai)
#pragma unroll
            for (int m = 0; m < 4; ++m) { const size_t row = (size_t)(row0 + ai * 128 + m * 16);
                const u32x2 g = gd[ai][m], q = gs[ai][m];
                const f32x2 ga = fp8_lo2(g.x), gb = fp8_hi2(g.x), gc = fp8_lo2(g.y), gdd = fp8_hi2(g.y), qa = fp8_lo2(q.x), qb = fp8_hi2(q.x), qc = fp8_lo2(q.y), qd = fp8_hi2(q.y);
                const f32x4 v0 = acc[ai][0][m][0] * (f32x4){sigmoidf(ga.x), sigmoidf(ga.y), sigmoidf(gb.x), sigmoidf(gb.y)} + acc[ai][1][m][0] * (f32x4){sigmoidf(qa.x), sigmoidf(qa.y), sigmoidf(qb.x), sigmoidf(qb.y)};
                const f32x4 v1 = acc[ai][0][m][1] * (f32x4){sigmoidf(gc.x), sigmoidf(gc.y), sigmoidf(gdd.x), sigmoidf(gdd.y)} + acc[ai][1][m][1] * (f32x4){sigmoidf(qc.x), sigmoidf(qc.y), sigmoidf(qd.x), sigmoidf(qd.y)};
                u32x2 w; w.x = pk4_fp8(8.f * v0.x, 8.f * v0.y, 8.f * v0.z, 8.f * v0.w); w.y = pk4_fp8(8.f * v1.x, 8.f * v1.y, 8.f * v1.z, 8.f * v1.w);
                *(u32x2*)(merged + row * 1024 + col0) = w; }
    }
};
struct BranchSched {
    static constexpr bool GATHER = false;
    int G, c; int pa, pb; unsigned A, B;
    DI bool next(int i, pg8::Unit& u) const {
        const int tile = (i >> 1) * G + c; if (tile >= 256 * 4) return false;
        u.pm = tile >> 2; u.pn = tile & 3; u.aux = i & 1;
        u.a = A + (unsigned)(u.pm * 256 * LDO * 2 + u.aux * 256 * 2); u.b = B + (unsigned)(u.aux * 1024 * 256 * 2 + u.pn * 256 * 256 * 2); return true;
    }
    DI void offs(const pg8::Unit&, const int (&RA)[2], const int (&CA)[2], unsigned (&v)[4]) const {
#pragma unroll
        for (int h = 0; h < 2; ++h)
#pragma unroll
            for (int i = 0; i < 2; ++i) v[h * 2 + i] = (unsigned)((h * 128 + RA[i]) * pa + CA[i] * 2);
    }
};

struct EpiOut {
    static constexpr bool PERM = true;
    bf16_t* upd; const float* mod;
    DI void operator()(const f32x4 (&acc)[2][2][4][2], const pg8::Unit& u, int wr, int wc, int fr, int fq, LAS unsigned char*) const {
        asm volatile("" : "+v"(fr), "+v"(fq));
        const int row0 = u.pm * 256 + wr * 64 + fr, col0 = u.pn * 256 + wc * 32 + 8 * fq; const int b = (u.pm * 256) >> 13;
        f32x4 gv[2][2];
#pragma unroll
        for (int bj = 0; bj < 2; ++bj)
#pragma unroll
            for (int n = 0; n < 2; ++n) gv[bj][n] = *(const f32x4*)(mod + b * 6144 + 2048 + col0 + bj * 128 + n * 4) * 0.125f;
#pragma unroll
        for (int ai = 0; ai < 2; ++ai)
#pragma unroll
            for (int m = 0; m < 4; ++m)
#pragma unroll
                for (int bj = 0; bj < 2; ++bj) { const f32x4 v0 = acc[ai][bj][m][0] * gv[bj][0], v1 = acc[ai][bj][m][1] * gv[bj][1];
                    u32x4 w; w.x = pk2(v0.x, v0.y); w.y = pk2(v0.z, v0.w); w.z = pk2(v1.x, v1.y); w.w = pk2(v1.z, v1.w);
                    *(u32x4*)(upd + (size_t)(row0 + ai * 128 + m * 16) * 1024 + col0 + bj * 128) = w; }
    }
};

struct EpiLogit {
    static constexpr bool PERM = false;
    float* logit;
    DI void operator()(const f32x4 (&acc)[2][2][4][2], const pg8::Unit& u, int wr, int wc, int fr, int fq, LAS unsigned char*) const {
        asm volatile("" : "+v"(fr), "+v"(fq));
        const int row0 = u.pm * 256 + wr * 64 + fr, col0 = wc * 32 + 4 * fq;
#pragma unroll
        for (int ai = 0; ai < 2; ++ai)
#pragma unroll
            for (int m = 0; m < 4; ++m)
#pragma unroll
                for (int n = 0; n < 2; ++n) *(f32x4*)(logit + (size_t)(row0 + ai * 128 + m * 16) * 128 + col0 + n * 16) = acc[ai][0][m][n];
    }
};

struct MoeSched {
    static constexpr bool GATHER_ = true;
    int G, c, nc; int pa, pb; unsigned A, B; const LAS int* cstart; const int* slot_tok; unsigned estride, pnstride;
};
struct MoeSchedUp : MoeSched {
    static constexpr bool GATHER = true, BLOCKDIAG = false;
    DI bool next(int i, pg8::Unit& u) const {
        const int L = i * G + c; if (L >= nc * 4) return false;
        const int chunk = L >> 2; int e = 0;
        for (int q = 1; q < 32; ++q) e += (chunk >= cstart[q]) ? 1 : 0;
        e = __builtin_amdgcn_readfirstlane(e);
        u.pm = chunk; u.pn = L & 3; u.aux = e; u.a = A; u.b = B + (unsigned)e * estride + (unsigned)u.pn * pnstride; return true;
    }
    DI void offs(const pg8::Unit& u, const int (&RA)[2], const int (&CA)[2], unsigned (&v)[4]) const {
#pragma unroll
        for (int h = 0; h < 2; ++h)
#pragma unroll
            for (int i = 0; i < 2; ++i) { const int tok = slot_tok[u.pm * 256 + h * 128 + RA[i]]; v[h * 2 + i] = (unsigned)(tok * pa + CA[i] * 2); }
    }
    DI void rows(const pg8::Unit& u, const int (&RA)[2], unsigned (&v)[4]) const {
#pragma unroll
        for (int h = 0; h < 2; ++h)
#pragma unroll
            for (int i = 0; i < 2; ++i) v[h * 2 + i] = (unsigned)slot_tok[u.pm * 256 + h * 128 + RA[i]];
    }
};
struct MoeSchedDn : MoeSched {
    static constexpr bool GATHER = false, BLOCKDIAG = false;
    DI bool next(int i, pg8::Unit& u) const {
        const int L = i * G + c; if (L >= nc * 4) return false;
        const int chunk = L >> 2; int e = 0;
        for (int q = 1; q < 32; ++q) e += (chunk >= cstart[q]) ? 1 : 0;
        e = __builtin_amdgcn_readfirstlane(e);
        u.pm = chunk; u.pn = L & 3; u.aux = e; u.a = A + (unsigned)(chunk * 256 * pa); u.b = B + (unsigned)e * estride + (unsigned)u.pn * pnstride; return true;
    }
    DI void offs(const pg8::Unit&, const int (&RA)[2], const int (&CA)[2], unsigned (&v)[4]) const {
#pragma unroll
        for (int h = 0; h < 2; ++h)
#pragma unroll
            for (int i = 0; i < 2; ++i) v[h * 2 + i] = (unsigned)((h * 128 + RA[i]) * pa + CA[i] * 2);
    }
};
struct EpiSwiglu {
    static constexpr bool PERM = true;
    unsigned char* hmid;
    DI void operator()(const f32x4 (&acc)[2][2][4][2], const pg8::Unit& u, int wr, int wc, int fr, int fq, LAS unsigned char*) const {
        asm volatile("" : "+v"(fr), "+v"(fq));
        const int row0 = u.pm * 256 + wr * 64 + fr, col0 = u.pn * 128 + wc * 32 + 8 * fq;
#pragma unroll
        for (int ai = 0; ai < 2; ++ai)
#pragma unroll
            for (int m = 0; m < 4; ++m) {
                f32x4 h[2];
#pragma unroll
                for (int n = 0; n < 2; ++n) { const f32x4 g = acc[ai][0][m][n], up = acc[ai][1][m][n];
                    h[n] = (f32x4){g.x * sigmoidf(g.x) * up.x, g.y * sigmoidf(g.y) * up.y, g.z * sigmoidf(g.z) * up.z, g.w * sigmoidf(g.w) * up.w}; }
                u32x2 w; w.x = pk4_fp8(h[0].x, h[0].y, h[0].z, h[0].w); w.y = pk4_fp8(h[1].x, h[1].y, h[1].z, h[1].w);
                *(u32x2*)(hmid + (size_t)(row0 + ai * 128 + m * 16) * DE + col0) = w; }
    }
};
struct EpiDown {
    static constexpr bool PERM = true;
    unsigned char* y;
    DI void operator()(const f32x4 (&acc)[2][2][4][2], const pg8::Unit& u, int wr, int wc, int fr, int fq, LAS unsigned char*) const {
        asm volatile("" : "+v"(fr), "+v"(fq));
        const int row0 = u.pm * 256 + wr * 64 + fr, col0 = u.pn * 256 + wc * 32 + 8 * fq;
#pragma unroll
        for (int ai = 0; ai < 2; ++ai)
#pragma unroll
            for (int m = 0; m < 4; ++m) { const int slot = row0 + ai * 128 + m * 16;
#pragma unroll
                for (int bj = 0; bj < 2; ++bj) { const f32x4 v0 = acc[ai][bj][m][0] * 8.f, v1 = acc[ai][bj][m][1] * 8.f;
                    u32x2 o; o.x = pk4_fp8(v0.x, v0.y, v0.z, v0.w); o.y = pk4_fp8(v1.x, v1.y, v1.z, v1.w);
                    *(u32x2*)(y + (size_t)slot * 1024 + col0 + bj * 128) = o; } }
    }
};

constexpr int SLOT_BYTES = 8192;
DI f32x16 mfma32(bf16x8 a, bf16x8 b, f32x16 c) { return __builtin_amdgcn_mfma_f32_32x32x16_bf16(a, b, c, 0, 0, 0); }
DI int swz_f(int r) { return (((r >> 1) & 1) << 2) | ((r >> 2) & 3); }
struct AttnLane { unsigned doff[4]; unsigned ka[4]; unsigned va[2][2]; };
DI void attn_lane_init(AttnLane& L, int lane) {
#pragma unroll
    for (int i = 0; i < 4; ++i) { const int r = 8 * i + (lane >> 3), c = (lane & 7) ^ swz_f(r); L.doff[i] = (unsigned)(r * 128 + c * 16); }
    { const int r = lane & 31, h = lane >> 5; const unsigned a0 = (unsigned)(r * 128 + 16 * ((h ^ swz_f(r)) & 7));
#pragma unroll
      for (int s = 0; s < 4; ++s) L.ka[s] = a0 ^ (unsigned)(32 * s); }
    { const int h = lane >> 5, blk = (lane >> 4) & 1, q = (lane & 15) >> 2, p = lane & 3, fb2 = (q >> 1) & 1;
#pragma unroll
      for (int t = 0; t < 2; ++t) { const int flow = (2 * t + h) & 3;
#pragma unroll
        for (int mt = 0; mt < 2; ++mt) L.va[t][mt] = (unsigned)(4096 + (8 * t + 4 * h + q) * 128 + 16 * (4 * (mt ^ fb2) + ((2 * blk + (p >> 1)) ^ flow)) + 8 * (p & 1)); } }
}
DI void dma_tile(const AttnLane& L, const __amdgpu_buffer_rsrc_t rs, unsigned koff, unsigned voff, LAS unsigned char* slot) {
#pragma unroll
    for (int i = 0; i < 4; ++i) __builtin_amdgcn_raw_ptr_buffer_load_lds(rs, (LAS unsigned*)(slot + 1024 * i), 16, (int)L.doff[i], (int)koff, 0, 0);
#pragma unroll
    for (int i = 0; i < 4; ++i) __builtin_amdgcn_raw_ptr_buffer_load_lds(rs, (LAS unsigned*)(slot + 4096 + 1024 * i), 16, (int)L.doff[i], (int)voff, 0, 0);
}
DI void tr_read8(const AttnLane& L, unsigned sb, bf16x8 (&vf)[2][2]) {
    s16x4 r0, r1, r2, r3, r4, r5, r6, r7;
    const unsigned a00 = sb + L.va[0][0], a10 = sb + L.va[1][0], a01 = sb + L.va[0][1], a11 = sb + L.va[1][1];
    asm volatile("ds_read_b64_tr_b16 %0, %8\n\tds_read_b64_tr_b16 %1, %9\n\tds_read_b64_tr_b16 %2, %8 offset:2048\n\tds_read_b64_tr_b16 %3, %9 offset:2048\n\t"
                 "ds_read_b64_tr_b16 %4, %10\n\tds_read_b64_tr_b16 %5, %11\n\tds_read_b64_tr_b16 %6, %10 offset:2048\n\tds_read_b64_tr_b16 %7, %11 offset:2048\n\ts_waitcnt lgkmcnt(0)"
                 : "=&v"(r0), "=&v"(r1), "=&v"(r2), "=&v"(r3), "=&v"(r4), "=&v"(r5), "=&v"(r6), "=&v"(r7)
                 : "v"(a00), "v"(a10), "v"(a01), "v"(a11) : "memory");
    vf[0][0] = __builtin_shufflevector(r0, r1, 0, 1, 2, 3, 4, 5, 6, 7); vf[0][1] = __builtin_shufflevector(r2, r3, 0, 1, 2, 3, 4, 5, 6, 7);
    vf[1][0] = __builtin_shufflevector(r4, r5, 0, 1, 2, 3, 4, 5, 6, 7); vf[1][1] = __builtin_shufflevector(r6, r7, 0, 1, 2, 3, 4, 5, 6, 7);
}
DI bf16x8 pack8(const f32x16& x, int s) {
    u32x4 p; p.x = pk2(x[8 * s], x[8 * s + 1]); p.y = pk2(x[8 * s + 2], x[8 * s + 3]); p.z = pk2(x[8 * s + 4], x[8 * s + 5]); p.w = pk2(x[8 * s + 6], x[8 * s + 7]);
    return __builtin_bit_cast(bf16x8, p);
}
DI void store_o_row(bf16_t* rowp, const f32x16& O0, const f32x16& O1, float sc, int h) {
#pragma unroll
    for (int mt = 0; mt < 2; ++mt)
#pragma unroll
        for (int kp = 0; kp < 2; ++kp) { const f32x16& O = mt ? O1 : O0; const int g0 = 8 * kp, g1 = 8 * kp + 4;
            u32x2 a, b; a.x = pk2(O[g0] * sc, O[g0 + 1] * sc); a.y = pk2(O[g0 + 2] * sc, O[g0 + 3] * sc); b.x = pk2(O[g1] * sc, O[g1 + 1] * sc); b.y = pk2(O[g1 + 2] * sc, O[g1 + 3] * sc);
            { auto r = __builtin_amdgcn_permlane32_swap(a.x, b.x, false, false); a.x = r[0]; b.x = r[1]; }
            { auto r = __builtin_amdgcn_permlane32_swap(a.y, b.y, false, false); a.y = r[0]; b.y = r[1]; }
            *(u32x4*)(rowp + 32 * mt + 16 * kp + 8 * h) = (u32x4){a.x, a.y, b.x, b.y}; }
}
DI void store_o_row_fp8(unsigned char* rowp, const f32x16& O0, const f32x16& O1, int h) {
#pragma unroll
    for (int mt = 0; mt < 2; ++mt)
#pragma unroll
        for (int kp = 0; kp < 2; ++kp) { const f32x16& O = mt ? O1 : O0; const int g0 = 8 * kp, g1 = 8 * kp + 4;
            unsigned a = pk4_fp8(O[g0], O[g0 + 1], O[g0 + 2], O[g0 + 3]), b = pk4_fp8(O[g1], O[g1 + 1], O[g1 + 2], O[g1 + 3]);
            { auto r = __builtin_amdgcn_permlane32_swap(a, b, false, false); a = r[0]; b = r[1]; }
            *(u32x2*)(rowp + 32 * mt + 16 * kp + 8 * h) = (u32x2){a, b}; }
}
#define ATTN_WAIT_TILE(more) do { if (more) asm volatile("s_waitcnt vmcnt(8)" ::: "memory"); else asm volatile("s_waitcnt vmcnt(0)" ::: "memory"); } while (0)
DI void dil_tile(const AttnLane& L, const __amdgpu_buffer_rsrc_t rs, const bf16_t* hb, int hd, long row0, int j, LAS unsigned char* ldsW, bf16_t* og, float* lse, int lane, const float (&gq)[32], const bf16_t* ropet, long tok0, int dil) {
    const int qi = lane & 31, h = lane >> 5;
    const bf16_t* qh = hb + (size_t)hd * T * 64;
    const unsigned kh = (unsigned)(WS_PROJ + ((size_t)(16 + hd) * T + row0) * 128), vh = (unsigned)(WS_PROJ + ((size_t)(32 + hd) * T + row0) * 128);
    bf16x8 qf[4];
    {
        const bf16_t* qp = qh + (size_t)(row0 + 32 * j + qi) * 64 + 8 * h;
        u32x4 qr[4];
#pragma unroll
        for (int s = 0; s < 4; ++s) qr[s] = *(const u32x4*)(qp + 16 * s);
        const u32x4* rpt = (const u32x4*)(ropet + (size_t)(tok0 + (long)dil * (32 * j + qi)) * 16); const u32x4 cc = rpt[0], sn = rpt[1];
        float qv[4][8]; float ss = 0.f;
#pragma unroll
        for (int s = 0; s < 4; ++s) { const u32x4 u = qr[s]; qv[s][0] = bf_lo(u.x); qv[s][1] = bf_hi(u.x); qv[s][2] = bf_lo(u.y); qv[s][3] = bf_hi(u.y); qv[s][4] = bf_lo(u.z); qv[s][5] = bf_hi(u.z); qv[s][6] = bf_lo(u.w); qv[s][7] = bf_hi(u.w);
#pragma unroll
            for (int e = 0; e < 8; ++e) ss += qv[s][e] * qv[s][e]; }
        ss += __shfl_xor(ss, 32);
        const float rinv = __builtin_amdgcn_rsqf(ss * (1.f / 64.f) + RMS_EPS) * QSCALE;
#pragma unroll
        for (int s = 0; s < 4; ++s)
#pragma unroll
            for (int e = 0; e < 8; ++e) qv[s][e] *= rinv * gq[s * 8 + e];
        { const float cs[8] = {bf_lo(cc.x), bf_hi(cc.x), bf_lo(cc.y), bf_hi(cc.y), bf_lo(cc.z), bf_hi(cc.z), bf_lo(cc.w), bf_hi(cc.w)};
          const float sv[8] = {bf_lo(sn.x), bf_hi(sn.x), bf_lo(sn.y), bf_hi(sn.y), bf_lo(sn.z), bf_hi(sn.z), bf_lo(sn.w), bf_hi(sn.w)};
#pragma unroll
          for (int e = 0; e < 8; ++e) { const float other = __shfl_xor(qv[0][e], 32); qv[0][e] = qv[0][e] * cs[e] + other * (h ? sv[e] : -sv[e]); } }
#pragma unroll
        for (int s = 0; s < 4; ++s) { u32x4 o; o.x = pk2(qv[s][0], qv[s][1]); o.y = pk2(qv[s][2], qv[s][3]); o.z = pk2(qv[s][4], qv[s][5]); o.w = pk2(qv[s][6], qv[s][7]); qf[s] = __builtin_bit_cast(bf16x8, o); }
    }
    float mrun = -INFINITY, lrun = 0.f;
    f32x16 O0, O1;
#pragma unroll
    for (int i = 0; i < 16; ++i) { O0[i] = 0.f; O1[i] = 0.f; }
    const int kt0 = j >= 4 ? j - 4 : 0;
    dma_tile(L, rs, kh + (unsigned)(4096 * kt0), vh + (unsigned)(4096 * kt0), ldsW);
    unsigned buf = 0;
    for (int kt = kt0; kt <= j; ++kt) {
        const bool more = kt < j;
        if (more) dma_tile(L, rs, kh + (unsigned)(4096 * (kt + 1)), vh + (unsigned)(4096 * (kt + 1)), ldsW + (buf ^ 1u) * SLOT_BYTES);
        ATTN_WAIT_TILE(more);
        LAS unsigned char* slot = ldsW + buf * SLOT_BYTES;
        f32x16 sc;
#pragma unroll
        for (int i = 0; i < 16; ++i) sc[i] = 0.f;
#pragma unroll
        for (int s = 0; s < 4; ++s) { const bf16x8 kf = *(const LAS bf16x8*)(slot + L.ka[s]); sc = mfma32(kf, qf[s], sc); }
        if (kt == j) {
#pragma unroll
            for (int i = 0; i < 16; ++i) { const int key = (i & 3) + 8 * (i >> 2) + 4 * h; if (key > qi) sc[i] = -INFINITY; }
        }
        if (kt == j - 4) {
#pragma unroll
            for (int i = 0; i < 16; ++i) { const int key = (i & 3) + 8 * (i >> 2) + 4 * h; if (key < qi) sc[i] = -INFINITY; }
        }
        float mx = sc[0];
#pragma unroll
        for (int i = 1; i < 16; ++i) mx = fmaxf(mx, sc[i]);
        mx = fmaxf(mx, __shfl_xor(mx, 32));
        const float mnew = fmaxf(mrun, mx), alpha = fexp2(mrun - mnew);
        float ps = 0.f;
#pragma unroll
        for (int i = 0; i < 16; ++i) { sc[i] = fexp2(sc[i] - mnew); ps += sc[i]; }
        lrun = lrun * alpha + ps; mrun = mnew;
#pragma unroll
        for (int i = 0; i < 16; ++i) { O0[i] *= alpha; O1[i] *= alpha; }
        const bf16x8 p0 = pack8(sc, 0), p1 = pack8(sc, 1);
        bf16x8 vf[2][2]; tr_read8(L, (unsigned)(size_t)slot, vf);
        O0 = mfma32(vf[0][0], p0, O0); O0 = mfma32(vf[0][1], p1, O0);
        O1 = mfma32(vf[1][0], p0, O1); O1 = mfma32(vf[1][1], p1, O1);
        buf ^= 1u;
    }
    const float ltot = lrun + __shfl_xor(lrun, 32), inv = frcp(ltot);
    const size_t row = (size_t)(row0 + 32 * j + qi);
    store_o_row(og + row * 64, O0, O1, inv, h);
    if (h == 0) lse[row] = mrun + flog2(ltot);
}
DI void sb_tile(const AttnLane& L, const __amdgpu_buffer_rsrc_t rs, const bf16_t* hb, int b, int h4, int j, LAS unsigned char* ldsW, unsigned char* ocat, int lane) {
    const int qi = lane & 31, h = lane >> 5;
    const long base = (long)b * S;
    const bf16_t* qh = hb + (size_t)(12 + h4) * T * 64;
    const unsigned kh = (unsigned)(WS_PROJ + ((size_t)(16 + 12 + h4) * T + base) * 128), vh = (unsigned)(WS_PROJ + ((size_t)(32 + 12 + h4) * T + base) * 128);
    bf16x8 qf[4];
    { const bf16_t* qp = qh + (size_t)(base + 32 * j + qi) * 64 + 8 * h;
#pragma unroll
      for (int s = 0; s < 4; ++s) qf[s] = *(const bf16x8*)(qp + 16 * s); }
    float carry = 0.f;
    f32x16 O0, O1;
#pragma unroll
    for (int i = 0; i < 16; ++i) { O0[i] = 0.f; O1[i] = 0.f; }
    dma_tile(L, rs, kh + (unsigned)(4096 * j), vh + (unsigned)(4096 * j), ldsW);
    unsigned buf = 0;
    for (int kt = j; kt >= 0; --kt) {
        const bool more = kt > 0;
        if (more) dma_tile(L, rs, kh + (unsigned)(4096 * (kt - 1)), vh + (unsigned)(4096 * (kt - 1)), ldsW + (buf ^ 1u) * SLOT_BYTES);
        ATTN_WAIT_TILE(more);
        LAS unsigned char* slot = ldsW + buf * SLOT_BYTES;
        f32x16 z;
#pragma unroll
        for (int i = 0; i < 16; ++i) z[i] = 0.f;
#pragma unroll
        for (int s = 0; s < 4; ++s) { const bf16x8 kf = *(const LAS bf16x8*)(slot + L.ka[s]); z = mfma32(kf, qf[s], z); }
#pragma unroll
        for (int i = 0; i < 16; ++i) z[i] = fexp2(fminf(z[i], 31.f));
        if (kt == j) {
#pragma unroll
            for (int i = 0; i < 16; ++i) { const int key = (i & 3) + 8 * (i >> 2) + 4 * h; if (key >= qi) z[i] = 0.f; }
        }
        float lg[4], par[4], u0[4], p01[4], p012[4];
#pragma unroll
        for (int g = 0; g < 4; ++g) { const float a0 = 1.f + z[4 * g], a1 = 1.f + z[4 * g + 1], a2 = 1.f + z[4 * g + 2], a3 = 1.f + z[4 * g + 3];
            u0[g] = a0; p01[g] = a0 * a1; p012[g] = p01[g] * a2; lg[g] = -flog2(p012[g] * a3); }
#pragma unroll
        for (int g = 0; g < 4; ++g) par[g] = __shfl_xor(lg[g], 32);
        float tg[4]; tg[3] = carry; tg[2] = tg[3] + (lg[3] + par[3]); tg[1] = tg[2] + (lg[2] + par[2]); tg[0] = tg[1] + (lg[1] + par[1]);
        carry = tg[0] + (lg[0] + par[0]);
#pragma unroll
        for (int g = 0; g < 4; ++g) { const float suf = tg[g] + lg[g] + (h == 0 ? par[g] : 0.f); const float y = fexp2(suf);
            z[4 * g] = z[4 * g] * y; z[4 * g + 1] = z[4 * g + 1] * (y * u0[g]); z[4 * g + 2] = z[4 * g + 2] * (y * p01[g]); z[4 * g + 3] = z[4 * g + 3] * (y * p012[g]); }
        const bf16x8 p0 = pack8(z, 0), p1 = pack8(z, 1);
        bf16x8 vf[2][2]; tr_read8(L, (unsigned)(size_t)slot, vf);
        O0 = mfma32(vf[0][0], p0, O0); O0 = mfma32(vf[0][1], p1, O0);
        O1 = mfma32(vf[1][0], p0, O1); O1 = mfma32(vf[1][1], p1, O1);
        if (__all(carry < -40.f)) break;
        buf ^= 1u;
    }
    store_o_row_fp8(ocat + (size_t)(base + 32 * j + qi) * LDO + 256 + h4 * 64, O0, O1, h);
}
DI void phase_attn(const Frame& F, const Params& p) {
    const int tid_ = fresh_tid(), lane_ = tid_ & 63;
    const bf16_t* hb = (const bf16_t*)(F.ws + WS_PROJ); unsigned char* ocat = F.ws + WS_OCAT;
    bf16_t* og = (bf16_t*)(F.ws + WS_OG); float* lse = (float*)(F.ws + WS_LSE);
    LAS unsigned char* ldsW = F.lds + F.wave * (2 * SLOT_BYTES);
    AttnLane L; attn_lane_init(L, lane_);
    float gq[32];
#pragma unroll
    for (int s4 = 0; s4 < 4; ++s4)
#pragma unroll
        for (int e = 0; e < 8; ++e) gq[s4 * 8 + e] = p.in[I_QG][16 * s4 + 8 * (lane_ >> 5) + e];
    const __amdgpu_buffer_rsrc_t rs = __builtin_amdgcn_make_buffer_rsrc(F.ws, 0, (int)WS_END, 0x00020000);
    const int NU = NB * 4 * 16;
    for (int i = 0;; ++i) {
        const int u = (F.G == 256) ? ((F.bid & 7) * 32 + (F.bid >> 3) + 256 * i) : (F.bid + F.G * i);
        if (u >= NU) break;
        const int qb = u & 15, hs = (u >> 4) & 3, b = u >> 6, t0 = qb * 512;
        for (int w = F.wave; w < 16; w += 8) sb_tile(L, rs, hb, b, hs, t0 / 32 + w, ldsW, ocat, lane_);
        for (int w = F.wave; w < 48; w += 8) {
            const int g = w >> 4, ti = w & 15, l2d = 2 * g, per = 16 >> l2d, r = ti / per, jj = ti % per;
            dil_tile(L, rs, hb, g * 4 + hs, (long)b * S + (long)r * (S >> l2d), ((t0 >> l2d) >> 5) + jj, ldsW, og + (size_t)(g * 4 + hs) * T * 64, lse + (size_t)(g * 4 + hs) * T, lane_, gq, (const bf16_t*)(F.ws + WS_ROPE), (long)b * S + r, 1 << l2d);
        }
        VM_WAIT();
        __syncthreads();
        {
            const int piece = tid_ & 7; const size_t bb = (size_t)b * S;
#pragma unroll 2
            for (int pass = 0; pass < 8; ++pass) {
                const int sq = t0 + pass * 64 + (tid_ >> 3);
                const size_t r0 = bb + sq, r1 = bb + ((size_t)(sq & 3) << 11) + (sq >> 2), r2 = bb + ((size_t)(sq & 15) << 9) + (sq >> 4);
                const float l0 = lse[(size_t)(0 + hs) * T + r0], l1 = lse[(size_t)(4 + hs) * T + r1], l2 = lse[(size_t)(8 + hs) * T + r2];
                const u32x4 x = *((const u32x4*)(og + ((size_t)(0 + hs) * T + r0) * 64) + piece), y = *((const u32x4*)(og + ((size_t)(4 + hs) * T + r1) * 64) + piece), z = *((const u32x4*)(og + ((size_t)(8 + hs) * T + r2) * 64) + piece);
                const float mx = fmaxf(l0, fmaxf(l1, l2)); float w0 = fexp2(l0 - mx), w1 = fexp2(l1 - mx), w2 = fexp2(l2 - mx); const float inv = frcp(w0 + w1 + w2); w0 *= inv; w1 *= inv; w2 *= inv;
                u32x2 r;
                r.x = pk4_fp8(w0 * bf_lo(x.x) + w1 * bf_lo(y.x) + w2 * bf_lo(z.x), w0 * bf_hi(x.x) + w1 * bf_hi(y.x) + w2 * bf_hi(z.x), w0 * bf_lo(x.y) + w1 * bf_lo(y.y) + w2 * bf_lo(z.y), w0 * bf_hi(x.y) + w1 * bf_hi(y.y) + w2 * bf_hi(z.y));
                r.y = pk4_fp8(w0 * bf_lo(x.z) + w1 * bf_lo(y.z) + w2 * bf_lo(z.z), w0 * bf_hi(x.z) + w1 * bf_hi(y.z) + w2 * bf_hi(z.z), w0 * bf_lo(x.w) + w1 * bf_lo(y.w) + w2 * bf_lo(z.w), w0 * bf_hi(x.w) + w1 * bf_hi(y.w) + w2 * bf_hi(z.w));
                *((u32x2*)(ocat + (bb + sq) * LDO + hs * 64) + piece) = r;
            }
        }
        __syncthreads();
    }
}

DI void route_rows(const Frame& F, const Params& p, int pm) {
    const int tid_ = fresh_tid(), lane_ = tid_ & 63;
    LAS int* hist = (LAS int*)(F.lds);
    const int ftid = fresh_tid();
    __syncthreads();
    if (ftid < 32) hist[ftid] = 0;
    __syncthreads();
    if (tid_ < 256) {
        const int row = pm * 256 + tid_; const float* L = (const float*)(F.ws + WS_LOGIT) + (size_t)row * 128;
        const float* brg = p.in[I_BRG]; const float* bre = p.in[I_BRE];
        float lgp[4];
#pragma unroll
        for (int c = 0; c < 4; ++c) lgp[c] = L[c] + L[36 + c] + brg[c];
        int gsel = 0; float gm = lgp[0];
#pragma unroll
        for (int c = 1; c < 4; ++c) if (lgp[c] > gm) { gm = lgp[c]; gsel = c; }
        float zs = 0.f;
#pragma unroll
        for (int c = 0; c < 4; ++c) zs += fexp2((lgp[c] - gm) * LOG2E);
        const float pg = frcp(zs);
        float l1 = -INFINITY, l2 = -INFINITY; int e1 = 0, e2 = 0;
#pragma unroll
        for (int i = 0; i < 8; ++i) { const int c = 4 + gsel * 8 + i; const float v = L[c] + L[36 + c] + bre[gsel * 8 + i];
            if (v > l1) { l2 = l1; e2 = e1; l1 = v; e1 = i; } else if (v > l2) { l2 = v; e2 = i; } }
        const float ex = fexp2((l2 - l1) * LOG2E), den = frcp(1.f + ex);
        int* te = (int*)(F.ws + WS_TOKE) + (size_t)row * 2; float* tw = (float*)(F.ws + WS_TOKW) + (size_t)row * 2;
        te[0] = gsel * 8 + e1; te[1] = gsel * 8 + e2; tw[0] = pg * den; tw[1] = pg * ex * den;
        lds_add(&hist[gsel * 8 + e1], 1); lds_add(&hist[gsel * 8 + e2], 1);
    }
    __syncthreads();
    if (ftid < 32) ((int*)(F.ws + WS_HIST))[pm * 32 + ftid] = hist[ftid];
}


DI void router_weights_to_lds(const Frame& F, const Params& p) {
    const int tid_ = fresh_tid(), lane_ = tid_ & 63;
    constexpr int WP = 1028;
    LAS float* wt = (LAS float*)(F.lds + LDS_RW); LAS float* bias = (LAS float*)(F.lds + LDS_RS) + 8 * 80 + 32;
    const float* wrg = p.in[I_WRG]; const float* wre = p.in[I_WRE]; const float* brg = p.in[I_BRG]; const float* bre = p.in[I_BRE];
    const int ftid = fresh_tid();
    __syncthreads();
#pragma unroll 8
    for (int i = ftid; i < 1024 * 32; i += 512) wt[(4 + (i & 31)) * WP + (i >> 5)] = wre[i];
#pragma unroll 8
    for (int i = ftid; i < 1024 * 4; i += 512) wt[(i & 3) * WP + (i >> 2)] = wrg[i];
    if (ftid < 36) bias[ftid] = ftid < 4 ? brg[ftid] : bre[ftid - 4];
}

DI void phase_norm2_route(const Frame& F, const Params& p) {
    const int tid_ = fresh_tid(), lane_ = tid_ & 63;
    constexpr int WP = 1028;
    LAS float* wt = (LAS float*)(F.lds + LDS_RW);
    LAS float* gs = (LAS float*)(F.lds + LDS_RV); LAS float* sh = gs + 1024;
    LAS float* scr = (LAS float*)(F.lds + LDS_RS) + F.wave * 80;
    LAS int* hist = (LAS int*)(F.lds + LDS_RS) + 8 * 80;
    LAS float* bias = (LAS float*)(F.lds + LDS_RS) + 8 * 80 + 32;
    const float* mod = (const float*)(F.ws + WS_MOD); const float* gn = p.in[I_GFFN];
    const bf16_t* upd = (const bf16_t*)(F.ws + WS_UPD1); unsigned* h8 = (unsigned*)(F.ws + WS_H28);
    const float* wrg = p.in[I_WRG]; const float* wre = p.in[I_WRE]; const float* brg = p.in[I_BRG]; const float* bre = p.in[I_BRE];
    const int ftid = fresh_tid();
    __syncthreads();
    for (int chunk = F.bid; chunk < T / 256; chunk += F.G) {
        const int b = chunk >> 5;
        __syncthreads();
        for (int col = ftid; col < 1024; col += 512) { gs[col] = gn[col] * (1.f + mod[b * 6144 + 4096 + col]); sh[col] = mod[b * 6144 + 3072 + col]; }
        if (ftid < 32) hist[ftid] = 0;
        __syncthreads();
        f32x4 vn[2][4]; u32x2 un[2][4];
#pragma unroll
        for (int r = 0; r < 2; ++r) { const int row = chunk * 256 + F.wave * 2 + r;
            const f32x4* xr = (const f32x4*)(p.in[I_X] + (size_t)row * 1024) + lane_; const u32x2* ur = (const u32x2*)(upd + (size_t)row * 1024) + lane_;
#pragma unroll
            for (int j = 0; j < 4; ++j) { vn[r][j] = xr[64 * j]; un[r][j] = ur[64 * j]; } }
        for (int rr = F.wave * 2; rr < 256; rr += 16) {
            const int row0 = chunk * 256 + rr;
            f32x4 y[2][4];
#pragma unroll
            for (int r = 0; r < 2; ++r) {
                const int row = row0 + r; float ss = 0.f;
#pragma unroll
                for (int j = 0; j < 4; ++j) { vn[r][j].x += bf_lo(un[r][j].x); vn[r][j].y += bf_hi(un[r][j].x); vn[r][j].z += bf_lo(un[r][j].y); vn[r][j].w += bf_hi(un[r][j].y);
                    ss += (vn[r][j].x * vn[r][j].x + vn[r][j].y * vn[r][j].y) + (vn[r][j].z * vn[r][j].z + vn[r][j].w * vn[r][j].w); }
                const float rinv = __builtin_amdgcn_rsqf(wave_sum(ss) * (1.f / 1024.f) + RMS_EPS);
#pragma unroll
                for (int j = 0; j < 4; ++j) { const f32x4 gj = *(const LAS f32x4*)(gs + 256 * j + 4 * lane_), sj = *(const LAS f32x4*)(sh + 256 * j + 4 * lane_);
                    y[r][j] = vn[r][j] * rinv * gj + sj; h8[(size_t)row * 256 + 64 * j + lane_] = pk4_fp8(y[r][j].x, y[r][j].y, y[r][j].z, y[r][j].w); }
            }
            if (rr + 16 < 256) {
#pragma unroll
                for (int r = 0; r < 2; ++r) { const int row = row0 + 16 + r;
                    const f32x4* xr = (const f32x4*)(p.in[I_X] + (size_t)row * 1024) + lane_; const u32x2* ur = (const u32x2*)(upd + (size_t)row * 1024) + lane_;
#pragma unroll
                    for (int j = 0; j < 4; ++j) { vn[r][j] = xr[64 * j]; un[r][j] = ur[64 * j]; } }
            }
            const bool up32 = (lane_ & 32) != 0, up16 = (lane_ & 16) != 0, up8 = (lane_ & 8) != 0, up4 = (lane_ & 4) != 0;
            {
                f32x2 ga[2][4], gb[2][4];
#pragma unroll
                for (int r = 0; r < 2; ++r)
#pragma unroll
                    for (int c = 0; c < 4; ++c) { ga[r][c] = (f32x2){0.f, 0.f}; gb[r][c] = ga[r][c]; }
#pragma unroll
                for (int c = 0; c < 4; ++c)
#pragma unroll
                    for (int j = 0; j < 4; ++j) { const f32x4 w = *(const LAS f32x4*)(wt + c * WP + 4 * lane_ + 256 * j); const f32x2 wl = {w.x, w.y}, wh = {w.z, w.w};
#pragma unroll
                        for (int r = 0; r < 2; ++r) { ga[r][c] = __builtin_elementwise_fma((f32x2){y[r][j].x, y[r][j].y}, wl, ga[r][c]); gb[r][c] = __builtin_elementwise_fma((f32x2){y[r][j].z, y[r][j].w}, wh, gb[r][c]); } }
                float k4[4];
#pragma unroll
                for (int c = 0; c < 4; ++c) { const f32x2 t0 = ga[0][c] + gb[0][c], t1 = ga[1][c] + gb[1][c]; const float p0 = t0.x + t0.y, p1 = t1.x + t1.y;
                    k4[c] = up32 ? p0 : p1; ga[0][c].x = up32 ? p1 : p0; }
#pragma unroll
                for (int c = 0; c < 4; ++c) k4[c] = ga[0][c].x + __shfl_xor(k4[c], 32);
                float k2[2];
#pragma unroll
                for (int i = 0; i < 2; ++i) k2[i] = (up16 ? k4[2 + i] : k4[i]) + __shfl_xor(up16 ? k4[i] : k4[2 + i], 16);
                float k1 = (up8 ? k2[1] : k2[0]) + __shfl_xor(up8 ? k2[0] : k2[1], 8);
                k1 += __shfl_xor(k1, 4); k1 += __shfl_xor(k1, 2); k1 += __shfl_xor(k1, 1);
                if ((lane_ & 7) == 0) scr[(lane_ >> 5) * 36 + ((lane_ >> 4) & 1) * 2 + ((lane_ >> 3) & 1)] = k1;
            }
            LDS_WAIT();
            int gsel[2];
#pragma unroll
            for (int r = 0; r < 2; ++r) { int gi = 0; float gm = scr[r * 36] + bias[0];
#pragma unroll
                for (int c = 1; c < 4; ++c) { const float v = scr[r * 36 + c] + bias[c]; if (v > gm) { gm = v; gi = c; } }
                gsel[r] = __builtin_amdgcn_readfirstlane(gi); }
            {
                float pe[2][8];
#pragma unroll
                for (int r = 0; r < 2; ++r) {
                    const LAS float* wb = wt + (4 + gsel[r] * 8) * WP + 4 * lane_;
#pragma unroll
                    for (int hh = 0; hh < 2; ++hh) {
                        f32x2 ea[4], eb[4];
#pragma unroll
                        for (int i = 0; i < 4; ++i) { ea[i] = (f32x2){0.f, 0.f}; eb[i] = ea[i]; }
#pragma unroll
                        for (int i = 0; i < 4; ++i)
#pragma unroll
                            for (int j = 0; j < 4; ++j) { const f32x4 w = *(const LAS f32x4*)(wb + (hh * 4 + i) * WP + 256 * j);
                                ea[i] = __builtin_elementwise_fma((f32x2){y[r][j].x, y[r][j].y}, (f32x2){w.x, w.y}, ea[i]); eb[i] = __builtin_elementwise_fma((f32x2){y[r][j].z, y[r][j].w}, (f32x2){w.z, w.w}, eb[i]); }
#pragma unroll
                        for (int i = 0; i < 4; ++i) { const f32x2 t = ea[i] + eb[i]; pe[r][hh * 4 + i] = t.x + t.y; }
                        __builtin_amdgcn_sched_barrier(0);
                    }
                }
                float e8[8], e4[4], e2[2];
#pragma unroll
                for (int i = 0; i < 8; ++i) e8[i] = (up32 ? pe[1][i] : pe[0][i]) + __shfl_xor(up32 ? pe[0][i] : pe[1][i], 32);
#pragma unroll
                for (int i = 0; i < 4; ++i) e4[i] = (up16 ? e8[4 + i] : e8[i]) + __shfl_xor(up16 ? e8[i] : e8[4 + i], 16);
#pragma unroll
                for (int i = 0; i < 2; ++i) e2[i] = (up8 ? e4[2 + i] : e4[i]) + __shfl_xor(up8 ? e4[i] : e4[2 + i], 8);
                float e1 = (up4 ? e2[1] : e2[0]) + __shfl_xor(up4 ? e2[0] : e2[1], 4);
                e1 += __shfl_xor(e1, 2); e1 += __shfl_xor(e1, 1);
                if ((lane_ & 3) == 0) scr[(lane_ >> 5) * 36 + 4 + ((lane_ >> 4) & 1) * 4 + ((lane_ >> 3) & 1) * 2 + ((lane_ >> 2) & 1)] = e1;
            }
            LDS_WAIT();
            if (lane_ < 2) {
                const LAS float* L = scr + lane_ * 36; const int row = row0 + lane_;
                float lgp[4];
#pragma unroll
                for (int c = 0; c < 4; ++c) lgp[c] = L[c] + bias[c];
                int gsel = 0; float gm = lgp[0];
#pragma unroll
                for (int c = 1; c < 4; ++c) if (lgp[c] > gm) { gm = lgp[c]; gsel = c; }
                float zs = 0.f;
#pragma unroll
                for (int c = 0; c < 4; ++c) zs += fexp2((lgp[c] - gm) * LOG2E);
                const float pg = frcp(zs);
                float l1 = -INFINITY, l2 = -INFINITY; int e1 = 0, e2 = 0;
#pragma unroll
                for (int i = 0; i < 8; ++i) { const float v = L[4 + i] + bias[4 + gsel * 8 + i];
                    if (v > l1) { l2 = l1; e2 = e1; l1 = v; e1 = i; } else if (v > l2) { l2 = v; e2 = i; } }
                const float ex = fexp2((l2 - l1) * LOG2E), den = frcp(1.f + ex);
                int* te = (int*)(F.ws + WS_TOKE) + (size_t)row * 2; float* tw = (float*)(F.ws + WS_TOKW) + (size_t)row * 2;
                te[0] = gsel * 8 + e1; te[1] = gsel * 8 + e2; tw[0] = pg * den; tw[1] = pg * ex * den;
                lds_add(&hist[gsel * 8 + e1], 1); lds_add(&hist[gsel * 8 + e2], 1);
            }
            LDS_WAIT();
        }
        __syncthreads();
        if (ftid < 32) ((int*)(F.ws + WS_HIST))[chunk * 32 + ftid] = hist[ftid];
    }
}

DI void phase_slots(const Frame& F, const Params& p) {
    const int tid_ = fresh_tid(), lane_ = tid_ & 63;
    LAS int* tot = (LAS int*)(F.lds); LAS int* bas = tot + 32; LAS int* pst = tot + 64; LAS int* wcnt = tot + 128;
    const int* hist = (const int*)(F.ws + WS_HIST);
    for (int pm = F.bid; pm < T / 256; pm += F.G) {
        const int ftid = fresh_tid();
        __syncthreads();
        if (ftid < 64) tot[ftid] = 0;
        __syncthreads();
        { const int e = tid_ & 31, part = tid_ >> 5; int t = 0, bs = 0;
          for (int q = part; q < T / 256; q += 16) { const int v = hist[q * 32 + e]; t += v; if (q < pm) bs += v; }
          lds_add(&tot[e], t); lds_add(&bas[e], bs); }
        __syncthreads();
        if (tid_ == 0) { int run = 0; for (int e = 0; e < 32; ++e) { pst[e] = run; run += (tot[e] + 255) / 256 * 256; } pst[32] = run; }
        const int my_e = ((const int*)(F.ws + WS_TOKE))[(size_t)pm * 512 + tid_];
        int rank = 0;
        for (int e = 0; e < 32; ++e) { const unsigned long long mask = __ballot(my_e == e); if (my_e == e) rank = __popcll(mask & ((1ull << lane_) - 1ull)); if (lane_ == 0) wcnt[F.wave * 32 + e] = __popcll(mask); }
        __syncthreads();
        int woff = 0;
        for (int w = 0; w < F.wave; ++w) woff += wcnt[w * 32 + my_e];
        const int slot = pst[my_e] + bas[my_e] + woff + rank;
        ((int*)(F.ws + WS_SLOTTOK))[slot] = pm * 256 + (tid_ >> 1);
        ((float*)(F.ws + WS_SLOTW))[slot] = ((const float*)(F.ws + WS_TOKW))[(size_t)pm * 512 + tid_];
        ((int*)(F.ws + WS_TOKS))[(size_t)pm * 512 + tid_] = slot;
        if (pm < 32) { const int e = pm; for (int s = pst[e] + tot[e] + tid_; s < pst[e + 1]; s += 512) { ((int*)(F.ws + WS_SLOTTOK))[s] = 0; ((float*)(F.ws + WS_SLOTW))[s] = 0.f; } }
        if (pm == 0 && tid_ < 34) { int* et = (int*)(F.ws + WS_ETAB); if (tid_ < 33) et[64 + tid_] = pst[tid_] >> 8; if (tid_ < 32) { et[tid_] = tot[tid_]; et[32 + tid_] = pst[tid_]; } if (tid_ == 33) et[97] = pst[32] >> 8; }
    }
}

DI void phase_combine(const Frame& F, const Params& p) {
    const int tid_ = fresh_tid(), lane_ = tid_ & 63;
    const unsigned* y = (const unsigned*)(F.ws + WS_Y); const int* ts = (const int*)(F.ws + WS_TOKS); const float* tw = (const float*)(F.ws + WS_TOKW); const float* mod = (const float*)(F.ws + WS_MOD);
    const int gw = F.bid * 8 + F.wave, NGW = F.G * 8;
    for (int row = gw; row < T; row += NGW) {
        const int s0 = ts[(size_t)row * 2], s1 = ts[(size_t)row * 2 + 1]; const float w0 = tw[(size_t)row * 2] * 0.125f, w1 = tw[(size_t)row * 2 + 1] * 0.125f;
        const f32x4* xr = (const f32x4*)(p.in[I_X] + (size_t)row * 1024) + lane_; f32x4* orow = (f32x4*)(p.out + (size_t)row * 1024) + lane_;
        const u32x2* ur = (const u32x2*)((const bf16_t*)(F.ws + WS_UPD1) + (size_t)row * 1024) + lane_;
        const unsigned* y0 = y + (size_t)s0 * 256 + lane_; const unsigned* y1 = y + (size_t)s1 * 256 + lane_;
        const f32x4* g2 = (const f32x4*)(mod + (row >> 13) * 6144 + 5120) + lane_;
        f32x4 v[4], g[4]; unsigned a[4], c[4]; u32x2 uu[4];
#pragma unroll
        for (int j = 0; j < 4; ++j) { v[j] = xr[64 * j]; uu[j] = ur[64 * j]; a[j] = y0[64 * j]; c[j] = y1[64 * j]; g[j] = g2[64 * j]; }
#pragma unroll
        for (int j = 0; j < 4; ++j) { if (!DBG_X1_PLAIN) { v[j].x += bf_lo(uu[j].x); v[j].y += bf_hi(uu[j].x); v[j].z += bf_lo(uu[j].y); v[j].w += bf_hi(uu[j].y); }
            if (!DBG_SKIP_Y) { const f32x2 al = fp8_lo2(a[j]), ah = fp8_hi2(a[j]), cl = fp8_lo2(c[j]), ch = fp8_hi2(c[j]);
                v[j].x += g[j].x * (w0 * al.x + w1 * cl.x); v[j].y += g[j].y * (w0 * al.y + w1 * cl.y); v[j].z += g[j].z * (w0 * ah.x + w1 * ch.x); v[j].w += g[j].w * (w0 * ah.y + w1 * ch.y); } orow[64 * j] = v[j]; }
    }
}

__global__ void __launch_bounds__(512, 2) fwd(Params p) {
    extern __shared__ __attribute__((aligned(16))) unsigned char lds_raw[];
    Frame F;
    F.lds = (LAS unsigned char*)lds_raw; F.ws = p.ws;
    F.wave = __builtin_amdgcn_readfirstlane((int)threadIdx.x >> 6); F.G = gridDim.x; F.bid = blockIdx.x;
    volatile LAS unsigned* ctl = (volatile LAS unsigned*)(F.lds + LDS_CTLO);
    { const int ftid = fresh_tid(); if (ftid < 64) ctl[ftid] = 0u; }
    __syncthreads();
    XcdBarrier bar; bar.bar = (unsigned*)(p.ws + WS_CTL) + CW_BAR; bar.x = 0; bar.st = ctl;
    if (MK_N_LAUNCHES == 1) bar = xcd_barrier_post((unsigned*)(p.ws + WS_CTL) + CW_BAR, ctl);
    const int lo = p.ph_lo, hi = p.ph_hi;
    const __amdgpu_buffer_rsrc_t rsw = __builtin_amdgcn_make_buffer_rsrc(p.ws, 0, (int)WS_END, 0x00020000);
#define IN(k) (lo <= (k) && (k) < hi)
#define REP(k) for (int rep_ = 0; rep_ < ((PROBE_PH) == (k) ? 2 : 1); ++rep_)
#define SEAM(k) do { if (IN(k) && IN((k) + 1)) xcd_barrier(bar); } while (0)

    if (IN(0)) REP(0) { phase0(F, p); } SEAM(0);
    if (IN(1)) REP(1) { phase_norm<0>(F, p); } SEAM(1);
    if (IN(2)) REP(2) {
        REP(20) {
            pg8::DenseSched Sd; Sd.init(T, 2304, F.G, F.bid, WS_H8, 1024, WS_W1D8, 1024);
            EpiProj<false> E{(bf16_t*)(F.ws + WS_PROJ), (bf16_t*)(F.ws + WS_GATES), (const bf16_t*)(F.ws + WS_ROPE), p.in[I_QG], p.in[I_KG], 0};
            pg8::gemm_phase<EpiProj<false>, pg8::DenseSched, true>(F.lds, 1024, Sd, E, rsw);
        }
        REP(21) {
            pg8::DenseSched Sd; Sd.init(T, 768, F.G, F.bid, WS_H, 2048, WS_W1 + (size_t)2304 * 2048, 2048);
            EpiProj<false> E{(bf16_t*)(F.ws + WS_PROJ), (bf16_t*)(F.ws + WS_GATES), (const bf16_t*)(F.ws + WS_ROPE), p.in[I_QG], p.in[I_KG], 9};
            pg8::gemm_phase<EpiProj<false>, pg8::DenseSched, false>(F.lds, 1024, Sd, E, rsw);
        }
        REP(22) {
            pg8::DenseSched Sd; Sd.init(T, 2048, F.G, F.bid, WS_H8, 1024, WS_WG8, 1024);
            EpiProj<true> E{(bf16_t*)(F.ws + WS_PROJ), (bf16_t*)(F.ws + WS_GATES), (const bf16_t*)(F.ws + WS_ROPE), p.in[I_QG], p.in[I_KG], 0};
            pg8::gemm_phase<EpiProj<true>, pg8::DenseSched, true>(F.lds, 1024, Sd, E, rsw);
        }
    } SEAM(2);
    if (IN(3)) REP(3) { phase_attn(F, p); } SEAM(3);
    if (IN(4)) REP(4) {
        pg8::DiagSched Sd; Sd.init(T, 2048, F.G, F.bid, WS_OCAT, 512, WS_WB, 512);
        EpiBranch E{(const unsigned char*)(F.ws + WS_GATES), F.ws + WS_MERGED};
        pg8::gemm_phase<EpiBranch, pg8::DiagSched, true>(F.lds, 512, Sd, E, rsw);
    } SEAM(4);
    if (IN(5)) REP(5) {
        pg8::DenseSched Sd; Sd.init(T, 1024, F.G, F.bid, WS_MERGED, 1024, WS_WO, 1024);
        EpiOut E{(bf16_t*)(F.ws + WS_UPD1), (const float*)(F.ws + WS_MOD)};
        pg8::gemm_phase<EpiOut, pg8::DenseSched, true>(F.lds, 1024, Sd, E, rsw);
        if (rep_ + 1 == ((PROBE_PH) == 5 ? 2 : 1)) router_weights_to_lds(F, p);
    } SEAM(5);
    if (IN(6)) REP(6) { phase_norm2_route(F, p); }
    if (IN(6) && IN(8)) xcd_barrier(bar);
    if (IN(8)) REP(8) { phase_slots(F, p); } SEAM(8);
    if (IN(9) || IN(10)) {
        LAS int* cst = (LAS int*)(F.lds + LDS_CTLO) + 16;
        __syncthreads();
        { const int ftid = fresh_tid(); if (ftid < 34) cst[ftid] = ((const int*)(F.ws + WS_ETAB))[64 + ftid]; }
        __syncthreads();
    }
    if (IN(9)) REP(9) {
        const LAS int* cst = (const LAS int*)(F.lds + LDS_CTLO) + 16;
        MoeSchedUp Sm; Sm.G = F.G; Sm.c = (F.G == 256) ? ((F.bid & 7) * 32 + (F.bid >> 3)) : F.bid; Sm.nc = __builtin_amdgcn_readfirstlane(cst[33]); Sm.pa = 1024; Sm.pb = 1024; Sm.A = (unsigned)WS_H28; Sm.B = (unsigned)WS_WGU; Sm.cstart = cst;
        Sm.slot_tok = (const int*)(F.ws + WS_SLOTTOK); Sm.estride = 1024u * 1024u; Sm.pnstride = 256u * 1024u;
        EpiSwiglu E{F.ws + WS_HMID};
        pg8::gemm_phase<EpiSwiglu, MoeSchedUp, true>(F.lds, 1024, Sm, E, rsw);
    } SEAM(9);
    if (IN(10)) REP(10) {
        const LAS int* cst = (const LAS int*)(F.lds + LDS_CTLO) + 16;
        MoeSchedDn Sm; Sm.G = F.G; Sm.c = (F.G == 256) ? ((F.bid & 7) * 32 + (F.bid >> 3)) : F.bid; Sm.nc = __builtin_amdgcn_readfirstlane(cst[33]); Sm.pa = 512; Sm.pb = 512; Sm.A = (unsigned)WS_HMID; Sm.B = (unsigned)WS_WDN; Sm.cstart = cst;
        Sm.slot_tok = (const int*)(F.ws + WS_SLOTTOK); Sm.estride = 1024u * 512u; Sm.pnstride = 256u * 512u;
        EpiDown E{F.ws + WS_Y};
        pg8::gemm_phase<EpiDown, MoeSchedDn, true>(F.lds, 512, Sm, E, rsw);
    } SEAM(10);
    if (IN(11)) { phase_combine(F, p); }
#undef IN
#undef SEAM
}

extern "C" void kernel_launch(void* const* d_in, const int* in_sizes, int n_in, void* d_out, int out_size, void* d_ws, size_t ws_size, hipStream_t stream) {
    static int grid = 0;
    if (grid == 0) {
        if (n_in != 21 || in_sizes[0] != T * D || out_size != T * D || ws_size < WS_END) { fprintf(stderr, "kernel_launch: unexpected problem (n_in %d, ws %zu)\n", n_in, ws_size); grid = -1; return; }
        int dev = 0, cus = 0, per_cu = 0;
        if (hipGetDevice(&dev) != hipSuccess || hipDeviceGetAttribute(&cus, hipDeviceAttributeMultiprocessorCount, dev) != hipSuccess) { grid = -1; return; }
        if (hipFuncSetAttribute((const void*)fwd, hipFuncAttributeMaxDynamicSharedMemorySize, LDS_BYTES) != hipSuccess) { fprintf(stderr, "kernel_launch: hipFuncSetAttribute failed\n"); grid = -1; return; }
        if (hipOccupancyMaxActiveBlocksPerMultiprocessor(&per_cu, (const void*)fwd, 512, LDS_BYTES) != hipSuccess || per_cu < 1) { fprintf(stderr, "kernel_launch: occupancy query says %d\n", per_cu); (void)hipGetLastError(); grid = -1; return; }
        grid = cus;
    }
    if (grid < 0) return;
    (void)hipMemsetAsync((char*)d_ws + WS_CTL, 0, CTL_ZERO_BYTES, stream);
    Params p{};
    for (int i = 0; i < 21; ++i) p.in[i] = (const float*)d_in[i];
    p.out = (float*)d_out; p.ws = (unsigned char*)d_ws;
    if (MK_N_LAUNCHES == 1) { p.ph_lo = 0; p.ph_hi = NPH; hipLaunchKernelGGL(fwd, dim3(grid), dim3(512), LDS_BYTES, stream, p); }
    else { for (int k = 0; k < NPH; ++k) { p.ph_lo = k; p.ph_hi = k + 1; hipLaunchKernelGGL(fwd, dim3(grid), dim3(512), LDS_BYTES, stream, p); } }
}
```

```cpp
#include <hip/hip_runtime.h>
#include <cstdio>
#include <cstdint>

#ifndef MK_N_LAUNCHES
#define MK_N_LAUNCHES 1
#endif
#define DBG_X1_PLAIN 0
#define DBG_SKIP_Y 0
#ifndef PROBE_PH
#define PROBE_PH -1
#endif

#define LAS __attribute__((address_space(3)))
#define DI __device__ __forceinline__
typedef unsigned short bf16_t;
typedef short bf16x8 __attribute__((ext_vector_type(8)));
typedef short s16x4 __attribute__((ext_vector_type(4)));
typedef float f32x2 __attribute__((ext_vector_type(2)));
typedef float f32x4 __attribute__((ext_vector_type(4)));
typedef float f32x16 __attribute__((ext_vector_type(16)));
typedef unsigned u32x2 __attribute__((ext_vector_type(2)));
typedef unsigned u32x4 __attribute__((ext_vector_type(4)));
typedef __bf16 bf16x2n __attribute__((ext_vector_type(2)));
typedef int i32x8 __attribute__((ext_vector_type(8)));

constexpr int NB = 8, S = 8192, D = 1024, T = NB * S;
constexpr int LDP = 3072, LDG = 2048, LDO = 512;
constexpr int NE = 32, DE = 512;
constexpr int MAXSLOT = T * 2 + NE * 256;
constexpr int NPH = 12;
constexpr float LOG2E = 1.4426950408889634f;
constexpr float QSCALE = 0.125f * LOG2E;
constexpr float RMS_EPS = 1e-6f;

constexpr size_t MiB = 1u << 20;
constexpr size_t WS_CTL = 0, CTL_ZERO_BYTES = 64 * 1024;
constexpr int CW_BAR = 1024;
constexpr size_t WS_MODP = 1 * MiB;
constexpr size_t WS_MOD = 3 * MiB;
constexpr size_t WS_ROPE = 4 * MiB;
constexpr size_t WS_LOGIT = 144 * MiB;
constexpr size_t WS_TOKE = 24 * MiB;
constexpr size_t WS_TOKW = 24 * MiB + 512 * 1024;
constexpr size_t WS_TOKS = 25 * MiB;
constexpr size_t WS_SLOTTOK = 25 * MiB + 512 * 1024;
constexpr size_t WS_SLOTW = 26 * MiB + 256 * 1024;
constexpr size_t WS_HIST = 27 * MiB;
constexpr size_t WS_ETAB = 27 * MiB + 256 * 1024;
constexpr size_t WS_WR = 28 * MiB;
constexpr size_t WS_W1D8 = 28 * MiB + 512 * 1024;
constexpr size_t WS_W1 = 32 * MiB;
constexpr size_t WS_WG8 = 38 * MiB;
constexpr size_t WS_WB = 40 * MiB;
constexpr size_t WS_WO = 43 * MiB;
constexpr size_t WS_WGU = 48 * MiB;
constexpr size_t WS_WDN = 80 * MiB;
constexpr size_t WS_H = 144 * MiB;
constexpr size_t WS_OG = 144 * MiB;
constexpr size_t WS_LSE = 240 * MiB;
constexpr size_t WS_PROJ = 272 * MiB;
constexpr size_t WS_GATES = 656 * MiB;
constexpr size_t WS_OCAT = 912 * MiB;
constexpr size_t WS_H8 = 912 * MiB;
constexpr size_t WS_MERGED = 272 * MiB;
constexpr size_t WS_H2 = 400 * MiB;
constexpr size_t WS_H28 = 528 * MiB;
constexpr size_t WS_HMID = 592 * MiB;
constexpr size_t WS_Y = 664 * MiB;
constexpr size_t WS_UPD1 = 800 * MiB;
constexpr size_t WS_END = 976 * MiB;

constexpr int LDS_STAGE = 0, LDS_EPI = 131072, LDS_RW = 0, LDS_RV = 148480, LDS_RS = 148480 + 8192, LDS_CTLO = 148480 + 8192 + 3072, LDS_BYTES = LDS_CTLO + 256;

DI unsigned pk2(float lo, float hi) { f32x2 v = {lo, hi}; bf16x2n r = __builtin_convertvector(v, bf16x2n); return __builtin_bit_cast(unsigned, r); }
DI unsigned pk4_fp8(float a, float b, float c, float d) { int r = __builtin_amdgcn_cvt_pk_fp8_f32(a, b, 0, false); r = __builtin_amdgcn_cvt_pk_fp8_f32(c, d, r, true); return (unsigned)r; }
DI f32x2 fp8_lo2(unsigned u) { return __builtin_amdgcn_cvt_pk_f32_fp8((int)u, false); }
DI f32x2 fp8_hi2(unsigned u) { return __builtin_amdgcn_cvt_pk_f32_fp8((int)u, true); }
DI float bf_lo(unsigned u) { return __builtin_bit_cast(float, u << 16); }
DI float bf_hi(unsigned u) { return __builtin_bit_cast(float, u & 0xffff0000u); }
DI float wave_sum(float v) {
#pragma unroll
    for (int o = 1; o < 64; o <<= 1) v += __shfl_xor(v, o);
    return v;
}
DI float fexp2(float x) { return __builtin_amdgcn_exp2f(x); }
DI float flog2(float x) { return __builtin_amdgcn_logf(x); }
DI float frcp(float x) { return __builtin_amdgcn_rcpf(x); }
DI float sigmoidf(float v) { return frcp(1.0f + fexp2(-v * LOG2E)); }
DI void lds_add(LAS int* p, int v) { (void)__hip_atomic_fetch_add(p, v, __ATOMIC_RELAXED, __HIP_MEMORY_SCOPE_WORKGROUP); }
#define LDS_WAIT() asm volatile("s_waitcnt lgkmcnt(0)" ::: "memory")
#define VM_WAIT() asm volatile("s_waitcnt vmcnt(0)" ::: "memory")
DI int fresh_tid() { int t = threadIdx.x; asm volatile("" : "+v"(t)); return t; }

#define XB_TMO      128
#define XB_XCNT(j)  (256  + 64 * (j))
#define XB_XSUB(j)  (1280 + 64 * (j))
#define XB_XGEN(j)  (2304 + 64 * (j))
#define XB_TOP      3328
#define XB_TOPGEN   3392
#define XCD_BAR_WORDS 3456
#define XB_SPIN_CAP (1u << 18)

__device__ __forceinline__ unsigned xb_ld(unsigned* p)              { return __hip_atomic_load(p, __ATOMIC_RELAXED, __HIP_MEMORY_SCOPE_AGENT); }
__device__ __forceinline__ unsigned xb_add(unsigned* p, unsigned v) { return __hip_atomic_fetch_add(p, v, __ATOMIC_RELAXED, __HIP_MEMORY_SCOPE_AGENT); }
__device__ __forceinline__ unsigned xb_xcc_id() { return (unsigned)__builtin_amdgcn_s_getreg((3 << 11) | 20) & 0xFu; }
#define XB_SPIN(cond, bar) do { unsigned _sp = 0; while (cond) { __builtin_amdgcn_s_sleep(1); \
    if ((++_sp & 255u) == 0u) { if (xb_ld(&(bar)[XB_TMO])) break; if (_sp > XB_SPIN_CAP) { atomicAdd(&(bar)[XB_TMO], 1u); break; } } } } while (0)

struct XcdBarrier {
    unsigned* bar; unsigned x;
    volatile LAS unsigned* st;
};
__device__ __forceinline__ XcdBarrier xcd_barrier_post(unsigned* bar, volatile LAS unsigned* st) {
    XcdBarrier b; b.bar = bar; b.x = xb_xcc_id(); b.st = st;
    if (threadIdx.x == 0) (void)xb_add(&bar[XB_XCNT(b.x)], 1u);
    return b;
}
__device__ __forceinline__ void xcd_barrier_complete(unsigned* bar, unsigned x, unsigned& nloc, unsigned& nx) {
    const unsigned G = gridDim.x * gridDim.y * gridDim.z;
    unsigned sum, cnt, mine, sp = 0u;
    for (;;) {
        sum = 0u; cnt = 0u; mine = 0u;
#pragma unroll
        for (unsigned j = 0; j < 16; ++j) { const unsigned c = xb_ld(&bar[XB_XCNT(j)]); sum += c; cnt += (c > 0u) ? 1u : 0u; mine = (j == x) ? c : mine; }
        if (sum == G) break;
        __builtin_amdgcn_s_sleep(1);
        if ((++sp & 255u) == 0u) { if (xb_ld(&bar[XB_TMO])) break; if (sp > XB_SPIN_CAP) { atomicAdd(&bar[XB_TMO], 1u); break; } }
    }
    nloc = mine > 0u ? mine : 1u; nx = cnt > 0u ? cnt : 1u;
}
__device__ __forceinline__ void xcd_barrier(const XcdBarrier& b) {
    asm volatile("s_waitcnt vmcnt(0)" ::: "memory");
    __syncthreads();
    if (threadIdx.x == 0) {
        unsigned* bar = b.bar;
        __builtin_amdgcn_s_waitcnt(0);
        unsigned nloc = b.st[0], nx = b.st[1];
        if (nloc == 0u) { xcd_barrier_complete(bar, b.x, nloc, nx); b.st[0] = nloc; b.st[1] = nx; }
        const unsigned old = xb_add(&bar[XB_XSUB(b.x)], 1u);
        const unsigned gen = old / nloc;
        if (old + 1u == (gen + 1u) * nloc) {
            __builtin_amdgcn_fence(__ATOMIC_RELEASE, "agent");
            asm volatile("s_waitcnt vmcnt(0)" ::: "memory");
            const unsigned og = xb_add(&bar[XB_TOP], 1u);
            const unsigned tg = og / nx;
            if (og + 1u == (tg + 1u) * nx) xb_add(&bar[XB_TOPGEN], 1u);
            else XB_SPIN(xb_ld(&bar[XB_TOPGEN]) == tg, bar);
            __builtin_amdgcn_fence(__ATOMIC_ACQUIRE, "agent");
            xb_add(&bar[XB_XGEN(b.x)], 1u);
            asm volatile("s_waitcnt vmcnt(0)" ::: "memory");
        } else {
            XB_SPIN(xb_ld(&bar[XB_XGEN(b.x)]) == gen, bar);
            __builtin_amdgcn_fence(__ATOMIC_ACQUIRE, "agent");
            asm volatile("s_waitcnt vmcnt(0)" ::: "memory");
        }
    }
    __syncthreads();
}

namespace pg8 {
constexpr int BM = 256, BK = 64, HALF = 128, HTB = HALF * BK * 2, STAGE_BYTES = 8 * HTB, NXCD = 8, WGM = 8;
__host__ __device__ __forceinline__ int lds_byte(int r, int c) { const int st = (r >> 4) * 2 + (c >> 5), rr = r & 15, cc = c & 31, ob = rr * 64 + cc * 2; return st * 1024 + (ob ^ (((ob >> 9) & 1) << 5)); }
__host__ __device__ __forceinline__ void stage_rc(int b, int& R, int& C) { const int st = b / 1024, sb = b % 1024, swz = sb ^ (((sb >> 9) & 1) << 5); R = (st >> 1) * 16 + swz / 64; C = (st & 1) * 32 + (swz % 64) / 2; }
__host__ __device__ __forceinline__ int perm32(int rho) { const int n = rho >> 4, i = rho & 15; return 8 * (i >> 2) + 4 * n + (i & 3); }

struct Unit { int pm, pn, aux; unsigned a, b; };
typedef int i32x4 __attribute__((ext_vector_type(4)));
__device__ __forceinline__ i32x8 frag8(bf16x8 lo, bf16x8 hi) { return __builtin_shufflevector(__builtin_bit_cast(i32x4, lo), __builtin_bit_cast(i32x4, hi), 0, 1, 2, 3, 4, 5, 6, 7); }

template <class Epi, class Sched, bool FP8 = false>
__device__ __forceinline__ void gemm_phase(LAS unsigned char* lds, const int K, const Sched& S, const Epi& E, const __amdgpu_buffer_rsrc_t rs) {
    const int tid = fresh_tid(), wid = __builtin_amdgcn_readfirstlane(tid >> 6), lane = tid & 63, wr = wid >> 2, wc = wid & 3, fr = lane & 15, fq = lane >> 4;
    const int nt = FP8 ? K / 128 : K / BK;
    int RA[2], CA[2];
    unsigned voffA[4], voffB[2];
#pragma unroll
    for (int i = 0; i < 2; ++i) { int R, C; stage_rc(tid * 16 + i * 8192, R, C); RA[i] = R; CA[i] = C; const int Rb = Epi::PERM ? ((R & ~31) + perm32(R & 31)) : R;
        voffB[i] = (unsigned)(Rb * S.pb + C * 2); }
    const unsigned kstep = (unsigned)(BK * 2);
    const unsigned hstepB = (unsigned)(HALF * S.pb), hstepA = (unsigned)(HALF * S.pa);
    const unsigned ldsw = (unsigned)wid * 1024u;
    const int aoff = lds_byte(wr * 64 + fr, fq * 8), boff = lds_byte(wc * 32 + fr, fq * 8);
    constexpr int kpiece = 1024;
#define PG8_SA(b, h) (((b) * 2 + (h)) * HTB)
#define PG8_SB(b, h) ((4 + (b) * 2 + (h)) * HTB)
#define PG8_STAGE_B(bufoff, gbase) do { _Pragma("unroll") for (int _i = 0; _i < 2; ++_i) \
        __builtin_amdgcn_raw_ptr_buffer_load_lds(rs, (LAS unsigned*)(lds + (bufoff) + ldsw + _i * 8192), 16, (int)voffB[_i], (int)(gbase), 0, 0); } while (0)
#define PG8_STAGE_A(bufoff, gbase, h) do { _Pragma("unroll") for (int _i = 0; _i < 2; ++_i) \
        __builtin_amdgcn_raw_ptr_buffer_load_lds(rs, (LAS unsigned*)(lds + (bufoff) + ldsw + _i * 8192), 16, (int)voffA[Sched::GATHER ? (h) * 2 + _i : _i], (int)((gbase) + (Sched::GATHER ? 0u : (unsigned)(h) * hstepA)), 0, 0); } while (0)
#define PG8_LDA(dst, b, h) do { _Pragma("unroll") for (int m = 0; m < 4; ++m) _Pragma("unroll") for (int k = 0; k < 2; ++k) dst[m][k] = *(const LAS bf16x8*)(lds + PG8_SA(b, h) + aoff + m * 2048 + k * kpiece); } while (0)
#define PG8_LDB(dst, b, h) do { _Pragma("unroll") for (int n = 0; n < 2; ++n) _Pragma("unroll") for (int k = 0; k < 2; ++k) dst[n][k] = *(const LAS bf16x8*)(lds + PG8_SB(b, h) + boff + n * 2048 + k * kpiece); } while (0)
#define PG8_MMA(ai, bj, At, Bt) do { __builtin_amdgcn_s_setprio(1); if constexpr (FP8) { _Pragma("unroll") for (int m = 0; m < 4; ++m) _Pragma("unroll") for (int n = 0; n < 2; ++n) \
        acc[ai][bj][m][n] = __builtin_amdgcn_mfma_scale_f32_16x16x128_f8f6f4(frag8(Bt[n][0], Bt[n][1]), frag8(At[m][0], At[m][1]), acc[ai][bj][m][n], 0, 0, 0, 0x7C7C7C7C, 0, 0x7C7C7C7C); } \
      else { _Pragma("unroll") for (int m = 0; m < 4; ++m) _Pragma("unroll") for (int n = 0; n < 2; ++n) _Pragma("unroll") for (int k = 0; k < 2; ++k) \
        acc[ai][bj][m][n] = __builtin_amdgcn_mfma_f32_16x16x32_bf16(Bt[n][k], At[m][k], acc[ai][bj][m][n], 0, 0, 0); } __builtin_amdgcn_s_setprio(0); } while (0)
#define PG8_MMA2(ai, At) do { if constexpr (Sched::BLOCKDIAG) { if (lo_half) PG8_MMA(ai, 0, At, B0); else PG8_MMA(ai, 1, At, B1); } else { PG8_MMA(ai, 0, At, B0); PG8_MMA(ai, 1, At, B1); } } while (0)
#define PG8_WAIT_V(n) asm volatile("s_waitcnt vmcnt(" #n ")" ::: "memory")
#define PG8_WAIT_L(n) asm volatile("s_waitcnt lgkmcnt(" #n ")" ::: "memory")
#define PG8_BAR __builtin_amdgcn_s_barrier()
#define PG8_SCHED __builtin_amdgcn_sched_barrier(0)
    Unit cur, nxt; int ui = 0;
    if (!S.next(0, cur)) return;
    S.offs(cur, RA, CA, voffA);
    f32x4 acc[2][2][4][2];
#pragma unroll
    for (int a = 0; a < 2; ++a)
#pragma unroll
        for (int b = 0; b < 2; ++b)
#pragma unroll
            for (int m = 0; m < 4; ++m)
#pragma unroll
                for (int n = 0; n < 2; ++n) acc[a][b][m][n] = (f32x4){0.f, 0.f, 0.f, 0.f};
    bf16x8 At[4][2], B0[2][2], B1[2][2];
    unsigned cA = cur.a, cB = cur.b;
    PG8_STAGE_B(PG8_SB(0, 0), cB); PG8_STAGE_B(PG8_SB(0, 1), cB + hstepB); PG8_STAGE_A(PG8_SA(0, 0), cA, 0); PG8_STAGE_A(PG8_SA(0, 1), cA, 1);
    if (wr == 1) PG8_BAR;
    PG8_WAIT_V(2); PG8_BAR;
    PG8_STAGE_B(PG8_SB(1, 0), cB + kstep); PG8_STAGE_A(PG8_SA(1, 0), cA + kstep, 0); PG8_STAGE_B(PG8_SB(1, 1), cB + hstepB + kstep);
    PG8_WAIT_V(6); PG8_BAR;
    for (;;) {
        const bool has_next = S.next(ui + 1, nxt);
        const unsigned nA = has_next ? nxt.a : cA, nB = has_next ? nxt.b : cB;
        unsigned nvoff[4];
        if constexpr (Sched::GATHER) { if (has_next) S.rows(nxt, RA, nvoff); }
#pragma nounroll
        for (int t = 0; t < nt; t += 2) {
            const bool last = (t == nt - 2), lo_half = t < (nt >> 1);
            const unsigned a1 = cA + (unsigned)(t + 1) * kstep;
            const unsigned a2 = last ? nA : cA + (unsigned)(t + 2) * kstep, b2 = last ? nB : cB + (unsigned)(t + 2) * kstep;
            const unsigned a3 = a2 + kstep, b3 = b2 + kstep;
            PG8_LDB(B0, 0, 0); PG8_LDB(B1, 0, 1); PG8_SCHED; PG8_LDA(At, 0, 0); PG8_STAGE_A(PG8_SA(1, 1), a1, 1);
            PG8_WAIT_V(8); PG8_WAIT_L(0); PG8_BAR; PG8_MMA2(0, At); PG8_BAR; PG8_SCHED;
            if constexpr (Sched::GATHER) { if (last && has_next) {
#pragma unroll
                for (int q = 0; q < 4; ++q) voffA[q] = nvoff[q] * (unsigned)S.pa + (unsigned)(CA[q & 1] * 2); } }
            PG8_LDA(At, 0, 1); PG8_STAGE_B(PG8_SB(0, 0), b2); PG8_STAGE_B(PG8_SB(0, 1), b2 + hstepB); PG8_STAGE_A(PG8_SA(0, 0), a2, 0);
            PG8_WAIT_V(8); PG8_WAIT_L(0); PG8_BAR; PG8_MMA2(1, At); PG8_BAR; PG8_SCHED;
            PG8_LDB(B0, 1, 0); PG8_LDB(B1, 1, 1); PG8_SCHED; PG8_LDA(At, 1, 0); PG8_STAGE_A(PG8_SA(0, 1), a2, 1);
            PG8_WAIT_V(8); PG8_WAIT_L(0); PG8_BAR; PG8_MMA2(0, At); PG8_BAR; PG8_SCHED;
            PG8_LDA(At, 1, 1); PG8_STAGE_B(PG8_SB(1, 0), b3); PG8_STAGE_B(PG8_SB(1, 1), b3 + hstepB); PG8_STAGE_A(PG8_SA(1, 0), a3, 0);
            PG8_WAIT_V(8); PG8_WAIT_L(0); PG8_BAR; PG8_MMA2(1, At); PG8_BAR; PG8_SCHED;
        }
        if (wr == 0) PG8_BAR;
        { const int t2 = fresh_tid() & 63; E(acc, cur, wr, wc, t2 & 15, t2 >> 4, lds + LDS_EPI); }
        if (!has_next) break;
#pragma unroll
        for (int a = 0; a < 2; ++a)
#pragma unroll
            for (int b = 0; b < 2; ++b)
#pragma unroll
                for (int m = 0; m < 4; ++m)
#pragma unroll
                    for (int n = 0; n < 2; ++n) acc[a][b][m][n] = (f32x4){0.f, 0.f, 0.f, 0.f};
        cur = nxt; cA = nA; cB = nB; ++ui;
        if (wr == 1) PG8_BAR;
    }
    PG8_WAIT_V(0);
    PG8_BAR;
#undef PG8_SA
#undef PG8_SB
#undef PG8_STAGE_A
#undef PG8_STAGE_B
#undef PG8_LDA
#undef PG8_LDB
#undef PG8_MMA
#undef PG8_MMA2
#undef PG8_WAIT_V
#undef PG8_WAIT_L
#undef PG8_BAR
#undef PG8_SCHED
}

struct DenseSched {
    static constexpr bool GATHER = false, BLOCKDIAG = false;
    int nM, nN, nwg, G, c; int pa, pb; unsigned A, B;
    __device__ void init(int M, int N, int G_, int c_, size_t A_, int pa_, size_t B_, int pb_) { nM = M / BM; nN = N / BM; nwg = nM * nN; G = G_; c = c_; A = (unsigned)A_; B = (unsigned)B_; pa = pa_; pb = pb_; }
    __device__ __forceinline__ bool next(int i, Unit& u) const {
        const long L = (long)i * G + c; if (L >= nwg) return false;
        int wgid = (int)L; { const int q = nwg / NXCD, r = nwg % NXCD, xcd = wgid % NXCD, off = wgid / NXCD; wgid = (xcd < r ? xcd * (q + 1) : r * (q + 1) + (xcd - r) * q) + off; }
        const int nig = WGM * nN, gid = wgid / nig, fm = gid * WGM, gsz = (nM - fm) < WGM ? (nM - fm) : WGM;
        u.pm = fm + ((wgid % nig) % gsz); u.pn = (wgid % nig) / gsz; u.aux = 0;
        u.a = A + (unsigned)(u.pm * BM * pa); u.b = B + (unsigned)(u.pn * BM * pb); return true;
    }
    __device__ __forceinline__ void offs(const Unit&, const int (&RA)[2], const int (&CA)[2], unsigned (&v)[4]) const {
#pragma unroll
        for (int h = 0; h < 2; ++h)
#pragma unroll
            for (int i = 0; i < 2; ++i) v[h * 2 + i] = (unsigned)((h * HALF + RA[i]) * pa + CA[i] * 2);
    }
};
struct DiagSched : DenseSched { static constexpr bool BLOCKDIAG = true; };
}

struct Params { const float* in[21]; float* out; unsigned char* ws; int ph_lo, ph_hi; };
enum { I_X = 0, I_C, I_POS, I_WADA, I_BADA, I_GMIX, I_GFFN, I_WIN, I_WBG, I_QG, I_KG, I_WBD, I_WBS, I_WOUT, I_WRG, I_BRG, I_WRE, I_BRE, I_WEG, I_WEU, I_WED };

struct Frame {
    LAS unsigned char* lds;
    unsigned char* ws;
    int wave, G, bid;
};

template <bool FP8>
DI void p0_transpose_item(const float* W, int N, void* WTv, int ldt, int k0, int n0, int row_base, LAS float* scr, int lane) {
#pragma unroll 8
    for (int i = 0; i < 32; ++i) { const int kk = 2 * i + (lane >> 5); scr[kk * 33 + (lane & 31)] = W[(size_t)(k0 + kk) * N + n0 + (lane & 31)]; }
    LDS_WAIT();
    const int c = lane & 7;
#pragma unroll
    for (int j = 0; j < 4; ++j) { const int n = (lane >> 3) + 8 * j; const LAS float* sp = scr + (8 * c) * 33 + n;
        if (FP8) { u32x2 o; o.x = pk4_fp8(64.f * sp[0 * 33], 64.f * sp[1 * 33], 64.f * sp[2 * 33], 64.f * sp[3 * 33]); o.y = pk4_fp8(64.f * sp[4 * 33], 64.f * sp[5 * 33], 64.f * sp[6 * 33], 64.f * sp[7 * 33]);
            *(u32x2*)((unsigned char*)WTv + (size_t)(row_base + n) * ldt + k0 + 8 * c) = o; }
        else { u32x4 o; o.x = pk2(sp[0 * 33], sp[1 * 33]); o.y = pk2(sp[2 * 33], sp[3 * 33]); o.z = pk2(sp[4 * 33], sp[5 * 33]); o.w = pk2(sp[6 * 33], sp[7 * 33]);
            *(u32x4*)((bf16_t*)WTv + (size_t)(row_base + n) * ldt + k0 + 8 * c) = o; } }
    LDS_WAIT();
}
DI void phase0(const Frame& F, const Params& p) {
    const int tid_ = fresh_tid(), lane_ = tid_ & 63;
    LAS float* scr = (LAS float*)(F.lds + F.wave * 16384);
    const int gw = F.bid * 8 + F.wave, NGW = F.G * 8;
    bf16_t* W1 = (bf16_t*)(F.ws + WS_W1); bf16_t* WB = (bf16_t*)(F.ws + WS_WB); bf16_t* WO = (bf16_t*)(F.ws + WS_WO);
    unsigned char* WG8 = F.ws + WS_WG8; unsigned char* WGU = F.ws + WS_WGU; unsigned char* WDN = F.ws + WS_WDN;
    constexpr int I1 = 16 * 96, I2 = 16 * 64, I3 = 4 * 32, I4 = 4 * 32, I5 = 16 * 32, I6 = 32 * 256, I7 = 32 * 256, I8 = 32 * 256;
    constexpr int NITEMS = I1 + I2 + I3 + I4 + I5 + I6 + I7 + I8;
    for (int it = gw; it < NITEMS; it += NGW) {
        int r = it;
        if (r < I1) { const int kb = r / 96, nb = r % 96, n0 = 32 * nb, o0 = n0 & 255, rb = (n0 & ~255) + 128 * ((o0 >> 5) & 1) + 32 * (o0 >> 6);
            if (nb < 72) p0_transpose_item<true>(p.in[I_WIN], 3072, F.ws + WS_W1D8, 1024, 64 * kb, n0, rb, scr, lane_); else p0_transpose_item<false>(p.in[I_WIN], 3072, W1, 1024, 64 * kb, n0, rb, scr, lane_); continue; } r -= I1;
        if (r < I2) { const int kb = r / 64, nb = r % 64; p0_transpose_item<true>(p.in[I_WBG], 2048, WG8, 1024, 64 * kb, 32 * nb, 32 * nb, scr, lane_); continue; } r -= I2;
        if (r < I3) { const int kb = r / 32, nb = r % 32, n0 = 32 * nb; p0_transpose_item<true>(p.in[I_WBD], 1024, (unsigned char*)WB, 512, 64 * kb, n0, (n0 >> 7) * 256 + (n0 & 127), scr, lane_); continue; } r -= I3;
        if (r < I4) { const int kb = r / 32, nb = r % 32, n0 = 32 * nb; p0_transpose_item<true>(p.in[I_WBS], 1024, (unsigned char*)WB + 256, 512, 64 * kb, n0, (n0 >> 7) * 256 + 128 + (n0 & 127), scr, lane_); continue; } r -= I4;
        if (r < I5) { const int kb = r / 32, nb = r % 32; p0_transpose_item<true>(p.in[I_WOUT], 1024, WO, 1024, 64 * kb, 32 * nb, 32 * nb, scr, lane_); continue; } r -= I5;
        if (r < I6) { const int e = r >> 8, q = r & 255, kb = q >> 4, nb = q & 15, n0 = 32 * nb;
            p0_transpose_item<true>(p.in[I_WEG] + (size_t)e * 1024 * 512, 512, WGU + (size_t)e * 1024 * 1024, 1024, 64 * kb, n0, (n0 >> 7) * 256 + (n0 & 127), scr, lane_); continue; } r -= I6;
        if (r < I7) { const int e = r >> 8, q = r & 255, kb = q >> 4, nb = q & 15, n0 = 32 * nb;
            p0_transpose_item<true>(p.in[I_WEU] + (size_t)e * 1024 * 512, 512, WGU + (size_t)e * 1024 * 1024, 1024, 64 * kb, n0, (n0 >> 7) * 256 + 128 + (n0 & 127), scr, lane_); continue; } r -= I7;
        { const int e = r >> 8, q = r & 255, kb = q >> 5, nb = q & 31, n0 = 32 * nb, o0 = n0 & 255;
            p0_transpose_item<true>(p.in[I_WED] + (size_t)e * 512 * 1024, 1024, WDN + (size_t)e * 1024 * 512, 512, 64 * kb, n0, (n0 & ~255) + 128 * ((o0 >> 5) & 1) + 32 * (o0 >> 6), scr, lane_); }
    }
    {
        unsigned char* WBz = F.ws + WS_WB;
        for (int idx = F.bid * 512 + tid_; idx < 2048 * 16; idx += F.G * 512) { const int row = idx >> 4, c = idx & 15; *(u32x4*)(WBz + (size_t)row * 512 + ((row & 128) ? 0 : 256) + c * 16) = (u32x4){0u, 0u, 0u, 0u}; }
    }
    {
        float* modp = (float*)(F.ws + WS_MODP); const float* c = p.in[I_C]; const float* wada = p.in[I_WADA];
        for (int task = gw; task < 96 * 8; task += NGW) {
            const int ct = task % 96, ks = task / 96, k0 = ks * 128;
#pragma unroll
            for (int i = 0; i < 16; ++i) { const int idx = i * 64 + lane_, b = idx >> 7, k = idx & 127; const float v = c[b * 1024 + k0 + k]; scr[idx] = v * sigmoidf(v); }
            LDS_WAIT();
            float acc[8];
#pragma unroll
            for (int b = 0; b < 8; ++b) acc[b] = 0.f;
            const float* wp = wada + (size_t)k0 * 6144 + ct * 64 + lane_;
#pragma unroll 8
            for (int k = 0; k < 128; ++k) { const float w = wp[(size_t)k * 6144];
#pragma unroll
                for (int b = 0; b < 8; ++b) acc[b] += scr[b * 128 + k] * w; }
#pragma unroll
            for (int b = 0; b < 8; ++b) modp[((size_t)ks * 8 + b) * 6144 + ct * 64 + lane_] = acc[b];
            LDS_WAIT();
        }
    }
}

DI float inv_freq_of(int i) {
    return i == 0 ? 1.0f : i == 1 ? 0.1939227432012558f : i == 2 ? 0.03760603070259094f : i == 3 ? 0.007292664609849453f : i == 4 ? 0.0014142135623842478f : i == 5 ? 0.00027424818836152554f : i == 6 ? 5.318296098266728e-05f : 1.0313386155758053e-05f;
}
template <int WHICH>
DI void phase_norm(const Frame& F, const Params& p) {
    const int tid_ = fresh_tid(), lane_ = tid_ & 63;
    LAS float* gs = (LAS float*)(F.lds); LAS float* sh = gs + 1024;
    const float* modp = (const float*)(F.ws + WS_MODP); float* mod = (float*)(F.ws + WS_MOD); const float* bada = p.in[I_BADA];
    const float* xin = p.in[I_X]; const bf16_t* upd = (const bf16_t*)(F.ws + WS_UPD1); bf16_t* hout = (bf16_t*)(F.ws + (WHICH == 0 ? WS_H : WS_H2)); unsigned* h8 = (unsigned*)(F.ws + (WHICH == 0 ? WS_H8 : WS_H28));
    const float* gn = p.in[WHICH == 0 ? I_GMIX : I_GFFN];
    for (int chunk = F.bid; chunk < T / 256; chunk += F.G) {
        const int b = chunk >> 5;
        __syncthreads();
        if (WHICH == 0) {
            if (tid_ < 192) { const int j = (chunk & 31) * 192 + tid_; float s = bada[j];
#pragma unroll
                for (int ks = 0; ks < 8; ++ks) s += modp[((size_t)ks * 8 + b) * 6144 + j];
                mod[b * 6144 + j] = s; }
            for (int col = tid_; col < 1024; col += 512) { float s1 = bada[col], s2 = bada[1024 + col];
#pragma unroll
                for (int ks = 0; ks < 8; ++ks) { s1 += modp[((size_t)ks * 8 + b) * 6144 + col]; s2 += modp[((size_t)ks * 8 + b) * 6144 + 1024 + col]; }
                gs[col] = gn[col] * (1.f + s2); sh[col] = s1; }
        } else {
            for (int col = tid_; col < 1024; col += 512) { gs[col] = gn[col] * (1.f + mod[b * 6144 + 4096 + col]); sh[col] = mod[b * 6144 + 3072 + col]; }
        }
        __syncthreads();
        f32x4 g4[4], s4[4];
#pragma unroll
        for (int j = 0; j < 4; ++j) { g4[j] = *(const LAS f32x4*)(gs + 256 * j + 4 * lane_); s4[j] = *(const LAS f32x4*)(sh + 256 * j + 4 * lane_); }
        for (int rr = F.wave; rr < 256; rr += 8) {
            const int row = chunk * 256 + rr;
            const f32x4* xr = (const f32x4*)(xin + (size_t)row * 1024) + lane_;
            f32x4 v[4]; float ss = 0.f;
#pragma unroll
            for (int j = 0; j < 4; ++j) v[j] = xr[64 * j];
            if (WHICH == 1) { const u32x2* ur = (const u32x2*)(upd + (size_t)row * 1024) + lane_; u32x2 uu[4];
#pragma unroll
                for (int j = 0; j < 4; ++j) uu[j] = ur[64 * j];
#pragma unroll
                for (int j = 0; j < 4; ++j) { v[j].x += bf_lo(uu[j].x); v[j].y += bf_hi(uu[j].x); v[j].z += bf_lo(uu[j].y); v[j].w += bf_hi(uu[j].y); } }
#pragma unroll
            for (int j = 0; j < 4; ++j) ss += (v[j].x * v[j].x + v[j].y * v[j].y) + (v[j].z * v[j].z + v[j].w * v[j].w);
            const float rinv = __builtin_amdgcn_rsqf(wave_sum(ss) * (1.f / 1024.f) + RMS_EPS);
            u32x2* o8 = (u32x2*)(hout + (size_t)row * 1024) + lane_;
#pragma unroll
            for (int j = 0; j < 4; ++j) { const f32x4 y = v[j] * rinv * g4[j] + s4[j]; u32x2 o; o.x = pk2(y.x, y.y); o.y = pk2(y.z, y.w); o8[64 * j] = o; h8[(size_t)row * 256 + 64 * j + lane_] = pk4_fp8(y.x, y.y, y.z, y.w); }
            if (WHICH == 0 && lane_ < 8) {
                const int pos = ((const int*)p.in[I_POS])[row];
                const float angf = (float)pos * inv_freq_of(lane_);
                double rv = (double)angf * 0.15915494309189535; rv -= __builtin_rint(rv);
                const float fr = (float)rv;
                bf16_t* rp = (bf16_t*)(F.ws + WS_ROPE) + (size_t)row * 16;
                rp[lane_] = (bf16_t)(pk2(__builtin_amdgcn_cosf(fr), 0.f) & 0xffffu); rp[8 + lane_] = (bf16_t)(pk2(__builtin_amdgcn_sinf(fr), 0.f) & 0xffffu);
            }
        }
    }
}

template <bool GATES> struct EpiProj {
    static constexpr bool PERM = true;
    bf16_t* proj; bf16_t* gates; const bf16_t* rope; const float* qg; const float* kg; int pn0;
    DI void operator()(const f32x4 (&acc)[2][2][4][2], const pg8::Unit& u, int wr, int wc, int fr, int fq, LAS unsigned char* scr) const {
        asm volatile("" : "+v"(fr), "+v"(fq));
        const int pn = u.pn + pn0, row0 = u.pm * 256 + wr * 64 + fr, cw = wc * 32 + 8 * fq;
        const int typ = pn < 9 ? pn / 3 : pn - 9, grp = pn < 9 ? pn % 3 : 0, l2d = pn < 9 ? 2 * grp : 0, hbase = pn < 9 ? grp * 4 : 12;
        if (GATES) {
            unsigned char* base = (unsigned char*)gates + (size_t)(u.pm * 8 + pn) * 65536 + (size_t)(((wr * 4 + wc) * 64 + fq * 16 + fr) * 8);
#pragma unroll
            for (int ai = 0; ai < 2; ++ai)
#pragma unroll
                for (int m = 0; m < 4; ++m)
#pragma unroll
                    for (int bj = 0; bj < 2; ++bj) { const f32x4 v0 = acc[ai][bj][m][0], v1 = acc[ai][bj][m][1];
                        u32x2 w; w.x = pk4_fp8(v0.x, v0.y, v0.z, v0.w); w.y = pk4_fp8(v1.x, v1.y, v1.z, v1.w);
                        *(u32x2*)(base + ((ai * 4 + m) * 2 + bj) * 4096) = w; }
        } else if (pn >= 6 || pn < 3) {
            const float sc = pn == 9 ? QSCALE : 1.f;
            const int head = hbase + wc;
#pragma unroll
            for (int ai = 0; ai < 2; ++ai)
#pragma unroll
                for (int m = 0; m < 4; ++m) { const int t = row0 + ai * 128 + m * 16, sq = t & (S - 1); const int rp = (t & ~(S - 1)) + ((sq & ((1 << l2d) - 1)) << (13 - l2d)) + (sq >> l2d);
                    bf16_t* rowp = proj + ((size_t)(typ * 16 + head) * T + rp) * 64 + 8 * fq;
#pragma unroll
                    for (int bj = 0; bj < 2; ++bj) { const f32x4 v0 = acc[ai][bj][m][0] * sc, v1 = acc[ai][bj][m][1] * sc;
                        u32x4 w; w.x = pk2(v0.x, v0.y); w.y = pk2(v0.z, v0.w); w.z = pk2(v1.x, v1.y); w.w = pk2(v1.z, v1.w);
                        *(u32x4*)(rowp + 32 * bj) = w; } }
        } else {
            const int head = hbase + wc;
            const f32x4 g0 = *(const f32x4*)(kg + 8 * fq), g1 = *(const f32x4*)(kg + 8 * fq + 4), g2 = *(const f32x4*)(kg + 32 + 8 * fq), g3 = *(const f32x4*)(kg + 32 + 8 * fq + 4);
#pragma unroll
            for (int ai = 0; ai < 2; ++ai) {
                u32x4 rcs[4][2];
#pragma unroll
                for (int m = 0; m < 4; ++m) { const u32x4* rpt = (const u32x4*)(rope + (size_t)(u.pm * 256 + ai * 128 + wr * 64 + m * 16 + fr) * 16); rcs[m][0] = rpt[0]; rcs[m][1] = rpt[1]; }
                __builtin_amdgcn_sched_barrier(0);
#pragma unroll
                for (int m = 0; m < 4; ++m) { const int row = u.pm * 256 + ai * 128 + wr * 64 + m * 16 + fr, sq = row & (S - 1);
                    const int rp = (row & ~(S - 1)) + ((sq & ((1 << l2d) - 1)) << (13 - l2d)) + (sq >> l2d);
                    const f32x4 a0 = acc[ai][0][m][0], a1 = acc[ai][0][m][1], b0 = acc[ai][1][m][0], b1 = acc[ai][1][m][1];
                    float ss = ((a0.x * a0.x + a0.y * a0.y) + (a0.z * a0.z + a0.w * a0.w)) + ((a1.x * a1.x + a1.y * a1.y) + (a1.z * a1.z + a1.w * a1.w))
                             + ((b0.x * b0.x + b0.y * b0.y) + (b0.z * b0.z + b0.w * b0.w)) + ((b1.x * b1.x + b1.y * b1.y) + (b1.z * b1.z + b1.w * b1.w));
                    ss += __shfl_xor(ss, 16); ss += __shfl_xor(ss, 32);
                    const float rinv = __builtin_amdgcn_rsqf(ss * (1.f / 64.f) + RMS_EPS);
                    f32x4 v0 = a0 * (g0 * rinv), v1 = a1 * (g1 * rinv); const f32x4 v2 = b0 * (g2 * rinv), v3 = b1 * (g3 * rinv);
                    f32x4 c0 = {1.f, 1.f, 1.f, 1.f}, c1 = c0, s0 = {0.f, 0.f, 0.f, 0.f}, s1 = s0;
                    if (fq < 2) { const u32x4 cc = rcs[m][0], sn = rcs[m][1];
                        c0 = (f32x4){bf_lo(cc.x), bf_hi(cc.x), bf_lo(cc.y), bf_hi(cc.y)}; c1 = (f32x4){bf_lo(cc.z), bf_hi(cc.z), bf_lo(cc.w), bf_hi(cc.w)};
                        s0 = (f32x4){bf_lo(sn.x), bf_hi(sn.x), bf_lo(sn.y), bf_hi(sn.y)}; s1 = (f32x4){bf_lo(sn.z), bf_hi(sn.z), bf_lo(sn.w), bf_hi(sn.w)};
                        if (fq == 0) { s0 = -s0; s1 = -s1; } }
                    f32x4 p0, p1;
                    p0.x = __shfl_xor(v0.x, 16); p0.y = __shfl_xor(v0.y, 16); p0.z = __shfl_xor(v0.z, 16); p0.w = __shfl_xor(v0.w, 16);
                    p1.x = __shfl_xor(v1.x, 16); p1.y = __shfl_xor(v1.y, 16); p1.z = __shfl_xor(v1.z, 16); p1.w = __shfl_xor(v1.w, 16);
                    v0 = v0 * c0 + p0 * s0; v1 = v1 * c1 + p1 * s1;
                    bf16_t* rowp = proj + ((size_t)(typ * 16 + head) * T + rp) * 64 + 8 * fq;
                    u32x4 w; w.x = pk2(v0.x, v0.y); w.y = pk2(v0.z, v0.w); w.z = pk2(v1.x, v1.y); w.w = pk2(v1.z, v1.w);
                    *(u32x4*)rowp = w;
                    w.x = pk2(v2.x, v2.y); w.y = pk2(v2.z, v2.w); w.z = pk2(v3.x, v3.y); w.w = pk2(v3.z, v3.w);
                    *(u32x4*)(rowp + 32) = w; }
            }
        }
    }
};

struct EpiBranch {
    static constexpr bool PERM = true;
    const unsigned char* gates; unsigned char* merged;
    DI void operator()(const f32x4 (&acc)[2][2][4][2], const pg8::Unit& u, int wr, int wc, int fr, int fq, LAS unsigned char*) const {
        asm volatile("" : "+v"(fr), "+v"(fq));
        const int row0 = u.pm * 256 + wr * 64 + fr, col0 = u.pn * 128 + wc * 32 + 8 * fq;
        const unsigned char* gbase = gates + (size_t)(u.pm * 8 + (u.pn >> 1)) * 65536 + (size_t)((u.pn & 1) * 4096) + (size_t)(((wr * 4 + wc) * 64 + fq * 16 + fr) * 8);
        u32x2 gd[2][4], gs[2][4];
#pragma unroll
        for (int ai = 0; ai < 2; ++ai)
#pragma unroll
            for (int m = 0; m < 4; ++m) { const unsigned char* gp = gbase + ((ai * 4 + m) * 2) * 4096;
                gd[ai][m] = *(const u32x2*)gp; gs[ai][m] = *(const u32x2*)(gp + 4 * 65536); }
        __builtin_amdgcn_sched_barrier(0);
#pragma unroll
        for (int ai = 0; ai < 2; ++ai)
#pragma unroll
            for (int m = 0; m < 4; ++m) { const size_t row = (size_t)(row0 + ai * 128 + m * 16);
                const u32x2 g = gd[ai][m], q = gs[ai][m];
                const f32x2 ga = fp8_lo2(g.x), gb = fp8_hi2(g.x), gc = fp8_lo2(g.y), gdd = fp8_hi2(g.y), qa = fp8_lo2(q.x), qb = fp8_hi2(q.x), qc = fp8_lo2(q.y), qd = fp8_hi2(q.y);
                const f32x4 v0 = acc[ai][0][m][0] * (f32x4){sigmoidf(ga.x), sigmoidf(ga.y), sigmoidf(gb.x), sigmoidf(gb.y)} + acc[ai][1][m][0] * (f32x4){sigmoidf(qa.x), sigmoidf(qa.y), sigmoidf(qb.x), sigmoidf(qb.y)};
                const f32x4 v1 = acc[ai][0][m][1] * (f32x4){sigmoidf(gc.x), sigmoidf(gc.y), sigmoidf(gdd.x), sigmoidf(gdd.y)} + acc[ai][1][m][1] * (f32x4){sigmoidf(qc.x), sigmoidf(qc.y), sigmoidf(qd.x), sigmoidf(qd.y)};
                u32x2 w; w.x = pk4_fp8(8.f * v0.x, 8.f * v0.y, 8.f * v0.z, 8.f * v0.w); w.y = pk4_fp8(8.f * v1.x, 8.f * v1.y, 8.f * v1.z, 8.f * v1.w);
                *(u32x2*)(merged + row * 1024 + col0) = w; }
    }
};
struct BranchSched {
    static constexpr bool GATHER = false;
    int G, c; int pa, pb; unsigned A, B;
    DI bool next(int i, pg8::Unit& u) const {
        const int tile = (i >> 1) * G + c; if (tile >= 256 * 4) return false;
        u.pm = tile >> 2; u.pn = tile & 3; u.aux = i & 1;
        u.a = A + (unsigned)(u.pm * 256 * LDO * 2 + u.aux * 256 * 2); u.b = B + (unsigned)(u.aux * 1024 * 256 * 2 + u.pn * 256 * 256 * 2); return true;
    }
    DI void offs(const pg8::Unit&, const int (&RA)[2], const int (&CA)[2], unsigned (&v)[4]) const {
#pragma unroll
        for (int h = 0; h < 2; ++h)
#pragma unroll
            for (int i = 0; i < 2; ++i) v[h * 2 + i] = (unsigned)((h * 128 + RA[i]) * pa + CA[i] * 2);
    }
};

struct EpiOut {
    static constexpr bool PERM = true;
    bf16_t* upd; const float* mod;
    DI void operator()(const f32x4 (&acc)[2][2][4][2], const pg8::Unit& u, int wr, int wc, int fr, int fq, LAS unsigned char*) const {
        asm volatile("" : "+v"(fr), "+v"(fq));
        const int row0 = u.pm * 256 + wr * 64 + fr, col0 = u.pn * 256 + wc * 32 + 8 * fq; const int b = (u.pm * 256) >> 13;
        f32x4 gv[2][2];
#pragma unroll
        for (int bj = 0; bj < 2; ++bj)
#pragma unroll
            for (int n = 0; n < 2; ++n) gv[bj][n] = *(const f32x4*)(mod + b * 6144 + 2048 + col0 + bj * 128 + n * 4) * 0.125f;
#pragma unroll
        for (int ai = 0; ai < 2; ++ai)
#pragma unroll
            for (int m = 0; m < 4; ++m)
#pragma unroll
                for (int bj = 0; bj < 2; ++bj) { const f32x4 v0 = acc[ai][bj][m][0] * gv[bj][0], v1 = acc[ai][bj][m][1] * gv[bj][1];
                    u32x4 w; w.x = pk2(v0.x, v0.y); w.y = pk2(v0.z, v0.w); w.z = pk2(v1.x, v1.y); w.w = pk2(v1.z, v1.w);
                    *(u32x4*)(upd + (size_t)(row0 + ai * 128 + m * 16) * 1024 + col0 + bj * 128) = w; }
    }
};

struct EpiLogit {
    static constexpr bool PERM = false;
    float* logit;
    DI void operator()(const f32x4 (&acc)[2][2][4][2], const pg8::Unit& u, int wr, int wc, int fr, int fq, LAS unsigned char*) const {
        asm volatile("" : "+v"(fr), "+v"(fq));
        const int row0 = u.pm * 256 + wr * 64 + fr, col0 = wc * 32 + 4 * fq;
#pragma unroll
        for (int ai = 0; ai < 2; ++ai)
#pragma unroll
            for (int m = 0; m < 4; ++m)
#pragma unroll
                for (int n = 0; n < 2; ++n) *(f32x4*)(logit + (size_t)(row0 + ai * 128 + m * 16) * 128 + col0 + n * 16) = acc[ai][0][m][n];
    }
};

struct MoeSched {
    static constexpr bool GATHER_ = true;
    int G, c, nc; int pa, pb; unsigned A, B; const LAS int* cstart; const int* slot_tok; unsigned estride, pnstride;
};
struct MoeSchedUp : MoeSched {
    static constexpr bool GATHER = true, BLOCKDIAG = false;
    DI bool next(int i, pg8::Unit& u) const {
        const int L = i * G + c; if (L >= nc * 4) return false;
        const int chunk = L >> 2; int e = 0;
        for (int q = 1; q < 32; ++q) e += (chunk >= cstart[q]) ? 1 : 0;
        e = __builtin_amdgcn_readfirstlane(e);
        u.pm = chunk; u.pn = L & 3; u.aux = e; u.a = A; u.b = B + (unsigned)e * estride + (unsigned)u.pn * pnstride; return true;
    }
    DI void offs(const pg8::Unit& u, const int (&RA)[2], const int (&CA)[2], unsigned (&v)[4]) const {
#pragma unroll
        for (int h = 0; h < 2; ++h)
#pragma unroll
            for (int i = 0; i < 2; ++i) { const int tok = slot_tok[u.pm * 256 + h * 128 + RA[i]]; v[h * 2 + i] = (unsigned)(tok * pa + CA[i] * 2); }
    }
    DI void rows(const pg8::Unit& u, const int (&RA)[2], unsigned (&v)[4]) const {
#pragma unroll
        for (int h = 0; h < 2; ++h)
#pragma unroll
            for (int i = 0; i < 2; ++i) v[h * 2 + i] = (unsigned)slot_tok[u.pm * 256 + h * 128 + RA[i]];
    }
};
struct MoeSchedDn : MoeSched {
    static constexpr bool GATHER = false, BLOCKDIAG = false;
    DI bool next(int i, pg8::Unit& u) const {
        const int L = i * G + c; if (L >= nc * 4) return false;
        const int chunk = L >> 2; int e = 0;
        for (int q = 1; q < 32; ++q) e += (chunk >= cstart[q]) ? 1 : 0;
        e = __builtin_amdgcn_readfirstlane(e);
        u.pm = chunk; u.pn = L & 3; u.aux = e; u.a = A + (unsigned)(chunk * 256 * pa); u.b = B + (unsigned)e * estride + (unsigned)u.pn * pnstride; return true;
    }
    DI void offs(const pg8::Unit&, const int (&RA)[2], const int (&CA)[2], unsigned (&v)[4]) const {
#pragma unroll
        for (int h = 0; h < 2; ++h)
#pragma unroll
            for (int i = 0; i < 2; ++i) v[h * 2 + i] = (unsigned)((h * 128 + RA[i]) * pa + CA[i] * 2);
    }
};
struct EpiSwiglu {
    static constexpr bool PERM = true;
    unsigned char* hmid;
    DI void operator()(const f32x4 (&acc)[2][2][4][2], const pg8::Unit& u, int wr, int wc, int fr, int fq, LAS unsigned char*) const {
        asm volatile("" : "+v"(fr), "+v"(fq));
        const int row0 = u.pm * 256 + wr * 64 + fr, col0 = u.pn * 128 + wc * 32 + 8 * fq;
#pragma unroll
        for (int ai = 0; ai < 2; ++ai)
#pragma unroll
            for (int m = 0; m < 4; ++m) {
                f32x4 h[2];
#pragma unroll
                for (int n = 0; n < 2; ++n) { const f32x4 g = acc[ai][0][m][n], up = acc[ai][1][m][n];
                    h[n] = (f32x4){g.x * sigmoidf(g.x) * up.x, g.y * sigmoidf(g.y) * up.y, g.z * sigmoidf(g.z) * up.z, g.w * sigmoidf(g.w) * up.w}; }
                u32x2 w; w.x = pk4_fp8(h[0].x, h[0].y, h[0].z, h[0].w); w.y = pk4_fp8(h[1].x, h[1].y, h[1].z, h[1].w);
                *(u32x2*)(hmid + (size_t)(row0 + ai * 128 + m * 16) * DE + col0) = w; }
    }
};
struct EpiDown {
    static constexpr bool PERM = true;
    unsigned char* y;
    DI void operator()(const f32x4 (&acc)[2][2][4][2], const pg8::Unit& u, int wr, int wc, int fr, int fq, LAS unsigned char*) const {
        asm volatile("" : "+v"(fr), "+v"(fq));
        const int row0 = u.pm * 256 + wr * 64 + fr, col0 = u.pn * 256 + wc * 64 + (fq & 1) * 32 + (fq >> 1) * 16;
#pragma unroll
        for (int ai = 0; ai < 2; ++ai)
#pragma unroll
            for (int m = 0; m < 4; ++m) { const int slot = row0 + ai * 128 + m * 16;
                u32x2 o[2];
#pragma unroll
                for (int bj = 0; bj < 2; ++bj) { const f32x4 v0 = acc[ai][bj][m][0] * 8.f, v1 = acc[ai][bj][m][1] * 8.f; o[bj].x = pk4_fp8(v0.x, v0.y, v0.z, v0.w); o[bj].y = pk4_fp8(v1.x, v1.y, v1.z, v1.w); }
                u32x4 w;
                { auto r = __builtin_amdgcn_permlane16_swap(o[0].x, o[1].x, false, false); w.x = r[0]; w.z = r[1]; }
                { auto r = __builtin_amdgcn_permlane16_swap(o[0].y, o[1].y, false, false); w.y = r[0]; w.w = r[1]; }
                *(u32x4*)(y + (size_t)slot * 1024 + col0) = w; }
    }
};

constexpr int SLOT_BYTES = 8192;
DI f32x16 mfma32(bf16x8 a, bf16x8 b, f32x16 c) { return __builtin_amdgcn_mfma_f32_32x32x16_bf16(a, b, c, 0, 0, 0); }
DI int swz_f(int r) { return (((r >> 1) & 1) << 2) | ((r >> 2) & 3); }
struct AttnLane { unsigned doff[4]; unsigned ka[4]; unsigned va[2][2]; };
DI void attn_lane_init(AttnLane& L, int lane) {
#pragma unroll
    for (int i = 0; i < 4; ++i) { const int r = 8 * i + (lane >> 3), c = (lane & 7) ^ swz_f(r); L.doff[i] = (unsigned)(r * 128 + c * 16); }
    { const int r = lane & 31, h = lane >> 5; const unsigned a0 = (unsigned)(r * 128 + 16 * ((h ^ swz_f(r)) & 7));
#pragma unroll
      for (int s = 0; s < 4; ++s) L.ka[s] = a0 ^ (unsigned)(32 * s); }
    { const int h = lane >> 5, blk = (lane >> 4) & 1, q = (lane & 15) >> 2, p = lane & 3, fb2 = (q >> 1) & 1;
#pragma unroll
      for (int t = 0; t < 2; ++t) { const int flow = (2 * t + h) & 3;
#pragma unroll
        for (int mt = 0; mt < 2; ++mt) L.va[t][mt] = (unsigned)(4096 + (8 * t + 4 * h + q) * 128 + 16 * (4 * (mt ^ fb2) + ((2 * blk + (p >> 1)) ^ flow)) + 8 * (p & 1)); } }
}
DI void dma_tile(const AttnLane& L, const __amdgpu_buffer_rsrc_t rs, unsigned koff, unsigned voff, LAS unsigned char* slot) {
#pragma unroll
    for (int i = 0; i < 4; ++i) __builtin_amdgcn_raw_ptr_buffer_load_lds(rs, (LAS unsigned*)(slot + 1024 * i), 16, (int)L.doff[i], (int)koff, 0, 0);
#pragma unroll
    for (int i = 0; i < 4; ++i) __builtin_amdgcn_raw_ptr_buffer_load_lds(rs, (LAS unsigned*)(slot + 4096 + 1024 * i), 16, (int)L.doff[i], (int)voff, 0, 0);
}
DI void tr_read8(const AttnLane& L, unsigned sb, bf16x8 (&vf)[2][2]) {
    s16x4 r0, r1, r2, r3, r4, r5, r6, r7;
    const unsigned a00 = sb + L.va[0][0], a10 = sb + L.va[1][0], a01 = sb + L.va[0][1], a11 = sb + L.va[1][1];
    asm volatile("ds_read_b64_tr_b16 %0, %8\n\tds_read_b64_tr_b16 %1, %9\n\tds_read_b64_tr_b16 %2, %8 offset:2048\n\tds_read_b64_tr_b16 %3, %9 offset:2048\n\t"
                 "ds_read_b64_tr_b16 %4, %10\n\tds_read_b64_tr_b16 %5, %11\n\tds_read_b64_tr_b16 %6, %10 offset:2048\n\tds_read_b64_tr_b16 %7, %11 offset:2048\n\ts_waitcnt lgkmcnt(0)"
                 : "=&v"(r0), "=&v"(r1), "=&v"(r2), "=&v"(r3), "=&v"(r4), "=&v"(r5), "=&v"(r6), "=&v"(r7)
                 : "v"(a00), "v"(a10), "v"(a01), "v"(a11) : "memory");
    vf[0][0] = __builtin_shufflevector(r0, r1, 0, 1, 2, 3, 4, 5, 6, 7); vf[0][1] = __builtin_shufflevector(r2, r3, 0, 1, 2, 3, 4, 5, 6, 7);
    vf[1][0] = __builtin_shufflevector(r4, r5, 0, 1, 2, 3, 4, 5, 6, 7); vf[1][1] = __builtin_shufflevector(r6, r7, 0, 1, 2, 3, 4, 5, 6, 7);
}
DI bf16x8 pack8(const f32x16& x, int s) {
    u32x4 p; p.x = pk2(x[8 * s], x[8 * s + 1]); p.y = pk2(x[8 * s + 2], x[8 * s + 3]); p.z = pk2(x[8 * s + 4], x[8 * s + 5]); p.w = pk2(x[8 * s + 6], x[8 * s + 7]);
    return __builtin_bit_cast(bf16x8, p);
}
DI void store_o_row(bf16_t* rowp, const f32x16& O0, const f32x16& O1, float sc, int h) {
#pragma unroll
    for (int mt = 0; mt < 2; ++mt)
#pragma unroll
        for (int kp = 0; kp < 2; ++kp) { const f32x16& O = mt ? O1 : O0; const int g0 = 8 * kp, g1 = 8 * kp + 4;
            u32x2 a, b; a.x = pk2(O[g0] * sc, O[g0 + 1] * sc); a.y = pk2(O[g0 + 2] * sc, O[g0 + 3] * sc); b.x = pk2(O[g1] * sc, O[g1 + 1] * sc); b.y = pk2(O[g1 + 2] * sc, O[g1 + 3] * sc);
            { auto r = __builtin_amdgcn_permlane32_swap(a.x, b.x, false, false); a.x = r[0]; b.x = r[1]; }
            { auto r = __builtin_amdgcn_permlane32_swap(a.y, b.y, false, false); a.y = r[0]; b.y = r[1]; }
            *(u32x4*)(rowp + 32 * mt + 16 * kp + 8 * h) = (u32x4){a.x, a.y, b.x, b.y}; }
}
DI void store_o_row_fp8(unsigned char* rowp, const f32x16& O0, const f32x16& O1, int h) {
#pragma unroll
    for (int mt = 0; mt < 2; ++mt)
#pragma unroll
        for (int kp = 0; kp < 2; ++kp) { const f32x16& O = mt ? O1 : O0; const int g0 = 8 * kp, g1 = 8 * kp + 4;
            unsigned a = pk4_fp8(O[g0], O[g0 + 1], O[g0 + 2], O[g0 + 3]), b = pk4_fp8(O[g1], O[g1 + 1], O[g1 + 2], O[g1 + 3]);
            { auto r = __builtin_amdgcn_permlane32_swap(a, b, false, false); a = r[0]; b = r[1]; }
            *(u32x2*)(rowp + 32 * mt + 16 * kp + 8 * h) = (u32x2){a, b}; }
}
#define ATTN_WAIT_TILE(more) do { if (more) asm volatile("s_waitcnt vmcnt(8)" ::: "memory"); else asm volatile("s_waitcnt vmcnt(0)" ::: "memory"); } while (0)
DI void dil_tile(const AttnLane& L, const __amdgpu_buffer_rsrc_t rs, const bf16_t* hb, int hd, long row0, int j, LAS unsigned char* ldsW, bf16_t* og, float* lse, int lane, const float (&gq)[32], const bf16_t* ropet, long tok0, int dil) {
    const int qi = lane & 31, h = lane >> 5;
    const bf16_t* qh = hb + (size_t)hd * T * 64;
    const unsigned kh = (unsigned)(WS_PROJ + ((size_t)(16 + hd) * T + row0) * 128), vh = (unsigned)(WS_PROJ + ((size_t)(32 + hd) * T + row0) * 128);
    bf16x8 qf[4];
    {
        const bf16_t* qp = qh + (size_t)(row0 + 32 * j + qi) * 64 + 8 * h;
        u32x4 qr[4];
#pragma unroll
        for (int s = 0; s < 4; ++s) qr[s] = *(const u32x4*)(qp + 16 * s);
        const u32x4* rpt = (const u32x4*)(ropet + (size_t)(tok0 + (long)dil * (32 * j + qi)) * 16); const u32x4 cc = rpt[0], sn = rpt[1];
        float qv[4][8]; float ss = 0.f;
#pragma unroll
        for (int s = 0; s < 4; ++s) { const u32x4 u = qr[s]; qv[s][0] = bf_lo(u.x); qv[s][1] = bf_hi(u.x); qv[s][2] = bf_lo(u.y); qv[s][3] = bf_hi(u.y); qv[s][4] = bf_lo(u.z); qv[s][5] = bf_hi(u.z); qv[s][6] = bf_lo(u.w); qv[s][7] = bf_hi(u.w);
#pragma unroll
            for (int e = 0; e < 8; ++e) ss += qv[s][e] * qv[s][e]; }
        ss += __shfl_xor(ss, 32);
        const float rinv = __builtin_amdgcn_rsqf(ss * (1.f / 64.f) + RMS_EPS) * QSCALE;
#pragma unroll
        for (int s = 0; s < 4; ++s)
#pragma unroll
            for (int e = 0; e < 8; ++e) qv[s][e] *= rinv * gq[s * 8 + e];
        { const float cs[8] = {bf_lo(cc.x), bf_hi(cc.x), bf_lo(cc.y), bf_hi(cc.y), bf_lo(cc.z), bf_hi(cc.z), bf_lo(cc.w), bf_hi(cc.w)};
          const float sv[8] = {bf_lo(sn.x), bf_hi(sn.x), bf_lo(sn.y), bf_hi(sn.y), bf_lo(sn.z), bf_hi(sn.z), bf_lo(sn.w), bf_hi(sn.w)};
#pragma unroll
          for (int e = 0; e < 8; ++e) { const float other = __shfl_xor(qv[0][e], 32); qv[0][e] = qv[0][e] * cs[e] + other * (h ? sv[e] : -sv[e]); } }
#pragma unroll
        for (int s = 0; s < 4; ++s) { u32x4 o; o.x = pk2(qv[s][0], qv[s][1]); o.y = pk2(qv[s][2], qv[s][3]); o.z = pk2(qv[s][4], qv[s][5]); o.w = pk2(qv[s][6], qv[s][7]); qf[s] = __builtin_bit_cast(bf16x8, o); }
    }
    float mrun = -INFINITY, lrun = 0.f;
    f32x16 O0, O1;
#pragma unroll
    for (int i = 0; i < 16; ++i) { O0[i] = 0.f; O1[i] = 0.f; }
    const int kt0 = j >= 4 ? j - 4 : 0;
    dma_tile(L, rs, kh + (unsigned)(4096 * kt0), vh + (unsigned)(4096 * kt0), ldsW);
    unsigned buf = 0;
    for (int kt = kt0; kt <= j; ++kt) {
        const bool more = kt < j;
        if (more) dma_tile(L, rs, kh + (unsigned)(4096 * (kt + 1)), vh + (unsigned)(4096 * (kt + 1)), ldsW + (buf ^ 1u) * SLOT_BYTES);
        ATTN_WAIT_TILE(more);
        LAS unsigned char* slot = ldsW + buf * SLOT_BYTES;
        f32x16 sc;
#pragma unroll
        for (int i = 0; i < 16; ++i) sc[i] = 0.f;
#pragma unroll
        for (int s = 0; s < 4; ++s) { const bf16x8 kf = *(const LAS bf16x8*)(slot + L.ka[s]); sc = mfma32(kf, qf[s], sc); }
        if (kt == j) {
#pragma unroll
            for (int i = 0; i < 16; ++i) { const int key = (i & 3) + 8 * (i >> 2) + 4 * h; if (key > qi) sc[i] = -INFINITY; }
        }
        if (kt == j - 4) {
#pragma unroll
            for (int i = 0; i < 16; ++i) { const int key = (i & 3) + 8 * (i >> 2) + 4 * h; if (key < qi) sc[i] = -INFINITY; }
        }
        float mx = sc[0];
#pragma unroll
        for (int i = 1; i < 16; ++i) mx = fmaxf(mx, sc[i]);
        mx = fmaxf(mx, __shfl_xor(mx, 32));
        const float mnew = fmaxf(mrun, mx), alpha = fexp2(mrun - mnew);
        float ps = 0.f;
#pragma unroll
        for (int i = 0; i < 16; ++i) { sc[i] = fexp2(sc[i] - mnew); ps += sc[i]; }
        lrun = lrun * alpha + ps; mrun = mnew;
#pragma unroll
        for (int i = 0; i < 16; ++i) { O0[i] *= alpha; O1[i] *= alpha; }
        const bf16x8 p0 = pack8(sc, 0), p1 = pack8(sc, 1);
        bf16x8 vf[2][2]; tr_read8(L, (unsigned)(size_t)slot, vf);
        O0 = mfma32(vf[0][0], p0, O0); O0 = mfma32(vf[0][1], p1, O0);
        O1 = mfma32(vf[1][0], p0, O1); O1 = mfma32(vf[1][1], p1, O1);
        buf ^= 1u;
    }
    const float ltot = lrun + __shfl_xor(lrun, 32), inv = frcp(ltot);
    const size_t row = (size_t)(row0 + 32 * j + qi);
    store_o_row(og + row * 64, O0, O1, inv, h);
    if (h == 0) lse[row] = mrun + flog2(ltot);
}
DI void sb_tile(const AttnLane& L, const __amdgpu_buffer_rsrc_t rs, const bf16_t* hb, int b, int h4, int j, LAS unsigned char* ldsW, unsigned char* ocat, int lane) {
    const int qi = lane & 31, h = lane >> 5;
    const long base = (long)b * S;
    const bf16_t* qh = hb + (size_t)(12 + h4) * T * 64;
    const unsigned kh = (unsigned)(WS_PROJ + ((size_t)(16 + 12 + h4) * T + base) * 128), vh = (unsigned)(WS_PROJ + ((size_t)(32 + 12 + h4) * T + base) * 128);
    bf16x8 qf[4];
    { const bf16_t* qp = qh + (size_t)(base + 32 * j + qi) * 64 + 8 * h;
#pragma unroll
      for (int s = 0; s < 4; ++s) qf[s] = *(const bf16x8*)(qp + 16 * s); }
    float carry = 0.f;
    f32x16 O0, O1;
#pragma unroll
    for (int i = 0; i < 16; ++i) { O0[i] = 0.f; O1[i] = 0.f; }
    dma_tile(L, rs, kh + (unsigned)(4096 * j), vh + (unsigned)(4096 * j), ldsW);
    unsigned buf = 0;
    for (int kt = j; kt >= 0; --kt) {
        const bool more = kt > 0;
        if (more) dma_tile(L, rs, kh + (unsigned)(4096 * (kt - 1)), vh + (unsigned)(4096 * (kt - 1)), ldsW + (buf ^ 1u) * SLOT_BYTES);
        ATTN_WAIT_TILE(more);
        LAS unsigned char* slot = ldsW + buf * SLOT_BYTES;
        f32x16 z;
#pragma unroll
        for (int i = 0; i < 16; ++i) z[i] = 0.f;
#pragma unroll
        for (int s = 0; s < 4; ++s) { const bf16x8 kf = *(const LAS bf16x8*)(slot + L.ka[s]); z = mfma32(kf, qf[s], z); }
#pragma unroll
        for (int i = 0; i < 16; ++i) z[i] = fexp2(fminf(z[i], 31.f));
        if (kt == j) {
#pragma unroll
            for (int i = 0; i < 16; ++i) { const int key = (i & 3) + 8 * (i >> 2) + 4 * h; if (key >= qi) z[i] = 0.f; }
        }
        float lg[4], par[4], u0[4], p01[4], p012[4];
#pragma unroll
        for (int g = 0; g < 4; ++g) { const float a0 = 1.f + z[4 * g], a1 = 1.f + z[4 * g + 1], a2 = 1.f + z[4 * g + 2], a3 = 1.f + z[4 * g + 3];
            u0[g] = a0; p01[g] = a0 * a1; p012[g] = p01[g] * a2; lg[g] = -flog2(p012[g] * a3); }
#pragma unroll
        for (int g = 0; g < 4; ++g) par[g] = __shfl_xor(lg[g], 32);
        float tg[4]; tg[3] = carry; tg[2] = tg[3] + (lg[3] + par[3]); tg[1] = tg[2] + (lg[2] + par[2]); tg[0] = tg[1] + (lg[1] + par[1]);
        carry = tg[0] + (lg[0] + par[0]);
#pragma unroll
        for (int g = 0; g < 4; ++g) { const float suf = tg[g] + lg[g] + (h == 0 ? par[g] : 0.f); const float y = fexp2(suf);
            z[4 * g] = z[4 * g] * y; z[4 * g + 1] = z[4 * g + 1] * (y * u0[g]); z[4 * g + 2] = z[4 * g + 2] * (y * p01[g]); z[4 * g + 3] = z[4 * g + 3] * (y * p012[g]); }
        const bf16x8 p0 = pack8(z, 0), p1 = pack8(z, 1);
        bf16x8 vf[2][2]; tr_read8(L, (unsigned)(size_t)slot, vf);
        O0 = mfma32(vf[0][0], p0, O0); O0 = mfma32(vf[0][1], p1, O0);
        O1 = mfma32(vf[1][0], p0, O1); O1 = mfma32(vf[1][1], p1, O1);
        if (__all(carry < -40.f)) break;
        buf ^= 1u;
    }
    store_o_row_fp8(ocat + (size_t)(base + 32 * j + qi) * LDO + 256 + h4 * 64, O0, O1, h);
}
DI void phase_attn(const Frame& F, const Params& p) {
    const int tid_ = fresh_tid(), lane_ = tid_ & 63;
    const bf16_t* hb = (const bf16_t*)(F.ws + WS_PROJ); unsigned char* ocat = F.ws + WS_OCAT;
    bf16_t* og = (bf16_t*)(F.ws + WS_OG); float* lse = (float*)(F.ws + WS_LSE);
    LAS unsigned char* ldsW = F.lds + F.wave * (2 * SLOT_BYTES);
    AttnLane L; attn_lane_init(L, lane_);
    float gq[32];
#pragma unroll
    for (int s4 = 0; s4 < 4; ++s4)
#pragma unroll
        for (int e = 0; e < 8; ++e) gq[s4 * 8 + e] = p.in[I_QG][16 * s4 + 8 * (lane_ >> 5) + e];
    const __amdgpu_buffer_rsrc_t rs = __builtin_amdgcn_make_buffer_rsrc(F.ws, 0, (int)WS_END, 0x00020000);
    const int NU = NB * 4 * 16;
    for (int i = 0;; ++i) {
        const int u = (F.G == 256) ? ((F.bid & 7) * 32 + (F.bid >> 3) + 256 * i) : (F.bid + F.G * i);
        if (u >= NU) break;
        const int qb = u & 15, hs = (u >> 4) & 3, b = u >> 6, t0 = qb * 512;
        for (int w = F.wave; w < 16; w += 8) sb_tile(L, rs, hb, b, hs, t0 / 32 + w, ldsW, ocat, lane_);
        for (int w = F.wave; w < 48; w += 8) {
            const int g = w >> 4, ti = w & 15, l2d = 2 * g, per = 16 >> l2d, r = ti / per, jj = ti % per;
            dil_tile(L, rs, hb, g * 4 + hs, (long)b * S + (long)r * (S >> l2d), ((t0 >> l2d) >> 5) + jj, ldsW, og + (size_t)(g * 4 + hs) * T * 64, lse + (size_t)(g * 4 + hs) * T, lane_, gq, (const bf16_t*)(F.ws + WS_ROPE), (long)b * S + r, 1 << l2d);
        }
        VM_WAIT();
        __syncthreads();
        {
            const int piece = tid_ & 7; const size_t bb = (size_t)b * S;
#pragma unroll 2
            for (int pass = 0; pass < 8; ++pass) {
                const int sq = t0 + pass * 64 + (tid_ >> 3);
                const size_t r0 = bb + sq, r1 = bb + ((size_t)(sq & 3) << 11) + (sq >> 2), r2 = bb + ((size_t)(sq & 15) << 9) + (sq >> 4);
                const float l0 = lse[(size_t)(0 + hs) * T + r0], l1 = lse[(size_t)(4 + hs) * T + r1], l2 = lse[(size_t)(8 + hs) * T + r2];
                const u32x4 x = *((const u32x4*)(og + ((size_t)(0 + hs) * T + r0) * 64) + piece), y = *((const u32x4*)(og + ((size_t)(4 + hs) * T + r1) * 64) + piece), z = *((const u32x4*)(og + ((size_t)(8 + hs) * T + r2) * 64) + piece);
                const float mx = fmaxf(l0, fmaxf(l1, l2)); float w0 = fexp2(l0 - mx), w1 = fexp2(l1 - mx), w2 = fexp2(l2 - mx); const float inv = frcp(w0 + w1 + w2); w0 *= inv; w1 *= inv; w2 *= inv;
                u32x2 r;
                r.x = pk4_fp8(w0 * bf_lo(x.x) + w1 * bf_lo(y.x) + w2 * bf_lo(z.x), w0 * bf_hi(x.x) + w1 * bf_hi(y.x) + w2 * bf_hi(z.x), w0 * bf_lo(x.y) + w1 * bf_lo(y.y) + w2 * bf_lo(z.y), w0 * bf_hi(x.y) + w1 * bf_hi(y.y) + w2 * bf_hi(z.y));
                r.y = pk4_fp8(w0 * bf_lo(x.z) + w1 * bf_lo(y.z) + w2 * bf_lo(z.z), w0 * bf_hi(x.z) + w1 * bf_hi(y.z) + w2 * bf_hi(z.z), w0 * bf_lo(x.w) + w1 * bf_lo(y.w) + w2 * bf_lo(z.w), w0 * bf_hi(x.w) + w1 * bf_hi(y.w) + w2 * bf_hi(z.w));
                *((u32x2*)(ocat + (bb + sq) * LDO + hs * 64) + piece) = r;
            }
        }
        __syncthreads();
    }
}

DI void route_rows(const Frame& F, const Params& p, int pm) {
    const int tid_ = fresh_tid(), lane_ = tid_ & 63;
    LAS int* hist = (LAS int*)(F.lds);
    const int ftid = fresh_tid();
    __syncthreads();
    if (ftid < 32) hist[ftid] = 0;
    __syncthreads();
    if (tid_ < 256) {
        const int row = pm * 256 + tid_; const float* L = (const float*)(F.ws + WS_LOGIT) + (size_t)row * 128;
        const float* brg = p.in[I_BRG]; const float* bre = p.in[I_BRE];
        float lgp[4];
#pragma unroll
        for (int c = 0; c < 4; ++c) lgp[c] = L[c] + L[36 + c] + brg[c];
        int gsel = 0; float gm = lgp[0];
#pragma unroll
        for (int c = 1; c < 4; ++c) if (lgp[c] > gm) { gm = lgp[c]; gsel = c; }
        float zs = 0.f;
#pragma unroll
        for (int c = 0; c < 4; ++c) zs += fexp2((lgp[c] - gm) * LOG2E);
        const float pg = frcp(zs);
        float l1 = -INFINITY, l2 = -INFINITY; int e1 = 0, e2 = 0;
#pragma unroll
        for (int i = 0; i < 8; ++i) { const int c = 4 + gsel * 8 + i; const float v = L[c] + L[36 + c] + bre[gsel * 8 + i];
            if (v > l1) { l2 = l1; e2 = e1; l1 = v; e1 = i; } else if (v > l2) { l2 = v; e2 = i; } }
        const float ex = fexp2((l2 - l1) * LOG2E), den = frcp(1.f + ex);
        int* te = (int*)(F.ws + WS_TOKE) + (size_t)row * 2; float* tw = (float*)(F.ws + WS_TOKW) + (size_t)row * 2;
        te[0] = gsel * 8 + e1; te[1] = gsel * 8 + e2; tw[0] = pg * den; tw[1] = pg * ex * den;
        lds_add(&hist[gsel * 8 + e1], 1); lds_add(&hist[gsel * 8 + e2], 1);
    }
    __syncthreads();
    if (ftid < 32) ((int*)(F.ws + WS_HIST))[pm * 32 + ftid] = hist[ftid];
}


DI void router_weights_to_lds(const Frame& F, const Params& p) {
    const int tid_ = fresh_tid(), lane_ = tid_ & 63;
    constexpr int WP = 1028;
    LAS float* wt = (LAS float*)(F.lds + LDS_RW); LAS float* bias = (LAS float*)(F.lds + LDS_RS) + 8 * 80 + 32;
    const float* wrg = p.in[I_WRG]; const float* wre = p.in[I_WRE]; const float* brg = p.in[I_BRG]; const float* bre = p.in[I_BRE];
    const int ftid = fresh_tid();
    __syncthreads();
#pragma unroll 8
    for (int i = ftid; i < 1024 * 32; i += 512) wt[(4 + (i & 31)) * WP + (i >> 5)] = wre[i];
#pragma unroll 8
    for (int i = ftid; i < 1024 * 4; i += 512) wt[(i & 3) * WP + (i >> 2)] = wrg[i];
    if (ftid < 36) bias[ftid] = ftid < 4 ? brg[ftid] : bre[ftid - 4];
}

DI void phase_norm2_route(const Frame& F, const Params& p) {
    const int tid_ = fresh_tid(), lane_ = tid_ & 63;
    constexpr int WP = 1028;
    LAS float* wt = (LAS float*)(F.lds + LDS_RW);
    LAS float* gs = (LAS float*)(F.lds + LDS_RV); LAS float* sh = gs + 1024;
    LAS float* scr = (LAS float*)(F.lds + LDS_RS) + F.wave * 80;
    LAS int* hist = (LAS int*)(F.lds + LDS_RS) + 8 * 80;
    LAS float* bias = (LAS float*)(F.lds + LDS_RS) + 8 * 80 + 32;
    const float* mod = (const float*)(F.ws + WS_MOD); const float* gn = p.in[I_GFFN];
    const bf16_t* upd = (const bf16_t*)(F.ws + WS_UPD1); bf16_t* x1w = (bf16_t*)(F.ws + WS_UPD1); unsigned* h8 = (unsigned*)(F.ws + WS_H28);
    const float* wrg = p.in[I_WRG]; const float* wre = p.in[I_WRE]; const float* brg = p.in[I_BRG]; const float* bre = p.in[I_BRE];
    const int ftid = fresh_tid();
    __syncthreads();
    for (int chunk = F.bid; chunk < T / 256; chunk += F.G) {
        const int b = chunk >> 5;
        __syncthreads();
        for (int col = ftid; col < 1024; col += 512) { gs[col] = gn[col] * (1.f + mod[b * 6144 + 4096 + col]); sh[col] = mod[b * 6144 + 3072 + col]; }
        if (ftid < 32) hist[ftid] = 0;
        __syncthreads();
        f32x4 vn[2][4]; u32x2 un[2][4];
#pragma unroll
        for (int r = 0; r < 2; ++r) { const int row = chunk * 256 + F.wave * 2 + r;
            const f32x4* xr = (const f32x4*)(p.in[I_X] + (size_t)row * 1024) + lane_; const u32x2* ur = (const u32x2*)(upd + (size_t)row * 1024) + lane_;
#pragma unroll
            for (int j = 0; j < 4; ++j) { vn[r][j] = xr[64 * j]; un[r][j] = ur[64 * j]; } }
        for (int rr = F.wave * 2; rr < 256; rr += 16) {
            const int row0 = chunk * 256 + rr;
            f32x4 y[2][4];
#pragma unroll
            for (int r = 0; r < 2; ++r) {
                const int row = row0 + r; float ss = 0.f;
#pragma unroll
                for (int j = 0; j < 4; ++j) { vn[r][j].x += bf_lo(un[r][j].x); vn[r][j].y += bf_hi(un[r][j].x); vn[r][j].z += bf_lo(un[r][j].y); vn[r][j].w += bf_hi(un[r][j].y);
                    { u32x2 o; o.x = pk2(vn[r][j].x, vn[r][j].y); o.y = pk2(vn[r][j].z, vn[r][j].w); *((u32x2*)(x1w + (size_t)row * 1024) + lane_ + 64 * j) = o; }
                    ss += (vn[r][j].x * vn[r][j].x + vn[r][j].y * vn[r][j].y) + (vn[r][j].z * vn[r][j].z + vn[r][j].w * vn[r][j].w); }
                const float rinv = __builtin_amdgcn_rsqf(wave_sum(ss) * (1.f / 1024.f) + RMS_EPS);
#pragma unroll
                for (int j = 0; j < 4; ++j) { const f32x4 gj = *(const LAS f32x4*)(gs + 256 * j + 4 * lane_), sj = *(const LAS f32x4*)(sh + 256 * j + 4 * lane_);
                    y[r][j] = vn[r][j] * rinv * gj + sj; h8[(size_t)row * 256 + 64 * j + lane_] = pk4_fp8(y[r][j].x, y[r][j].y, y[r][j].z, y[r][j].w); }
            }
            if (rr + 16 < 256) {
#pragma unroll
                for (int r = 0; r < 2; ++r) { const int row = row0 + 16 + r;
                    const f32x4* xr = (const f32x4*)(p.in[I_X] + (size_t)row * 1024) + lane_; const u32x2* ur = (const u32x2*)(upd + (size_t)row * 1024) + lane_;
#pragma unroll
                    for (int j = 0; j < 4; ++j) { vn[r][j] = xr[64 * j]; un[r][j] = ur[64 * j]; } }
            }
            const bool up32 = (lane_ & 32) != 0, up16 = (lane_ & 16) != 0, up8 = (lane_ & 8) != 0, up4 = (lane_ & 4) != 0;
            {
                f32x2 ga[2][4], gb[2][4];
#pragma unroll
                for (int r = 0; r < 2; ++r)
#pragma unroll
                    for (int c = 0; c < 4; ++c) { ga[r][c] = (f32x2){0.f, 0.f}; gb[r][c] = ga[r][c]; }
#pragma unroll
                for (int c = 0; c < 4; ++c)
#pragma unroll
                    for (int j = 0; j < 4; ++j) { const f32x4 w = *(const LAS f32x4*)(wt + c * WP + 4 * lane_ + 256 * j); const f32x2 wl = {w.x, w.y}, wh = {w.z, w.w};
#pragma unroll
                        for (int r = 0; r < 2; ++r) { ga[r][c] = __builtin_elementwise_fma((f32x2){y[r][j].x, y[r][j].y}, wl, ga[r][c]); gb[r][c] = __builtin_elementwise_fma((f32x2){y[r][j].z, y[r][j].w}, wh, gb[r][c]); } }
                float k4[4];
#pragma unroll
                for (int c = 0; c < 4; ++c) { const f32x2 t0 = ga[0][c] + gb[0][c], t1 = ga[1][c] + gb[1][c]; const float p0 = t0.x + t0.y, p1 = t1.x + t1.y;
                    k4[c] = up32 ? p0 : p1; ga[0][c].x = up32 ? p1 : p0; }
#pragma unroll
                for (int c = 0; c < 4; ++c) k4[c] = ga[0][c].x + __shfl_xor(k4[c], 32);
                float k2[2];
#pragma unroll
                for (int i = 0; i < 2; ++i) k2[i] = (up16 ? k4[2 + i] : k4[i]) + __shfl_xor(up16 ? k4[i] : k4[2 + i], 16);
                float k1 = (up8 ? k2[1] : k2[0]) + __shfl_xor(up8 ? k2[0] : k2[1], 8);
                k1 += __shfl_xor(k1, 4); k1 += __shfl_xor(k1, 2); k1 += __shfl_xor(k1, 1);
                if ((lane_ & 7) == 0) scr[(lane_ >> 5) * 36 + ((lane_ >> 4) & 1) * 2 + ((lane_ >> 3) & 1)] = k1;
            }
            LDS_WAIT();
            int gsel[2];
#pragma unroll
            for (int r = 0; r < 2; ++r) { int gi = 0; float gm = scr[r * 36] + bias[0];
#pragma unroll
                for (int c = 1; c < 4; ++c) { const float v = scr[r * 36 + c] + bias[c]; if (v > gm) { gm = v; gi = c; } }
                gsel[r] = __builtin_amdgcn_readfirstlane(gi); }
            {
                float pe[2][8];
#pragma unroll
                for (int r = 0; r < 2; ++r) {
                    const LAS float* wb = wt + (4 + gsel[r] * 8) * WP + 4 * lane_;
#pragma unroll
                    for (int hh = 0; hh < 2; ++hh) {
                        f32x2 ea[4], eb[4];
#pragma unroll
                        for (int i = 0; i < 4; ++i) { ea[i] = (f32x2){0.f, 0.f}; eb[i] = ea[i]; }
#pragma unroll
                        for (int i = 0; i < 4; ++i)
#pragma unroll
                            for (int j = 0; j < 4; ++j) { const f32x4 w = *(const LAS f32x4*)(wb + (hh * 4 + i) * WP + 256 * j);
                                ea[i] = __builtin_elementwise_fma((f32x2){y[r][j].x, y[r][j].y}, (f32x2){w.x, w.y}, ea[i]); eb[i] = __builtin_elementwise_fma((f32x2){y[r][j].z, y[r][j].w}, (f32x2){w.z, w.w}, eb[i]); }
#pragma unroll
                        for (int i = 0; i < 4; ++i) { const f32x2 t = ea[i] + eb[i]; pe[r][hh * 4 + i] = t.x + t.y; }
                        __builtin_amdgcn_sched_barrier(0);
                    }
                }
                float e8[8], e4[4], e2[2];
#pragma unroll
                for (int i = 0; i < 8; ++i) e8[i] = (up32 ? pe[1][i] : pe[0][i]) + __shfl_xor(up32 ? pe[0][i] : pe[1][i], 32);
#pragma unroll
                for (int i = 0; i < 4; ++i) e4[i] = (up16 ? e8[4 + i] : e8[i]) + __shfl_xor(up16 ? e8[i] : e8[4 + i], 16);
#pragma unroll
                for (int i = 0; i < 2; ++i) e2[i] = (up8 ? e4[2 + i] : e4[i]) + __shfl_xor(up8 ? e4[i] : e4[2 + i], 8);
                float e1 = (up4 ? e2[1] : e2[0]) + __shfl_xor(up4 ? e2[0] : e2[1], 4);
                e1 += __shfl_xor(e1, 2); e1 += __shfl_xor(e1, 1);
                if ((lane_ & 3) == 0) scr[(lane_ >> 5) * 36 + 4 + ((lane_ >> 4) & 1) * 4 + ((lane_ >> 3) & 1) * 2 + ((lane_ >> 2) & 1)] = e1;
            }
            LDS_WAIT();
            if (lane_ < 2) {
                const LAS float* L = scr + lane_ * 36; const int row = row0 + lane_;
                float lgp[4];
#pragma unroll
                for (int c = 0; c < 4; ++c) lgp[c] = L[c] + bias[c];
                int gsel = 0; float gm = lgp[0];
#pragma unroll
                for (int c = 1; c < 4; ++c) if (lgp[c] > gm) { gm = lgp[c]; gsel = c; }
                float zs = 0.f;
#pragma unroll
                for (int c = 0; c < 4; ++c) zs += fexp2((lgp[c] - gm) * LOG2E);
                const float pg = frcp(zs);
                float l1 = -INFINITY, l2 = -INFINITY; int e1 = 0, e2 = 0;
#pragma unroll
                for (int i = 0; i < 8; ++i) { const float v = L[4 + i] + bias[4 + gsel * 8 + i];
                    if (v > l1) { l2 = l1; e2 = e1; l1 = v; e1 = i; } else if (v > l2) { l2 = v; e2 = i; } }
                const float ex = fexp2((l2 - l1) * LOG2E), den = frcp(1.f + ex);
                int* te = (int*)(F.ws + WS_TOKE) + (size_t)row * 2; float* tw = (float*)(F.ws + WS_TOKW) + (size_t)row * 2;
                te[0] = gsel * 8 + e1; te[1] = gsel * 8 + e2; tw[0] = pg * den; tw[1] = pg * ex * den;
                lds_add(&hist[gsel * 8 + e1], 1); lds_add(&hist[gsel * 8 + e2], 1);
            }
            LDS_WAIT();
        }
        __syncthreads();
        if (ftid < 32) ((int*)(F.ws + WS_HIST))[chunk * 32 + ftid] = hist[ftid];
    }
}

DI void phase_slots(const Frame& F, const Params& p) {
    const int tid_ = fresh_tid(), lane_ = tid_ & 63;
    LAS int* tot = (LAS int*)(F.lds); LAS int* bas = tot + 32; LAS int* pst = tot + 64; LAS int* wcnt = tot + 128;
    const int* hist = (const int*)(F.ws + WS_HIST);
    for (int pm = F.bid; pm < T / 256; pm += F.G) {
        const int ftid = fresh_tid();
        __syncthreads();
        if (ftid < 64) tot[ftid] = 0;
        __syncthreads();
        { const int e = tid_ & 31, part = tid_ >> 5; int t = 0, bs = 0;
          for (int q = part; q < T / 256; q += 16) { const int v = hist[q * 32 + e]; t += v; if (q < pm) bs += v; }
          lds_add(&tot[e], t); lds_add(&bas[e], bs); }
        __syncthreads();
        if (tid_ == 0) { int run = 0; for (int e = 0; e < 32; ++e) { pst[e] = run; run += (tot[e] + 255) / 256 * 256; } pst[32] = run; }
        const int my_e = ((const int*)(F.ws + WS_TOKE))[(size_t)pm * 512 + tid_];
        int rank = 0;
        for (int e = 0; e < 32; ++e) { const unsigned long long mask = __ballot(my_e == e); if (my_e == e) rank = __popcll(mask & ((1ull << lane_) - 1ull)); if (lane_ == 0) wcnt[F.wave * 32 + e] = __popcll(mask); }
        __syncthreads();
        int woff = 0;
        for (int w = 0; w < F.wave; ++w) woff += wcnt[w * 32 + my_e];
        const int slot = pst[my_e] + bas[my_e] + woff + rank;
        ((int*)(F.ws + WS_SLOTTOK))[slot] = pm * 256 + (tid_ >> 1);
        ((float*)(F.ws + WS_SLOTW))[slot] = ((const float*)(F.ws + WS_TOKW))[(size_t)pm * 512 + tid_];
        ((int*)(F.ws + WS_TOKS))[(size_t)pm * 512 + tid_] = slot;
        if (pm < 32) { const int e = pm; for (int s = pst[e] + tot[e] + tid_; s < pst[e + 1]; s += 512) { ((int*)(F.ws + WS_SLOTTOK))[s] = 0; ((float*)(F.ws + WS_SLOTW))[s] = 0.f; } }
        if (pm == 0 && tid_ < 34) { int* et = (int*)(F.ws + WS_ETAB); if (tid_ < 33) et[64 + tid_] = pst[tid_] >> 8; if (tid_ < 32) { et[tid_] = tot[tid_]; et[32 + tid_] = pst[tid_]; } if (tid_ == 33) et[97] = pst[32] >> 8; }
    }
}

DI void phase_combine(const Frame& F, const Params& p) {
    const int tid_ = fresh_tid(), lane_ = tid_ & 63;
    const unsigned* y = (const unsigned*)(F.ws + WS_Y); const int* ts = (const int*)(F.ws + WS_TOKS); const float* tw = (const float*)(F.ws + WS_TOKW); const float* mod = (const float*)(F.ws + WS_MOD);
    const int gw = F.bid * 8 + F.wave, NGW = F.G * 8;
    for (int row = gw; row < T; row += NGW) {
        const int s0 = ts[(size_t)row * 2], s1 = ts[(size_t)row * 2 + 1]; const float w0 = tw[(size_t)row * 2] * 0.125f, w1 = tw[(size_t)row * 2 + 1] * 0.125f;
        f32x4* orow = (f32x4*)(p.out + (size_t)row * 1024) + lane_;
        const u32x2* ur = (const u32x2*)((const bf16_t*)(F.ws + WS_UPD1) + (size_t)row * 1024) + lane_;
        const unsigned* y0 = y + (size_t)s0 * 256 + lane_; const unsigned* y1 = y + (size_t)s1 * 256 + lane_;
        const f32x4* g2 = (const f32x4*)(mod + (row >> 13) * 6144 + 5120) + lane_;
        f32x4 v[4], g[4]; unsigned a[4], c[4]; u32x2 uu[4];
#pragma unroll
        for (int j = 0; j < 4; ++j) { uu[j] = ur[64 * j]; a[j] = y0[64 * j]; c[j] = y1[64 * j]; g[j] = g2[64 * j]; }
#pragma unroll
        for (int j = 0; j < 4; ++j) { v[j] = (f32x4){bf_lo(uu[j].x), bf_hi(uu[j].x), bf_lo(uu[j].y), bf_hi(uu[j].y)};
            if (!DBG_SKIP_Y) { const f32x2 al = fp8_lo2(a[j]), ah = fp8_hi2(a[j]), cl = fp8_lo2(c[j]), ch = fp8_hi2(c[j]);
                v[j].x += g[j].x * (w0 * al.x + w1 * cl.x); v[j].y += g[j].y * (w0 * al.y + w1 * cl.y); v[j].z += g[j].z * (w0 * ah.x + w1 * ch.x); v[j].w += g[j].w * (w0 * ah.y + w1 * ch.y); } orow[64 * j] = v[j]; }
    }
}

__global__ void __launch_bounds__(512, 2) fwd(Params p) {
    extern __shared__ __attribute__((aligned(16))) unsigned char lds_raw[];
    Frame F;
    F.lds = (LAS unsigned char*)lds_raw; F.ws = p.ws;
    F.wave = __builtin_amdgcn_readfirstlane((int)threadIdx.x >> 6); F.G = gridDim.x; F.bid = blockIdx.x;
    volatile LAS unsigned* ctl = (volatile LAS unsigned*)(F.lds + LDS_CTLO);
    { const int ftid = fresh_tid(); if (ftid < 64) ctl[ftid] = 0u; }
    __syncthreads();
    XcdBarrier bar; bar.bar = (unsigned*)(p.ws + WS_CTL) + CW_BAR; bar.x = 0; bar.st = ctl;
    if (MK_N_LAUNCHES == 1) bar = xcd_barrier_post((unsigned*)(p.ws + WS_CTL) + CW_BAR, ctl);
    const int lo = p.ph_lo, hi = p.ph_hi;
    const __amdgpu_buffer_rsrc_t rsw = __builtin_amdgcn_make_buffer_rsrc(p.ws, 0, (int)WS_END, 0x00020000);
#define IN(k) (lo <= (k) && (k) < hi)
#define REP(k) for (int rep_ = 0; rep_ < ((PROBE_PH) == (k) ? 2 : 1); ++rep_)
#define SEAM(k) do { if (IN(k) && IN((k) + 1)) xcd_barrier(bar); } while (0)

    if (IN(0)) REP(0) { phase0(F, p); } SEAM(0);
    if (IN(1)) REP(1) { phase_norm<0>(F, p); } SEAM(1);
    if (IN(2)) REP(2) {
        REP(20) {
            pg8::DenseSched Sd; Sd.init(T, 2304, F.G, F.bid, WS_H8, 1024, WS_W1D8, 1024);
            EpiProj<false> E{(bf16_t*)(F.ws + WS_PROJ), (bf16_t*)(F.ws + WS_GATES), (const bf16_t*)(F.ws + WS_ROPE), p.in[I_QG], p.in[I_KG], 0};
            pg8::gemm_phase<EpiProj<false>, pg8::DenseSched, true>(F.lds, 1024, Sd, E, rsw);
        }
        REP(21) {
            pg8::DenseSched Sd; Sd.init(T, 768, F.G, F.bid, WS_H, 2048, WS_W1 + (size_t)2304 * 2048, 2048);
            EpiProj<false> E{(bf16_t*)(F.ws + WS_PROJ), (bf16_t*)(F.ws + WS_GATES), (const bf16_t*)(F.ws + WS_ROPE), p.in[I_QG], p.in[I_KG], 9};
            pg8::gemm_phase<EpiProj<false>, pg8::DenseSched, false>(F.lds, 1024, Sd, E, rsw);
        }
        REP(22) {
            pg8::DenseSched Sd; Sd.init(T, 2048, F.G, F.bid, WS_H8, 1024, WS_WG8, 1024);
            EpiProj<true> E{(bf16_t*)(F.ws + WS_PROJ), (bf16_t*)(F.ws + WS_GATES), (const bf16_t*)(F.ws + WS_ROPE), p.in[I_QG], p.in[I_KG], 0};
            pg8::gemm_phase<EpiProj<true>, pg8::DenseSched, true>(F.lds, 1024, Sd, E, rsw);
        }
    } SEAM(2);
    if (IN(3)) REP(3) { phase_attn(F, p); } SEAM(3);
    if (IN(4)) REP(4) {
        pg8::DiagSched Sd; Sd.init(T, 2048, F.G, F.bid, WS_OCAT, 512, WS_WB, 512);
        EpiBranch E{(const unsigned char*)(F.ws + WS_GATES), F.ws + WS_MERGED};
        pg8::gemm_phase<EpiBranch, pg8::DiagSched, true>(F.lds, 512, Sd, E, rsw);
    } SEAM(4);
    if (IN(5)) REP(5) {
        pg8::DenseSched Sd; Sd.init(T, 1024, F.G, F.bid, WS_MERGED, 1024, WS_WO, 1024);
        EpiOut E{(bf16_t*)(F.ws + WS_UPD1), (const float*)(F.ws + WS_MOD)};
        pg8::gemm_phase<EpiOut, pg8::DenseSched, true>(F.lds, 1024, Sd, E, rsw);
        if (rep_ + 1 == ((PROBE_PH) == 5 ? 2 : 1)) router_weights_to_lds(F, p);
    } SEAM(5);
    if (IN(6)) REP(6) { phase_norm2_route(F, p); }
    if (IN(6) && IN(8)) xcd_barrier(bar);
    if (IN(8)) REP(8) { phase_slots(F, p); } SEAM(8);
    if (IN(9) || IN(10)) {
        LAS int* cst = (LAS int*)(F.lds + LDS_CTLO) + 16;
        __syncthreads();
        { const int ftid = fresh_tid(); if (ftid < 34) cst[ftid] = ((const int*)(F.ws + WS_ETAB))[64 + ftid]; }
        __syncthreads();
    }
    if (IN(9)) REP(9) {
        const LAS int* cst = (const LAS int*)(F.lds + LDS_CTLO) + 16;
        MoeSchedUp Sm; Sm.G = F.G; Sm.c = (F.G == 256) ? ((F.bid & 7) * 32 + (F.bid >> 3)) : F.bid; Sm.nc = __builtin_amdgcn_readfirstlane(cst[33]); Sm.pa = 1024; Sm.pb = 1024; Sm.A = (unsigned)WS_H28; Sm.B = (unsigned)WS_WGU; Sm.cstart = cst;
        Sm.slot_tok = (const int*)(F.ws + WS_SLOTTOK); Sm.estride = 1024u * 1024u; Sm.pnstride = 256u * 1024u;
        EpiSwiglu E{F.ws + WS_HMID};
        pg8::gemm_phase<EpiSwiglu, MoeSchedUp, true>(F.lds, 1024, Sm, E, rsw);
    } SEAM(9);
    if (IN(10)) REP(10) {
        const LAS int* cst = (const LAS int*)(F.lds + LDS_CTLO) + 16;
        MoeSchedDn Sm; Sm.G = F.G; Sm.c = (F.G == 256) ? ((F.bid & 7) * 32 + (F.bid >> 3)) : F.bid; Sm.nc = __builtin_amdgcn_readfirstlane(cst[33]); Sm.pa = 512; Sm.pb = 512; Sm.A = (unsigned)WS_HMID; Sm.B = (unsigned)WS_WDN; Sm.cstart = cst;
        Sm.slot_tok = (const int*)(F.ws + WS_SLOTTOK); Sm.estride = 1024u * 512u; Sm.pnstride = 256u * 512u;
        EpiDown E{F.ws + WS_Y};
        pg8::gemm_phase<EpiDown, MoeSchedDn, true>(F.lds, 512, Sm, E, rsw);
    } SEAM(10);
    if (IN(11)) { phase_combine(F, p); }
#undef IN
#undef SEAM
}

extern "C" void kernel_launch(void* const* d_in, const int* in_sizes, int n_in, void* d_out, int out_size, void* d_ws, size_t ws_size, hipStream_t stream) {
    static int grid = 0;
    if (grid == 0) {
        if (n_in != 21 || in_sizes[0] != T * D || out_size != T * D || ws_size < WS_END) { fprintf(stderr, "kernel_launch: unexpected problem (n_in %d, ws %zu)\n", n_in, ws_size); grid = -1; return; }
        int dev = 0, cus = 0, per_cu = 0;
        if (hipGetDevice(&dev) != hipSuccess || hipDeviceGetAttribute(&cus, hipDeviceAttributeMultiprocessorCount, dev) != hipSuccess) { grid = -1; return; }
        if (hipFuncSetAttribute((const void*)fwd, hipFuncAttributeMaxDynamicSharedMemorySize, LDS_BYTES) != hipSuccess) { fprintf(stderr, "kernel_launch: hipFuncSetAttribute failed\n"); grid = -1; return; }
        if (hipOccupancyMaxActiveBlocksPerMultiprocessor(&per_cu, (const void*)fwd, 512, LDS_BYTES) != hipSuccess || per_cu < 1) { fprintf(stderr, "kernel_launch: occupancy query says %d\n", per_cu); (void)hipGetLastError(); grid = -1; return; }
        grid = cus;
    }
    if (grid < 0) return;
    (void)hipMemsetAsync((char*)d_ws + WS_CTL, 0, CTL_ZERO_BYTES, stream);
    Params p{};
    for (int i = 0; i < 21; ++i) p.in[i] = (const float*)d_in[i];
    p.out = (float*)d_out; p.ws = (unsigned char*)d_ws;
    if (MK_N_LAUNCHES == 1) { p.ph_lo = 0; p.ph_hi = NPH; hipLaunchKernelGGL(fwd, dim3(grid), dim3(512), LDS_BYTES, stream, p); }
    else { for (int k = 0; k < NPH; ++k) { p.ph_lo = k; p.ph_hi = k + 1; hipLaunchKernelGGL(fwd, dim3(grid), dim3(512), LDS_BYTES, stream, p); } }
}
```

```cpp
#include <hip/hip_runtime.h>
#include <cstdio>
#include <cstdint>

#ifndef MK_N_LAUNCHES
#define MK_N_LAUNCHES 1
#endif
#define DBG_X1_PLAIN 0
#define DBG_SKIP_Y 0
#ifndef PROBE_PH
#define PROBE_PH -1
#endif

#define LAS __attribute__((address_space(3)))
#define DI __device__ __forceinline__
typedef unsigned short bf16_t;
typedef short bf16x8 __attribute__((ext_vector_type(8)));
typedef short s16x4 __attribute__((ext_vector_type(4)));
typedef float f32x2 __attribute__((ext_vector_type(2)));
typedef float f32x4 __attribute__((ext_vector_type(4)));
typedef float f32x16 __attribute__((ext_vector_type(16)));
typedef unsigned u32x2 __attribute__((ext_vector_type(2)));
typedef unsigned u32x4 __attribute__((ext_vector_type(4)));
typedef __bf16 bf16x2n __attribute__((ext_vector_type(2)));
typedef int i32x8 __attribute__((ext_vector_type(8)));

constexpr int NB = 8, S = 8192, D = 1024, T = NB * S;
constexpr int LDP = 3072, LDG = 2048, LDO = 512;
constexpr int NE = 32, DE = 512;
constexpr int MAXSLOT = T * 2 + NE * 256;
constexpr int NPH = 12;
constexpr float LOG2E = 1.4426950408889634f;
constexpr float QSCALE = 0.125f * LOG2E;
constexpr float RMS_EPS = 1e-6f;

constexpr size_t MiB = 1u << 20;
constexpr size_t WS_CTL = 0, CTL_ZERO_BYTES = 64 * 1024;
constexpr int CW_BAR = 1024;
constexpr size_t WS_MODP = 1 * MiB;
constexpr size_t WS_MOD = 3 * MiB;
constexpr size_t WS_ROPE = 4 * MiB;
constexpr size_t WS_LOGIT = 144 * MiB;
constexpr size_t WS_TOKE = 24 * MiB;
constexpr size_t WS_TOKW = 24 * MiB + 512 * 1024;
constexpr size_t WS_TOKS = 25 * MiB;
constexpr size_t WS_SLOTTOK = 25 * MiB + 512 * 1024;
constexpr size_t WS_SLOTW = 26 * MiB + 256 * 1024;
constexpr size_t WS_HIST = 27 * MiB;
constexpr size_t WS_ETAB = 27 * MiB + 256 * 1024;
constexpr size_t WS_WR = 28 * MiB;
constexpr size_t WS_W1D8 = 28 * MiB + 512 * 1024;
constexpr size_t WS_W1 = 32 * MiB;
constexpr size_t WS_WG8 = 38 * MiB;
constexpr size_t WS_WB = 40 * MiB;
constexpr size_t WS_WO = 43 * MiB;
constexpr size_t WS_WGU = 48 * MiB;
constexpr size_t WS_WDN = 80 * MiB;
constexpr size_t WS_H = 144 * MiB;
constexpr size_t WS_OG = 144 * MiB;
constexpr size_t WS_LSE = 240 * MiB;
constexpr size_t WS_PROJ = 272 * MiB;
constexpr size_t WS_GATES = 656 * MiB;
constexpr size_t WS_OCAT = 912 * MiB;
constexpr size_t WS_H8 = 912 * MiB;
constexpr size_t WS_MERGED = 272 * MiB;
constexpr size_t WS_H2 = 400 * MiB;
constexpr size_t WS_H28 = 528 * MiB;
constexpr size_t WS_HMID = 592 * MiB;
constexpr size_t WS_Y = 664 * MiB;
constexpr size_t WS_UPD1 = 800 * MiB;
constexpr size_t WS_END = 976 * MiB;

constexpr int LDS_STAGE = 0, LDS_EPI = 131072, LDS_RW = 0, LDS_RV = 148480, LDS_RS = 148480 + 8192, LDS_CTLO = 148480 + 8192 + 3072, LDS_BYTES = LDS_CTLO + 256;

DI unsigned pk2(float lo, float hi) { f32x2 v = {lo, hi}; bf16x2n r = __builtin_convertvector(v, bf16x2n); return __builtin_bit_cast(unsigned, r); }
DI unsigned pk4_fp8(float a, float b, float c, float d) { int r = __builtin_amdgcn_cvt_pk_fp8_f32(a, b, 0, false); r = __builtin_amdgcn_cvt_pk_fp8_f32(c, d, r, true); return (unsigned)r; }
DI f32x2 fp8_lo2(unsigned u) { return __builtin_amdgcn_cvt_pk_f32_fp8((int)u, false); }
DI f32x2 fp8_hi2(unsigned u) { return __builtin_amdgcn_cvt_pk_f32_fp8((int)u, true); }
DI float bf_lo(unsigned u) { return __builtin_bit_cast(float, u << 16); }
DI float bf_hi(unsigned u) { return __builtin_bit_cast(float, u & 0xffff0000u); }
DI float wave_sum(float v) {
#pragma unroll
    for (int o = 1; o < 64; o <<= 1) v += __shfl_xor(v, o);
    return v;
}
DI float fexp2(float x) { return __builtin_amdgcn_exp2f(x); }
DI float flog2(float x) { return __builtin_amdgcn_logf(x); }
DI float frcp(float x) { return __builtin_amdgcn_rcpf(x); }
DI float sigmoidf(float v) { return frcp(1.0f + fexp2(-v * LOG2E)); }
DI void lds_add(LAS int* p, int v) { (void)__hip_atomic_fetch_add(p, v, __ATOMIC_RELAXED, __HIP_MEMORY_SCOPE_WORKGROUP); }
#define LDS_WAIT() asm volatile("s_waitcnt lgkmcnt(0)" ::: "memory")
#define VM_WAIT() asm volatile("s_waitcnt vmcnt(0)" ::: "memory")
DI int fresh_tid() { int t = threadIdx.x; asm volatile("" : "+v"(t)); return t; }

#define XB_TMO      128
#define XB_XCNT(j)  (256  + 64 * (j))
#define XB_XSUB(j)  (1280 + 64 * (j))
#define XB_XGEN(j)  (2304 + 64 * (j))
#define XB_TOP      3328
#define XB_TOPGEN   3392
#define XCD_BAR_WORDS 3456
#define XB_SPIN_CAP (1u << 18)

__device__ __forceinline__ unsigned xb_ld(unsigned* p)              { return __hip_atomic_load(p, __ATOMIC_RELAXED, __HIP_MEMORY_SCOPE_AGENT); }
__device__ __forceinline__ unsigned xb_add(unsigned* p, unsigned v) { return __hip_atomic_fetch_add(p, v, __ATOMIC_RELAXED, __HIP_MEMORY_SCOPE_AGENT); }
__device__ __forceinline__ unsigned xb_xcc_id() { return (unsigned)__builtin_amdgcn_s_getreg((3 << 11) | 20) & 0xFu; }
#define XB_SPIN(cond, bar) do { unsigned _sp = 0; while (cond) { __builtin_amdgcn_s_sleep(1); \
    if ((++_sp & 255u) == 0u) { if (xb_ld(&(bar)[XB_TMO])) break; if (_sp > XB_SPIN_CAP) { atomicAdd(&(bar)[XB_TMO], 1u); break; } } } } while (0)

struct XcdBarrier {
    unsigned* bar; unsigned x;
    volatile LAS unsigned* st;
};
__device__ __forceinline__ XcdBarrier xcd_barrier_post(unsigned* bar, volatile LAS unsigned* st) {
    XcdBarrier b; b.bar = bar; b.x = xb_xcc_id(); b.st = st;
    if (threadIdx.x == 0) (void)xb_add(&bar[XB_XCNT(b.x)], 1u);
    return b;
}
__device__ __forceinline__ void xcd_barrier_complete(unsigned* bar, unsigned x, unsigned& nloc, unsigned& nx) {
    const unsigned G = gridDim.x * gridDim.y * gridDim.z;
    unsigned sum, cnt, mine, sp = 0u;
    for (;;) {
        sum = 0u; cnt = 0u; mine = 0u;
#pragma unroll
        for (unsigned j = 0; j < 16; ++j) { const unsigned c = xb_ld(&bar[XB_XCNT(j)]); sum += c; cnt += (c > 0u) ? 1u : 0u; mine = (j == x) ? c : mine; }
        if (sum == G) break;
        __builtin_amdgcn_s_sleep(1);
        if ((++sp & 255u) == 0u) { if (xb_ld(&bar[XB_TMO])) break; if (sp > XB_SPIN_CAP) { atomicAdd(&bar[XB_TMO], 1u); break; } }
    }
    nloc = mine > 0u ? mine : 1u; nx = cnt > 0u ? cnt : 1u;
}
__device__ __forceinline__ void xcd_barrier(const XcdBarrier& b) {
    asm volatile("s_waitcnt vmcnt(0)" ::: "memory");
    __syncthreads();
    if (threadIdx.x == 0) {
        unsigned* bar = b.bar;
        __builtin_amdgcn_s_waitcnt(0);
        unsigned nloc = b.st[0], nx = b.st[1];
        if (nloc == 0u) { xcd_barrier_complete(bar, b.x, nloc, nx); b.st[0] = nloc; b.st[1] = nx; }
        const unsigned old = xb_add(&bar[XB_XSUB(b.x)], 1u);
        const unsigned gen = old / nloc;
        if (old + 1u == (gen + 1u) * nloc) {
            __builtin_amdgcn_fence(__ATOMIC_RELEASE, "agent");
            asm volatile("s_waitcnt vmcnt(0)" ::: "memory");
            const unsigned og = xb_add(&bar[XB_TOP], 1u);
            const unsigned tg = og / nx;
            if (og + 1u == (tg + 1u) * nx) xb_add(&bar[XB_TOPGEN], 1u);
            else XB_SPIN(xb_ld(&bar[XB_TOPGEN]) == tg, bar);
            __builtin_amdgcn_fence(__ATOMIC_ACQUIRE, "agent");
            xb_add(&bar[XB_XGEN(b.x)], 1u);
            asm volatile("s_waitcnt vmcnt(0)" ::: "memory");
        } else {
            XB_SPIN(xb_ld(&bar[XB_XGEN(b.x)]) == gen, bar);
            __builtin_amdgcn_fence(__ATOMIC_ACQUIRE, "agent");
            asm volatile("s_waitcnt vmcnt(0)" ::: "memory");
        }
    }
    __syncthreads();
}

namespace pg8 {
constexpr int BM = 256, BK = 64, HALF = 128, HTB = HALF * BK * 2, STAGE_BYTES = 8 * HTB, NXCD = 8, WGM = 8;
__host__ __device__ __forceinline__ int lds_byte(int r, int c) { const int st = (r >> 4) * 2 + (c >> 5), rr = r & 15, cc = c & 31, ob = rr * 64 + cc * 2; return st * 1024 + (ob ^ (((ob >> 9) & 1) << 5)); }
__host__ __device__ __forceinline__ void stage_rc(int b, int& R, int& C) { const int st = b / 1024, sb = b % 1024, swz = sb ^ (((sb >> 9) & 1) << 5); R = (st >> 1) * 16 + swz / 64; C = (st & 1) * 32 + (swz % 64) / 2; }
__host__ __device__ __forceinline__ int perm32(int rho) { const int n = rho >> 4, i = rho & 15; return 8 * (i >> 2) + 4 * n + (i & 3); }

struct Unit { int pm, pn, aux; unsigned a, b; };
typedef int i32x4 __attribute__((ext_vector_type(4)));
__device__ __forceinline__ i32x8 frag8(bf16x8 lo, bf16x8 hi) { return __builtin_shufflevector(__builtin_bit_cast(i32x4, lo), __builtin_bit_cast(i32x4, hi), 0, 1, 2, 3, 4, 5, 6, 7); }

template <class Epi, class Sched, bool FP8 = false>
__device__ __forceinline__ void gemm_phase(LAS unsigned char* lds, const int K, const Sched& S, const Epi& E, const __amdgpu_buffer_rsrc_t rs) {
    const int tid = fresh_tid(), wid = __builtin_amdgcn_readfirstlane(tid >> 6), lane = tid & 63, wr = wid >> 2, wc = wid & 3, fr = lane & 15, fq = lane >> 4;
    const int nt = FP8 ? K / 128 : K / BK;
    int RA[2], CA[2];
    unsigned voffA[4], voffB[2];
#pragma unroll
    for (int i = 0; i < 2; ++i) { int R, C; stage_rc(tid * 16 + i * 8192, R, C); RA[i] = R; CA[i] = C; const int Rb = Epi::PERM ? ((R & ~31) + perm32(R & 31)) : R;
        voffB[i] = (unsigned)(Rb * S.pb + C * 2); }
    const unsigned kstep = (unsigned)(BK * 2);
    const unsigned hstepB = (unsigned)(HALF * S.pb), hstepA = (unsigned)(HALF * S.pa);
    const unsigned ldsw = (unsigned)wid * 1024u;
    const int aoff = lds_byte(wr * 64 + fr, fq * 8), boff = lds_byte(wc * 32 + fr, fq * 8);
    constexpr int kpiece = 1024;
#define PG8_SA(b, h) (((b) * 2 + (h)) * HTB)
#define PG8_SB(b, h) ((4 + (b) * 2 + (h)) * HTB)
#define PG8_STAGE_B(bufoff, gbase) do { _Pragma("unroll") for (int _i = 0; _i < 2; ++_i) \
        __builtin_amdgcn_raw_ptr_buffer_load_lds(rs, (LAS unsigned*)(lds + (bufoff) + ldsw + _i * 8192), 16, (int)voffB[_i], (int)(gbase), 0, 0); } while (0)
#define PG8_STAGE_A(bufoff, gbase, h) do { _Pragma("unroll") for (int _i = 0; _i < 2; ++_i) \
        __builtin_amdgcn_raw_ptr_buffer_load_lds(rs, (LAS unsigned*)(lds + (bufoff) + ldsw + _i * 8192), 16, (int)voffA[Sched::GATHER ? (h) * 2 + _i : _i], (int)((gbase) + (Sched::GATHER ? 0u : (unsigned)(h) * hstepA)), 0, 0); } while (0)
#define PG8_LDA(dst, b, h) do { _Pragma("unroll") for (int m = 0; m < 4; ++m) _Pragma("unroll") for (int k = 0; k < 2; ++k) dst[m][k] = *(const LAS bf16x8*)(lds + PG8_SA(b, h) + aoff + m * 2048 + k * kpiece); } while (0)
#define PG8_LDB(dst, b, h) do { _Pragma("unroll") for (int n = 0; n < 2; ++n) _Pragma("unroll") for (int k = 0; k < 2; ++k) dst[n][k] = *(const LAS bf16x8*)(lds + PG8_SB(b, h) + boff + n * 2048 + k * kpiece); } while (0)
#define PG8_MMA(ai, bj, At, Bt) do { __builtin_amdgcn_s_setprio(1); if constexpr (FP8) { _Pragma("unroll") for (int m = 0; m < 4; ++m) _Pragma("unroll") for (int n = 0; n < 2; ++n) \
        acc[ai][bj][m][n] = __builtin_amdgcn_mfma_scale_f32_16x16x128_f8f6f4(frag8(Bt[n][0], Bt[n][1]), frag8(At[m][0], At[m][1]), acc[ai][bj][m][n], 0, 0, 0, 0x7C7C7C7C, 0, 0x7C7C7C7C); } \
      else { _Pragma("unroll") for (int m = 0; m < 4; ++m) _Pragma("unroll") for (int n = 0; n < 2; ++n) _Pragma("unroll") for (int k = 0; k < 2; ++k) \
        acc[ai][bj][m][n] = __builtin_amdgcn_mfma_f32_16x16x32_bf16(Bt[n][k], At[m][k], acc[ai][bj][m][n], 0, 0, 0); } __builtin_amdgcn_s_setprio(0); } while (0)
#define PG8_MMA2(ai, At) do { if constexpr (Sched::BLOCKDIAG) { if (lo_half) PG8_MMA(ai, 0, At, B0); else PG8_MMA(ai, 1, At, B1); } else { PG8_MMA(ai, 0, At, B0); PG8_MMA(ai, 1, At, B1); } } while (0)
#define PG8_WAIT_V(n) asm volatile("s_waitcnt vmcnt(" #n ")" ::: "memory")
#define PG8_WAIT_L(n) asm volatile("s_waitcnt lgkmcnt(" #n ")" ::: "memory")
#define PG8_BAR __builtin_amdgcn_s_barrier()
#define PG8_SCHED __builtin_amdgcn_sched_barrier(0)
    Unit cur, nxt; int ui = 0;
    if (!S.next(0, cur)) return;
    S.offs(cur, RA, CA, voffA);
    f32x4 acc[2][2][4][2];
#pragma unroll
    for (int a = 0; a < 2; ++a)
#pragma unroll
        for (int b = 0; b < 2; ++b)
#pragma unroll
            for (int m = 0; m < 4; ++m)
#pragma unroll
                for (int n = 0; n < 2; ++n) acc[a][b][m][n] = (f32x4){0.f, 0.f, 0.f, 0.f};
    bf16x8 At[4][2], B0[2][2], B1[2][2];
    unsigned cA = cur.a, cB = cur.b;
    PG8_STAGE_B(PG8_SB(0, 0), cB); PG8_STAGE_B(PG8_SB(0, 1), cB + hstepB); PG8_STAGE_A(PG8_SA(0, 0), cA, 0); PG8_STAGE_A(PG8_SA(0, 1), cA, 1);
    if (wr == 1) PG8_BAR;
    PG8_WAIT_V(2); PG8_BAR;
    PG8_STAGE_B(PG8_SB(1, 0), cB + kstep); PG8_STAGE_A(PG8_SA(1, 0), cA + kstep, 0); PG8_STAGE_B(PG8_SB(1, 1), cB + hstepB + kstep);
    PG8_WAIT_V(6); PG8_BAR;
    for (;;) {
        const bool has_next = S.next(ui + 1, nxt);
        const unsigned nA = has_next ? nxt.a : cA, nB = has_next ? nxt.b : cB;
        unsigned nvoff[4];
        if constexpr (Sched::GATHER) { if (has_next) S.rows(nxt, RA, nvoff); }
#pragma nounroll
        for (int t = 0; t < nt; t += 2) {
            const bool last = (t == nt - 2), lo_half = t < (nt >> 1);
            const unsigned a1 = cA + (unsigned)(t + 1) * kstep;
            const unsigned a2 = last ? nA : cA + (unsigned)(t + 2) * kstep, b2 = last ? nB : cB + (unsigned)(t + 2) * kstep;
            const unsigned a3 = a2 + kstep, b3 = b2 + kstep;
            PG8_LDB(B0, 0, 0); PG8_LDB(B1, 0, 1); PG8_SCHED; PG8_LDA(At, 0, 0); PG8_STAGE_A(PG8_SA(1, 1), a1, 1);
            PG8_WAIT_V(8); PG8_WAIT_L(0); PG8_BAR; PG8_MMA2(0, At); PG8_BAR; PG8_SCHED;
            if constexpr (Sched::GATHER) { if (last && has_next) {
#pragma unroll
                for (int q = 0; q < 4; ++q) voffA[q] = nvoff[q] * (unsigned)S.pa + (unsigned)(CA[q & 1] * 2); } }
            PG8_LDA(At, 0, 1); PG8_STAGE_B(PG8_SB(0, 0), b2); PG8_STAGE_B(PG8_SB(0, 1), b2 + hstepB); PG8_STAGE_A(PG8_SA(0, 0), a2, 0);
            PG8_WAIT_V(8); PG8_WAIT_L(0); PG8_BAR; PG8_MMA2(1, At); PG8_BAR; PG8_SCHED;
            PG8_LDB(B0, 1, 0); PG8_LDB(B1, 1, 1); PG8_SCHED; PG8_LDA(At, 1, 0); PG8_STAGE_A(PG8_SA(0, 1), a2, 1);
            PG8_WAIT_V(8); PG8_WAIT_L(0); PG8_BAR; PG8_MMA2(0, At); PG8_BAR; PG8_SCHED;
            PG8_LDA(At, 1, 1); PG8_STAGE_B(PG8_SB(1, 0), b3); PG8_STAGE_B(PG8_SB(1, 1), b3 + hstepB); PG8_STAGE_A(PG8_SA(1, 0), a3, 0);
            PG8_WAIT_V(8); PG8_WAIT_L(0); PG8_BAR; PG8_MMA2(1, At); PG8_BAR; PG8_SCHED;
        }
        if (wr == 0) PG8_BAR;
        { const int t2 = fresh_tid() & 63; E(acc, cur, wr, wc, t2 & 15, t2 >> 4, lds + LDS_EPI); }
        if (!has_next) break;
#pragma unroll
        for (int a = 0; a < 2; ++a)
#pragma unroll
            for (int b = 0; b < 2; ++b)
#pragma unroll
                for (int m = 0; m < 4; ++m)
#pragma unroll
                    for (int n = 0; n < 2; ++n) acc[a][b][m][n] = (f32x4){0.f, 0.f, 0.f, 0.f};
        cur = nxt; cA = nA; cB = nB; ++ui;
        if (wr == 1) PG8_BAR;
    }
    PG8_WAIT_V(0);
    PG8_BAR;
#undef PG8_SA
#undef PG8_SB
#undef PG8_STAGE_A
#undef PG8_STAGE_B
#undef PG8_LDA
#undef PG8_LDB
#undef PG8_MMA
#undef PG8_MMA2
#undef PG8_WAIT_V
#undef PG8_WAIT_L
#undef PG8_BAR
#undef PG8_SCHED
}

struct DenseSched {
    static constexpr bool GATHER = false, BLOCKDIAG = false;
    int nM, nN, nwg, G, c; int pa, pb; unsigned A, B;
    __device__ void init(int M, int N, int G_, int c_, size_t A_, int pa_, size_t B_, int pb_) { nM = M / BM; nN = N / BM; nwg = nM * nN; G = G_; c = c_; A = (unsigned)A_; B = (unsigned)B_; pa = pa_; pb = pb_; }
    __device__ __forceinline__ bool next(int i, Unit& u) const {
        const long L = (long)i * G + c; if (L >= nwg) return false;
        int wgid = (int)L; { const int q = nwg / NXCD, r = nwg % NXCD, xcd = wgid % NXCD, off = wgid / NXCD; wgid = (xcd < r ? xcd * (q + 1) : r * (q + 1) + (xcd - r) * q) + off; }
        const int nig = WGM * nN, gid = wgid / nig, fm = gid * WGM, gsz = (nM - fm) < WGM ? (nM - fm) : WGM;
        u.pm = fm + ((wgid % nig) % gsz); u.pn = (wgid % nig) / gsz; u.aux = 0;
        u.a = A + (unsigned)(u.pm * BM * pa); u.b = B + (unsigned)(u.pn * BM * pb); return true;
    }
    __device__ __forceinline__ void offs(const Unit&, const int (&RA)[2], const int (&CA)[2], unsigned (&v)[4]) const {
#pragma unroll
        for (int h = 0; h < 2; ++h)
#pragma unroll
            for (int i = 0; i < 2; ++i) v[h * 2 + i] = (unsigned)((h * HALF + RA[i]) * pa + CA[i] * 2);
    }
};
struct DiagSched : DenseSched { static constexpr bool BLOCKDIAG = true; };
}

struct Params { const float* in[21]; float* out; unsigned char* ws; int ph_lo, ph_hi; };
enum { I_X = 0, I_C, I_POS, I_WADA, I_BADA, I_GMIX, I_GFFN, I_WIN, I_WBG, I_QG, I_KG, I_WBD, I_WBS, I_WOUT, I_WRG, I_BRG, I_WRE, I_BRE, I_WEG, I_WEU, I_WED };

struct Frame {
    LAS unsigned char* lds;
    unsigned char* ws;
    int wave, G, bid;
};

template <bool FP8>
DI void p0_transpose_item(const float* W, int N, void* WTv, int ldt, int k0, int n0, int row_base, LAS float* scr, int lane) {
#pragma unroll 8
    for (int i = 0; i < 32; ++i) { const int kk = 2 * i + (lane >> 5); scr[kk * 33 + (lane & 31)] = W[(size_t)(k0 + kk) * N + n0 + (lane & 31)]; }
    LDS_WAIT();
    const int c = lane & 7;
#pragma unroll
    for (int j = 0; j < 4; ++j) { const int n = (lane >> 3) + 8 * j; const LAS float* sp = scr + (8 * c) * 33 + n;
        if (FP8) { u32x2 o; o.x = pk4_fp8(64.f * sp[0 * 33], 64.f * sp[1 * 33], 64.f * sp[2 * 33], 64.f * sp[3 * 33]); o.y = pk4_fp8(64.f * sp[4 * 33], 64.f * sp[5 * 33], 64.f * sp[6 * 33], 64.f * sp[7 * 33]);
            *(u32x2*)((unsigned char*)WTv + (size_t)(row_base + n) * ldt + k0 + 8 * c) = o; }
        else { u32x4 o; o.x = pk2(sp[0 * 33], sp[1 * 33]); o.y = pk2(sp[2 * 33], sp[3 * 33]); o.z = pk2(sp[4 * 33], sp[5 * 33]); o.w = pk2(sp[6 * 33], sp[7 * 33]);
            *(u32x4*)((bf16_t*)WTv + (size_t)(row_base + n) * ldt + k0 + 8 * c) = o; } }
    LDS_WAIT();
}
DI void phase0(const Frame& F, const Params& p) {
    const int tid_ = fresh_tid(), lane_ = tid_ & 63;
    LAS float* scr = (LAS float*)(F.lds + F.wave * 16384);
    const int gw = F.bid * 8 + F.wave, NGW = F.G * 8;
    bf16_t* W1 = (bf16_t*)(F.ws + WS_W1); bf16_t* WB = (bf16_t*)(F.ws + WS_WB); bf16_t* WO = (bf16_t*)(F.ws + WS_WO);
    unsigned char* WG8 = F.ws + WS_WG8; unsigned char* WGU = F.ws + WS_WGU; unsigned char* WDN = F.ws + WS_WDN;
    constexpr int I1 = 16 * 96, I2 = 16 * 64, I3 = 4 * 32, I4 = 4 * 32, I5 = 16 * 32, I6 = 32 * 256, I7 = 32 * 256, I8 = 32 * 256;
    constexpr int NITEMS = I1 + I2 + I3 + I4 + I5 + I6 + I7 + I8;
    for (int it = gw; it < NITEMS; it += NGW) {
        int r = it;
        if (r < I1) { const int kb = r / 96, nb = r % 96, n0 = 32 * nb, o0 = n0 & 255, rb = (n0 & ~255) + 128 * ((o0 >> 5) & 1) + 32 * (o0 >> 6);
            if (nb < 72) p0_transpose_item<true>(p.in[I_WIN], 3072, F.ws + WS_W1D8, 1024, 64 * kb, n0, rb, scr, lane_); else p0_transpose_item<false>(p.in[I_WIN], 3072, W1, 1024, 64 * kb, n0, rb, scr, lane_); continue; } r -= I1;
        if (r < I2) { const int kb = r / 64, nb = r % 64; p0_transpose_item<true>(p.in[I_WBG], 2048, WG8, 1024, 64 * kb, 32 * nb, 32 * nb, scr, lane_); continue; } r -= I2;
        if (r < I3) { const int kb = r / 32, nb = r % 32, n0 = 32 * nb; p0_transpose_item<true>(p.in[I_WBD], 1024, (unsigned char*)WB, 512, 64 * kb, n0, (n0 >> 7) * 256 + (n0 & 127), scr, lane_); continue; } r -= I3;
        if (r < I4) { const int kb = r / 32, nb = r % 32, n0 = 32 * nb; p0_transpose_item<true>(p.in[I_WBS], 1024, (unsigned char*)WB + 256, 512, 64 * kb, n0, (n0 >> 7) * 256 + 128 + (n0 & 127), scr, lane_); continue; } r -= I4;
        if (r < I5) { const int kb = r / 32, nb = r % 32; p0_transpose_item<true>(p.in[I_WOUT], 1024, WO, 1024, 64 * kb, 32 * nb, 32 * nb, scr, lane_); continue; } r -= I5;
        if (r < I6) { const int e = r >> 8, q = r & 255, kb = q >> 4, nb = q & 15, n0 = 32 * nb;
            p0_transpose_item<true>(p.in[I_WEG] + (size_t)e * 1024 * 512, 512, WGU + (size_t)e * 1024 * 1024, 1024, 64 * kb, n0, (n0 >> 7) * 256 + (n0 & 127), scr, lane_); continue; } r -= I6;
        if (r < I7) { const int e = r >> 8, q = r & 255, kb = q >> 4, nb = q & 15, n0 = 32 * nb;
            p0_transpose_item<true>(p.in[I_WEU] + (size_t)e * 1024 * 512, 512, WGU + (size_t)e * 1024 * 1024, 1024, 64 * kb, n0, (n0 >> 7) * 256 + 128 + (n0 & 127), scr, lane_); continue; } r -= I7;
        { const int e = r >> 8, q = r & 255, kb = q >> 5, nb = q & 31, n0 = 32 * nb, o0 = n0 & 255;
            p0_transpose_item<true>(p.in[I_WED] + (size_t)e * 512 * 1024, 1024, WDN + (size_t)e * 1024 * 512, 512, 64 * kb, n0, (n0 & ~255) + 128 * ((o0 >> 5) & 1) + 32 * (o0 >> 6), scr, lane_); }
    }
    {
        unsigned char* WBz = F.ws + WS_WB;
        for (int idx = F.bid * 512 + tid_; idx < 2048 * 16; idx += F.G * 512) { const int row = idx >> 4, c = idx & 15; *(u32x4*)(WBz + (size_t)row * 512 + ((row & 128) ? 0 : 256) + c * 16) = (u32x4){0u, 0u, 0u, 0u}; }
    }
    {
        float* modp = (float*)(F.ws + WS_MODP); const float* c = p.in[I_C]; const float* wada = p.in[I_WADA];
        for (int task = gw; task < 96 * 8; task += NGW) {
            const int ct = task % 96, ks = task / 96, k0 = ks * 128;
#pragma unroll
            for (int i = 0; i < 16; ++i) { const int idx = i * 64 + lane_, b = idx >> 7, k = idx & 127; const float v = c[b * 1024 + k0 + k]; scr[idx] = v * sigmoidf(v); }
            LDS_WAIT();
            float acc[8];
#pragma unroll
            for (int b = 0; b < 8; ++b) acc[b] = 0.f;
            const float* wp = wada + (size_t)k0 * 6144 + ct * 64 + lane_;
#pragma unroll 8
            for (int k = 0; k < 128; ++k) { const float w = wp[(size_t)k * 6144];
#pragma unroll
                for (int b = 0; b < 8; ++b) acc[b] += scr[b * 128 + k] * w; }
#pragma unroll
            for (int b = 0; b < 8; ++b) modp[((size_t)ks * 8 + b) * 6144 + ct * 64 + lane_] = acc[b];
            LDS_WAIT();
        }
    }
}

DI float inv_freq_of(int i) {
    return i == 0 ? 1.0f : i == 1 ? 0.1939227432012558f : i == 2 ? 0.03760603070259094f : i == 3 ? 0.007292664609849453f : i == 4 ? 0.0014142135623842478f : i == 5 ? 0.00027424818836152554f : i == 6 ? 5.318296098266728e-05f : 1.0313386155758053e-05f;
}
template <int WHICH>
DI void phase_norm(const Frame& F, const Params& p) {
    const int tid_ = fresh_tid(), lane_ = tid_ & 63;
    LAS float* gs = (LAS float*)(F.lds); LAS float* sh = gs + 1024;
    const float* modp = (const float*)(F.ws + WS_MODP); float* mod = (float*)(F.ws + WS_MOD); const float* bada = p.in[I_BADA];
    const float* xin = p.in[I_X]; const bf16_t* upd = (const bf16_t*)(F.ws + WS_UPD1); bf16_t* hout = (bf16_t*)(F.ws + (WHICH == 0 ? WS_H : WS_H2)); unsigned* h8 = (unsigned*)(F.ws + (WHICH == 0 ? WS_H8 : WS_H28));
    const float* gn = p.in[WHICH == 0 ? I_GMIX : I_GFFN];
    for (int chunk = F.bid; chunk < T / 256; chunk += F.G) {
        const int b = chunk >> 5;
        __syncthreads();
        if (WHICH == 0) {
            if (tid_ < 192) { const int j = (chunk & 31) * 192 + tid_; float s = bada[j];
#pragma unroll
                for (int ks = 0; ks < 8; ++ks) s += modp[((size_t)ks * 8 + b) * 6144 + j];
                mod[b * 6144 + j] = s; }
            for (int col = tid_; col < 1024; col += 512) { float s1 = bada[col], s2 = bada[1024 + col];
#pragma unroll
                for (int ks = 0; ks < 8; ++ks) { s1 += modp[((size_t)ks * 8 + b) * 6144 + col]; s2 += modp[((size_t)ks * 8 + b) * 6144 + 1024 + col]; }
                gs[col] = gn[col] * (1.f + s2); sh[col] = s1; }
        } else {
            for (int col = tid_; col < 1024; col += 512) { gs[col] = gn[col] * (1.f + mod[b * 6144 + 4096 + col]); sh[col] = mod[b * 6144 + 3072 + col]; }
        }
        __syncthreads();
        f32x4 g4[4], s4[4];
#pragma unroll
        for (int j = 0; j < 4; ++j) { g4[j] = *(const LAS f32x4*)(gs + 256 * j + 4 * lane_); s4[j] = *(const LAS f32x4*)(sh + 256 * j + 4 * lane_); }
        for (int rr = F.wave; rr < 256; rr += 8) {
            const int row = chunk * 256 + rr;
            const f32x4* xr = (const f32x4*)(xin + (size_t)row * 1024) + lane_;
            f32x4 v[4]; float ss = 0.f;
#pragma unroll
            for (int j = 0; j < 4; ++j) v[j] = xr[64 * j];
            if (WHICH == 1) { const u32x2* ur = (const u32x2*)(upd + (size_t)row * 1024) + lane_; u32x2 uu[4];
#pragma unroll
                for (int j = 0; j < 4; ++j) uu[j] = ur[64 * j];
#pragma unroll
                for (int j = 0; j < 4; ++j) { v[j].x += bf_lo(uu[j].x); v[j].y += bf_hi(uu[j].x); v[j].z += bf_lo(uu[j].y); v[j].w += bf_hi(uu[j].y); } }
#pragma unroll
            for (int j = 0; j < 4; ++j) ss += (v[j].x * v[j].x + v[j].y * v[j].y) + (v[j].z * v[j].z + v[j].w * v[j].w);
            const float rinv = __builtin_amdgcn_rsqf(wave_sum(ss) * (1.f / 1024.f) + RMS_EPS);
            u32x2* o8 = (u32x2*)(hout + (size_t)row * 1024) + lane_;
#pragma unroll
            for (int j = 0; j < 4; ++j) { const f32x4 y = v[j] * rinv * g4[j] + s4[j]; u32x2 o; o.x = pk2(y.x, y.y); o.y = pk2(y.z, y.w); o8[64 * j] = o; h8[(size_t)row * 256 + 64 * j + lane_] = pk4_fp8(y.x, y.y, y.z, y.w); }
            if (WHICH == 0 && lane_ < 8) {
                const int pos = ((const int*)p.in[I_POS])[row];
                const float angf = (float)pos * inv_freq_of(lane_);
                double rv = (double)angf * 0.15915494309189535; rv -= __builtin_rint(rv);
                const float fr = (float)rv;
                bf16_t* rp = (bf16_t*)(F.ws + WS_ROPE) + (size_t)row * 16;
                rp[lane_] = (bf16_t)(pk2(__builtin_amdgcn_cosf(fr), 0.f) & 0xffffu); rp[8 + lane_] = (bf16_t)(pk2(__builtin_amdgcn_sinf(fr), 0.f) & 0xffffu);
            }
        }
    }
}

template <bool GATES> struct EpiProj {
    static constexpr bool PERM = true;
    bf16_t* proj; bf16_t* gates; const bf16_t* rope; const float* qg; const float* kg; int pn0;
    DI void operator()(const f32x4 (&acc)[2][2][4][2], const pg8::Unit& u, int wr, int wc, int fr, int fq, LAS unsigned char* scr) const {
        asm volatile("" : "+v"(fr), "+v"(fq));
        const int pn = u.pn + pn0, row0 = u.pm * 256 + wr * 64 + fr, cw = wc * 32 + 8 * fq;
        const int typ = pn < 9 ? pn / 3 : pn - 9, grp = pn < 9 ? pn % 3 : 0, l2d = pn < 9 ? 2 * grp : 0, hbase = pn < 9 ? grp * 4 : 12;
        if (GATES) {
            unsigned char* base = (unsigned char*)gates + (size_t)(u.pm * 8 + pn) * 65536 + (size_t)(((wr * 4 + wc) * 64 + fq * 16 + fr) * 8);
#pragma unroll
            for (int ai = 0; ai < 2; ++ai)
#pragma unroll
                for (int m = 0; m < 4; ++m)
#pragma unroll
                    for (int bj = 0; bj < 2; ++bj) { const f32x4 v0 = acc[ai][bj][m][0], v1 = acc[ai][bj][m][1];
                        u32x2 w; w.x = pk4_fp8(v0.x, v0.y, v0.z, v0.w); w.y = pk4_fp8(v1.x, v1.y, v1.z, v1.w);
                        *(u32x2*)(base + ((ai * 4 + m) * 2 + bj) * 4096) = w; }
        } else if (pn >= 6 || pn < 3) {
            const float sc = pn == 9 ? QSCALE : 1.f;
            const int head = hbase + wc;
#pragma unroll
            for (int ai = 0; ai < 2; ++ai)
#pragma unroll
                for (int m = 0; m < 4; ++m) { const int t = row0 + ai * 128 + m * 16, sq = t & (S - 1); const int rp = (t & ~(S - 1)) + ((sq & ((1 << l2d) - 1)) << (13 - l2d)) + (sq >> l2d);
                    bf16_t* rowp = proj + ((size_t)(typ * 16 + head) * T + rp) * 64 + 8 * fq;
#pragma unroll
                    for (int bj = 0; bj < 2; ++bj) { const f32x4 v0 = acc[ai][bj][m][0] * sc, v1 = acc[ai][bj][m][1] * sc;
                        u32x4 w; w.x = pk2(v0.x, v0.y); w.y = pk2(v0.z, v0.w); w.z = pk2(v1.x, v1.y); w.w = pk2(v1.z, v1.w);
                        *(u32x4*)(rowp + 32 * bj) = w; } }
        } else {
            const int head = hbase + wc;
            const f32x4 g0 = *(const f32x4*)(kg + 8 * fq), g1 = *(const f32x4*)(kg + 8 * fq + 4), g2 = *(const f32x4*)(kg + 32 + 8 * fq), g3 = *(const f32x4*)(kg + 32 + 8 * fq + 4);
#pragma unroll
            for (int ai = 0; ai < 2; ++ai) {
                u32x4 rcs[4][2];
#pragma unroll
                for (int m = 0; m < 4; ++m) { const u32x4* rpt = (const u32x4*)(rope + (size_t)(u.pm * 256 + ai * 128 + wr * 64 + m * 16 + fr) * 16); rcs[m][0] = rpt[0]; rcs[m][1] = rpt[1]; }
                __builtin_amdgcn_sched_barrier(0);
#pragma unroll
                for (int m = 0; m < 4; ++m) { const int row = u.pm * 256 + ai * 128 + wr * 64 + m * 16 + fr, sq = row & (S - 1);
                    const int rp = (row & ~(S - 1)) + ((sq & ((1 << l2d) - 1)) << (13 - l2d)) + (sq >> l2d);
                    const f32x4 a0 = acc[ai][0][m][0], a1 = acc[ai][0][m][1], b0 = acc[ai][1][m][0], b1 = acc[ai][1][m][1];
                    float ss = ((a0.x * a0.x + a0.y * a0.y) + (a0.z * a0.z + a0.w * a0.w)) + ((a1.x * a1.x + a1.y * a1.y) + (a1.z * a1.z + a1.w * a1.w))
                             + ((b0.x * b0.x + b0.y * b0.y) + (b0.z * b0.z + b0.w * b0.w)) + ((b1.x * b1.x + b1.y * b1.y) + (b1.z * b1.z + b1.w * b1.w));
                    { const unsigned sb_ = __builtin_bit_cast(unsigned, ss); auto r = __builtin_amdgcn_permlane16_swap(sb_, sb_, false, false); const unsigned r0 = r[0], r1 = r[1]; ss = __builtin_bit_cast(float, r0) + __builtin_bit_cast(float, r1); }
                    { const unsigned sb_ = __builtin_bit_cast(unsigned, ss); auto r = __builtin_amdgcn_permlane32_swap(sb_, sb_, false, false); const unsigned r0 = r[0], r1 = r[1]; ss = __builtin_bit_cast(float, r0) + __builtin_bit_cast(float, r1); }
                    const float rinv = __builtin_amdgcn_rsqf(ss * (1.f / 64.f) + RMS_EPS);
                    f32x4 v0 = a0 * (g0 * rinv), v1 = a1 * (g1 * rinv); const f32x4 v2 = b0 * (g2 * rinv), v3 = b1 * (g3 * rinv);
                    f32x4 c0 = {1.f, 1.f, 1.f, 1.f}, c1 = c0, s0 = {0.f, 0.f, 0.f, 0.f}, s1 = s0;
                    if (fq < 2) { const u32x4 cc = rcs[m][0], sn = rcs[m][1];
                        c0 = (f32x4){bf_lo(cc.x), bf_hi(cc.x), bf_lo(cc.y), bf_hi(cc.y)}; c1 = (f32x4){bf_lo(cc.z), bf_hi(cc.z), bf_lo(cc.w), bf_hi(cc.w)};
                        s0 = (f32x4){bf_lo(sn.x), bf_hi(sn.x), bf_lo(sn.y), bf_hi(sn.y)}; s1 = (f32x4){bf_lo(sn.z), bf_hi(sn.z), bf_lo(sn.w), bf_hi(sn.w)};
                        if (fq == 0) { s0 = -s0; s1 = -s1; } }
                    f32x4 p0, p1;
#define KX16(x) ([&] { const unsigned b_ = __builtin_bit_cast(unsigned, (float)(x)); auto r = __builtin_amdgcn_permlane16_swap(b_, b_, false, false); const unsigned r0 = r[0], r1 = r[1]; return __builtin_bit_cast(float, (fq & 1) ? r0 : r1); }())
                    p0.x = KX16(v0.x); p0.y = KX16(v0.y); p0.z = KX16(v0.z); p0.w = KX16(v0.w);
                    p1.x = KX16(v1.x); p1.y = KX16(v1.y); p1.z = KX16(v1.z); p1.w = KX16(v1.w);
#undef KX16
                    v0 = v0 * c0 + p0 * s0; v1 = v1 * c1 + p1 * s1;
                    bf16_t* rowp = proj + ((size_t)(typ * 16 + head) * T + rp) * 64 + 8 * fq;
                    u32x4 w; w.x = pk2(v0.x, v0.y); w.y = pk2(v0.z, v0.w); w.z = pk2(v1.x, v1.y); w.w = pk2(v1.z, v1.w);
                    *(u32x4*)rowp = w;
                    w.x = pk2(v2.x, v2.y); w.y = pk2(v2.z, v2.w); w.z = pk2(v3.x, v3.y); w.w = pk2(v3.z, v3.w);
                    *(u32x4*)(rowp + 32) = w; }
            }
        }
    }
};

struct EpiBranch {
    static constexpr bool PERM = true;
    const unsigned char* gates; unsigned char* merged;
    DI void operator()(const f32x4 (&acc)[2][2][4][2], const pg8::Unit& u, int wr, int wc, int fr, int fq, LAS unsigned char*) const {
        asm volatile("" : "+v"(fr), "+v"(fq));
        const int row0 = u.pm * 256 + wr * 64 + fr, col0 = u.pn * 128 + wc * 32 + 8 * fq;
        const unsigned char* gbase = gates + (size_t)(u.pm * 8 + (u.pn >> 1)) * 65536 + (size_t)((u.pn & 1) * 4096) + (size_t)(((wr * 4 + wc) * 64 + fq * 16 + fr) * 8);
        u32x2 gd[2][4], gs[2][4];
#pragma unroll
        for (int ai = 0; ai < 2; ++ai)
#pragma unroll
            for (int m = 0; m < 4; ++m) { const unsigned char* gp = gbase + ((ai * 4 + m) * 2) * 4096;
                gd[ai][m] = *(const u32x2*)gp; gs[ai][m] = *(const u32x2*)(gp + 4 * 65536); }
        __builtin_amdgcn_sched_barrier(0);
#pragma unroll
        for (int ai = 0; ai < 2; ++ai)
#pragma unroll
            for (int m = 0; m < 4; ++m) { const size_t row = (size_t)(row0 + ai * 128 + m * 16);
                const u32x2 g = gd[ai][m], q = gs[ai][m];
                const f32x2 ga = fp8_lo2(g.x), gb = fp8_hi2(g.x), gc = fp8_lo2(g.y), gdd = fp8_hi2(g.y), qa = fp8_lo2(q.x), qb = fp8_hi2(q.x), qc = fp8_lo2(q.y), qd = fp8_hi2(q.y);
                const f32x4 v0 = acc[ai][0][m][0] * (f32x4){sigmoidf(ga.x), sigmoidf(ga.y), sigmoidf(gb.x), sigmoidf(gb.y)} + acc[ai][1][m][0] * (f32x4){sigmoidf(qa.x), sigmoidf(qa.y), sigmoidf(qb.x), sigmoidf(qb.y)};
                const f32x4 v1 = acc[ai][0][m][1] * (f32x4){sigmoidf(gc.x), sigmoidf(gc.y), sigmoidf(gdd.x), sigmoidf(gdd.y)} + acc[ai][1][m][1] * (f32x4){sigmoidf(qc.x), sigmoidf(qc.y), sigmoidf(qd.x), sigmoidf(qd.y)};
                u32x2 w; w.x = pk4_fp8(8.f * v0.x, 8.f * v0.y, 8.f * v0.z, 8.f * v0.w); w.y = pk4_fp8(8.f * v1.x, 8.f * v1.y, 8.f * v1.z, 8.f * v1.w);
                *(u32x2*)(merged + row * 1024 + col0) = w; }
    }
};
struct BranchSched {
    static constexpr bool GATHER = false;
    int G, c; int pa, pb; unsigned A, B;
    DI bool next(int i, pg8::Unit& u) const {
        const int tile = (i >> 1) * G + c; if (tile >= 256 * 4) return false;
        u.pm = tile >> 2; u.pn = tile & 3; u.aux = i & 1;
        u.a = A + (unsigned)(u.pm * 256 * LDO * 2 + u.aux * 256 * 2); u.b = B + (unsigned)(u.aux * 1024 * 256 * 2 + u.pn * 256 * 256 * 2); return true;
    }
    DI void offs(const pg8::Unit&, const int (&RA)[2], const int (&CA)[2], unsigned (&v)[4]) const {
#pragma unroll
        for (int h = 0; h < 2; ++h)
#pragma unroll
            for (int i = 0; i < 2; ++i) v[h * 2 + i] = (unsigned)((h * 128 + RA[i]) * pa + CA[i] * 2);
    }
};

struct EpiOut {
    static constexpr bool PERM = true;
    bf16_t* upd; const float* mod;
    DI void operator()(const f32x4 (&acc)[2][2][4][2], const pg8::Unit& u, int wr, int wc, int fr, int fq, LAS unsigned char*) const {
        asm volatile("" : "+v"(fr), "+v"(fq));
        const int row0 = u.pm * 256 + wr * 64 + fr, col0 = u.pn * 256 + wc * 32 + 8 * fq; const int b = (u.pm * 256) >> 13;
        f32x4 gv[2][2];
#pragma unroll
        for (int bj = 0; bj < 2; ++bj)
#pragma unroll
            for (int n = 0; n < 2; ++n) gv[bj][n] = *(const f32x4*)(mod + b * 6144 + 2048 + col0 + bj * 128 + n * 4) * 0.125f;
#pragma unroll
        for (int ai = 0; ai < 2; ++ai)
#pragma unroll
            for (int m = 0; m < 4; ++m)
#pragma unroll
                for (int bj = 0; bj < 2; ++bj) { const f32x4 v0 = acc[ai][bj][m][0] * gv[bj][0], v1 = acc[ai][bj][m][1] * gv[bj][1];
                    u32x4 w; w.x = pk2(v0.x, v0.y); w.y = pk2(v0.z, v0.w); w.z = pk2(v1.x, v1.y); w.w = pk2(v1.z, v1.w);
                    *(u32x4*)(upd + (size_t)(row0 + ai * 128 + m * 16) * 1024 + col0 + bj * 128) = w; }
    }
};

struct EpiLogit {
    static constexpr bool PERM = false;
    float* logit;
    DI void operator()(const f32x4 (&acc)[2][2][4][2], const pg8::Unit& u, int wr, int wc, int fr, int fq, LAS unsigned char*) const {
        asm volatile("" : "+v"(fr), "+v"(fq));
        const int row0 = u.pm * 256 + wr * 64 + fr, col0 = wc * 32 + 4 * fq;
#pragma unroll
        for (int ai = 0; ai < 2; ++ai)
#pragma unroll
            for (int m = 0; m < 4; ++m)
#pragma unroll
                for (int n = 0; n < 2; ++n) *(f32x4*)(logit + (size_t)(row0 + ai * 128 + m * 16) * 128 + col0 + n * 16) = acc[ai][0][m][n];
    }
};

struct MoeSched {
    static constexpr bool GATHER_ = true;
    int G, c, nc; int pa, pb; unsigned A, B; const LAS int* cstart; const int* slot_tok; unsigned estride, pnstride;
};
struct MoeSchedUp : MoeSched {
    static constexpr bool GATHER = true, BLOCKDIAG = false;
    DI bool next(int i, pg8::Unit& u) const {
        const int L = i * G + c; if (L >= nc * 4) return false;
        const int chunk = L >> 2; int e = 0;
        for (int q = 1; q < 32; ++q) e += (chunk >= cstart[q]) ? 1 : 0;
        e = __builtin_amdgcn_readfirstlane(e);
        u.pm = chunk; u.pn = L & 3; u.aux = e; u.a = A; u.b = B + (unsigned)e * estride + (unsigned)u.pn * pnstride; return true;
    }
    DI void offs(const pg8::Unit& u, const int (&RA)[2], const int (&CA)[2], unsigned (&v)[4]) const {
#pragma unroll
        for (int h = 0; h < 2; ++h)
#pragma unroll
            for (int i = 0; i < 2; ++i) { const int tok = slot_tok[u.pm * 256 + h * 128 + RA[i]]; v[h * 2 + i] = (unsigned)(tok * pa + CA[i] * 2); }
    }
    DI void rows(const pg8::Unit& u, const int (&RA)[2], unsigned (&v)[4]) const {
#pragma unroll
        for (int h = 0; h < 2; ++h)
#pragma unroll
            for (int i = 0; i < 2; ++i) v[h * 2 + i] = (unsigned)slot_tok[u.pm * 256 + h * 128 + RA[i]];
    }
};
struct MoeSchedDn : MoeSched {
    static constexpr bool GATHER = false, BLOCKDIAG = false;
    DI bool next(int i, pg8::Unit& u) const {
        const int L = i * G + c; if (L >= nc * 4) return false;
        const int chunk = L >> 2; int e = 0;
        for (int q = 1; q < 32; ++q) e += (chunk >= cstart[q]) ? 1 : 0;
        e = __builtin_amdgcn_readfirstlane(e);
        u.pm = chunk; u.pn = L & 3; u.aux = e; u.a = A + (unsigned)(chunk * 256 * pa); u.b = B + (unsigned)e * estride + (unsigned)u.pn * pnstride; return true;
    }
    DI void offs(const pg8::Unit&, const int (&RA)[2], const int (&CA)[2], unsigned (&v)[4]) const {
#pragma unroll
        for (int h = 0; h < 2; ++h)
#pragma unroll
            for (int i = 0; i < 2; ++i) v[h * 2 + i] = (unsigned)((h * 128 + RA[i]) * pa + CA[i] * 2);
    }
};
struct EpiSwiglu {
    static constexpr bool PERM = true;
    unsigned char* hmid;
    DI void operator()(const f32x4 (&acc)[2][2][4][2], const pg8::Unit& u, int wr, int wc, int fr, int fq, LAS unsigned char*) const {
        asm volatile("" : "+v"(fr), "+v"(fq));
        const int row0 = u.pm * 256 + wr * 64 + fr, col0 = u.pn * 128 + wc * 32 + 8 * fq;
#pragma unroll
        for (int ai = 0; ai < 2; ++ai)
#pragma unroll
            for (int m = 0; m < 4; ++m) {
                f32x4 h[2];
#pragma unroll
                for (int n = 0; n < 2; ++n) { const f32x4 g = acc[ai][0][m][n], up = acc[ai][1][m][n];
                    h[n] = (f32x4){g.x * sigmoidf(g.x) * up.x, g.y * sigmoidf(g.y) * up.y, g.z * sigmoidf(g.z) * up.z, g.w * sigmoidf(g.w) * up.w}; }
                u32x2 w; w.x = pk4_fp8(h[0].x, h[0].y, h[0].z, h[0].w); w.y = pk4_fp8(h[1].x, h[1].y, h[1].z, h[1].w);
                *(u32x2*)(hmid + (size_t)(row0 + ai * 128 + m * 16) * DE + col0) = w; }
    }
};
struct EpiDown {
    static constexpr bool PERM = true;
    unsigned char* y;
    DI void operator()(const f32x4 (&acc)[2][2][4][2], const pg8::Unit& u, int wr, int wc, int fr, int fq, LAS unsigned char*) const {
        asm volatile("" : "+v"(fr), "+v"(fq));
        const int row0 = u.pm * 256 + wr * 64 + fr, col0 = u.pn * 256 + wc * 64 + (fq & 1) * 32 + (fq >> 1) * 16;
#pragma unroll
        for (int ai = 0; ai < 2; ++ai)
#pragma unroll
            for (int m = 0; m < 4; ++m) { const int slot = row0 + ai * 128 + m * 16;
                u32x2 o[2];
#pragma unroll
                for (int bj = 0; bj < 2; ++bj) { const f32x4 v0 = acc[ai][bj][m][0] * 8.f, v1 = acc[ai][bj][m][1] * 8.f; o[bj].x = pk4_fp8(v0.x, v0.y, v0.z, v0.w); o[bj].y = pk4_fp8(v1.x, v1.y, v1.z, v1.w); }
                u32x4 w;
                { auto r = __builtin_amdgcn_permlane16_swap(o[0].x, o[1].x, false, false); w.x = r[0]; w.z = r[1]; }
                { auto r = __builtin_amdgcn_permlane16_swap(o[0].y, o[1].y, false, false); w.y = r[0]; w.w = r[1]; }
                *(u32x4*)(y + (size_t)slot * 1024 + col0) = w; }
    }
};

constexpr int SLOT_BYTES = 8192;
DI f32x16 mfma32(bf16x8 a, bf16x8 b, f32x16 c) { return __builtin_amdgcn_mfma_f32_32x32x16_bf16(a, b, c, 0, 0, 0); }
DI int swz_f(int r) { return (((r >> 1) & 1) << 2) | ((r >> 2) & 3); }
struct AttnLane { unsigned doff[4]; unsigned ka[4]; unsigned va[2][2]; };
DI void attn_lane_init(AttnLane& L, int lane) {
#pragma unroll
    for (int i = 0; i < 4; ++i) { const int r = 8 * i + (lane >> 3), c = (lane & 7) ^ swz_f(r); L.doff[i] = (unsigned)(r * 128 + c * 16); }
    { const int r = lane & 31, h = lane >> 5; const unsigned a0 = (unsigned)(r * 128 + 16 * ((h ^ swz_f(r)) & 7));
#pragma unroll
      for (int s = 0; s < 4; ++s) L.ka[s] = a0 ^ (unsigned)(32 * s); }
    { const int h = lane >> 5, blk = (lane >> 4) & 1, q = (lane & 15) >> 2, p = lane & 3, fb2 = (q >> 1) & 1;
#pragma unroll
      for (int t = 0; t < 2; ++t) { const int flow = (2 * t + h) & 3;
#pragma unroll
        for (int mt = 0; mt < 2; ++mt) L.va[t][mt] = (unsigned)(4096 + (8 * t + 4 * h + q) * 128 + 16 * (4 * (mt ^ fb2) + ((2 * blk + (p >> 1)) ^ flow)) + 8 * (p & 1)); } }
}
DI void dma_tile(const AttnLane& L, const __amdgpu_buffer_rsrc_t rs, unsigned koff, unsigned voff, LAS unsigned char* slot) {
#pragma unroll
    for (int i = 0; i < 4; ++i) __builtin_amdgcn_raw_ptr_buffer_load_lds(rs, (LAS unsigned*)(slot + 1024 * i), 16, (int)L.doff[i], (int)koff, 0, 0);
#pragma unroll
    for (int i = 0; i < 4; ++i) __builtin_amdgcn_raw_ptr_buffer_load_lds(rs, (LAS unsigned*)(slot + 4096 + 1024 * i), 16, (int)L.doff[i], (int)voff, 0, 0);
}
DI void tr_read8(const AttnLane& L, unsigned sb, bf16x8 (&vf)[2][2]) {
    s16x4 r0, r1, r2, r3, r4, r5, r6, r7;
    const unsigned a00 = sb + L.va[0][0], a10 = sb + L.va[1][0], a01 = sb + L.va[0][1], a11 = sb + L.va[1][1];
    asm volatile("ds_read_b64_tr_b16 %0, %8\n\tds_read_b64_tr_b16 %1, %9\n\tds_read_b64_tr_b16 %2, %8 offset:2048\n\tds_read_b64_tr_b16 %3, %9 offset:2048\n\t"
                 "ds_read_b64_tr_b16 %4, %10\n\tds_read_b64_tr_b16 %5, %11\n\tds_read_b64_tr_b16 %6, %10 offset:2048\n\tds_read_b64_tr_b16 %7, %11 offset:2048\n\ts_waitcnt lgkmcnt(0)"
                 : "=&v"(r0), "=&v"(r1), "=&v"(r2), "=&v"(r3), "=&v"(r4), "=&v"(r5), "=&v"(r6), "=&v"(r7)
                 : "v"(a00), "v"(a10), "v"(a01), "v"(a11) : "memory");
    vf[0][0] = __builtin_shufflevector(r0, r1, 0, 1, 2, 3, 4, 5, 6, 7); vf[0][1] = __builtin_shufflevector(r2, r3, 0, 1, 2, 3, 4, 5, 6, 7);
    vf[1][0] = __builtin_shufflevector(r4, r5, 0, 1, 2, 3, 4, 5, 6, 7); vf[1][1] = __builtin_shufflevector(r6, r7, 0, 1, 2, 3, 4, 5, 6, 7);
}
DI bf16x8 pack8(const f32x16& x, int s) {
    u32x4 p; p.x = pk2(x[8 * s], x[8 * s + 1]); p.y = pk2(x[8 * s + 2], x[8 * s + 3]); p.z = pk2(x[8 * s + 4], x[8 * s + 5]); p.w = pk2(x[8 * s + 6], x[8 * s + 7]);
    return __builtin_bit_cast(bf16x8, p);
}
DI void store_o_row(bf16_t* rowp, const f32x16& O0, const f32x16& O1, float sc, int h) {
#pragma unroll
    for (int mt = 0; mt < 2; ++mt)
#pragma unroll
        for (int kp = 0; kp < 2; ++kp) { const f32x16& O = mt ? O1 : O0; const int g0 = 8 * kp, g1 = 8 * kp + 4;
            u32x2 a, b; a.x = pk2(O[g0] * sc, O[g0 + 1] * sc); a.y = pk2(O[g0 + 2] * sc, O[g0 + 3] * sc); b.x = pk2(O[g1] * sc, O[g1 + 1] * sc); b.y = pk2(O[g1 + 2] * sc, O[g1 + 3] * sc);
            { auto r = __builtin_amdgcn_permlane32_swap(a.x, b.x, false, false); a.x = r[0]; b.x = r[1]; }
            { auto r = __builtin_amdgcn_permlane32_swap(a.y, b.y, false, false); a.y = r[0]; b.y = r[1]; }
            *(u32x4*)(rowp + 32 * mt + 16 * kp + 8 * h) = (u32x4){a.x, a.y, b.x, b.y}; }
}
DI void store_o_row_fp8(unsigned char* rowp, const f32x16& O0, const f32x16& O1, int h) {
#pragma unroll
    for (int mt = 0; mt < 2; ++mt)
#pragma unroll
        for (int kp = 0; kp < 2; ++kp) { const f32x16& O = mt ? O1 : O0; const int g0 = 8 * kp, g1 = 8 * kp + 4;
            unsigned a = pk4_fp8(O[g0], O[g0 + 1], O[g0 + 2], O[g0 + 3]), b = pk4_fp8(O[g1], O[g1 + 1], O[g1 + 2], O[g1 + 3]);
            { auto r = __builtin_amdgcn_permlane32_swap(a, b, false, false); a = r[0]; b = r[1]; }
            *(u32x2*)(rowp + 32 * mt + 16 * kp + 8 * h) = (u32x2){a, b}; }
}
#define ATTN_WAIT_TILE(more) do { if (more) asm volatile("s_waitcnt vmcnt(8)" ::: "memory"); else asm volatile("s_waitcnt vmcnt(0)" ::: "memory"); } while (0)
DI void dil_tile(const AttnLane& L, const __amdgpu_buffer_rsrc_t rs, const bf16_t* hb, int hd, long row0, int j, LAS unsigned char* ldsW, bf16_t* og, float* lse, int lane, const float (&gq)[32], const bf16_t* ropet, long tok0, int dil) {
    const int qi = lane & 31, h = lane >> 5;
    const bf16_t* qh = hb + (size_t)hd * T * 64;
    const unsigned kh = (unsigned)(WS_PROJ + ((size_t)(16 + hd) * T + row0) * 128), vh = (unsigned)(WS_PROJ + ((size_t)(32 + hd) * T + row0) * 128);
    bf16x8 qf[4];
    {
        const bf16_t* qp = qh + (size_t)(row0 + 32 * j + qi) * 64 + 8 * h;
        u32x4 qr[4];
#pragma unroll
        for (int s = 0; s < 4; ++s) qr[s] = *(const u32x4*)(qp + 16 * s);
        const u32x4* rpt = (const u32x4*)(ropet + (size_t)(tok0 + (long)dil * (32 * j + qi)) * 16); const u32x4 cc = rpt[0], sn = rpt[1];
        float qv[4][8]; float ss = 0.f;
#pragma unroll
        for (int s = 0; s < 4; ++s) { const u32x4 u = qr[s]; qv[s][0] = bf_lo(u.x); qv[s][1] = bf_hi(u.x); qv[s][2] = bf_lo(u.y); qv[s][3] = bf_hi(u.y); qv[s][4] = bf_lo(u.z); qv[s][5] = bf_hi(u.z); qv[s][6] = bf_lo(u.w); qv[s][7] = bf_hi(u.w);
#pragma unroll
            for (int e = 0; e < 8; ++e) ss += qv[s][e] * qv[s][e]; }
        ss += __shfl_xor(ss, 32);
        const float rinv = __builtin_amdgcn_rsqf(ss * (1.f / 64.f) + RMS_EPS) * QSCALE;
#pragma unroll
        for (int s = 0; s < 4; ++s)
#pragma unroll
            for (int e = 0; e < 8; ++e) qv[s][e] *= rinv * gq[s * 8 + e];
        { const float cs[8] = {bf_lo(cc.x), bf_hi(cc.x), bf_lo(cc.y), bf_hi(cc.y), bf_lo(cc.z), bf_hi(cc.z), bf_lo(cc.w), bf_hi(cc.w)};
          const float sv[8] = {bf_lo(sn.x), bf_hi(sn.x), bf_lo(sn.y), bf_hi(sn.y), bf_lo(sn.z), bf_hi(sn.z), bf_lo(sn.w), bf_hi(sn.w)};
#pragma unroll
          for (int e = 0; e < 8; ++e) { const float other = __shfl_xor(qv[0][e], 32); qv[0][e] = qv[0][e] * cs[e] + other * (h ? sv[e] : -sv[e]); } }
#pragma unroll
        for (int s = 0; s < 4; ++s) { u32x4 o; o.x = pk2(qv[s][0], qv[s][1]); o.y = pk2(qv[s][2], qv[s][3]); o.z = pk2(qv[s][4], qv[s][5]); o.w = pk2(qv[s][6], qv[s][7]); qf[s] = __builtin_bit_cast(bf16x8, o); }
    }
    float mrun = -INFINITY, lrun = 0.f;
    f32x16 O0, O1;
#pragma unroll
    for (int i = 0; i < 16; ++i) { O0[i] = 0.f; O1[i] = 0.f; }
    const int kt0 = j >= 4 ? j - 4 : 0;
    dma_tile(L, rs, kh + (unsigned)(4096 * kt0), vh + (unsigned)(4096 * kt0), ldsW);
    unsigned buf = 0;
    for (int kt = kt0; kt <= j; ++kt) {
        const bool more = kt < j;
        if (more) dma_tile(L, rs, kh + (unsigned)(4096 * (kt + 1)), vh + (unsigned)(4096 * (kt + 1)), ldsW + (buf ^ 1u) * SLOT_BYTES);
        ATTN_WAIT_TILE(more);
        LAS unsigned char* slot = ldsW + buf * SLOT_BYTES;
        f32x16 sc;
#pragma unroll
        for (int i = 0; i < 16; ++i) sc[i] = 0.f;
#pragma unroll
        for (int s = 0; s < 4; ++s) { const bf16x8 kf = *(const LAS bf16x8*)(slot + L.ka[s]); sc = mfma32(kf, qf[s], sc); }
        if (kt == j) {
#pragma unroll
            for (int i = 0; i < 16; ++i) { const int key = (i & 3) + 8 * (i >> 2) + 4 * h; if (key > qi) sc[i] = -INFINITY; }
        }
        if (kt == j - 4) {
#pragma unroll
            for (int i = 0; i < 16; ++i) { const int key = (i & 3) + 8 * (i >> 2) + 4 * h; if (key < qi) sc[i] = -INFINITY; }
        }
        float mx = sc[0];
#pragma unroll
        for (int i = 1; i < 16; ++i) mx = fmaxf(mx, sc[i]);
        mx = fmaxf(mx, __shfl_xor(mx, 32));
        const float mnew = fmaxf(mrun, mx), alpha = fexp2(mrun - mnew);
        float ps = 0.f;
#pragma unroll
        for (int i = 0; i < 16; ++i) { sc[i] = fexp2(sc[i] - mnew); ps += sc[i]; }
        lrun = lrun * alpha + ps; mrun = mnew;
#pragma unroll
        for (int i = 0; i < 16; ++i) { O0[i] *= alpha; O1[i] *= alpha; }
        const bf16x8 p0 = pack8(sc, 0), p1 = pack8(sc, 1);
        bf16x8 vf[2][2]; tr_read8(L, (unsigned)(size_t)slot, vf);
        O0 = mfma32(vf[0][0], p0, O0); O0 = mfma32(vf[0][1], p1, O0);
        O1 = mfma32(vf[1][0], p0, O1); O1 = mfma32(vf[1][1], p1, O1);
        buf ^= 1u;
    }
    const float ltot = lrun + __shfl_xor(lrun, 32), inv = frcp(ltot);
    const size_t row = (size_t)(row0 + 32 * j + qi);
    store_o_row(og + row * 64, O0, O1, inv, h);
    if (h == 0) lse[row] = mrun + flog2(ltot);
}
DI void sb_tile(const AttnLane& L, const __amdgpu_buffer_rsrc_t rs, const bf16_t* hb, int b, int h4, int j, LAS unsigned char* ldsW, unsigned char* ocat, int lane) {
    const int qi = lane & 31, h = lane >> 5;
    const long base = (long)b * S;
    const bf16_t* qh = hb + (size_t)(12 + h4) * T * 64;
    const unsigned kh = (unsigned)(WS_PROJ + ((size_t)(16 + 12 + h4) * T + base) * 128), vh = (unsigned)(WS_PROJ + ((size_t)(32 + 12 + h4) * T + base) * 128);
    bf16x8 qf[4];
    { const bf16_t* qp = qh + (size_t)(base + 32 * j + qi) * 64 + 8 * h;
#pragma unroll
      for (int s = 0; s < 4; ++s) qf[s] = *(const bf16x8*)(qp + 16 * s); }
    float carry = 0.f;
    f32x16 O0, O1;
#pragma unroll
    for (int i = 0; i < 16; ++i) { O0[i] = 0.f; O1[i] = 0.f; }
    dma_tile(L, rs, kh + (unsigned)(4096 * j), vh + (unsigned)(4096 * j), ldsW);
    unsigned buf = 0;
    for (int kt = j; kt >= 0; --kt) {
        const bool more = kt > 0;
        if (more) dma_tile(L, rs, kh + (unsigned)(4096 * (kt - 1)), vh + (unsigned)(4096 * (kt - 1)), ldsW + (buf ^ 1u) * SLOT_BYTES);
        ATTN_WAIT_TILE(more);
        LAS unsigned char* slot = ldsW + buf * SLOT_BYTES;
        f32x16 z;
#pragma unroll
        for (int i = 0; i < 16; ++i) z[i] = 0.f;
#pragma unroll
        for (int s = 0; s < 4; ++s) { const bf16x8 kf = *(const LAS bf16x8*)(slot + L.ka[s]); z = mfma32(kf, qf[s], z); }
#pragma unroll
        for (int i = 0; i < 16; ++i) z[i] = fexp2(fminf(z[i], 31.f));
        if (kt == j) {
#pragma unroll
            for (int i = 0; i < 16; ++i) { const int key = (i & 3) + 8 * (i >> 2) + 4 * h; if (key >= qi) z[i] = 0.f; }
        }
        float lg[4], par[4], u0[4], p01[4], p012[4];
#pragma unroll
        for (int g = 0; g < 4; ++g) { const float a0 = 1.f + z[4 * g], a1 = 1.f + z[4 * g + 1], a2 = 1.f + z[4 * g + 2], a3 = 1.f + z[4 * g + 3];
            u0[g] = a0; p01[g] = a0 * a1; p012[g] = p01[g] * a2; lg[g] = -flog2(p012[g] * a3); }
#pragma unroll
        for (int g = 0; g < 4; ++g) par[g] = __shfl_xor(lg[g], 32);
        float tg[4]; tg[3] = carry; tg[2] = tg[3] + (lg[3] + par[3]); tg[1] = tg[2] + (lg[2] + par[2]); tg[0] = tg[1] + (lg[1] + par[1]);
        carry = tg[0] + (lg[0] + par[0]);
#pragma unroll
        for (int g = 0; g < 4; ++g) { const float suf = tg[g] + lg[g] + (h == 0 ? par[g] : 0.f); const float y = fexp2(suf);
            z[4 * g] = z[4 * g] * y; z[4 * g + 1] = z[4 * g + 1] * (y * u0[g]); z[4 * g + 2] = z[4 * g + 2] * (y * p01[g]); z[4 * g + 3] = z[4 * g + 3] * (y * p012[g]); }
        const bf16x8 p0 = pack8(z, 0), p1 = pack8(z, 1);
        bf16x8 vf[2][2]; tr_read8(L, (unsigned)(size_t)slot, vf);
        O0 = mfma32(vf[0][0], p0, O0); O0 = mfma32(vf[0][1], p1, O0);
        O1 = mfma32(vf[1][0], p0, O1); O1 = mfma32(vf[1][1], p1, O1);
        if (__all(carry < -40.f)) break;
        buf ^= 1u;
    }
    store_o_row_fp8(ocat + (size_t)(base + 32 * j + qi) * LDO + 256 + h4 * 64, O0, O1, h);
}
DI void phase_attn(const Frame& F, const Params& p) {
    const int tid_ = fresh_tid(), lane_ = tid_ & 63;
    const bf16_t* hb = (const bf16_t*)(F.ws + WS_PROJ); unsigned char* ocat = F.ws + WS_OCAT;
    bf16_t* og = (bf16_t*)(F.ws + WS_OG); float* lse = (float*)(F.ws + WS_LSE);
    LAS unsigned char* ldsW = F.lds + F.wave * (2 * SLOT_BYTES);
    AttnLane L; attn_lane_init(L, lane_);
    float gq[32];
#pragma unroll
    for (int s4 = 0; s4 < 4; ++s4)
#pragma unroll
        for (int e = 0; e < 8; ++e) gq[s4 * 8 + e] = p.in[I_QG][16 * s4 + 8 * (lane_ >> 5) + e];
    const __amdgpu_buffer_rsrc_t rs = __builtin_amdgcn_make_buffer_rsrc(F.ws, 0, (int)WS_END, 0x00020000);
    const int NU = NB * 4 * 16;
    for (int i = 0;; ++i) {
        const int u = (F.G == 256) ? ((F.bid & 7) * 32 + (F.bid >> 3) + 256 * i) : (F.bid + F.G * i);
        if (u >= NU) break;
        const int qb = u & 15, hs = (u >> 4) & 3, b = u >> 6, t0 = qb * 512;
        for (int w = F.wave; w < 16; w += 8) sb_tile(L, rs, hb, b, hs, t0 / 32 + w, ldsW, ocat, lane_);
        for (int w = F.wave; w < 48; w += 8) {
            const int g = w >> 4, ti = w & 15, l2d = 2 * g, per = 16 >> l2d, r = ti / per, jj = ti % per;
            dil_tile(L, rs, hb, g * 4 + hs, (long)b * S + (long)r * (S >> l2d), ((t0 >> l2d) >> 5) + jj, ldsW, og + (size_t)(g * 4 + hs) * T * 64, lse + (size_t)(g * 4 + hs) * T, lane_, gq, (const bf16_t*)(F.ws + WS_ROPE), (long)b * S + r, 1 << l2d);
        }
        VM_WAIT();
        __syncthreads();
        {
            const int piece = tid_ & 7; const size_t bb = (size_t)b * S;
#pragma unroll 2
            for (int pass = 0; pass < 8; ++pass) {
                const int sq = t0 + pass * 64 + (tid_ >> 3);
                const size_t r0 = bb + sq, r1 = bb + ((size_t)(sq & 3) << 11) + (sq >> 2), r2 = bb + ((size_t)(sq & 15) << 9) + (sq >> 4);
                const float l0 = lse[(size_t)(0 + hs) * T + r0], l1 = lse[(size_t)(4 + hs) * T + r1], l2 = lse[(size_t)(8 + hs) * T + r2];
                const u32x4 x = *((const u32x4*)(og + ((size_t)(0 + hs) * T + r0) * 64) + piece), y = *((const u32x4*)(og + ((size_t)(4 + hs) * T + r1) * 64) + piece), z = *((const u32x4*)(og + ((size_t)(8 + hs) * T + r2) * 64) + piece);
                const float mx = fmaxf(l0, fmaxf(l1, l2)); float w0 = fexp2(l0 - mx), w1 = fexp2(l1 - mx), w2 = fexp2(l2 - mx); const float inv = frcp(w0 + w1 + w2); w0 *= inv; w1 *= inv; w2 *= inv;
                u32x2 r;
                r.x = pk4_fp8(w0 * bf_lo(x.x) + w1 * bf_lo(y.x) + w2 * bf_lo(z.x), w0 * bf_hi(x.x) + w1 * bf_hi(y.x) + w2 * bf_hi(z.x), w0 * bf_lo(x.y) + w1 * bf_lo(y.y) + w2 * bf_lo(z.y), w0 * bf_hi(x.y) + w1 * bf_hi(y.y) + w2 * bf_hi(z.y));
                r.y = pk4_fp8(w0 * bf_lo(x.z) + w1 * bf_lo(y.z) + w2 * bf_lo(z.z), w0 * bf_hi(x.z) + w1 * bf_hi(y.z) + w2 * bf_hi(z.z), w0 * bf_lo(x.w) + w1 * bf_lo(y.w) + w2 * bf_lo(z.w), w0 * bf_hi(x.w) + w1 * bf_hi(y.w) + w2 * bf_hi(z.w));
                *((u32x2*)(ocat + (bb + sq) * LDO + hs * 64) + piece) = r;
            }
        }
        __syncthreads();
    }
}

DI void route_rows(const Frame& F, const Params& p, int pm) {
    const int tid_ = fresh_tid(), lane_ = tid_ & 63;
    LAS int* hist = (LAS int*)(F.lds);
    const int ftid = fresh_tid();
    __syncthreads();
    if (ftid < 32) hist[ftid] = 0;
    __syncthreads();
    if (tid_ < 256) {
        const int row = pm * 256 + tid_; const float* L = (const float*)(F.ws + WS_LOGIT) + (size_t)row * 128;
        const float* brg = p.in[I_BRG]; const float* bre = p.in[I_BRE];
        float lgp[4];
#pragma unroll
        for (int c = 0; c < 4; ++c) lgp[c] = L[c] + L[36 + c] + brg[c];
        int gsel = 0; float gm = lgp[0];
#pragma unroll
        for (int c = 1; c < 4; ++c) if (lgp[c] > gm) { gm = lgp[c]; gsel = c; }
        float zs = 0.f;
#pragma unroll
        for (int c = 0; c < 4; ++c) zs += fexp2((lgp[c] - gm) * LOG2E);
        const float pg = frcp(zs);
        float l1 = -INFINITY, l2 = -INFINITY; int e1 = 0, e2 = 0;
#pragma unroll
        for (int i = 0; i < 8; ++i) { const int c = 4 + gsel * 8 + i; const float v = L[c] + L[36 + c] + bre[gsel * 8 + i];
            if (v > l1) { l2 = l1; e2 = e1; l1 = v; e1 = i; } else if (v > l2) { l2 = v; e2 = i; } }
        const float ex = fexp2((l2 - l1) * LOG2E), den = frcp(1.f + ex);
        int* te = (int*)(F.ws + WS_TOKE) + (size_t)row * 2; float* tw = (float*)(F.ws + WS_TOKW) + (size_t)row * 2;
        te[0] = gsel * 8 + e1; te[1] = gsel * 8 + e2; tw[0] = pg * den; tw[1] = pg * ex * den;
        lds_add(&hist[gsel * 8 + e1], 1); lds_add(&hist[gsel * 8 + e2], 1);
    }
    __syncthreads();
    if (ftid < 32) ((int*)(F.ws + WS_HIST))[pm * 32 + ftid] = hist[ftid];
}


DI void router_weights_to_lds(const Frame& F, const Params& p) {
    const int tid_ = fresh_tid(), lane_ = tid_ & 63;
    constexpr int WP = 1028;
    LAS float* wt = (LAS float*)(F.lds + LDS_RW); LAS float* bias = (LAS float*)(F.lds + LDS_RS) + 8 * 80 + 32;
    const float* wrg = p.in[I_WRG]; const float* wre = p.in[I_WRE]; const float* brg = p.in[I_BRG]; const float* bre = p.in[I_BRE];
    const int ftid = fresh_tid();
    __syncthreads();
#pragma unroll 8
    for (int i = ftid; i < 1024 * 32; i += 512) wt[(4 + (i & 31)) * WP + (i >> 5)] = wre[i];
#pragma unroll 8
    for (int i = ftid; i < 1024 * 4; i += 512) wt[(i & 3) * WP + (i >> 2)] = wrg[i];
    if (ftid < 36) bias[ftid] = ftid < 4 ? brg[ftid] : bre[ftid - 4];
}

DI void phase_norm2_route(const Frame& F, const Params& p) {
    const int tid_ = fresh_tid(), lane_ = tid_ & 63;
    constexpr int WP = 1028;
    LAS float* wt = (LAS float*)(F.lds + LDS_RW);
    LAS float* gs = (LAS float*)(F.lds + LDS_RV); LAS float* sh = gs + 1024;
    LAS float* scr = (LAS float*)(F.lds + LDS_RS) + F.wave * 80;
    LAS int* hist = (LAS int*)(F.lds + LDS_RS) + 8 * 80;
    LAS float* bias = (LAS float*)(F.lds + LDS_RS) + 8 * 80 + 32;
    const float* mod = (const float*)(F.ws + WS_MOD); const float* gn = p.in[I_GFFN];
    const bf16_t* upd = (const bf16_t*)(F.ws + WS_UPD1); bf16_t* x1w = (bf16_t*)(F.ws + WS_UPD1); unsigned* h8 = (unsigned*)(F.ws + WS_H28);
    const float* wrg = p.in[I_WRG]; const float* wre = p.in[I_WRE]; const float* brg = p.in[I_BRG]; const float* bre = p.in[I_BRE];
    const int ftid = fresh_tid();
    __syncthreads();
    for (int chunk = F.bid; chunk < T / 256; chunk += F.G) {
        const int b = chunk >> 5;
        __syncthreads();
        for (int col = ftid; col < 1024; col += 512) { gs[col] = gn[col] * (1.f + mod[b * 6144 + 4096 + col]); sh[col] = mod[b * 6144 + 3072 + col]; }
        if (ftid < 32) hist[ftid] = 0;
        __syncthreads();
        f32x4 vn[2][4]; u32x2 un[2][4];
#pragma unroll
        for (int r = 0; r < 2; ++r) { const int row = chunk * 256 + F.wave * 2 + r;
            const f32x4* xr = (const f32x4*)(p.in[I_X] + (size_t)row * 1024) + lane_; const u32x2* ur = (const u32x2*)(upd + (size_t)row * 1024) + lane_;
#pragma unroll
            for (int j = 0; j < 4; ++j) { vn[r][j] = xr[64 * j]; un[r][j] = ur[64 * j]; } }
        for (int rr = F.wave * 2; rr < 256; rr += 16) {
            const int row0 = chunk * 256 + rr;
            f32x4 y[2][4];
#pragma unroll
            for (int r = 0; r < 2; ++r) {
                const int row = row0 + r; float ss = 0.f;
#pragma unroll
                for (int j = 0; j < 4; ++j) { vn[r][j].x += bf_lo(un[r][j].x); vn[r][j].y += bf_hi(un[r][j].x); vn[r][j].z += bf_lo(un[r][j].y); vn[r][j].w += bf_hi(un[r][j].y);
                    { u32x2 o; o.x = pk2(vn[r][j].x, vn[r][j].y); o.y = pk2(vn[r][j].z, vn[r][j].w); *((u32x2*)(x1w + (size_t)row * 1024) + lane_ + 64 * j) = o; }
                    ss += (vn[r][j].x * vn[r][j].x + vn[r][j].y * vn[r][j].y) + (vn[r][j].z * vn[r][j].z + vn[r][j].w * vn[r][j].w); }
                const float rinv = __builtin_amdgcn_rsqf(wave_sum(ss) * (1.f / 1024.f) + RMS_EPS);
#pragma unroll
                for (int j = 0; j < 4; ++j) { const f32x4 gj = *(const LAS f32x4*)(gs + 256 * j + 4 * lane_), sj = *(const LAS f32x4*)(sh + 256 * j + 4 * lane_);
                    y[r][j] = vn[r][j] * rinv * gj + sj; h8[(size_t)row * 256 + 64 * j + lane_] = pk4_fp8(y[r][j].x, y[r][j].y, y[r][j].z, y[r][j].w); }
            }
            if (rr + 16 < 256) {
#pragma unroll
                for (int r = 0; r < 2; ++r) { const int row = row0 + 16 + r;
                    const f32x4* xr = (const f32x4*)(p.in[I_X] + (size_t)row * 1024) + lane_; const u32x2* ur = (const u32x2*)(upd + (size_t)row * 1024) + lane_;
#pragma unroll
                    for (int j = 0; j < 4; ++j) { vn[r][j] = xr[64 * j]; un[r][j] = ur[64 * j]; } }
            }
            const bool up32 = (lane_ & 32) != 0, up16 = (lane_ & 16) != 0, up8 = (lane_ & 8) != 0, up4 = (lane_ & 4) != 0;
            {
                f32x2 ga[2][4], gb[2][4];
#pragma unroll
                for (int r = 0; r < 2; ++r)
#pragma unroll
                    for (int c = 0; c < 4; ++c) { ga[r][c] = (f32x2){0.f, 0.f}; gb[r][c] = ga[r][c]; }
#pragma unroll
                for (int c = 0; c < 4; ++c)
#pragma unroll
                    for (int j = 0; j < 4; ++j) { const f32x4 w = *(const LAS f32x4*)(wt + c * WP + 4 * lane_ + 256 * j); const f32x2 wl = {w.x, w.y}, wh = {w.z, w.w};
#pragma unroll
                        for (int r = 0; r < 2; ++r) { ga[r][c] = __builtin_elementwise_fma((f32x2){y[r][j].x, y[r][j].y}, wl, ga[r][c]); gb[r][c] = __builtin_elementwise_fma((f32x2){y[r][j].z, y[r][j].w}, wh, gb[r][c]); } }
                float k4[4];
#pragma unroll
                for (int c = 0; c < 4; ++c) { const f32x2 t0 = ga[0][c] + gb[0][c], t1 = ga[1][c] + gb[1][c]; const float p0 = t0.x + t0.y, p1 = t1.x + t1.y;
                    k4[c] = up32 ? p0 : p1; ga[0][c].x = up32 ? p1 : p0; }
#pragma unroll
                for (int c = 0; c < 4; ++c) k4[c] = ga[0][c].x + __shfl_xor(k4[c], 32);
                float k2[2];
#pragma unroll
                for (int i = 0; i < 2; ++i) k2[i] = (up16 ? k4[2 + i] : k4[i]) + __shfl_xor(up16 ? k4[i] : k4[2 + i], 16);
                float k1 = (up8 ? k2[1] : k2[0]) + __shfl_xor(up8 ? k2[0] : k2[1], 8);
                k1 += __shfl_xor(k1, 4); k1 += __shfl_xor(k1, 2); k1 += __shfl_xor(k1, 1);
                if ((lane_ & 7) == 0) scr[(lane_ >> 5) * 36 + ((lane_ >> 4) & 1) * 2 + ((lane_ >> 3) & 1)] = k1;
            }
            LDS_WAIT();
            int gsel[2];
#pragma unroll
            for (int r = 0; r < 2; ++r) { int gi = 0; float gm = scr[r * 36] + bias[0];
#pragma unroll
                for (int c = 1; c < 4; ++c) { const float v = scr[r * 36 + c] + bias[c]; if (v > gm) { gm = v; gi = c; } }
                gsel[r] = __builtin_amdgcn_readfirstlane(gi); }
            {
                float pe[2][8];
#pragma unroll
                for (int r = 0; r < 2; ++r) {
                    const LAS float* wb = wt + (4 + gsel[r] * 8) * WP + 4 * lane_;
#pragma unroll
                    for (int hh = 0; hh < 2; ++hh) {
                        f32x2 ea[4], eb[4];
#pragma unroll
                        for (int i = 0; i < 4; ++i) { ea[i] = (f32x2){0.f, 0.f}; eb[i] = ea[i]; }
#pragma unroll
                        for (int i = 0; i < 4; ++i)
#pragma unroll
                            for (int j = 0; j < 4; ++j) { const f32x4 w = *(const LAS f32x4*)(wb + (hh * 4 + i) * WP + 256 * j);
                                ea[i] = __builtin_elementwise_fma((f32x2){y[r][j].x, y[r][j].y}, (f32x2){w.x, w.y}, ea[i]); eb[i] = __builtin_elementwise_fma((f32x2){y[r][j].z, y[r][j].w}, (f32x2){w.z, w.w}, eb[i]); }
#pragma unroll
                        for (int i = 0; i < 4; ++i) { const f32x2 t = ea[i] + eb[i]; pe[r][hh * 4 + i] = t.x + t.y; }
                        __builtin_amdgcn_sched_barrier(0);
                    }
                }
                float e8[8], e4[4], e2[2];
#pragma unroll
                for (int i = 0; i < 8; ++i) e8[i] = (up32 ? pe[1][i] : pe[0][i]) + __shfl_xor(up32 ? pe[0][i] : pe[1][i], 32);
#pragma unroll
                for (int i = 0; i < 4; ++i) e4[i] = (up16 ? e8[4 + i] : e8[i]) + __shfl_xor(up16 ? e8[i] : e8[4 + i], 16);
#pragma unroll
                for (int i = 0; i < 2; ++i) e2[i] = (up8 ? e4[2 + i] : e4[i]) + __shfl_xor(up8 ? e4[i] : e4[2 + i], 8);
                float e1 = (up4 ? e2[1] : e2[0]) + __shfl_xor(up4 ? e2[0] : e2[1], 4);
                e1 += __shfl_xor(e1, 2); e1 += __shfl_xor(e1, 1);
                if ((lane_ & 3) == 0) scr[(lane_ >> 5) * 36 + 4 + ((lane_ >> 4) & 1) * 4 + ((lane_ >> 3) & 1) * 2 + ((lane_ >> 2) & 1)] = e1;
            }
            LDS_WAIT();
            if (lane_ < 2) {
                const LAS float* L = scr + lane_ * 36; const int row = row0 + lane_;
                float lgp[4];
#pragma unroll
                for (int c = 0; c < 4; ++c) lgp[c] = L[c] + bias[c];
                int gsel = 0; float gm = lgp[0];
#pragma unroll
                for (int c = 1; c < 4; ++c) if (lgp[c] > gm) { gm = lgp[c]; gsel = c; }
                float zs = 0.f;
#pragma unroll
                for (int c = 0; c < 4; ++c) zs += fexp2((lgp[c] - gm) * LOG2E);
                const float pg = frcp(zs);
                float l1 = -INFINITY, l2 = -INFINITY; int e1 = 0, e2 = 0;
#pragma unroll
                for (int i = 0; i < 8; ++i) { const float v = L[4 + i] + bias[4 + gsel * 8 + i];
                    if (v > l1) { l2 = l1; e2 = e1; l1 = v; e1 = i; } else if (v > l2) { l2 = v; e2 = i; } }
                const float ex = fexp2((l2 - l1) * LOG2E), den = frcp(1.f + ex);
                int* te = (int*)(F.ws + WS_TOKE) + (size_t)row * 2; float* tw = (float*)(F.ws + WS_TOKW) + (size_t)row * 2;
                te[0] = gsel * 8 + e1; te[1] = gsel * 8 + e2; tw[0] = pg * den; tw[1] = pg * ex * den;
                lds_add(&hist[gsel * 8 + e1], 1); lds_add(&hist[gsel * 8 + e2], 1);
            }
            LDS_WAIT();
        }
        __syncthreads();
        if (ftid < 32) ((int*)(F.ws + WS_HIST))[chunk * 32 + ftid] = hist[ftid];
    }
}

DI void phase_slots(const Frame& F, const Params& p) {
    const int tid_ = fresh_tid(), lane_ = tid_ & 63;
    LAS int* tot = (LAS int*)(F.lds); LAS int* bas = tot + 32; LAS int* pst = tot + 64; LAS int* wcnt = tot + 128;
    const int* hist = (const int*)(F.ws + WS_HIST);
    for (int pm = F.bid; pm < T / 256; pm += F.G) {
        const int ftid = fresh_tid();
        __syncthreads();
        if (ftid < 64) tot[ftid] = 0;
        __syncthreads();
        { const int e = tid_ & 31, part = tid_ >> 5; int t = 0, bs = 0;
          for (int q = part; q < T / 256; q += 16) { const int v = hist[q * 32 + e]; t += v; if (q < pm) bs += v; }
          lds_add(&tot[e], t); lds_add(&bas[e], bs); }
        __syncthreads();
        if (tid_ == 0) { int run = 0; for (int e = 0; e < 32; ++e) { pst[e] = run; run += (tot[e] + 255) / 256 * 256; } pst[32] = run; }
        const int my_e = ((const int*)(F.ws + WS_TOKE))[(size_t)pm * 512 + tid_];
        int rank = 0;
        for (int e = 0; e < 32; ++e) { const unsigned long long mask = __ballot(my_e == e); if (my_e == e) rank = __popcll(mask & ((1ull << lane_) - 1ull)); if (lane_ == 0) wcnt[F.wave * 32 + e] = __popcll(mask); }
        __syncthreads();
        int woff = 0;
        for (int w = 0; w < F.wave; ++w) woff += wcnt[w * 32 + my_e];
        const int slot = pst[my_e] + bas[my_e] + woff + rank;
        ((int*)(F.ws + WS_SLOTTOK))[slot] = pm * 256 + (tid_ >> 1);
        ((float*)(F.ws + WS_SLOTW))[slot] = ((const float*)(F.ws + WS_TOKW))[(size_t)pm * 512 + tid_];
        ((int*)(F.ws + WS_TOKS))[(size_t)pm * 512 + tid_] = slot;
        if (pm < 32) { const int e = pm; for (int s = pst[e] + tot[e] + tid_; s < pst[e + 1]; s += 512) { ((int*)(F.ws + WS_SLOTTOK))[s] = 0; ((float*)(F.ws + WS_SLOTW))[s] = 0.f; } }
        if (pm == 0 && tid_ < 34) { int* et = (int*)(F.ws + WS_ETAB); if (tid_ < 33) et[64 + tid_] = pst[tid_] >> 8; if (tid_ < 32) { et[tid_] = tot[tid_]; et[32 + tid_] = pst[tid_]; } if (tid_ == 33) et[97] = pst[32] >> 8; }
    }
}

DI void phase_combine(const Frame& F, const Params& p) {
    const int tid_ = fresh_tid(), lane_ = tid_ & 63;
    const unsigned* y = (const unsigned*)(F.ws + WS_Y); const int* ts = (const int*)(F.ws + WS_TOKS); const float* tw = (const float*)(F.ws + WS_TOKW); const float* mod = (const float*)(F.ws + WS_MOD);
    const int gw = F.bid * 8 + F.wave, NGW = F.G * 8;
    for (int row = gw; row < T; row += NGW) {
        const int s0 = ts[(size_t)row * 2], s1 = ts[(size_t)row * 2 + 1]; const float w0 = tw[(size_t)row * 2] * 0.125f, w1 = tw[(size_t)row * 2 + 1] * 0.125f;
        f32x4* orow = (f32x4*)(p.out + (size_t)row * 1024) + lane_;
        const u32x2* ur = (const u32x2*)((const bf16_t*)(F.ws + WS_UPD1) + (size_t)row * 1024) + lane_;
        const unsigned* y0 = y + (size_t)s0 * 256 + lane_; const unsigned* y1 = y + (size_t)s1 * 256 + lane_;
        const f32x4* g2 = (const f32x4*)(mod + (row >> 13) * 6144 + 5120) + lane_;
        f32x4 v[4], g[4]; unsigned a[4], c[4]; u32x2 uu[4];
#pragma unroll
        for (int j = 0; j < 4; ++j) { uu[j] = ur[64 * j]; a[j] = y0[64 * j]; c[j] = y1[64 * j]; g[j] = g2[64 * j]; }
#pragma unroll
        for (int j = 0; j < 4; ++j) { v[j] = (f32x4){bf_lo(uu[j].x), bf_hi(uu[j].x), bf_lo(uu[j].y), bf_hi(uu[j].y)};
            if (!DBG_SKIP_Y) { const f32x2 al = fp8_lo2(a[j]), ah = fp8_hi2(a[j]), cl = fp8_lo2(c[j]), ch = fp8_hi2(c[j]);
                v[j].x += g[j].x * (w0 * al.x + w1 * cl.x); v[j].y += g[j].y * (w0 * al.y + w1 * cl.y); v[j].z += g[j].z * (w0 * ah.x + w1 * ch.x); v[j].w += g[j].w * (w0 * ah.y + w1 * ch.y); } orow[64 * j] = v[j]; }
    }
}

__global__ void __launch_bounds__(512, 2) fwd(Params p) {
    extern __shared__ __attribute__((aligned(16))) unsigned char lds_raw[];
    Frame F;
    F.lds = (LAS unsigned char*)lds_raw; F.ws = p.ws;
    F.wave = __builtin_amdgcn_readfirstlane((int)threadIdx.x >> 6); F.G = gridDim.x; F.bid = blockIdx.x;
    volatile LAS unsigned* ctl = (volatile LAS unsigned*)(F.lds + LDS_CTLO);
    { const int ftid = fresh_tid(); if (ftid < 64) ctl[ftid] = 0u; }
    __syncthreads();
    XcdBarrier bar; bar.bar = (unsigned*)(p.ws + WS_CTL) + CW_BAR; bar.x = 0; bar.st = ctl;
    if (MK_N_LAUNCHES == 1) bar = xcd_barrier_post((unsigned*)(p.ws + WS_CTL) + CW_BAR, ctl);
    const int lo = p.ph_lo, hi = p.ph_hi;
    const __amdgpu_buffer_rsrc_t rsw = __builtin_amdgcn_make_buffer_rsrc(p.ws, 0, (int)WS_END, 0x00020000);
#define IN(k) (lo <= (k) && (k) < hi)
#define REP(k) for (int rep_ = 0; rep_ < ((PROBE_PH) == (k) ? 2 : 1); ++rep_)
#define SEAM(k) do { if (IN(k) && IN((k) + 1)) xcd_barrier(bar); } while (0)

    if (IN(0)) REP(0) { phase0(F, p); } SEAM(0);
    if (IN(1)) REP(1) { phase_norm<0>(F, p); } SEAM(1);
    if (IN(2)) REP(2) {
        REP(20) {
            pg8::DenseSched Sd; Sd.init(T, 2304, F.G, F.bid, WS_H8, 1024, WS_W1D8, 1024);
            EpiProj<false> E{(bf16_t*)(F.ws + WS_PROJ), (bf16_t*)(F.ws + WS_GATES), (const bf16_t*)(F.ws + WS_ROPE), p.in[I_QG], p.in[I_KG], 0};
            pg8::gemm_phase<EpiProj<false>, pg8::DenseSched, true>(F.lds, 1024, Sd, E, rsw);
        }
        REP(21) {
            pg8::DenseSched Sd; Sd.init(T, 768, F.G, F.bid, WS_H, 2048, WS_W1 + (size_t)2304 * 2048, 2048);
            EpiProj<false> E{(bf16_t*)(F.ws + WS_PROJ), (bf16_t*)(F.ws + WS_GATES), (const bf16_t*)(F.ws + WS_ROPE), p.in[I_QG], p.in[I_KG], 9};
            pg8::gemm_phase<EpiProj<false>, pg8::DenseSched, false>(F.lds, 1024, Sd, E, rsw);
        }
        REP(22) {
            pg8::DenseSched Sd; Sd.init(T, 2048, F.G, F.bid, WS_H8, 1024, WS_WG8, 1024);
            EpiProj<true> E{(bf16_t*)(F.ws + WS_PROJ), (bf16_t*)(F.ws + WS_GATES), (const bf16_t*)(F.ws + WS_ROPE), p.in[I_QG], p.in[I_KG], 0};
            pg8::gemm_phase<EpiProj<true>, pg8::DenseSched, true>(F.lds, 1024, Sd, E, rsw);
        }
    } SEAM(2);
    if (IN(3)) REP(3) { phase_attn(F, p); } SEAM(3);
    if (IN(4)) REP(4) {
        pg8::DiagSched Sd; Sd.init(T, 2048, F.G, F.bid, WS_OCAT, 512, WS_WB, 512);
        EpiBranch E{(const unsigned char*)(F.ws + WS_GATES), F.ws + WS_MERGED};
        pg8::gemm_phase<EpiBranch, pg8::DiagSched, true>(F.lds, 512, Sd, E, rsw);
    } SEAM(4);
    if (IN(5)) REP(5) {
        pg8::DenseSched Sd; Sd.init(T, 1024, F.G, F.bid, WS_MERGED, 1024, WS_WO, 1024);
        EpiOut E{(bf16_t*)(F.ws + WS_UPD1), (const float*)(F.ws + WS_MOD)};
        pg8::gemm_phase<EpiOut, pg8::DenseSched, true>(F.lds, 1024, Sd, E, rsw);
        if (rep_ + 1 == ((PROBE_PH) == 5 ? 2 : 1)) router_weights_to_lds(F, p);
    } SEAM(5);
    if (IN(6)) REP(6) { phase_norm2_route(F, p); }
    if (IN(6) && IN(8)) xcd_barrier(bar);
    if (IN(8)) REP(8) { phase_slots(F, p); } SEAM(8);
    if (IN(9) || IN(10)) {
        LAS int* cst = (LAS int*)(F.lds + LDS_CTLO) + 16;
        __syncthreads();
        { const int ftid = fresh_tid(); if (ftid < 34) cst[ftid] = ((const int*)(F.ws + WS_ETAB))[64 + ftid]; }
        __syncthreads();
    }
    if (IN(9)) REP(9) {
        const LAS int* cst = (const LAS int*)(F.lds + LDS_CTLO) + 16;
        MoeSchedUp Sm; Sm.G = F.G; Sm.c = (F.G == 256) ? ((F.bid & 7) * 32 + (F.bid >> 3)) : F.bid; Sm.nc = __builtin_amdgcn_readfirstlane(cst[33]); Sm.pa = 1024; Sm.pb = 1024; Sm.A = (unsigned)WS_H28; Sm.B = (unsigned)WS_WGU; Sm.cstart = cst;
        Sm.slot_tok = (const int*)(F.ws + WS_SLOTTOK); Sm.estride = 1024u * 1024u; Sm.pnstride = 256u * 1024u;
        EpiSwiglu E{F.ws + WS_HMID};
        pg8::gemm_phase<EpiSwiglu, MoeSchedUp, true>(F.lds, 1024, Sm, E, rsw);
    } SEAM(9);
    if (IN(10)) REP(10) {
        const LAS int* cst = (const LAS int*)(F.lds + LDS_CTLO) + 16;
        MoeSchedDn Sm; Sm.G = F.G; Sm.c = (F.G == 256) ? ((F.bid & 7) * 32 + (F.bid >> 3)) : F.bid; Sm.nc = __builtin_amdgcn_readfirstlane(cst[33]); Sm.pa = 512; Sm.pb = 512; Sm.A = (unsigned)WS_HMID; Sm.B = (unsigned)WS_WDN; Sm.cstart = cst;
        Sm.slot_tok = (const int*)(F.ws + WS_SLOTTOK); Sm.estride = 1024u * 512u; Sm.pnstride = 256u * 512u;
        EpiDown E{F.ws + WS_Y};
        pg8::gemm_phase<EpiDown, MoeSchedDn, true>(F.lds, 512, Sm, E, rsw);
    } SEAM(10);
    if (IN(11)) { phase_combine(F, p); }
#undef IN
#undef SEAM
}

extern "C" void kernel_launch(void* const* d_in, const int* in_sizes, int n_in, void* d_out, int out_size, void* d_ws, size_t ws_size, hipStream_t stream) {
    static int grid = 0;
    if (grid == 0) {
        if (n_in != 21 || in_sizes[0] != T * D || out_size != T * D || ws_size < WS_END) { fprintf(stderr, "kernel_launch: unexpected problem (n_in %d, ws %zu)\n", n_in, ws_size); grid = -1; return; }
        int dev = 0, cus = 0, per_cu = 0;
        if (hipGetDevice(&dev) != hipSuccess || hipDeviceGetAttribute(&cus, hipDeviceAttributeMultiprocessorCount, dev) != hipSuccess) { grid = -1; return; }
        if (hipFuncSetAttribute((const void*)fwd, hipFuncAttributeMaxDynamicSharedMemorySize, LDS_BYTES) != hipSuccess) { fprintf(stderr, "kernel_launch: hipFuncSetAttribute failed\n"); grid = -1; return; }
        if (hipOccupancyMaxActiveBlocksPerMultiprocessor(&per_cu, (const void*)fwd, 512, LDS_BYTES) != hipSuccess || per_cu < 1) { fprintf(stderr, "kernel_launch: occupancy query says %d\n", per_cu); (void)hipGetLastError(); grid = -1; return; }
        grid = cus;
    }
    if (grid < 0) return;
    (void)hipMemsetAsync((char*)d_ws + WS_CTL, 0, CTL_ZERO_BYTES, stream);
    Params p{};
    for (int i = 0; i < 21; ++i) p.in[i] = (const float*)d_in[i];
    p.out = (float*)d_out; p.ws = (unsigned char*)d_ws;
    if (MK_N_LAUNCHES == 1) { p.ph_lo = 0; p.ph_hi = NPH; hipLaunchKernelGGL(fwd, dim3(grid), dim3(512), LDS_BYTES, stream, p); }
    else { for (int k = 0; k < NPH; ++k) { p.ph_lo = k; p.ph_hi = k + 1; hipLaunchKernelGGL(fwd, dim3(grid), dim3(512), LDS_BYTES, stream, p); } }
}
```

```cpp
#include <hip/hip_runtime.h>
#include <cstdio>
#include <cstdint>

#ifndef MK_N_LAUNCHES
#define MK_N_LAUNCHES 1
#endif
#define DBG_X1_PLAIN 0
#define DBG_SKIP_Y 0
#ifndef PROBE_PH
#define PROBE_PH -1
#endif

#define LAS __attribute__((address_space(3)))
#define DI __device__ __forceinline__
typedef unsigned short bf16_t;
typedef short bf16x8 __attribute__((ext_vector_type(8)));
typedef short s16x4 __attribute__((ext_vector_type(4)));
typedef float f32x2 __attribute__((ext_vector_type(2)));
typedef float f32x4 __attribute__((ext_vector_type(4)));
typedef float f32x16 __attribute__((ext_vector_type(16)));
typedef unsigned u32x2 __attribute__((ext_vector_type(2)));
typedef unsigned u32x4 __attribute__((ext_vector_type(4)));
typedef __bf16 bf16x2n __attribute__((ext_vector_type(2)));
typedef int i32x8 __attribute__((ext_vector_type(8)));

constexpr int NB = 8, S = 8192, D = 1024, T = NB * S;
constexpr int LDP = 3072, LDG = 2048, LDO = 512;
constexpr int NE = 32, DE = 512;
constexpr int MAXSLOT = T * 2 + NE * 256;
constexpr int NPH = 12;
constexpr float LOG2E = 1.4426950408889634f;
constexpr float QSCALE = 0.125f * LOG2E;
constexpr float RMS_EPS = 1e-6f;

constexpr size_t MiB = 1u << 20;
constexpr size_t WS_CTL = 0, CTL_ZERO_BYTES = 64 * 1024;
constexpr int CW_BAR = 1024;
constexpr size_t WS_MODP = 1 * MiB;
constexpr size_t WS_MOD = 3 * MiB;
constexpr size_t WS_ROPE = 4 * MiB;
constexpr size_t WS_LOGIT = 144 * MiB;
constexpr size_t WS_TOKE = 24 * MiB;
constexpr size_t WS_TOKW = 24 * MiB + 512 * 1024;
constexpr size_t WS_TOKS = 25 * MiB;
constexpr size_t WS_SLOTTOK = 25 * MiB + 512 * 1024;
constexpr size_t WS_SLOTW = 26 * MiB + 256 * 1024;
constexpr size_t WS_HIST = 27 * MiB;
constexpr size_t WS_ETAB = 27 * MiB + 256 * 1024;
constexpr size_t WS_WR = 28 * MiB;
constexpr size_t WS_W1D8 = 28 * MiB + 512 * 1024;
constexpr size_t WS_W1 = 32 * MiB;
constexpr size_t WS_WG8 = 38 * MiB;
constexpr size_t WS_WB = 40 * MiB;
constexpr size_t WS_WO = 43 * MiB;
constexpr size_t WS_WGU = 48 * MiB;
constexpr size_t WS_WDN = 80 * MiB;
constexpr size_t WS_H = 144 * MiB;
constexpr size_t WS_OG = 144 * MiB;
constexpr size_t WS_LSE = 240 * MiB;
constexpr size_t WS_PROJ = 272 * MiB;
constexpr size_t WS_GATES = 656 * MiB;
constexpr size_t WS_OCAT = 912 * MiB;
constexpr size_t WS_H8 = 912 * MiB;
constexpr size_t WS_MERGED = 272 * MiB;
constexpr size_t WS_H2 = 400 * MiB;
constexpr size_t WS_H28 = 528 * MiB;
constexpr size_t WS_HMID = 592 * MiB;
constexpr size_t WS_Y = 664 * MiB;
constexpr size_t WS_UPD1 = 800 * MiB;
constexpr size_t WS_END = 976 * MiB;

constexpr int LDS_STAGE = 0, LDS_EPI = 131072, LDS_RW = 0, LDS_RV = 148480, LDS_RS = 148480 + 8192, LDS_CTLO = 148480 + 8192 + 3072, LDS_BYTES = LDS_CTLO + 256;

DI unsigned pk2(float lo, float hi) { f32x2 v = {lo, hi}; bf16x2n r = __builtin_convertvector(v, bf16x2n); return __builtin_bit_cast(unsigned, r); }
DI unsigned pk4_fp8(float a, float b, float c, float d) { int r = __builtin_amdgcn_cvt_pk_fp8_f32(a, b, 0, false); r = __builtin_amdgcn_cvt_pk_fp8_f32(c, d, r, true); return (unsigned)r; }
DI f32x2 fp8_lo2(unsigned u) { return __builtin_amdgcn_cvt_pk_f32_fp8((int)u, false); }
DI f32x2 fp8_hi2(unsigned u) { return __builtin_amdgcn_cvt_pk_f32_fp8((int)u, true); }
DI float bf_lo(unsigned u) { return __builtin_bit_cast(float, u << 16); }
DI float bf_hi(unsigned u) { return __builtin_bit_cast(float, u & 0xffff0000u); }
struct Swap2 { float lo, hi; };
DI Swap2 swap32(float x) { const unsigned b = __builtin_bit_cast(unsigned, x); auto r = __builtin_amdgcn_permlane32_swap(b, b, false, false); const unsigned r0 = r[0], r1 = r[1]; return Swap2{__builtin_bit_cast(float, r0), __builtin_bit_cast(float, r1)}; }
DI Swap2 swap16(float x) { const unsigned b = __builtin_bit_cast(unsigned, x); auto r = __builtin_amdgcn_permlane16_swap(b, b, false, false); const unsigned r0 = r[0], r1 = r[1]; return Swap2{__builtin_bit_cast(float, r0), __builtin_bit_cast(float, r1)}; }
DI float xsum32(float x) { const Swap2 s = swap32(x); return s.lo + s.hi; }
DI float xmax32(float x) { const Swap2 s = swap32(x); return fmaxf(s.lo, s.hi); }
DI float xget32(float x, int upper) { const Swap2 s = swap32(x); return upper ? s.lo : s.hi; }
DI float wave_sum(float v) {
    v += __builtin_bit_cast(float, __builtin_amdgcn_update_dpp(0, __builtin_bit_cast(int, v), 0xB1, 0xF, 0xF, true));
    v += __builtin_bit_cast(float, __builtin_amdgcn_update_dpp(0, __builtin_bit_cast(int, v), 0x4E, 0xF, 0xF, true));
    v += __builtin_bit_cast(float, __builtin_amdgcn_update_dpp(0, __builtin_bit_cast(int, v), 0x141, 0xF, 0xF, true));
    v += __builtin_bit_cast(float, __builtin_amdgcn_update_dpp(0, __builtin_bit_cast(int, v), 0x140, 0xF, 0xF, true));
    { const Swap2 s = swap16(v); v = s.lo + s.hi; }
    { const Swap2 s = swap32(v); v = s.lo + s.hi; }
    return v;
}
DI float fexp2(float x) { return __builtin_amdgcn_exp2f(x); }
DI float flog2(float x) { return __builtin_amdgcn_logf(x); }
DI float frcp(float x) { return __builtin_amdgcn_rcpf(x); }
DI float sigmoidf(float v) { return frcp(1.0f + fexp2(-v * LOG2E)); }
DI void lds_add(LAS int* p, int v) { (void)__hip_atomic_fetch_add(p, v, __ATOMIC_RELAXED, __HIP_MEMORY_SCOPE_WORKGROUP); }
#define LDS_WAIT() asm volatile("s_waitcnt lgkmcnt(0)" ::: "memory")
#define VM_WAIT() asm volatile("s_waitcnt vmcnt(0)" ::: "memory")
DI int fresh_tid() { int t = threadIdx.x; asm volatile("" : "+v"(t)); return t; }

#define XB_TMO      128
#define XB_XCNT(j)  (256  + 64 * (j))
#define XB_XSUB(j)  (1280 + 64 * (j))
#define XB_XGEN(j)  (2304 + 64 * (j))
#define XB_TOP      3328
#define XB_TOPGEN   3392
#define XCD_BAR_WORDS 3456
#define XB_SPIN_CAP (1u << 18)

__device__ __forceinline__ unsigned xb_ld(unsigned* p)              { return __hip_atomic_load(p, __ATOMIC_RELAXED, __HIP_MEMORY_SCOPE_AGENT); }
__device__ __forceinline__ unsigned xb_add(unsigned* p, unsigned v) { return __hip_atomic_fetch_add(p, v, __ATOMIC_RELAXED, __HIP_MEMORY_SCOPE_AGENT); }
__device__ __forceinline__ unsigned xb_xcc_id() { return (unsigned)__builtin_amdgcn_s_getreg((3 << 11) | 20) & 0xFu; }
#define XB_SPIN(cond, bar) do { unsigned _sp = 0; while (cond) { __builtin_amdgcn_s_sleep(1); \
    if ((++_sp & 255u) == 0u) { if (xb_ld(&(bar)[XB_TMO])) break; if (_sp > XB_SPIN_CAP) { atomicAdd(&(bar)[XB_TMO], 1u); break; } } } } while (0)

struct XcdBarrier {
    unsigned* bar; unsigned x;
    volatile LAS unsigned* st;
};
__device__ __forceinline__ XcdBarrier xcd_barrier_post(unsigned* bar, volatile LAS unsigned* st) {
    XcdBarrier b; b.bar = bar; b.x = xb_xcc_id(); b.st = st;
    if (threadIdx.x == 0) (void)xb_add(&bar[XB_XCNT(b.x)], 1u);
    return b;
}
__device__ __forceinline__ void xcd_barrier_complete(unsigned* bar, unsigned x, unsigned& nloc, unsigned& nx) {
    const unsigned G = gridDim.x * gridDim.y * gridDim.z;
    unsigned sum, cnt, mine, sp = 0u;
    for (;;) {
        sum = 0u; cnt = 0u; mine = 0u;
#pragma unroll
        for (unsigned j = 0; j < 16; ++j) { const unsigned c = xb_ld(&bar[XB_XCNT(j)]); sum += c; cnt += (c > 0u) ? 1u : 0u; mine = (j == x) ? c : mine; }
        if (sum == G) break;
        __builtin_amdgcn_s_sleep(1);
        if ((++sp & 255u) == 0u) { if (xb_ld(&bar[XB_TMO])) break; if (sp > XB_SPIN_CAP) { atomicAdd(&bar[XB_TMO], 1u); break; } }
    }
    nloc = mine > 0u ? mine : 1u; nx = cnt > 0u ? cnt : 1u;
}
__device__ __forceinline__ void xcd_barrier(const XcdBarrier& b) {
    asm volatile("s_waitcnt vmcnt(0)" ::: "memory");
    __syncthreads();
    if (threadIdx.x == 0) {
        unsigned* bar = b.bar;
        __builtin_amdgcn_s_waitcnt(0);
        unsigned nloc = b.st[0], nx = b.st[1];
        if (nloc == 0u) { xcd_barrier_complete(bar, b.x, nloc, nx); b.st[0] = nloc; b.st[1] = nx; }
        const unsigned old = xb_add(&bar[XB_XSUB(b.x)], 1u);
        const unsigned gen = old / nloc;
        if (old + 1u == (gen + 1u) * nloc) {
            __builtin_amdgcn_fence(__ATOMIC_RELEASE, "agent");
            asm volatile("s_waitcnt vmcnt(0)" ::: "memory");
            const unsigned og = xb_add(&bar[XB_TOP], 1u);
            const unsigned tg = og / nx;
            if (og + 1u == (tg + 1u) * nx) xb_add(&bar[XB_TOPGEN], 1u);
            else XB_SPIN(xb_ld(&bar[XB_TOPGEN]) == tg, bar);
            __builtin_amdgcn_fence(__ATOMIC_ACQUIRE, "agent");
            xb_add(&bar[XB_XGEN(b.x)], 1u);
            asm volatile("s_waitcnt vmcnt(0)" ::: "memory");
        } else {
            XB_SPIN(xb_ld(&bar[XB_XGEN(b.x)]) == gen, bar);
            __builtin_amdgcn_fence(__ATOMIC_ACQUIRE, "agent");
            asm volatile("s_waitcnt vmcnt(0)" ::: "memory");
        }
    }
    __syncthreads();
}

namespace pg8 {
constexpr int BM = 256, BK = 64, HALF = 128, HTB = HALF * BK * 2, STAGE_BYTES = 8 * HTB, NXCD = 8, WGM = 8;
__host__ __device__ __forceinline__ int lds_byte(int r, int c) { const int st = (r >> 4) * 2 + (c >> 5), rr = r & 15, cc = c & 31, ob = rr * 64 + cc * 2; return st * 1024 + (ob ^ (((ob >> 9) & 1) << 5)); }
__host__ __device__ __forceinline__ void stage_rc(int b, int& R, int& C) { const int st = b / 1024, sb = b % 1024, swz = sb ^ (((sb >> 9) & 1) << 5); R = (st >> 1) * 16 + swz / 64; C = (st & 1) * 32 + (swz % 64) / 2; }
__host__ __device__ __forceinline__ int perm32(int rho) { const int n = rho >> 4, i = rho & 15; return 8 * (i >> 2) + 4 * n + (i & 3); }

struct Unit { int pm, pn, aux; unsigned a, b; };
typedef int i32x4 __attribute__((ext_vector_type(4)));
__device__ __forceinline__ i32x8 frag8(bf16x8 lo, bf16x8 hi) { return __builtin_shufflevector(__builtin_bit_cast(i32x4, lo), __builtin_bit_cast(i32x4, hi), 0, 1, 2, 3, 4, 5, 6, 7); }

template <class Epi, class Sched, bool FP8 = false>
__device__ __forceinline__ void gemm_phase(LAS unsigned char* lds, const int K, const Sched& S, const Epi& E, const __amdgpu_buffer_rsrc_t rs) {
    const int tid = fresh_tid(), wid = __builtin_amdgcn_readfirstlane(tid >> 6), lane = tid & 63, wr = wid >> 2, wc = wid & 3, fr = lane & 15, fq = lane >> 4;
    const int nt = FP8 ? K / 128 : K / BK;
    int RA[2], CA[2];
    unsigned voffA[4], voffB[2];
#pragma unroll
    for (int i = 0; i < 2; ++i) { int R, C; stage_rc(tid * 16 + i * 8192, R, C); RA[i] = R; CA[i] = C; const int Rb = Epi::PERM ? ((R & ~31) + perm32(R & 31)) : R;
        voffB[i] = (unsigned)(Rb * S.pb + C * 2); }
    const unsigned kstep = (unsigned)(BK * 2);
    const unsigned hstepB = (unsigned)(HALF * S.pb), hstepA = (unsigned)(HALF * S.pa);
    const unsigned ldsw = (unsigned)wid * 1024u;
    const int aoff = lds_byte(wr * 64 + fr, fq * 8), boff = lds_byte(wc * 32 + fr, fq * 8);
    constexpr int kpiece = 1024;
#define PG8_SA(b, h) (((b) * 2 + (h)) * HTB)
#define PG8_SB(b, h) ((4 + (b) * 2 + (h)) * HTB)
#define PG8_STAGE_B(bufoff, gbase) do { _Pragma("unroll") for (int _i = 0; _i < 2; ++_i) \
        __builtin_amdgcn_raw_ptr_buffer_load_lds(rs, (LAS unsigned*)(lds + (bufoff) + ldsw + _i * 8192), 16, (int)voffB[_i], (int)(gbase), 0, 0); } while (0)
#define PG8_STAGE_A(bufoff, gbase, h) do { _Pragma("unroll") for (int _i = 0; _i < 2; ++_i) \
        __builtin_amdgcn_raw_ptr_buffer_load_lds(rs, (LAS unsigned*)(lds + (bufoff) + ldsw + _i * 8192), 16, (int)voffA[Sched::GATHER ? (h) * 2 + _i : _i], (int)((gbase) + (Sched::GATHER ? 0u : (unsigned)(h) * hstepA)), 0, 0); } while (0)
#define PG8_LDA(dst, b, h) do { _Pragma("unroll") for (int m = 0; m < 4; ++m) _Pragma("unroll") for (int k = 0; k < 2; ++k) dst[m][k] = *(const LAS bf16x8*)(lds + PG8_SA(b, h) + aoff + m * 2048 + k * kpiece); } while (0)
#define PG8_LDB(dst, b, h) do { _Pragma("unroll") for (int n = 0; n < 2; ++n) _Pragma("unroll") for (int k = 0; k < 2; ++k) dst[n][k] = *(const LAS bf16x8*)(lds + PG8_SB(b, h) + boff + n * 2048 + k * kpiece); } while (0)
#define PG8_MMA(ai, bj, At, Bt) do { __builtin_amdgcn_s_setprio(1); if constexpr (FP8) { _Pragma("unroll") for (int m = 0; m < 4; ++m) _Pragma("unroll") for (int n = 0; n < 2; ++n) \
        acc[ai][bj][m][n] = __builtin_amdgcn_mfma_scale_f32_16x16x128_f8f6f4(frag8(Bt[n][0], Bt[n][1]), frag8(At[m][0], At[m][1]), acc[ai][bj][m][n], 0, 0, 0, 0x7C7C7C7C, 0, 0x7C7C7C7C); } \
      else { _Pragma("unroll") for (int m = 0; m < 4; ++m) _Pragma("unroll") for (int n = 0; n < 2; ++n) _Pragma("unroll") for (int k = 0; k < 2; ++k) \
        acc[ai][bj][m][n] = __builtin_amdgcn_mfma_f32_16x16x32_bf16(Bt[n][k], At[m][k], acc[ai][bj][m][n], 0, 0, 0); } __builtin_amdgcn_s_setprio(0); } while (0)
#define PG8_MMA2(ai, At) do { if constexpr (Sched::BLOCKDIAG) { if (lo_half) PG8_MMA(ai, 0, At, B0); else PG8_MMA(ai, 1, At, B1); } else { PG8_MMA(ai, 0, At, B0); PG8_MMA(ai, 1, At, B1); } } while (0)
#define PG8_WAIT_V(n) asm volatile("s_waitcnt vmcnt(" #n ")" ::: "memory")
#define PG8_WAIT_L(n) asm volatile("s_waitcnt lgkmcnt(" #n ")" ::: "memory")
#define PG8_BAR __builtin_amdgcn_s_barrier()
#define PG8_SCHED __builtin_amdgcn_sched_barrier(0)
    Unit cur, nxt; int ui = 0;
    if (!S.next(0, cur)) return;
    S.offs(cur, RA, CA, voffA);
    f32x4 acc[2][2][4][2];
#pragma unroll
    for (int a = 0; a < 2; ++a)
#pragma unroll
        for (int b = 0; b < 2; ++b)
#pragma unroll
            for (int m = 0; m < 4; ++m)
#pragma unroll
                for (int n = 0; n < 2; ++n) acc[a][b][m][n] = (f32x4){0.f, 0.f, 0.f, 0.f};
    bf16x8 At[4][2], B0[2][2], B1[2][2];
    unsigned cA = cur.a, cB = cur.b;
    PG8_STAGE_B(PG8_SB(0, 0), cB); PG8_STAGE_B(PG8_SB(0, 1), cB + hstepB); PG8_STAGE_A(PG8_SA(0, 0), cA, 0); PG8_STAGE_A(PG8_SA(0, 1), cA, 1);
    if (wr == 1) PG8_BAR;
    PG8_WAIT_V(2); PG8_BAR;
    PG8_STAGE_B(PG8_SB(1, 0), cB + kstep); PG8_STAGE_A(PG8_SA(1, 0), cA + kstep, 0); PG8_STAGE_B(PG8_SB(1, 1), cB + hstepB + kstep);
    PG8_WAIT_V(6); PG8_BAR;
    for (;;) {
        const bool has_next = S.next(ui + 1, nxt);
        const unsigned nA = has_next ? nxt.a : cA, nB = has_next ? nxt.b : cB;
        unsigned nvoff[4];
        if constexpr (Sched::GATHER) { if (has_next) S.rows(nxt, RA, nvoff); }
#pragma nounroll
        for (int t = 0; t < nt; t += 2) {
            const bool last = (t == nt - 2), lo_half = t < (nt >> 1);
            const unsigned a1 = cA + (unsigned)(t + 1) * kstep;
            const unsigned a2 = last ? nA : cA + (unsigned)(t + 2) * kstep, b2 = last ? nB : cB + (unsigned)(t + 2) * kstep;
            const unsigned a3 = a2 + kstep, b3 = b2 + kstep;
            PG8_LDB(B0, 0, 0); PG8_LDB(B1, 0, 1); PG8_SCHED; PG8_LDA(At, 0, 0); PG8_STAGE_A(PG8_SA(1, 1), a1, 1);
            PG8_WAIT_V(8); PG8_WAIT_L(0); PG8_BAR; PG8_MMA2(0, At); PG8_BAR; PG8_SCHED;
            if constexpr (Sched::GATHER) { if (last && has_next) {
#pragma unroll
                for (int q = 0; q < 4; ++q) voffA[q] = nvoff[q] * (unsigned)S.pa + (unsigned)(CA[q & 1] * 2); } }
            PG8_LDA(At, 0, 1); PG8_STAGE_B(PG8_SB(0, 0), b2); PG8_STAGE_B(PG8_SB(0, 1), b2 + hstepB); PG8_STAGE_A(PG8_SA(0, 0), a2, 0);
            PG8_WAIT_V(8); PG8_WAIT_L(0); PG8_BAR; PG8_MMA2(1, At); PG8_BAR; PG8_SCHED;
            PG8_LDB(B0, 1, 0); PG8_LDB(B1, 1, 1); PG8_SCHED; PG8_LDA(At, 1, 0); PG8_STAGE_A(PG8_SA(0, 1), a2, 1);
            PG8_WAIT_V(8); PG8_WAIT_L(0); PG8_BAR; PG8_MMA2(0, At); PG8_BAR; PG8_SCHED;
            PG8_LDA(At, 1, 1); PG8_STAGE_B(PG8_SB(1, 0), b3); PG8_STAGE_B(PG8_SB(1, 1), b3 + hstepB); PG8_STAGE_A(PG8_SA(1, 0), a3, 0);
            PG8_WAIT_V(8); PG8_WAIT_L(0); PG8_BAR; PG8_MMA2(1, At); PG8_BAR; PG8_SCHED;
        }
        if (wr == 0) PG8_BAR;
        { const int t2 = fresh_tid() & 63; E(acc, cur, wr, wc, t2 & 15, t2 >> 4, lds + LDS_EPI); }
        if (!has_next) break;
#pragma unroll
        for (int a = 0; a < 2; ++a)
#pragma unroll
            for (int b = 0; b < 2; ++b)
#pragma unroll
                for (int m = 0; m < 4; ++m)
#pragma unroll
                    for (int n = 0; n < 2; ++n) acc[a][b][m][n] = (f32x4){0.f, 0.f, 0.f, 0.f};
        cur = nxt; cA = nA; cB = nB; ++ui;
        if (wr == 1) PG8_BAR;
    }
    PG8_WAIT_V(0);
    PG8_BAR;
#undef PG8_SA
#undef PG8_SB
#undef PG8_STAGE_A
#undef PG8_STAGE_B
#undef PG8_LDA
#undef PG8_LDB
#undef PG8_MMA
#undef PG8_MMA2
#undef PG8_WAIT_V
#undef PG8_WAIT_L
#undef PG8_BAR
#undef PG8_SCHED
}

struct DenseSched {
    static constexpr bool GATHER = false, BLOCKDIAG = false;
    int nM, nN, nwg, G, c; int pa, pb; unsigned A, B;
    __device__ void init(int M, int N, int G_, int c_, size_t A_, int pa_, size_t B_, int pb_) { nM = M / BM; nN = N / BM; nwg = nM * nN; G = G_; c = c_; A = (unsigned)A_; B = (unsigned)B_; pa = pa_; pb = pb_; }
    __device__ __forceinline__ bool next(int i, Unit& u) const {
        const long L = (long)i * G + c; if (L >= nwg) return false;
        int wgid = (int)L; { const int q = nwg / NXCD, r = nwg % NXCD, xcd = wgid % NXCD, off = wgid / NXCD; wgid = (xcd < r ? xcd * (q + 1) : r * (q + 1) + (xcd - r) * q) + off; }
        const int nig = WGM * nN, gid = wgid / nig, fm = gid * WGM, gsz = (nM - fm) < WGM ? (nM - fm) : WGM;
        u.pm = fm + ((wgid % nig) % gsz); u.pn = (wgid % nig) / gsz; u.aux = 0;
        u.a = A + (unsigned)(u.pm * BM * pa); u.b = B + (unsigned)(u.pn * BM * pb); return true;
    }
    __device__ __forceinline__ void offs(const Unit&, const int (&RA)[2], const int (&CA)[2], unsigned (&v)[4]) const {
#pragma unroll
        for (int h = 0; h < 2; ++h)
#pragma unroll
            for (int i = 0; i < 2; ++i) v[h * 2 + i] = (unsigned)((h * HALF + RA[i]) * pa + CA[i] * 2);
    }
};
struct DiagSched : DenseSched { static constexpr bool BLOCKDIAG = true; };
}

struct Params { const float* in[21]; float* out; unsigned char* ws; int ph_lo, ph_hi; };
enum { I_X = 0, I_C, I_POS, I_WADA, I_BADA, I_GMIX, I_GFFN, I_WIN, I_WBG, I_QG, I_KG, I_WBD, I_WBS, I_WOUT, I_WRG, I_BRG, I_WRE, I_BRE, I_WEG, I_WEU, I_WED };

struct Frame {
    LAS unsigned char* lds;
    unsigned char* ws;
    int wave, G, bid;
};

template <bool FP8>
DI void p0_transpose_item(const float* W, int N, void* WTv, int ldt, int k0, int n0, int row_base, LAS float* scr, int lane) {
#pragma unroll 8
    for (int i = 0; i < 32; ++i) { const int kk = 2 * i + (lane >> 5); scr[kk * 33 + (lane & 31)] = W[(size_t)(k0 + kk) * N + n0 + (lane & 31)]; }
    LDS_WAIT();
    const int c = lane & 7;
#pragma unroll
    for (int j = 0; j < 4; ++j) { const int n = (lane >> 3) + 8 * j; const LAS float* sp = scr + (8 * c) * 33 + n;
        if (FP8) { u32x2 o; o.x = pk4_fp8(64.f * sp[0 * 33], 64.f * sp[1 * 33], 64.f * sp[2 * 33], 64.f * sp[3 * 33]); o.y = pk4_fp8(64.f * sp[4 * 33], 64.f * sp[5 * 33], 64.f * sp[6 * 33], 64.f * sp[7 * 33]);
            *(u32x2*)((unsigned char*)WTv + (size_t)(row_base + n) * ldt + k0 + 8 * c) = o; }
        else { u32x4 o; o.x = pk2(sp[0 * 33], sp[1 * 33]); o.y = pk2(sp[2 * 33], sp[3 * 33]); o.z = pk2(sp[4 * 33], sp[5 * 33]); o.w = pk2(sp[6 * 33], sp[7 * 33]);
            *(u32x4*)((bf16_t*)WTv + (size_t)(row_base + n) * ldt + k0 + 8 * c) = o; } }
    LDS_WAIT();
}
DI void phase0(const Frame& F, const Params& p) {
    const int tid_ = fresh_tid(), lane_ = tid_ & 63;
    LAS float* scr = (LAS float*)(F.lds + F.wave * 16384);
    const int gw = F.bid * 8 + F.wave, NGW = F.G * 8;
    bf16_t* W1 = (bf16_t*)(F.ws + WS_W1); bf16_t* WB = (bf16_t*)(F.ws + WS_WB); bf16_t* WO = (bf16_t*)(F.ws + WS_WO);
    unsigned char* WG8 = F.ws + WS_WG8; unsigned char* WGU = F.ws + WS_WGU; unsigned char* WDN = F.ws + WS_WDN;
    constexpr int I1 = 16 * 96, I2 = 16 * 64, I3 = 4 * 32, I4 = 4 * 32, I5 = 16 * 32, I6 = 32 * 256, I7 = 32 * 256, I8 = 32 * 256;
    constexpr int NITEMS = I1 + I2 + I3 + I4 + I5 + I6 + I7 + I8;
    for (int it = gw; it < NITEMS; it += NGW) {
        int r = it;
        if (r < I1) { const int kb = r / 96, nb = r % 96, n0 = 32 * nb, o0 = n0 & 255, rb = (n0 & ~255) + 128 * ((o0 >> 5) & 1) + 32 * (o0 >> 6);
            if (nb < 72) p0_transpose_item<true>(p.in[I_WIN], 3072, F.ws + WS_W1D8, 1024, 64 * kb, n0, rb, scr, lane_); else p0_transpose_item<false>(p.in[I_WIN], 3072, W1, 1024, 64 * kb, n0, rb, scr, lane_); continue; } r -= I1;
        if (r < I2) { const int kb = r / 64, nb = r % 64; p0_transpose_item<true>(p.in[I_WBG], 2048, WG8, 1024, 64 * kb, 32 * nb, 32 * nb, scr, lane_); continue; } r -= I2;
        if (r < I3) { const int kb = r / 32, nb = r % 32, n0 = 32 * nb; p0_transpose_item<true>(p.in[I_WBD], 1024, (unsigned char*)WB, 512, 64 * kb, n0, (n0 >> 7) * 256 + (n0 & 127), scr, lane_); continue; } r -= I3;
        if (r < I4) { const int kb = r / 32, nb = r % 32, n0 = 32 * nb; p0_transpose_item<true>(p.in[I_WBS], 1024, (unsigned char*)WB + 256, 512, 64 * kb, n0, (n0 >> 7) * 256 + 128 + (n0 & 127), scr, lane_); continue; } r -= I4;
        if (r < I5) { const int kb = r / 32, nb = r % 32; p0_transpose_item<true>(p.in[I_WOUT], 1024, WO, 1024, 64 * kb, 32 * nb, 32 * nb, scr, lane_); continue; } r -= I5;
        if (r < I6) { const int e = r >> 8, q = r & 255, kb = q >> 4, nb = q & 15, n0 = 32 * nb;
            p0_transpose_item<true>(p.in[I_WEG] + (size_t)e * 1024 * 512, 512, WGU + (size_t)e * 1024 * 1024, 1024, 64 * kb, n0, (n0 >> 7) * 256 + (n0 & 127), scr, lane_); continue; } r -= I6;
        if (r < I7) { const int e = r >> 8, q = r & 255, kb = q >> 4, nb = q & 15, n0 = 32 * nb;
            p0_transpose_item<true>(p.in[I_WEU] + (size_t)e * 1024 * 512, 512, WGU + (size_t)e * 1024 * 1024, 1024, 64 * kb, n0, (n0 >> 7) * 256 + 128 + (n0 & 127), scr, lane_); continue; } r -= I7;
        { const int e = r >> 8, q = r & 255, kb = q >> 5, nb = q & 31, n0 = 32 * nb, o0 = n0 & 255;
            p0_transpose_item<true>(p.in[I_WED] + (size_t)e * 512 * 1024, 1024, WDN + (size_t)e * 1024 * 512, 512, 64 * kb, n0, (n0 & ~255) + 128 * ((o0 >> 5) & 1) + 32 * (o0 >> 6), scr, lane_); }
    }
    {
        unsigned char* WBz = F.ws + WS_WB;
        for (int idx = F.bid * 512 + tid_; idx < 2048 * 16; idx += F.G * 512) { const int row = idx >> 4, c = idx & 15; *(u32x4*)(WBz + (size_t)row * 512 + ((row & 128) ? 0 : 256) + c * 16) = (u32x4){0u, 0u, 0u, 0u}; }
    }
    {
        float* modp = (float*)(F.ws + WS_MODP); const float* c = p.in[I_C]; const float* wada = p.in[I_WADA];
        for (int task = gw; task < 96 * 8; task += NGW) {
            const int ct = task % 96, ks = task / 96, k0 = ks * 128;
#pragma unroll
            for (int i = 0; i < 16; ++i) { const int idx = i * 64 + lane_, b = idx >> 7, k = idx & 127; const float v = c[b * 1024 + k0 + k]; scr[idx] = v * sigmoidf(v); }
            LDS_WAIT();
            float acc[8];
#pragma unroll
            for (int b = 0; b < 8; ++b) acc[b] = 0.f;
            const float* wp = wada + (size_t)k0 * 6144 + ct * 64 + lane_;
#pragma unroll 8
            for (int k = 0; k < 128; ++k) { const float w = wp[(size_t)k * 6144];
#pragma unroll
                for (int b = 0; b < 8; ++b) acc[b] += scr[b * 128 + k] * w; }
#pragma unroll
            for (int b = 0; b < 8; ++b) modp[((size_t)ks * 8 + b) * 6144 + ct * 64 + lane_] = acc[b];
            LDS_WAIT();
        }
    }
}

DI float inv_freq_of(int i) {
    return i == 0 ? 1.0f : i == 1 ? 0.1939227432012558f : i == 2 ? 0.03760603070259094f : i == 3 ? 0.007292664609849453f : i == 4 ? 0.0014142135623842478f : i == 5 ? 0.00027424818836152554f : i == 6 ? 5.318296098266728e-05f : 1.0313386155758053e-05f;
}
template <int WHICH>
DI void phase_norm(const Frame& F, const Params& p) {
    const int tid_ = fresh_tid(), lane_ = tid_ & 63;
    LAS float* gs = (LAS float*)(F.lds); LAS float* sh = gs + 1024;
    const float* modp = (const float*)(F.ws + WS_MODP); float* mod = (float*)(F.ws + WS_MOD); const float* bada = p.in[I_BADA];
    const float* xin = p.in[I_X]; const bf16_t* upd = (const bf16_t*)(F.ws + WS_UPD1); bf16_t* hout = (bf16_t*)(F.ws + (WHICH == 0 ? WS_H : WS_H2)); unsigned* h8 = (unsigned*)(F.ws + (WHICH == 0 ? WS_H8 : WS_H28));
    const float* gn = p.in[WHICH == 0 ? I_GMIX : I_GFFN];
    for (int chunk = F.bid; chunk < T / 256; chunk += F.G) {
        const int b = chunk >> 5;
        __syncthreads();
        if (WHICH == 0) {
            if (tid_ < 192) { const int j = (chunk & 31) * 192 + tid_; float s = bada[j];
#pragma unroll
                for (int ks = 0; ks < 8; ++ks) s += modp[((size_t)ks * 8 + b) * 6144 + j];
                mod[b * 6144 + j] = s; }
            for (int col = tid_; col < 1024; col += 512) { float s1 = bada[col], s2 = bada[1024 + col];
#pragma unroll
                for (int ks = 0; ks < 8; ++ks) { s1 += modp[((size_t)ks * 8 + b) * 6144 + col]; s2 += modp[((size_t)ks * 8 + b) * 6144 + 1024 + col]; }
                gs[col] = gn[col] * (1.f + s2); sh[col] = s1; }
        } else {
            for (int col = tid_; col < 1024; col += 512) { gs[col] = gn[col] * (1.f + mod[b * 6144 + 4096 + col]); sh[col] = mod[b * 6144 + 3072 + col]; }
        }
        __syncthreads();
        f32x4 g4[4], s4[4];
#pragma unroll
        for (int j = 0; j < 4; ++j) { g4[j] = *(const LAS f32x4*)(gs + 256 * j + 4 * lane_); s4[j] = *(const LAS f32x4*)(sh + 256 * j + 4 * lane_); }
        for (int rr = F.wave; rr < 256; rr += 8) {
            const int row = chunk * 256 + rr;
            const f32x4* xr = (const f32x4*)(xin + (size_t)row * 1024) + lane_;
            f32x4 v[4]; float ss = 0.f;
#pragma unroll
            for (int j = 0; j < 4; ++j) v[j] = xr[64 * j];
            if (WHICH == 1) { const u32x2* ur = (const u32x2*)(upd + (size_t)row * 1024) + lane_; u32x2 uu[4];
#pragma unroll
                for (int j = 0; j < 4; ++j) uu[j] = ur[64 * j];
#pragma unroll
                for (int j = 0; j < 4; ++j) { v[j].x += bf_lo(uu[j].x); v[j].y += bf_hi(uu[j].x); v[j].z += bf_lo(uu[j].y); v[j].w += bf_hi(uu[j].y); } }
#pragma unroll
            for (int j = 0; j < 4; ++j) ss += (v[j].x * v[j].x + v[j].y * v[j].y) + (v[j].z * v[j].z + v[j].w * v[j].w);
            const float rinv = __builtin_amdgcn_rsqf(wave_sum(ss) * (1.f / 1024.f) + RMS_EPS);
            u32x2* o8 = (u32x2*)(hout + (size_t)row * 1024) + lane_;
#pragma unroll
            for (int j = 0; j < 4; ++j) { const f32x4 y = v[j] * rinv * g4[j] + s4[j]; u32x2 o; o.x = pk2(y.x, y.y); o.y = pk2(y.z, y.w); o8[64 * j] = o; h8[(size_t)row * 256 + 64 * j + lane_] = pk4_fp8(y.x, y.y, y.z, y.w); }
            if (WHICH == 0 && lane_ < 8) {
                const int pos = ((const int*)p.in[I_POS])[row];
                const float angf = (float)pos * inv_freq_of(lane_);
                double rv = (double)angf * 0.15915494309189535; rv -= __builtin_rint(rv);
                const float fr = (float)rv;
                bf16_t* rp = (bf16_t*)(F.ws + WS_ROPE) + (size_t)row * 16;
                rp[lane_] = (bf16_t)(pk2(__builtin_amdgcn_cosf(fr), 0.f) & 0xffffu); rp[8 + lane_] = (bf16_t)(pk2(__builtin_amdgcn_sinf(fr), 0.f) & 0xffffu);
            }
        }
    }
}

template <bool GATES> struct EpiProj {
    static constexpr bool PERM = true;
    bf16_t* proj; bf16_t* gates; const bf16_t* rope; const float* qg; const float* kg; int pn0;
    DI void operator()(const f32x4 (&acc)[2][2][4][2], const pg8::Unit& u, int wr, int wc, int fr, int fq, LAS unsigned char* scr) const {
        asm volatile("" : "+v"(fr), "+v"(fq));
        const int pn = u.pn + pn0, row0 = u.pm * 256 + wr * 64 + fr, cw = wc * 32 + 8 * fq;
        const int typ = pn < 9 ? pn / 3 : pn - 9, grp = pn < 9 ? pn % 3 : 0, l2d = pn < 9 ? 2 * grp : 0, hbase = pn < 9 ? grp * 4 : 12;
        if (GATES) {
            unsigned char* base = (unsigned char*)gates + (size_t)(u.pm * 8 + pn) * 65536 + (size_t)(((wr * 4 + wc) * 64 + fq * 16 + fr) * 8);
#pragma unroll
            for (int ai = 0; ai < 2; ++ai)
#pragma unroll
                for (int m = 0; m < 4; ++m)
#pragma unroll
                    for (int bj = 0; bj < 2; ++bj) { const f32x4 v0 = acc[ai][bj][m][0], v1 = acc[ai][bj][m][1];
                        u32x2 w; w.x = pk4_fp8(v0.x, v0.y, v0.z, v0.w); w.y = pk4_fp8(v1.x, v1.y, v1.z, v1.w);
                        *(u32x2*)(base + ((ai * 4 + m) * 2 + bj) * 4096) = w; }
        } else if (pn >= 6 || pn < 3) {
            const float sc = pn == 9 ? QSCALE : 1.f;
            const int head = hbase + wc;
#pragma unroll
            for (int ai = 0; ai < 2; ++ai)
#pragma unroll
                for (int m = 0; m < 4; ++m) { const int t = row0 + ai * 128 + m * 16, sq = t & (S - 1); const int rp = (t & ~(S - 1)) + ((sq & ((1 << l2d) - 1)) << (13 - l2d)) + (sq >> l2d);
                    bf16_t* rowp = proj + ((size_t)(typ * 16 + head) * T + rp) * 64 + 8 * fq;
#pragma unroll
                    for (int bj = 0; bj < 2; ++bj) { const f32x4 v0 = acc[ai][bj][m][0] * sc, v1 = acc[ai][bj][m][1] * sc;
                        u32x4 w; w.x = pk2(v0.x, v0.y); w.y = pk2(v0.z, v0.w); w.z = pk2(v1.x, v1.y); w.w = pk2(v1.z, v1.w);
                        *(u32x4*)(rowp + 32 * bj) = w; } }
        } else {
            const int head = hbase + wc;
            const f32x4 g0 = *(const f32x4*)(kg + 8 * fq), g1 = *(const f32x4*)(kg + 8 * fq + 4), g2 = *(const f32x4*)(kg + 32 + 8 * fq), g3 = *(const f32x4*)(kg + 32 + 8 * fq + 4);
#pragma unroll
            for (int ai = 0; ai < 2; ++ai) {
                u32x4 rcs[4][2];
#pragma unroll
                for (int m = 0; m < 4; ++m) { const u32x4* rpt = (const u32x4*)(rope + (size_t)(u.pm * 256 + ai * 128 + wr * 64 + m * 16 + fr) * 16); rcs[m][0] = rpt[0]; rcs[m][1] = rpt[1]; }
                __builtin_amdgcn_sched_barrier(0);
#pragma unroll
                for (int m = 0; m < 4; ++m) { const int row = u.pm * 256 + ai * 128 + wr * 64 + m * 16 + fr, sq = row & (S - 1);
                    const int rp = (row & ~(S - 1)) + ((sq & ((1 << l2d) - 1)) << (13 - l2d)) + (sq >> l2d);
                    const f32x4 a0 = acc[ai][0][m][0], a1 = acc[ai][0][m][1], b0 = acc[ai][1][m][0], b1 = acc[ai][1][m][1];
                    float ss = ((a0.x * a0.x + a0.y * a0.y) + (a0.z * a0.z + a0.w * a0.w)) + ((a1.x * a1.x + a1.y * a1.y) + (a1.z * a1.z + a1.w * a1.w))
                             + ((b0.x * b0.x + b0.y * b0.y) + (b0.z * b0.z + b0.w * b0.w)) + ((b1.x * b1.x + b1.y * b1.y) + (b1.z * b1.z + b1.w * b1.w));
                    { const unsigned sb_ = __builtin_bit_cast(unsigned, ss); auto r = __builtin_amdgcn_permlane16_swap(sb_, sb_, false, false); const unsigned r0 = r[0], r1 = r[1]; ss = __builtin_bit_cast(float, r0) + __builtin_bit_cast(float, r1); }
                    { const unsigned sb_ = __builtin_bit_cast(unsigned, ss); auto r = __builtin_amdgcn_permlane32_swap(sb_, sb_, false, false); const unsigned r0 = r[0], r1 = r[1]; ss = __builtin_bit_cast(float, r0) + __builtin_bit_cast(float, r1); }
                    const float rinv = __builtin_amdgcn_rsqf(ss * (1.f / 64.f) + RMS_EPS);
                    f32x4 v0 = a0 * (g0 * rinv), v1 = a1 * (g1 * rinv); const f32x4 v2 = b0 * (g2 * rinv), v3 = b1 * (g3 * rinv);
                    f32x4 c0 = {1.f, 1.f, 1.f, 1.f}, c1 = c0, s0 = {0.f, 0.f, 0.f, 0.f}, s1 = s0;
                    if (fq < 2) { const u32x4 cc = rcs[m][0], sn = rcs[m][1];
                        c0 = (f32x4){bf_lo(cc.x), bf_hi(cc.x), bf_lo(cc.y), bf_hi(cc.y)}; c1 = (f32x4){bf_lo(cc.z), bf_hi(cc.z), bf_lo(cc.w), bf_hi(cc.w)};
                        s0 = (f32x4){bf_lo(sn.x), bf_hi(sn.x), bf_lo(sn.y), bf_hi(sn.y)}; s1 = (f32x4){bf_lo(sn.z), bf_hi(sn.z), bf_lo(sn.w), bf_hi(sn.w)};
                        if (fq == 0) { s0 = -s0; s1 = -s1; } }
                    f32x4 p0, p1;
#define KX16(x) ([&] { const unsigned b_ = __builtin_bit_cast(unsigned, (float)(x)); auto r = __builtin_amdgcn_permlane16_swap(b_, b_, false, false); const unsigned r0 = r[0], r1 = r[1]; return __builtin_bit_cast(float, (fq & 1) ? r0 : r1); }())
                    p0.x = KX16(v0.x); p0.y = KX16(v0.y); p0.z = KX16(v0.z); p0.w = KX16(v0.w);
                    p1.x = KX16(v1.x); p1.y = KX16(v1.y); p1.z = KX16(v1.z); p1.w = KX16(v1.w);
#undef KX16
                    v0 = v0 * c0 + p0 * s0; v1 = v1 * c1 + p1 * s1;
                    bf16_t* rowp = proj + ((size_t)(typ * 16 + head) * T + rp) * 64 + 8 * fq;
                    u32x4 w; w.x = pk2(v0.x, v0.y); w.y = pk2(v0.z, v0.w); w.z = pk2(v1.x, v1.y); w.w = pk2(v1.z, v1.w);
                    *(u32x4*)rowp = w;
                    w.x = pk2(v2.x, v2.y); w.y = pk2(v2.z, v2.w); w.z = pk2(v3.x, v3.y); w.w = pk2(v3.z, v3.w);
                    *(u32x4*)(rowp + 32) = w; }
            }
        }
    }
};

struct EpiBranch {
    static constexpr bool PERM = true;
    const unsigned char* gates; unsigned char* merged;
    DI void operator()(const f32x4 (&acc)[2][2][4][2], const pg8::Unit& u, int wr, int wc, int fr, int fq, LAS unsigned char*) const {
        asm volatile("" : "+v"(fr), "+v"(fq));
        const int row0 = u.pm * 256 + wr * 64 + fr, col0 = u.pn * 128 + wc * 32 + 8 * fq;
        const unsigned char* gbase = gates + (size_t)(u.pm * 8 + (u.pn >> 1)) * 65536 + (size_t)((u.pn & 1) * 4096) + (size_t)(((wr * 4 + wc) * 64 + fq * 16 + fr) * 8);
        u32x2 gd[2][4], gs[2][4];
#pragma unroll
        for (int ai = 0; ai < 2; ++ai)
#pragma unroll
            for (int m = 0; m < 4; ++m) { const unsigned char* gp = gbase + ((ai * 4 + m) * 2) * 4096;
                gd[ai][m] = *(const u32x2*)gp; gs[ai][m] = *(const u32x2*)(gp + 4 * 65536); }
        __builtin_amdgcn_sched_barrier(0);
#pragma unroll
        for (int ai = 0; ai < 2; ++ai)
#pragma unroll
            for (int m = 0; m < 4; ++m) { const size_t row = (size_t)(row0 + ai * 128 + m * 16);
                const u32x2 g = gd[ai][m], q = gs[ai][m];
                const f32x2 ga = fp8_lo2(g.x), gb = fp8_hi2(g.x), gc = fp8_lo2(g.y), gdd = fp8_hi2(g.y), qa = fp8_lo2(q.x), qb = fp8_hi2(q.x), qc = fp8_lo2(q.y), qd = fp8_hi2(q.y);
                const f32x4 v0 = acc[ai][0][m][0] * (f32x4){sigmoidf(ga.x), sigmoidf(ga.y), sigmoidf(gb.x), sigmoidf(gb.y)} + acc[ai][1][m][0] * (f32x4){sigmoidf(qa.x), sigmoidf(qa.y), sigmoidf(qb.x), sigmoidf(qb.y)};
                const f32x4 v1 = acc[ai][0][m][1] * (f32x4){sigmoidf(gc.x), sigmoidf(gc.y), sigmoidf(gdd.x), sigmoidf(gdd.y)} + acc[ai][1][m][1] * (f32x4){sigmoidf(qc.x), sigmoidf(qc.y), sigmoidf(qd.x), sigmoidf(qd.y)};
                u32x2 w; w.x = pk4_fp8(8.f * v0.x, 8.f * v0.y, 8.f * v0.z, 8.f * v0.w); w.y = pk4_fp8(8.f * v1.x, 8.f * v1.y, 8.f * v1.z, 8.f * v1.w);
                *(u32x2*)(merged + row * 1024 + col0) = w; }
    }
};
struct BranchSched {
    static constexpr bool GATHER = false;
    int G, c; int pa, pb; unsigned A, B;
    DI bool next(int i, pg8::Unit& u) const {
        const int tile = (i >> 1) * G + c; if (tile >= 256 * 4) return false;
        u.pm = tile >> 2; u.pn = tile & 3; u.aux = i & 1;
        u.a = A + (unsigned)(u.pm * 256 * LDO * 2 + u.aux * 256 * 2); u.b = B + (unsigned)(u.aux * 1024 * 256 * 2 + u.pn * 256 * 256 * 2); return true;
    }
    DI void offs(const pg8::Unit&, const int (&RA)[2], const int (&CA)[2], unsigned (&v)[4]) const {
#pragma unroll
        for (int h = 0; h < 2; ++h)
#pragma unroll
            for (int i = 0; i < 2; ++i) v[h * 2 + i] = (unsigned)((h * 128 + RA[i]) * pa + CA[i] * 2);
    }
};

struct EpiOut {
    static constexpr bool PERM = true;
    bf16_t* upd; const float* mod;
    DI void operator()(const f32x4 (&acc)[2][2][4][2], const pg8::Unit& u, int wr, int wc, int fr, int fq, LAS unsigned char*) const {
        asm volatile("" : "+v"(fr), "+v"(fq));
        const int row0 = u.pm * 256 + wr * 64 + fr, col0 = u.pn * 256 + wc * 32 + 8 * fq; const int b = (u.pm * 256) >> 13;
        f32x4 gv[2][2];
#pragma unroll
        for (int bj = 0; bj < 2; ++bj)
#pragma unroll
            for (int n = 0; n < 2; ++n) gv[bj][n] = *(const f32x4*)(mod + b * 6144 + 2048 + col0 + bj * 128 + n * 4) * 0.125f;
#pragma unroll
        for (int ai = 0; ai < 2; ++ai)
#pragma unroll
            for (int m = 0; m < 4; ++m)
#pragma unroll
                for (int bj = 0; bj < 2; ++bj) { const f32x4 v0 = acc[ai][bj][m][0] * gv[bj][0], v1 = acc[ai][bj][m][1] * gv[bj][1];
                    u32x4 w; w.x = pk2(v0.x, v0.y); w.y = pk2(v0.z, v0.w); w.z = pk2(v1.x, v1.y); w.w = pk2(v1.z, v1.w);
                    *(u32x4*)(upd + (size_t)(row0 + ai * 128 + m * 16) * 1024 + col0 + bj * 128) = w; }
    }
};

struct EpiLogit {
    static constexpr bool PERM = false;
    float* logit;
    DI void operator()(const f32x4 (&acc)[2][2][4][2], const pg8::Unit& u, int wr, int wc, int fr, int fq, LAS unsigned char*) const {
        asm volatile("" : "+v"(fr), "+v"(fq));
        const int row0 = u.pm * 256 + wr * 64 + fr, col0 = wc * 32 + 4 * fq;
#pragma unroll
        for (int ai = 0; ai < 2; ++ai)
#pragma unroll
            for (int m = 0; m < 4; ++m)
#pragma unroll
                for (int n = 0; n < 2; ++n) *(f32x4*)(logit + (size_t)(row0 + ai * 128 + m * 16) * 128 + col0 + n * 16) = acc[ai][0][m][n];
    }
};

struct MoeSched {
    static constexpr bool GATHER_ = true;
    int G, c, nc; int pa, pb; unsigned A, B; const LAS int* cstart; const int* slot_tok; unsigned estride, pnstride;
};
struct MoeSchedUp : MoeSched {
    static constexpr bool GATHER = true, BLOCKDIAG = false;
    DI bool next(int i, pg8::Unit& u) const {
        const int L = i * G + c; if (L >= nc * 4) return false;
        const int chunk = L >> 2; int e = 0;
        for (int q = 1; q < 32; ++q) e += (chunk >= cstart[q]) ? 1 : 0;
        e = __builtin_amdgcn_readfirstlane(e);
        u.pm = chunk; u.pn = L & 3; u.aux = e; u.a = A; u.b = B + (unsigned)e * estride + (unsigned)u.pn * pnstride; return true;
    }
    DI void offs(const pg8::Unit& u, const int (&RA)[2], const int (&CA)[2], unsigned (&v)[4]) const {
#pragma unroll
        for (int h = 0; h < 2; ++h)
#pragma unroll
            for (int i = 0; i < 2; ++i) { const int tok = slot_tok[u.pm * 256 + h * 128 + RA[i]]; v[h * 2 + i] = (unsigned)(tok * pa + CA[i] * 2); }
    }
    DI void rows(const pg8::Unit& u, const int (&RA)[2], unsigned (&v)[4]) const {
#pragma unroll
        for (int h = 0; h < 2; ++h)
#pragma unroll
            for (int i = 0; i < 2; ++i) v[h * 2 + i] = (unsigned)slot_tok[u.pm * 256 + h * 128 + RA[i]];
    }
};
struct MoeSchedDn : MoeSched {
    static constexpr bool GATHER = false, BLOCKDIAG = false;
    DI bool next(int i, pg8::Unit& u) const {
        const int L = i * G + c; if (L >= nc * 4) return false;
        const int chunk = L >> 2; int e = 0;
        for (int q = 1; q < 32; ++q) e += (chunk >= cstart[q]) ? 1 : 0;
        e = __builtin_amdgcn_readfirstlane(e);
        u.pm = chunk; u.pn = L & 3; u.aux = e; u.a = A + (unsigned)(chunk * 256 * pa); u.b = B + (unsigned)e * estride + (unsigned)u.pn * pnstride; return true;
    }
    DI void offs(const pg8::Unit&, const int (&RA)[2], const int (&CA)[2], unsigned (&v)[4]) const {
#pragma unroll
        for (int h = 0; h < 2; ++h)
#pragma unroll
            for (int i = 0; i < 2; ++i) v[h * 2 + i] = (unsigned)((h * 128 + RA[i]) * pa + CA[i] * 2);
    }
};
struct EpiSwiglu {
    static constexpr bool PERM = true;
    unsigned char* hmid;
    DI void operator()(const f32x4 (&acc)[2][2][4][2], const pg8::Unit& u, int wr, int wc, int fr, int fq, LAS unsigned char*) const {
        asm volatile("" : "+v"(fr), "+v"(fq));
        const int row0 = u.pm * 256 + wr * 64 + fr, col0 = u.pn * 128 + wc * 32 + 8 * fq;
#pragma unroll
        for (int ai = 0; ai < 2; ++ai)
#pragma unroll
            for (int m = 0; m < 4; ++m) {
                f32x4 h[2];
#pragma unroll
                for (int n = 0; n < 2; ++n) { const f32x4 g = acc[ai][0][m][n], up = acc[ai][1][m][n];
                    h[n] = (f32x4){g.x * sigmoidf(g.x) * up.x, g.y * sigmoidf(g.y) * up.y, g.z * sigmoidf(g.z) * up.z, g.w * sigmoidf(g.w) * up.w}; }
                u32x2 w; w.x = pk4_fp8(h[0].x, h[0].y, h[0].z, h[0].w); w.y = pk4_fp8(h[1].x, h[1].y, h[1].z, h[1].w);
                *(u32x2*)(hmid + (size_t)(row0 + ai * 128 + m * 16) * DE + col0) = w; }
    }
};
struct EpiDown {
    static constexpr bool PERM = true;
    unsigned char* y;
    DI void operator()(const f32x4 (&acc)[2][2][4][2], const pg8::Unit& u, int wr, int wc, int fr, int fq, LAS unsigned char*) const {
        asm volatile("" : "+v"(fr), "+v"(fq));
        const int row0 = u.pm * 256 + wr * 64 + fr, col0 = u.pn * 256 + wc * 64 + (fq & 1) * 32 + (fq >> 1) * 16;
#pragma unroll
        for (int ai = 0; ai < 2; ++ai)
#pragma unroll
            for (int m = 0; m < 4; ++m) { const int slot = row0 + ai * 128 + m * 16;
                u32x2 o[2];
#pragma unroll
                for (int bj = 0; bj < 2; ++bj) { const f32x4 v0 = acc[ai][bj][m][0] * 8.f, v1 = acc[ai][bj][m][1] * 8.f; o[bj].x = pk4_fp8(v0.x, v0.y, v0.z, v0.w); o[bj].y = pk4_fp8(v1.x, v1.y, v1.z, v1.w); }
                u32x4 w;
                { auto r = __builtin_amdgcn_permlane16_swap(o[0].x, o[1].x, false, false); w.x = r[0]; w.z = r[1]; }
                { auto r = __builtin_amdgcn_permlane16_swap(o[0].y, o[1].y, false, false); w.y = r[0]; w.w = r[1]; }
                *(u32x4*)(y + (size_t)slot * 1024 + col0) = w; }
    }
};

constexpr int SLOT_BYTES = 8192;
DI f32x16 mfma32(bf16x8 a, bf16x8 b, f32x16 c) { return __builtin_amdgcn_mfma_f32_32x32x16_bf16(a, b, c, 0, 0, 0); }
DI int swz_f(int r) { return (((r >> 1) & 1) << 2) | ((r >> 2) & 3); }
struct AttnLane { unsigned doff[4]; unsigned ka[4]; unsigned va[2][2]; };
DI void attn_lane_init(AttnLane& L, int lane) {
#pragma unroll
    for (int i = 0; i < 4; ++i) { const int r = 8 * i + (lane >> 3), c = (lane & 7) ^ swz_f(r); L.doff[i] = (unsigned)(r * 128 + c * 16); }
    { const int r = lane & 31, h = lane >> 5; const unsigned a0 = (unsigned)(r * 128 + 16 * ((h ^ swz_f(r)) & 7));
#pragma unroll
      for (int s = 0; s < 4; ++s) L.ka[s] = a0 ^ (unsigned)(32 * s); }
    { const int h = lane >> 5, blk = (lane >> 4) & 1, q = (lane & 15) >> 2, p = lane & 3, fb2 = (q >> 1) & 1;
#pragma unroll
      for (int t = 0; t < 2; ++t) { const int flow = (2 * t + h) & 3;
#pragma unroll
        for (int mt = 0; mt < 2; ++mt) L.va[t][mt] = (unsigned)(4096 + (8 * t + 4 * h + q) * 128 + 16 * (4 * (mt ^ fb2) + ((2 * blk + (p >> 1)) ^ flow)) + 8 * (p & 1)); } }
}
DI void dma_tile(const AttnLane& L, const __amdgpu_buffer_rsrc_t rs, unsigned koff, unsigned voff, LAS unsigned char* slot) {
#pragma unroll
    for (int i = 0; i < 4; ++i) __builtin_amdgcn_raw_ptr_buffer_load_lds(rs, (LAS unsigned*)(slot + 1024 * i), 16, (int)L.doff[i], (int)koff, 0, 0);
#pragma unroll
    for (int i = 0; i < 4; ++i) __builtin_amdgcn_raw_ptr_buffer_load_lds(rs, (LAS unsigned*)(slot + 4096 + 1024 * i), 16, (int)L.doff[i], (int)voff, 0, 0);
}
DI void dma_q(const AttnLane& L, const __amdgpu_buffer_rsrc_t rs, unsigned qoff, LAS unsigned char* slot) {
#pragma unroll
    for (int i = 0; i < 4; ++i) __builtin_amdgcn_raw_ptr_buffer_load_lds(rs, (LAS unsigned*)(slot + 1024 * i), 16, (int)L.doff[i], (int)qoff, 0, 0);
}
DI void tr_read8(const AttnLane& L, unsigned sb, bf16x8 (&vf)[2][2]) {
    s16x4 r0, r1, r2, r3, r4, r5, r6, r7;
    const unsigned a00 = sb + L.va[0][0], a10 = sb + L.va[1][0], a01 = sb + L.va[0][1], a11 = sb + L.va[1][1];
    asm volatile("ds_read_b64_tr_b16 %0, %8\n\tds_read_b64_tr_b16 %1, %9\n\tds_read_b64_tr_b16 %2, %8 offset:2048\n\tds_read_b64_tr_b16 %3, %9 offset:2048\n\t"
                 "ds_read_b64_tr_b16 %4, %10\n\tds_read_b64_tr_b16 %5, %11\n\tds_read_b64_tr_b16 %6, %10 offset:2048\n\tds_read_b64_tr_b16 %7, %11 offset:2048\n\ts_waitcnt lgkmcnt(0)"
                 : "=&v"(r0), "=&v"(r1), "=&v"(r2), "=&v"(r3), "=&v"(r4), "=&v"(r5), "=&v"(r6), "=&v"(r7)
                 : "v"(a00), "v"(a10), "v"(a01), "v"(a11) : "memory");
    vf[0][0] = __builtin_shufflevector(r0, r1, 0, 1, 2, 3, 4, 5, 6, 7); vf[0][1] = __builtin_shufflevector(r2, r3, 0, 1, 2, 3, 4, 5, 6, 7);
    vf[1][0] = __builtin_shufflevector(r4, r5, 0, 1, 2, 3, 4, 5, 6, 7); vf[1][1] = __builtin_shufflevector(r6, r7, 0, 1, 2, 3, 4, 5, 6, 7);
}
DI bf16x8 pack8(const f32x16& x, int s) {
    u32x4 p; p.x = pk2(x[8 * s], x[8 * s + 1]); p.y = pk2(x[8 * s + 2], x[8 * s + 3]); p.z = pk2(x[8 * s + 4], x[8 * s + 5]); p.w = pk2(x[8 * s + 6], x[8 * s + 7]);
    return __builtin_bit_cast(bf16x8, p);
}
DI void store_o_row(bf16_t* rowp, const f32x16& O0, const f32x16& O1, float sc, int h) {
#pragma unroll
    for (int mt = 0; mt < 2; ++mt)
#pragma unroll
        for (int kp = 0; kp < 2; ++kp) { const f32x16& O = mt ? O1 : O0; const int g0 = 8 * kp, g1 = 8 * kp + 4;
            u32x2 a, b; a.x = pk2(O[g0] * sc, O[g0 + 1] * sc); a.y = pk2(O[g0 + 2] * sc, O[g0 + 3] * sc); b.x = pk2(O[g1] * sc, O[g1 + 1] * sc); b.y = pk2(O[g1 + 2] * sc, O[g1 + 3] * sc);
            { auto r = __builtin_amdgcn_permlane32_swap(a.x, b.x, false, false); a.x = r[0]; b.x = r[1]; }
            { auto r = __builtin_amdgcn_permlane32_swap(a.y, b.y, false, false); a.y = r[0]; b.y = r[1]; }
            *(u32x4*)(rowp + 32 * mt + 16 * kp + 8 * h) = (u32x4){a.x, a.y, b.x, b.y}; }
}
DI void store_o_row_fp8(unsigned char* rowp, const f32x16& O0, const f32x16& O1, int h) {
#pragma unroll
    for (int mt = 0; mt < 2; ++mt)
#pragma unroll
        for (int kp = 0; kp < 2; ++kp) { const f32x16& O = mt ? O1 : O0; const int g0 = 8 * kp, g1 = 8 * kp + 4;
            unsigned a = pk4_fp8(O[g0], O[g0 + 1], O[g0 + 2], O[g0 + 3]), b = pk4_fp8(O[g1], O[g1 + 1], O[g1 + 2], O[g1 + 3]);
            { auto r = __builtin_amdgcn_permlane32_swap(a, b, false, false); a = r[0]; b = r[1]; }
            *(u32x2*)(rowp + 32 * mt + 16 * kp + 8 * h) = (u32x2){a, b}; }
}
#define ATTN_WAIT_TILE(more) do { if (more) asm volatile("s_waitcnt vmcnt(8)" ::: "memory"); else asm volatile("s_waitcnt vmcnt(0)" ::: "memory"); } while (0)
DI void q_prep(bf16x8 (&qf)[4], const AttnLane& L, LAS unsigned char* qimg, const u32x4 cc, const u32x4 sn, const float* qg, int h) {
    u32x4 qr[4];
#pragma unroll
    for (int s = 0; s < 4; ++s) qr[s] = *(const LAS u32x4*)(qimg + L.ka[s]);
    float qv[4][8]; float ss = 0.f;
#pragma unroll
    for (int s = 0; s < 4; ++s) { const u32x4 u = qr[s]; qv[s][0] = bf_lo(u.x); qv[s][1] = bf_hi(u.x); qv[s][2] = bf_lo(u.y); qv[s][3] = bf_hi(u.y); qv[s][4] = bf_lo(u.z); qv[s][5] = bf_hi(u.z); qv[s][6] = bf_lo(u.w); qv[s][7] = bf_hi(u.w);
#pragma unroll
        for (int e = 0; e < 8; ++e) ss += qv[s][e] * qv[s][e]; }
    ss = xsum32(ss);
    const float rinv = __builtin_amdgcn_rsqf(ss * (1.f / 64.f) + RMS_EPS) * QSCALE;
#pragma unroll
    for (int s = 0; s < 4; ++s) { const f32x4 ga = *(const f32x4*)(qg + 16 * s + 8 * h), gb = *(const f32x4*)(qg + 16 * s + 8 * h + 4);
        qv[s][0] *= rinv * ga.x; qv[s][1] *= rinv * ga.y; qv[s][2] *= rinv * ga.z; qv[s][3] *= rinv * ga.w; qv[s][4] *= rinv * gb.x; qv[s][5] *= rinv * gb.y; qv[s][6] *= rinv * gb.z; qv[s][7] *= rinv * gb.w; }
    { const float cs[8] = {bf_lo(cc.x), bf_hi(cc.x), bf_lo(cc.y), bf_hi(cc.y), bf_lo(cc.z), bf_hi(cc.z), bf_lo(cc.w), bf_hi(cc.w)};
      const float sv[8] = {bf_lo(sn.x), bf_hi(sn.x), bf_lo(sn.y), bf_hi(sn.y), bf_lo(sn.z), bf_hi(sn.z), bf_lo(sn.w), bf_hi(sn.w)};
#pragma unroll
      for (int e = 0; e < 8; ++e) { const float other = xget32(qv[0][e], h); qv[0][e] = qv[0][e] * cs[e] + other * (h ? sv[e] : -sv[e]); } }
#pragma unroll
    for (int s = 0; s < 4; ++s) { u32x4 o; o.x = pk2(qv[s][0], qv[s][1]); o.y = pk2(qv[s][2], qv[s][3]); o.z = pk2(qv[s][4], qv[s][5]); o.w = pk2(qv[s][6], qv[s][7]); qf[s] = __builtin_bit_cast(bf16x8, o); }
}
DI void sm_step(f32x16& sc, float& mrun, float& lrun, f32x16& O0, f32x16& O1, bf16x8& p0, bf16x8& p1) {
    float mx = sc[0];
#pragma unroll
    for (int i = 1; i < 16; ++i) mx = fmaxf(mx, sc[i]);
    mx = xmax32(mx);
    const float mnew = fmaxf(mrun, mx), alpha = fexp2(mrun - mnew);
    float ps = 0.f;
#pragma unroll
    for (int i = 0; i < 16; ++i) { sc[i] = fexp2(sc[i] - mnew); ps += sc[i]; }
    lrun = lrun * alpha + ps; mrun = mnew;
#pragma unroll
    for (int i = 0; i < 16; ++i) { O0[i] *= alpha; O1[i] *= alpha; }
    p0 = pack8(sc, 0); p1 = pack8(sc, 1);
}
DI void dil_pair(const AttnLane& L, const __amdgpu_buffer_rsrc_t rs, const bf16_t* hb, int hd, long row0, int j, LAS unsigned char* ldsW, bf16_t* og, float* lse, int lrow0, int lane, const float* qg, const bf16_t* ropet, long tok0, int dil) {
    const int qi = lane & 31, h = lane >> 5;
    const unsigned kh = (unsigned)(WS_PROJ + ((size_t)(16 + hd) * T + row0) * 128), vh = (unsigned)(WS_PROJ + ((size_t)(32 + hd) * T + row0) * 128);
    const int kt0 = j >= 4 ? j - 4 : 0;
    bf16x8 qa[4], qb[4];
    {
        const unsigned qoff = (unsigned)(WS_PROJ + ((size_t)hd * T + row0 + 32 * j) * 128);
        dma_q(L, rs, qoff, ldsW + SLOT_BYTES); dma_q(L, rs, qoff + 4096u, ldsW + SLOT_BYTES + 4096);
        dma_tile(L, rs, kh + (unsigned)(4096 * kt0), vh + (unsigned)(4096 * kt0), ldsW);
        const u32x4* rpa = (const u32x4*)(ropet + (size_t)(tok0 + (long)dil * (32 * j + qi)) * 16); const u32x4* rpb = (const u32x4*)(ropet + (size_t)(tok0 + (long)dil * (32 * j + 32 + qi)) * 16);
        const u32x4 cca = rpa[0], sna = rpa[1], ccb = rpb[0], snb = rpb[1];
        asm volatile("s_waitcnt vmcnt(8)" ::: "memory");
        q_prep(qa, L, ldsW + SLOT_BYTES, cca, sna, qg, h);
        q_prep(qb, L, ldsW + SLOT_BYTES + 4096, ccb, snb, qg, h);
    }
    float ma = -INFINITY, la = 0.f, mb = -INFINITY, lb = 0.f;
    f32x16 A0, A1, B0, B1;
#pragma unroll
    for (int i = 0; i < 16; ++i) { A0[i] = 0.f; A1[i] = 0.f; B0[i] = 0.f; B1[i] = 0.f; }
    LDS_WAIT();
    unsigned buf = 0;
    for (int kt = kt0; kt <= j + 1; ++kt) {
        const bool more = kt <= j;
        if (more) dma_tile(L, rs, kh + (unsigned)(4096 * (kt + 1)), vh + (unsigned)(4096 * (kt + 1)), ldsW + (buf ^ 1u) * SLOT_BYTES);
        ATTN_WAIT_TILE(more);
        LAS unsigned char* slot = ldsW + buf * SLOT_BYTES;
        const bool useA = kt <= j, useB = kt >= j - 3;
        bf16x8 kf[4];
#pragma unroll
        for (int s = 0; s < 4; ++s) kf[s] = *(const LAS bf16x8*)(slot + L.ka[s]);
        f32x16 sa, sb;
#pragma unroll
        for (int i = 0; i < 16; ++i) { sa[i] = 0.f; sb[i] = 0.f; }
        if (useA) {
#pragma unroll
            for (int s = 0; s < 4; ++s) sa = mfma32(kf[s], qa[s], sa);
        }
        if (useB) {
#pragma unroll
            for (int s = 0; s < 4; ++s) sb = mfma32(kf[s], qb[s], sb);
        }
        if (kt == j) {
#pragma unroll
            for (int i = 0; i < 16; ++i) { const int key = (i & 3) + 8 * (i >> 2) + 4 * h; if (key > qi) sa[i] = -INFINITY; }
        }
        if (kt == j + 1) {
#pragma unroll
            for (int i = 0; i < 16; ++i) { const int key = (i & 3) + 8 * (i >> 2) + 4 * h; if (key > qi) sb[i] = -INFINITY; }
        }
        if (kt == j - 4) {
#pragma unroll
            for (int i = 0; i < 16; ++i) { const int key = (i & 3) + 8 * (i >> 2) + 4 * h; if (key < qi) sa[i] = -INFINITY; }
        }
        if (kt == j - 3) {
#pragma unroll
            for (int i = 0; i < 16; ++i) { const int key = (i & 3) + 8 * (i >> 2) + 4 * h; if (key < qi) sb[i] = -INFINITY; }
        }
        bf16x8 pa0, pa1, pb0, pb1;
        if (useA) sm_step(sa, ma, la, A0, A1, pa0, pa1);
        if (useB) sm_step(sb, mb, lb, B0, B1, pb0, pb1);
        bf16x8 vf[2][2]; tr_read8(L, (unsigned)(size_t)slot, vf);
        if (useA) { A0 = mfma32(vf[0][0], pa0, A0); A0 = mfma32(vf[0][1], pa1, A0); A1 = mfma32(vf[1][0], pa0, A1); A1 = mfma32(vf[1][1], pa1, A1); }
        if (useB) { B0 = mfma32(vf[0][0], pb0, B0); B0 = mfma32(vf[0][1], pb1, B0); B1 = mfma32(vf[1][0], pb0, B1); B1 = mfma32(vf[1][1], pb1, B1); }
        buf ^= 1u;
    }
    {   const float ltot = xsum32(la), inv = frcp(ltot); const int row = lrow0 + qi;
        store_o_row(og + (size_t)row * 64, A0, A1, inv, h);
        if (h == 0) lse[row] = ma + flog2(ltot); }
    {   const float ltot = xsum32(lb), inv = frcp(ltot); const int row = lrow0 + 32 + qi;
        store_o_row(og + (size_t)row * 64, B0, B1, inv, h);
        if (h == 0) lse[row] = mb + flog2(ltot); }
}
DI void sb_tile(const AttnLane& L, const __amdgpu_buffer_rsrc_t rs, const bf16_t* hb, int b, int h4, int j, LAS unsigned char* ldsW, unsigned char* ocat, int lane) {
    const int qi = lane & 31, h = lane >> 5;
    const long base = (long)b * S;
    const bf16_t* qh = hb + (size_t)(12 + h4) * T * 64;
    const unsigned kh = (unsigned)(WS_PROJ + ((size_t)(16 + 12 + h4) * T + base) * 128), vh = (unsigned)(WS_PROJ + ((size_t)(32 + 12 + h4) * T + base) * 128);
    bf16x8 qf[4];
    { const bf16_t* qp = qh + (size_t)(base + 32 * j + qi) * 64 + 8 * h;
#pragma unroll
      for (int s = 0; s < 4; ++s) qf[s] = *(const bf16x8*)(qp + 16 * s); }
    float carry = 0.f;
    f32x16 O0, O1;
#pragma unroll
    for (int i = 0; i < 16; ++i) { O0[i] = 0.f; O1[i] = 0.f; }
    dma_tile(L, rs, kh + (unsigned)(4096 * j), vh + (unsigned)(4096 * j), ldsW);
    unsigned buf = 0;
    for (int kt = j; kt >= 0; --kt) {
        const bool more = kt > 0;
        if (more) dma_tile(L, rs, kh + (unsigned)(4096 * (kt - 1)), vh + (unsigned)(4096 * (kt - 1)), ldsW + (buf ^ 1u) * SLOT_BYTES);
        ATTN_WAIT_TILE(more);
        LAS unsigned char* slot = ldsW + buf * SLOT_BYTES;
        f32x16 z;
#pragma unroll
        for (int i = 0; i < 16; ++i) z[i] = 0.f;
#pragma unroll
        for (int s = 0; s < 4; ++s) { const bf16x8 kf = *(const LAS bf16x8*)(slot + L.ka[s]); z = mfma32(kf, qf[s], z); }
#pragma unroll
        for (int i = 0; i < 16; ++i) z[i] = fexp2(fminf(z[i], 31.f));
        if (kt == j) {
#pragma unroll
            for (int i = 0; i < 16; ++i) { const int key = (i & 3) + 8 * (i >> 2) + 4 * h; if (key >= qi) z[i] = 0.f; }
        }
        float lg[4], par[4], u0[4], p01[4], p012[4];
#pragma unroll
        for (int g = 0; g < 4; ++g) { const float a0 = 1.f + z[4 * g], a1 = 1.f + z[4 * g + 1], a2 = 1.f + z[4 * g + 2], a3 = 1.f + z[4 * g + 3];
            u0[g] = a0; p01[g] = a0 * a1; p012[g] = p01[g] * a2; lg[g] = -flog2(p012[g] * a3); }
#pragma unroll
        for (int g = 0; g < 4; ++g) par[g] = xget32(lg[g], h);
        float tg[4]; tg[3] = carry; tg[2] = tg[3] + (lg[3] + par[3]); tg[1] = tg[2] + (lg[2] + par[2]); tg[0] = tg[1] + (lg[1] + par[1]);
        carry = tg[0] + (lg[0] + par[0]);
#pragma unroll
        for (int g = 0; g < 4; ++g) { const float suf = tg[g] + lg[g] + (h == 0 ? par[g] : 0.f); const float y = fexp2(suf);
            z[4 * g] = z[4 * g] * y; z[4 * g + 1] = z[4 * g + 1] * (y * u0[g]); z[4 * g + 2] = z[4 * g + 2] * (y * p01[g]); z[4 * g + 3] = z[4 * g + 3] * (y * p012[g]); }
        const bf16x8 p0 = pack8(z, 0), p1 = pack8(z, 1);
        bf16x8 vf[2][2]; tr_read8(L, (unsigned)(size_t)slot, vf);
        O0 = mfma32(vf[0][0], p0, O0); O0 = mfma32(vf[0][1], p1, O0);
        O1 = mfma32(vf[1][0], p0, O1); O1 = mfma32(vf[1][1], p1, O1);
        if (__all(carry < -40.f)) break;
        buf ^= 1u;
    }
    store_o_row_fp8(ocat + (size_t)(base + 32 * j + qi) * LDO + 256 + h4 * 64, O0, O1, h);
}
DI void phase_attn(const Frame& F, const Params& p) {
    const int tid_ = fresh_tid(), lane_ = tid_ & 63;
    const bf16_t* hb = (const bf16_t*)(F.ws + WS_PROJ); unsigned char* ocat = F.ws + WS_OCAT;
    bf16_t* og = (bf16_t*)(F.ws + WS_OG) + (size_t)F.bid * (3 * 1024 * 64); float* lse = (float*)(F.ws + WS_LSE) + (size_t)F.bid * (3 * 1024);
    LAS unsigned char* ldsW = F.lds + F.wave * (2 * SLOT_BYTES);
    AttnLane L; attn_lane_init(L, lane_);
    const __amdgpu_buffer_rsrc_t rs = __builtin_amdgcn_make_buffer_rsrc(F.ws, 0, (int)WS_END, 0x00020000);
    const int NU = NB * 4 * 8;
    for (int i = 0;; ++i) {
        const int u = (F.G == 256) ? ((F.bid & 7) * 32 + (F.bid >> 3) + 256 * i) : (F.bid + F.G * i);
        if (u >= NU) break;
        const int qb = u & 7, hs = (u >> 3) & 3, b = u >> 5, t0 = qb * 1024;
        if (i > 0) __syncthreads();
        for (int w = F.wave; w < 32; w += 8) sb_tile(L, rs, hb, b, hs, t0 / 32 + w, ldsW, ocat, lane_);
        for (int w = F.wave; w < 48; w += 8) {
            const int g = w >> 4, ti = 2 * (w & 15), l2d = 2 * g, per = 32 >> l2d, r = ti / per, jj = ti % per;
            dil_pair(L, rs, hb, g * 4 + hs, (long)b * S + (long)r * (S >> l2d), ((t0 >> l2d) >> 5) + jj, ldsW, og + (size_t)g * (1024 * 64), lse + g * 1024, ti * 32, lane_, p.in[I_QG], (const bf16_t*)(F.ws + WS_ROPE), (long)b * S + r, 1 << l2d);
        }
        VM_WAIT();
        __syncthreads();
        {
            const int piece = tid_ & 7; const size_t bb = (size_t)b * S;
#pragma unroll 2
            for (int pass = 0; pass < 16; ++pass) {
                const int sq = t0 + pass * 64 + (tid_ >> 3);
                const int r0 = sq - t0, r1 = 1024 + (sq & 3) * 256 + ((sq - t0) >> 2), r2 = 2048 + (sq & 15) * 64 + ((sq - t0) >> 4);
                const float l0 = lse[r0], l1 = lse[r1], l2 = lse[r2];
                const u32x4 x = *((const u32x4*)(og + (size_t)r0 * 64) + piece), y = *((const u32x4*)(og + (size_t)r1 * 64) + piece), z = *((const u32x4*)(og + (size_t)r2 * 64) + piece);
                const float mx = fmaxf(l0, fmaxf(l1, l2)); float w0 = fexp2(l0 - mx), w1 = fexp2(l1 - mx), w2 = fexp2(l2 - mx); const float inv = frcp(w0 + w1 + w2); w0 *= inv; w1 *= inv; w2 *= inv;
                u32x2 r;
                r.x = pk4_fp8(w0 * bf_lo(x.x) + w1 * bf_lo(y.x) + w2 * bf_lo(z.x), w0 * bf_hi(x.x) + w1 * bf_hi(y.x) + w2 * bf_hi(z.x), w0 * bf_lo(x.y) + w1 * bf_lo(y.y) + w2 * bf_lo(z.y), w0 * bf_hi(x.y) + w1 * bf_hi(y.y) + w2 * bf_hi(z.y));
                r.y = pk4_fp8(w0 * bf_lo(x.z) + w1 * bf_lo(y.z) + w2 * bf_lo(z.z), w0 * bf_hi(x.z) + w1 * bf_hi(y.z) + w2 * bf_hi(z.z), w0 * bf_lo(x.w) + w1 * bf_lo(y.w) + w2 * bf_lo(z.w), w0 * bf_hi(x.w) + w1 * bf_hi(y.w) + w2 * bf_hi(z.w));
                *((u32x2*)(ocat + (bb + sq) * LDO + hs * 64) + piece) = r;
            }
        }
        __syncthreads();
    }
}

DI void route_rows(const Frame& F, const Params& p, int pm) {
    const int tid_ = fresh_tid(), lane_ = tid_ & 63;
    LAS int* hist = (LAS int*)(F.lds);
    const int ftid = fresh_tid();
    __syncthreads();
    if (ftid < 32) hist[ftid] = 0;
    __syncthreads();
    if (tid_ < 256) {
        const int row = pm * 256 + tid_; const float* L = (const float*)(F.ws + WS_LOGIT) + (size_t)row * 128;
        const float* brg = p.in[I_BRG]; const float* bre = p.in[I_BRE];
        float lgp[4];
#pragma unroll
        for (int c = 0; c < 4; ++c) lgp[c] = L[c] + L[36 + c] + brg[c];
        int gsel = 0; float gm = lgp[0];
#pragma unroll
        for (int c = 1; c < 4; ++c) if (lgp[c] > gm) { gm = lgp[c]; gsel = c; }
        float zs = 0.f;
#pragma unroll
        for (int c = 0; c < 4; ++c) zs += fexp2((lgp[c] - gm) * LOG2E);
        const float pg = frcp(zs);
        float l1 = -INFINITY, l2 = -INFINITY; int e1 = 0, e2 = 0;
#pragma unroll
        for (int i = 0; i < 8; ++i) { const int c = 4 + gsel * 8 + i; const float v = L[c] + L[36 + c] + bre[gsel * 8 + i];
            if (v > l1) { l2 = l1; e2 = e1; l1 = v; e1 = i; } else if (v > l2) { l2 = v; e2 = i; } }
        const float ex = fexp2((l2 - l1) * LOG2E), den = frcp(1.f + ex);
        int* te = (int*)(F.ws + WS_TOKE) + (size_t)row * 2; float* tw = (float*)(F.ws + WS_TOKW) + (size_t)row * 2;
        te[0] = gsel * 8 + e1; te[1] = gsel * 8 + e2; tw[0] = pg * den; tw[1] = pg * ex * den;
        lds_add(&hist[gsel * 8 + e1], 1); lds_add(&hist[gsel * 8 + e2], 1);
    }
    __syncthreads();
    if (ftid < 32) ((int*)(F.ws + WS_HIST))[pm * 32 + ftid] = hist[ftid];
}


DI void router_weights_to_lds(const Frame& F, const Params& p) {
    const int tid_ = fresh_tid(), lane_ = tid_ & 63;
    constexpr int WP = 1028;
    LAS float* wt = (LAS float*)(F.lds + LDS_RW); LAS float* bias = (LAS float*)(F.lds + LDS_RS) + 8 * 80 + 32;
    const float* wrg = p.in[I_WRG]; const float* wre = p.in[I_WRE]; const float* brg = p.in[I_BRG]; const float* bre = p.in[I_BRE];
    const int ftid = fresh_tid();
    __syncthreads();
#pragma unroll 8
    for (int i = ftid; i < 1024 * 32; i += 512) wt[(4 + (i & 31)) * WP + (i >> 5)] = wre[i];
#pragma unroll 8
    for (int i = ftid; i < 1024 * 4; i += 512) wt[(i & 3) * WP + (i >> 2)] = wrg[i];
    if (ftid < 36) bias[ftid] = ftid < 4 ? brg[ftid] : bre[ftid - 4];
}

DI void phase_norm2_route(const Frame& F, const Params& p) {
    const int tid_ = fresh_tid(), lane_ = tid_ & 63;
    constexpr int WP = 1028;
    LAS float* wt = (LAS float*)(F.lds + LDS_RW);
    LAS float* gs = (LAS float*)(F.lds + LDS_RV); LAS float* sh = gs + 1024;
    LAS float* scr = (LAS float*)(F.lds + LDS_RS) + F.wave * 80;
    LAS int* hist = (LAS int*)(F.lds + LDS_RS) + 8 * 80;
    LAS float* bias = (LAS float*)(F.lds + LDS_RS) + 8 * 80 + 32;
    const float* mod = (const float*)(F.ws + WS_MOD); const float* gn = p.in[I_GFFN];
    const bf16_t* upd = (const bf16_t*)(F.ws + WS_UPD1); bf16_t* x1w = (bf16_t*)(F.ws + WS_UPD1); unsigned* h8 = (unsigned*)(F.ws + WS_H28);
    const float* wrg = p.in[I_WRG]; const float* wre = p.in[I_WRE]; const float* brg = p.in[I_BRG]; const float* bre = p.in[I_BRE];
    const int ftid = fresh_tid();
    __syncthreads();
    for (int chunk = F.bid; chunk < T / 256; chunk += F.G) {
        const int b = chunk >> 5;
        __syncthreads();
        for (int col = ftid; col < 1024; col += 512) { gs[col] = gn[col] * (1.f + mod[b * 6144 + 4096 + col]); sh[col] = mod[b * 6144 + 3072 + col]; }
        if (ftid < 32) hist[ftid] = 0;
        __syncthreads();
        f32x4 vn[2][4]; u32x2 un[2][4];
#pragma unroll
        for (int r = 0; r < 2; ++r) { const int row = chunk * 256 + F.wave * 2 + r;
            const f32x4* xr = (const f32x4*)(p.in[I_X] + (size_t)row * 1024) + lane_; const u32x2* ur = (const u32x2*)(upd + (size_t)row * 1024) + lane_;
#pragma unroll
            for (int j = 0; j < 4; ++j) { vn[r][j] = xr[64 * j]; un[r][j] = ur[64 * j]; } }
        for (int rr = F.wave * 2; rr < 256; rr += 16) {
            const int row0 = chunk * 256 + rr;
            f32x4 y[2][4];
#pragma unroll
            for (int r = 0; r < 2; ++r) {
                const int row = row0 + r; float ss = 0.f;
#pragma unroll
                for (int j = 0; j < 4; ++j) { vn[r][j].x += bf_lo(un[r][j].x); vn[r][j].y += bf_hi(un[r][j].x); vn[r][j].z += bf_lo(un[r][j].y); vn[r][j].w += bf_hi(un[r][j].y);
                    { u32x2 o; o.x = pk2(vn[r][j].x, vn[r][j].y); o.y = pk2(vn[r][j].z, vn[r][j].w); *((u32x2*)(x1w + (size_t)row * 1024) + lane_ + 64 * j) = o; }
                    ss += (vn[r][j].x * vn[r][j].x + vn[r][j].y * vn[r][j].y) + (vn[r][j].z * vn[r][j].z + vn[r][j].w * vn[r][j].w); }
                const float rinv = __builtin_amdgcn_rsqf(wave_sum(ss) * (1.f / 1024.f) + RMS_EPS);
#pragma unroll
                for (int j = 0; j < 4; ++j) { const f32x4 gj = *(const LAS f32x4*)(gs + 256 * j + 4 * lane_), sj = *(const LAS f32x4*)(sh + 256 * j + 4 * lane_);
                    y[r][j] = vn[r][j] * rinv * gj + sj; h8[(size_t)row * 256 + 64 * j + lane_] = pk4_fp8(y[r][j].x, y[r][j].y, y[r][j].z, y[r][j].w); }
            }
            if (rr + 16 < 256) {
#pragma unroll
                for (int r = 0; r < 2; ++r) { const int row = row0 + 16 + r;
                    const f32x4* xr = (const f32x4*)(p.in[I_X] + (size_t)row * 1024) + lane_; const u32x2* ur = (const u32x2*)(upd + (size_t)row * 1024) + lane_;
#pragma unroll
                    for (int j = 0; j < 4; ++j) { vn[r][j] = xr[64 * j]; un[r][j] = ur[64 * j]; } }
            }
            const bool up32 = (lane_ & 32) != 0, up16 = (lane_ & 16) != 0, up8 = (lane_ & 8) != 0, up4 = (lane_ & 4) != 0;
            {
                f32x2 ga[2][4], gb[2][4];
#pragma unroll
                for (int r = 0; r < 2; ++r)
#pragma unroll
                    for (int c = 0; c < 4; ++c) { ga[r][c] = (f32x2){0.f, 0.f}; gb[r][c] = ga[r][c]; }
#pragma unroll
                for (int c = 0; c < 4; ++c)
#pragma unroll
                    for (int j = 0; j < 4; ++j) { const f32x4 w = *(const LAS f32x4*)(wt + c * WP + 4 * lane_ + 256 * j); const f32x2 wl = {w.x, w.y}, wh = {w.z, w.w};
#pragma unroll
                        for (int r = 0; r < 2; ++r) { ga[r][c] = __builtin_elementwise_fma((f32x2){y[r][j].x, y[r][j].y}, wl, ga[r][c]); gb[r][c] = __builtin_elementwise_fma((f32x2){y[r][j].z, y[r][j].w}, wh, gb[r][c]); } }
                float k4[4];
#pragma unroll
                for (int c = 0; c < 4; ++c) { const f32x2 t0 = ga[0][c] + gb[0][c], t1 = ga[1][c] + gb[1][c]; const float p0 = t0.x + t0.y, p1 = t1.x + t1.y;
                    k4[c] = up32 ? p0 : p1; ga[0][c].x = up32 ? p1 : p0; }
#pragma unroll
                for (int c = 0; c < 4; ++c) k4[c] = ga[0][c].x + __shfl_xor(k4[c], 32);
                float k2[2];
#pragma unroll
                for (int i = 0; i < 2; ++i) k2[i] = (up16 ? k4[2 + i] : k4[i]) + __shfl_xor(up16 ? k4[i] : k4[2 + i], 16);
                float k1 = (up8 ? k2[1] : k2[0]) + __shfl_xor(up8 ? k2[0] : k2[1], 8);
                k1 += __shfl_xor(k1, 4); k1 += __shfl_xor(k1, 2); k1 += __shfl_xor(k1, 1);
                if ((lane_ & 7) == 0) scr[(lane_ >> 5) * 36 + ((lane_ >> 4) & 1) * 2 + ((lane_ >> 3) & 1)] = k1;
            }
            LDS_WAIT();
            int gsel[2];
#pragma unroll
            for (int r = 0; r < 2; ++r) { int gi = 0; float gm = scr[r * 36] + bias[0];
#pragma unroll
                for (int c = 1; c < 4; ++c) { const float v = scr[r * 36 + c] + bias[c]; if (v > gm) { gm = v; gi = c; } }
                gsel[r] = __builtin_amdgcn_readfirstlane(gi); }
            {
                float pe[2][8];
#pragma unroll
                for (int r = 0; r < 2; ++r) {
                    const LAS float* wb = wt + (4 + gsel[r] * 8) * WP + 4 * lane_;
#pragma unroll
                    for (int hh = 0; hh < 2; ++hh) {
                        f32x2 ea[4], eb[4];
#pragma unroll
                        for (int i = 0; i < 4; ++i) { ea[i] = (f32x2){0.f, 0.f}; eb[i] = ea[i]; }
#pragma unroll
                        for (int i = 0; i < 4; ++i)
#pragma unroll
                            for (int j = 0; j < 4; ++j) { const f32x4 w = *(const LAS f32x4*)(wb + (hh * 4 + i) * WP + 256 * j);
                                ea[i] = __builtin_elementwise_fma((f32x2){y[r][j].x, y[r][j].y}, (f32x2){w.x, w.y}, ea[i]); eb[i] = __builtin_elementwise_fma((f32x2){y[r][j].z, y[r][j].w}, (f32x2){w.z, w.w}, eb[i]); }
#pragma unroll
                        for (int i = 0; i < 4; ++i) { const f32x2 t = ea[i] + eb[i]; pe[r][hh * 4 + i] = t.x + t.y; }
                        __builtin_amdgcn_sched_barrier(0);
                    }
                }
                float e8[8], e4[4], e2[2];
#pragma unroll
                for (int i = 0; i < 8; ++i) e8[i] = (up32 ? pe[1][i] : pe[0][i]) + __shfl_xor(up32 ? pe[0][i] : pe[1][i], 32);
#pragma unroll
                for (int i = 0; i < 4; ++i) e4[i] = (up16 ? e8[4 + i] : e8[i]) + __shfl_xor(up16 ? e8[i] : e8[4 + i], 16);
#pragma unroll
                for (int i = 0; i < 2; ++i) e2[i] = (up8 ? e4[2 + i] : e4[i]) + __shfl_xor(up8 ? e4[i] : e4[2 + i], 8);
                float e1 = (up4 ? e2[1] : e2[0]) + __shfl_xor(up4 ? e2[0] : e2[1], 4);
                e1 += __shfl_xor(e1, 2); e1 += __shfl_xor(e1, 1);
                if ((lane_ & 3) == 0) scr[(lane_ >> 5) * 36 + 4 + ((lane_ >> 4) & 1) * 4 + ((lane_ >> 3) & 1) * 2 + ((lane_ >> 2) & 1)] = e1;
            }
            LDS_WAIT();
            if (lane_ < 2) {
                const LAS float* L = scr + lane_ * 36; const int row = row0 + lane_;
                float lgp[4];
#pragma unroll
                for (int c = 0; c < 4; ++c) lgp[c] = L[c] + bias[c];
                int gsel = 0; float gm = lgp[0];
#pragma unroll
                for (int c = 1; c < 4; ++c) if (lgp[c] > gm) { gm = lgp[c]; gsel = c; }
                float zs = 0.f;
#pragma unroll
                for (int c = 0; c < 4; ++c) zs += fexp2((lgp[c] - gm) * LOG2E);
                const float pg = frcp(zs);
                float l1 = -INFINITY, l2 = -INFINITY; int e1 = 0, e2 = 0;
#pragma unroll
                for (int i = 0; i < 8; ++i) { const float v = L[4 + i] + bias[4 + gsel * 8 + i];
                    if (v > l1) { l2 = l1; e2 = e1; l1 = v; e1 = i; } else if (v > l2) { l2 = v; e2 = i; } }
                const float ex = fexp2((l2 - l1) * LOG2E), den = frcp(1.f + ex);
                int* te = (int*)(F.ws + WS_TOKE) + (size_t)row * 2; float* tw = (float*)(F.ws + WS_TOKW) + (size_t)row * 2;
                te[0] = gsel * 8 + e1; te[1] = gsel * 8 + e2; tw[0] = pg * den; tw[1] = pg * ex * den;
                lds_add(&hist[gsel * 8 + e1], 1); lds_add(&hist[gsel * 8 + e2], 1);
            }
            LDS_WAIT();
        }
        __syncthreads();
        if (ftid < 32) ((int*)(F.ws + WS_HIST))[chunk * 32 + ftid] = hist[ftid];
    }
}

DI void phase_slots(const Frame& F, const Params& p) {
    const int tid_ = fresh_tid(), lane_ = tid_ & 63;
    LAS int* tot = (LAS int*)(F.lds); LAS int* bas = tot + 32; LAS int* pst = tot + 64; LAS int* wcnt = tot + 128;
    const int* hist = (const int*)(F.ws + WS_HIST);
    for (int pm = F.bid; pm < T / 256; pm += F.G) {
        const int ftid = fresh_tid();
        __syncthreads();
        if (ftid < 64) tot[ftid] = 0;
        __syncthreads();
        { const int e = tid_ & 31, part = tid_ >> 5; int t = 0, bs = 0;
          for (int q = part; q < T / 256; q += 16) { const int v = hist[q * 32 + e]; t += v; if (q < pm) bs += v; }
          lds_add(&tot[e], t); lds_add(&bas[e], bs); }
        __syncthreads();
        if (tid_ == 0) { int run = 0; for (int e = 0; e < 32; ++e) { pst[e] = run; run += (tot[e] + 255) / 256 * 256; } pst[32] = run; }
        const int my_e = ((const int*)(F.ws + WS_TOKE))[(size_t)pm * 512 + tid_];
        int rank = 0;
        for (int e = 0; e < 32; ++e) { const unsigned long long mask = __ballot(my_e == e); if (my_e == e) rank = __popcll(mask & ((1ull << lane_) - 1ull)); if (lane_ == 0) wcnt[F.wave * 32 + e] = __popcll(mask); }
        __syncthreads();
        int woff = 0;
        for (int w = 0; w < F.wave; ++w) woff += wcnt[w * 32 + my_e];
        const int slot = pst[my_e] + bas[my_e] + woff + rank;
        ((int*)(F.ws + WS_SLOTTOK))[slot] = pm * 256 + (tid_ >> 1);
        ((float*)(F.ws + WS_SLOTW))[slot] = ((const float*)(F.ws + WS_TOKW))[(size_t)pm * 512 + tid_];
        ((int*)(F.ws + WS_TOKS))[(size_t)pm * 512 + tid_] = slot;
        if (pm < 32) { const int e = pm; for (int s = pst[e] + tot[e] + tid_; s < pst[e + 1]; s += 512) { ((int*)(F.ws + WS_SLOTTOK))[s] = 0; ((float*)(F.ws + WS_SLOTW))[s] = 0.f; } }
        if (pm == 0 && tid_ < 34) { int* et = (int*)(F.ws + WS_ETAB); if (tid_ < 33) et[64 + tid_] = pst[tid_] >> 8; if (tid_ < 32) { et[tid_] = tot[tid_]; et[32 + tid_] = pst[tid_]; } if (tid_ == 33) et[97] = pst[32] >> 8; }
    }
}

DI void phase_combine(const Frame& F, const Params& p) {
    const int tid_ = fresh_tid(), lane_ = tid_ & 63;
    const unsigned* y = (const unsigned*)(F.ws + WS_Y); const int* ts = (const int*)(F.ws + WS_TOKS); const float* tw = (const float*)(F.ws + WS_TOKW); const float* mod = (const float*)(F.ws + WS_MOD);
    const int gw = F.bid * 8 + F.wave, NGW = F.G * 8;
    for (int row = gw; row < T; row += NGW) {
        const int s0 = ts[(size_t)row * 2], s1 = ts[(size_t)row * 2 + 1]; const float w0 = tw[(size_t)row * 2] * 0.125f, w1 = tw[(size_t)row * 2 + 1] * 0.125f;
        f32x4* orow = (f32x4*)(p.out + (size_t)row * 1024) + lane_;
        const u32x2* ur = (const u32x2*)((const bf16_t*)(F.ws + WS_UPD1) + (size_t)row * 1024) + lane_;
        const unsigned* y0 = y + (size_t)s0 * 256 + lane_; const unsigned* y1 = y + (size_t)s1 * 256 + lane_;
        const f32x4* g2 = (const f32x4*)(mod + (row >> 13) * 6144 + 5120) + lane_;
        f32x4 v[4], g[4]; unsigned a[4], c[4]; u32x2 uu[4];
#pragma unroll
        for (int j = 0; j < 4; ++j) { uu[j] = ur[64 * j]; a[j] = y0[64 * j]; c[j] = y1[64 * j]; g[j] = g2[64 * j]; }
#pragma unroll
        for (int j = 0; j < 4; ++j) { v[j] = (f32x4){bf_lo(uu[j].x), bf_hi(uu[j].x), bf_lo(uu[j].y), bf_hi(uu[j].y)};
            if (!DBG_SKIP_Y) { const f32x2 al = fp8_lo2(a[j]), ah = fp8_hi2(a[j]), cl = fp8_lo2(c[j]), ch = fp8_hi2(c[j]);
                v[j].x += g[j].x * (w0 * al.x + w1 * cl.x); v[j].y += g[j].y * (w0 * al.y + w1 * cl.y); v[j].z += g[j].z * (w0 * ah.x + w1 * ch.x); v[j].w += g[j].w * (w0 * ah.y + w1 * ch.y); } orow[64 * j] = v[j]; }
    }
}

__global__ void __launch_bounds__(512, 2) fwd(Params p) {
    extern __shared__ __attribute__((aligned(16))) unsigned char lds_raw[];
    Frame F;
    F.lds = (LAS unsigned char*)lds_raw; F.ws = p.ws;
    F.wave = __builtin_amdgcn_readfirstlane((int)threadIdx.x >> 6); F.G = gridDim.x; F.bid = blockIdx.x;
    volatile LAS unsigned* ctl = (volatile LAS unsigned*)(F.lds + LDS_CTLO);
    { const int ftid = fresh_tid(); if (ftid < 64) ctl[ftid] = 0u; }
    __syncthreads();
    XcdBarrier bar; bar.bar = (unsigned*)(p.ws + WS_CTL) + CW_BAR; bar.x = 0; bar.st = ctl;
    if (MK_N_LAUNCHES == 1) bar = xcd_barrier_post((unsigned*)(p.ws + WS_CTL) + CW_BAR, ctl);
    const int lo = p.ph_lo, hi = p.ph_hi;
    const __amdgpu_buffer_rsrc_t rsw = __builtin_amdgcn_make_buffer_rsrc(p.ws, 0, (int)WS_END, 0x00020000);
#define IN(k) (lo <= (k) && (k) < hi)
#define REP(k) for (int rep_ = 0; rep_ < ((PROBE_PH) == (k) ? 2 : 1); ++rep_)
#define SEAM(k) do { if (IN(k) && IN((k) + 1)) xcd_barrier(bar); } while (0)

    if (IN(0)) REP(0) { phase0(F, p); } SEAM(0);
    if (IN(1)) REP(1) { phase_norm<0>(F, p); } SEAM(1);
    if (IN(2)) REP(2) {
        REP(20) {
            pg8::DenseSched Sd; Sd.init(T, 2304, F.G, F.bid, WS_H8, 1024, WS_W1D8, 1024);
            EpiProj<false> E{(bf16_t*)(F.ws + WS_PROJ), (bf16_t*)(F.ws + WS_GATES), (const bf16_t*)(F.ws + WS_ROPE), p.in[I_QG], p.in[I_KG], 0};
            pg8::gemm_phase<EpiProj<false>, pg8::DenseSched, true>(F.lds, 1024, Sd, E, rsw);
        }
        REP(21) {
            pg8::DenseSched Sd; Sd.init(T, 768, F.G, F.bid, WS_H, 2048, WS_W1 + (size_t)2304 * 2048, 2048);
            EpiProj<false> E{(bf16_t*)(F.ws + WS_PROJ), (bf16_t*)(F.ws + WS_GATES), (const bf16_t*)(F.ws + WS_ROPE), p.in[I_QG], p.in[I_KG], 9};
            pg8::gemm_phase<EpiProj<false>, pg8::DenseSched, false>(F.lds, 1024, Sd, E, rsw);
        }
        REP(22) {
            pg8::DenseSched Sd; Sd.init(T, 2048, F.G, F.bid, WS_H8, 1024, WS_WG8, 1024);
            EpiProj<true> E{(bf16_t*)(F.ws + WS_PROJ), (bf16_t*)(F.ws + WS_GATES), (const bf16_t*)(F.ws + WS_ROPE), p.in[I_QG], p.in[I_KG], 0};
            pg8::gemm_phase<EpiProj<true>, pg8::DenseSched, true>(F.lds, 1024, Sd, E, rsw);
        }
    } SEAM(2);
    if (IN(3)) REP(3) { phase_attn(F, p); } SEAM(3);
    if (IN(4)) REP(4) {
        pg8::DiagSched Sd; Sd.init(T, 2048, F.G, F.bid, WS_OCAT, 512, WS_WB, 512);
        EpiBranch E{(const unsigned char*)(F.ws + WS_GATES), F.ws + WS_MERGED};
        pg8::gemm_phase<EpiBranch, pg8::DiagSched, true>(F.lds, 512, Sd, E, rsw);
    } SEAM(4);
    if (IN(5)) REP(5) {
        pg8::DenseSched Sd; Sd.init(T, 1024, F.G, F.bid, WS_MERGED, 1024, WS_WO, 1024);
        EpiOut E{(bf16_t*)(F.ws + WS_UPD1), (const float*)(F.ws + WS_MOD)};
        pg8::gemm_phase<EpiOut, pg8::DenseSched, true>(F.lds, 1024, Sd, E, rsw);
        if (rep_ + 1 == ((PROBE_PH) == 5 ? 2 : 1)) router_weights_to_lds(F, p);
    } SEAM(5);
    if (IN(6)) REP(6) { phase_norm2_route(F, p); }
    if (IN(6) && IN(8)) xcd_barrier(bar);
    if (IN(8)) REP(8) { phase_slots(F, p); } SEAM(8);
    if (IN(9) || IN(10)) {
        LAS int* cst = (LAS int*)(F.lds + LDS_CTLO) + 16;
        __syncthreads();
        { const int ftid = fresh_tid(); if (ftid < 34) cst[ftid] = ((const int*)(F.ws + WS_ETAB))[64 + ftid]; }
        __syncthreads();
    }
    if (IN(9)) REP(9) {
        const LAS int* cst = (const LAS int*)(F.lds + LDS_CTLO) + 16;
        MoeSchedUp Sm; Sm.G = F.G; Sm.c = (F.G == 256) ? ((F.bid & 7) * 32 + (F.bid >> 3)) : F.bid; Sm.nc = __builtin_amdgcn_readfirstlane(cst[33]); Sm.pa = 1024; Sm.pb = 1024; Sm.A = (unsigned)WS_H28; Sm.B = (unsigned)WS_WGU; Sm.cstart = cst;
        Sm.slot_tok = (const int*)(F.ws + WS_SLOTTOK); Sm.estride = 1024u * 1024u; Sm.pnstride = 256u * 1024u;
        EpiSwiglu E{F.ws + WS_HMID};
        pg8::gemm_phase<EpiSwiglu, MoeSchedUp, true>(F.lds, 1024, Sm, E, rsw);
    } SEAM(9);
    if (IN(10)) REP(10) {
        const LAS int* cst = (const LAS int*)(F.lds + LDS_CTLO) + 16;
        MoeSchedDn Sm; Sm.G = F.G; Sm.c = (F.G == 256) ? ((F.bid & 7) * 32 + (F.bid >> 3)) : F.bid; Sm.nc = __builtin_amdgcn_readfirstlane(cst[33]); Sm.pa = 512; Sm.pb = 512; Sm.A = (unsigned)WS_HMID; Sm.B = (unsigned)WS_WDN; Sm.cstart = cst;
        Sm.slot_tok = (const int*)(F.ws + WS_SLOTTOK); Sm.estride = 1024u * 512u; Sm.pnstride = 256u * 512u;
        EpiDown E{F.ws + WS_Y};
        pg8::gemm_phase<EpiDown, MoeSchedDn, true>(F.lds, 512, Sm, E, rsw);
    } SEAM(10);
    if (IN(11)) { phase_combine(F, p); }
#undef IN
#undef SEAM
}

extern "C" void kernel_launch(void* const* d_in, const int* in_sizes, int n_in, void* d_out, int out_size, void* d_ws, size_t ws_size, hipStream_t stream) {
    static int grid = 0;
    if (grid == 0) {
        if (n_in != 21 || in_sizes[0] != T * D || out_size != T * D || ws_size < WS_END) { fprintf(stderr, "kernel_launch: unexpected problem (n_in %d, ws %zu)\n", n_in, ws_size); grid = -1; return; }
        int dev = 0, cus = 0, per_cu = 0;
        if (hipGetDevice(&dev) != hipSuccess || hipDeviceGetAttribute(&cus, hipDeviceAttributeMultiprocessorCount, dev) != hipSuccess) { grid = -1; return; }
        if (hipFuncSetAttribute((const void*)fwd, hipFuncAttributeMaxDynamicSharedMemorySize, LDS_BYTES) != hipSuccess) { fprintf(stderr, "kernel_launch: hipFuncSetAttribute failed\n"); grid = -1; return; }
        if (hipOccupancyMaxActiveBlocksPerMultiprocessor(&per_cu, (const void*)fwd, 512, LDS_BYTES) != hipSuccess || per_cu < 1) { fprintf(stderr, "kernel_launch: occupancy query says %d\n", per_cu); (void)hipGetLastError(); grid = -1; return; }
        grid = cus;
    }
    if (grid < 0) return;
    (void)hipMemsetAsync((char*)d_ws + WS_CTL, 0, CTL_ZERO_BYTES, stream);
    Params p{};
    for (int i = 0; i < 21; ++i) p.in[i] = (const float*)d_in[i];
    p.out = (float*)d_out; p.ws = (unsigned char*)d_ws;
    if (MK_N_LAUNCHES == 1) { p.ph_lo = 0; p.ph_hi = NPH; hipLaunchKernelGGL(fwd, dim3(grid), dim3(512), LDS_BYTES, stream, p); }
    else { for (int k = 0; k < NPH; ++k) { p.ph_lo = k; p.ph_hi = k + 1; hipLaunchKernelGGL(fwd, dim3(grid), dim3(512), LDS_BYTES, stream, p); } }
}
```

```cpp
#include <hip/hip_runtime.h>
#include <cstdio>
#include <cstdint>

#ifndef MK_N_LAUNCHES
#define MK_N_LAUNCHES 1
#endif
#define DBG_X1_PLAIN 0
#define DBG_SKIP_Y 0
#ifndef PROBE_PH
#define PROBE_PH -1
#endif

#define LAS __attribute__((address_space(3)))
#define DI __device__ __forceinline__
typedef unsigned short bf16_t;
typedef short bf16x8 __attribute__((ext_vector_type(8)));
typedef short s16x4 __attribute__((ext_vector_type(4)));
typedef float f32x2 __attribute__((ext_vector_type(2)));
typedef float f32x4 __attribute__((ext_vector_type(4)));
typedef float f32x16 __attribute__((ext_vector_type(16)));
typedef unsigned u32x2 __attribute__((ext_vector_type(2)));
typedef unsigned u32x4 __attribute__((ext_vector_type(4)));
typedef __bf16 bf16x2n __attribute__((ext_vector_type(2)));
typedef int i32x8 __attribute__((ext_vector_type(8)));

constexpr int NB = 8, S = 8192, D = 1024, T = NB * S;
constexpr int LDP = 3072, LDG = 2048, LDO = 512;
constexpr int NE = 32, DE = 512;
constexpr int MAXSLOT = T * 2 + NE * 256;
constexpr int NPH = 12;
constexpr float LOG2E = 1.4426950408889634f;
constexpr float QSCALE = 0.125f * LOG2E;
constexpr float RMS_EPS = 1e-6f;

constexpr size_t MiB = 1u << 20;
constexpr size_t WS_CTL = 0, CTL_ZERO_BYTES = 64 * 1024;
constexpr int CW_BAR = 1024;
constexpr size_t WS_MODP = 1 * MiB;
constexpr size_t WS_MOD = 3 * MiB;
constexpr size_t WS_ROPE = 4 * MiB;
constexpr size_t WS_LOGIT = 144 * MiB;
constexpr size_t WS_TOKE = 24 * MiB;
constexpr size_t WS_TOKW = 24 * MiB + 512 * 1024;
constexpr size_t WS_TOKS = 25 * MiB;
constexpr size_t WS_SLOTTOK = 25 * MiB + 512 * 1024;
constexpr size_t WS_SLOTW = 26 * MiB + 256 * 1024;
constexpr size_t WS_HIST = 27 * MiB;
constexpr size_t WS_ETAB = 27 * MiB + 256 * 1024;
constexpr size_t WS_WR = 28 * MiB;
constexpr size_t WS_W1D8 = 28 * MiB + 512 * 1024;
constexpr size_t WS_W1 = 32 * MiB;
constexpr size_t WS_WG8 = 38 * MiB;
constexpr size_t WS_WB = 40 * MiB;
constexpr size_t WS_WO = 43 * MiB;
constexpr size_t WS_WGU = 48 * MiB;
constexpr size_t WS_WDN = 80 * MiB;
constexpr size_t WS_H = 144 * MiB;
constexpr size_t WS_OG = 144 * MiB;
constexpr size_t WS_LSE = 240 * MiB;
constexpr size_t WS_PROJ = 272 * MiB;
constexpr size_t WS_GATES = 656 * MiB;
constexpr size_t WS_OCAT = 912 * MiB;
constexpr size_t WS_H8 = 912 * MiB;
constexpr size_t WS_MERGED = 272 * MiB;
constexpr size_t WS_H2 = 400 * MiB;
constexpr size_t WS_H28 = 528 * MiB;
constexpr size_t WS_HMID = 592 * MiB;
constexpr size_t WS_Y = 664 * MiB;
constexpr size_t WS_UPD1 = 800 * MiB;
constexpr size_t WS_END = 976 * MiB;

constexpr int LDS_STAGE = 0, LDS_EPI = 131072, LDS_RW = 0, LDS_RV = 148480, LDS_RS = 148480 + 8192, LDS_CTLO = 148480 + 8192 + 3072, LDS_BYTES = LDS_CTLO + 256;

DI unsigned pk2(float lo, float hi) { f32x2 v = {lo, hi}; bf16x2n r = __builtin_convertvector(v, bf16x2n); return __builtin_bit_cast(unsigned, r); }
DI unsigned pk4_fp8(float a, float b, float c, float d) { int r = __builtin_amdgcn_cvt_pk_fp8_f32(a, b, 0, false); r = __builtin_amdgcn_cvt_pk_fp8_f32(c, d, r, true); return (unsigned)r; }
DI f32x2 fp8_lo2(unsigned u) { return __builtin_amdgcn_cvt_pk_f32_fp8((int)u, false); }
DI f32x2 fp8_hi2(unsigned u) { return __builtin_amdgcn_cvt_pk_f32_fp8((int)u, true); }
DI float bf_lo(unsigned u) { return __builtin_bit_cast(float, u << 16); }
DI float bf_hi(unsigned u) { return __builtin_bit_cast(float, u & 0xffff0000u); }
struct Swap2 { float lo, hi; };
DI Swap2 swap32(float x) { const unsigned b = __builtin_bit_cast(unsigned, x); auto r = __builtin_amdgcn_permlane32_swap(b, b, false, false); const unsigned r0 = r[0], r1 = r[1]; return Swap2{__builtin_bit_cast(float, r0), __builtin_bit_cast(float, r1)}; }
DI Swap2 swap16(float x) { const unsigned b = __builtin_bit_cast(unsigned, x); auto r = __builtin_amdgcn_permlane16_swap(b, b, false, false); const unsigned r0 = r[0], r1 = r[1]; return Swap2{__builtin_bit_cast(float, r0), __builtin_bit_cast(float, r1)}; }
DI float xsum32(float x) { const Swap2 s = swap32(x); return s.lo + s.hi; }
DI float xmax32(float x) { const Swap2 s = swap32(x); return fmaxf(s.lo, s.hi); }
DI float xget32(float x, int upper) { const Swap2 s = swap32(x); return upper ? s.lo : s.hi; }
DI float wave_sum(float v) {
    v += __builtin_bit_cast(float, __builtin_amdgcn_update_dpp(0, __builtin_bit_cast(int, v), 0xB1, 0xF, 0xF, true));
    v += __builtin_bit_cast(float, __builtin_amdgcn_update_dpp(0, __builtin_bit_cast(int, v), 0x4E, 0xF, 0xF, true));
    v += __builtin_bit_cast(float, __builtin_amdgcn_update_dpp(0, __builtin_bit_cast(int, v), 0x141, 0xF, 0xF, true));
    v += __builtin_bit_cast(float, __builtin_amdgcn_update_dpp(0, __builtin_bit_cast(int, v), 0x140, 0xF, 0xF, true));
    { const Swap2 s = swap16(v); v = s.lo + s.hi; }
    { const Swap2 s = swap32(v); v = s.lo + s.hi; }
    return v;
}
DI float fexp2(float x) { return __builtin_amdgcn_exp2f(x); }
DI float flog2(float x) { return __builtin_amdgcn_logf(x); }
DI float frcp(float x) { return __builtin_amdgcn_rcpf(x); }
DI float sigmoidf(float v) { return frcp(1.0f + fexp2(-v * LOG2E)); }
DI void lds_add(LAS int* p, int v) { (void)__hip_atomic_fetch_add(p, v, __ATOMIC_RELAXED, __HIP_MEMORY_SCOPE_WORKGROUP); }
#define LDS_WAIT() asm volatile("s_waitcnt lgkmcnt(0)" ::: "memory")
#define VM_WAIT() asm volatile("s_waitcnt vmcnt(0)" ::: "memory")
DI int fresh_tid() { int t = threadIdx.x; asm volatile("" : "+v"(t)); return t; }

#define XB_TMO      128
#define XB_XCNT(j)  (256  + 64 * (j))
#define XB_XSUB(j)  (1280 + 64 * (j))
#define XB_XGEN(j)  (2304 + 64 * (j))
#define XB_TOP      3328
#define XB_TOPGEN   3392
#define XCD_BAR_WORDS 3456
#define XB_SPIN_CAP (1u << 18)

__device__ __forceinline__ unsigned xb_ld(unsigned* p)              { return __hip_atomic_load(p, __ATOMIC_RELAXED, __HIP_MEMORY_SCOPE_AGENT); }
__device__ __forceinline__ unsigned xb_add(unsigned* p, unsigned v) { return __hip_atomic_fetch_add(p, v, __ATOMIC_RELAXED, __HIP_MEMORY_SCOPE_AGENT); }
__device__ __forceinline__ unsigned xb_xcc_id() { return (unsigned)__builtin_amdgcn_s_getreg((3 << 11) | 20) & 0xFu; }
#define XB_SPIN(cond, bar) do { unsigned _sp = 0; while (cond) { __builtin_amdgcn_s_sleep(1); \
    if ((++_sp & 255u) == 0u) { if (xb_ld(&(bar)[XB_TMO])) break; if (_sp > XB_SPIN_CAP) { atomicAdd(&(bar)[XB_TMO], 1u); break; } } } } while (0)

struct XcdBarrier {
    unsigned* bar; unsigned x;
    volatile LAS unsigned* st;
};
__device__ __forceinline__ XcdBarrier xcd_barrier_post(unsigned* bar, volatile LAS unsigned* st) {
    XcdBarrier b; b.bar = bar; b.x = xb_xcc_id(); b.st = st;
    if (threadIdx.x == 0) (void)xb_add(&bar[XB_XCNT(b.x)], 1u);
    return b;
}
__device__ __forceinline__ void xcd_barrier_complete(unsigned* bar, unsigned x, unsigned& nloc, unsigned& nx) {
    const unsigned G = gridDim.x * gridDim.y * gridDim.z;
    unsigned sum, cnt, mine, sp = 0u;
    for (;;) {
        sum = 0u; cnt = 0u; mine = 0u;
#pragma unroll
        for (unsigned j = 0; j < 16; ++j) { const unsigned c = xb_ld(&bar[XB_XCNT(j)]); sum += c; cnt += (c > 0u) ? 1u : 0u; mine = (j == x) ? c : mine; }
        if (sum == G) break;
        __builtin_amdgcn_s_sleep(1);
        if ((++sp & 255u) == 0u) { if (xb_ld(&bar[XB_TMO])) break; if (sp > XB_SPIN_CAP) { atomicAdd(&bar[XB_TMO], 1u); break; } }
    }
    nloc = mine > 0u ? mine : 1u; nx = cnt > 0u ? cnt : 1u;
}
__device__ __forceinline__ void xcd_barrier(const XcdBarrier& b) {
    asm volatile("s_waitcnt vmcnt(0)" ::: "memory");
    __syncthreads();
    if (threadIdx.x == 0) {
        unsigned* bar = b.bar;
        __builtin_amdgcn_s_waitcnt(0);
        unsigned nloc = b.st[0], nx = b.st[1];
        if (nloc == 0u) { xcd_barrier_complete(bar, b.x, nloc, nx); b.st[0] = nloc; b.st[1] = nx; }
        const unsigned old = xb_add(&bar[XB_XSUB(b.x)], 1u);
        const unsigned gen = old / nloc;
        if (old + 1u == (gen + 1u) * nloc) {
            __builtin_amdgcn_fence(__ATOMIC_RELEASE, "agent");
            asm volatile("s_waitcnt vmcnt(0)" ::: "memory");
            const unsigned og = xb_add(&bar[XB_TOP], 1u);
            const unsigned tg = og / nx;
            if (og + 1u == (tg + 1u) * nx) xb_add(&bar[XB_TOPGEN], 1u);
            else XB_SPIN(xb_ld(&bar[XB_TOPGEN]) == tg, bar);
            __builtin_amdgcn_fence(__ATOMIC_ACQUIRE, "agent");
            xb_add(&bar[XB_XGEN(b.x)], 1u);
            asm volatile("s_waitcnt vmcnt(0)" ::: "memory");
        } else {
            XB_SPIN(xb_ld(&bar[XB_XGEN(b.x)]) == gen, bar);
            __builtin_amdgcn_fence(__ATOMIC_ACQUIRE, "agent");
            asm volatile("s_waitcnt vmcnt(0)" ::: "memory");
        }
    }
    __syncthreads();
}

namespace pg8 {
constexpr int BM = 256, BK = 64, HALF = 128, HTB = HALF * BK * 2, STAGE_BYTES = 8 * HTB, NXCD = 8, WGM = 8;
__host__ __device__ __forceinline__ int lds_byte(int r, int c) { const int st = (r >> 4) * 2 + (c >> 5), rr = r & 15, cc = c & 31, ob = rr * 64 + cc * 2; return st * 1024 + (ob ^ (((ob >> 9) & 1) << 5)); }
__host__ __device__ __forceinline__ void stage_rc(int b, int& R, int& C) { const int st = b / 1024, sb = b % 1024, swz = sb ^ (((sb >> 9) & 1) << 5); R = (st >> 1) * 16 + swz / 64; C = (st & 1) * 32 + (swz % 64) / 2; }
__host__ __device__ __forceinline__ int perm32(int rho) { const int n = rho >> 4, i = rho & 15; return 8 * (i >> 2) + 4 * n + (i & 3); }

struct Unit { int pm, pn, aux; unsigned a, b; };
typedef int i32x4 __attribute__((ext_vector_type(4)));
__device__ __forceinline__ i32x8 frag8(bf16x8 lo, bf16x8 hi) { return __builtin_shufflevector(__builtin_bit_cast(i32x4, lo), __builtin_bit_cast(i32x4, hi), 0, 1, 2, 3, 4, 5, 6, 7); }

template <class Epi, class Sched, bool FP8 = false>
__device__ __forceinline__ void gemm_phase(LAS unsigned char* lds, const int K, const Sched& S, const Epi& E, const __amdgpu_buffer_rsrc_t rs) {
    const int tid = fresh_tid(), wid = __builtin_amdgcn_readfirstlane(tid >> 6), lane = tid & 63, wr = wid >> 2, wc = wid & 3, fr = lane & 15, fq = lane >> 4;
    const int nt = FP8 ? K / 128 : K / BK;
    int RA[2], CA[2];
    unsigned voffA[4], voffB[2];
#pragma unroll
    for (int i = 0; i < 2; ++i) { int R, C; stage_rc(tid * 16 + i * 8192, R, C); RA[i] = R; CA[i] = C; const int Rb = Epi::PERM ? ((R & ~31) + perm32(R & 31)) : R;
        voffB[i] = (unsigned)(Rb * S.pb + C * 2); }
    const unsigned kstep = (unsigned)(BK * 2);
    const unsigned hstepB = (unsigned)(HALF * S.pb), hstepA = (unsigned)(HALF * S.pa);
    const unsigned ldsw = (unsigned)wid * 1024u;
    const int aoff = lds_byte(wr * 64 + fr, fq * 8), boff = lds_byte(wc * 32 + fr, fq * 8);
    constexpr int kpiece = 1024;
#define PG8_SA(b, h) (((b) * 2 + (h)) * HTB)
#define PG8_SB(b, h) ((4 + (b) * 2 + (h)) * HTB)
#define PG8_STAGE_B(bufoff, gbase) do { _Pragma("unroll") for (int _i = 0; _i < 2; ++_i) \
        __builtin_amdgcn_raw_ptr_buffer_load_lds(rs, (LAS unsigned*)(lds + (bufoff) + ldsw + _i * 8192), 16, (int)voffB[_i], (int)(gbase), 0, 0); } while (0)
#define PG8_STAGE_A(bufoff, gbase, h) do { _Pragma("unroll") for (int _i = 0; _i < 2; ++_i) \
        __builtin_amdgcn_raw_ptr_buffer_load_lds(rs, (LAS unsigned*)(lds + (bufoff) + ldsw + _i * 8192), 16, (int)voffA[Sched::GATHER ? (h) * 2 + _i : _i], (int)((gbase) + (Sched::GATHER ? 0u : (unsigned)(h) * hstepA)), 0, 0); } while (0)
#define PG8_LDA(dst, b, h) do { _Pragma("unroll") for (int m = 0; m < 4; ++m) _Pragma("unroll") for (int k = 0; k < 2; ++k) dst[m][k] = *(const LAS bf16x8*)(lds + PG8_SA(b, h) + aoff + m * 2048 + k * kpiece); } while (0)
#define PG8_LDB(dst, b, h) do { _Pragma("unroll") for (int n = 0; n < 2; ++n) _Pragma("unroll") for (int k = 0; k < 2; ++k) dst[n][k] = *(const LAS bf16x8*)(lds + PG8_SB(b, h) + boff + n * 2048 + k * kpiece); } while (0)
#define PG8_MMA(ai, bj, At, Bt) do { __builtin_amdgcn_s_setprio(1); if constexpr (FP8) { _Pragma("unroll") for (int m = 0; m < 4; ++m) _Pragma("unroll") for (int n = 0; n < 2; ++n) \
        acc[ai][bj][m][n] = __builtin_amdgcn_mfma_scale_f32_16x16x128_f8f6f4(frag8(Bt[n][0], Bt[n][1]), frag8(At[m][0], At[m][1]), acc[ai][bj][m][n], 0, 0, 0, 0x7C7C7C7C, 0, 0x7C7C7C7C); } \
      else { _Pragma("unroll") for (int m = 0; m < 4; ++m) _Pragma("unroll") for (int n = 0; n < 2; ++n) _Pragma("unroll") for (int k = 0; k < 2; ++k) \
        acc[ai][bj][m][n] = __builtin_amdgcn_mfma_f32_16x16x32_bf16(Bt[n][k], At[m][k], acc[ai][bj][m][n], 0, 0, 0); } __builtin_amdgcn_s_setprio(0); } while (0)
#define PG8_MMA2(ai, At) do { if constexpr (Sched::BLOCKDIAG) { if (lo_half) PG8_MMA(ai, 0, At, B0); else PG8_MMA(ai, 1, At, B1); } else { PG8_MMA(ai, 0, At, B0); PG8_MMA(ai, 1, At, B1); } } while (0)
#define PG8_WAIT_V(n) asm volatile("s_waitcnt vmcnt(" #n ")" ::: "memory")
#define PG8_WAIT_L(n) asm volatile("s_waitcnt lgkmcnt(" #n ")" ::: "memory")
#define PG8_BAR __builtin_amdgcn_s_barrier()
#define PG8_SCHED __builtin_amdgcn_sched_barrier(0)
    Unit cur, nxt; int ui = 0;
    if (!S.next(0, cur)) return;
    S.offs(cur, RA, CA, voffA);
    f32x4 acc[2][2][4][2];
#pragma unroll
    for (int a = 0; a < 2; ++a)
#pragma unroll
        for (int b = 0; b < 2; ++b)
#pragma unroll
            for (int m = 0; m < 4; ++m)
#pragma unroll
                for (int n = 0; n < 2; ++n) acc[a][b][m][n] = (f32x4){0.f, 0.f, 0.f, 0.f};
    bf16x8 At[4][2], B0[2][2], B1[2][2];
    unsigned cA = cur.a, cB = cur.b;
    PG8_STAGE_B(PG8_SB(0, 0), cB); PG8_STAGE_B(PG8_SB(0, 1), cB + hstepB); PG8_STAGE_A(PG8_SA(0, 0), cA, 0); PG8_STAGE_A(PG8_SA(0, 1), cA, 1);
    if (wr == 1) PG8_BAR;
    PG8_WAIT_V(2); PG8_BAR;
    PG8_STAGE_B(PG8_SB(1, 0), cB + kstep); PG8_STAGE_A(PG8_SA(1, 0), cA + kstep, 0); PG8_STAGE_B(PG8_SB(1, 1), cB + hstepB + kstep);
    PG8_WAIT_V(6); PG8_BAR;
    for (;;) {
        const bool has_next = S.next(ui + 1, nxt);
        const unsigned nA = has_next ? nxt.a : cA, nB = has_next ? nxt.b : cB;
        unsigned nvoff[4];
        if constexpr (Sched::GATHER) { if (has_next) S.rows(nxt, RA, nvoff); }
#pragma nounroll
        for (int t = 0; t < nt; t += 2) {
            const bool last = (t == nt - 2), lo_half = t < (nt >> 1);
            const unsigned a1 = cA + (unsigned)(t + 1) * kstep;
            const unsigned a2 = last ? nA : cA + (unsigned)(t + 2) * kstep, b2 = last ? nB : cB + (unsigned)(t + 2) * kstep;
            const unsigned a3 = a2 + kstep, b3 = b2 + kstep;
            PG8_LDB(B0, 0, 0); PG8_LDB(B1, 0, 1); PG8_SCHED; PG8_LDA(At, 0, 0); PG8_STAGE_A(PG8_SA(1, 1), a1, 1);
            PG8_WAIT_V(8); PG8_WAIT_L(0); PG8_BAR; PG8_MMA2(0, At); PG8_BAR; PG8_SCHED;
            if constexpr (Sched::GATHER) { if (last && has_next) {
#pragma unroll
                for (int q = 0; q < 4; ++q) voffA[q] = nvoff[q] * (unsigned)S.pa + (unsigned)(CA[q & 1] * 2); } }
            PG8_LDA(At, 0, 1); PG8_STAGE_B(PG8_SB(0, 0), b2); PG8_STAGE_B(PG8_SB(0, 1), b2 + hstepB); PG8_STAGE_A(PG8_SA(0, 0), a2, 0);
            PG8_WAIT_V(8); PG8_WAIT_L(0); PG8_BAR; PG8_MMA2(1, At); PG8_BAR; PG8_SCHED;
            PG8_LDB(B0, 1, 0); PG8_LDB(B1, 1, 1); PG8_SCHED; PG8_LDA(At, 1, 0); PG8_STAGE_A(PG8_SA(0, 1), a2, 1);
            PG8_WAIT_V(8); PG8_WAIT_L(0); PG8_BAR; PG8_MMA2(0, At); PG8_BAR; PG8_SCHED;
            PG8_LDA(At, 1, 1); PG8_STAGE_B(PG8_SB(1, 0), b3); PG8_STAGE_B(PG8_SB(1, 1), b3 + hstepB); PG8_STAGE_A(PG8_SA(1, 0), a3, 0);
            PG8_WAIT_V(8); PG8_WAIT_L(0); PG8_BAR; PG8_MMA2(1, At); PG8_BAR; PG8_SCHED;
        }
        if (wr == 0) PG8_BAR;
        { const int t2 = fresh_tid() & 63; E(acc, cur, wr, wc, t2 & 15, t2 >> 4, lds + LDS_EPI); }
        if (!has_next) break;
#pragma unroll
        for (int a = 0; a < 2; ++a)
#pragma unroll
            for (int b = 0; b < 2; ++b)
#pragma unroll
                for (int m = 0; m < 4; ++m)
#pragma unroll
                    for (int n = 0; n < 2; ++n) acc[a][b][m][n] = (f32x4){0.f, 0.f, 0.f, 0.f};
        cur = nxt; cA = nA; cB = nB; ++ui;
        if (wr == 1) PG8_BAR;
    }
    PG8_WAIT_V(0);
    PG8_BAR;
#undef PG8_SA
#undef PG8_SB
#undef PG8_STAGE_A
#undef PG8_STAGE_B
#undef PG8_LDA
#undef PG8_LDB
#undef PG8_MMA
#undef PG8_MMA2
#undef PG8_WAIT_V
#undef PG8_WAIT_L
#undef PG8_BAR
#undef PG8_SCHED
}

struct DenseSched {
    static constexpr bool GATHER = false, BLOCKDIAG = false;
    int nM, nN, nwg, G, c; int pa, pb; unsigned A, B;
    __device__ void init(int M, int N, int G_, int c_, size_t A_, int pa_, size_t B_, int pb_) { nM = M / BM; nN = N / BM; nwg = nM * nN; G = G_; c = c_; A = (unsigned)A_; B = (unsigned)B_; pa = pa_; pb = pb_; }
    __device__ __forceinline__ bool next(int i, Unit& u) const {
        const long L = (long)i * G + c; if (L >= nwg) return false;
        int wgid = (int)L; { const int q = nwg / NXCD, r = nwg % NXCD, xcd = wgid % NXCD, off = wgid / NXCD; wgid = (xcd < r ? xcd * (q + 1) : r * (q + 1) + (xcd - r) * q) + off; }
        const int nig = WGM * nN, gid = wgid / nig, fm = gid * WGM, gsz = (nM - fm) < WGM ? (nM - fm) : WGM;
        u.pm = fm + ((wgid % nig) % gsz); u.pn = (wgid % nig) / gsz; u.aux = 0;
        u.a = A + (unsigned)(u.pm * BM * pa); u.b = B + (unsigned)(u.pn * BM * pb); return true;
    }
    __device__ __forceinline__ void offs(const Unit&, const int (&RA)[2], const int (&CA)[2], unsigned (&v)[4]) const {
#pragma unroll
        for (int h = 0; h < 2; ++h)
#pragma unroll
            for (int i = 0; i < 2; ++i) v[h * 2 + i] = (unsigned)((h * HALF + RA[i]) * pa + CA[i] * 2);
    }
};
struct DiagSched : DenseSched { static constexpr bool BLOCKDIAG = true; };
}

struct Params { const float* in[21]; float* out; unsigned char* ws; int ph_lo, ph_hi; };
enum { I_X = 0, I_C, I_POS, I_WADA, I_BADA, I_GMIX, I_GFFN, I_WIN, I_WBG, I_QG, I_KG, I_WBD, I_WBS, I_WOUT, I_WRG, I_BRG, I_WRE, I_BRE, I_WEG, I_WEU, I_WED };

struct Frame {
    LAS unsigned char* lds;
    unsigned char* ws;
    int wave, G, bid;
};

template <bool FP8>
DI void p0_transpose_item(const float* W, int N, void* WTv, int ldt, int k0, int n0, int row_base, LAS float* scr, int lane) {
#pragma unroll 8
    for (int i = 0; i < 32; ++i) { const int kk = 2 * i + (lane >> 5); scr[kk * 33 + (lane & 31)] = W[(size_t)(k0 + kk) * N + n0 + (lane & 31)]; }
    LDS_WAIT();
    const int c = lane & 7;
#pragma unroll
    for (int j = 0; j < 4; ++j) { const int n = (lane >> 3) + 8 * j; const LAS float* sp = scr + (8 * c) * 33 + n;
        if (FP8) { u32x2 o; o.x = pk4_fp8(64.f * sp[0 * 33], 64.f * sp[1 * 33], 64.f * sp[2 * 33], 64.f * sp[3 * 33]); o.y = pk4_fp8(64.f * sp[4 * 33], 64.f * sp[5 * 33], 64.f * sp[6 * 33], 64.f * sp[7 * 33]);
            *(u32x2*)((unsigned char*)WTv + (size_t)(row_base + n) * ldt + k0 + 8 * c) = o; }
        else { u32x4 o; o.x = pk2(sp[0 * 33], sp[1 * 33]); o.y = pk2(sp[2 * 33], sp[3 * 33]); o.z = pk2(sp[4 * 33], sp[5 * 33]); o.w = pk2(sp[6 * 33], sp[7 * 33]);
            *(u32x4*)((bf16_t*)WTv + (size_t)(row_base + n) * ldt + k0 + 8 * c) = o; } }
    LDS_WAIT();
}
DI void phase0(const Frame& F, const Params& p) {
    const int tid_ = fresh_tid(), lane_ = tid_ & 63;
    LAS float* scr = (LAS float*)(F.lds + F.wave * 16384);
    const int gw = F.bid * 8 + F.wave, NGW = F.G * 8;
    bf16_t* W1 = (bf16_t*)(F.ws + WS_W1); bf16_t* WB = (bf16_t*)(F.ws + WS_WB); bf16_t* WO = (bf16_t*)(F.ws + WS_WO);
    unsigned char* WG8 = F.ws + WS_WG8; unsigned char* WGU = F.ws + WS_WGU; unsigned char* WDN = F.ws + WS_WDN;
    constexpr int I1 = 16 * 96, I2 = 16 * 64, I3 = 4 * 32, I4 = 4 * 32, I5 = 16 * 32, I6 = 32 * 256, I7 = 32 * 256, I8 = 32 * 256;
    constexpr int NITEMS = I1 + I2 + I3 + I4 + I5 + I6 + I7 + I8;
    for (int it = gw; it < NITEMS; it += NGW) {
        int r = it;
        if (r < I1) { const int kb = r / 96, nb = r % 96, n0 = 32 * nb, o0 = n0 & 255, rb = (n0 & ~255) + 128 * ((o0 >> 5) & 1) + 32 * (o0 >> 6);
            if (nb < 72) p0_transpose_item<true>(p.in[I_WIN], 3072, F.ws + WS_W1D8, 1024, 64 * kb, n0, rb, scr, lane_); else p0_transpose_item<false>(p.in[I_WIN], 3072, W1, 1024, 64 * kb, n0, rb, scr, lane_); continue; } r -= I1;
        if (r < I2) { const int kb = r / 64, nb = r % 64; p0_transpose_item<true>(p.in[I_WBG], 2048, WG8, 1024, 64 * kb, 32 * nb, 32 * nb, scr, lane_); continue; } r -= I2;
        if (r < I3) { const int kb = r / 32, nb = r % 32, n0 = 32 * nb; p0_transpose_item<true>(p.in[I_WBD], 1024, (unsigned char*)WB, 512, 64 * kb, n0, (n0 >> 7) * 256 + (n0 & 127), scr, lane_); continue; } r -= I3;
        if (r < I4) { const int kb = r / 32, nb = r % 32, n0 = 32 * nb; p0_transpose_item<true>(p.in[I_WBS], 1024, (unsigned char*)WB + 256, 512, 64 * kb, n0, (n0 >> 7) * 256 + 128 + (n0 & 127), scr, lane_); continue; } r -= I4;
        if (r < I5) { const int kb = r / 32, nb = r % 32; p0_transpose_item<true>(p.in[I_WOUT], 1024, WO, 1024, 64 * kb, 32 * nb, 32 * nb, scr, lane_); continue; } r -= I5;
        if (r < I6) { const int e = r >> 8, q = r & 255, kb = q >> 4, nb = q & 15, n0 = 32 * nb;
            p0_transpose_item<true>(p.in[I_WEG] + (size_t)e * 1024 * 512, 512, WGU + (size_t)e * 1024 * 1024, 1024, 64 * kb, n0, (n0 >> 7) * 256 + (n0 & 127), scr, lane_); continue; } r -= I6;
        if (r < I7) { const int e = r >> 8, q = r & 255, kb = q >> 4, nb = q & 15, n0 = 32 * nb;
            p0_transpose_item<true>(p.in[I_WEU] + (size_t)e * 1024 * 512, 512, WGU + (size_t)e * 1024 * 1024, 1024, 64 * kb, n0, (n0 >> 7) * 256 + 128 + (n0 & 127), scr, lane_); continue; } r -= I7;
        { const int e = r >> 8, q = r & 255, kb = q >> 5, nb = q & 31, n0 = 32 * nb, o0 = n0 & 255;
            p0_transpose_item<true>(p.in[I_WED] + (size_t)e * 512 * 1024, 1024, WDN + (size_t)e * 1024 * 512, 512, 64 * kb, n0, (n0 & ~255) + 128 * ((o0 >> 5) & 1) + 32 * (o0 >> 6), scr, lane_); }
    }
    {
        unsigned char* WBz = F.ws + WS_WB;
        for (int idx = F.bid * 512 + tid_; idx < 2048 * 16; idx += F.G * 512) { const int row = idx >> 4, c = idx & 15; *(u32x4*)(WBz + (size_t)row * 512 + ((row & 128) ? 0 : 256) + c * 16) = (u32x4){0u, 0u, 0u, 0u}; }
    }
    {
        float* modp = (float*)(F.ws + WS_MODP); const float* c = p.in[I_C]; const float* wada = p.in[I_WADA];
        for (int task = gw; task < 96 * 8; task += NGW) {
            const int ct = task % 96, ks = task / 96, k0 = ks * 128;
#pragma unroll
            for (int i = 0; i < 16; ++i) { const int idx = i * 64 + lane_, b = idx >> 7, k = idx & 127; const float v = c[b * 1024 + k0 + k]; scr[idx] = v * sigmoidf(v); }
            LDS_WAIT();
            float acc[8];
#pragma unroll
            for (int b = 0; b < 8; ++b) acc[b] = 0.f;
            const float* wp = wada + (size_t)k0 * 6144 + ct * 64 + lane_;
#pragma unroll 8
            for (int k = 0; k < 128; ++k) { const float w = wp[(size_t)k * 6144];
#pragma unroll
                for (int b = 0; b < 8; ++b) acc[b] += scr[b * 128 + k] * w; }
#pragma unroll
            for (int b = 0; b < 8; ++b) modp[((size_t)ks * 8 + b) * 6144 + ct * 64 + lane_] = acc[b];
            LDS_WAIT();
        }
    }
}

DI float inv_freq_of(int i) {
    return i == 0 ? 1.0f : i == 1 ? 0.1939227432012558f : i == 2 ? 0.03760603070259094f : i == 3 ? 0.007292664609849453f : i == 4 ? 0.0014142135623842478f : i == 5 ? 0.00027424818836152554f : i == 6 ? 5.318296098266728e-05f : 1.0313386155758053e-05f;
}
template <int WHICH>
DI void phase_norm(const Frame& F, const Params& p) {
    const int tid_ = fresh_tid(), lane_ = tid_ & 63;
    LAS float* gs = (LAS float*)(F.lds); LAS float* sh = gs + 1024;
    const float* modp = (const float*)(F.ws + WS_MODP); float* mod = (float*)(F.ws + WS_MOD); const float* bada = p.in[I_BADA];
    const float* xin = p.in[I_X]; const bf16_t* upd = (const bf16_t*)(F.ws + WS_UPD1); bf16_t* hout = (bf16_t*)(F.ws + (WHICH == 0 ? WS_H : WS_H2)); unsigned* h8 = (unsigned*)(F.ws + (WHICH == 0 ? WS_H8 : WS_H28));
    const float* gn = p.in[WHICH == 0 ? I_GMIX : I_GFFN];
    for (int chunk = F.bid; chunk < T / 256; chunk += F.G) {
        const int b = chunk >> 5;
        __syncthreads();
        if (WHICH == 0) {
            if (tid_ < 192) { const int j = (chunk & 31) * 192 + tid_; float s = bada[j];
#pragma unroll
                for (int ks = 0; ks < 8; ++ks) s += modp[((size_t)ks * 8 + b) * 6144 + j];
                mod[b * 6144 + j] = s; }
            for (int col = tid_; col < 1024; col += 512) { float s1 = bada[col], s2 = bada[1024 + col];
#pragma unroll
                for (int ks = 0; ks < 8; ++ks) { s1 += modp[((size_t)ks * 8 + b) * 6144 + col]; s2 += modp[((size_t)ks * 8 + b) * 6144 + 1024 + col]; }
                gs[col] = gn[col] * (1.f + s2); sh[col] = s1; }
        } else {
            for (int col = tid_; col < 1024; col += 512) { gs[col] = gn[col] * (1.f + mod[b * 6144 + 4096 + col]); sh[col] = mod[b * 6144 + 3072 + col]; }
        }
        __syncthreads();
        f32x4 g4[4], s4[4];
#pragma unroll
        for (int j = 0; j < 4; ++j) { g4[j] = *(const LAS f32x4*)(gs + 256 * j + 4 * lane_); s4[j] = *(const LAS f32x4*)(sh + 256 * j + 4 * lane_); }
        for (int rr = F.wave; rr < 256; rr += 8) {
            const int row = chunk * 256 + rr;
            const f32x4* xr = (const f32x4*)(xin + (size_t)row * 1024) + lane_;
            f32x4 v[4]; float ss = 0.f;
#pragma unroll
            for (int j = 0; j < 4; ++j) v[j] = xr[64 * j];
            if (WHICH == 1) { const u32x2* ur = (const u32x2*)(upd + (size_t)row * 1024) + lane_; u32x2 uu[4];
#pragma unroll
                for (int j = 0; j < 4; ++j) uu[j] = ur[64 * j];
#pragma unroll
                for (int j = 0; j < 4; ++j) { v[j].x += bf_lo(uu[j].x); v[j].y += bf_hi(uu[j].x); v[j].z += bf_lo(uu[j].y); v[j].w += bf_hi(uu[j].y); } }
#pragma unroll
            for (int j = 0; j < 4; ++j) ss += (v[j].x * v[j].x + v[j].y * v[j].y) + (v[j].z * v[j].z + v[j].w * v[j].w);
            const float rinv = __builtin_amdgcn_rsqf(wave_sum(ss) * (1.f / 1024.f) + RMS_EPS);
            u32x2* o8 = (u32x2*)(hout + (size_t)row * 1024) + lane_;
#pragma unroll
            for (int j = 0; j < 4; ++j) { const f32x4 y = v[j] * rinv * g4[j] + s4[j]; u32x2 o; o.x = pk2(y.x, y.y); o.y = pk2(y.z, y.w); o8[64 * j] = o; h8[(size_t)row * 256 + 64 * j + lane_] = pk4_fp8(y.x, y.y, y.z, y.w); }
            if (WHICH == 0 && lane_ < 8) {
                const int pos = ((const int*)p.in[I_POS])[row];
                const float angf = (float)pos * inv_freq_of(lane_);
                double rv = (double)angf * 0.15915494309189535; rv -= __builtin_rint(rv);
                const float fr = (float)rv;
                bf16_t* rp = (bf16_t*)(F.ws + WS_ROPE) + (size_t)row * 16;
                rp[lane_] = (bf16_t)(pk2(__builtin_amdgcn_cosf(fr), 0.f) & 0xffffu); rp[8 + lane_] = (bf16_t)(pk2(__builtin_amdgcn_sinf(fr), 0.f) & 0xffffu);
            }
        }
    }
}

template <bool GATES> struct EpiProj {
    static constexpr bool PERM = true;
    bf16_t* proj; bf16_t* gates; const bf16_t* rope; const float* qg; const float* kg; int pn0;
    DI void operator()(const f32x4 (&acc)[2][2][4][2], const pg8::Unit& u, int wr, int wc, int fr, int fq, LAS unsigned char* scr) const {
        asm volatile("" : "+v"(fr), "+v"(fq));
        const int pn = u.pn + pn0, row0 = u.pm * 256 + wr * 64 + fr, cw = wc * 32 + 8 * fq;
        const int typ = pn < 9 ? pn / 3 : pn - 9, grp = pn < 9 ? pn % 3 : 0, l2d = pn < 9 ? 2 * grp : 0, hbase = pn < 9 ? grp * 4 : 12;
        if (GATES) {
            unsigned char* base = (unsigned char*)gates + (size_t)(u.pm * 8 + pn) * 65536 + (size_t)(((wr * 4 + wc) * 64 + fq * 16 + fr) * 8);
#pragma unroll
            for (int ai = 0; ai < 2; ++ai)
#pragma unroll
                for (int m = 0; m < 4; ++m)
#pragma unroll
                    for (int bj = 0; bj < 2; ++bj) { const f32x4 v0 = acc[ai][bj][m][0], v1 = acc[ai][bj][m][1];
                        u32x2 w; w.x = pk4_fp8(v0.x, v0.y, v0.z, v0.w); w.y = pk4_fp8(v1.x, v1.y, v1.z, v1.w);
                        *(u32x2*)(base + ((ai * 4 + m) * 2 + bj) * 4096) = w; }
        } else if (pn >= 6 || pn < 3) {
            const float sc = pn == 9 ? QSCALE : 1.f;
            const int head = hbase + wc;
#pragma unroll
            for (int ai = 0; ai < 2; ++ai)
#pragma unroll
                for (int m = 0; m < 4; ++m) { const int t = row0 + ai * 128 + m * 16, sq = t & (S - 1); const int rp = (t & ~(S - 1)) + ((sq & ((1 << l2d) - 1)) << (13 - l2d)) + (sq >> l2d);
                    bf16_t* rowp = proj + ((size_t)(typ * 16 + head) * T + rp) * 64 + 8 * fq;
#pragma unroll
                    for (int bj = 0; bj < 2; ++bj) { const f32x4 v0 = acc[ai][bj][m][0] * sc, v1 = acc[ai][bj][m][1] * sc;
                        u32x4 w; w.x = pk2(v0.x, v0.y); w.y = pk2(v0.z, v0.w); w.z = pk2(v1.x, v1.y); w.w = pk2(v1.z, v1.w);
                        *(u32x4*)(rowp + 32 * bj) = w; } }
        } else {
            const int head = hbase + wc;
            const f32x4 g0 = *(const f32x4*)(kg + 8 * fq), g1 = *(const f32x4*)(kg + 8 * fq + 4), g2 = *(const f32x4*)(kg + 32 + 8 * fq), g3 = *(const f32x4*)(kg + 32 + 8 * fq + 4);
#pragma unroll
            for (int ai = 0; ai < 2; ++ai) {
                u32x4 rcs[4][2];
#pragma unroll
                for (int m = 0; m < 4; ++m) { const u32x4* rpt = (const u32x4*)(rope + (size_t)(u.pm * 256 + ai * 128 + wr * 64 + m * 16 + fr) * 16); rcs[m][0] = rpt[0]; rcs[m][1] = rpt[1]; }
                __builtin_amdgcn_sched_barrier(0);
#pragma unroll
                for (int m = 0; m < 4; ++m) { const int row = u.pm * 256 + ai * 128 + wr * 64 + m * 16 + fr, sq = row & (S - 1);
                    const int rp = (row & ~(S - 1)) + ((sq & ((1 << l2d) - 1)) << (13 - l2d)) + (sq >> l2d);
                    const f32x4 a0 = acc[ai][0][m][0], a1 = acc[ai][0][m][1], b0 = acc[ai][1][m][0], b1 = acc[ai][1][m][1];
                    float ss = ((a0.x * a0.x + a0.y * a0.y) + (a0.z * a0.z + a0.w * a0.w)) + ((a1.x * a1.x + a1.y * a1.y) + (a1.z * a1.z + a1.w * a1.w))
                             + ((b0.x * b0.x + b0.y * b0.y) + (b0.z * b0.z + b0.w * b0.w)) + ((b1.x * b1.x + b1.y * b1.y) + (b1.z * b1.z + b1.w * b1.w));
                    { const unsigned sb_ = __builtin_bit_cast(unsigned, ss); auto r = __builtin_amdgcn_permlane16_swap(sb_, sb_, false, false); const unsigned r0 = r[0], r1 = r[1]; ss = __builtin_bit_cast(float, r0) + __builtin_bit_cast(float, r1); }
                    { const unsigned sb_ = __builtin_bit_cast(unsigned, ss); auto r = __builtin_amdgcn_permlane32_swap(sb_, sb_, false, false); const unsigned r0 = r[0], r1 = r[1]; ss = __builtin_bit_cast(float, r0) + __builtin_bit_cast(float, r1); }
                    const float rinv = __builtin_amdgcn_rsqf(ss * (1.f / 64.f) + RMS_EPS);
                    f32x4 v0 = a0 * (g0 * rinv), v1 = a1 * (g1 * rinv); const f32x4 v2 = b0 * (g2 * rinv), v3 = b1 * (g3 * rinv);
                    f32x4 c0 = {1.f, 1.f, 1.f, 1.f}, c1 = c0, s0 = {0.f, 0.f, 0.f, 0.f}, s1 = s0;
                    if (fq < 2) { const u32x4 cc = rcs[m][0], sn = rcs[m][1];
                        c0 = (f32x4){bf_lo(cc.x), bf_hi(cc.x), bf_lo(cc.y), bf_hi(cc.y)}; c1 = (f32x4){bf_lo(cc.z), bf_hi(cc.z), bf_lo(cc.w), bf_hi(cc.w)};
                        s0 = (f32x4){bf_lo(sn.x), bf_hi(sn.x), bf_lo(sn.y), bf_hi(sn.y)}; s1 = (f32x4){bf_lo(sn.z), bf_hi(sn.z), bf_lo(sn.w), bf_hi(sn.w)};
                        if (fq == 0) { s0 = -s0; s1 = -s1; } }
                    f32x4 p0, p1;
#define KX16(x) ([&] { const unsigned b_ = __builtin_bit_cast(unsigned, (float)(x)); auto r = __builtin_amdgcn_permlane16_swap(b_, b_, false, false); const unsigned r0 = r[0], r1 = r[1]; return __builtin_bit_cast(float, (fq & 1) ? r0 : r1); }())
                    p0.x = KX16(v0.x); p0.y = KX16(v0.y); p0.z = KX16(v0.z); p0.w = KX16(v0.w);
                    p1.x = KX16(v1.x); p1.y = KX16(v1.y); p1.z = KX16(v1.z); p1.w = KX16(v1.w);
#undef KX16
                    v0 = v0 * c0 + p0 * s0; v1 = v1 * c1 + p1 * s1;
                    bf16_t* rowp = proj + ((size_t)(typ * 16 + head) * T + rp) * 64 + 8 * fq;
                    u32x4 w; w.x = pk2(v0.x, v0.y); w.y = pk2(v0.z, v0.w); w.z = pk2(v1.x, v1.y); w.w = pk2(v1.z, v1.w);
                    *(u32x4*)rowp = w;
                    w.x = pk2(v2.x, v2.y); w.y = pk2(v2.z, v2.w); w.z = pk2(v3.x, v3.y); w.w = pk2(v3.z, v3.w);
                    *(u32x4*)(rowp + 32) = w; }
            }
        }
    }
};

struct EpiBranch {
    static constexpr bool PERM = true;
    const unsigned char* gates; unsigned char* merged;
    DI void operator()(const f32x4 (&acc)[2][2][4][2], const pg8::Unit& u, int wr, int wc, int fr, int fq, LAS unsigned char*) const {
        asm volatile("" : "+v"(fr), "+v"(fq));
        const int row0 = u.pm * 256 + wr * 64 + fr, col0 = u.pn * 128 + wc * 32 + 8 * fq;
        const unsigned char* gbase = gates + (size_t)(u.pm * 8 + (u.pn >> 1)) * 65536 + (size_t)((u.pn & 1) * 4096) + (size_t)(((wr * 4 + wc) * 64 + fq * 16 + fr) * 8);
        u32x2 gd[2][4], gs[2][4];
#pragma unroll
        for (int ai = 0; ai < 2; ++ai)
#pragma unroll
            for (int m = 0; m < 4; ++m) { const unsigned char* gp = gbase + ((ai * 4 + m) * 2) * 4096;
                gd[ai][m] = *(const u32x2*)gp; gs[ai][m] = *(const u32x2*)(gp + 4 * 65536); }
        __builtin_amdgcn_sched_barrier(0);
#pragma unroll
        for (int ai = 0; ai < 2; ++ai)
#pragma unroll
            for (int m = 0; m < 4; ++m) { const size_t row = (size_t)(row0 + ai * 128 + m * 16);
                const u32x2 g = gd[ai][m], q = gs[ai][m];
                const f32x2 ga = fp8_lo2(g.x), gb = fp8_hi2(g.x), gc = fp8_lo2(g.y), gdd = fp8_hi2(g.y), qa = fp8_lo2(q.x), qb = fp8_hi2(q.x), qc = fp8_lo2(q.y), qd = fp8_hi2(q.y);
                const f32x4 v0 = acc[ai][0][m][0] * (f32x4){sigmoidf(ga.x), sigmoidf(ga.y), sigmoidf(gb.x), sigmoidf(gb.y)} + acc[ai][1][m][0] * (f32x4){sigmoidf(qa.x), sigmoidf(qa.y), sigmoidf(qb.x), sigmoidf(qb.y)};
                const f32x4 v1 = acc[ai][0][m][1] * (f32x4){sigmoidf(gc.x), sigmoidf(gc.y), sigmoidf(gdd.x), sigmoidf(gdd.y)} + acc[ai][1][m][1] * (f32x4){sigmoidf(qc.x), sigmoidf(qc.y), sigmoidf(qd.x), sigmoidf(qd.y)};
                u32x2 w; w.x = pk4_fp8(8.f * v0.x, 8.f * v0.y, 8.f * v0.z, 8.f * v0.w); w.y = pk4_fp8(8.f * v1.x, 8.f * v1.y, 8.f * v1.z, 8.f * v1.w);
                *(u32x2*)(merged + row * 1024 + col0) = w; }
    }
};
struct BranchSched {
    static constexpr bool GATHER = false;
    int G, c; int pa, pb; unsigned A, B;
    DI bool next(int i, pg8::Unit& u) const {
        const int tile = (i >> 1) * G + c; if (tile >= 256 * 4) return false;
        u.pm = tile >> 2; u.pn = tile & 3; u.aux = i & 1;
        u.a = A + (unsigned)(u.pm * 256 * LDO * 2 + u.aux * 256 * 2); u.b = B + (unsigned)(u.aux * 1024 * 256 * 2 + u.pn * 256 * 256 * 2); return true;
    }
    DI void offs(const pg8::Unit&, const int (&RA)[2], const int (&CA)[2], unsigned (&v)[4]) const {
#pragma unroll
        for (int h = 0; h < 2; ++h)
#pragma unroll
            for (int i = 0; i < 2; ++i) v[h * 2 + i] = (unsigned)((h * 128 + RA[i]) * pa + CA[i] * 2);
    }
};

struct EpiOut {
    static constexpr bool PERM = true;
    bf16_t* upd; const float* mod;
    DI void operator()(const f32x4 (&acc)[2][2][4][2], const pg8::Unit& u, int wr, int wc, int fr, int fq, LAS unsigned char*) const {
        asm volatile("" : "+v"(fr), "+v"(fq));
        const int row0 = u.pm * 256 + wr * 64 + fr, col0 = u.pn * 256 + wc * 32 + 8 * fq; const int b = (u.pm * 256) >> 13;
        f32x4 gv[2][2];
#pragma unroll
        for (int bj = 0; bj < 2; ++bj)
#pragma unroll
            for (int n = 0; n < 2; ++n) gv[bj][n] = *(const f32x4*)(mod + b * 6144 + 2048 + col0 + bj * 128 + n * 4) * 0.125f;
#pragma unroll
        for (int ai = 0; ai < 2; ++ai)
#pragma unroll
            for (int m = 0; m < 4; ++m)
#pragma unroll
                for (int bj = 0; bj < 2; ++bj) { const f32x4 v0 = acc[ai][bj][m][0] * gv[bj][0], v1 = acc[ai][bj][m][1] * gv[bj][1];
                    u32x4 w; w.x = pk2(v0.x, v0.y); w.y = pk2(v0.z, v0.w); w.z = pk2(v1.x, v1.y); w.w = pk2(v1.z, v1.w);
                    *(u32x4*)(upd + (size_t)(row0 + ai * 128 + m * 16) * 1024 + col0 + bj * 128) = w; }
    }
};

struct EpiLogit {
    static constexpr bool PERM = false;
    float* logit;
    DI void operator()(const f32x4 (&acc)[2][2][4][2], const pg8::Unit& u, int wr, int wc, int fr, int fq, LAS unsigned char*) const {
        asm volatile("" : "+v"(fr), "+v"(fq));
        const int row0 = u.pm * 256 + wr * 64 + fr, col0 = wc * 32 + 4 * fq;
#pragma unroll
        for (int ai = 0; ai < 2; ++ai)
#pragma unroll
            for (int m = 0; m < 4; ++m)
#pragma unroll
                for (int n = 0; n < 2; ++n) *(f32x4*)(logit + (size_t)(row0 + ai * 128 + m * 16) * 128 + col0 + n * 16) = acc[ai][0][m][n];
    }
};

struct MoeSched {
    static constexpr bool GATHER_ = true;
    int G, c, nc; int pa, pb; unsigned A, B; const LAS int* cstart; const int* slot_tok; unsigned estride, pnstride;
};
struct MoeSchedUp : MoeSched {
    static constexpr bool GATHER = true, BLOCKDIAG = false;
    DI bool next(int i, pg8::Unit& u) const {
        const int L = i * G + c; if (L >= nc * 4) return false;
        const int chunk = L >> 2; int e = 0;
        for (int q = 1; q < 32; ++q) e += (chunk >= cstart[q]) ? 1 : 0;
        e = __builtin_amdgcn_readfirstlane(e);
        u.pm = chunk; u.pn = L & 3; u.aux = e; u.a = A; u.b = B + (unsigned)e * estride + (unsigned)u.pn * pnstride; return true;
    }
    DI void offs(const pg8::Unit& u, const int (&RA)[2], const int (&CA)[2], unsigned (&v)[4]) const {
#pragma unroll
        for (int h = 0; h < 2; ++h)
#pragma unroll
            for (int i = 0; i < 2; ++i) { const int tok = slot_tok[u.pm * 256 + h * 128 + RA[i]]; v[h * 2 + i] = (unsigned)(tok * pa + CA[i] * 2); }
    }
    DI void rows(const pg8::Unit& u, const int (&RA)[2], unsigned (&v)[4]) const {
#pragma unroll
        for (int h = 0; h < 2; ++h)
#pragma unroll
            for (int i = 0; i < 2; ++i) v[h * 2 + i] = (unsigned)slot_tok[u.pm * 256 + h * 128 + RA[i]];
    }
};
struct MoeSchedDn : MoeSched {
    static constexpr bool GATHER = false, BLOCKDIAG = false;
    DI bool next(int i, pg8::Unit& u) const {
        const int L = i * G + c; if (L >= nc * 4) return false;
        const int chunk = L >> 2; int e = 0;
        for (int q = 1; q < 32; ++q) e += (chunk >= cstart[q]) ? 1 : 0;
        e = __builtin_amdgcn_readfirstlane(e);
        u.pm = chunk; u.pn = L & 3; u.aux = e; u.a = A + (unsigned)(chunk * 256 * pa); u.b = B + (unsigned)e * estride + (unsigned)u.pn * pnstride; return true;
    }
    DI void offs(const pg8::Unit&, const int (&RA)[2], const int (&CA)[2], unsigned (&v)[4]) const {
#pragma unroll
        for (int h = 0; h < 2; ++h)
#pragma unroll
            for (int i = 0; i < 2; ++i) v[h * 2 + i] = (unsigned)((h * 128 + RA[i]) * pa + CA[i] * 2);
    }
};
struct EpiSwiglu {
    static constexpr bool PERM = true;
    unsigned char* hmid;
    DI void operator()(const f32x4 (&acc)[2][2][4][2], const pg8::Unit& u, int wr, int wc, int fr, int fq, LAS unsigned char*) const {
        asm volatile("" : "+v"(fr), "+v"(fq));
        const int row0 = u.pm * 256 + wr * 64 + fr, col0 = u.pn * 128 + wc * 32 + 8 * fq;
#pragma unroll
        for (int ai = 0; ai < 2; ++ai)
#pragma unroll
            for (int m = 0; m < 4; ++m) {
                f32x4 h[2];
#pragma unroll
                for (int n = 0; n < 2; ++n) { const f32x4 g = acc[ai][0][m][n], up = acc[ai][1][m][n];
                    h[n] = (f32x4){g.x * sigmoidf(g.x) * up.x, g.y * sigmoidf(g.y) * up.y, g.z * sigmoidf(g.z) * up.z, g.w * sigmoidf(g.w) * up.w}; }
                u32x2 w; w.x = pk4_fp8(h[0].x, h[0].y, h[0].z, h[0].w); w.y = pk4_fp8(h[1].x, h[1].y, h[1].z, h[1].w);
                *(u32x2*)(hmid + (size_t)(row0 + ai * 128 + m * 16) * DE + col0) = w; }
    }
};
struct EpiDown {
    static constexpr bool PERM = true;
    unsigned char* y;
    DI void operator()(const f32x4 (&acc)[2][2][4][2], const pg8::Unit& u, int wr, int wc, int fr, int fq, LAS unsigned char*) const {
        asm volatile("" : "+v"(fr), "+v"(fq));
        const int row0 = u.pm * 256 + wr * 64 + fr, col0 = u.pn * 256 + wc * 64 + (fq & 1) * 32 + (fq >> 1) * 16;
#pragma unroll
        for (int ai = 0; ai < 2; ++ai)
#pragma unroll
            for (int m = 0; m < 4; ++m) { const int slot = row0 + ai * 128 + m * 16;
                u32x2 o[2];
#pragma unroll
                for (int bj = 0; bj < 2; ++bj) { const f32x4 v0 = acc[ai][bj][m][0] * 8.f, v1 = acc[ai][bj][m][1] * 8.f; o[bj].x = pk4_fp8(v0.x, v0.y, v0.z, v0.w); o[bj].y = pk4_fp8(v1.x, v1.y, v1.z, v1.w); }
                u32x4 w;
                { auto r = __builtin_amdgcn_permlane16_swap(o[0].x, o[1].x, false, false); w.x = r[0]; w.z = r[1]; }
                { auto r = __builtin_amdgcn_permlane16_swap(o[0].y, o[1].y, false, false); w.y = r[0]; w.w = r[1]; }
                *(u32x4*)(y + (size_t)slot * 1024 + col0) = w; }
    }
};

constexpr int SLOT_BYTES = 8192;
DI f32x16 mfma32(bf16x8 a, bf16x8 b, f32x16 c) { return __builtin_amdgcn_mfma_f32_32x32x16_bf16(a, b, c, 0, 0, 0); }
DI int swz_f(int r) { return (((r >> 1) & 1) << 2) | ((r >> 2) & 3); }
struct AttnLane { unsigned doff[4]; unsigned ka[4]; unsigned va[2][2]; };
DI void attn_lane_init(AttnLane& L, int lane) {
#pragma unroll
    for (int i = 0; i < 4; ++i) { const int r = 8 * i + (lane >> 3), c = (lane & 7) ^ swz_f(r); L.doff[i] = (unsigned)(r * 128 + c * 16); }
    { const int r = lane & 31, h = lane >> 5; const unsigned a0 = (unsigned)(r * 128 + 16 * ((h ^ swz_f(r)) & 7));
#pragma unroll
      for (int s = 0; s < 4; ++s) L.ka[s] = a0 ^ (unsigned)(32 * s); }
    { const int h = lane >> 5, blk = (lane >> 4) & 1, q = (lane & 15) >> 2, p = lane & 3, fb2 = (q >> 1) & 1;
#pragma unroll
      for (int t = 0; t < 2; ++t) { const int flow = (2 * t + h) & 3;
#pragma unroll
        for (int mt = 0; mt < 2; ++mt) L.va[t][mt] = (unsigned)(4096 + (8 * t + 4 * h + q) * 128 + 16 * (4 * (mt ^ fb2) + ((2 * blk + (p >> 1)) ^ flow)) + 8 * (p & 1)); } }
}
DI void dma_tile(const AttnLane& L, const __amdgpu_buffer_rsrc_t rs, unsigned koff, unsigned voff, LAS unsigned char* slot) {
#pragma unroll
    for (int i = 0; i < 4; ++i) __builtin_amdgcn_raw_ptr_buffer_load_lds(rs, (LAS unsigned*)(slot + 1024 * i), 16, (int)L.doff[i], (int)koff, 0, 0);
#pragma unroll
    for (int i = 0; i < 4; ++i) __builtin_amdgcn_raw_ptr_buffer_load_lds(rs, (LAS unsigned*)(slot + 4096 + 1024 * i), 16, (int)L.doff[i], (int)voff, 0, 0);
}
DI void dma_q(const AttnLane& L, const __amdgpu_buffer_rsrc_t rs, unsigned qoff, LAS unsigned char* slot) {
#pragma unroll
    for (int i = 0; i < 4; ++i) __builtin_amdgcn_raw_ptr_buffer_load_lds(rs, (LAS unsigned*)(slot + 1024 * i), 16, (int)L.doff[i], (int)qoff, 0, 0);
}
DI void tr_read8(const AttnLane& L, unsigned sb, bf16x8 (&vf)[2][2]) {
    s16x4 r0, r1, r2, r3, r4, r5, r6, r7;
    const unsigned a00 = sb + L.va[0][0], a10 = sb + L.va[1][0], a01 = sb + L.va[0][1], a11 = sb + L.va[1][1];
    asm volatile("ds_read_b64_tr_b16 %0, %8\n\tds_read_b64_tr_b16 %1, %9\n\tds_read_b64_tr_b16 %2, %8 offset:2048\n\tds_read_b64_tr_b16 %3, %9 offset:2048\n\t"
                 "ds_read_b64_tr_b16 %4, %10\n\tds_read_b64_tr_b16 %5, %11\n\tds_read_b64_tr_b16 %6, %10 offset:2048\n\tds_read_b64_tr_b16 %7, %11 offset:2048\n\ts_waitcnt lgkmcnt(0)"
                 : "=&v"(r0), "=&v"(r1), "=&v"(r2), "=&v"(r3), "=&v"(r4), "=&v"(r5), "=&v"(r6), "=&v"(r7)
                 : "v"(a00), "v"(a10), "v"(a01), "v"(a11) : "memory");
    vf[0][0] = __builtin_shufflevector(r0, r1, 0, 1, 2, 3, 4, 5, 6, 7); vf[0][1] = __builtin_shufflevector(r2, r3, 0, 1, 2, 3, 4, 5, 6, 7);
    vf[1][0] = __builtin_shufflevector(r4, r5, 0, 1, 2, 3, 4, 5, 6, 7); vf[1][1] = __builtin_shufflevector(r6, r7, 0, 1, 2, 3, 4, 5, 6, 7);
}
DI bf16x8 pack8(const f32x16& x, int s) {
    u32x4 p; p.x = pk2(x[8 * s], x[8 * s + 1]); p.y = pk2(x[8 * s + 2], x[8 * s + 3]); p.z = pk2(x[8 * s + 4], x[8 * s + 5]); p.w = pk2(x[8 * s + 6], x[8 * s + 7]);
    return __builtin_bit_cast(bf16x8, p);
}
DI void store_o_row(bf16_t* rowp, const f32x16& O0, const f32x16& O1, float sc, int h) {
#pragma unroll
    for (int mt = 0; mt < 2; ++mt)
#pragma unroll
        for (int kp = 0; kp < 2; ++kp) { const f32x16& O = mt ? O1 : O0; const int g0 = 8 * kp, g1 = 8 * kp + 4;
            u32x2 a, b; a.x = pk2(O[g0] * sc, O[g0 + 1] * sc); a.y = pk2(O[g0 + 2] * sc, O[g0 + 3] * sc); b.x = pk2(O[g1] * sc, O[g1 + 1] * sc); b.y = pk2(O[g1 + 2] * sc, O[g1 + 3] * sc);
            { auto r = __builtin_amdgcn_permlane32_swap(a.x, b.x, false, false); a.x = r[0]; b.x = r[1]; }
            { auto r = __builtin_amdgcn_permlane32_swap(a.y, b.y, false, false); a.y = r[0]; b.y = r[1]; }
            *(u32x4*)(rowp + 32 * mt + 16 * kp + 8 * h) = (u32x4){a.x, a.y, b.x, b.y}; }
}
DI void store_o_row_fp8(unsigned char* rowp, const f32x16& O0, const f32x16& O1, int h) {
#pragma unroll
    for (int mt = 0; mt < 2; ++mt)
#pragma unroll
        for (int kp = 0; kp < 2; ++kp) { const f32x16& O = mt ? O1 : O0; const int g0 = 8 * kp, g1 = 8 * kp + 4;
            unsigned a = pk4_fp8(O[g0], O[g0 + 1], O[g0 + 2], O[g0 + 3]), b = pk4_fp8(O[g1], O[g1 + 1], O[g1 + 2], O[g1 + 3]);
            { auto r = __builtin_amdgcn_permlane32_swap(a, b, false, false); a = r[0]; b = r[1]; }
            *(u32x2*)(rowp + 32 * mt + 16 * kp + 8 * h) = (u32x2){a, b}; }
}
#define ATTN_WAIT_TILE(more) do { if (more) asm volatile("s_waitcnt vmcnt(8)" ::: "memory"); else asm volatile("s_waitcnt vmcnt(0)" ::: "memory"); } while (0)
DI void q_prep(bf16x8 (&qf)[4], const AttnLane& L, LAS unsigned char* qimg, const u32x4 cc, const u32x4 sn, const float* qg, int h) {
    u32x4 qr[4];
#pragma unroll
    for (int s = 0; s < 4; ++s) qr[s] = *(const LAS u32x4*)(qimg + L.ka[s]);
    float qv[4][8]; float ss = 0.f;
#pragma unroll
    for (int s = 0; s < 4; ++s) { const u32x4 u = qr[s]; qv[s][0] = bf_lo(u.x); qv[s][1] = bf_hi(u.x); qv[s][2] = bf_lo(u.y); qv[s][3] = bf_hi(u.y); qv[s][4] = bf_lo(u.z); qv[s][5] = bf_hi(u.z); qv[s][6] = bf_lo(u.w); qv[s][7] = bf_hi(u.w);
#pragma unroll
        for (int e = 0; e < 8; ++e) ss += qv[s][e] * qv[s][e]; }
    ss = xsum32(ss);
    const float rinv = __builtin_amdgcn_rsqf(ss * (1.f / 64.f) + RMS_EPS) * QSCALE;
#pragma unroll
    for (int s = 0; s < 4; ++s) { const f32x4 ga = *(const f32x4*)(qg + 16 * s + 8 * h), gb = *(const f32x4*)(qg + 16 * s + 8 * h + 4);
        qv[s][0] *= rinv * ga.x; qv[s][1] *= rinv * ga.y; qv[s][2] *= rinv * ga.z; qv[s][3] *= rinv * ga.w; qv[s][4] *= rinv * gb.x; qv[s][5] *= rinv * gb.y; qv[s][6] *= rinv * gb.z; qv[s][7] *= rinv * gb.w; }
    { const float cs[8] = {bf_lo(cc.x), bf_hi(cc.x), bf_lo(cc.y), bf_hi(cc.y), bf_lo(cc.z), bf_hi(cc.z), bf_lo(cc.w), bf_hi(cc.w)};
      const float sv[8] = {bf_lo(sn.x), bf_hi(sn.x), bf_lo(sn.y), bf_hi(sn.y), bf_lo(sn.z), bf_hi(sn.z), bf_lo(sn.w), bf_hi(sn.w)};
#pragma unroll
      for (int e = 0; e < 8; ++e) { const float other = xget32(qv[0][e], h); qv[0][e] = qv[0][e] * cs[e] + other * (h ? sv[e] : -sv[e]); } }
#pragma unroll
    for (int s = 0; s < 4; ++s) { u32x4 o; o.x = pk2(qv[s][0], qv[s][1]); o.y = pk2(qv[s][2], qv[s][3]); o.z = pk2(qv[s][4], qv[s][5]); o.w = pk2(qv[s][6], qv[s][7]); qf[s] = __builtin_bit_cast(bf16x8, o); }
}
DI void sm_step(f32x16& sc, float& mrun, float& lrun, f32x16& O0, f32x16& O1, bf16x8& p0, bf16x8& p1) {
    float mx = sc[0];
#pragma unroll
    for (int i = 1; i < 16; ++i) mx = fmaxf(mx, sc[i]);
    mx = xmax32(mx);
    const float mnew = fmaxf(mrun, mx), alpha = fexp2(mrun - mnew);
    float ps = 0.f;
#pragma unroll
    for (int i = 0; i < 16; ++i) { sc[i] = fexp2(sc[i] - mnew); ps += sc[i]; }
    lrun = lrun * alpha + ps; mrun = mnew;
#pragma unroll
    for (int i = 0; i < 16; ++i) { O0[i] *= alpha; O1[i] *= alpha; }
    p0 = pack8(sc, 0); p1 = pack8(sc, 1);
}
DI void dil_pair(const AttnLane& L, const __amdgpu_buffer_rsrc_t rs, const bf16_t* hb, int hd, long row0, int j, LAS unsigned char* ldsW, bf16_t* og, float* lse, int lrow0, int lane, const float* qg, const bf16_t* ropet, long tok0, int dil) {
    const int qi = lane & 31, h = lane >> 5;
    const unsigned kh = (unsigned)(WS_PROJ + ((size_t)(16 + hd) * T + row0) * 128), vh = (unsigned)(WS_PROJ + ((size_t)(32 + hd) * T + row0) * 128);
    const int kt0 = j >= 4 ? j - 4 : 0;
    bf16x8 qa[4], qb[4];
    {
        const unsigned qoff = (unsigned)(WS_PROJ + ((size_t)hd * T + row0 + 32 * j) * 128);
        dma_q(L, rs, qoff, ldsW + SLOT_BYTES); dma_q(L, rs, qoff + 4096u, ldsW + SLOT_BYTES + 4096);
        dma_tile(L, rs, kh + (unsigned)(4096 * kt0), vh + (unsigned)(4096 * kt0), ldsW);
        const u32x4* rpa = (const u32x4*)(ropet + (size_t)(tok0 + (long)dil * (32 * j + qi)) * 16); const u32x4* rpb = (const u32x4*)(ropet + (size_t)(tok0 + (long)dil * (32 * j + 32 + qi)) * 16);
        const u32x4 cca = rpa[0], sna = rpa[1], ccb = rpb[0], snb = rpb[1];
        asm volatile("s_waitcnt vmcnt(8)" ::: "memory");
        q_prep(qa, L, ldsW + SLOT_BYTES, cca, sna, qg, h);
        q_prep(qb, L, ldsW + SLOT_BYTES + 4096, ccb, snb, qg, h);
    }
    float ma = -INFINITY, la = 0.f, mb = -INFINITY, lb = 0.f;
    f32x16 A0, A1, B0, B1;
#pragma unroll
    for (int i = 0; i < 16; ++i) { A0[i] = 0.f; A1[i] = 0.f; B0[i] = 0.f; B1[i] = 0.f; }
    LDS_WAIT();
    unsigned buf = 0;
    for (int kt = kt0; kt <= j + 1; ++kt) {
        const bool more = kt <= j;
        if (more) dma_tile(L, rs, kh + (unsigned)(4096 * (kt + 1)), vh + (unsigned)(4096 * (kt + 1)), ldsW + (buf ^ 1u) * SLOT_BYTES);
        ATTN_WAIT_TILE(more);
        LAS unsigned char* slot = ldsW + buf * SLOT_BYTES;
        const bool useA = kt <= j, useB = kt >= j - 3;
        bf16x8 kf[4];
#pragma unroll
        for (int s = 0; s < 4; ++s) kf[s] = *(const LAS bf16x8*)(slot + L.ka[s]);
        f32x16 sa, sb;
#pragma unroll
        for (int i = 0; i < 16; ++i) { sa[i] = 0.f; sb[i] = 0.f; }
        if (useA) {
#pragma unroll
            for (int s = 0; s < 4; ++s) sa = mfma32(kf[s], qa[s], sa);
        }
        if (useB) {
#pragma unroll
            for (int s = 0; s < 4; ++s) sb = mfma32(kf[s], qb[s], sb);
        }
        if (kt == j) {
#pragma unroll
            for (int i = 0; i < 16; ++i) { const int key = (i & 3) + 8 * (i >> 2) + 4 * h; if (key > qi) sa[i] = -INFINITY; }
        }
        if (kt == j + 1) {
#pragma unroll
            for (int i = 0; i < 16; ++i) { const int key = (i & 3) + 8 * (i >> 2) + 4 * h; if (key > qi) sb[i] = -INFINITY; }
        }
        if (kt == j - 4) {
#pragma unroll
            for (int i = 0; i < 16; ++i) { const int key = (i & 3) + 8 * (i >> 2) + 4 * h; if (key < qi) sa[i] = -INFINITY; }
        }
        if (kt == j - 3) {
#pragma unroll
            for (int i = 0; i < 16; ++i) { const int key = (i & 3) + 8 * (i >> 2) + 4 * h; if (key < qi) sb[i] = -INFINITY; }
        }
        bf16x8 pa0, pa1, pb0, pb1;
        if (useA) sm_step(sa, ma, la, A0, A1, pa0, pa1);
        if (useB) sm_step(sb, mb, lb, B0, B1, pb0, pb1);
        bf16x8 vf[2][2]; tr_read8(L, (unsigned)(size_t)slot, vf);
        if (useA) { A0 = mfma32(vf[0][0], pa0, A0); A0 = mfma32(vf[0][1], pa1, A0); A1 = mfma32(vf[1][0], pa0, A1); A1 = mfma32(vf[1][1], pa1, A1); }
        if (useB) { B0 = mfma32(vf[0][0], pb0, B0); B0 = mfma32(vf[0][1], pb1, B0); B1 = mfma32(vf[1][0], pb0, B1); B1 = mfma32(vf[1][1], pb1, B1); }
        buf ^= 1u;
    }
    {   const float ltot = xsum32(la), inv = frcp(ltot); const int row = lrow0 + qi;
        store_o_row(og + (size_t)row * 64, A0, A1, inv, h);
        if (h == 0) lse[row] = ma + flog2(ltot); }
    {   const float ltot = xsum32(lb), inv = frcp(ltot); const int row = lrow0 + 32 + qi;
        store_o_row(og + (size_t)row * 64, B0, B1, inv, h);
        if (h == 0) lse[row] = mb + flog2(ltot); }
}
DI void sb_step(f32x16& z, float& carry, bool diag, int qi, int h, bf16x8& p0, bf16x8& p1) {
#pragma unroll
    for (int i = 0; i < 16; ++i) z[i] = fexp2(fminf(z[i], 31.f));
    if (diag) {
#pragma unroll
        for (int i = 0; i < 16; ++i) { const int key = (i & 3) + 8 * (i >> 2) + 4 * h; if (key >= qi) z[i] = 0.f; }
    }
    float lg[4], par[4], u0[4], p01[4], p012[4];
#pragma unroll
    for (int g = 0; g < 4; ++g) { const float a0 = 1.f + z[4 * g], a1 = 1.f + z[4 * g + 1], a2 = 1.f + z[4 * g + 2], a3 = 1.f + z[4 * g + 3];
        u0[g] = a0; p01[g] = a0 * a1; p012[g] = p01[g] * a2; lg[g] = -flog2(p012[g] * a3); }
#pragma unroll
    for (int g = 0; g < 4; ++g) par[g] = xget32(lg[g], h);
    float tg[4]; tg[3] = carry; tg[2] = tg[3] + (lg[3] + par[3]); tg[1] = tg[2] + (lg[2] + par[2]); tg[0] = tg[1] + (lg[1] + par[1]);
    carry = tg[0] + (lg[0] + par[0]);
#pragma unroll
    for (int g = 0; g < 4; ++g) { const float suf = tg[g] + lg[g] + (h == 0 ? par[g] : 0.f); const float y = fexp2(suf);
        z[4 * g] = z[4 * g] * y; z[4 * g + 1] = z[4 * g + 1] * (y * u0[g]); z[4 * g + 2] = z[4 * g + 2] * (y * p01[g]); z[4 * g + 3] = z[4 * g + 3] * (y * p012[g]); }
    p0 = pack8(z, 0); p1 = pack8(z, 1);
}
DI void sb_pair(const AttnLane& L, const __amdgpu_buffer_rsrc_t rs, const bf16_t* hb, int b, int h4, int j, LAS unsigned char* ldsW, unsigned char* ocat, int lane) {
    const int qi = lane & 31, h = lane >> 5;
    const long base = (long)b * S;
    const unsigned kh = (unsigned)(WS_PROJ + ((size_t)(16 + 12 + h4) * T + base) * 128), vh = (unsigned)(WS_PROJ + ((size_t)(32 + 12 + h4) * T + base) * 128);
    bf16x8 qa[4], qb[4];
    {
        const unsigned qoff = (unsigned)(WS_PROJ + ((size_t)(12 + h4) * T + base + 32 * j) * 128);
        dma_q(L, rs, qoff, ldsW + SLOT_BYTES); dma_q(L, rs, qoff + 4096u, ldsW + SLOT_BYTES + 4096);
        dma_tile(L, rs, kh + (unsigned)(4096 * (j + 1)), vh + (unsigned)(4096 * (j + 1)), ldsW);
        asm volatile("s_waitcnt vmcnt(8)" ::: "memory");
#pragma unroll
        for (int s = 0; s < 4; ++s) { qa[s] = *(const LAS bf16x8*)(ldsW + SLOT_BYTES + L.ka[s]); qb[s] = *(const LAS bf16x8*)(ldsW + SLOT_BYTES + 4096 + L.ka[s]); }
    }
    float ca = 0.f, cb = 0.f;
    f32x16 A0, A1, B0, B1;
#pragma unroll
    for (int i = 0; i < 16; ++i) { A0[i] = 0.f; A1[i] = 0.f; B0[i] = 0.f; B1[i] = 0.f; }
    bool doneA = false, doneB = false;
    LDS_WAIT();
    unsigned buf = 0;
    for (int kt = j + 1; kt >= 0; --kt) {
        const bool more = kt > 0;
        if (more) dma_tile(L, rs, kh + (unsigned)(4096 * (kt - 1)), vh + (unsigned)(4096 * (kt - 1)), ldsW + (buf ^ 1u) * SLOT_BYTES);
        ATTN_WAIT_TILE(more);
        LAS unsigned char* slot = ldsW + buf * SLOT_BYTES;
        const bool actA = kt <= j && !doneA, actB = !doneB;
        bf16x8 kf[4];
#pragma unroll
        for (int s = 0; s < 4; ++s) kf[s] = *(const LAS bf16x8*)(slot + L.ka[s]);
        f32x16 za, zb;
#pragma unroll
        for (int i = 0; i < 16; ++i) { za[i] = 0.f; zb[i] = 0.f; }
        if (actA) {
#pragma unroll
            for (int s = 0; s < 4; ++s) za = mfma32(kf[s], qa[s], za);
        }
        if (actB) {
#pragma unroll
            for (int s = 0; s < 4; ++s) zb = mfma32(kf[s], qb[s], zb);
        }
        bf16x8 pa0, pa1, pb0, pb1;
        if (actA) sb_step(za, ca, kt == j, qi, h, pa0, pa1);
        if (actB) sb_step(zb, cb, kt == j + 1, qi, h, pb0, pb1);
        bf16x8 vf[2][2]; tr_read8(L, (unsigned)(size_t)slot, vf);
        if (actA) { A0 = mfma32(vf[0][0], pa0, A0); A0 = mfma32(vf[0][1], pa1, A0); A1 = mfma32(vf[1][0], pa0, A1); A1 = mfma32(vf[1][1], pa1, A1); doneA = __all(ca < -40.f); }
        if (actB) { B0 = mfma32(vf[0][0], pb0, B0); B0 = mfma32(vf[0][1], pb1, B0); B1 = mfma32(vf[1][0], pb0, B1); B1 = mfma32(vf[1][1], pb1, B1); doneB = __all(cb < -40.f); }
        if (doneA && doneB) break;
        buf ^= 1u;
    }
    store_o_row_fp8(ocat + (size_t)(base + 32 * j + qi) * LDO + 256 + h4 * 64, A0, A1, h);
    store_o_row_fp8(ocat + (size_t)(base + 32 * j + 32 + qi) * LDO + 256 + h4 * 64, B0, B1, h);
}
DI void phase_attn(const Frame& F, const Params& p) {
    const int tid_ = fresh_tid(), lane_ = tid_ & 63;
    const bf16_t* hb = (const bf16_t*)(F.ws + WS_PROJ); unsigned char* ocat = F.ws + WS_OCAT;
    bf16_t* og = (bf16_t*)(F.ws + WS_OG) + (size_t)F.bid * (3 * 1024 * 64); float* lse = (float*)(F.ws + WS_LSE) + (size_t)F.bid * (3 * 1024);
    LAS unsigned char* ldsW = F.lds + F.wave * (2 * SLOT_BYTES);
    AttnLane L; attn_lane_init(L, lane_);
    const __amdgpu_buffer_rsrc_t rs = __builtin_amdgcn_make_buffer_rsrc(F.ws, 0, (int)WS_END, 0x00020000);
    const int NU = NB * 4 * 8;
    for (int i = 0;; ++i) {
        const int u = (F.G == 256) ? ((F.bid & 7) * 32 + (F.bid >> 3) + 256 * i) : (F.bid + F.G * i);
        if (u >= NU) break;
        const int qb = u & 7, hs = (u >> 3) & 3, b = u >> 5, t0 = qb * 1024;
        if (i > 0) __syncthreads();
        for (int w = F.wave; w < 16; w += 8) sb_pair(L, rs, hb, b, hs, t0 / 32 + 2 * w, ldsW, ocat, lane_);
        for (int w = F.wave; w < 48; w += 8) {
            const int g = w >> 4, ti = 2 * (w & 15), l2d = 2 * g, per = 32 >> l2d, r = ti / per, jj = ti % per;
            dil_pair(L, rs, hb, g * 4 + hs, (long)b * S + (long)r * (S >> l2d), ((t0 >> l2d) >> 5) + jj, ldsW, og + (size_t)g * (1024 * 64), lse + g * 1024, ti * 32, lane_, p.in[I_QG], (const bf16_t*)(F.ws + WS_ROPE), (long)b * S + r, 1 << l2d);
        }
        VM_WAIT();
        __syncthreads();
        {
            const int piece = tid_ & 7; const size_t bb = (size_t)b * S;
#pragma unroll 2
            for (int pass = 0; pass < 16; ++pass) {
                const int sq = t0 + pass * 64 + (tid_ >> 3);
                const int r0 = sq - t0, r1 = 1024 + (sq & 3) * 256 + ((sq - t0) >> 2), r2 = 2048 + (sq & 15) * 64 + ((sq - t0) >> 4);
                const float l0 = lse[r0], l1 = lse[r1], l2 = lse[r2];
                const u32x4 x = *((const u32x4*)(og + (size_t)r0 * 64) + piece), y = *((const u32x4*)(og + (size_t)r1 * 64) + piece), z = *((const u32x4*)(og + (size_t)r2 * 64) + piece);
                const float mx = fmaxf(l0, fmaxf(l1, l2)); float w0 = fexp2(l0 - mx), w1 = fexp2(l1 - mx), w2 = fexp2(l2 - mx); const float inv = frcp(w0 + w1 + w2); w0 *= inv; w1 *= inv; w2 *= inv;
                u32x2 r;
                r.x = pk4_fp8(w0 * bf_lo(x.x) + w1 * bf_lo(y.x) + w2 * bf_lo(z.x), w0 * bf_hi(x.x) + w1 * bf_hi(y.x) + w2 * bf_hi(z.x), w0 * bf_lo(x.y) + w1 * bf_lo(y.y) + w2 * bf_lo(z.y), w0 * bf_hi(x.y) + w1 * bf_hi(y.y) + w2 * bf_hi(z.y));
                r.y = pk4_fp8(w0 * bf_lo(x.z) + w1 * bf_lo(y.z) + w2 * bf_lo(z.z), w0 * bf_hi(x.z) + w1 * bf_hi(y.z) + w2 * bf_hi(z.z), w0 * bf_lo(x.w) + w1 * bf_lo(y.w) + w2 * bf_lo(z.w), w0 * bf_hi(x.w) + w1 * bf_hi(y.w) + w2 * bf_hi(z.w));
                *((u32x2*)(ocat + (bb + sq) * LDO + hs * 64) + piece) = r;
            }
        }
        __syncthreads();
    }
}

DI void route_rows(const Frame& F, const Params& p, int pm) {
    const int tid_ = fresh_tid(), lane_ = tid_ & 63;
    LAS int* hist = (LAS int*)(F.lds);
    const int ftid = fresh_tid();
    __syncthreads();
    if (ftid < 32) hist[ftid] = 0;
    __syncthreads();
    if (tid_ < 256) {
        const int row = pm * 256 + tid_; const float* L = (const float*)(F.ws + WS_LOGIT) + (size_t)row * 128;
        const float* brg = p.in[I_BRG]; const float* bre = p.in[I_BRE];
        float lgp[4];
#pragma unroll
        for (int c = 0; c < 4; ++c) lgp[c] = L[c] + L[36 + c] + brg[c];
        int gsel = 0; float gm = lgp[0];
#pragma unroll
        for (int c = 1; c < 4; ++c) if (lgp[c] > gm) { gm = lgp[c]; gsel = c; }
        float zs = 0.f;
#pragma unroll
        for (int c = 0; c < 4; ++c) zs += fexp2((lgp[c] - gm) * LOG2E);
        const float pg = frcp(zs);
        float l1 = -INFINITY, l2 = -INFINITY; int e1 = 0, e2 = 0;
#pragma unroll
        for (int i = 0; i < 8; ++i) { const int c = 4 + gsel * 8 + i; const float v = L[c] + L[36 + c] + bre[gsel * 8 + i];
            if (v > l1) { l2 = l1; e2 = e1; l1 = v; e1 = i; } else if (v > l2) { l2 = v; e2 = i; } }
        const float ex = fexp2((l2 - l1) * LOG2E), den = frcp(1.f + ex);
        int* te = (int*)(F.ws + WS_TOKE) + (size_t)row * 2; float* tw = (float*)(F.ws + WS_TOKW) + (size_t)row * 2;
        te[0] = gsel * 8 + e1; te[1] = gsel * 8 + e2; tw[0] = pg * den; tw[1] = pg * ex * den;
        lds_add(&hist[gsel * 8 + e1], 1); lds_add(&hist[gsel * 8 + e2], 1);
    }
    __syncthreads();
    if (ftid < 32) ((int*)(F.ws + WS_HIST))[pm * 32 + ftid] = hist[ftid];
}


DI void router_weights_to_lds(const Frame& F, const Params& p) {
    const int tid_ = fresh_tid(), lane_ = tid_ & 63;
    constexpr int WP = 1028;
    LAS float* wt = (LAS float*)(F.lds + LDS_RW); LAS float* bias = (LAS float*)(F.lds + LDS_RS) + 8 * 80 + 32;
    const float* wrg = p.in[I_WRG]; const float* wre = p.in[I_WRE]; const float* brg = p.in[I_BRG]; const float* bre = p.in[I_BRE];
    const int ftid = fresh_tid();
    __syncthreads();
#pragma unroll 8
    for (int i = ftid; i < 1024 * 32; i += 512) wt[(4 + (i & 31)) * WP + (i >> 5)] = wre[i];
#pragma unroll 8
    for (int i = ftid; i < 1024 * 4; i += 512) wt[(i & 3) * WP + (i >> 2)] = wrg[i];
    if (ftid < 36) bias[ftid] = ftid < 4 ? brg[ftid] : bre[ftid - 4];
}

DI void phase_norm2_route(const Frame& F, const Params& p) {
    const int tid_ = fresh_tid(), lane_ = tid_ & 63;
    constexpr int WP = 1028;
    LAS float* wt = (LAS float*)(F.lds + LDS_RW);
    LAS float* gs = (LAS float*)(F.lds + LDS_RV); LAS float* sh = gs + 1024;
    LAS float* scr = (LAS float*)(F.lds + LDS_RS) + F.wave * 80;
    LAS int* hist = (LAS int*)(F.lds + LDS_RS) + 8 * 80;
    LAS float* bias = (LAS float*)(F.lds + LDS_RS) + 8 * 80 + 32;
    const float* mod = (const float*)(F.ws + WS_MOD); const float* gn = p.in[I_GFFN];
    const bf16_t* upd = (const bf16_t*)(F.ws + WS_UPD1); bf16_t* x1w = (bf16_t*)(F.ws + WS_UPD1); unsigned* h8 = (unsigned*)(F.ws + WS_H28);
    const float* wrg = p.in[I_WRG]; const float* wre = p.in[I_WRE]; const float* brg = p.in[I_BRG]; const float* bre = p.in[I_BRE];
    const int ftid = fresh_tid();
    __syncthreads();
    for (int chunk = F.bid; chunk < T / 256; chunk += F.G) {
        const int b = chunk >> 5;
        __syncthreads();
        for (int col = ftid; col < 1024; col += 512) { gs[col] = gn[col] * (1.f + mod[b * 6144 + 4096 + col]); sh[col] = mod[b * 6144 + 3072 + col]; }
        if (ftid < 32) hist[ftid] = 0;
        __syncthreads();
        f32x4 vn[2][4]; u32x2 un[2][4];
#pragma unroll
        for (int r = 0; r < 2; ++r) { const int row = chunk * 256 + F.wave * 2 + r;
            const f32x4* xr = (const f32x4*)(p.in[I_X] + (size_t)row * 1024) + lane_; const u32x2* ur = (const u32x2*)(upd + (size_t)row * 1024) + lane_;
#pragma unroll
            for (int j = 0; j < 4; ++j) { vn[r][j] = xr[64 * j]; un[r][j] = ur[64 * j]; } }
        for (int rr = F.wave * 2; rr < 256; rr += 16) {
            const int row0 = chunk * 256 + rr;
            f32x4 y[2][4];
#pragma unroll
            for (int r = 0; r < 2; ++r) {
                const int row = row0 + r; float ss = 0.f;
#pragma unroll
                for (int j = 0; j < 4; ++j) { vn[r][j].x += bf_lo(un[r][j].x); vn[r][j].y += bf_hi(un[r][j].x); vn[r][j].z += bf_lo(un[r][j].y); vn[r][j].w += bf_hi(un[r][j].y);
                    { u32x2 o; o.x = pk2(vn[r][j].x, vn[r][j].y); o.y = pk2(vn[r][j].z, vn[r][j].w); *((u32x2*)(x1w + (size_t)row * 1024) + lane_ + 64 * j) = o; }
                    ss += (vn[r][j].x * vn[r][j].x + vn[r][j].y * vn[r][j].y) + (vn[r][j].z * vn[r][j].z + vn[r][j].w * vn[r][j].w); }
                const float rinv = __builtin_amdgcn_rsqf(wave_sum(ss) * (1.f / 1024.f) + RMS_EPS);
#pragma unroll
                for (int j = 0; j < 4; ++j) { const f32x4 gj = *(const LAS f32x4*)(gs + 256 * j + 4 * lane_), sj = *(const LAS f32x4*)(sh + 256 * j + 4 * lane_);
                    y[r][j] = vn[r][j] * rinv * gj + sj; h8[(size_t)row * 256 + 64 * j + lane_] = pk4_fp8(y[r][j].x, y[r][j].y, y[r][j].z, y[r][j].w); }
            }
            if (rr + 16 < 256) {
#pragma unroll
                for (int r = 0; r < 2; ++r) { const int row = row0 + 16 + r;
                    const f32x4* xr = (const f32x4*)(p.in[I_X] + (size_t)row * 1024) + lane_; const u32x2* ur = (const u32x2*)(upd + (size_t)row * 1024) + lane_;
#pragma unroll
                    for (int j = 0; j < 4; ++j) { vn[r][j] = xr[64 * j]; un[r][j] = ur[64 * j]; } }
            }
            const bool up32 = (lane_ & 32) != 0, up16 = (lane_ & 16) != 0, up8 = (lane_ & 8) != 0, up4 = (lane_ & 4) != 0;
            {
                f32x2 ga[2][4], gb[2][4];
#pragma unroll
                for (int r = 0; r < 2; ++r)
#pragma unroll
                    for (int c = 0; c < 4; ++c) { ga[r][c] = (f32x2){0.f, 0.f}; gb[r][c] = ga[r][c]; }
#pragma unroll
                for (int c = 0; c < 4; ++c)
#pragma unroll
                    for (int j = 0; j < 4; ++j) { const f32x4 w = *(const LAS f32x4*)(wt + c * WP + 4 * lane_ + 256 * j); const f32x2 wl = {w.x, w.y}, wh = {w.z, w.w};
#pragma unroll
                        for (int r = 0; r < 2; ++r) { ga[r][c] = __builtin_elementwise_fma((f32x2){y[r][j].x, y[r][j].y}, wl, ga[r][c]); gb[r][c] = __builtin_elementwise_fma((f32x2){y[r][j].z, y[r][j].w}, wh, gb[r][c]); } }
                float k4[4];
#pragma unroll
                for (int c = 0; c < 4; ++c) { const f32x2 t0 = ga[0][c] + gb[0][c], t1 = ga[1][c] + gb[1][c]; const float p0 = t0.x + t0.y, p1 = t1.x + t1.y;
                    k4[c] = up32 ? p0 : p1; ga[0][c].x = up32 ? p1 : p0; }
#pragma unroll
                for (int c = 0; c < 4; ++c) k4[c] = ga[0][c].x + __shfl_xor(k4[c], 32);
                float k2[2];
#pragma unroll
                for (int i = 0; i < 2; ++i) k2[i] = (up16 ? k4[2 + i] : k4[i]) + __shfl_xor(up16 ? k4[i] : k4[2 + i], 16);
                float k1 = (up8 ? k2[1] : k2[0]) + __shfl_xor(up8 ? k2[0] : k2[1], 8);
                k1 += __shfl_xor(k1, 4); k1 += __shfl_xor(k1, 2); k1 += __shfl_xor(k1, 1);
                if ((lane_ & 7) == 0) scr[(lane_ >> 5) * 36 + ((lane_ >> 4) & 1) * 2 + ((lane_ >> 3) & 1)] = k1;
            }
            LDS_WAIT();
            int gsel[2];
#pragma unroll
            for (int r = 0; r < 2; ++r) { int gi = 0; float gm = scr[r * 36] + bias[0];
#pragma unroll
                for (int c = 1; c < 4; ++c) { const float v = scr[r * 36 + c] + bias[c]; if (v > gm) { gm = v; gi = c; } }
                gsel[r] = __builtin_amdgcn_readfirstlane(gi); }
            {
                float pe[2][8];
#pragma unroll
                for (int r = 0; r < 2; ++r) {
                    const LAS float* wb = wt + (4 + gsel[r] * 8) * WP + 4 * lane_;
#pragma unroll
                    for (int hh = 0; hh < 2; ++hh) {
                        f32x2 ea[4], eb[4];
#pragma unroll
                        for (int i = 0; i < 4; ++i) { ea[i] = (f32x2){0.f, 0.f}; eb[i] = ea[i]; }
#pragma unroll
                        for (int i = 0; i < 4; ++i)
#pragma unroll
                            for (int j = 0; j < 4; ++j) { const f32x4 w = *(const LAS f32x4*)(wb + (hh * 4 + i) * WP + 256 * j);
                                ea[i] = __builtin_elementwise_fma((f32x2){y[r][j].x, y[r][j].y}, (f32x2){w.x, w.y}, ea[i]); eb[i] = __builtin_elementwise_fma((f32x2){y[r][j].z, y[r][j].w}, (f32x2){w.z, w.w}, eb[i]); }
#pragma unroll
                        for (int i = 0; i < 4; ++i) { const f32x2 t = ea[i] + eb[i]; pe[r][hh * 4 + i] = t.x + t.y; }
                        __builtin_amdgcn_sched_barrier(0);
                    }
                }
                float e8[8], e4[4], e2[2];
#pragma unroll
                for (int i = 0; i < 8; ++i) e8[i] = (up32 ? pe[1][i] : pe[0][i]) + __shfl_xor(up32 ? pe[0][i] : pe[1][i], 32);
#pragma unroll
                for (int i = 0; i < 4; ++i) e4[i] = (up16 ? e8[4 + i] : e8[i]) + __shfl_xor(up16 ? e8[i] : e8[4 + i], 16);
#pragma unroll
                for (int i = 0; i < 2; ++i) e2[i] = (up8 ? e4[2 + i] : e4[i]) + __shfl_xor(up8 ? e4[i] : e4[2 + i], 8);
                float e1 = (up4 ? e2[1] : e2[0]) + __shfl_xor(up4 ? e2[0] : e2[1], 4);
                e1 += __shfl_xor(e1, 2); e1 += __shfl_xor(e1, 1);
                if ((lane_ & 3) == 0) scr[(lane_ >> 5) * 36 + 4 + ((lane_ >> 4) & 1) * 4 + ((lane_ >> 3) & 1) * 2 + ((lane_ >> 2) & 1)] = e1;
            }
            LDS_WAIT();
            if (lane_ < 2) {
                const LAS float* L = scr + lane_ * 36; const int row = row0 + lane_;
                float lgp[4];
#pragma unroll
                for (int c = 0; c < 4; ++c) lgp[c] = L[c] + bias[c];
                int gsel = 0; float gm = lgp[0];
#pragma unroll
                for (int c = 1; c < 4; ++c) if (lgp[c] > gm) { gm = lgp[c]; gsel = c; }
                float zs = 0.f;
#pragma unroll
                for (int c = 0; c < 4; ++c) zs += fexp2((lgp[c] - gm) * LOG2E);
                const float pg = frcp(zs);
                float l1 = -INFINITY, l2 = -INFINITY; int e1 = 0, e2 = 0;
#pragma unroll
                for (int i = 0; i < 8; ++i) { const float v = L[4 + i] + bias[4 + gsel * 8 + i];
                    if (v > l1) { l2 = l1; e2 = e1; l1 = v; e1 = i; } else if (v > l2) { l2 = v; e2 = i; } }
                const float ex = fexp2((l2 - l1) * LOG2E), den = frcp(1.f + ex);
                int* te = (int*)(F.ws + WS_TOKE) + (size_t)row * 2; float* tw = (float*)(F.ws + WS_TOKW) + (size_t)row * 2;
                te[0] = gsel * 8 + e1; te[1] = gsel * 8 + e2; tw[0] = pg * den; tw[1] = pg * ex * den;
                lds_add(&hist[gsel * 8 + e1], 1); lds_add(&hist[gsel * 8 + e2], 1);
            }
            LDS_WAIT();
        }
        __syncthreads();
        if (ftid < 32) ((int*)(F.ws + WS_HIST))[chunk * 32 + ftid] = hist[ftid];
    }
}

DI void phase_slots(const Frame& F, const Params& p) {
    const int tid_ = fresh_tid(), lane_ = tid_ & 63;
    LAS int* tot = (LAS int*)(F.lds); LAS int* bas = tot + 32; LAS int* pst = tot + 64; LAS int* wcnt = tot + 128;
    const int* hist = (const int*)(F.ws + WS_HIST);
    for (int pm = F.bid; pm < T / 256; pm += F.G) {
        const int ftid = fresh_tid();
        __syncthreads();
        if (ftid < 64) tot[ftid] = 0;
        __syncthreads();
        { const int e = tid_ & 31, part = tid_ >> 5; int t = 0, bs = 0;
          for (int q = part; q < T / 256; q += 16) { const int v = hist[q * 32 + e]; t += v; if (q < pm) bs += v; }
          lds_add(&tot[e], t); lds_add(&bas[e], bs); }
        __syncthreads();
        if (tid_ == 0) { int run = 0; for (int e = 0; e < 32; ++e) { pst[e] = run; run += (tot[e] + 255) / 256 * 256; } pst[32] = run; }
        const int my_e = ((const int*)(F.ws + WS_TOKE))[(size_t)pm * 512 + tid_];
        int rank = 0;
        for (int e = 0; e < 32; ++e) { const unsigned long long mask = __ballot(my_e == e); if (my_e == e) rank = __popcll(mask & ((1ull << lane_) - 1ull)); if (lane_ == 0) wcnt[F.wave * 32 + e] = __popcll(mask); }
        __syncthreads();
        int woff = 0;
        for (int w = 0; w < F.wave; ++w) woff += wcnt[w * 32 + my_e];
        const int slot = pst[my_e] + bas[my_e] + woff + rank;
        ((int*)(F.ws + WS_SLOTTOK))[slot] = pm * 256 + (tid_ >> 1);
        ((float*)(F.ws + WS_SLOTW))[slot] = ((const float*)(F.ws + WS_TOKW))[(size_t)pm * 512 + tid_];
        ((int*)(F.ws + WS_TOKS))[(size_t)pm * 512 + tid_] = slot;
        if (pm < 32) { const int e = pm; for (int s = pst[e] + tot[e] + tid_; s < pst[e + 1]; s += 512) { ((int*)(F.ws + WS_SLOTTOK))[s] = 0; ((float*)(F.ws + WS_SLOTW))[s] = 0.f; } }
        if (pm == 0 && tid_ < 34) { int* et = (int*)(F.ws + WS_ETAB); if (tid_ < 33) et[64 + tid_] = pst[tid_] >> 8; if (tid_ < 32) { et[tid_] = tot[tid_]; et[32 + tid_] = pst[tid_]; } if (tid_ == 33) et[97] = pst[32] >> 8; }
    }
}

DI void phase_combine(const Frame& F, const Params& p) {
    const int tid_ = fresh_tid(), lane_ = tid_ & 63;
    const unsigned* y = (const unsigned*)(F.ws + WS_Y); const int* ts = (const int*)(F.ws + WS_TOKS); const float* tw = (const float*)(F.ws + WS_TOKW); const float* mod = (const float*)(F.ws + WS_MOD);
    const int gw = F.bid * 8 + F.wave, NGW = F.G * 8;
    for (int row = gw; row < T; row += NGW) {
        const int s0 = ts[(size_t)row * 2], s1 = ts[(size_t)row * 2 + 1]; const float w0 = tw[(size_t)row * 2] * 0.125f, w1 = tw[(size_t)row * 2 + 1] * 0.125f;
        f32x4* orow = (f32x4*)(p.out + (size_t)row * 1024) + lane_;
        const u32x2* ur = (const u32x2*)((const bf16_t*)(F.ws + WS_UPD1) + (size_t)row * 1024) + lane_;
        const unsigned* y0 = y + (size_t)s0 * 256 + lane_; const unsigned* y1 = y + (size_t)s1 * 256 + lane_;
        const f32x4* g2 = (const f32x4*)(mod + (row >> 13) * 6144 + 5120) + lane_;
        f32x4 v[4], g[4]; unsigned a[4], c[4]; u32x2 uu[4];
#pragma unroll
        for (int j = 0; j < 4; ++j) { uu[j] = ur[64 * j]; a[j] = y0[64 * j]; c[j] = y1[64 * j]; g[j] = g2[64 * j]; }
#pragma unroll
        for (int j = 0; j < 4; ++j) { v[j] = (f32x4){bf_lo(uu[j].x), bf_hi(uu[j].x), bf_lo(uu[j].y), bf_hi(uu[j].y)};
            if (!DBG_SKIP_Y) { const f32x2 al = fp8_lo2(a[j]), ah = fp8_hi2(a[j]), cl = fp8_lo2(c[j]), ch = fp8_hi2(c[j]);
                v[j].x += g[j].x * (w0 * al.x + w1 * cl.x); v[j].y += g[j].y * (w0 * al.y + w1 * cl.y); v[j].z += g[j].z * (w0 * ah.x + w1 * ch.x); v[j].w += g[j].w * (w0 * ah.y + w1 * ch.y); } orow[64 * j] = v[j]; }
    }
}

__global__ void __launch_bounds__(512, 2) fwd(Params p) {
    extern __shared__ __attribute__((aligned(16))) unsigned char lds_raw[];
    Frame F;
    F.lds = (LAS unsigned char*)lds_raw; F.ws = p.ws;
    F.wave = __builtin_amdgcn_readfirstlane((int)threadIdx.x >> 6); F.G = gridDim.x; F.bid = blockIdx.x;
    volatile LAS unsigned* ctl = (volatile LAS unsigned*)(F.lds + LDS_CTLO);
    { const int ftid = fresh_tid(); if (ftid < 64) ctl[ftid] = 0u; }
    __syncthreads();
    XcdBarrier bar; bar.bar = (unsigned*)(p.ws + WS_CTL) + CW_BAR; bar.x = 0; bar.st = ctl;
    if (MK_N_LAUNCHES == 1) bar = xcd_barrier_post((unsigned*)(p.ws + WS_CTL) + CW_BAR, ctl);
    const int lo = p.ph_lo, hi = p.ph_hi;
    const __amdgpu_buffer_rsrc_t rsw = __builtin_amdgcn_make_buffer_rsrc(p.ws, 0, (int)WS_END, 0x00020000);
#define IN(k) (lo <= (k) && (k) < hi)
#define REP(k) for (int rep_ = 0; rep_ < ((PROBE_PH) == (k) ? 2 : 1); ++rep_)
#define SEAM(k) do { if (IN(k) && IN((k) + 1)) xcd_barrier(bar); } while (0)

    if (IN(0)) REP(0) { phase0(F, p); } SEAM(0);
    if (IN(1)) REP(1) { phase_norm<0>(F, p); } SEAM(1);
    if (IN(2)) REP(2) {
        REP(20) {
            pg8::DenseSched Sd; Sd.init(T, 2304, F.G, F.bid, WS_H8, 1024, WS_W1D8, 1024);
            EpiProj<false> E{(bf16_t*)(F.ws + WS_PROJ), (bf16_t*)(F.ws + WS_GATES), (const bf16_t*)(F.ws + WS_ROPE), p.in[I_QG], p.in[I_KG], 0};
            pg8::gemm_phase<EpiProj<false>, pg8::DenseSched, true>(F.lds, 1024, Sd, E, rsw);
        }
        REP(21) {
            pg8::DenseSched Sd; Sd.init(T, 768, F.G, F.bid, WS_H, 2048, WS_W1 + (size_t)2304 * 2048, 2048);
            EpiProj<false> E{(bf16_t*)(F.ws + WS_PROJ), (bf16_t*)(F.ws + WS_GATES), (const bf16_t*)(F.ws + WS_ROPE), p.in[I_QG], p.in[I_KG], 9};
            pg8::gemm_phase<EpiProj<false>, pg8::DenseSched, false>(F.lds, 1024, Sd, E, rsw);
        }
        REP(22) {
            pg8::DenseSched Sd; Sd.init(T, 2048, F.G, F.bid, WS_H8, 1024, WS_WG8, 1024);
            EpiProj<true> E{(bf16_t*)(F.ws + WS_PROJ), (bf16_t*)(F.ws + WS_GATES), (const bf16_t*)(F.ws + WS_ROPE), p.in[I_QG], p.in[I_KG], 0};
            pg8::gemm_phase<EpiProj<true>, pg8::DenseSched, true>(F.lds, 1024, Sd, E, rsw);
        }
    } SEAM(2);
    if (IN(3)) REP(3) { phase_attn(F, p); } SEAM(3);
    if (IN(4)) REP(4) {
        pg8::DiagSched Sd; Sd.init(T, 2048, F.G, F.bid, WS_OCAT, 512, WS_WB, 512);
        EpiBranch E{(const unsigned char*)(F.ws + WS_GATES), F.ws + WS_MERGED};
        pg8::gemm_phase<EpiBranch, pg8::DiagSched, true>(F.lds, 512, Sd, E, rsw);
    } SEAM(4);
    if (IN(5)) REP(5) {
        pg8::DenseSched Sd; Sd.init(T, 1024, F.G, F.bid, WS_MERGED, 1024, WS_WO, 1024);
        EpiOut E{(bf16_t*)(F.ws + WS_UPD1), (const float*)(F.ws + WS_MOD)};
        pg8::gemm_phase<EpiOut, pg8::DenseSched, true>(F.lds, 1024, Sd, E, rsw);
        if (rep_ + 1 == ((PROBE_PH) == 5 ? 2 : 1)) router_weights_to_lds(F, p);
    } SEAM(5);
    if (IN(6)) REP(6) { phase_norm2_route(F, p); }
    if (IN(6) && IN(8)) xcd_barrier(bar);
    if (IN(8)) REP(8) { phase_slots(F, p); } SEAM(8);
    if (IN(9) || IN(10)) {
        LAS int* cst = (LAS int*)(F.lds + LDS_CTLO) + 16;
        __syncthreads();
        { const int ftid = fresh_tid(); if (ftid < 34) cst[ftid] = ((const int*)(F.ws + WS_ETAB))[64 + ftid]; }
        __syncthreads();
    }
    if (IN(9)) REP(9) {
        const LAS int* cst = (const LAS int*)(F.lds + LDS_CTLO) + 16;
        MoeSchedUp Sm; Sm.G = F.G; Sm.c = (F.G == 256) ? ((F.bid & 7) * 32 + (F.bid >> 3)) : F.bid; Sm.nc = __builtin_amdgcn_readfirstlane(cst[33]); Sm.pa = 1024; Sm.pb = 1024; Sm.A = (unsigned)WS_H28; Sm.B = (unsigned)WS_WGU; Sm.cstart = cst;
        Sm.slot_tok = (const int*)(F.ws + WS_SLOTTOK); Sm.estride = 1024u * 1024u; Sm.pnstride = 256u * 1024u;
        EpiSwiglu E{F.ws + WS_HMID};
        pg8::gemm_phase<EpiSwiglu, MoeSchedUp, true>(F.lds, 1024, Sm, E, rsw);
    } SEAM(9);
    if (IN(10)) REP(10) {
        const LAS int* cst = (const LAS int*)(F.lds + LDS_CTLO) + 16;
        MoeSchedDn Sm; Sm.G = F.G; Sm.c = (F.G == 256) ? ((F.bid & 7) * 32 + (F.bid >> 3)) : F.bid; Sm.nc = __builtin_amdgcn_readfirstlane(cst[33]); Sm.pa = 512; Sm.pb = 512; Sm.A = (unsigned)WS_HMID; Sm.B = (unsigned)WS_WDN; Sm.cstart = cst;
        Sm.slot_tok = (const int*)(F.ws + WS_SLOTTOK); Sm.estride = 1024u * 512u; Sm.pnstride = 256u * 512u;
        EpiDown E{F.ws + WS_Y};
        pg8::gemm_phase<EpiDown, MoeSchedDn, true>(F.lds, 512, Sm, E, rsw);
    } SEAM(10);
    if (IN(11)) { phase_combine(F, p); }
#undef IN
#undef SEAM
}

extern "C" void kernel_launch(void* const* d_in, const int* in_sizes, int n_in, void* d_out, int out_size, void* d_ws, size_t ws_size, hipStream_t stream) {
    static int grid = 0;
    if (grid == 0) {
        if (n_in != 21 || in_sizes[0] != T * D || out_size != T * D || ws_size < WS_END) { fprintf(stderr, "kernel_launch: unexpected problem (n_in %d, ws %zu)\n", n_in, ws_size); grid = -1; return; }
        int dev = 0, cus = 0, per_cu = 0;
        if (hipGetDevice(&dev) != hipSuccess || hipDeviceGetAttribute(&cus, hipDeviceAttributeMultiprocessorCount, dev) != hipSuccess) { grid = -1; return; }
        if (hipFuncSetAttribute((const void*)fwd, hipFuncAttributeMaxDynamicSharedMemorySize, LDS_BYTES) != hipSuccess) { fprintf(stderr, "kernel_launch: hipFuncSetAttribute failed\n"); grid = -1; return; }
        if (hipOccupancyMaxActiveBlocksPerMultiprocessor(&per_cu, (const void*)fwd, 512, LDS_BYTES) != hipSuccess || per_cu < 1) { fprintf(stderr, "kernel_launch: occupancy query says %d\n", per_cu); (void)hipGetLastError(); grid = -1; return; }
        grid = cus;
    }
    if (grid < 0) return;
    (void)hipMemsetAsync((char*)d_ws + WS_CTL, 0, CTL_ZERO_BYTES, stream);
    Params p{};
    for (int i = 0; i < 21; ++i) p.in[i] = (const float*)d_in[i];
    p.out = (float*)d_out; p.ws = (unsigned char*)d_ws;
    if (MK_N_LAUNCHES == 1) { p.ph_lo = 0; p.ph_hi = NPH; hipLaunchKernelGGL(fwd, dim3(grid), dim3(512), LDS_BYTES, stream, p); }
    else { for (int k = 0; k < NPH; ++k) { p.ph_lo = k; p.ph_hi = k + 1; hipLaunchKernelGGL(fwd, dim3(grid), dim3(512), LDS_BYTES, stream, p); } }
}
```

```cpp
#include <hip/hip_runtime.h>
#include <cstdio>
#include <cstdint>

#ifndef MK_N_LAUNCHES
#define MK_N_LAUNCHES 1
#endif
#define DBG_X1_PLAIN 0
#define DBG_SKIP_Y 0
#ifndef PROBE_PH
#define PROBE_PH -1
#endif

#define LAS __attribute__((address_space(3)))
#define DI __device__ __forceinline__
typedef unsigned short bf16_t;
typedef short bf16x8 __attribute__((ext_vector_type(8)));
typedef short s16x4 __attribute__((ext_vector_type(4)));
typedef float f32x2 __attribute__((ext_vector_type(2)));
typedef float f32x4 __attribute__((ext_vector_type(4)));
typedef float f32x16 __attribute__((ext_vector_type(16)));
typedef unsigned u32x2 __attribute__((ext_vector_type(2)));
typedef unsigned u32x4 __attribute__((ext_vector_type(4)));
typedef __bf16 bf16x2n __attribute__((ext_vector_type(2)));
typedef int i32x8 __attribute__((ext_vector_type(8)));

constexpr int NB = 8, S = 8192, D = 1024, T = NB * S;
constexpr int LDP = 3072, LDG = 2048, LDO = 512;
constexpr int NE = 32, DE = 512;
constexpr int MAXSLOT = T * 2 + NE * 256;
constexpr int NPH = 12;
constexpr float LOG2E = 1.4426950408889634f;
constexpr float QSCALE = 0.125f * LOG2E;
constexpr float RMS_EPS = 1e-6f;

constexpr size_t MiB = 1u << 20;
constexpr size_t WS_CTL = 0, CTL_ZERO_BYTES = 64 * 1024;
constexpr int CW_BAR = 1024;
constexpr size_t WS_MODP = 1 * MiB;
constexpr size_t WS_MOD = 3 * MiB;
constexpr size_t WS_ROPE = 4 * MiB;
constexpr size_t WS_LOGIT = 144 * MiB;
constexpr size_t WS_TOKE = 24 * MiB;
constexpr size_t WS_TOKW = 24 * MiB + 512 * 1024;
constexpr size_t WS_TOKS = 25 * MiB;
constexpr size_t WS_SLOTTOK = 25 * MiB + 512 * 1024;
constexpr size_t WS_SLOTW = 26 * MiB + 256 * 1024;
constexpr size_t WS_HIST = 27 * MiB;
constexpr size_t WS_ETAB = 27 * MiB + 256 * 1024;
constexpr size_t WS_WR = 28 * MiB;
constexpr size_t WS_W1D8 = 28 * MiB + 512 * 1024;
constexpr size_t WS_W1 = 32 * MiB;
constexpr size_t WS_WG8 = 38 * MiB;
constexpr size_t WS_WB = 40 * MiB;
constexpr size_t WS_WO = 43 * MiB;
constexpr size_t WS_WGU = 48 * MiB;
constexpr size_t WS_WDN = 80 * MiB;
constexpr size_t WS_H = 144 * MiB;
constexpr size_t WS_OG = 144 * MiB;
constexpr size_t WS_LSE = 240 * MiB;
constexpr size_t WS_PROJ = 272 * MiB;
constexpr size_t WS_GATES = 656 * MiB;
constexpr size_t WS_OCAT = 912 * MiB;
constexpr size_t WS_H8 = 912 * MiB;
constexpr size_t WS_MERGED = 272 * MiB;
constexpr size_t WS_H2 = 400 * MiB;
constexpr size_t WS_H28 = 528 * MiB;
constexpr size_t WS_HMID = 592 * MiB;
constexpr size_t WS_Y = 664 * MiB;
constexpr size_t WS_UPD1 = 800 * MiB;
constexpr size_t WS_END = 976 * MiB;

constexpr int LDS_STAGE = 0, LDS_EPI = 131072, LDS_RW = 0, LDS_RV = 148480, LDS_RS = 148480 + 8192, LDS_CTLO = 148480 + 8192 + 3072, LDS_BYTES = LDS_CTLO + 256;

DI unsigned pk2(float lo, float hi) { f32x2 v = {lo, hi}; bf16x2n r = __builtin_convertvector(v, bf16x2n); return __builtin_bit_cast(unsigned, r); }
DI unsigned pk4_fp8(float a, float b, float c, float d) { int r = __builtin_amdgcn_cvt_pk_fp8_f32(a, b, 0, false); r = __builtin_amdgcn_cvt_pk_fp8_f32(c, d, r, true); return (unsigned)r; }
DI f32x2 fp8_lo2(unsigned u) { return __builtin_amdgcn_cvt_pk_f32_fp8((int)u, false); }
DI f32x2 fp8_hi2(unsigned u) { return __builtin_amdgcn_cvt_pk_f32_fp8((int)u, true); }
DI float bf_lo(unsigned u) { return __builtin_bit_cast(float, u << 16); }
DI float bf_hi(unsigned u) { return __builtin_bit_cast(float, u & 0xffff0000u); }
struct Swap2 { float lo, hi; };
DI Swap2 swap32(float x) { const unsigned b = __builtin_bit_cast(unsigned, x); auto r = __builtin_amdgcn_permlane32_swap(b, b, false, false); const unsigned r0 = r[0], r1 = r[1]; return Swap2{__builtin_bit_cast(float, r0), __builtin_bit_cast(float, r1)}; }
DI Swap2 swap16(float x) { const unsigned b = __builtin_bit_cast(unsigned, x); auto r = __builtin_amdgcn_permlane16_swap(b, b, false, false); const unsigned r0 = r[0], r1 = r[1]; return Swap2{__builtin_bit_cast(float, r0), __builtin_bit_cast(float, r1)}; }
DI float xsum32(float x) { const Swap2 s = swap32(x); return s.lo + s.hi; }
DI float xmax32(float x) { const Swap2 s = swap32(x); return fmaxf(s.lo, s.hi); }
DI float xget32(float x, int upper) { const Swap2 s = swap32(x); return upper ? s.lo : s.hi; }
DI float wave_sum(float v) {
    v += __builtin_bit_cast(float, __builtin_amdgcn_update_dpp(0, __builtin_bit_cast(int, v), 0xB1, 0xF, 0xF, true));
    v += __builtin_bit_cast(float, __builtin_amdgcn_update_dpp(0, __builtin_bit_cast(int, v), 0x4E, 0xF, 0xF, true));
    v += __builtin_bit_cast(float, __builtin_amdgcn_update_dpp(0, __builtin_bit_cast(int, v), 0x141, 0xF, 0xF, true));
    v += __builtin_bit_cast(float, __builtin_amdgcn_update_dpp(0, __builtin_bit_cast(int, v), 0x140, 0xF, 0xF, true));
    { const Swap2 s = swap16(v); v = s.lo + s.hi; }
    { const Swap2 s = swap32(v); v = s.lo + s.hi; }
    return v;
}
DI float fexp2(float x) { return __builtin_amdgcn_exp2f(x); }
DI float flog2(float x) { return __builtin_amdgcn_logf(x); }
DI float frcp(float x) { return __builtin_amdgcn_rcpf(x); }
DI float sigmoidf(float v) { return frcp(1.0f + fexp2(-v * LOG2E)); }
DI void lds_add(LAS int* p, int v) { (void)__hip_atomic_fetch_add(p, v, __ATOMIC_RELAXED, __HIP_MEMORY_SCOPE_WORKGROUP); }
#define LDS_WAIT() asm volatile("s_waitcnt lgkmcnt(0)" ::: "memory")
#define VM_WAIT() asm volatile("s_waitcnt vmcnt(0)" ::: "memory")
DI int fresh_tid() { int t = threadIdx.x; asm volatile("" : "+v"(t)); return t; }

#define XB_TMO      128
#define XB_XCNT(j)  (256  + 64 * (j))
#define XB_XSUB(j)  (1280 + 64 * (j))
#define XB_XGEN(j)  (2304 + 64 * (j))
#define XB_TOP      3328
#define XB_TOPGEN   3392
#define XCD_BAR_WORDS 3456
#define XB_SPIN_CAP (1u << 18)

__device__ __forceinline__ unsigned xb_ld(unsigned* p)              { return __hip_atomic_load(p, __ATOMIC_RELAXED, __HIP_MEMORY_SCOPE_AGENT); }
__device__ __forceinline__ unsigned xb_add(unsigned* p, unsigned v) { return __hip_atomic_fetch_add(p, v, __ATOMIC_RELAXED, __HIP_MEMORY_SCOPE_AGENT); }
__device__ __forceinline__ unsigned xb_xcc_id() { return (unsigned)__builtin_amdgcn_s_getreg((3 << 11) | 20) & 0xFu; }
#define XB_SPIN(cond, bar) do { unsigned _sp = 0; while (cond) { __builtin_amdgcn_s_sleep(1); \
    if ((++_sp & 255u) == 0u) { if (xb_ld(&(bar)[XB_TMO])) break; if (_sp > XB_SPIN_CAP) { atomicAdd(&(bar)[XB_TMO], 1u); break; } } } } while (0)

struct XcdBarrier {
    unsigned* bar; unsigned x;
    volatile LAS unsigned* st;
};
__device__ __forceinline__ XcdBarrier xcd_barrier_post(unsigned* bar, volatile LAS unsigned* st) {
    XcdBarrier b; b.bar = bar; b.x = xb_xcc_id(); b.st = st;
    if (threadIdx.x == 0) (void)xb_add(&bar[XB_XCNT(b.x)], 1u);
    return b;
}
__device__ __forceinline__ void xcd_barrier_complete(unsigned* bar, unsigned x, unsigned& nloc, unsigned& nx) {
    const unsigned G = gridDim.x * gridDim.y * gridDim.z;
    unsigned sum, cnt, mine, sp = 0u;
    for (;;) {
        sum = 0u; cnt = 0u; mine = 0u;
#pragma unroll
        for (unsigned j = 0; j < 16; ++j) { const unsigned c = xb_ld(&bar[XB_XCNT(j)]); sum += c; cnt += (c > 0u) ? 1u : 0u; mine = (j == x) ? c : mine; }
        if (sum == G) break;
        __builtin_amdgcn_s_sleep(1);
        if ((++sp & 255u) == 0u) { if (xb_ld(&bar[XB_TMO])) break; if (sp > XB_SPIN_CAP) { atomicAdd(&bar[XB_TMO], 1u); break; } }
    }
    nloc = mine > 0u ? mine : 1u; nx = cnt > 0u ? cnt : 1u;
}
__device__ __forceinline__ void xcd_barrier(const XcdBarrier& b) {
    asm volatile("s_waitcnt vmcnt(0)" ::: "memory");
    __syncthreads();
    if (threadIdx.x == 0) {
        unsigned* bar = b.bar;
        __builtin_amdgcn_s_waitcnt(0);
        unsigned nloc = b.st[0], nx = b.st[1];
        if (nloc == 0u) { xcd_barrier_complete(bar, b.x, nloc, nx); b.st[0] = nloc; b.st[1] = nx; }
        const unsigned old = xb_add(&bar[XB_XSUB(b.x)], 1u);
        const unsigned gen = old / nloc;
        if (old + 1u == (gen + 1u) * nloc) {
            __builtin_amdgcn_fence(__ATOMIC_RELEASE, "agent");
            asm volatile("s_waitcnt vmcnt(0)" ::: "memory");
            const unsigned og = xb_add(&bar[XB_TOP], 1u);
            const unsigned tg = og / nx;
            if (og + 1u == (tg + 1u) * nx) xb_add(&bar[XB_TOPGEN], 1u);
            else XB_SPIN(xb_ld(&bar[XB_TOPGEN]) == tg, bar);
            __builtin_amdgcn_fence(__ATOMIC_ACQUIRE, "agent");
            xb_add(&bar[XB_XGEN(b.x)], 1u);
            asm volatile("s_waitcnt vmcnt(0)" ::: "memory");
        } else {
            XB_SPIN(xb_ld(&bar[XB_XGEN(b.x)]) == gen, bar);
            __builtin_amdgcn_fence(__ATOMIC_ACQUIRE, "agent");
            asm volatile("s_waitcnt vmcnt(0)" ::: "memory");
        }
    }
    __syncthreads();
}

namespace pg8 {
constexpr int BM = 256, BK = 64, HALF = 128, HTB = HALF * BK * 2, STAGE_BYTES = 8 * HTB, NXCD = 8, WGM = 8;
__host__ __device__ __forceinline__ int lds_byte(int r, int c) { const int st = (r >> 4) * 2 + (c >> 5), rr = r & 15, cc = c & 31, ob = rr * 64 + cc * 2; return st * 1024 + (ob ^ (((ob >> 9) & 1) << 5)); }
__host__ __device__ __forceinline__ void stage_rc(int b, int& R, int& C) { const int st = b / 1024, sb = b % 1024, swz = sb ^ (((sb >> 9) & 1) << 5); R = (st >> 1) * 16 + swz / 64; C = (st & 1) * 32 + (swz % 64) / 2; }
__host__ __device__ __forceinline__ int perm32(int rho) { const int n = rho >> 4, i = rho & 15; return 8 * (i >> 2) + 4 * n + (i & 3); }

struct Unit { int pm, pn, aux; unsigned a, b; };
typedef int i32x4 __attribute__((ext_vector_type(4)));
__device__ __forceinline__ i32x8 frag8(bf16x8 lo, bf16x8 hi) { return __builtin_shufflevector(__builtin_bit_cast(i32x4, lo), __builtin_bit_cast(i32x4, hi), 0, 1, 2, 3, 4, 5, 6, 7); }

template <class Epi, class Sched, bool FP8 = false>
__device__ __forceinline__ void gemm_phase(LAS unsigned char* lds, const int K, const Sched& S, const Epi& E, const __amdgpu_buffer_rsrc_t rs) {
    const int tid = fresh_tid(), wid = __builtin_amdgcn_readfirstlane(tid >> 6), lane = tid & 63, wr = wid >> 2, wc = wid & 3, fr = lane & 15, fq = lane >> 4;
    const int nt = FP8 ? K / 128 : K / BK;
    int RA[2], CA[2];
    unsigned voffA[4], voffB[2];
#pragma unroll
    for (int i = 0; i < 2; ++i) { int R, C; stage_rc(tid * 16 + i * 8192, R, C); RA[i] = R; CA[i] = C; const int Rb = Epi::PERM ? ((R & ~31) + perm32(R & 31)) : R;
        voffB[i] = (unsigned)(Rb * S.pb + C * 2); }
    const unsigned kstep = (unsigned)(BK * 2);
    const unsigned hstepB = (unsigned)(HALF * S.pb), hstepA = (unsigned)(HALF * S.pa);
    const unsigned ldsw = (unsigned)wid * 1024u;
    const int aoff = lds_byte(wr * 64 + fr, fq * 8), boff = lds_byte(wc * 32 + fr, fq * 8);
    constexpr int kpiece = 1024;
#define PG8_SA(b, h) (((b) * 2 + (h)) * HTB)
#define PG8_SB(b, h) ((4 + (b) * 2 + (h)) * HTB)
#define PG8_STAGE_B(bufoff, gbase) do { _Pragma("unroll") for (int _i = 0; _i < 2; ++_i) \
        __builtin_amdgcn_raw_ptr_buffer_load_lds(rs, (LAS unsigned*)(lds + (bufoff) + ldsw + _i * 8192), 16, (int)voffB[_i], (int)(gbase), 0, 0); } while (0)
#define PG8_STAGE_A(bufoff, gbase, h) do { _Pragma("unroll") for (int _i = 0; _i < 2; ++_i) \
        __builtin_amdgcn_raw_ptr_buffer_load_lds(rs, (LAS unsigned*)(lds + (bufoff) + ldsw + _i * 8192), 16, (int)voffA[Sched::GATHER ? (h) * 2 + _i : _i], (int)((gbase) + (Sched::GATHER ? 0u : (unsigned)(h) * hstepA)), 0, 0); } while (0)
#define PG8_LDA(dst, b, h) do { _Pragma("unroll") for (int m = 0; m < 4; ++m) _Pragma("unroll") for (int k = 0; k < 2; ++k) dst[m][k] = *(const LAS bf16x8*)(lds + PG8_SA(b, h) + aoff + m * 2048 + k * kpiece); } while (0)
#define PG8_LDB(dst, b, h) do { _Pragma("unroll") for (int n = 0; n < 2; ++n) _Pragma("unroll") for (int k = 0; k < 2; ++k) dst[n][k] = *(const LAS bf16x8*)(lds + PG8_SB(b, h) + boff + n * 2048 + k * kpiece); } while (0)
#define PG8_MMA(ai, bj, At, Bt) do { __builtin_amdgcn_s_setprio(1); if constexpr (FP8) { _Pragma("unroll") for (int m = 0; m < 4; ++m) _Pragma("unroll") for (int n = 0; n < 2; ++n) \
        acc[ai][bj][m][n] = __builtin_amdgcn_mfma_scale_f32_16x16x128_f8f6f4(frag8(Bt[n][0], Bt[n][1]), frag8(At[m][0], At[m][1]), acc[ai][bj][m][n], 0, 0, 0, 0x7C7C7C7C, 0, 0x7C7C7C7C); } \
      else { _Pragma("unroll") for (int m = 0; m < 4; ++m) _Pragma("unroll") for (int n = 0; n < 2; ++n) _Pragma("unroll") for (int k = 0; k < 2; ++k) \
        acc[ai][bj][m][n] = __builtin_amdgcn_mfma_f32_16x16x32_bf16(Bt[n][k], At[m][k], acc[ai][bj][m][n], 0, 0, 0); } __builtin_amdgcn_s_setprio(0); } while (0)
#define PG8_MMA2(ai, At) do { if constexpr (Sched::BLOCKDIAG) { if (lo_half) PG8_MMA(ai, 0, At, B0); else PG8_MMA(ai, 1, At, B1); } else { PG8_MMA(ai, 0, At, B0); PG8_MMA(ai, 1, At, B1); } } while (0)
#define PG8_WAIT_V(n) asm volatile("s_waitcnt vmcnt(" #n ")" ::: "memory")
#define PG8_WAIT_L(n) asm volatile("s_waitcnt lgkmcnt(" #n ")" ::: "memory")
#define PG8_BAR __builtin_amdgcn_s_barrier()
#define PG8_SCHED __builtin_amdgcn_sched_barrier(0)
    Unit cur, nxt; int ui = 0;
    if (!S.next(0, cur)) return;
    S.offs(cur, RA, CA, voffA);
    f32x4 acc[2][2][4][2];
#pragma unroll
    for (int a = 0; a < 2; ++a)
#pragma unroll
        for (int b = 0; b < 2; ++b)
#pragma unroll
            for (int m = 0; m < 4; ++m)
#pragma unroll
                for (int n = 0; n < 2; ++n) acc[a][b][m][n] = (f32x4){0.f, 0.f, 0.f, 0.f};
    bf16x8 At[4][2], B0[2][2], B1[2][2];
    unsigned cA = cur.a, cB = cur.b;
    PG8_STAGE_B(PG8_SB(0, 0), cB); PG8_STAGE_B(PG8_SB(0, 1), cB + hstepB); PG8_STAGE_A(PG8_SA(0, 0), cA, 0); PG8_STAGE_A(PG8_SA(0, 1), cA, 1);
    if (wr == 1) PG8_BAR;
    PG8_WAIT_V(2); PG8_BAR;
    PG8_STAGE_B(PG8_SB(1, 0), cB + kstep); PG8_STAGE_A(PG8_SA(1, 0), cA + kstep, 0); PG8_STAGE_B(PG8_SB(1, 1), cB + hstepB + kstep);
    PG8_WAIT_V(6); PG8_BAR;
    for (;;) {
        const bool has_next = S.next(ui + 1, nxt);
        const unsigned nA = has_next ? nxt.a : cA, nB = has_next ? nxt.b : cB;
        unsigned nvoff[4];
        if constexpr (Sched::GATHER) { if (has_next) S.rows(nxt, RA, nvoff); }
#pragma nounroll
        for (int t = 0; t < nt; t += 2) {
            const bool last = (t == nt - 2), lo_half = t < (nt >> 1);
            const unsigned a1 = cA + (unsigned)(t + 1) * kstep;
            const unsigned a2 = last ? nA : cA + (unsigned)(t + 2) * kstep, b2 = last ? nB : cB + (unsigned)(t + 2) * kstep;
            const unsigned a3 = a2 + kstep, b3 = b2 + kstep;
            PG8_LDB(B0, 0, 0); PG8_LDB(B1, 0, 1); PG8_SCHED; PG8_LDA(At, 0, 0); PG8_STAGE_A(PG8_SA(1, 1), a1, 1);
            PG8_WAIT_V(8); PG8_WAIT_L(0); PG8_BAR; PG8_MMA2(0, At); PG8_BAR; PG8_SCHED;
            if constexpr (Sched::GATHER) { if (last && has_next) {
#pragma unroll
                for (int q = 0; q < 4; ++q) voffA[q] = nvoff[q] * (unsigned)S.pa + (unsigned)(CA[q & 1] * 2); } }
            PG8_LDA(At, 0, 1); PG8_STAGE_B(PG8_SB(0, 0), b2); PG8_STAGE_B(PG8_SB(0, 1), b2 + hstepB); PG8_STAGE_A(PG8_SA(0, 0), a2, 0);
            PG8_WAIT_V(8); PG8_WAIT_L(0); PG8_BAR; PG8_MMA2(1, At); PG8_BAR; PG8_SCHED;
            PG8_LDB(B0, 1, 0); PG8_LDB(B1, 1, 1); PG8_SCHED; PG8_LDA(At, 1, 0); PG8_STAGE_A(PG8_SA(0, 1), a2, 1);
            PG8_WAIT_V(8); PG8_WAIT_L(0); PG8_BAR; PG8_MMA2(0, At); PG8_BAR; PG8_SCHED;
            PG8_LDA(At, 1, 1); PG8_STAGE_B(PG8_SB(1, 0), b3); PG8_STAGE_B(PG8_SB(1, 1), b3 + hstepB); PG8_STAGE_A(PG8_SA(1, 0), a3, 0);
            PG8_WAIT_V(8); PG8_WAIT_L(0); PG8_BAR; PG8_MMA2(1, At); PG8_BAR; PG8_SCHED;
        }
        if (wr == 0) PG8_BAR;
        { const int t2 = fresh_tid() & 63; E(acc, cur, wr, wc, t2 & 15, t2 >> 4, lds + LDS_EPI); }
        if (!has_next) break;
#pragma unroll
        for (int a = 0; a < 2; ++a)
#pragma unroll
            for (int b = 0; b < 2; ++b)
#pragma unroll
                for (int m = 0; m < 4; ++m)
#pragma unroll
                    for (int n = 0; n < 2; ++n) acc[a][b][m][n] = (f32x4){0.f, 0.f, 0.f, 0.f};
        cur = nxt; cA = nA; cB = nB; ++ui;
        if (wr == 1) PG8_BAR;
    }
    PG8_WAIT_V(0);
    PG8_BAR;
#undef PG8_SA
#undef PG8_SB
#undef PG8_STAGE_A
#undef PG8_STAGE_B
#undef PG8_LDA
#undef PG8_LDB
#undef PG8_MMA
#undef PG8_MMA2
#undef PG8_WAIT_V
#undef PG8_WAIT_L
#undef PG8_BAR
#undef PG8_SCHED
}

struct DenseSched {
    static constexpr bool GATHER = false, BLOCKDIAG = false;
    int nM, nN, nwg, G, c; int pa, pb; unsigned A, B;
    __device__ void init(int M, int N, int G_, int c_, size_t A_, int pa_, size_t B_, int pb_) { nM = M / BM; nN = N / BM; nwg = nM * nN; G = G_; c = c_; A = (unsigned)A_; B = (unsigned)B_; pa = pa_; pb = pb_; }
    __device__ __forceinline__ bool next(int i, Unit& u) const {
        const long L = (long)i * G + c; if (L >= nwg) return false;
        int wgid = (int)L; { const int q = nwg / NXCD, r = nwg % NXCD, xcd = wgid % NXCD, off = wgid / NXCD; wgid = (xcd < r ? xcd * (q + 1) : r * (q + 1) + (xcd - r) * q) + off; }
        const int nig = WGM * nN, gid = wgid / nig, fm = gid * WGM, gsz = (nM - fm) < WGM ? (nM - fm) : WGM;
        u.pm = fm + ((wgid % nig) % gsz); u.pn = (wgid % nig) / gsz; u.aux = 0;
        u.a = A + (unsigned)(u.pm * BM * pa); u.b = B + (unsigned)(u.pn * BM * pb); return true;
    }
    __device__ __forceinline__ void offs(const Unit&, const int (&RA)[2], const int (&CA)[2], unsigned (&v)[4]) const {
#pragma unroll
        for (int h = 0; h < 2; ++h)
#pragma unroll
            for (int i = 0; i < 2; ++i) v[h * 2 + i] = (unsigned)((h * HALF + RA[i]) * pa + CA[i] * 2);
    }
};
struct DiagSched : DenseSched { static constexpr bool BLOCKDIAG = true; };
}

struct Params { const float* in[21]; float* out; unsigned char* ws; int ph_lo, ph_hi; };
enum { I_X = 0, I_C, I_POS, I_WADA, I_BADA, I_GMIX, I_GFFN, I_WIN, I_WBG, I_QG, I_KG, I_WBD, I_WBS, I_WOUT, I_WRG, I_BRG, I_WRE, I_BRE, I_WEG, I_WEU, I_WED };

struct Frame {
    LAS unsigned char* lds;
    unsigned char* ws;
    int wave, G, bid;
};

template <bool FP8>
DI void p0_transpose_item(const float* W, int N, void* WTv, int ldt, int k0, int n0, int row_base, LAS float* scr, int lane) {
#pragma unroll 8
    for (int i = 0; i < 32; ++i) { const int kk = 2 * i + (lane >> 5); scr[kk * 33 + (lane & 31)] = W[(size_t)(k0 + kk) * N + n0 + (lane & 31)]; }
    LDS_WAIT();
    const int c = lane & 7;
#pragma unroll
    for (int j = 0; j < 4; ++j) { const int n = (lane >> 3) + 8 * j; const LAS float* sp = scr + (8 * c) * 33 + n;
        if (FP8) { u32x2 o; o.x = pk4_fp8(64.f * sp[0 * 33], 64.f * sp[1 * 33], 64.f * sp[2 * 33], 64.f * sp[3 * 33]); o.y = pk4_fp8(64.f * sp[4 * 33], 64.f * sp[5 * 33], 64.f * sp[6 * 33], 64.f * sp[7 * 33]);
            *(u32x2*)((unsigned char*)WTv + (size_t)(row_base + n) * ldt + k0 + 8 * c) = o; }
        else { u32x4 o; o.x = pk2(sp[0 * 33], sp[1 * 33]); o.y = pk2(sp[2 * 33], sp[3 * 33]); o.z = pk2(sp[4 * 33], sp[5 * 33]); o.w = pk2(sp[6 * 33], sp[7 * 33]);
            *(u32x4*)((bf16_t*)WTv + (size_t)(row_base + n) * ldt + k0 + 8 * c) = o; } }
    LDS_WAIT();
}
DI void phase0(const Frame& F, const Params& p) {
    const int tid_ = fresh_tid(), lane_ = tid_ & 63;
    LAS float* scr = (LAS float*)(F.lds + F.wave * 16384);
    const int gw = F.bid * 8 + F.wave, NGW = F.G * 8;
    bf16_t* W1 = (bf16_t*)(F.ws + WS_W1); bf16_t* WB = (bf16_t*)(F.ws + WS_WB); bf16_t* WO = (bf16_t*)(F.ws + WS_WO);
    unsigned char* WG8 = F.ws + WS_WG8; unsigned char* WGU = F.ws + WS_WGU; unsigned char* WDN = F.ws + WS_WDN;
    constexpr int I1 = 16 * 96, I2 = 16 * 64, I3 = 4 * 32, I4 = 4 * 32, I5 = 16 * 32, I6 = 32 * 256, I7 = 32 * 256, I8 = 32 * 256;
    constexpr int NITEMS = I1 + I2 + I3 + I4 + I5 + I6 + I7 + I8;
    for (int it = gw; it < NITEMS; it += NGW) {
        int r = it;
        if (r < I1) { const int kb = r / 96, nb = r % 96, n0 = 32 * nb, o0 = n0 & 255, rb = (n0 & ~255) + 128 * ((o0 >> 5) & 1) + 32 * (o0 >> 6);
            if (nb < 72) p0_transpose_item<true>(p.in[I_WIN], 3072, F.ws + WS_W1D8, 1024, 64 * kb, n0, rb, scr, lane_); else p0_transpose_item<false>(p.in[I_WIN], 3072, W1, 1024, 64 * kb, n0, rb, scr, lane_); continue; } r -= I1;
        if (r < I2) { const int kb = r / 64, nb = r % 64; p0_transpose_item<true>(p.in[I_WBG], 2048, WG8, 1024, 64 * kb, 32 * nb, 32 * nb, scr, lane_); continue; } r -= I2;
        if (r < I3) { const int kb = r / 32, nb = r % 32, n0 = 32 * nb; p0_transpose_item<true>(p.in[I_WBD], 1024, (unsigned char*)WB, 512, 64 * kb, n0, (n0 >> 7) * 256 + (n0 & 127), scr, lane_); continue; } r -= I3;
        if (r < I4) { const int kb = r / 32, nb = r % 32, n0 = 32 * nb; p0_transpose_item<true>(p.in[I_WBS], 1024, (unsigned char*)WB + 256, 512, 64 * kb, n0, (n0 >> 7) * 256 + 128 + (n0 & 127), scr, lane_); continue; } r -= I4;
        if (r < I5) { const int kb = r / 32, nb = r % 32; p0_transpose_item<true>(p.in[I_WOUT], 1024, WO, 1024, 64 * kb, 32 * nb, 32 * nb, scr, lane_); continue; } r -= I5;
        if (r < I6) { const int e = r >> 8, q = r & 255, kb = q >> 4, nb = q & 15, n0 = 32 * nb;
            p0_transpose_item<true>(p.in[I_WEG] + (size_t)e * 1024 * 512, 512, WGU + (size_t)e * 1024 * 1024, 1024, 64 * kb, n0, (n0 >> 7) * 256 + (n0 & 127), scr, lane_); continue; } r -= I6;
        if (r < I7) { const int e = r >> 8, q = r & 255, kb = q >> 4, nb = q & 15, n0 = 32 * nb;
            p0_transpose_item<true>(p.in[I_WEU] + (size_t)e * 1024 * 512, 512, WGU + (size_t)e * 1024 * 1024, 1024, 64 * kb, n0, (n0 >> 7) * 256 + 128 + (n0 & 127), scr, lane_); continue; } r -= I7;
        { const int e = r >> 8, q = r & 255, kb = q >> 5, nb = q & 31, n0 = 32 * nb, o0 = n0 & 255;
            p0_transpose_item<true>(p.in[I_WED] + (size_t)e * 512 * 1024, 1024, WDN + (size_t)e * 1024 * 512, 512, 64 * kb, n0, (n0 & ~255) + 128 * ((o0 >> 5) & 1) + 32 * (o0 >> 6), scr, lane_); }
    }
    {
        unsigned char* WBz = F.ws + WS_WB;
        for (int idx = F.bid * 512 + tid_; idx < 2048 * 16; idx += F.G * 512) { const int row = idx >> 4, c = idx & 15; *(u32x4*)(WBz + (size_t)row * 512 + ((row & 128) ? 0 : 256) + c * 16) = (u32x4){0u, 0u, 0u, 0u}; }
    }
    {
        float* modp = (float*)(F.ws + WS_MODP); const float* c = p.in[I_C]; const float* wada = p.in[I_WADA];
        for (int task = gw; task < 96 * 8; task += NGW) {
            const int ct = task % 96, ks = task / 96, k0 = ks * 128;
#pragma unroll
            for (int i = 0; i < 16; ++i) { const int idx = i * 64 + lane_, b = idx >> 7, k = idx & 127; const float v = c[b * 1024 + k0 + k]; scr[idx] = v * sigmoidf(v); }
            LDS_WAIT();
            float acc[8];
#pragma unroll
            for (int b = 0; b < 8; ++b) acc[b] = 0.f;
            const float* wp = wada + (size_t)k0 * 6144 + ct * 64 + lane_;
#pragma unroll 8
            for (int k = 0; k < 128; ++k) { const float w = wp[(size_t)k * 6144];
#pragma unroll
                for (int b = 0; b < 8; ++b) acc[b] += scr[b * 128 + k] * w; }
#pragma unroll
            for (int b = 0; b < 8; ++b) modp[((size_t)ks * 8 + b) * 6144 + ct * 64 + lane_] = acc[b];
            LDS_WAIT();
        }
    }
}

DI float inv_freq_of(int i) {
    return i == 0 ? 1.0f : i == 1 ? 0.1939227432012558f : i == 2 ? 0.03760603070259094f : i == 3 ? 0.007292664609849453f : i == 4 ? 0.0014142135623842478f : i == 5 ? 0.00027424818836152554f : i == 6 ? 5.318296098266728e-05f : 1.0313386155758053e-05f;
}
template <int WHICH>
DI void phase_norm(const Frame& F, const Params& p) {
    const int tid_ = fresh_tid(), lane_ = tid_ & 63;
    LAS float* gs = (LAS float*)(F.lds); LAS float* sh = gs + 1024;
    const float* modp = (const float*)(F.ws + WS_MODP); float* mod = (float*)(F.ws + WS_MOD); const float* bada = p.in[I_BADA];
    const float* xin = p.in[I_X]; const bf16_t* upd = (const bf16_t*)(F.ws + WS_UPD1); bf16_t* hout = (bf16_t*)(F.ws + (WHICH == 0 ? WS_H : WS_H2)); unsigned* h8 = (unsigned*)(F.ws + (WHICH == 0 ? WS_H8 : WS_H28));
    const float* gn = p.in[WHICH == 0 ? I_GMIX : I_GFFN];
    for (int chunk = F.bid; chunk < T / 256; chunk += F.G) {
        const int b = chunk >> 5;
        __syncthreads();
        if (WHICH == 0) {
            if (tid_ < 192) { const int j = (chunk & 31) * 192 + tid_; float s = bada[j];
#pragma unroll
                for (int ks = 0; ks < 8; ++ks) s += modp[((size_t)ks * 8 + b) * 6144 + j];
                mod[b * 6144 + j] = s; }
            for (int col = tid_; col < 1024; col += 512) { float s1 = bada[col], s2 = bada[1024 + col];
#pragma unroll
                for (int ks = 0; ks < 8; ++ks) { s1 += modp[((size_t)ks * 8 + b) * 6144 + col]; s2 += modp[((size_t)ks * 8 + b) * 6144 + 1024 + col]; }
                gs[col] = gn[col] * (1.f + s2); sh[col] = s1; }
        } else {
            for (int col = tid_; col < 1024; col += 512) { gs[col] = gn[col] * (1.f + mod[b * 6144 + 4096 + col]); sh[col] = mod[b * 6144 + 3072 + col]; }
        }
        __syncthreads();
        f32x4 g4[4], s4[4];
#pragma unroll
        for (int j = 0; j < 4; ++j) { g4[j] = *(const LAS f32x4*)(gs + 256 * j + 4 * lane_); s4[j] = *(const LAS f32x4*)(sh + 256 * j + 4 * lane_); }
        for (int rr = F.wave; rr < 256; rr += 8) {
            const int row = chunk * 256 + rr;
            const f32x4* xr = (const f32x4*)(xin + (size_t)row * 1024) + lane_;
            f32x4 v[4]; float ss = 0.f;
#pragma unroll
            for (int j = 0; j < 4; ++j) v[j] = xr[64 * j];
            if (WHICH == 1) { const u32x2* ur = (const u32x2*)(upd + (size_t)row * 1024) + lane_; u32x2 uu[4];
#pragma unroll
                for (int j = 0; j < 4; ++j) uu[j] = ur[64 * j];
#pragma unroll
                for (int j = 0; j < 4; ++j) { v[j].x += bf_lo(uu[j].x); v[j].y += bf_hi(uu[j].x); v[j].z += bf_lo(uu[j].y); v[j].w += bf_hi(uu[j].y); } }
#pragma unroll
            for (int j = 0; j < 4; ++j) ss += (v[j].x * v[j].x + v[j].y * v[j].y) + (v[j].z * v[j].z + v[j].w * v[j].w);
            const float rinv = __builtin_amdgcn_rsqf(wave_sum(ss) * (1.f / 1024.f) + RMS_EPS);
            u32x2* o8 = (u32x2*)(hout + (size_t)row * 1024) + lane_;
#pragma unroll
            for (int j = 0; j < 4; ++j) { const f32x4 y = v[j] * rinv * g4[j] + s4[j]; u32x2 o; o.x = pk2(y.x, y.y); o.y = pk2(y.z, y.w); o8[64 * j] = o; h8[(size_t)row * 256 + 64 * j + lane_] = pk4_fp8(y.x, y.y, y.z, y.w); }
            if (WHICH == 0 && lane_ < 8) {
                const int pos = ((const int*)p.in[I_POS])[row];
                const float angf = (float)pos * inv_freq_of(lane_);
                double rv = (double)angf * 0.15915494309189535; rv -= __builtin_rint(rv);
                const float fr = (float)rv;
                bf16_t* rp = (bf16_t*)(F.ws + WS_ROPE) + (size_t)row * 16;
                rp[lane_] = (bf16_t)(pk2(__builtin_amdgcn_cosf(fr), 0.f) & 0xffffu); rp[8 + lane_] = (bf16_t)(pk2(__builtin_amdgcn_sinf(fr), 0.f) & 0xffffu);
            }
        }
    }
}

template <bool GATES> struct EpiProj {
    static constexpr bool PERM = true;
    bf16_t* proj; bf16_t* gates; const bf16_t* rope; const float* qg; const float* kg; int pn0;
    DI void operator()(const f32x4 (&acc)[2][2][4][2], const pg8::Unit& u, int wr, int wc, int fr, int fq, LAS unsigned char* scr) const {
        asm volatile("" : "+v"(fr), "+v"(fq));
        const int pn = u.pn + pn0, row0 = u.pm * 256 + wr * 64 + fr, cw = wc * 32 + 8 * fq;
        const int typ = pn < 9 ? pn / 3 : pn - 9, grp = pn < 9 ? pn % 3 : 0, l2d = pn < 9 ? 2 * grp : 0, hbase = pn < 9 ? grp * 4 : 12;
        if (GATES) {
            unsigned char* base = (unsigned char*)gates + (size_t)(u.pm * 8 + pn) * 65536 + (size_t)(((wr * 4 + wc) * 64 + fq * 16 + fr) * 8);
#pragma unroll
            for (int ai = 0; ai < 2; ++ai)
#pragma unroll
                for (int m = 0; m < 4; ++m)
#pragma unroll
                    for (int bj = 0; bj < 2; ++bj) { const f32x4 v0 = acc[ai][bj][m][0], v1 = acc[ai][bj][m][1];
                        u32x2 w; w.x = pk4_fp8(v0.x, v0.y, v0.z, v0.w); w.y = pk4_fp8(v1.x, v1.y, v1.z, v1.w);
                        *(u32x2*)(base + ((ai * 4 + m) * 2 + bj) * 4096) = w; }
        } else if (pn >= 6 || pn < 3) {
            const float sc = pn == 9 ? QSCALE : 1.f;
            const int head = hbase + wc;
#pragma unroll
            for (int ai = 0; ai < 2; ++ai)
#pragma unroll
                for (int m = 0; m < 4; ++m) { const int t = row0 + ai * 128 + m * 16, sq = t & (S - 1); const int rp = (t & ~(S - 1)) + ((sq & ((1 << l2d) - 1)) << (13 - l2d)) + (sq >> l2d);
                    bf16_t* rowp = proj + ((size_t)(typ * 16 + head) * T + rp) * 64 + 8 * fq;
#pragma unroll
                    for (int bj = 0; bj < 2; ++bj) { const f32x4 v0 = acc[ai][bj][m][0] * sc, v1 = acc[ai][bj][m][1] * sc;
                        u32x4 w; w.x = pk2(v0.x, v0.y); w.y = pk2(v0.z, v0.w); w.z = pk2(v1.x, v1.y); w.w = pk2(v1.z, v1.w);
                        *(u32x4*)(rowp + 32 * bj) = w; } }
        } else {
            const int head = hbase + wc;
            const f32x4 g0 = *(const f32x4*)(kg + 8 * fq), g1 = *(const f32x4*)(kg + 8 * fq + 4), g2 = *(const f32x4*)(kg + 32 + 8 * fq), g3 = *(const f32x4*)(kg + 32 + 8 * fq + 4);
            u32x4 rcsa[2][4];
#pragma unroll
            for (int ai = 0; ai < 2; ++ai)
#pragma unroll
                for (int m = 0; m < 4; ++m) { const u32x4* rpt = (const u32x4*)(rope + (size_t)(u.pm * 256 + ai * 128 + wr * 64 + m * 16 + fr) * 16); rcsa[ai][m] = rpt[fq & 1]; }
            __builtin_amdgcn_sched_barrier(0);
#pragma unroll
            for (int ai = 0; ai < 2; ++ai) {
#pragma unroll
                for (int m = 0; m < 4; ++m) { const int row = u.pm * 256 + ai * 128 + wr * 64 + m * 16 + fr, sq = row & (S - 1);
                    const int rp = (row & ~(S - 1)) + ((sq & ((1 << l2d) - 1)) << (13 - l2d)) + (sq >> l2d);
                    const f32x4 a0 = acc[ai][0][m][0], a1 = acc[ai][0][m][1], b0 = acc[ai][1][m][0], b1 = acc[ai][1][m][1];
                    float ss = ((a0.x * a0.x + a0.y * a0.y) + (a0.z * a0.z + a0.w * a0.w)) + ((a1.x * a1.x + a1.y * a1.y) + (a1.z * a1.z + a1.w * a1.w))
                             + ((b0.x * b0.x + b0.y * b0.y) + (b0.z * b0.z + b0.w * b0.w)) + ((b1.x * b1.x + b1.y * b1.y) + (b1.z * b1.z + b1.w * b1.w));
                    { const unsigned sb_ = __builtin_bit_cast(unsigned, ss); auto r = __builtin_amdgcn_permlane16_swap(sb_, sb_, false, false); const unsigned r0 = r[0], r1 = r[1]; ss = __builtin_bit_cast(float, r0) + __builtin_bit_cast(float, r1); }
                    { const unsigned sb_ = __builtin_bit_cast(unsigned, ss); auto r = __builtin_amdgcn_permlane32_swap(sb_, sb_, false, false); const unsigned r0 = r[0], r1 = r[1]; ss = __builtin_bit_cast(float, r0) + __builtin_bit_cast(float, r1); }
                    const float rinv = __builtin_amdgcn_rsqf(ss * (1.f / 64.f) + RMS_EPS);
                    f32x4 v0 = a0 * (g0 * rinv), v1 = a1 * (g1 * rinv); const f32x4 v2 = b0 * (g2 * rinv), v3 = b1 * (g3 * rinv);
                    f32x4 c0 = {1.f, 1.f, 1.f, 1.f}, c1 = c0, s0 = {0.f, 0.f, 0.f, 0.f}, s1 = s0;
                    u32x4 cc, sn;
                    { const u32x4 x = rcsa[ai][m]; u32x4 pp;
#define RX16(v) ([&] { const unsigned b_ = (v); auto r = __builtin_amdgcn_permlane16_swap(b_, b_, false, false); const unsigned r0 = r[0], r1 = r[1]; return (fq & 1) ? r0 : r1; }())
                      pp.x = RX16(x.x); pp.y = RX16(x.y); pp.z = RX16(x.z); pp.w = RX16(x.w);
#undef RX16
                      cc = (fq & 1) ? pp : x; sn = (fq & 1) ? x : pp; }
                    if (fq < 2) {
                        c0 = (f32x4){bf_lo(cc.x), bf_hi(cc.x), bf_lo(cc.y), bf_hi(cc.y)}; c1 = (f32x4){bf_lo(cc.z), bf_hi(cc.z), bf_lo(cc.w), bf_hi(cc.w)};
                        s0 = (f32x4){bf_lo(sn.x), bf_hi(sn.x), bf_lo(sn.y), bf_hi(sn.y)}; s1 = (f32x4){bf_lo(sn.z), bf_hi(sn.z), bf_lo(sn.w), bf_hi(sn.w)};
                        if (fq == 0) { s0 = -s0; s1 = -s1; } }
                    f32x4 p0, p1;
#define KX16(x) ([&] { const unsigned b_ = __builtin_bit_cast(unsigned, (float)(x)); auto r = __builtin_amdgcn_permlane16_swap(b_, b_, false, false); const unsigned r0 = r[0], r1 = r[1]; return __builtin_bit_cast(float, (fq & 1) ? r0 : r1); }())
                    p0.x = KX16(v0.x); p0.y = KX16(v0.y); p0.z = KX16(v0.z); p0.w = KX16(v0.w);
                    p1.x = KX16(v1.x); p1.y = KX16(v1.y); p1.z = KX16(v1.z); p1.w = KX16(v1.w);
#undef KX16
                    v0 = v0 * c0 + p0 * s0; v1 = v1 * c1 + p1 * s1;
                    bf16_t* rowp = proj + ((size_t)(typ * 16 + head) * T + rp) * 64 + 8 * fq;
                    u32x4 w; w.x = pk2(v0.x, v0.y); w.y = pk2(v0.z, v0.w); w.z = pk2(v1.x, v1.y); w.w = pk2(v1.z, v1.w);
                    *(u32x4*)rowp = w;
                    w.x = pk2(v2.x, v2.y); w.y = pk2(v2.z, v2.w); w.z = pk2(v3.x, v3.y); w.w = pk2(v3.z, v3.w);
                    *(u32x4*)(rowp + 32) = w; }
            }
        }
    }
};

struct EpiBranch {
    static constexpr bool PERM = true;
    const unsigned char* gates; unsigned char* merged;
    DI void operator()(const f32x4 (&acc)[2][2][4][2], const pg8::Unit& u, int wr, int wc, int fr, int fq, LAS unsigned char*) const {
        asm volatile("" : "+v"(fr), "+v"(fq));
        const int row0 = u.pm * 256 + wr * 64 + fr, col0 = u.pn * 128 + wc * 32 + 8 * fq;
        const unsigned char* gbase = gates + (size_t)(u.pm * 8 + (u.pn >> 1)) * 65536 + (size_t)((u.pn & 1) * 4096) + (size_t)(((wr * 4 + wc) * 64 + fq * 16 + fr) * 8);
        u32x2 gd[2][4], gs[2][4];
#pragma unroll
        for (int ai = 0; ai < 2; ++ai)
#pragma unroll
            for (int m = 0; m < 4; ++m) { const unsigned char* gp = gbase + ((ai * 4 + m) * 2) * 4096;
                gd[ai][m] = *(const u32x2*)gp; gs[ai][m] = *(const u32x2*)(gp + 4 * 65536); }
        __builtin_amdgcn_sched_barrier(0);
#pragma unroll
        for (int ai = 0; ai < 2; ++ai)
#pragma unroll
            for (int m = 0; m < 4; ++m) { const size_t row = (size_t)(row0 + ai * 128 + m * 16);
                const u32x2 g = gd[ai][m], q = gs[ai][m];
                const f32x2 ga = fp8_lo2(g.x), gb = fp8_hi2(g.x), gc = fp8_lo2(g.y), gdd = fp8_hi2(g.y), qa = fp8_lo2(q.x), qb = fp8_hi2(q.x), qc = fp8_lo2(q.y), qd = fp8_hi2(q.y);
                const f32x4 v0 = acc[ai][0][m][0] * (f32x4){sigmoidf(ga.x), sigmoidf(ga.y), sigmoidf(gb.x), sigmoidf(gb.y)} + acc[ai][1][m][0] * (f32x4){sigmoidf(qa.x), sigmoidf(qa.y), sigmoidf(qb.x), sigmoidf(qb.y)};
                const f32x4 v1 = acc[ai][0][m][1] * (f32x4){sigmoidf(gc.x), sigmoidf(gc.y), sigmoidf(gdd.x), sigmoidf(gdd.y)} + acc[ai][1][m][1] * (f32x4){sigmoidf(qc.x), sigmoidf(qc.y), sigmoidf(qd.x), sigmoidf(qd.y)};
                u32x2 w; w.x = pk4_fp8(8.f * v0.x, 8.f * v0.y, 8.f * v0.z, 8.f * v0.w); w.y = pk4_fp8(8.f * v1.x, 8.f * v1.y, 8.f * v1.z, 8.f * v1.w);
                *(u32x2*)(merged + row * 1024 + col0) = w; }
    }
};
struct BranchSched {
    static constexpr bool GATHER = false;
    int G, c; int pa, pb; unsigned A, B;
    DI bool next(int i, pg8::Unit& u) const {
        const int tile = (i >> 1) * G + c; if (tile >= 256 * 4) return false;
        u.pm = tile >> 2; u.pn = tile & 3; u.aux = i & 1;
        u.a = A + (unsigned)(u.pm * 256 * LDO * 2 + u.aux * 256 * 2); u.b = B + (unsigned)(u.aux * 1024 * 256 * 2 + u.pn * 256 * 256 * 2); return true;
    }
    DI void offs(const pg8::Unit&, const int (&RA)[2], const int (&CA)[2], unsigned (&v)[4]) const {
#pragma unroll
        for (int h = 0; h < 2; ++h)
#pragma unroll
            for (int i = 0; i < 2; ++i) v[h * 2 + i] = (unsigned)((h * 128 + RA[i]) * pa + CA[i] * 2);
    }
};

struct EpiOut {
    static constexpr bool PERM = true;
    bf16_t* upd; const float* mod;
    DI void operator()(const f32x4 (&acc)[2][2][4][2], const pg8::Unit& u, int wr, int wc, int fr, int fq, LAS unsigned char*) const {
        asm volatile("" : "+v"(fr), "+v"(fq));
        const int row0 = u.pm * 256 + wr * 64 + fr, col0 = u.pn * 256 + wc * 32 + 8 * fq; const int b = (u.pm * 256) >> 13;
        f32x4 gv[2][2];
#pragma unroll
        for (int bj = 0; bj < 2; ++bj)
#pragma unroll
            for (int n = 0; n < 2; ++n) gv[bj][n] = *(const f32x4*)(mod + b * 6144 + 2048 + col0 + bj * 128 + n * 4) * 0.125f;
#pragma unroll
        for (int ai = 0; ai < 2; ++ai)
#pragma unroll
            for (int m = 0; m < 4; ++m)
#pragma unroll
                for (int bj = 0; bj < 2; ++bj) { const f32x4 v0 = acc[ai][bj][m][0] * gv[bj][0], v1 = acc[ai][bj][m][1] * gv[bj][1];
                    u32x4 w; w.x = pk2(v0.x, v0.y); w.y = pk2(v0.z, v0.w); w.z = pk2(v1.x, v1.y); w.w = pk2(v1.z, v1.w);
                    *(u32x4*)(upd + (size_t)(row0 + ai * 128 + m * 16) * 1024 + col0 + bj * 128) = w; }
    }
};

struct EpiLogit {
    static constexpr bool PERM = false;
    float* logit;
    DI void operator()(const f32x4 (&acc)[2][2][4][2], const pg8::Unit& u, int wr, int wc, int fr, int fq, LAS unsigned char*) const {
        asm volatile("" : "+v"(fr), "+v"(fq));
        const int row0 = u.pm * 256 + wr * 64 + fr, col0 = wc * 32 + 4 * fq;
#pragma unroll
        for (int ai = 0; ai < 2; ++ai)
#pragma unroll
            for (int m = 0; m < 4; ++m)
#pragma unroll
                for (int n = 0; n < 2; ++n) *(f32x4*)(logit + (size_t)(row0 + ai * 128 + m * 16) * 128 + col0 + n * 16) = acc[ai][0][m][n];
    }
};

struct MoeSched {
    static constexpr bool GATHER_ = true;
    int G, c, nc; int pa, pb; unsigned A, B; const LAS int* cstart; const int* slot_tok; unsigned estride, pnstride;
};
struct MoeSchedUp : MoeSched {
    static constexpr bool GATHER = true, BLOCKDIAG = false;
    DI bool next(int i, pg8::Unit& u) const {
        const int L = i * G + c; if (L >= nc * 4) return false;
        const int chunk = L >> 2; int e = 0;
        for (int q = 1; q < 32; ++q) e += (chunk >= cstart[q]) ? 1 : 0;
        e = __builtin_amdgcn_readfirstlane(e);
        u.pm = chunk; u.pn = L & 3; u.aux = e; u.a = A; u.b = B + (unsigned)e * estride + (unsigned)u.pn * pnstride; return true;
    }
    DI void offs(const pg8::Unit& u, const int (&RA)[2], const int (&CA)[2], unsigned (&v)[4]) const {
#pragma unroll
        for (int h = 0; h < 2; ++h)
#pragma unroll
            for (int i = 0; i < 2; ++i) { const int tok = slot_tok[u.pm * 256 + h * 128 + RA[i]]; v[h * 2 + i] = (unsigned)(tok * pa + CA[i] * 2); }
    }
    DI void rows(const pg8::Unit& u, const int (&RA)[2], unsigned (&v)[4]) const {
#pragma unroll
        for (int h = 0; h < 2; ++h)
#pragma unroll
            for (int i = 0; i < 2; ++i) v[h * 2 + i] = (unsigned)slot_tok[u.pm * 256 + h * 128 + RA[i]];
    }
};
struct MoeSchedDn : MoeSched {
    static constexpr bool GATHER = false, BLOCKDIAG = false;
    DI bool next(int i, pg8::Unit& u) const {
        const int L = i * G + c; if (L >= nc * 4) return false;
        const int chunk = L >> 2; int e = 0;
        for (int q = 1; q < 32; ++q) e += (chunk >= cstart[q]) ? 1 : 0;
        e = __builtin_amdgcn_readfirstlane(e);
        u.pm = chunk; u.pn = L & 3; u.aux = e; u.a = A + (unsigned)(chunk * 256 * pa); u.b = B + (unsigned)e * estride + (unsigned)u.pn * pnstride; return true;
    }
    DI void offs(const pg8::Unit&, const int (&RA)[2], const int (&CA)[2], unsigned (&v)[4]) const {
#pragma unroll
        for (int h = 0; h < 2; ++h)
#pragma unroll
            for (int i = 0; i < 2; ++i) v[h * 2 + i] = (unsigned)((h * 128 + RA[i]) * pa + CA[i] * 2);
    }
};
struct EpiSwiglu {
    static constexpr bool PERM = true;
    unsigned char* hmid;
    DI void operator()(const f32x4 (&acc)[2][2][4][2], const pg8::Unit& u, int wr, int wc, int fr, int fq, LAS unsigned char*) const {
        asm volatile("" : "+v"(fr), "+v"(fq));
        const int row0 = u.pm * 256 + wr * 64 + fr, col0 = u.pn * 128 + wc * 32 + 8 * fq;
#pragma unroll
        for (int ai = 0; ai < 2; ++ai)
#pragma unroll
            for (int m = 0; m < 4; ++m) {
                f32x4 h[2];
#pragma unroll
                for (int n = 0; n < 2; ++n) { const f32x4 g = acc[ai][0][m][n], up = acc[ai][1][m][n];
                    h[n] = (f32x4){g.x * sigmoidf(g.x) * up.x, g.y * sigmoidf(g.y) * up.y, g.z * sigmoidf(g.z) * up.z, g.w * sigmoidf(g.w) * up.w}; }
                u32x2 w; w.x = pk4_fp8(h[0].x, h[0].y, h[0].z, h[0].w); w.y = pk4_fp8(h[1].x, h[1].y, h[1].z, h[1].w);
                *(u32x2*)(hmid + (size_t)(row0 + ai * 128 + m * 16) * DE + col0) = w; }
    }
};
struct EpiDown {
    static constexpr bool PERM = true;
    unsigned char* y;
    DI void operator()(const f32x4 (&acc)[2][2][4][2], const pg8::Unit& u, int wr, int wc, int fr, int fq, LAS unsigned char*) const {
        asm volatile("" : "+v"(fr), "+v"(fq));
        const int row0 = u.pm * 256 + wr * 64 + fr, col0 = u.pn * 256 + wc * 64 + (fq & 1) * 32 + (fq >> 1) * 16;
#pragma unroll
        for (int ai = 0; ai < 2; ++ai)
#pragma unroll
            for (int m = 0; m < 4; ++m) { const int slot = row0 + ai * 128 + m * 16;
                u32x2 o[2];
#pragma unroll
                for (int bj = 0; bj < 2; ++bj) { const f32x4 v0 = acc[ai][bj][m][0] * 8.f, v1 = acc[ai][bj][m][1] * 8.f; o[bj].x = pk4_fp8(v0.x, v0.y, v0.z, v0.w); o[bj].y = pk4_fp8(v1.x, v1.y, v1.z, v1.w); }
                u32x4 w;
                { auto r = __builtin_amdgcn_permlane16_swap(o[0].x, o[1].x, false, false); w.x = r[0]; w.z = r[1]; }
                { auto r = __builtin_amdgcn_permlane16_swap(o[0].y, o[1].y, false, false); w.y = r[0]; w.w = r[1]; }
                *(u32x4*)(y + (size_t)slot * 1024 + col0) = w; }
    }
};

constexpr int SLOT_BYTES = 8192;
DI f32x16 mfma32(bf16x8 a, bf16x8 b, f32x16 c) { return __builtin_amdgcn_mfma_f32_32x32x16_bf16(a, b, c, 0, 0, 0); }
DI int swz_f(int r) { return (((r >> 1) & 1) << 2) | ((r >> 2) & 3); }
struct AttnLane { unsigned doff[4]; unsigned ka[4]; unsigned va[2][2]; };
DI void attn_lane_init(AttnLane& L, int lane) {
#pragma unroll
    for (int i = 0; i < 4; ++i) { const int r = 8 * i + (lane >> 3), c = (lane & 7) ^ swz_f(r); L.doff[i] = (unsigned)(r * 128 + c * 16); }
    { const int r = lane & 31, h = lane >> 5; const unsigned a0 = (unsigned)(r * 128 + 16 * ((h ^ swz_f(r)) & 7));
#pragma unroll
      for (int s = 0; s < 4; ++s) L.ka[s] = a0 ^ (unsigned)(32 * s); }
    { const int h = lane >> 5, blk = (lane >> 4) & 1, q = (lane & 15) >> 2, p = lane & 3, fb2 = (q >> 1) & 1;
#pragma unroll
      for (int t = 0; t < 2; ++t) { const int flow = (2 * t + h) & 3;
#pragma unroll
        for (int mt = 0; mt < 2; ++mt) L.va[t][mt] = (unsigned)(4096 + (8 * t + 4 * h + q) * 128 + 16 * (4 * (mt ^ fb2) + ((2 * blk + (p >> 1)) ^ flow)) + 8 * (p & 1)); } }
}
DI void dma_tile(const AttnLane& L, const __amdgpu_buffer_rsrc_t rs, unsigned koff, unsigned voff, LAS unsigned char* slot) {
#pragma unroll
    for (int i = 0; i < 4; ++i) __builtin_amdgcn_raw_ptr_buffer_load_lds(rs, (LAS unsigned*)(slot + 1024 * i), 16, (int)L.doff[i], (int)koff, 0, 0);
#pragma unroll
    for (int i = 0; i < 4; ++i) __builtin_amdgcn_raw_ptr_buffer_load_lds(rs, (LAS unsigned*)(slot + 4096 + 1024 * i), 16, (int)L.doff[i], (int)voff, 0, 0);
}
DI void dma_q(const AttnLane& L, const __amdgpu_buffer_rsrc_t rs, unsigned qoff, LAS unsigned char* slot) {
#pragma unroll
    for (int i = 0; i < 4; ++i) __builtin_amdgcn_raw_ptr_buffer_load_lds(rs, (LAS unsigned*)(slot + 1024 * i), 16, (int)L.doff[i], (int)qoff, 0, 0);
}
DI void tr_read8(const AttnLane& L, unsigned sb, bf16x8 (&vf)[2][2]) {
    s16x4 r0, r1, r2, r3, r4, r5, r6, r7;
    const unsigned a00 = sb + L.va[0][0], a10 = sb + L.va[1][0], a01 = sb + L.va[0][1], a11 = sb + L.va[1][1];
    asm volatile("ds_read_b64_tr_b16 %0, %8\n\tds_read_b64_tr_b16 %1, %9\n\tds_read_b64_tr_b16 %2, %8 offset:2048\n\tds_read_b64_tr_b16 %3, %9 offset:2048\n\t"
                 "ds_read_b64_tr_b16 %4, %10\n\tds_read_b64_tr_b16 %5, %11\n\tds_read_b64_tr_b16 %6, %10 offset:2048\n\tds_read_b64_tr_b16 %7, %11 offset:2048\n\ts_waitcnt lgkmcnt(0)"
                 : "=&v"(r0), "=&v"(r1), "=&v"(r2), "=&v"(r3), "=&v"(r4), "=&v"(r5), "=&v"(r6), "=&v"(r7)
                 : "v"(a00), "v"(a10), "v"(a01), "v"(a11) : "memory");
    vf[0][0] = __builtin_shufflevector(r0, r1, 0, 1, 2, 3, 4, 5, 6, 7); vf[0][1] = __builtin_shufflevector(r2, r3, 0, 1, 2, 3, 4, 5, 6, 7);
    vf[1][0] = __builtin_shufflevector(r4, r5, 0, 1, 2, 3, 4, 5, 6, 7); vf[1][1] = __builtin_shufflevector(r6, r7, 0, 1, 2, 3, 4, 5, 6, 7);
}
DI bf16x8 pack8(const f32x16& x, int s) {
    u32x4 p; p.x = pk2(x[8 * s], x[8 * s + 1]); p.y = pk2(x[8 * s + 2], x[8 * s + 3]); p.z = pk2(x[8 * s + 4], x[8 * s + 5]); p.w = pk2(x[8 * s + 6], x[8 * s + 7]);
    return __builtin_bit_cast(bf16x8, p);
}
DI void store_o_row(bf16_t* rowp, const f32x16& O0, const f32x16& O1, float sc, int h) {
#pragma unroll
    for (int mt = 0; mt < 2; ++mt)
#pragma unroll
        for (int kp = 0; kp < 2; ++kp) { const f32x16& O = mt ? O1 : O0; const int g0 = 8 * kp, g1 = 8 * kp + 4;
            u32x2 a, b; a.x = pk2(O[g0] * sc, O[g0 + 1] * sc); a.y = pk2(O[g0 + 2] * sc, O[g0 + 3] * sc); b.x = pk2(O[g1] * sc, O[g1 + 1] * sc); b.y = pk2(O[g1 + 2] * sc, O[g1 + 3] * sc);
            { auto r = __builtin_amdgcn_permlane32_swap(a.x, b.x, false, false); a.x = r[0]; b.x = r[1]; }
            { auto r = __builtin_amdgcn_permlane32_swap(a.y, b.y, false, false); a.y = r[0]; b.y = r[1]; }
            *(u32x4*)(rowp + 32 * mt + 16 * kp + 8 * h) = (u32x4){a.x, a.y, b.x, b.y}; }
}
DI void store_o_row_fp8(unsigned char* rowp, const f32x16& O0, const f32x16& O1, int h) {
#pragma unroll
    for (int mt = 0; mt < 2; ++mt)
#pragma unroll
        for (int kp = 0; kp < 2; ++kp) { const f32x16& O = mt ? O1 : O0; const int g0 = 8 * kp, g1 = 8 * kp + 4;
            unsigned a = pk4_fp8(O[g0], O[g0 + 1], O[g0 + 2], O[g0 + 3]), b = pk4_fp8(O[g1], O[g1 + 1], O[g1 + 2], O[g1 + 3]);
            { auto r = __builtin_amdgcn_permlane32_swap(a, b, false, false); a = r[0]; b = r[1]; }
            *(u32x2*)(rowp + 32 * mt + 16 * kp + 8 * h) = (u32x2){a, b}; }
}
#define ATTN_WAIT_TILE(more) do { if (more) asm volatile("s_waitcnt vmcnt(8)" ::: "memory"); else asm volatile("s_waitcnt vmcnt(0)" ::: "memory"); } while (0)
DI void q_prep(bf16x8 (&qf)[4], const AttnLane& L, LAS unsigned char* qimg, const u32x4 cc, const u32x4 sn, const float* qg, int h) {
    u32x4 qr[4];
#pragma unroll
    for (int s = 0; s < 4; ++s) qr[s] = *(const LAS u32x4*)(qimg + L.ka[s]);
    float qv[4][8]; float ss = 0.f;
#pragma unroll
    for (int s = 0; s < 4; ++s) { const u32x4 u = qr[s]; qv[s][0] = bf_lo(u.x); qv[s][1] = bf_hi(u.x); qv[s][2] = bf_lo(u.y); qv[s][3] = bf_hi(u.y); qv[s][4] = bf_lo(u.z); qv[s][5] = bf_hi(u.z); qv[s][6] = bf_lo(u.w); qv[s][7] = bf_hi(u.w);
#pragma unroll
        for (int e = 0; e < 8; ++e) ss += qv[s][e] * qv[s][e]; }
    ss = xsum32(ss);
    const float rinv = __builtin_amdgcn_rsqf(ss * (1.f / 64.f) + RMS_EPS) * QSCALE;
#pragma unroll
    for (int s = 0; s < 4; ++s) { const f32x4 ga = *(const f32x4*)(qg + 16 * s + 8 * h), gb = *(const f32x4*)(qg + 16 * s + 8 * h + 4);
        qv[s][0] *= rinv * ga.x; qv[s][1] *= rinv * ga.y; qv[s][2] *= rinv * ga.z; qv[s][3] *= rinv * ga.w; qv[s][4] *= rinv * gb.x; qv[s][5] *= rinv * gb.y; qv[s][6] *= rinv * gb.z; qv[s][7] *= rinv * gb.w; }
    { const float cs[8] = {bf_lo(cc.x), bf_hi(cc.x), bf_lo(cc.y), bf_hi(cc.y), bf_lo(cc.z), bf_hi(cc.z), bf_lo(cc.w), bf_hi(cc.w)};
      const float sv[8] = {bf_lo(sn.x), bf_hi(sn.x), bf_lo(sn.y), bf_hi(sn.y), bf_lo(sn.z), bf_hi(sn.z), bf_lo(sn.w), bf_hi(sn.w)};
#pragma unroll
      for (int e = 0; e < 8; ++e) { const float other = xget32(qv[0][e], h); qv[0][e] = qv[0][e] * cs[e] + other * (h ? sv[e] : -sv[e]); } }
#pragma unroll
    for (int s = 0; s < 4; ++s) { u32x4 o; o.x = pk2(qv[s][0], qv[s][1]); o.y = pk2(qv[s][2], qv[s][3]); o.z = pk2(qv[s][4], qv[s][5]); o.w = pk2(qv[s][6], qv[s][7]); qf[s] = __builtin_bit_cast(bf16x8, o); }
}
DI void sm_step(f32x16& sc, float& mrun, float& lrun, f32x16& O0, f32x16& O1, bf16x8& p0, bf16x8& p1) {
    float mx = sc[0];
#pragma unroll
    for (int i = 1; i < 16; ++i) mx = fmaxf(mx, sc[i]);
    mx = xmax32(mx);
    const float mnew = fmaxf(mrun, mx), alpha = fexp2(mrun - mnew);
    float ps = 0.f;
#pragma unroll
    for (int i = 0; i < 16; ++i) { sc[i] = fexp2(sc[i] - mnew); ps += sc[i]; }
    lrun = lrun * alpha + ps; mrun = mnew;
#pragma unroll
    for (int i = 0; i < 16; ++i) { O0[i] *= alpha; O1[i] *= alpha; }
    p0 = pack8(sc, 0); p1 = pack8(sc, 1);
}
DI void dil_pair(const AttnLane& L, const __amdgpu_buffer_rsrc_t rs, const bf16_t* hb, int hd, long row0, int j, LAS unsigned char* ldsW, bf16_t* og, float* lse, int lrow0, int lane, const float* qg, const bf16_t* ropet, long tok0, int dil) {
    const int qi = lane & 31, h = lane >> 5;
    const unsigned kh = (unsigned)(WS_PROJ + ((size_t)(16 + hd) * T + row0) * 128), vh = (unsigned)(WS_PROJ + ((size_t)(32 + hd) * T + row0) * 128);
    const int kt0 = j >= 4 ? j - 4 : 0;
    bf16x8 qa[4], qb[4];
    {
        const unsigned qoff = (unsigned)(WS_PROJ + ((size_t)hd * T + row0 + 32 * j) * 128);
        dma_q(L, rs, qoff, ldsW + SLOT_BYTES); dma_q(L, rs, qoff + 4096u, ldsW + SLOT_BYTES + 4096);
        dma_tile(L, rs, kh + (unsigned)(4096 * kt0), vh + (unsigned)(4096 * kt0), ldsW);
        const u32x4* rpa = (const u32x4*)(ropet + (size_t)(tok0 + (long)dil * (32 * j + qi)) * 16); const u32x4* rpb = (const u32x4*)(ropet + (size_t)(tok0 + (long)dil * (32 * j + 32 + qi)) * 16);
        const u32x4 cca = rpa[0], sna = rpa[1], ccb = rpb[0], snb = rpb[1];
        asm volatile("s_waitcnt vmcnt(8)" ::: "memory");
        q_prep(qa, L, ldsW + SLOT_BYTES, cca, sna, qg, h);
        q_prep(qb, L, ldsW + SLOT_BYTES + 4096, ccb, snb, qg, h);
    }
    float ma = -INFINITY, la = 0.f, mb = -INFINITY, lb = 0.f;
    f32x16 A0, A1, B0, B1;
#pragma unroll
    for (int i = 0; i < 16; ++i) { A0[i] = 0.f; A1[i] = 0.f; B0[i] = 0.f; B1[i] = 0.f; }
    LDS_WAIT();
    unsigned buf = 0;
    for (int kt = kt0; kt <= j + 1; ++kt) {
        const bool more = kt <= j;
        if (more) dma_tile(L, rs, kh + (unsigned)(4096 * (kt + 1)), vh + (unsigned)(4096 * (kt + 1)), ldsW + (buf ^ 1u) * SLOT_BYTES);
        ATTN_WAIT_TILE(more);
        LAS unsigned char* slot = ldsW + buf * SLOT_BYTES;
        const bool useA = kt <= j, useB = kt >= j - 3;
        bf16x8 kf[4];
#pragma unroll
        for (int s = 0; s < 4; ++s) kf[s] = *(const LAS bf16x8*)(slot + L.ka[s]);
        f32x16 sa, sb;
#pragma unroll
        for (int i = 0; i < 16; ++i) { sa[i] = 0.f; sb[i] = 0.f; }
        if (useA) {
#pragma unroll
            for (int s = 0; s < 4; ++s) sa = mfma32(kf[s], qa[s], sa);
        }
        if (useB) {
#pragma unroll
            for (int s = 0; s < 4; ++s) sb = mfma32(kf[s], qb[s], sb);
        }
        if (kt == j) {
#pragma unroll
            for (int i = 0; i < 16; ++i) { const int key = (i & 3) + 8 * (i >> 2) + 4 * h; if (key > qi) sa[i] = -INFINITY; }
        }
        if (kt == j + 1) {
#pragma unroll
            for (int i = 0; i < 16; ++i) { const int key = (i & 3) + 8 * (i >> 2) + 4 * h; if (key > qi) sb[i] = -INFINITY; }
        }
        if (kt == j - 4) {
#pragma unroll
            for (int i = 0; i < 16; ++i) { const int key = (i & 3) + 8 * (i >> 2) + 4 * h; if (key < qi) sa[i] = -INFINITY; }
        }
        if (kt == j - 3) {
#pragma unroll
            for (int i = 0; i < 16; ++i) { const int key = (i & 3) + 8 * (i >> 2) + 4 * h; if (key < qi) sb[i] = -INFINITY; }
        }
        bf16x8 pa0, pa1, pb0, pb1;
        if (useA) sm_step(sa, ma, la, A0, A1, pa0, pa1);
        if (useB) sm_step(sb, mb, lb, B0, B1, pb0, pb1);
        bf16x8 vf[2][2]; tr_read8(L, (unsigned)(size_t)slot, vf);
        if (useA) { A0 = mfma32(vf[0][0], pa0, A0); A0 = mfma32(vf[0][1], pa1, A0); A1 = mfma32(vf[1][0], pa0, A1); A1 = mfma32(vf[1][1], pa1, A1); }
        if (useB) { B0 = mfma32(vf[0][0], pb0, B0); B0 = mfma32(vf[0][1], pb1, B0); B1 = mfma32(vf[1][0], pb0, B1); B1 = mfma32(vf[1][1], pb1, B1); }
        buf ^= 1u;
    }
    {   const float ltot = xsum32(la), inv = frcp(ltot); const int row = lrow0 + qi;
        store_o_row(og + (size_t)row * 64, A0, A1, inv, h);
        if (h == 0) lse[row] = ma + flog2(ltot); }
    {   const float ltot = xsum32(lb), inv = frcp(ltot); const int row = lrow0 + 32 + qi;
        store_o_row(og + (size_t)row * 64, B0, B1, inv, h);
        if (h == 0) lse[row] = mb + flog2(ltot); }
}
DI void sb_step(f32x16& z, float& carry, bool diag, int qi, int h, bf16x8& p0, bf16x8& p1) {
#pragma unroll
    for (int i = 0; i < 16; ++i) z[i] = fexp2(fminf(z[i], 31.f));
    if (diag) {
#pragma unroll
        for (int i = 0; i < 16; ++i) { const int key = (i & 3) + 8 * (i >> 2) + 4 * h; if (key >= qi) z[i] = 0.f; }
    }
    float lg[4], par[4], u0[4], p01[4], p012[4];
#pragma unroll
    for (int g = 0; g < 4; ++g) { const float a0 = 1.f + z[4 * g], a1 = 1.f + z[4 * g + 1], a2 = 1.f + z[4 * g + 2], a3 = 1.f + z[4 * g + 3];
        u0[g] = a0; p01[g] = a0 * a1; p012[g] = p01[g] * a2; lg[g] = -flog2(p012[g] * a3); }
#pragma unroll
    for (int g = 0; g < 4; ++g) par[g] = xget32(lg[g], h);
    float tg[4]; tg[3] = carry; tg[2] = tg[3] + (lg[3] + par[3]); tg[1] = tg[2] + (lg[2] + par[2]); tg[0] = tg[1] + (lg[1] + par[1]);
    carry = tg[0] + (lg[0] + par[0]);
#pragma unroll
    for (int g = 0; g < 4; ++g) { const float suf = tg[g] + lg[g] + (h == 0 ? par[g] : 0.f); const float y = fexp2(suf);
        z[4 * g] = z[4 * g] * y; z[4 * g + 1] = z[4 * g + 1] * (y * u0[g]); z[4 * g + 2] = z[4 * g + 2] * (y * p01[g]); z[4 * g + 3] = z[4 * g + 3] * (y * p012[g]); }
    p0 = pack8(z, 0); p1 = pack8(z, 1);
}
DI void sb_pair(const AttnLane& L, const __amdgpu_buffer_rsrc_t rs, const bf16_t* hb, int b, int h4, int j, LAS unsigned char* ldsW, unsigned char* ocat, int lane) {
    const int qi = lane & 31, h = lane >> 5;
    const long base = (long)b * S;
    const unsigned kh = (unsigned)(WS_PROJ + ((size_t)(16 + 12 + h4) * T + base) * 128), vh = (unsigned)(WS_PROJ + ((size_t)(32 + 12 + h4) * T + base) * 128);
    bf16x8 qa[4], qb[4];
    {
        const unsigned qoff = (unsigned)(WS_PROJ + ((size_t)(12 + h4) * T + base + 32 * j) * 128);
        dma_q(L, rs, qoff, ldsW + SLOT_BYTES); dma_q(L, rs, qoff + 4096u, ldsW + SLOT_BYTES + 4096);
        dma_tile(L, rs, kh + (unsigned)(4096 * (j + 1)), vh + (unsigned)(4096 * (j + 1)), ldsW);
        asm volatile("s_waitcnt vmcnt(8)" ::: "memory");
#pragma unroll
        for (int s = 0; s < 4; ++s) { qa[s] = *(const LAS bf16x8*)(ldsW + SLOT_BYTES + L.ka[s]); qb[s] = *(const LAS bf16x8*)(ldsW + SLOT_BYTES + 4096 + L.ka[s]); }
    }
    float ca = 0.f, cb = 0.f;
    f32x16 A0, A1, B0, B1;
#pragma unroll
    for (int i = 0; i < 16; ++i) { A0[i] = 0.f; A1[i] = 0.f; B0[i] = 0.f; B1[i] = 0.f; }
    bool doneA = false, doneB = false;
    LDS_WAIT();
    unsigned buf = 0;
    for (int kt = j + 1; kt >= 0; --kt) {
        const bool more = kt > 0;
        if (more) dma_tile(L, rs, kh + (unsigned)(4096 * (kt - 1)), vh + (unsigned)(4096 * (kt - 1)), ldsW + (buf ^ 1u) * SLOT_BYTES);
        ATTN_WAIT_TILE(more);
        LAS unsigned char* slot = ldsW + buf * SLOT_BYTES;
        const bool actA = kt <= j && !doneA, actB = !doneB;
        bf16x8 kf[4];
#pragma unroll
        for (int s = 0; s < 4; ++s) kf[s] = *(const LAS bf16x8*)(slot + L.ka[s]);
        f32x16 za, zb;
#pragma unroll
        for (int i = 0; i < 16; ++i) { za[i] = 0.f; zb[i] = 0.f; }
        if (actA) {
#pragma unroll
            for (int s = 0; s < 4; ++s) za = mfma32(kf[s], qa[s], za);
        }
        if (actB) {
#pragma unroll
            for (int s = 0; s < 4; ++s) zb = mfma32(kf[s], qb[s], zb);
        }
        bf16x8 pa0, pa1, pb0, pb1;
        if (actA) sb_step(za, ca, kt == j, qi, h, pa0, pa1);
        if (actB) sb_step(zb, cb, kt == j + 1, qi, h, pb0, pb1);
        bf16x8 vf[2][2]; tr_read8(L, (unsigned)(size_t)slot, vf);
        if (actA) { A0 = mfma32(vf[0][0], pa0, A0); A0 = mfma32(vf[0][1], pa1, A0); A1 = mfma32(vf[1][0], pa0, A1); A1 = mfma32(vf[1][1], pa1, A1); doneA = __all(ca < -40.f); }
        if (actB) { B0 = mfma32(vf[0][0], pb0, B0); B0 = mfma32(vf[0][1], pb1, B0); B1 = mfma32(vf[1][0], pb0, B1); B1 = mfma32(vf[1][1], pb1, B1); doneB = __all(cb < -40.f); }
        if (doneA && doneB) break;
        buf ^= 1u;
    }
    store_o_row_fp8(ocat + (size_t)(base + 32 * j + qi) * LDO + 256 + h4 * 64, A0, A1, h);
    store_o_row_fp8(ocat + (size_t)(base + 32 * j + 32 + qi) * LDO + 256 + h4 * 64, B0, B1, h);
}
DI void phase_attn(const Frame& F, const Params& p) {
    const int tid_ = fresh_tid(), lane_ = tid_ & 63;
    const bf16_t* hb = (const bf16_t*)(F.ws + WS_PROJ); unsigned char* ocat = F.ws + WS_OCAT;
    bf16_t* og = (bf16_t*)(F.ws + WS_OG) + (size_t)F.bid * (3 * 1024 * 64); float* lse = (float*)(F.ws + WS_LSE) + (size_t)F.bid * (3 * 1024);
    LAS unsigned char* ldsW = F.lds + F.wave * (2 * SLOT_BYTES);
    AttnLane L; attn_lane_init(L, lane_);
    const __amdgpu_buffer_rsrc_t rs = __builtin_amdgcn_make_buffer_rsrc(F.ws, 0, (int)WS_END, 0x00020000);
    const int NU = NB * 4 * 8;
    for (int i = 0;; ++i) {
        const int u = (F.G == 256) ? ((F.bid & 7) * 32 + (F.bid >> 3) + 256 * i) : (F.bid + F.G * i);
        if (u >= NU) break;
        const int qb = u & 7, hs = (u >> 3) & 3, b = u >> 5, t0 = qb * 1024;
        if (i > 0) __syncthreads();
        for (int w = F.wave; w < 16; w += 8) sb_pair(L, rs, hb, b, hs, t0 / 32 + 2 * w, ldsW, ocat, lane_);
        for (int w = F.wave; w < 48; w += 8) {
            const int g = w >> 4, ti = 2 * (w & 15), l2d = 2 * g, per = 32 >> l2d, r = ti / per, jj = ti % per;
            dil_pair(L, rs, hb, g * 4 + hs, (long)b * S + (long)r * (S >> l2d), ((t0 >> l2d) >> 5) + jj, ldsW, og + (size_t)g * (1024 * 64), lse + g * 1024, ti * 32, lane_, p.in[I_QG], (const bf16_t*)(F.ws + WS_ROPE), (long)b * S + r, 1 << l2d);
        }
        VM_WAIT();
        __syncthreads();
        {
            const int piece = tid_ & 7; const size_t bb = (size_t)b * S;
#pragma unroll 2
            for (int pass = 0; pass < 16; ++pass) {
                const int sq = t0 + pass * 64 + (tid_ >> 3);
                const int r0 = sq - t0, r1 = 1024 + (sq & 3) * 256 + ((sq - t0) >> 2), r2 = 2048 + (sq & 15) * 64 + ((sq - t0) >> 4);
                const float l0 = lse[r0], l1 = lse[r1], l2 = lse[r2];
                const u32x4 x = *((const u32x4*)(og + (size_t)r0 * 64) + piece), y = *((const u32x4*)(og + (size_t)r1 * 64) + piece), z = *((const u32x4*)(og + (size_t)r2 * 64) + piece);
                const float mx = fmaxf(l0, fmaxf(l1, l2)); float w0 = fexp2(l0 - mx), w1 = fexp2(l1 - mx), w2 = fexp2(l2 - mx); const float inv = frcp(w0 + w1 + w2); w0 *= inv; w1 *= inv; w2 *= inv;
                u32x2 r;
                r.x = pk4_fp8(w0 * bf_lo(x.x) + w1 * bf_lo(y.x) + w2 * bf_lo(z.x), w0 * bf_hi(x.x) + w1 * bf_hi(y.x) + w2 * bf_hi(z.x), w0 * bf_lo(x.y) + w1 * bf_lo(y.y) + w2 * bf_lo(z.y), w0 * bf_hi(x.y) + w1 * bf_hi(y.y) + w2 * bf_hi(z.y));
                r.y = pk4_fp8(w0 * bf_lo(x.z) + w1 * bf_lo(y.z) + w2 * bf_lo(z.z), w0 * bf_hi(x.z) + w1 * bf_hi(y.z) + w2 * bf_hi(z.z), w0 * bf_lo(x.w) + w1 * bf_lo(y.w) + w2 * bf_lo(z.w), w0 * bf_hi(x.w) + w1 * bf_hi(y.w) + w2 * bf_hi(z.w));
                *((u32x2*)(ocat + (bb + sq) * LDO + hs * 64) + piece) = r;
            }
        }
        __syncthreads();
    }
}

DI void route_rows(const Frame& F, const Params& p, int pm) {
    const int tid_ = fresh_tid(), lane_ = tid_ & 63;
    LAS int* hist = (LAS int*)(F.lds);
    const int ftid = fresh_tid();
    __syncthreads();
    if (ftid < 32) hist[ftid] = 0;
    __syncthreads();
    if (tid_ < 256) {
        const int row = pm * 256 + tid_; const float* L = (const float*)(F.ws + WS_LOGIT) + (size_t)row * 128;
        const float* brg = p.in[I_BRG]; const float* bre = p.in[I_BRE];
        float lgp[4];
#pragma unroll
        for (int c = 0; c < 4; ++c) lgp[c] = L[c] + L[36 + c] + brg[c];
        int gsel = 0; float gm = lgp[0];
#pragma unroll
        for (int c = 1; c < 4; ++c) if (lgp[c] > gm) { gm = lgp[c]; gsel = c; }
        float zs = 0.f;
#pragma unroll
        for (int c = 0; c < 4; ++c) zs += fexp2((lgp[c] - gm) * LOG2E);
        const float pg = frcp(zs);
        float l1 = -INFINITY, l2 = -INFINITY; int e1 = 0, e2 = 0;
#pragma unroll
        for (int i = 0; i < 8; ++i) { const int c = 4 + gsel * 8 + i; const float v = L[c] + L[36 + c] + bre[gsel * 8 + i];
            if (v > l1) { l2 = l1; e2 = e1; l1 = v; e1 = i; } else if (v > l2) { l2 = v; e2 = i; } }
        const float ex = fexp2((l2 - l1) * LOG2E), den = frcp(1.f + ex);
        int* te = (int*)(F.ws + WS_TOKE) + (size_t)row * 2; float* tw = (float*)(F.ws + WS_TOKW) + (size_t)row * 2;
        te[0] = gsel * 8 + e1; te[1] = gsel * 8 + e2; tw[0] = pg * den; tw[1] = pg * ex * den;
        lds_add(&hist[gsel * 8 + e1], 1); lds_add(&hist[gsel * 8 + e2], 1);
    }
    __syncthreads();
    if (ftid < 32) ((int*)(F.ws + WS_HIST))[pm * 32 + ftid] = hist[ftid];
}


DI void router_weights_to_lds(const Frame& F, const Params& p) {
    const int tid_ = fresh_tid(), lane_ = tid_ & 63;
    constexpr int WP = 1028;
    LAS float* wt = (LAS float*)(F.lds + LDS_RW); LAS float* bias = (LAS float*)(F.lds + LDS_RS) + 8 * 80 + 32;
    const float* wrg = p.in[I_WRG]; const float* wre = p.in[I_WRE]; const float* brg = p.in[I_BRG]; const float* bre = p.in[I_BRE];
    const int ftid = fresh_tid();
    __syncthreads();
#pragma unroll 8
    for (int i = ftid; i < 1024 * 32; i += 512) wt[(4 + (i & 31)) * WP + (i >> 5)] = wre[i];
#pragma unroll 8
    for (int i = ftid; i < 1024 * 4; i += 512) wt[(i & 3) * WP + (i >> 2)] = wrg[i];
    if (ftid < 36) bias[ftid] = ftid < 4 ? brg[ftid] : bre[ftid - 4];
}

DI void phase_norm2_route(const Frame& F, const Params& p) {
    const int tid_ = fresh_tid(), lane_ = tid_ & 63;
    constexpr int WP = 1028;
    LAS float* wt = (LAS float*)(F.lds + LDS_RW);
    LAS float* gs = (LAS float*)(F.lds + LDS_RV); LAS float* sh = gs + 1024;
    LAS float* scr = (LAS float*)(F.lds + LDS_RS) + F.wave * 80;
    LAS int* hist = (LAS int*)(F.lds + LDS_RS) + 8 * 80;
    LAS float* bias = (LAS float*)(F.lds + LDS_RS) + 8 * 80 + 32;
    const float* mod = (const float*)(F.ws + WS_MOD); const float* gn = p.in[I_GFFN];
    const bf16_t* upd = (const bf16_t*)(F.ws + WS_UPD1); bf16_t* x1w = (bf16_t*)(F.ws + WS_UPD1); unsigned* h8 = (unsigned*)(F.ws + WS_H28);
    const float* wrg = p.in[I_WRG]; const float* wre = p.in[I_WRE]; const float* brg = p.in[I_BRG]; const float* bre = p.in[I_BRE];
    const int ftid = fresh_tid();
    __syncthreads();
    for (int chunk = F.bid; chunk < T / 256; chunk += F.G) {
        const int b = chunk >> 5;
        __syncthreads();
        for (int col = ftid; col < 1024; col += 512) { gs[col] = gn[col] * (1.f + mod[b * 6144 + 4096 + col]); sh[col] = mod[b * 6144 + 3072 + col]; }
        if (ftid < 32) hist[ftid] = 0;
        __syncthreads();
        f32x4 vn[2][4]; u32x2 un[2][4];
#pragma unroll
        for (int r = 0; r < 2; ++r) { const int row = chunk * 256 + F.wave * 2 + r;
            const f32x4* xr = (const f32x4*)(p.in[I_X] + (size_t)row * 1024) + lane_; const u32x2* ur = (const u32x2*)(upd + (size_t)row * 1024) + lane_;
#pragma unroll
            for (int j = 0; j < 4; ++j) { vn[r][j] = xr[64 * j]; un[r][j] = ur[64 * j]; } }
        for (int rr = F.wave * 2; rr < 256; rr += 16) {
            const int row0 = chunk * 256 + rr;
            f32x4 y[2][4];
#pragma unroll
            for (int r = 0; r < 2; ++r) {
                const int row = row0 + r; float ss = 0.f;
#pragma unroll
                for (int j = 0; j < 4; ++j) { vn[r][j].x += bf_lo(un[r][j].x); vn[r][j].y += bf_hi(un[r][j].x); vn[r][j].z += bf_lo(un[r][j].y); vn[r][j].w += bf_hi(un[r][j].y);
                    { u32x2 o; o.x = pk2(vn[r][j].x, vn[r][j].y); o.y = pk2(vn[r][j].z, vn[r][j].w); *((u32x2*)(x1w + (size_t)row * 1024) + lane_ + 64 * j) = o; }
                    ss += (vn[r][j].x * vn[r][j].x + vn[r][j].y * vn[r][j].y) + (vn[r][j].z * vn[r][j].z + vn[r][j].w * vn[r][j].w); }
                const float rinv = __builtin_amdgcn_rsqf(wave_sum(ss) * (1.f / 1024.f) + RMS_EPS);
#pragma unroll
                for (int j = 0; j < 4; ++j) { const f32x4 gj = *(const LAS f32x4*)(gs + 256 * j + 4 * lane_), sj = *(const LAS f32x4*)(sh + 256 * j + 4 * lane_);
                    y[r][j] = vn[r][j] * rinv * gj + sj; h8[(size_t)row * 256 + 64 * j + lane_] = pk4_fp8(y[r][j].x, y[r][j].y, y[r][j].z, y[r][j].w); }
            }
            if (rr + 16 < 256) {
#pragma unroll
                for (int r = 0; r < 2; ++r) { const int row = row0 + 16 + r;
                    const f32x4* xr = (const f32x4*)(p.in[I_X] + (size_t)row * 1024) + lane_; const u32x2* ur = (const u32x2*)(upd + (size_t)row * 1024) + lane_;
#pragma unroll
                    for (int j = 0; j < 4; ++j) { vn[r][j] = xr[64 * j]; un[r][j] = ur[64 * j]; } }
            }
            const bool up32 = (lane_ & 32) != 0, up16 = (lane_ & 16) != 0, up8 = (lane_ & 8) != 0, up4 = (lane_ & 4) != 0;
            {
                f32x2 ga[2][4], gb[2][4];
#pragma unroll
                for (int r = 0; r < 2; ++r)
#pragma unroll
                    for (int c = 0; c < 4; ++c) { ga[r][c] = (f32x2){0.f, 0.f}; gb[r][c] = ga[r][c]; }
#pragma unroll
                for (int c = 0; c < 4; ++c)
#pragma unroll
                    for (int j = 0; j < 4; ++j) { const f32x4 w = *(const LAS f32x4*)(wt + c * WP + 4 * lane_ + 256 * j); const f32x2 wl = {w.x, w.y}, wh = {w.z, w.w};
#pragma unroll
                        for (int r = 0; r < 2; ++r) { ga[r][c] = __builtin_elementwise_fma((f32x2){y[r][j].x, y[r][j].y}, wl, ga[r][c]); gb[r][c] = __builtin_elementwise_fma((f32x2){y[r][j].z, y[r][j].w}, wh, gb[r][c]); } }
                float k4[4];
#pragma unroll
                for (int c = 0; c < 4; ++c) { const f32x2 t0 = ga[0][c] + gb[0][c], t1 = ga[1][c] + gb[1][c]; const float p0 = t0.x + t0.y, p1 = t1.x + t1.y;
                    k4[c] = up32 ? p0 : p1; ga[0][c].x = up32 ? p1 : p0; }
#pragma unroll
                for (int c = 0; c < 4; ++c) k4[c] = ga[0][c].x + __shfl_xor(k4[c], 32);
                float k2[2];
#pragma unroll
                for (int i = 0; i < 2; ++i) k2[i] = (up16 ? k4[2 + i] : k4[i]) + __shfl_xor(up16 ? k4[i] : k4[2 + i], 16);
                float k1 = (up8 ? k2[1] : k2[0]) + __shfl_xor(up8 ? k2[0] : k2[1], 8);
                k1 += __shfl_xor(k1, 4); k1 += __shfl_xor(k1, 2); k1 += __shfl_xor(k1, 1);
                if ((lane_ & 7) == 0) scr[(lane_ >> 5) * 36 + ((lane_ >> 4) & 1) * 2 + ((lane_ >> 3) & 1)] = k1;
            }
            LDS_WAIT();
            int gsel[2];
#pragma unroll
            for (int r = 0; r < 2; ++r) { int gi = 0; float gm = scr[r * 36] + bias[0];
#pragma unroll
                for (int c = 1; c < 4; ++c) { const float v = scr[r * 36 + c] + bias[c]; if (v > gm) { gm = v; gi = c; } }
                gsel[r] = __builtin_amdgcn_readfirstlane(gi); }
            {
                float pe[2][8];
#pragma unroll
                for (int r = 0; r < 2; ++r) {
                    const LAS float* wb = wt + (4 + gsel[r] * 8) * WP + 4 * lane_;
#pragma unroll
                    for (int hh = 0; hh < 2; ++hh) {
                        f32x2 ea[4], eb[4];
#pragma unroll
                        for (int i = 0; i < 4; ++i) { ea[i] = (f32x2){0.f, 0.f}; eb[i] = ea[i]; }
#pragma unroll
                        for (int i = 0; i < 4; ++i)
#pragma unroll
                            for (int j = 0; j < 4; ++j) { const f32x4 w = *(const LAS f32x4*)(wb + (hh * 4 + i) * WP + 256 * j);
                                ea[i] = __builtin_elementwise_fma((f32x2){y[r][j].x, y[r][j].y}, (f32x2){w.x, w.y}, ea[i]); eb[i] = __builtin_elementwise_fma((f32x2){y[r][j].z, y[r][j].w}, (f32x2){w.z, w.w}, eb[i]); }
#pragma unroll
                        for (int i = 0; i < 4; ++i) { const f32x2 t = ea[i] + eb[i]; pe[r][hh * 4 + i] = t.x + t.y; }
                        __builtin_amdgcn_sched_barrier(0);
                    }
                }
                float e8[8], e4[4], e2[2];
#pragma unroll
                for (int i = 0; i < 8; ++i) e8[i] = (up32 ? pe[1][i] : pe[0][i]) + __shfl_xor(up32 ? pe[0][i] : pe[1][i], 32);
#pragma unroll
                for (int i = 0; i < 4; ++i) e4[i] = (up16 ? e8[4 + i] : e8[i]) + __shfl_xor(up16 ? e8[i] : e8[4 + i], 16);
#pragma unroll
                for (int i = 0; i < 2; ++i) e2[i] = (up8 ? e4[2 + i] : e4[i]) + __shfl_xor(up8 ? e4[i] : e4[2 + i], 8);
                float e1 = (up4 ? e2[1] : e2[0]) + __shfl_xor(up4 ? e2[0] : e2[1], 4);
                e1 += __shfl_xor(e1, 2); e1 += __shfl_xor(e1, 1);
                if ((lane_ & 3) == 0) scr[(lane_ >> 5) * 36 + 4 + ((lane_ >> 4) & 1) * 4 + ((lane_ >> 3) & 1) * 2 + ((lane_ >> 2) & 1)] = e1;
            }
            LDS_WAIT();
            if (lane_ < 2) {
                const LAS float* L = scr + lane_ * 36; const int row = row0 + lane_;
                float lgp[4];
#pragma unroll
                for (int c = 0; c < 4; ++c) lgp[c] = L[c] + bias[c];
                int gsel = 0; float gm = lgp[0];
#pragma unroll
                for (int c = 1; c < 4; ++c) if (lgp[c] > gm) { gm = lgp[c]; gsel = c; }
                float zs = 0.f;
#pragma unroll
                for (int c = 0; c < 4; ++c) zs += fexp2((lgp[c] - gm) * LOG2E);
                const float pg = frcp(zs);
                float l1 = -INFINITY, l2 = -INFINITY; int e1 = 0, e2 = 0;
#pragma unroll
                for (int i = 0; i < 8; ++i) { const float v = L[4 + i] + bias[4 + gsel * 8 + i];
                    if (v > l1) { l2 = l1; e2 = e1; l1 = v; e1 = i; } else if (v > l2) { l2 = v; e2 = i; } }
                const float ex = fexp2((l2 - l1) * LOG2E), den = frcp(1.f + ex);
                int* te = (int*)(F.ws + WS_TOKE) + (size_t)row * 2; float* tw = (float*)(F.ws + WS_TOKW) + (size_t)row * 2;
                te[0] = gsel * 8 + e1; te[1] = gsel * 8 + e2; tw[0] = pg * den; tw[1] = pg * ex * den;
                lds_add(&hist[gsel * 8 + e1], 1); lds_add(&hist[gsel * 8 + e2], 1);
            }
            LDS_WAIT();
        }
        __syncthreads();
        if (ftid < 32) ((int*)(F.ws + WS_HIST))[chunk * 32 + ftid] = hist[ftid];
    }
}

DI void phase_slots(const Frame& F, const Params& p) {
    const int tid_ = fresh_tid(), lane_ = tid_ & 63;
    LAS int* tot = (LAS int*)(F.lds); LAS int* bas = tot + 32; LAS int* pst = tot + 64; LAS int* wcnt = tot + 128;
    const int* hist = (const int*)(F.ws + WS_HIST);
    for (int pm = F.bid; pm < T / 256; pm += F.G) {
        const int ftid = fresh_tid();
        __syncthreads();
        if (ftid < 64) tot[ftid] = 0;
        __syncthreads();
        { const int e = tid_ & 31, part = tid_ >> 5; int t = 0, bs = 0;
          for (int q = part; q < T / 256; q += 16) { const int v = hist[q * 32 + e]; t += v; if (q < pm) bs += v; }
          lds_add(&tot[e], t); lds_add(&bas[e], bs); }
        __syncthreads();
        if (tid_ == 0) { int run = 0; for (int e = 0; e < 32; ++e) { pst[e] = run; run += (tot[e] + 255) / 256 * 256; } pst[32] = run; }
        const int my_e = ((const int*)(F.ws + WS_TOKE))[(size_t)pm * 512 + tid_];
        int rank = 0;
        for (int e = 0; e < 32; ++e) { const unsigned long long mask = __ballot(my_e == e); if (my_e == e) rank = __popcll(mask & ((1ull << lane_) - 1ull)); if (lane_ == 0) wcnt[F.wave * 32 + e] = __popcll(mask); }
        __syncthreads();
        int woff = 0;
        for (int w = 0; w < F.wave; ++w) woff += wcnt[w * 32 + my_e];
        const int slot = pst[my_e] + bas[my_e] + woff + rank;
        ((int*)(F.ws + WS_SLOTTOK))[slot] = pm * 256 + (tid_ >> 1);
        ((float*)(F.ws + WS_SLOTW))[slot] = ((const float*)(F.ws + WS_TOKW))[(size_t)pm * 512 + tid_];
        ((int*)(F.ws + WS_TOKS))[(size_t)pm * 512 + tid_] = slot;
        if (pm < 32) { const int e = pm; for (int s = pst[e] + tot[e] + tid_; s < pst[e + 1]; s += 512) { ((int*)(F.ws + WS_SLOTTOK))[s] = 0; ((float*)(F.ws + WS_SLOTW))[s] = 0.f; } }
        if (pm == 0 && tid_ < 34) { int* et = (int*)(F.ws + WS_ETAB); if (tid_ < 33) et[64 + tid_] = pst[tid_] >> 8; if (tid_ < 32) { et[tid_] = tot[tid_]; et[32 + tid_] = pst[tid_]; } if (tid_ == 33) et[97] = pst[32] >> 8; }
    }
}

DI void phase_combine(const Frame& F, const Params& p) {
    const int tid_ = fresh_tid(), lane_ = tid_ & 63;
    const unsigned* y = (const unsigned*)(F.ws + WS_Y); const int* ts = (const int*)(F.ws + WS_TOKS); const float* tw = (const float*)(F.ws + WS_TOKW); const float* mod = (const float*)(F.ws + WS_MOD);
    const int gw = F.bid * 8 + F.wave, NGW = F.G * 8;
    for (int row = gw; row < T; row += NGW) {
        const int s0 = ts[(size_t)row * 2], s1 = ts[(size_t)row * 2 + 1]; const float w0 = tw[(size_t)row * 2] * 0.125f, w1 = tw[(size_t)row * 2 + 1] * 0.125f;
        f32x4* orow = (f32x4*)(p.out + (size_t)row * 1024) + lane_;
        const u32x2* ur = (const u32x2*)((const bf16_t*)(F.ws + WS_UPD1) + (size_t)row * 1024) + lane_;
        const unsigned* y0 = y + (size_t)s0 * 256 + lane_; const unsigned* y1 = y + (size_t)s1 * 256 + lane_;
        const f32x4* g2 = (const f32x4*)(mod + (row >> 13) * 6144 + 5120) + lane_;
        f32x4 v[4], g[4]; unsigned a[4], c[4]; u32x2 uu[4];
#pragma unroll
        for (int j = 0; j < 4; ++j) { uu[j] = ur[64 * j]; a[j] = y0[64 * j]; c[j] = y1[64 * j]; g[j] = g2[64 * j]; }
#pragma unroll
        for (int j = 0; j < 4; ++j) { v[j] = (f32x4){bf_lo(uu[j].x), bf_hi(uu[j].x), bf_lo(uu[j].y), bf_hi(uu[j].y)};
            if (!DBG_SKIP_Y) { const f32x2 al = fp8_lo2(a[j]), ah = fp8_hi2(a[j]), cl = fp8_lo2(c[j]), ch = fp8_hi2(c[j]);
                v[j].x += g[j].x * (w0 * al.x + w1 * cl.x); v[j].y += g[j].y * (w0 * al.y + w1 * cl.y); v[j].z += g[j].z * (w0 * ah.x + w1 * ch.x); v[j].w += g[j].w * (w0 * ah.y + w1 * ch.y); } orow[64 * j] = v[j]; }
    }
}

__global__ void __launch_bounds__(512, 2) fwd(Params p) {
    extern __shared__ __attribute__((aligned(16))) unsigned char lds_raw[];
    Frame F;
    F.lds = (LAS unsigned char*)lds_raw; F.ws = p.ws;
    F.wave = __builtin_amdgcn_readfirstlane((int)threadIdx.x >> 6); F.G = gridDim.x; F.bid = blockIdx.x;
    volatile LAS unsigned* ctl = (volatile LAS unsigned*)(F.lds + LDS_CTLO);
    { const int ftid = fresh_tid(); if (ftid < 64) ctl[ftid] = 0u; }
    __syncthreads();
    XcdBarrier bar; bar.bar = (unsigned*)(p.ws + WS_CTL) + CW_BAR; bar.x = 0; bar.st = ctl;
    if (MK_N_LAUNCHES == 1) bar = xcd_barrier_post((unsigned*)(p.ws + WS_CTL) + CW_BAR, ctl);
    const int lo = p.ph_lo, hi = p.ph_hi;
    const __amdgpu_buffer_rsrc_t rsw = __builtin_amdgcn_make_buffer_rsrc(p.ws, 0, (int)WS_END, 0x00020000);
#define IN(k) (lo <= (k) && (k) < hi)
#define REP(k) for (int rep_ = 0; rep_ < ((PROBE_PH) == (k) ? 2 : 1); ++rep_)
#define SEAM(k) do { if (IN(k) && IN((k) + 1)) xcd_barrier(bar); } while (0)

    if (IN(0)) REP(0) { phase0(F, p); } SEAM(0);
    if (IN(1)) REP(1) { phase_norm<0>(F, p); } SEAM(1);
    if (IN(2)) REP(2) {
        REP(20) {
            pg8::DenseSched Sd; Sd.init(T, 2304, F.G, F.bid, WS_H8, 1024, WS_W1D8, 1024);
            EpiProj<false> E{(bf16_t*)(F.ws + WS_PROJ), (bf16_t*)(F.ws + WS_GATES), (const bf16_t*)(F.ws + WS_ROPE), p.in[I_QG], p.in[I_KG], 0};
            pg8::gemm_phase<EpiProj<false>, pg8::DenseSched, true>(F.lds, 1024, Sd, E, rsw);
        }
        REP(21) {
            pg8::DenseSched Sd; Sd.init(T, 768, F.G, F.bid, WS_H, 2048, WS_W1 + (size_t)2304 * 2048, 2048);
            EpiProj<false> E{(bf16_t*)(F.ws + WS_PROJ), (bf16_t*)(F.ws + WS_GATES), (const bf16_t*)(F.ws + WS_ROPE), p.in[I_QG], p.in[I_KG], 9};
            pg8::gemm_phase<EpiProj<false>, pg8::DenseSched, false>(F.lds, 1024, Sd, E, rsw);
        }
        REP(22) {
            pg8::DenseSched Sd; Sd.init(T, 2048, F.G, F.bid, WS_H8, 1024, WS_WG8, 1024);
            EpiProj<true> E{(bf16_t*)(F.ws + WS_PROJ), (bf16_t*)(F.ws + WS_GATES), (const bf16_t*)(F.ws + WS_ROPE), p.in[I_QG], p.in[I_KG], 0};
            pg8::gemm_phase<EpiProj<true>, pg8::DenseSched, true>(F.lds, 1024, Sd, E, rsw);
        }
    } SEAM(2);
    if (IN(3)) REP(3) { phase_attn(F, p); } SEAM(3);
    if (IN(4)) REP(4) {
        pg8::DiagSched Sd; Sd.init(T, 2048, F.G, F.bid, WS_OCAT, 512, WS_WB, 512);
        EpiBranch E{(const unsigned char*)(F.ws + WS_GATES), F.ws + WS_MERGED};
        pg8::gemm_phase<EpiBranch, pg8::DiagSched, true>(F.lds, 512, Sd, E, rsw);
    } SEAM(4);
    if (IN(5)) REP(5) {
        pg8::DenseSched Sd; Sd.init(T, 1024, F.G, F.bid, WS_MERGED, 1024, WS_WO, 1024);
        EpiOut E{(bf16_t*)(F.ws + WS_UPD1), (const float*)(F.ws + WS_MOD)};
        pg8::gemm_phase<EpiOut, pg8::DenseSched, true>(F.lds, 1024, Sd, E, rsw);
        if (rep_ + 1 == ((PROBE_PH) == 5 ? 2 : 1)) router_weights_to_lds(F, p);
    } SEAM(5);
    if (IN(6)) REP(6) { phase_norm2_route(F, p); }
    if (IN(6) && IN(8)) xcd_barrier(bar);
    if (IN(8)) REP(8) { phase_slots(F, p); } SEAM(8);
    if (IN(9) || IN(10)) {
        LAS int* cst = (LAS int*)(F.lds + LDS_CTLO) + 16;
        __syncthreads();
        { const int ftid = fresh_tid(); if (ftid < 34) cst[ftid] = ((const int*)(F.ws + WS_ETAB))[64 + ftid]; }
        __syncthreads();
    }
    if (IN(9)) REP(9) {
        const LAS int* cst = (const LAS int*)(F.lds + LDS_CTLO) + 16;
        MoeSchedUp Sm; Sm.G = F.G; Sm.c = (F.G == 256) ? ((F.bid & 7) * 32 + (F.bid >> 3)) : F.bid; Sm.nc = __builtin_amdgcn_readfirstlane(cst[33]); Sm.pa = 1024; Sm.pb = 1024; Sm.A = (unsigned)WS_H28; Sm.B = (unsigned)WS_WGU; Sm.cstart = cst;
        Sm.slot_tok = (const int*)(F.ws + WS_SLOTTOK); Sm.estride = 1024u * 1024u; Sm.pnstride = 256u * 1024u;
        EpiSwiglu E{F.ws + WS_HMID};
        pg8::gemm_phase<EpiSwiglu, MoeSchedUp, true>(F.lds, 1024, Sm, E, rsw);
    } SEAM(9);
    if (IN(10)) REP(10) {
        const LAS int* cst = (const LAS int*)(F.lds + LDS_CTLO) + 16;
        MoeSchedDn Sm; Sm.G = F.G; Sm.c = (F.G == 256) ? ((F.bid & 7) * 32 + (F.bid >> 3)) : F.bid; Sm.nc = __builtin_amdgcn_readfirstlane(cst[33]); Sm.pa = 512; Sm.pb = 512; Sm.A = (unsigned)WS_HMID; Sm.B = (unsigned)WS_WDN; Sm.cstart = cst;
        Sm.slot_tok = (const int*)(F.ws + WS_SLOTTOK); Sm.estride = 1024u * 512u; Sm.pnstride = 256u * 512u;
        EpiDown E{F.ws + WS_Y};
        pg8::gemm_phase<EpiDown, MoeSchedDn, true>(F.lds, 512, Sm, E, rsw);
    } SEAM(10);
    if (IN(11)) { phase_combine(F, p); }
#undef IN
#undef SEAM
}

extern "C" void kernel_launch(void* const* d_in, const int* in_sizes, int n_in, void* d_out, int out_size, void* d_ws, size_t ws_size, hipStream_t stream) {
    static int grid = 0;
    if (grid == 0) {
        if (n_in != 21 || in_sizes[0] != T * D || out_size != T * D || ws_size < WS_END) { fprintf(stderr, "kernel_launch: unexpected problem (n_in %d, ws %zu)\n", n_in, ws_size); grid = -1; return; }
        int dev = 0, cus = 0, per_cu = 0;
        if (hipGetDevice(&dev) != hipSuccess || hipDeviceGetAttribute(&cus, hipDeviceAttributeMultiprocessorCount, dev) != hipSuccess) { grid = -1; return; }
        if (hipFuncSetAttribute((const void*)fwd, hipFuncAttributeMaxDynamicSharedMemorySize, LDS_BYTES) != hipSuccess) { fprintf(stderr, "kernel_launch: hipFuncSetAttribute failed\n"); grid = -1; return; }
        if (hipOccupancyMaxActiveBlocksPerMultiprocessor(&per_cu, (const void*)fwd, 512, LDS_BYTES) != hipSuccess || per_cu < 1) { fprintf(stderr, "kernel_launch: occupancy query says %d\n", per_cu); (void)hipGetLastError(); grid = -1; return; }
        grid = cus;
    }
    if (grid < 0) return;
    (void)hipMemsetAsync((char*)d_ws + WS_CTL, 0, CTL_ZERO_BYTES, stream);
    Params p{};
    for (int i = 0; i < 21; ++i) p.in[i] = (const float*)d_in[i];
    p.out = (float*)d_out; p.ws = (unsigned char*)d_ws;
    if (MK_N_LAUNCHES == 1) { p.ph_lo = 0; p.ph_hi = NPH; hipLaunchKernelGGL(fwd, dim3(grid), dim3(512), LDS_BYTES, stream, p); }
    else { for (int k = 0; k < NPH; ++k) { p.ph_lo = k; p.ph_hi = k + 1; hipLaunchKernelGGL(fwd, dim3(grid), dim3(512), LDS_BYTES, stream, p); } }
}
```

```cpp
#include <hip/hip_runtime.h>
#include <cstdio>
#include <cstdint>

#ifndef MK_N_LAUNCHES
#define MK_N_LAUNCHES 1
#endif
#define DBG_X1_PLAIN 0
#define DBG_SKIP_Y 0
#ifndef PROBE_PH
#define PROBE_PH -1
#endif

#define LAS __attribute__((address_space(3)))
#define DI __device__ __forceinline__
typedef unsigned short bf16_t;
typedef short bf16x8 __attribute__((ext_vector_type(8)));
typedef short s16x4 __attribute__((ext_vector_type(4)));
typedef float f32x2 __attribute__((ext_vector_type(2)));
typedef float f32x4 __attribute__((ext_vector_type(4)));
typedef float f32x16 __attribute__((ext_vector_type(16)));
typedef unsigned u32x2 __attribute__((ext_vector_type(2)));
typedef unsigned u32x4 __attribute__((ext_vector_type(4)));
typedef __bf16 bf16x2n __attribute__((ext_vector_type(2)));
typedef int i32x8 __attribute__((ext_vector_type(8)));

constexpr int NB = 8, S = 8192, D = 1024, T = NB * S;
constexpr int LDP = 3072, LDG = 2048, LDO = 512;
constexpr int NE = 32, DE = 512;
constexpr int MAXSLOT = T * 2 + NE * 256;
constexpr int NPH = 12;
constexpr float LOG2E = 1.4426950408889634f;
constexpr float QSCALE = 0.125f * LOG2E;
constexpr float RMS_EPS = 1e-6f;

constexpr size_t MiB = 1u << 20;
constexpr size_t WS_CTL = 0, CTL_ZERO_BYTES = 64 * 1024;
constexpr int CW_BAR = 1024;
constexpr size_t WS_MODP = 1 * MiB;
constexpr size_t WS_MOD = 3 * MiB;
constexpr size_t WS_ROPE = 4 * MiB;
constexpr size_t WS_LOGIT = 144 * MiB;
constexpr size_t WS_TOKE = 24 * MiB;
constexpr size_t WS_TOKW = 24 * MiB + 512 * 1024;
constexpr size_t WS_TOKS = 25 * MiB;
constexpr size_t WS_SLOTTOK = 25 * MiB + 512 * 1024;
constexpr size_t WS_SLOTW = 26 * MiB + 256 * 1024;
constexpr size_t WS_HIST = 27 * MiB;
constexpr size_t WS_ETAB = 27 * MiB + 256 * 1024;
constexpr size_t WS_WR = 28 * MiB;
constexpr size_t WS_W1D8 = 28 * MiB + 512 * 1024;
constexpr size_t WS_W1 = 32 * MiB;
constexpr size_t WS_WG8 = 38 * MiB;
constexpr size_t WS_WB = 40 * MiB;
constexpr size_t WS_WO = 43 * MiB;
constexpr size_t WS_WGU = 48 * MiB;
constexpr size_t WS_WDN = 80 * MiB;
constexpr size_t WS_H = 144 * MiB;
constexpr size_t WS_OG = 144 * MiB;
constexpr size_t WS_LSE = 240 * MiB;
constexpr size_t WS_PROJ = 272 * MiB;
constexpr size_t WS_GATES = 656 * MiB;
constexpr size_t WS_OCAT = 912 * MiB;
constexpr size_t WS_H8 = 912 * MiB;
constexpr size_t WS_MERGED = 272 * MiB;
constexpr size_t WS_H2 = 400 * MiB;
constexpr size_t WS_H28 = 528 * MiB;
constexpr size_t WS_HMID = 592 * MiB;
constexpr size_t WS_Y = 336 * MiB;
constexpr size_t WS_UPD1 = 784 * MiB;
constexpr size_t WS_END = 976 * MiB;

constexpr int LDS_STAGE = 0, LDS_EPI = 131072, LDS_RW = 0, LDS_RV = 148480, LDS_RS = 148480 + 8192, LDS_CTLO = 148480 + 8192 + 3072, LDS_BYTES = LDS_CTLO + 256;

DI unsigned pk2(float lo, float hi) { f32x2 v = {lo, hi}; bf16x2n r = __builtin_convertvector(v, bf16x2n); return __builtin_bit_cast(unsigned, r); }
DI unsigned pk4_fp8(float a, float b, float c, float d) { int r = __builtin_amdgcn_cvt_pk_fp8_f32(a, b, 0, false); r = __builtin_amdgcn_cvt_pk_fp8_f32(c, d, r, true); return (unsigned)r; }
DI f32x2 fp8_lo2(unsigned u) { return __builtin_amdgcn_cvt_pk_f32_fp8((int)u, false); }
DI f32x2 fp8_hi2(unsigned u) { return __builtin_amdgcn_cvt_pk_f32_fp8((int)u, true); }
DI float bf_lo(unsigned u) { return __builtin_bit_cast(float, u << 16); }
DI float bf_hi(unsigned u) { return __builtin_bit_cast(float, u & 0xffff0000u); }
struct Swap2 { float lo, hi; };
DI Swap2 swap32(float x) { const unsigned b = __builtin_bit_cast(unsigned, x); auto r = __builtin_amdgcn_permlane32_swap(b, b, false, false); const unsigned r0 = r[0], r1 = r[1]; return Swap2{__builtin_bit_cast(float, r0), __builtin_bit_cast(float, r1)}; }
DI Swap2 swap16(float x) { const unsigned b = __builtin_bit_cast(unsigned, x); auto r = __builtin_amdgcn_permlane16_swap(b, b, false, false); const unsigned r0 = r[0], r1 = r[1]; return Swap2{__builtin_bit_cast(float, r0), __builtin_bit_cast(float, r1)}; }
DI float xsum32(float x) { const Swap2 s = swap32(x); return s.lo + s.hi; }
DI float xmax32(float x) { const Swap2 s = swap32(x); return fmaxf(s.lo, s.hi); }
DI float xget32(float x, int upper) { const Swap2 s = swap32(x); return upper ? s.lo : s.hi; }
DI float wave_sum(float v) {
    v += __builtin_bit_cast(float, __builtin_amdgcn_update_dpp(0, __builtin_bit_cast(int, v), 0xB1, 0xF, 0xF, true));
    v += __builtin_bit_cast(float, __builtin_amdgcn_update_dpp(0, __builtin_bit_cast(int, v), 0x4E, 0xF, 0xF, true));
    v += __builtin_bit_cast(float, __builtin_amdgcn_update_dpp(0, __builtin_bit_cast(int, v), 0x141, 0xF, 0xF, true));
    v += __builtin_bit_cast(float, __builtin_amdgcn_update_dpp(0, __builtin_bit_cast(int, v), 0x140, 0xF, 0xF, true));
    { const Swap2 s = swap16(v); v = s.lo + s.hi; }
    { const Swap2 s = swap32(v); v = s.lo + s.hi; }
    return v;
}
DI float fexp2(float x) { return __builtin_amdgcn_exp2f(x); }
DI float flog2(float x) { return __builtin_amdgcn_logf(x); }
DI float frcp(float x) { return __builtin_amdgcn_rcpf(x); }
DI float sigmoidf(float v) { return frcp(1.0f + fexp2(-v * LOG2E)); }
DI void lds_add(LAS int* p, int v) { (void)__hip_atomic_fetch_add(p, v, __ATOMIC_RELAXED, __HIP_MEMORY_SCOPE_WORKGROUP); }
#define LDS_WAIT() asm volatile("s_waitcnt lgkmcnt(0)" ::: "memory")
#define VM_WAIT() asm volatile("s_waitcnt vmcnt(0)" ::: "memory")
DI int fresh_tid() { int t = threadIdx.x; asm volatile("" : "+v"(t)); return t; }

#define XB_TMO      128
#define XB_XCNT(j)  (256  + 64 * (j))
#define XB_XSUB(j)  (1280 + 64 * (j))
#define XB_XGEN(j)  (2304 + 64 * (j))
#define XB_TOP      3328
#define XB_TOPGEN   3392
#define XCD_BAR_WORDS 3456
#define XB_SPIN_CAP (1u << 18)

__device__ __forceinline__ unsigned xb_ld(unsigned* p)              { return __hip_atomic_load(p, __ATOMIC_RELAXED, __HIP_MEMORY_SCOPE_AGENT); }
__device__ __forceinline__ unsigned xb_add(unsigned* p, unsigned v) { return __hip_atomic_fetch_add(p, v, __ATOMIC_RELAXED, __HIP_MEMORY_SCOPE_AGENT); }
__device__ __forceinline__ unsigned xb_xcc_id() { return (unsigned)__builtin_amdgcn_s_getreg((3 << 11) | 20) & 0xFu; }
#define XB_SPIN(cond, bar) do { unsigned _sp = 0; while (cond) { __builtin_amdgcn_s_sleep(1); \
    if ((++_sp & 255u) == 0u) { if (xb_ld(&(bar)[XB_TMO])) break; if (_sp > XB_SPIN_CAP) { atomicAdd(&(bar)[XB_TMO], 1u); break; } } } } while (0)

struct XcdBarrier {
    unsigned* bar; unsigned x;
    volatile LAS unsigned* st;
};
__device__ __forceinline__ XcdBarrier xcd_barrier_post(unsigned* bar, volatile LAS unsigned* st) {
    XcdBarrier b; b.bar = bar; b.x = xb_xcc_id(); b.st = st;
    if (threadIdx.x == 0) (void)xb_add(&bar[XB_XCNT(b.x)], 1u);
    return b;
}
__device__ __forceinline__ void xcd_barrier_complete(unsigned* bar, unsigned x, unsigned& nloc, unsigned& nx) {
    const unsigned G = gridDim.x * gridDim.y * gridDim.z;
    unsigned sum, cnt, mine, sp = 0u;
    for (;;) {
        sum = 0u; cnt = 0u; mine = 0u;
#pragma unroll
        for (unsigned j = 0; j < 16; ++j) { const unsigned c = xb_ld(&bar[XB_XCNT(j)]); sum += c; cnt += (c > 0u) ? 1u : 0u; mine = (j == x) ? c : mine; }
        if (sum == G) break;
        __builtin_amdgcn_s_sleep(1);
        if ((++sp & 255u) == 0u) { if (xb_ld(&bar[XB_TMO])) break; if (sp > XB_SPIN_CAP) { atomicAdd(&bar[XB_TMO], 1u); break; } }
    }
    nloc = mine > 0u ? mine : 1u; nx = cnt > 0u ? cnt : 1u;
}
__device__ __forceinline__ void xcd_barrier(const XcdBarrier& b) {
    asm volatile("s_waitcnt vmcnt(0)" ::: "memory");
    __syncthreads();
    if (threadIdx.x == 0) {
        unsigned* bar = b.bar;
        __builtin_amdgcn_s_waitcnt(0);
        unsigned nloc = b.st[0], nx = b.st[1];
        if (nloc == 0u) { xcd_barrier_complete(bar, b.x, nloc, nx); b.st[0] = nloc; b.st[1] = nx; }
        const unsigned old = xb_add(&bar[XB_XSUB(b.x)], 1u);
        const unsigned gen = old / nloc;
        if (old + 1u == (gen + 1u) * nloc) {
            __builtin_amdgcn_fence(__ATOMIC_RELEASE, "agent");
            asm volatile("s_waitcnt vmcnt(0)" ::: "memory");
            const unsigned og = xb_add(&bar[XB_TOP], 1u);
            const unsigned tg = og / nx;
            if (og + 1u == (tg + 1u) * nx) xb_add(&bar[XB_TOPGEN], 1u);
            else XB_SPIN(xb_ld(&bar[XB_TOPGEN]) == tg, bar);
            __builtin_amdgcn_fence(__ATOMIC_ACQUIRE, "agent");
            xb_add(&bar[XB_XGEN(b.x)], 1u);
            asm volatile("s_waitcnt vmcnt(0)" ::: "memory");
        } else {
            XB_SPIN(xb_ld(&bar[XB_XGEN(b.x)]) == gen, bar);
            __builtin_amdgcn_fence(__ATOMIC_ACQUIRE, "agent");
            asm volatile("s_waitcnt vmcnt(0)" ::: "memory");
        }
    }
    __syncthreads();
}

namespace pg8 {
constexpr int BM = 256, BK = 64, HALF = 128, HTB = HALF * BK * 2, STAGE_BYTES = 8 * HTB, NXCD = 8, WGM = 8;
__host__ __device__ __forceinline__ int lds_byte(int r, int c) { const int st = (r >> 4) * 2 + (c >> 5), rr = r & 15, cc = c & 31, ob = rr * 64 + cc * 2; return st * 1024 + (ob ^ (((ob >> 9) & 1) << 5)); }
__host__ __device__ __forceinline__ void stage_rc(int b, int& R, int& C) { const int st = b / 1024, sb = b % 1024, swz = sb ^ (((sb >> 9) & 1) << 5); R = (st >> 1) * 16 + swz / 64; C = (st & 1) * 32 + (swz % 64) / 2; }
__host__ __device__ __forceinline__ int perm32(int rho) { const int n = rho >> 4, i = rho & 15; return 8 * (i >> 2) + 4 * n + (i & 3); }

struct Unit { int pm, pn, aux; unsigned a, b; };
typedef int i32x4 __attribute__((ext_vector_type(4)));
__device__ __forceinline__ i32x8 frag8(bf16x8 lo, bf16x8 hi) { return __builtin_shufflevector(__builtin_bit_cast(i32x4, lo), __builtin_bit_cast(i32x4, hi), 0, 1, 2, 3, 4, 5, 6, 7); }

template <class Epi, class Sched, bool FP8 = false>
__device__ __forceinline__ void gemm_phase(LAS unsigned char* lds, const int K, const Sched& S, const Epi& E, const __amdgpu_buffer_rsrc_t rs) {
    const int tid = fresh_tid(), wid = __builtin_amdgcn_readfirstlane(tid >> 6), lane = tid & 63, wr = wid >> 2, wc = wid & 3, fr = lane & 15, fq = lane >> 4;
    const int nt = FP8 ? K / 128 : K / BK;
    int RA[2], CA[2];
    unsigned voffA[4], voffB[2];
#pragma unroll
    for (int i = 0; i < 2; ++i) { int R, C; stage_rc(tid * 16 + i * 8192, R, C); RA[i] = R; CA[i] = C; const int Rb = Epi::PERM ? ((R & ~31) + perm32(R & 31)) : R;
        voffB[i] = (unsigned)(Rb * S.pb + C * 2); }
    const unsigned kstep = (unsigned)(BK * 2);
    const unsigned hstepB = (unsigned)(HALF * S.pb), hstepA = (unsigned)(HALF * S.pa);
    const unsigned ldsw = (unsigned)wid * 1024u;
    const int aoff = lds_byte(wr * 64 + fr, fq * 8), boff = lds_byte(wc * 32 + fr, fq * 8);
    constexpr int kpiece = 1024;
#define PG8_SA(b, h) (((b) * 2 + (h)) * HTB)
#define PG8_SB(b, h) ((4 + (b) * 2 + (h)) * HTB)
#define PG8_STAGE_B(bufoff, gbase) do { _Pragma("unroll") for (int _i = 0; _i < 2; ++_i) \
        __builtin_amdgcn_raw_ptr_buffer_load_lds(rs, (LAS unsigned*)(lds + (bufoff) + ldsw + _i * 8192), 16, (int)voffB[_i], (int)(gbase), 0, 0); } while (0)
#define PG8_STAGE_A(bufoff, gbase, h) do { _Pragma("unroll") for (int _i = 0; _i < 2; ++_i) \
        __builtin_amdgcn_raw_ptr_buffer_load_lds(rs, (LAS unsigned*)(lds + (bufoff) + ldsw + _i * 8192), 16, (int)voffA[Sched::GATHER ? (h) * 2 + _i : _i], (int)((gbase) + (Sched::GATHER ? 0u : (unsigned)(h) * hstepA)), 0, 0); } while (0)
#define PG8_LDA(dst, b, h) do { _Pragma("unroll") for (int m = 0; m < 4; ++m) _Pragma("unroll") for (int k = 0; k < 2; ++k) dst[m][k] = *(const LAS bf16x8*)(lds + PG8_SA(b, h) + aoff + m * 2048 + k * kpiece); } while (0)
#define PG8_LDB(dst, b, h) do { _Pragma("unroll") for (int n = 0; n < 2; ++n) _Pragma("unroll") for (int k = 0; k < 2; ++k) dst[n][k] = *(const LAS bf16x8*)(lds + PG8_SB(b, h) + boff + n * 2048 + k * kpiece); } while (0)
#define PG8_MMA(ai, bj, At, Bt) do { __builtin_amdgcn_s_setprio(1); if constexpr (FP8) { _Pragma("unroll") for (int m = 0; m < 4; ++m) _Pragma("unroll") for (int n = 0; n < 2; ++n) \
        acc[ai][bj][m][n] = __builtin_amdgcn_mfma_scale_f32_16x16x128_f8f6f4(frag8(Bt[n][0], Bt[n][1]), frag8(At[m][0], At[m][1]), acc[ai][bj][m][n], 0, 0, 0, 0x7C7C7C7C, 0, 0x7C7C7C7C); } \
      else { _Pragma("unroll") for (int m = 0; m < 4; ++m) _Pragma("unroll") for (int n = 0; n < 2; ++n) _Pragma("unroll") for (int k = 0; k < 2; ++k) \
        acc[ai][bj][m][n] = __builtin_amdgcn_mfma_f32_16x16x32_bf16(Bt[n][k], At[m][k], acc[ai][bj][m][n], 0, 0, 0); } __builtin_amdgcn_s_setprio(0); } while (0)
#define PG8_MMA2(ai, At) do { if constexpr (Sched::BLOCKDIAG) { if (lo_half) PG8_MMA(ai, 0, At, B0); else PG8_MMA(ai, 1, At, B1); } else { PG8_MMA(ai, 0, At, B0); PG8_MMA(ai, 1, At, B1); } } while (0)
#define PG8_WAIT_V(n) asm volatile("s_waitcnt vmcnt(" #n ")" ::: "memory")
#define PG8_WAIT_L(n) asm volatile("s_waitcnt lgkmcnt(" #n ")" ::: "memory")
#define PG8_BAR __builtin_amdgcn_s_barrier()
#define PG8_SCHED __builtin_amdgcn_sched_barrier(0)
    Unit cur, nxt; int ui = 0;
    if (!S.next(0, cur)) return;
    S.offs(cur, RA, CA, voffA);
    f32x4 acc[2][2][4][2];
#pragma unroll
    for (int a = 0; a < 2; ++a)
#pragma unroll
        for (int b = 0; b < 2; ++b)
#pragma unroll
            for (int m = 0; m < 4; ++m)
#pragma unroll
                for (int n = 0; n < 2; ++n) acc[a][b][m][n] = (f32x4){0.f, 0.f, 0.f, 0.f};
    bf16x8 At[4][2], B0[2][2], B1[2][2];
    unsigned cA = cur.a, cB = cur.b;
    PG8_STAGE_B(PG8_SB(0, 0), cB); PG8_STAGE_B(PG8_SB(0, 1), cB + hstepB); PG8_STAGE_A(PG8_SA(0, 0), cA, 0); PG8_STAGE_A(PG8_SA(0, 1), cA, 1);
    if (wr == 1) PG8_BAR;
    PG8_WAIT_V(2); PG8_BAR;
    PG8_STAGE_B(PG8_SB(1, 0), cB + kstep); PG8_STAGE_A(PG8_SA(1, 0), cA + kstep, 0); PG8_STAGE_B(PG8_SB(1, 1), cB + hstepB + kstep);
    PG8_WAIT_V(6); PG8_BAR;
    for (;;) {
        const bool has_next = S.next(ui + 1, nxt);
        const unsigned nA = has_next ? nxt.a : cA, nB = has_next ? nxt.b : cB;
        unsigned nvoff[4];
        if constexpr (Sched::GATHER) { if (has_next) S.rows(nxt, RA, nvoff); }
#pragma nounroll
        for (int t = 0; t < nt; t += 2) {
            const bool last = (t == nt - 2), lo_half = t < (nt >> 1);
            const unsigned a1 = cA + (unsigned)(t + 1) * kstep;
            const unsigned a2 = last ? nA : cA + (unsigned)(t + 2) * kstep, b2 = last ? nB : cB + (unsigned)(t + 2) * kstep;
            const unsigned a3 = a2 + kstep, b3 = b2 + kstep;
            PG8_LDB(B0, 0, 0); PG8_LDB(B1, 0, 1); PG8_SCHED; PG8_LDA(At, 0, 0); PG8_STAGE_A(PG8_SA(1, 1), a1, 1);
            PG8_WAIT_V(8); PG8_WAIT_L(0); PG8_BAR; PG8_MMA2(0, At); PG8_BAR; PG8_SCHED;
            if constexpr (Sched::GATHER) { if (last && has_next) {
#pragma unroll
                for (int q = 0; q < 4; ++q) voffA[q] = nvoff[q] * (unsigned)S.pa + (unsigned)(CA[q & 1] * 2); } }
            PG8_LDA(At, 0, 1); PG8_STAGE_B(PG8_SB(0, 0), b2); PG8_STAGE_B(PG8_SB(0, 1), b2 + hstepB); PG8_STAGE_A(PG8_SA(0, 0), a2, 0);
            PG8_WAIT_V(8); PG8_WAIT_L(0); PG8_BAR; PG8_MMA2(1, At); PG8_BAR; PG8_SCHED;
            PG8_LDB(B0, 1, 0); PG8_LDB(B1, 1, 1); PG8_SCHED; PG8_LDA(At, 1, 0); PG8_STAGE_A(PG8_SA(0, 1), a2, 1);
            PG8_WAIT_V(8); PG8_WAIT_L(0); PG8_BAR; PG8_MMA2(0, At); PG8_BAR; PG8_SCHED;
            PG8_LDA(At, 1, 1); PG8_STAGE_B(PG8_SB(1, 0), b3); PG8_STAGE_B(PG8_SB(1, 1), b3 + hstepB); PG8_STAGE_A(PG8_SA(1, 0), a3, 0);
            PG8_WAIT_V(8); PG8_WAIT_L(0); PG8_BAR; PG8_MMA2(1, At); PG8_BAR; PG8_SCHED;
        }
        if (wr == 0) PG8_BAR;
        { const int t2 = fresh_tid() & 63; E(acc, cur, wr, wc, t2 & 15, t2 >> 4, lds + LDS_EPI); }
        if (!has_next) break;
#pragma unroll
        for (int a = 0; a < 2; ++a)
#pragma unroll
            for (int b = 0; b < 2; ++b)
#pragma unroll
                for (int m = 0; m < 4; ++m)
#pragma unroll
                    for (int n = 0; n < 2; ++n) acc[a][b][m][n] = (f32x4){0.f, 0.f, 0.f, 0.f};
        cur = nxt; cA = nA; cB = nB; ++ui;
        if (wr == 1) PG8_BAR;
    }
    PG8_WAIT_V(0);
    PG8_BAR;
#undef PG8_SA
#undef PG8_SB
#undef PG8_STAGE_A
#undef PG8_STAGE_B
#undef PG8_LDA
#undef PG8_LDB
#undef PG8_MMA
#undef PG8_MMA2
#undef PG8_WAIT_V
#undef PG8_WAIT_L
#undef PG8_BAR
#undef PG8_SCHED
}

struct DenseSched {
    static constexpr bool GATHER = false, BLOCKDIAG = false;
    int nM, nN, nwg, G, c; int pa, pb; unsigned A, B;
    __device__ void init(int M, int N, int G_, int c_, size_t A_, int pa_, size_t B_, int pb_) { nM = M / BM; nN = N / BM; nwg = nM * nN; G = G_; c = c_; A = (unsigned)A_; B = (unsigned)B_; pa = pa_; pb = pb_; }
    __device__ __forceinline__ bool next(int i, Unit& u) const {
        const long L = (long)i * G + c; if (L >= nwg) return false;
        int wgid = (int)L; { const int q = nwg / NXCD, r = nwg % NXCD, xcd = wgid % NXCD, off = wgid / NXCD; wgid = (xcd < r ? xcd * (q + 1) : r * (q + 1) + (xcd - r) * q) + off; }
        const int nig = WGM * nN, gid = wgid / nig, fm = gid * WGM, gsz = (nM - fm) < WGM ? (nM - fm) : WGM;
        u.pm = fm + ((wgid % nig) % gsz); u.pn = (wgid % nig) / gsz; u.aux = 0;
        u.a = A + (unsigned)(u.pm * BM * pa); u.b = B + (unsigned)(u.pn * BM * pb); return true;
    }
    __device__ __forceinline__ void offs(const Unit&, const int (&RA)[2], const int (&CA)[2], unsigned (&v)[4]) const {
#pragma unroll
        for (int h = 0; h < 2; ++h)
#pragma unroll
            for (int i = 0; i < 2; ++i) v[h * 2 + i] = (unsigned)((h * HALF + RA[i]) * pa + CA[i] * 2);
    }
};
struct DiagSched : DenseSched { static constexpr bool BLOCKDIAG = true; };
}

struct Params { const float* in[21]; float* out; unsigned char* ws; int ph_lo, ph_hi; };
enum { I_X = 0, I_C, I_POS, I_WADA, I_BADA, I_GMIX, I_GFFN, I_WIN, I_WBG, I_QG, I_KG, I_WBD, I_WBS, I_WOUT, I_WRG, I_BRG, I_WRE, I_BRE, I_WEG, I_WEU, I_WED };

struct Frame {
    LAS unsigned char* lds;
    unsigned char* ws;
    int wave, G, bid;
};

template <bool FP8>
DI void p0_transpose_item(const float* W, int N, void* WTv, int ldt, int k0, int n0, int row_base, LAS float* scr, int lane) {
#pragma unroll 8
    for (int i = 0; i < 32; ++i) { const int kk = 2 * i + (lane >> 5); scr[kk * 33 + (lane & 31)] = W[(size_t)(k0 + kk) * N + n0 + (lane & 31)]; }
    LDS_WAIT();
    const int c = lane & 7;
#pragma unroll
    for (int j = 0; j < 4; ++j) { const int n = (lane >> 3) + 8 * j; const LAS float* sp = scr + (8 * c) * 33 + n;
        if (FP8) { u32x2 o; o.x = pk4_fp8(64.f * sp[0 * 33], 64.f * sp[1 * 33], 64.f * sp[2 * 33], 64.f * sp[3 * 33]); o.y = pk4_fp8(64.f * sp[4 * 33], 64.f * sp[5 * 33], 64.f * sp[6 * 33], 64.f * sp[7 * 33]);
            *(u32x2*)((unsigned char*)WTv + (size_t)(row_base + n) * ldt + k0 + 8 * c) = o; }
        else { u32x4 o; o.x = pk2(sp[0 * 33], sp[1 * 33]); o.y = pk2(sp[2 * 33], sp[3 * 33]); o.z = pk2(sp[4 * 33], sp[5 * 33]); o.w = pk2(sp[6 * 33], sp[7 * 33]);
            *(u32x4*)((bf16_t*)WTv + (size_t)(row_base + n) * ldt + k0 + 8 * c) = o; } }
    LDS_WAIT();
}
DI void phase0(const Frame& F, const Params& p) {
    const int tid_ = fresh_tid(), lane_ = tid_ & 63;
    LAS float* scr = (LAS float*)(F.lds + F.wave * 16384);
    const int gw = F.bid * 8 + F.wave, NGW = F.G * 8;
    bf16_t* W1 = (bf16_t*)(F.ws + WS_W1); bf16_t* WB = (bf16_t*)(F.ws + WS_WB); bf16_t* WO = (bf16_t*)(F.ws + WS_WO);
    unsigned char* WG8 = F.ws + WS_WG8; unsigned char* WGU = F.ws + WS_WGU; unsigned char* WDN = F.ws + WS_WDN;
    constexpr int I1 = 16 * 96, I2 = 16 * 64, I3 = 4 * 32, I4 = 4 * 32, I5 = 16 * 32, I6 = 32 * 256, I7 = 32 * 256, I8 = 32 * 256;
    constexpr int NITEMS = I1 + I2 + I3 + I4 + I5 + I6 + I7 + I8;
    for (int it = gw; it < NITEMS; it += NGW) {
        int r = it;
        if (r < I1) { const int kb = r / 96, nb = r % 96, n0 = 32 * nb, o0 = n0 & 255, rb = (n0 & ~255) + 128 * ((o0 >> 5) & 1) + 32 * (o0 >> 6);
            if (nb < 72) p0_transpose_item<true>(p.in[I_WIN], 3072, F.ws + WS_W1D8, 1024, 64 * kb, n0, rb, scr, lane_); else p0_transpose_item<false>(p.in[I_WIN], 3072, W1, 1024, 64 * kb, n0, rb, scr, lane_); continue; } r -= I1;
        if (r < I2) { const int kb = r / 64, nb = r % 64; p0_transpose_item<true>(p.in[I_WBG], 2048, WG8, 1024, 64 * kb, 32 * nb, 32 * nb, scr, lane_); continue; } r -= I2;
        if (r < I3) { const int kb = r / 32, nb = r % 32, n0 = 32 * nb; p0_transpose_item<true>(p.in[I_WBD], 1024, (unsigned char*)WB, 512, 64 * kb, n0, (n0 >> 7) * 256 + (n0 & 127), scr, lane_); continue; } r -= I3;
        if (r < I4) { const int kb = r / 32, nb = r % 32, n0 = 32 * nb; p0_transpose_item<true>(p.in[I_WBS], 1024, (unsigned char*)WB + 256, 512, 64 * kb, n0, (n0 >> 7) * 256 + 128 + (n0 & 127), scr, lane_); continue; } r -= I4;
        if (r < I5) { const int kb = r / 32, nb = r % 32; p0_transpose_item<true>(p.in[I_WOUT], 1024, WO, 1024, 64 * kb, 32 * nb, 32 * nb, scr, lane_); continue; } r -= I5;
        if (r < I6) { const int e = r >> 8, q = r & 255, kb = q >> 4, nb = q & 15, n0 = 32 * nb;
            p0_transpose_item<true>(p.in[I_WEG] + (size_t)e * 1024 * 512, 512, WGU + (size_t)e * 1024 * 1024, 1024, 64 * kb, n0, (n0 >> 7) * 256 + (n0 & 127), scr, lane_); continue; } r -= I6;
        if (r < I7) { const int e = r >> 8, q = r & 255, kb = q >> 4, nb = q & 15, n0 = 32 * nb;
            p0_transpose_item<true>(p.in[I_WEU] + (size_t)e * 1024 * 512, 512, WGU + (size_t)e * 1024 * 1024, 1024, 64 * kb, n0, (n0 >> 7) * 256 + 128 + (n0 & 127), scr, lane_); continue; } r -= I7;
        { const int e = r >> 8, q = r & 255, kb = q >> 5, nb = q & 31, n0 = 32 * nb, o0 = n0 & 255;
            p0_transpose_item<true>(p.in[I_WED] + (size_t)e * 512 * 1024, 1024, WDN + (size_t)e * 1024 * 512, 512, 64 * kb, n0, (n0 & ~255) + 128 * ((o0 >> 5) & 1) + 32 * (o0 >> 6), scr, lane_); }
    }
    {
        unsigned char* WBz = F.ws + WS_WB;
        for (int idx = F.bid * 512 + tid_; idx < 2048 * 16; idx += F.G * 512) { const int row = idx >> 4, c = idx & 15; *(u32x4*)(WBz + (size_t)row * 512 + ((row & 128) ? 0 : 256) + c * 16) = (u32x4){0u, 0u, 0u, 0u}; }
    }
    {
        float* modp = (float*)(F.ws + WS_MODP); const float* c = p.in[I_C]; const float* wada = p.in[I_WADA];
        for (int task = gw; task < 96 * 8; task += NGW) {
            const int ct = task % 96, ks = task / 96, k0 = ks * 128;
#pragma unroll
            for (int i = 0; i < 16; ++i) { const int idx = i * 64 + lane_, b = idx >> 7, k = idx & 127; const float v = c[b * 1024 + k0 + k]; scr[idx] = v * sigmoidf(v); }
            LDS_WAIT();
            float acc[8];
#pragma unroll
            for (int b = 0; b < 8; ++b) acc[b] = 0.f;
            const float* wp = wada + (size_t)k0 * 6144 + ct * 64 + lane_;
#pragma unroll 8
            for (int k = 0; k < 128; ++k) { const float w = wp[(size_t)k * 6144];
#pragma unroll
                for (int b = 0; b < 8; ++b) acc[b] += scr[b * 128 + k] * w; }
#pragma unroll
            for (int b = 0; b < 8; ++b) modp[((size_t)ks * 8 + b) * 6144 + ct * 64 + lane_] = acc[b];
            LDS_WAIT();
        }
    }
}

DI float inv_freq_of(int i) {
    return i == 0 ? 1.0f : i == 1 ? 0.1939227432012558f : i == 2 ? 0.03760603070259094f : i == 3 ? 0.007292664609849453f : i == 4 ? 0.0014142135623842478f : i == 5 ? 0.00027424818836152554f : i == 6 ? 5.318296098266728e-05f : 1.0313386155758053e-05f;
}
template <int WHICH>
DI void phase_norm(const Frame& F, const Params& p) {
    const int tid_ = fresh_tid(), lane_ = tid_ & 63;
    LAS float* gs = (LAS float*)(F.lds); LAS float* sh = gs + 1024;
    const float* modp = (const float*)(F.ws + WS_MODP); float* mod = (float*)(F.ws + WS_MOD); const float* bada = p.in[I_BADA];
    const float* xin = p.in[I_X]; const bf16_t* upd = (const bf16_t*)(F.ws + WS_UPD1); bf16_t* hout = (bf16_t*)(F.ws + (WHICH == 0 ? WS_H : WS_H2)); unsigned* h8 = (unsigned*)(F.ws + (WHICH == 0 ? WS_H8 : WS_H28));
    const float* gn = p.in[WHICH == 0 ? I_GMIX : I_GFFN];
    for (int chunk = F.bid; chunk < T / 256; chunk += F.G) {
        const int b = chunk >> 5;
        __syncthreads();
        if (WHICH == 0) {
            if (tid_ < 192) { const int j = (chunk & 31) * 192 + tid_; float s = bada[j];
#pragma unroll
                for (int ks = 0; ks < 8; ++ks) s += modp[((size_t)ks * 8 + b) * 6144 + j];
                mod[b * 6144 + j] = s; }
            for (int col = tid_; col < 1024; col += 512) { float s1 = bada[col], s2 = bada[1024 + col];
#pragma unroll
                for (int ks = 0; ks < 8; ++ks) { s1 += modp[((size_t)ks * 8 + b) * 6144 + col]; s2 += modp[((size_t)ks * 8 + b) * 6144 + 1024 + col]; }
                gs[col] = gn[col] * (1.f + s2); sh[col] = s1; }
        } else {
            for (int col = tid_; col < 1024; col += 512) { gs[col] = gn[col] * (1.f + mod[b * 6144 + 4096 + col]); sh[col] = mod[b * 6144 + 3072 + col]; }
        }
        __syncthreads();
        f32x4 g4[4], s4[4];
#pragma unroll
        for (int j = 0; j < 4; ++j) { g4[j] = *(const LAS f32x4*)(gs + 256 * j + 4 * lane_); s4[j] = *(const LAS f32x4*)(sh + 256 * j + 4 * lane_); }
        for (int rr = F.wave; rr < 256; rr += 8) {
            const int row = chunk * 256 + rr;
            const f32x4* xr = (const f32x4*)(xin + (size_t)row * 1024) + lane_;
            f32x4 v[4]; float ss = 0.f;
#pragma unroll
            for (int j = 0; j < 4; ++j) v[j] = xr[64 * j];
            if (WHICH == 1) { const u32x2* ur = (const u32x2*)(upd + (size_t)row * 1024) + lane_; u32x2 uu[4];
#pragma unroll
                for (int j = 0; j < 4; ++j) uu[j] = ur[64 * j];
#pragma unroll
                for (int j = 0; j < 4; ++j) { v[j].x += bf_lo(uu[j].x); v[j].y += bf_hi(uu[j].x); v[j].z += bf_lo(uu[j].y); v[j].w += bf_hi(uu[j].y); } }
#pragma unroll
            for (int j = 0; j < 4; ++j) ss += (v[j].x * v[j].x + v[j].y * v[j].y) + (v[j].z * v[j].z + v[j].w * v[j].w);
            const float rinv = __builtin_amdgcn_rsqf(wave_sum(ss) * (1.f / 1024.f) + RMS_EPS);
            u32x2* o8 = (u32x2*)(hout + (size_t)row * 1024) + lane_;
            if (WHICH == 0) { u32x2* xb8 = (u32x2*)((bf16_t*)(F.ws + WS_UPD1) + (size_t)row * 1024) + lane_;
#pragma unroll
                for (int j = 0; j < 4; ++j) { u32x2 o; o.x = pk2(v[j].x, v[j].y); o.y = pk2(v[j].z, v[j].w); xb8[64 * j] = o; } }
#pragma unroll
            for (int j = 0; j < 4; ++j) { const f32x4 y = v[j] * rinv * g4[j] + s4[j]; u32x2 o; o.x = pk2(y.x, y.y); o.y = pk2(y.z, y.w); o8[64 * j] = o; h8[(size_t)row * 256 + 64 * j + lane_] = pk4_fp8(y.x, y.y, y.z, y.w); }
            if (WHICH == 0 && lane_ < 8) {
                const int pos = ((const int*)p.in[I_POS])[row];
                const float angf = (float)pos * inv_freq_of(lane_);
                double rv = (double)angf * 0.15915494309189535; rv -= __builtin_rint(rv);
                const float fr = (float)rv;
                bf16_t* rp = (bf16_t*)(F.ws + WS_ROPE) + (size_t)row * 16;
                rp[lane_] = (bf16_t)(pk2(__builtin_amdgcn_cosf(fr), 0.f) & 0xffffu); rp[8 + lane_] = (bf16_t)(pk2(__builtin_amdgcn_sinf(fr), 0.f) & 0xffffu);
            }
        }
    }
}

template <bool GATES> struct EpiProj {
    static constexpr bool PERM = true;
    bf16_t* proj; bf16_t* gates; const bf16_t* rope; const float* qg; const float* kg; int pn0;
    DI void operator()(const f32x4 (&acc)[2][2][4][2], const pg8::Unit& u, int wr, int wc, int fr, int fq, LAS unsigned char* scr) const {
        asm volatile("" : "+v"(fr), "+v"(fq));
        const int pn = u.pn + pn0, row0 = u.pm * 256 + wr * 64 + fr, cw = wc * 32 + 8 * fq;
        const int typ = pn < 9 ? pn / 3 : pn - 9, grp = pn < 9 ? pn % 3 : 0, l2d = pn < 9 ? 2 * grp : 0, hbase = pn < 9 ? grp * 4 : 12;
        if (GATES) {
            unsigned char* base = (unsigned char*)gates + (size_t)(u.pm * 8 + pn) * 65536 + (size_t)(((wr * 4 + wc) * 64 + fq * 16 + fr) * 8);
#pragma unroll
            for (int ai = 0; ai < 2; ++ai)
#pragma unroll
                for (int m = 0; m < 4; ++m)
#pragma unroll
                    for (int bj = 0; bj < 2; ++bj) { const f32x4 v0 = acc[ai][bj][m][0], v1 = acc[ai][bj][m][1];
                        u32x2 w; w.x = pk4_fp8(v0.x, v0.y, v0.z, v0.w); w.y = pk4_fp8(v1.x, v1.y, v1.z, v1.w);
                        *(u32x2*)(base + ((ai * 4 + m) * 2 + bj) * 4096) = w; }
        } else if (pn >= 6 || pn < 3) {
            const float sc = pn == 9 ? QSCALE : 1.f;
            const int head = hbase + wc;
#pragma unroll
            for (int ai = 0; ai < 2; ++ai)
#pragma unroll
                for (int m = 0; m < 4; ++m) { const int t = row0 + ai * 128 + m * 16, sq = t & (S - 1); const int rp = (t & ~(S - 1)) + ((sq & ((1 << l2d) - 1)) << (13 - l2d)) + (sq >> l2d);
                    bf16_t* rowp = proj + ((size_t)(typ * 16 + head) * T + rp) * 64 + 8 * fq;
#pragma unroll
                    for (int bj = 0; bj < 2; ++bj) { const f32x4 v0 = acc[ai][bj][m][0] * sc, v1 = acc[ai][bj][m][1] * sc;
                        u32x4 w; w.x = pk2(v0.x, v0.y); w.y = pk2(v0.z, v0.w); w.z = pk2(v1.x, v1.y); w.w = pk2(v1.z, v1.w);
                        *(u32x4*)(rowp + 32 * bj) = w; } }
        } else {
            const int head = hbase + wc;
            const f32x4 g0 = *(const f32x4*)(kg + 8 * fq), g1 = *(const f32x4*)(kg + 8 * fq + 4), g2 = *(const f32x4*)(kg + 32 + 8 * fq), g3 = *(const f32x4*)(kg + 32 + 8 * fq + 4);
            u32x4 rcsa[2][4];
#pragma unroll
            for (int ai = 0; ai < 2; ++ai)
#pragma unroll
                for (int m = 0; m < 4; ++m) { const u32x4* rpt = (const u32x4*)(rope + (size_t)(u.pm * 256 + ai * 128 + wr * 64 + m * 16 + fr) * 16); rcsa[ai][m] = rpt[fq & 1]; }
            __builtin_amdgcn_sched_barrier(0);
#pragma unroll
            for (int ai = 0; ai < 2; ++ai) {
#pragma unroll
                for (int m = 0; m < 4; ++m) { const int row = u.pm * 256 + ai * 128 + wr * 64 + m * 16 + fr, sq = row & (S - 1);
                    const int rp = (row & ~(S - 1)) + ((sq & ((1 << l2d) - 1)) << (13 - l2d)) + (sq >> l2d);
                    const f32x4 a0 = acc[ai][0][m][0], a1 = acc[ai][0][m][1], b0 = acc[ai][1][m][0], b1 = acc[ai][1][m][1];
                    float ss = ((a0.x * a0.x + a0.y * a0.y) + (a0.z * a0.z + a0.w * a0.w)) + ((a1.x * a1.x + a1.y * a1.y) + (a1.z * a1.z + a1.w * a1.w))
                             + ((b0.x * b0.x + b0.y * b0.y) + (b0.z * b0.z + b0.w * b0.w)) + ((b1.x * b1.x + b1.y * b1.y) + (b1.z * b1.z + b1.w * b1.w));
                    { const unsigned sb_ = __builtin_bit_cast(unsigned, ss); auto r = __builtin_amdgcn_permlane16_swap(sb_, sb_, false, false); const unsigned r0 = r[0], r1 = r[1]; ss = __builtin_bit_cast(float, r0) + __builtin_bit_cast(float, r1); }
                    { const unsigned sb_ = __builtin_bit_cast(unsigned, ss); auto r = __builtin_amdgcn_permlane32_swap(sb_, sb_, false, false); const unsigned r0 = r[0], r1 = r[1]; ss = __builtin_bit_cast(float, r0) + __builtin_bit_cast(float, r1); }
                    const float rinv = __builtin_amdgcn_rsqf(ss * (1.f / 64.f) + RMS_EPS);
                    f32x4 v0 = a0 * (g0 * rinv), v1 = a1 * (g1 * rinv); const f32x4 v2 = b0 * (g2 * rinv), v3 = b1 * (g3 * rinv);
                    f32x4 c0 = {1.f, 1.f, 1.f, 1.f}, c1 = c0, s0 = {0.f, 0.f, 0.f, 0.f}, s1 = s0;
                    u32x4 cc, sn;
                    { const u32x4 x = rcsa[ai][m]; u32x4 pp;
#define RX16(v) ([&] { const unsigned b_ = (v); auto r = __builtin_amdgcn_permlane16_swap(b_, b_, false, false); const unsigned r0 = r[0], r1 = r[1]; return (fq & 1) ? r0 : r1; }())
                      pp.x = RX16(x.x); pp.y = RX16(x.y); pp.z = RX16(x.z); pp.w = RX16(x.w);
#undef RX16
                      cc = (fq & 1) ? pp : x; sn = (fq & 1) ? x : pp; }
                    if (fq < 2) {
                        c0 = (f32x4){bf_lo(cc.x), bf_hi(cc.x), bf_lo(cc.y), bf_hi(cc.y)}; c1 = (f32x4){bf_lo(cc.z), bf_hi(cc.z), bf_lo(cc.w), bf_hi(cc.w)};
                        s0 = (f32x4){bf_lo(sn.x), bf_hi(sn.x), bf_lo(sn.y), bf_hi(sn.y)}; s1 = (f32x4){bf_lo(sn.z), bf_hi(sn.z), bf_lo(sn.w), bf_hi(sn.w)};
                        if (fq == 0) { s0 = -s0; s1 = -s1; } }
                    f32x4 p0, p1;
#define KX16(x) ([&] { const unsigned b_ = __builtin_bit_cast(unsigned, (float)(x)); auto r = __builtin_amdgcn_permlane16_swap(b_, b_, false, false); const unsigned r0 = r[0], r1 = r[1]; return __builtin_bit_cast(float, (fq & 1) ? r0 : r1); }())
                    p0.x = KX16(v0.x); p0.y = KX16(v0.y); p0.z = KX16(v0.z); p0.w = KX16(v0.w);
                    p1.x = KX16(v1.x); p1.y = KX16(v1.y); p1.z = KX16(v1.z); p1.w = KX16(v1.w);
#undef KX16
                    v0 = v0 * c0 + p0 * s0; v1 = v1 * c1 + p1 * s1;
                    bf16_t* rowp = proj + ((size_t)(typ * 16 + head) * T + rp) * 64 + 8 * fq;
                    u32x4 w; w.x = pk2(v0.x, v0.y); w.y = pk2(v0.z, v0.w); w.z = pk2(v1.x, v1.y); w.w = pk2(v1.z, v1.w);
                    *(u32x4*)rowp = w;
                    w.x = pk2(v2.x, v2.y); w.y = pk2(v2.z, v2.w); w.z = pk2(v3.x, v3.y); w.w = pk2(v3.z, v3.w);
                    *(u32x4*)(rowp + 32) = w; }
            }
        }
    }
};

struct EpiBranch {
    static constexpr bool PERM = true;
    const unsigned char* gates; unsigned char* merged;
    DI void operator()(const f32x4 (&acc)[2][2][4][2], const pg8::Unit& u, int wr, int wc, int fr, int fq, LAS unsigned char*) const {
        asm volatile("" : "+v"(fr), "+v"(fq));
        const int row0 = u.pm * 256 + wr * 64 + fr, col0 = u.pn * 128 + wc * 32 + 8 * fq;
        const unsigned char* gbase = gates + (size_t)(u.pm * 8 + (u.pn >> 1)) * 65536 + (size_t)((u.pn & 1) * 4096) + (size_t)(((wr * 4 + wc) * 64 + fq * 16 + fr) * 8);
        u32x2 gd[2][4], gs[2][4];
#pragma unroll
        for (int ai = 0; ai < 2; ++ai)
#pragma unroll
            for (int m = 0; m < 4; ++m) { const unsigned char* gp = gbase + ((ai * 4 + m) * 2) * 4096;
                gd[ai][m] = *(const u32x2*)gp; gs[ai][m] = *(const u32x2*)(gp + 4 * 65536); }
        __builtin_amdgcn_sched_barrier(0);
#pragma unroll
        for (int ai = 0; ai < 2; ++ai)
#pragma unroll
            for (int m = 0; m < 4; ++m) { const size_t row = (size_t)(row0 + ai * 128 + m * 16);
                const u32x2 g = gd[ai][m], q = gs[ai][m];
                const f32x2 ga = fp8_lo2(g.x), gb = fp8_hi2(g.x), gc = fp8_lo2(g.y), gdd = fp8_hi2(g.y), qa = fp8_lo2(q.x), qb = fp8_hi2(q.x), qc = fp8_lo2(q.y), qd = fp8_hi2(q.y);
                const f32x4 v0 = acc[ai][0][m][0] * (f32x4){sigmoidf(ga.x), sigmoidf(ga.y), sigmoidf(gb.x), sigmoidf(gb.y)} + acc[ai][1][m][0] * (f32x4){sigmoidf(qa.x), sigmoidf(qa.y), sigmoidf(qb.x), sigmoidf(qb.y)};
                const f32x4 v1 = acc[ai][0][m][1] * (f32x4){sigmoidf(gc.x), sigmoidf(gc.y), sigmoidf(gdd.x), sigmoidf(gdd.y)} + acc[ai][1][m][1] * (f32x4){sigmoidf(qc.x), sigmoidf(qc.y), sigmoidf(qd.x), sigmoidf(qd.y)};
                u32x2 w; w.x = pk4_fp8(8.f * v0.x, 8.f * v0.y, 8.f * v0.z, 8.f * v0.w); w.y = pk4_fp8(8.f * v1.x, 8.f * v1.y, 8.f * v1.z, 8.f * v1.w);
                *(u32x2*)(merged + row * 1024 + col0) = w; }
    }
};
struct BranchSched {
    static constexpr bool GATHER = false;
    int G, c; int pa, pb; unsigned A, B;
    DI bool next(int i, pg8::Unit& u) const {
        const int tile = (i >> 1) * G + c; if (tile >= 256 * 4) return false;
        u.pm = tile >> 2; u.pn = tile & 3; u.aux = i & 1;
        u.a = A + (unsigned)(u.pm * 256 * LDO * 2 + u.aux * 256 * 2); u.b = B + (unsigned)(u.aux * 1024 * 256 * 2 + u.pn * 256 * 256 * 2); return true;
    }
    DI void offs(const pg8::Unit&, const int (&RA)[2], const int (&CA)[2], unsigned (&v)[4]) const {
#pragma unroll
        for (int h = 0; h < 2; ++h)
#pragma unroll
            for (int i = 0; i < 2; ++i) v[h * 2 + i] = (unsigned)((h * 128 + RA[i]) * pa + CA[i] * 2);
    }
};

struct EpiOut {
    static constexpr bool PERM = true;
    bf16_t* upd; const float* mod;
    DI void operator()(const f32x4 (&acc)[2][2][4][2], const pg8::Unit& u, int wr, int wc, int fr, int fq, LAS unsigned char*) const {
        asm volatile("" : "+v"(fr), "+v"(fq));
        const int row0 = u.pm * 256 + wr * 64 + fr, col0 = u.pn * 256 + wc * 32 + 8 * fq; const int b = (u.pm * 256) >> 13;
        f32x4 gv[2][2];
#pragma unroll
        for (int bj = 0; bj < 2; ++bj)
#pragma unroll
            for (int n = 0; n < 2; ++n) gv[bj][n] = *(const f32x4*)(mod + b * 6144 + 2048 + col0 + bj * 128 + n * 4) * 0.125f;
#pragma unroll
        for (int ai = 0; ai < 2; ++ai) {
            u32x4 xb[4][2];
#pragma unroll
            for (int m = 0; m < 4; ++m)
#pragma unroll
                for (int bj = 0; bj < 2; ++bj) xb[m][bj] = *(const u32x4*)(upd + (size_t)(row0 + ai * 128 + m * 16) * 1024 + col0 + bj * 128);
            __builtin_amdgcn_sched_barrier(0);
#pragma unroll
            for (int m = 0; m < 4; ++m)
#pragma unroll
                for (int bj = 0; bj < 2; ++bj) { const u32x4 x = xb[m][bj];
                    const f32x4 v0 = acc[ai][bj][m][0] * gv[bj][0] + (f32x4){bf_lo(x.x), bf_hi(x.x), bf_lo(x.y), bf_hi(x.y)}, v1 = acc[ai][bj][m][1] * gv[bj][1] + (f32x4){bf_lo(x.z), bf_hi(x.z), bf_lo(x.w), bf_hi(x.w)};
                    u32x4 w; w.x = pk2(v0.x, v0.y); w.y = pk2(v0.z, v0.w); w.z = pk2(v1.x, v1.y); w.w = pk2(v1.z, v1.w);
                    *(u32x4*)(upd + (size_t)(row0 + ai * 128 + m * 16) * 1024 + col0 + bj * 128) = w; }
        }
    }
};

struct EpiLogit {
    static constexpr bool PERM = false;
    float* logit;
    DI void operator()(const f32x4 (&acc)[2][2][4][2], const pg8::Unit& u, int wr, int wc, int fr, int fq, LAS unsigned char*) const {
        asm volatile("" : "+v"(fr), "+v"(fq));
        const int row0 = u.pm * 256 + wr * 64 + fr, col0 = wc * 32 + 4 * fq;
#pragma unroll
        for (int ai = 0; ai < 2; ++ai)
#pragma unroll
            for (int m = 0; m < 4; ++m)
#pragma unroll
                for (int n = 0; n < 2; ++n) *(f32x4*)(logit + (size_t)(row0 + ai * 128 + m * 16) * 128 + col0 + n * 16) = acc[ai][0][m][n];
    }
};

struct MoeSched {
    static constexpr bool GATHER_ = true;
    int G, c, nc; int pa, pb; unsigned A, B; const LAS int* cstart; const int* slot_tok; unsigned estride, pnstride;
};
struct MoeSchedUp : MoeSched {
    static constexpr bool GATHER = true, BLOCKDIAG = false;
    DI bool next(int i, pg8::Unit& u) const {
        const int L = i * G + c; if (L >= nc * 4) return false;
        const int chunk = L >> 2; int e = 0;
        for (int q = 1; q < 32; ++q) e += (chunk >= cstart[q]) ? 1 : 0;
        e = __builtin_amdgcn_readfirstlane(e);
        u.pm = chunk; u.pn = L & 3; u.aux = e; u.a = A; u.b = B + (unsigned)e * estride + (unsigned)u.pn * pnstride; return true;
    }
    DI void offs(const pg8::Unit& u, const int (&RA)[2], const int (&CA)[2], unsigned (&v)[4]) const {
#pragma unroll
        for (int h = 0; h < 2; ++h)
#pragma unroll
            for (int i = 0; i < 2; ++i) { const int tok = slot_tok[u.pm * 256 + h * 128 + RA[i]]; v[h * 2 + i] = (unsigned)(tok * pa + CA[i] * 2); }
    }
    DI void rows(const pg8::Unit& u, const int (&RA)[2], unsigned (&v)[4]) const {
#pragma unroll
        for (int h = 0; h < 2; ++h)
#pragma unroll
            for (int i = 0; i < 2; ++i) v[h * 2 + i] = (unsigned)slot_tok[u.pm * 256 + h * 128 + RA[i]];
    }
};
struct MoeSchedDn : MoeSched {
    static constexpr bool GATHER = false, BLOCKDIAG = false;
    DI bool next(int i, pg8::Unit& u) const {
        const int L = i * G + c; if (L >= nc * 4) return false;
        const int chunk = L >> 2; int e = 0;
        for (int q = 1; q < 32; ++q) e += (chunk >= cstart[q]) ? 1 : 0;
        e = __builtin_amdgcn_readfirstlane(e);
        u.pm = chunk; u.pn = L & 3; u.aux = e; u.a = A + (unsigned)(chunk * 256 * pa); u.b = B + (unsigned)e * estride + (unsigned)u.pn * pnstride; return true;
    }
    DI void offs(const pg8::Unit&, const int (&RA)[2], const int (&CA)[2], unsigned (&v)[4]) const {
#pragma unroll
        for (int h = 0; h < 2; ++h)
#pragma unroll
            for (int i = 0; i < 2; ++i) v[h * 2 + i] = (unsigned)((h * 128 + RA[i]) * pa + CA[i] * 2);
    }
};
struct EpiSwiglu {
    static constexpr bool PERM = true;
    unsigned char* hmid;
    DI void operator()(const f32x4 (&acc)[2][2][4][2], const pg8::Unit& u, int wr, int wc, int fr, int fq, LAS unsigned char*) const {
        asm volatile("" : "+v"(fr), "+v"(fq));
        const int row0 = u.pm * 256 + wr * 64 + fr, col0 = u.pn * 128 + wc * 32 + 8 * fq;
#pragma unroll
        for (int ai = 0; ai < 2; ++ai)
#pragma unroll
            for (int m = 0; m < 4; ++m) {
                f32x4 h[2];
#pragma unroll
                for (int n = 0; n < 2; ++n) { const f32x4 g = acc[ai][0][m][n], up = acc[ai][1][m][n];
                    h[n] = (f32x4){g.x * sigmoidf(g.x) * up.x, g.y * sigmoidf(g.y) * up.y, g.z * sigmoidf(g.z) * up.z, g.w * sigmoidf(g.w) * up.w}; }
                u32x2 w; w.x = pk4_fp8(h[0].x, h[0].y, h[0].z, h[0].w); w.y = pk4_fp8(h[1].x, h[1].y, h[1].z, h[1].w);
                *(u32x2*)(hmid + (size_t)(row0 + ai * 128 + m * 16) * DE + col0) = w; }
    }
};
struct EpiDown {
    static constexpr bool PERM = true;
    unsigned char* y;
    DI void operator()(const f32x4 (&acc)[2][2][4][2], const pg8::Unit& u, int wr, int wc, int fr, int fq, LAS unsigned char*) const {
        asm volatile("" : "+v"(fr), "+v"(fq));
        const int row0 = u.pm * 256 + wr * 64 + fr, col0 = u.pn * 256 + wc * 64 + (fq & 1) * 32 + (fq >> 1) * 16;
#pragma unroll
        for (int ai = 0; ai < 2; ++ai)
#pragma unroll
            for (int m = 0; m < 4; ++m) { const int slot = row0 + ai * 128 + m * 16;
                u32x2 o[2];
#pragma unroll
                for (int bj = 0; bj < 2; ++bj) { const f32x4 v0 = acc[ai][bj][m][0] * 8.f, v1 = acc[ai][bj][m][1] * 8.f; o[bj].x = pk4_fp8(v0.x, v0.y, v0.z, v0.w); o[bj].y = pk4_fp8(v1.x, v1.y, v1.z, v1.w); }
                u32x4 w;
                { auto r = __builtin_amdgcn_permlane16_swap(o[0].x, o[1].x, false, false); w.x = r[0]; w.z = r[1]; }
                { auto r = __builtin_amdgcn_permlane16_swap(o[0].y, o[1].y, false, false); w.y = r[0]; w.w = r[1]; }
                *(u32x4*)(y + (size_t)slot * 1024 + col0) = w; }
    }
};

constexpr int SLOT_BYTES = 8192;
DI f32x16 mfma32(bf16x8 a, bf16x8 b, f32x16 c) { return __builtin_amdgcn_mfma_f32_32x32x16_bf16(a, b, c, 0, 0, 0); }
DI int swz_f(int r) { return (((r >> 1) & 1) << 2) | ((r >> 2) & 3); }
struct AttnLane { unsigned doff[4]; unsigned ka[4]; unsigned va[2][2]; };
DI void attn_lane_init(AttnLane& L, int lane) {
#pragma unroll
    for (int i = 0; i < 4; ++i) { const int r = 8 * i + (lane >> 3), c = (lane & 7) ^ swz_f(r); L.doff[i] = (unsigned)(r * 128 + c * 16); }
    { const int r = lane & 31, h = lane >> 5; const unsigned a0 = (unsigned)(r * 128 + 16 * ((h ^ swz_f(r)) & 7));
#pragma unroll
      for (int s = 0; s < 4; ++s) L.ka[s] = a0 ^ (unsigned)(32 * s); }
    { const int h = lane >> 5, blk = (lane >> 4) & 1, q = (lane & 15) >> 2, p = lane & 3, fb2 = (q >> 1) & 1;
#pragma unroll
      for (int t = 0; t < 2; ++t) { const int flow = (2 * t + h) & 3;
#pragma unroll
        for (int mt = 0; mt < 2; ++mt) L.va[t][mt] = (unsigned)(4096 + (8 * t + 4 * h + q) * 128 + 16 * (4 * (mt ^ fb2) + ((2 * blk + (p >> 1)) ^ flow)) + 8 * (p & 1)); } }
}
DI void dma_tile(const AttnLane& L, const __amdgpu_buffer_rsrc_t rs, unsigned koff, unsigned voff, LAS unsigned char* slot) {
#pragma unroll
    for (int i = 0; i < 4; ++i) __builtin_amdgcn_raw_ptr_buffer_load_lds(rs, (LAS unsigned*)(slot + 1024 * i), 16, (int)L.doff[i], (int)koff, 0, 0);
#pragma unroll
    for (int i = 0; i < 4; ++i) __builtin_amdgcn_raw_ptr_buffer_load_lds(rs, (LAS unsigned*)(slot + 4096 + 1024 * i), 16, (int)L.doff[i], (int)voff, 0, 0);
}
DI void dma_q(const AttnLane& L, const __amdgpu_buffer_rsrc_t rs, unsigned qoff, LAS unsigned char* slot) {
#pragma unroll
    for (int i = 0; i < 4; ++i) __builtin_amdgcn_raw_ptr_buffer_load_lds(rs, (LAS unsigned*)(slot + 1024 * i), 16, (int)L.doff[i], (int)qoff, 0, 0);
}
DI void tr_read8(const AttnLane& L, unsigned sb, bf16x8 (&vf)[2][2]) {
    s16x4 r0, r1, r2, r3, r4, r5, r6, r7;
    const unsigned a00 = sb + L.va[0][0], a10 = sb + L.va[1][0], a01 = sb + L.va[0][1], a11 = sb + L.va[1][1];
    asm volatile("ds_read_b64_tr_b16 %0, %8\n\tds_read_b64_tr_b16 %1, %9\n\tds_read_b64_tr_b16 %2, %8 offset:2048\n\tds_read_b64_tr_b16 %3, %9 offset:2048\n\t"
                 "ds_read_b64_tr_b16 %4, %10\n\tds_read_b64_tr_b16 %5, %11\n\tds_read_b64_tr_b16 %6, %10 offset:2048\n\tds_read_b64_tr_b16 %7, %11 offset:2048\n\ts_waitcnt lgkmcnt(0)"
                 : "=&v"(r0), "=&v"(r1), "=&v"(r2), "=&v"(r3), "=&v"(r4), "=&v"(r5), "=&v"(r6), "=&v"(r7)
                 : "v"(a00), "v"(a10), "v"(a01), "v"(a11) : "memory");
    vf[0][0] = __builtin_shufflevector(r0, r1, 0, 1, 2, 3, 4, 5, 6, 7); vf[0][1] = __builtin_shufflevector(r2, r3, 0, 1, 2, 3, 4, 5, 6, 7);
    vf[1][0] = __builtin_shufflevector(r4, r5, 0, 1, 2, 3, 4, 5, 6, 7); vf[1][1] = __builtin_shufflevector(r6, r7, 0, 1, 2, 3, 4, 5, 6, 7);
}
DI bf16x8 pack8(const f32x16& x, int s) {
    u32x4 p; p.x = pk2(x[8 * s], x[8 * s + 1]); p.y = pk2(x[8 * s + 2], x[8 * s + 3]); p.z = pk2(x[8 * s + 4], x[8 * s + 5]); p.w = pk2(x[8 * s + 6], x[8 * s + 7]);
    return __builtin_bit_cast(bf16x8, p);
}
DI void store_o_row(bf16_t* rowp, const f32x16& O0, const f32x16& O1, float sc, int h) {
#pragma unroll
    for (int mt = 0; mt < 2; ++mt)
#pragma unroll
        for (int kp = 0; kp < 2; ++kp) { const f32x16& O = mt ? O1 : O0; const int g0 = 8 * kp, g1 = 8 * kp + 4;
            u32x2 a, b; a.x = pk2(O[g0] * sc, O[g0 + 1] * sc); a.y = pk2(O[g0 + 2] * sc, O[g0 + 3] * sc); b.x = pk2(O[g1] * sc, O[g1 + 1] * sc); b.y = pk2(O[g1 + 2] * sc, O[g1 + 3] * sc);
            { auto r = __builtin_amdgcn_permlane32_swap(a.x, b.x, false, false); a.x = r[0]; b.x = r[1]; }
            { auto r = __builtin_amdgcn_permlane32_swap(a.y, b.y, false, false); a.y = r[0]; b.y = r[1]; }
            *(u32x4*)(rowp + 32 * mt + 16 * kp + 8 * h) = (u32x4){a.x, a.y, b.x, b.y}; }
}
DI void store_o_row_fp8(unsigned char* rowp, const f32x16& O0, const f32x16& O1, int h) {
#pragma unroll
    for (int mt = 0; mt < 2; ++mt)
#pragma unroll
        for (int kp = 0; kp < 2; ++kp) { const f32x16& O = mt ? O1 : O0; const int g0 = 8 * kp, g1 = 8 * kp + 4;
            unsigned a = pk4_fp8(O[g0], O[g0 + 1], O[g0 + 2], O[g0 + 3]), b = pk4_fp8(O[g1], O[g1 + 1], O[g1 + 2], O[g1 + 3]);
            { auto r = __builtin_amdgcn_permlane32_swap(a, b, false, false); a = r[0]; b = r[1]; }
            *(u32x2*)(rowp + 32 * mt + 16 * kp + 8 * h) = (u32x2){a, b}; }
}
#define ATTN_WAIT_TILE(more) do { if (more) asm volatile("s_waitcnt vmcnt(8)" ::: "memory"); else asm volatile("s_waitcnt vmcnt(0)" ::: "memory"); } while (0)
DI void q_prep(bf16x8 (&qf)[4], const AttnLane& L, LAS unsigned char* qimg, const u32x4 cc, const u32x4 sn, const float* qg, int h) {
    u32x4 qr[4];
#pragma unroll
    for (int s = 0; s < 4; ++s) qr[s] = *(const LAS u32x4*)(qimg + L.ka[s]);
    float qv[4][8]; float ss = 0.f;
#pragma unroll
    for (int s = 0; s < 4; ++s) { const u32x4 u = qr[s]; qv[s][0] = bf_lo(u.x); qv[s][1] = bf_hi(u.x); qv[s][2] = bf_lo(u.y); qv[s][3] = bf_hi(u.y); qv[s][4] = bf_lo(u.z); qv[s][5] = bf_hi(u.z); qv[s][6] = bf_lo(u.w); qv[s][7] = bf_hi(u.w);
#pragma unroll
        for (int e = 0; e < 8; ++e) ss += qv[s][e] * qv[s][e]; }
    ss = xsum32(ss);
    const float rinv = __builtin_amdgcn_rsqf(ss * (1.f / 64.f) + RMS_EPS) * QSCALE;
#pragma unroll
    for (int s = 0; s < 4; ++s) { const f32x4 ga = *(const f32x4*)(qg + 16 * s + 8 * h), gb = *(const f32x4*)(qg + 16 * s + 8 * h + 4);
        qv[s][0] *= rinv * ga.x; qv[s][1] *= rinv * ga.y; qv[s][2] *= rinv * ga.z; qv[s][3] *= rinv * ga.w; qv[s][4] *= rinv * gb.x; qv[s][5] *= rinv * gb.y; qv[s][6] *= rinv * gb.z; qv[s][7] *= rinv * gb.w; }
    { const float cs[8] = {bf_lo(cc.x), bf_hi(cc.x), bf_lo(cc.y), bf_hi(cc.y), bf_lo(cc.z), bf_hi(cc.z), bf_lo(cc.w), bf_hi(cc.w)};
      const float sv[8] = {bf_lo(sn.x), bf_hi(sn.x), bf_lo(sn.y), bf_hi(sn.y), bf_lo(sn.z), bf_hi(sn.z), bf_lo(sn.w), bf_hi(sn.w)};
#pragma unroll
      for (int e = 0; e < 8; ++e) { const float other = xget32(qv[0][e], h); qv[0][e] = qv[0][e] * cs[e] + other * (h ? sv[e] : -sv[e]); } }
#pragma unroll
    for (int s = 0; s < 4; ++s) { u32x4 o; o.x = pk2(qv[s][0], qv[s][1]); o.y = pk2(qv[s][2], qv[s][3]); o.z = pk2(qv[s][4], qv[s][5]); o.w = pk2(qv[s][6], qv[s][7]); qf[s] = __builtin_bit_cast(bf16x8, o); }
}
DI void sm_step(f32x16& sc, float& mrun, float& lrun, f32x16& O0, f32x16& O1, bf16x8& p0, bf16x8& p1) {
    float mx = sc[0];
#pragma unroll
    for (int i = 1; i < 16; ++i) mx = fmaxf(mx, sc[i]);
    mx = xmax32(mx);
    const float mnew = fmaxf(mrun, mx), alpha = fexp2(mrun - mnew);
    float ps = 0.f;
#pragma unroll
    for (int i = 0; i < 16; ++i) { sc[i] = fexp2(sc[i] - mnew); ps += sc[i]; }
    lrun = lrun * alpha + ps; mrun = mnew;
#pragma unroll
    for (int i = 0; i < 16; ++i) { O0[i] *= alpha; O1[i] *= alpha; }
    p0 = pack8(sc, 0); p1 = pack8(sc, 1);
}
DI void dil_pair(const AttnLane& L, const __amdgpu_buffer_rsrc_t rs, const bf16_t* hb, int hd, long row0, int j, LAS unsigned char* ldsW, bf16_t* og, float* lse, int lrow0, int lane, const float* qg, const bf16_t* ropet, long tok0, int dil) {
    const int qi = lane & 31, h = lane >> 5;
    const unsigned kh = (unsigned)(WS_PROJ + ((size_t)(16 + hd) * T + row0) * 128), vh = (unsigned)(WS_PROJ + ((size_t)(32 + hd) * T + row0) * 128);
    const int kt0 = j >= 4 ? j - 4 : 0;
    bf16x8 qa[4], qb[4];
    {
        const unsigned qoff = (unsigned)(WS_PROJ + ((size_t)hd * T + row0 + 32 * j) * 128);
        dma_q(L, rs, qoff, ldsW + SLOT_BYTES); dma_q(L, rs, qoff + 4096u, ldsW + SLOT_BYTES + 4096);
        dma_tile(L, rs, kh + (unsigned)(4096 * kt0), vh + (unsigned)(4096 * kt0), ldsW);
        const u32x4* rpa = (const u32x4*)(ropet + (size_t)(tok0 + (long)dil * (32 * j + qi)) * 16); const u32x4* rpb = (const u32x4*)(ropet + (size_t)(tok0 + (long)dil * (32 * j + 32 + qi)) * 16);
        const u32x4 cca = rpa[0], sna = rpa[1], ccb = rpb[0], snb = rpb[1];
        asm volatile("s_waitcnt vmcnt(8)" ::: "memory");
        q_prep(qa, L, ldsW + SLOT_BYTES, cca, sna, qg, h);
        q_prep(qb, L, ldsW + SLOT_BYTES + 4096, ccb, snb, qg, h);
    }
    float ma = -INFINITY, la = 0.f, mb = -INFINITY, lb = 0.f;
    f32x16 A0, A1, B0, B1;
#pragma unroll
    for (int i = 0; i < 16; ++i) { A0[i] = 0.f; A1[i] = 0.f; B0[i] = 0.f; B1[i] = 0.f; }
    LDS_WAIT();
    unsigned buf = 0;
    for (int kt = kt0; kt <= j + 1; ++kt) {
        const bool more = kt <= j;
        if (more) dma_tile(L, rs, kh + (unsigned)(4096 * (kt + 1)), vh + (unsigned)(4096 * (kt + 1)), ldsW + (buf ^ 1u) * SLOT_BYTES);
        ATTN_WAIT_TILE(more);
        LAS unsigned char* slot = ldsW + buf * SLOT_BYTES;
        const bool useA = kt <= j, useB = kt >= j - 3;
        bf16x8 kf[4];
#pragma unroll
        for (int s = 0; s < 4; ++s) kf[s] = *(const LAS bf16x8*)(slot + L.ka[s]);
        f32x16 sa, sb;
#pragma unroll
        for (int i = 0; i < 16; ++i) { sa[i] = 0.f; sb[i] = 0.f; }
        if (useA) {
#pragma unroll
            for (int s = 0; s < 4; ++s) sa = mfma32(kf[s], qa[s], sa);
        }
        if (useB) {
#pragma unroll
            for (int s = 0; s < 4; ++s) sb = mfma32(kf[s], qb[s], sb);
        }
        if (kt == j) {
#pragma unroll
            for (int i = 0; i < 16; ++i) { const int key = (i & 3) + 8 * (i >> 2) + 4 * h; if (key > qi) sa[i] = -INFINITY; }
        }
        if (kt == j + 1) {
#pragma unroll
            for (int i = 0; i < 16; ++i) { const int key = (i & 3) + 8 * (i >> 2) + 4 * h; if (key > qi) sb[i] = -INFINITY; }
        }
        if (kt == j - 4) {
#pragma unroll
            for (int i = 0; i < 16; ++i) { const int key = (i & 3) + 8 * (i >> 2) + 4 * h; if (key < qi) sa[i] = -INFINITY; }
        }
        if (kt == j - 3) {
#pragma unroll
            for (int i = 0; i < 16; ++i) { const int key = (i & 3) + 8 * (i >> 2) + 4 * h; if (key < qi) sb[i] = -INFINITY; }
        }
        bf16x8 pa0, pa1, pb0, pb1;
        if (useA) sm_step(sa, ma, la, A0, A1, pa0, pa1);
        if (useB) sm_step(sb, mb, lb, B0, B1, pb0, pb1);
        bf16x8 vf[2][2]; tr_read8(L, (unsigned)(size_t)slot, vf);
        if (useA) { A0 = mfma32(vf[0][0], pa0, A0); A0 = mfma32(vf[0][1], pa1, A0); A1 = mfma32(vf[1][0], pa0, A1); A1 = mfma32(vf[1][1], pa1, A1); }
        if (useB) { B0 = mfma32(vf[0][0], pb0, B0); B0 = mfma32(vf[0][1], pb1, B0); B1 = mfma32(vf[1][0], pb0, B1); B1 = mfma32(vf[1][1], pb1, B1); }
        buf ^= 1u;
    }
    {   const float ltot = xsum32(la), inv = frcp(ltot); const int row = lrow0 + qi;
        store_o_row(og + (size_t)row * 64, A0, A1, inv, h);
        if (h == 0) lse[row] = ma + flog2(ltot); }
    {   const float ltot = xsum32(lb), inv = frcp(ltot); const int row = lrow0 + 32 + qi;
        store_o_row(og + (size_t)row * 64, B0, B1, inv, h);
        if (h == 0) lse[row] = mb + flog2(ltot); }
}
DI void sb_step(f32x16& z, float& carry, bool diag, int qi, int h, bf16x8& p0, bf16x8& p1) {
#pragma unroll
    for (int i = 0; i < 16; ++i) z[i] = fexp2(fminf(z[i], 31.f));
    if (diag) {
#pragma unroll
        for (int i = 0; i < 16; ++i) { const int key = (i & 3) + 8 * (i >> 2) + 4 * h; if (key >= qi) z[i] = 0.f; }
    }
    float lg[4], par[4], u0[4], p01[4], p012[4];
#pragma unroll
    for (int g = 0; g < 4; ++g) { const float a0 = 1.f + z[4 * g], a1 = 1.f + z[4 * g + 1], a2 = 1.f + z[4 * g + 2], a3 = 1.f + z[4 * g + 3];
        u0[g] = a0; p01[g] = a0 * a1; p012[g] = p01[g] * a2; lg[g] = -flog2(p012[g] * a3); }
#pragma unroll
    for (int g = 0; g < 4; ++g) par[g] = xget32(lg[g], h);
    float tg[4]; tg[3] = carry; tg[2] = tg[3] + (lg[3] + par[3]); tg[1] = tg[2] + (lg[2] + par[2]); tg[0] = tg[1] + (lg[1] + par[1]);
    carry = tg[0] + (lg[0] + par[0]);
#pragma unroll
    for (int g = 0; g < 4; ++g) { const float suf = tg[g] + lg[g] + (h == 0 ? par[g] : 0.f); const float y = fexp2(suf);
        z[4 * g] = z[4 * g] * y; z[4 * g + 1] = z[4 * g + 1] * (y * u0[g]); z[4 * g + 2] = z[4 * g + 2] * (y * p01[g]); z[4 * g + 3] = z[4 * g + 3] * (y * p012[g]); }
    p0 = pack8(z, 0); p1 = pack8(z, 1);
}
DI void sb_pair(const AttnLane& L, const __amdgpu_buffer_rsrc_t rs, const bf16_t* hb, int b, int h4, int j, LAS unsigned char* ldsW, unsigned char* ocat, int lane) {
    const int qi = lane & 31, h = lane >> 5;
    const long base = (long)b * S;
    const unsigned kh = (unsigned)(WS_PROJ + ((size_t)(16 + 12 + h4) * T + base) * 128), vh = (unsigned)(WS_PROJ + ((size_t)(32 + 12 + h4) * T + base) * 128);
    bf16x8 qa[4], qb[4];
    {
        const unsigned qoff = (unsigned)(WS_PROJ + ((size_t)(12 + h4) * T + base + 32 * j) * 128);
        dma_q(L, rs, qoff, ldsW + SLOT_BYTES); dma_q(L, rs, qoff + 4096u, ldsW + SLOT_BYTES + 4096);
        dma_tile(L, rs, kh + (unsigned)(4096 * (j + 1)), vh + (unsigned)(4096 * (j + 1)), ldsW);
        asm volatile("s_waitcnt vmcnt(8)" ::: "memory");
#pragma unroll
        for (int s = 0; s < 4; ++s) { qa[s] = *(const LAS bf16x8*)(ldsW + SLOT_BYTES + L.ka[s]); qb[s] = *(const LAS bf16x8*)(ldsW + SLOT_BYTES + 4096 + L.ka[s]); }
    }
    float ca = 0.f, cb = 0.f;
    f32x16 A0, A1, B0, B1;
#pragma unroll
    for (int i = 0; i < 16; ++i) { A0[i] = 0.f; A1[i] = 0.f; B0[i] = 0.f; B1[i] = 0.f; }
    bool doneA = false, doneB = false;
    LDS_WAIT();
    unsigned buf = 0;
    for (int kt = j + 1; kt >= 0; --kt) {
        const bool more = kt > 0;
        if (more) dma_tile(L, rs, kh + (unsigned)(4096 * (kt - 1)), vh + (unsigned)(4096 * (kt - 1)), ldsW + (buf ^ 1u) * SLOT_BYTES);
        ATTN_WAIT_TILE(more);
        LAS unsigned char* slot = ldsW + buf * SLOT_BYTES;
        const bool actA = kt <= j && !doneA, actB = !doneB;
        bf16x8 kf[4];
#pragma unroll
        for (int s = 0; s < 4; ++s) kf[s] = *(const LAS bf16x8*)(slot + L.ka[s]);
        f32x16 za, zb;
#pragma unroll
        for (int i = 0; i < 16; ++i) { za[i] = 0.f; zb[i] = 0.f; }
        if (actA) {
#pragma unroll
            for (int s = 0; s < 4; ++s) za = mfma32(kf[s], qa[s], za);
        }
        if (actB) {
#pragma unroll
            for (int s = 0; s < 4; ++s) zb = mfma32(kf[s], qb[s], zb);
        }
        bf16x8 pa0, pa1, pb0, pb1;
        if (actA) sb_step(za, ca, kt == j, qi, h, pa0, pa1);
        if (actB) sb_step(zb, cb, kt == j + 1, qi, h, pb0, pb1);
        bf16x8 vf[2][2]; tr_read8(L, (unsigned)(size_t)slot, vf);
        if (actA) { A0 = mfma32(vf[0][0], pa0, A0); A0 = mfma32(vf[0][1], pa1, A0); A1 = mfma32(vf[1][0], pa0, A1); A1 = mfma32(vf[1][1], pa1, A1); doneA = __all(ca < -40.f); }
        if (actB) { B0 = mfma32(vf[0][0], pb0, B0); B0 = mfma32(vf[0][1], pb1, B0); B1 = mfma32(vf[1][0], pb0, B1); B1 = mfma32(vf[1][1], pb1, B1); doneB = __all(cb < -40.f); }
        if (doneA && doneB) break;
        buf ^= 1u;
    }
    store_o_row_fp8(ocat + (size_t)(base + 32 * j + qi) * LDO + 256 + h4 * 64, A0, A1, h);
    store_o_row_fp8(ocat + (size_t)(base + 32 * j + 32 + qi) * LDO + 256 + h4 * 64, B0, B1, h);
}
DI void phase_attn(const Frame& F, const Params& p) {
    const int tid_ = fresh_tid(), lane_ = tid_ & 63;
    const bf16_t* hb = (const bf16_t*)(F.ws + WS_PROJ); unsigned char* ocat = F.ws + WS_OCAT;
    bf16_t* og = (bf16_t*)(F.ws + WS_OG) + (size_t)F.bid * (3 * 1024 * 64); float* lse = (float*)(F.ws + WS_LSE) + (size_t)F.bid * (3 * 1024);
    LAS unsigned char* ldsW = F.lds + F.wave * (2 * SLOT_BYTES);
    AttnLane L; attn_lane_init(L, lane_);
    const __amdgpu_buffer_rsrc_t rs = __builtin_amdgcn_make_buffer_rsrc(F.ws, 0, (int)WS_END, 0x00020000);
    const int NU = NB * 4 * 8;
    for (int i = 0;; ++i) {
        const int u = (F.G == 256) ? ((F.bid & 7) * 32 + (F.bid >> 3) + 256 * i) : (F.bid + F.G * i);
        if (u >= NU) break;
        const int qb = u & 7, hs = (u >> 3) & 3, b = u >> 5, t0 = qb * 1024;
        if (i > 0) __syncthreads();
        for (int w = F.wave; w < 16; w += 8) sb_pair(L, rs, hb, b, hs, t0 / 32 + 2 * w, ldsW, ocat, lane_);
        for (int w = F.wave; w < 48; w += 8) {
            const int g = w >> 4, ti = 2 * (w & 15), l2d = 2 * g, per = 32 >> l2d, r = ti / per, jj = ti % per;
            dil_pair(L, rs, hb, g * 4 + hs, (long)b * S + (long)r * (S >> l2d), ((t0 >> l2d) >> 5) + jj, ldsW, og + (size_t)g * (1024 * 64), lse + g * 1024, ti * 32, lane_, p.in[I_QG], (const bf16_t*)(F.ws + WS_ROPE), (long)b * S + r, 1 << l2d);
        }
        VM_WAIT();
        __syncthreads();
        {
            const int piece = tid_ & 7; const size_t bb = (size_t)b * S;
#pragma unroll 2
            for (int pass = 0; pass < 16; ++pass) {
                const int sq = t0 + pass * 64 + (tid_ >> 3);
                const int r0 = sq - t0, r1 = 1024 + (sq & 3) * 256 + ((sq - t0) >> 2), r2 = 2048 + (sq & 15) * 64 + ((sq - t0) >> 4);
                const float l0 = lse[r0], l1 = lse[r1], l2 = lse[r2];
                const u32x4 x = *((const u32x4*)(og + (size_t)r0 * 64) + piece), y = *((const u32x4*)(og + (size_t)r1 * 64) + piece), z = *((const u32x4*)(og + (size_t)r2 * 64) + piece);
                const float mx = fmaxf(l0, fmaxf(l1, l2)); float w0 = fexp2(l0 - mx), w1 = fexp2(l1 - mx), w2 = fexp2(l2 - mx); const float inv = frcp(w0 + w1 + w2); w0 *= inv; w1 *= inv; w2 *= inv;
                u32x2 r;
                r.x = pk4_fp8(w0 * bf_lo(x.x) + w1 * bf_lo(y.x) + w2 * bf_lo(z.x), w0 * bf_hi(x.x) + w1 * bf_hi(y.x) + w2 * bf_hi(z.x), w0 * bf_lo(x.y) + w1 * bf_lo(y.y) + w2 * bf_lo(z.y), w0 * bf_hi(x.y) + w1 * bf_hi(y.y) + w2 * bf_hi(z.y));
                r.y = pk4_fp8(w0 * bf_lo(x.z) + w1 * bf_lo(y.z) + w2 * bf_lo(z.z), w0 * bf_hi(x.z) + w1 * bf_hi(y.z) + w2 * bf_hi(z.z), w0 * bf_lo(x.w) + w1 * bf_lo(y.w) + w2 * bf_lo(z.w), w0 * bf_hi(x.w) + w1 * bf_hi(y.w) + w2 * bf_hi(z.w));
                *((u32x2*)(ocat + (bb + sq) * LDO + hs * 64) + piece) = r;
            }
        }
        __syncthreads();
    }
}

DI void route_rows(const Frame& F, const Params& p, int pm) {
    const int tid_ = fresh_tid(), lane_ = tid_ & 63;
    LAS int* hist = (LAS int*)(F.lds);
    const int ftid = fresh_tid();
    __syncthreads();
    if (ftid < 32) hist[ftid] = 0;
    __syncthreads();
    if (tid_ < 256) {
        const int row = pm * 256 + tid_; const float* L = (const float*)(F.ws + WS_LOGIT) + (size_t)row * 128;
        const float* brg = p.in[I_BRG]; const float* bre = p.in[I_BRE];
        float lgp[4];
#pragma unroll
        for (int c = 0; c < 4; ++c) lgp[c] = L[c] + L[36 + c] + brg[c];
        int gsel = 0; float gm = lgp[0];
#pragma unroll
        for (int c = 1; c < 4; ++c) if (lgp[c] > gm) { gm = lgp[c]; gsel = c; }
        float zs = 0.f;
#pragma unroll
        for (int c = 0; c < 4; ++c) zs += fexp2((lgp[c] - gm) * LOG2E);
        const float pg = frcp(zs);
        float l1 = -INFINITY, l2 = -INFINITY; int e1 = 0, e2 = 0;
#pragma unroll
        for (int i = 0; i < 8; ++i) { const int c = 4 + gsel * 8 + i; const float v = L[c] + L[36 + c] + bre[gsel * 8 + i];
            if (v > l1) { l2 = l1; e2 = e1; l1 = v; e1 = i; } else if (v > l2) { l2 = v; e2 = i; } }
        const float ex = fexp2((l2 - l1) * LOG2E), den = frcp(1.f + ex);
        int* te = (int*)(F.ws + WS_TOKE) + (size_t)row * 2; float* tw = (float*)(F.ws + WS_TOKW) + (size_t)row * 2;
        te[0] = gsel * 8 + e1; te[1] = gsel * 8 + e2; tw[0] = pg * den; tw[1] = pg * ex * den;
        lds_add(&hist[gsel * 8 + e1], 1); lds_add(&hist[gsel * 8 + e2], 1);
    }
    __syncthreads();
    if (ftid < 32) ((int*)(F.ws + WS_HIST))[pm * 32 + ftid] = hist[ftid];
}


DI void router_weights_to_lds(const Frame& F, const Params& p) {
    const int tid_ = fresh_tid(), lane_ = tid_ & 63;
    constexpr int WP = 1028;
    LAS float* wt = (LAS float*)(F.lds + LDS_RW); LAS float* bias = (LAS float*)(F.lds + LDS_RS) + 8 * 80 + 32;
    const float* wrg = p.in[I_WRG]; const float* wre = p.in[I_WRE]; const float* brg = p.in[I_BRG]; const float* bre = p.in[I_BRE];
    const int ftid = fresh_tid();
    __syncthreads();
#pragma unroll 8
    for (int i = ftid; i < 1024 * 32; i += 512) wt[(4 + (i & 31)) * WP + (i >> 5)] = wre[i];
#pragma unroll 8
    for (int i = ftid; i < 1024 * 4; i += 512) wt[(i & 3) * WP + (i >> 2)] = wrg[i];
    if (ftid < 36) bias[ftid] = ftid < 4 ? brg[ftid] : bre[ftid - 4];
}

DI void phase_norm2_route(const Frame& F, const Params& p) {
    const int tid_ = fresh_tid(), lane_ = tid_ & 63;
    constexpr int WP = 1028;
    LAS float* wt = (LAS float*)(F.lds + LDS_RW);
    LAS float* gs = (LAS float*)(F.lds + LDS_RV); LAS float* sh = gs + 1024;
    LAS float* scr = (LAS float*)(F.lds + LDS_RS) + F.wave * 80;
    LAS int* hist = (LAS int*)(F.lds + LDS_RS) + 8 * 80;
    LAS float* bias = (LAS float*)(F.lds + LDS_RS) + 8 * 80 + 32;
    const float* mod = (const float*)(F.ws + WS_MOD); const float* gn = p.in[I_GFFN];
    const bf16_t* upd = (const bf16_t*)(F.ws + WS_UPD1); unsigned* h8 = (unsigned*)(F.ws + WS_H28);
    const float* wrg = p.in[I_WRG]; const float* wre = p.in[I_WRE]; const float* brg = p.in[I_BRG]; const float* bre = p.in[I_BRE];
    const int ftid = fresh_tid();
    __syncthreads();
    for (int chunk = F.bid; chunk < T / 256; chunk += F.G) {
        const int b = chunk >> 5;
        __syncthreads();
        for (int col = ftid; col < 1024; col += 512) { gs[col] = gn[col] * (1.f + mod[b * 6144 + 4096 + col]); sh[col] = mod[b * 6144 + 3072 + col]; }
        if (ftid < 32) hist[ftid] = 0;
        __syncthreads();
        f32x4 vn[2][4]; u32x2 un[2][4];
#pragma unroll
        for (int r = 0; r < 2; ++r) { const int row = chunk * 256 + F.wave * 2 + r;
            const u32x2* ur = (const u32x2*)(upd + (size_t)row * 1024) + lane_;
#pragma unroll
            for (int j = 0; j < 4; ++j) un[r][j] = ur[64 * j]; }
        for (int rr = F.wave * 2; rr < 256; rr += 16) {
            const int row0 = chunk * 256 + rr;
            f32x4 y[2][4];
#pragma unroll
            for (int r = 0; r < 2; ++r) {
                const int row = row0 + r; float ss = 0.f;
#pragma unroll
                for (int j = 0; j < 4; ++j) { vn[r][j] = (f32x4){bf_lo(un[r][j].x), bf_hi(un[r][j].x), bf_lo(un[r][j].y), bf_hi(un[r][j].y)};
                    ss += (vn[r][j].x * vn[r][j].x + vn[r][j].y * vn[r][j].y) + (vn[r][j].z * vn[r][j].z + vn[r][j].w * vn[r][j].w); }
                const float rinv = __builtin_amdgcn_rsqf(wave_sum(ss) * (1.f / 1024.f) + RMS_EPS);
#pragma unroll
                for (int j = 0; j < 4; ++j) { const f32x4 gj = *(const LAS f32x4*)(gs + 256 * j + 4 * lane_), sj = *(const LAS f32x4*)(sh + 256 * j + 4 * lane_);
                    y[r][j] = vn[r][j] * rinv * gj + sj; h8[(size_t)row * 256 + 64 * j + lane_] = pk4_fp8(y[r][j].x, y[r][j].y, y[r][j].z, y[r][j].w); }
            }
            if (rr + 16 < 256) {
#pragma unroll
                for (int r = 0; r < 2; ++r) { const int row = row0 + 16 + r;
                    const u32x2* ur = (const u32x2*)(upd + (size_t)row * 1024) + lane_;
#pragma unroll
                    for (int j = 0; j < 4; ++j) un[r][j] = ur[64 * j]; }
            }
            const bool up32 = (lane_ & 32) != 0, up16 = (lane_ & 16) != 0, up8 = (lane_ & 8) != 0, up4 = (lane_ & 4) != 0;
            {
                f32x2 ga[2][4], gb[2][4];
#pragma unroll
                for (int r = 0; r < 2; ++r)
#pragma unroll
                    for (int c = 0; c < 4; ++c) { ga[r][c] = (f32x2){0.f, 0.f}; gb[r][c] = ga[r][c]; }
#pragma unroll
                for (int c = 0; c < 4; ++c)
#pragma unroll
                    for (int j = 0; j < 4; ++j) { const f32x4 w = *(const LAS f32x4*)(wt + c * WP + 4 * lane_ + 256 * j); const f32x2 wl = {w.x, w.y}, wh = {w.z, w.w};
#pragma unroll
                        for (int r = 0; r < 2; ++r) { ga[r][c] = __builtin_elementwise_fma((f32x2){y[r][j].x, y[r][j].y}, wl, ga[r][c]); gb[r][c] = __builtin_elementwise_fma((f32x2){y[r][j].z, y[r][j].w}, wh, gb[r][c]); } }
                float k4[4];
#pragma unroll
                for (int c = 0; c < 4; ++c) { const f32x2 t0 = ga[0][c] + gb[0][c], t1 = ga[1][c] + gb[1][c]; const float p0 = t0.x + t0.y, p1 = t1.x + t1.y;
                    k4[c] = up32 ? p0 : p1; ga[0][c].x = up32 ? p1 : p0; }
#pragma unroll
                for (int c = 0; c < 4; ++c) k4[c] = ga[0][c].x + __shfl_xor(k4[c], 32);
                float k2[2];
#pragma unroll
                for (int i = 0; i < 2; ++i) k2[i] = (up16 ? k4[2 + i] : k4[i]) + __shfl_xor(up16 ? k4[i] : k4[2 + i], 16);
                float k1 = (up8 ? k2[1] : k2[0]) + __shfl_xor(up8 ? k2[0] : k2[1], 8);
                k1 += __shfl_xor(k1, 4); k1 += __shfl_xor(k1, 2); k1 += __shfl_xor(k1, 1);
                if ((lane_ & 7) == 0) scr[(lane_ >> 5) * 36 + ((lane_ >> 4) & 1) * 2 + ((lane_ >> 3) & 1)] = k1;
            }
            LDS_WAIT();
            int gsel[2];
#pragma unroll
            for (int r = 0; r < 2; ++r) { int gi = 0; float gm = scr[r * 36] + bias[0];
#pragma unroll
                for (int c = 1; c < 4; ++c) { const float v = scr[r * 36 + c] + bias[c]; if (v > gm) { gm = v; gi = c; } }
                gsel[r] = __builtin_amdgcn_readfirstlane(gi); }
            {
                float pe[2][8];
#pragma unroll
                for (int r = 0; r < 2; ++r) {
                    const LAS float* wb = wt + (4 + gsel[r] * 8) * WP + 4 * lane_;
#pragma unroll
                    for (int hh = 0; hh < 2; ++hh) {
                        f32x2 ea[4], eb[4];
#pragma unroll
                        for (int i = 0; i < 4; ++i) { ea[i] = (f32x2){0.f, 0.f}; eb[i] = ea[i]; }
#pragma unroll
                        for (int i = 0; i < 4; ++i)
#pragma unroll
                            for (int j = 0; j < 4; ++j) { const f32x4 w = *(const LAS f32x4*)(wb + (hh * 4 + i) * WP + 256 * j);
                                ea[i] = __builtin_elementwise_fma((f32x2){y[r][j].x, y[r][j].y}, (f32x2){w.x, w.y}, ea[i]); eb[i] = __builtin_elementwise_fma((f32x2){y[r][j].z, y[r][j].w}, (f32x2){w.z, w.w}, eb[i]); }
#pragma unroll
                        for (int i = 0; i < 4; ++i) { const f32x2 t = ea[i] + eb[i]; pe[r][hh * 4 + i] = t.x + t.y; }
                        __builtin_amdgcn_sched_barrier(0);
                    }
                }
                float e8[8], e4[4], e2[2];
#pragma unroll
                for (int i = 0; i < 8; ++i) e8[i] = (up32 ? pe[1][i] : pe[0][i]) + __shfl_xor(up32 ? pe[0][i] : pe[1][i], 32);
#pragma unroll
                for (int i = 0; i < 4; ++i) e4[i] = (up16 ? e8[4 + i] : e8[i]) + __shfl_xor(up16 ? e8[i] : e8[4 + i], 16);
#pragma unroll
                for (int i = 0; i < 2; ++i) e2[i] = (up8 ? e4[2 + i] : e4[i]) + __shfl_xor(up8 ? e4[i] : e4[2 + i], 8);
                float e1 = (up4 ? e2[1] : e2[0]) + __shfl_xor(up4 ? e2[0] : e2[1], 4);
                e1 += __shfl_xor(e1, 2); e1 += __shfl_xor(e1, 1);
                if ((lane_ & 3) == 0) scr[(lane_ >> 5) * 36 + 4 + ((lane_ >> 4) & 1) * 4 + ((lane_ >> 3) & 1) * 2 + ((lane_ >> 2) & 1)] = e1;
            }
            LDS_WAIT();
            if (lane_ < 2) {
                const LAS float* L = scr + lane_ * 36; const int row = row0 + lane_;
                float lgp[4];
#pragma unroll
                for (int c = 0; c < 4; ++c) lgp[c] = L[c] + bias[c];
                int gsel = 0; float gm = lgp[0];
#pragma unroll
                for (int c = 1; c < 4; ++c) if (lgp[c] > gm) { gm = lgp[c]; gsel = c; }
                float zs = 0.f;
#pragma unroll
                for (int c = 0; c < 4; ++c) zs += fexp2((lgp[c] - gm) * LOG2E);
                const float pg = frcp(zs);
                float l1 = -INFINITY, l2 = -INFINITY; int e1 = 0, e2 = 0;
#pragma unroll
                for (int i = 0; i < 8; ++i) { const float v = L[4 + i] + bias[4 + gsel * 8 + i];
                    if (v > l1) { l2 = l1; e2 = e1; l1 = v; e1 = i; } else if (v > l2) { l2 = v; e2 = i; } }
                const float ex = fexp2((l2 - l1) * LOG2E), den = frcp(1.f + ex);
                int* te = (int*)(F.ws + WS_TOKE) + (size_t)row * 2; float* tw = (float*)(F.ws + WS_TOKW) + (size_t)row * 2;
                te[0] = gsel * 8 + e1; te[1] = gsel * 8 + e2; tw[0] = pg * den; tw[1] = pg * ex * den;
                lds_add(&hist[gsel * 8 + e1], 1); lds_add(&hist[gsel * 8 + e2], 1);
            }
            LDS_WAIT();
        }
        __syncthreads();
        if (ftid < 32) ((int*)(F.ws + WS_HIST))[chunk * 32 + ftid] = hist[ftid];
    }
}

DI void phase_slots(const Frame& F, const Params& p) {
    const int tid_ = fresh_tid(), lane_ = tid_ & 63;
    LAS int* tot = (LAS int*)(F.lds); LAS int* bas = tot + 32; LAS int* pst = tot + 64; LAS int* wcnt = tot + 128;
    const int* hist = (const int*)(F.ws + WS_HIST);
    for (int pm = F.bid; pm < T / 256; pm += F.G) {
        const int ftid = fresh_tid();
        __syncthreads();
        if (ftid < 64) tot[ftid] = 0;
        __syncthreads();
        { const int e = tid_ & 31, part = tid_ >> 5; int t = 0, bs = 0;
          for (int q = part; q < T / 256; q += 16) { const int v = hist[q * 32 + e]; t += v; if (q < pm) bs += v; }
          lds_add(&tot[e], t); lds_add(&bas[e], bs); }
        __syncthreads();
        if (tid_ == 0) { int run = 0; for (int e = 0; e < 32; ++e) { pst[e] = run; run += (tot[e] + 255) / 256 * 256; } pst[32] = run; }
        const int my_e = ((const int*)(F.ws + WS_TOKE))[(size_t)pm * 512 + tid_];
        int rank = 0;
        for (int e = 0; e < 32; ++e) { const unsigned long long mask = __ballot(my_e == e); if (my_e == e) rank = __popcll(mask & ((1ull << lane_) - 1ull)); if (lane_ == 0) wcnt[F.wave * 32 + e] = __popcll(mask); }
        __syncthreads();
        int woff = 0;
        for (int w = 0; w < F.wave; ++w) woff += wcnt[w * 32 + my_e];
        const int slot = pst[my_e] + bas[my_e] + woff + rank;
        ((int*)(F.ws + WS_SLOTTOK))[slot] = pm * 256 + (tid_ >> 1);
        ((float*)(F.ws + WS_SLOTW))[slot] = ((const float*)(F.ws + WS_TOKW))[(size_t)pm * 512 + tid_];
        ((int*)(F.ws + WS_TOKS))[(size_t)pm * 512 + tid_] = slot;
        if (pm < 32) { const int e = pm; for (int s = pst[e] + tot[e] + tid_; s < pst[e + 1]; s += 512) { ((int*)(F.ws + WS_SLOTTOK))[s] = 0; ((float*)(F.ws + WS_SLOTW))[s] = 0.f; } }
        if (pm == 0 && tid_ < 34) { int* et = (int*)(F.ws + WS_ETAB); if (tid_ < 33) et[64 + tid_] = pst[tid_] >> 8; if (tid_ < 32) { et[tid_] = tot[tid_]; et[32 + tid_] = pst[tid_]; } if (tid_ == 33) et[97] = pst[32] >> 8; }
    }
}

DI void phase_combine(const Frame& F, const Params& p) {
    const int tid_ = fresh_tid(), lane_ = tid_ & 63;
    const unsigned* y = (const unsigned*)(F.ws + WS_Y); const int* ts = (const int*)(F.ws + WS_TOKS); const float* tw = (const float*)(F.ws + WS_TOKW); const float* mod = (const float*)(F.ws + WS_MOD);
    const int gw = F.bid * 8 + F.wave, NGW = F.G * 8;
    for (int row = gw; row < T; row += NGW) {
        const int s0 = ts[(size_t)row * 2], s1 = ts[(size_t)row * 2 + 1]; const float w0 = tw[(size_t)row * 2] * 0.125f, w1 = tw[(size_t)row * 2 + 1] * 0.125f;
        f32x4* orow = (f32x4*)(p.out + (size_t)row * 1024) + lane_;
        const u32x2* ur = (const u32x2*)((const bf16_t*)(F.ws + WS_UPD1) + (size_t)row * 1024) + lane_;
        const unsigned* y0 = y + (size_t)s0 * 256 + lane_; const unsigned* y1 = y + (size_t)s1 * 256 + lane_;
        const f32x4* g2 = (const f32x4*)(mod + (row >> 13) * 6144 + 5120) + lane_;
        f32x4 v[4], g[4]; unsigned a[4], c[4]; u32x2 uu[4];
#pragma unroll
        for (int j = 0; j < 4; ++j) { uu[j] = ur[64 * j]; a[j] = y0[64 * j]; c[j] = y1[64 * j]; g[j] = g2[64 * j]; }
#pragma unroll
        for (int j = 0; j < 4; ++j) { v[j] = (f32x4){bf_lo(uu[j].x), bf_hi(uu[j].x), bf_lo(uu[j].y), bf_hi(uu[j].y)};
            if (!DBG_SKIP_Y) { const f32x2 al = fp8_lo2(a[j]), ah = fp8_hi2(a[j]), cl = fp8_lo2(c[j]), ch = fp8_hi2(c[j]);
                v[j].x += g[j].x * (w0 * al.x + w1 * cl.x); v[j].y += g[j].y * (w0 * al.y + w1 * cl.y); v[j].z += g[j].z * (w0 * ah.x + w1 * ch.x); v[j].w += g[j].w * (w0 * ah.y + w1 * ch.y); } orow[64 * j] = v[j]; }
    }
}

__global__ void __launch_bounds__(512, 2) fwd(Params p) {
    extern __shared__ __attribute__((aligned(16))) unsigned char lds_raw[];
    Frame F;
    F.lds = (LAS unsigned char*)lds_raw; F.ws = p.ws;
    F.wave = __builtin_amdgcn_readfirstlane((int)threadIdx.x >> 6); F.G = gridDim.x; F.bid = blockIdx.x;
    volatile LAS unsigned* ctl = (volatile LAS unsigned*)(F.lds + LDS_CTLO);
    { const int ftid = fresh_tid(); if (ftid < 64) ctl[ftid] = 0u; }
    __syncthreads();
    XcdBarrier bar; bar.bar = (unsigned*)(p.ws + WS_CTL) + CW_BAR; bar.x = 0; bar.st = ctl;
    if (MK_N_LAUNCHES == 1) bar = xcd_barrier_post((unsigned*)(p.ws + WS_CTL) + CW_BAR, ctl);
    const int lo = p.ph_lo, hi = p.ph_hi;
    const __amdgpu_buffer_rsrc_t rsw = __builtin_amdgcn_make_buffer_rsrc(p.ws, 0, (int)WS_END, 0x00020000);
#define IN(k) (lo <= (k) && (k) < hi)
#define REP(k) for (int rep_ = 0; rep_ < ((PROBE_PH) == (k) ? 2 : 1); ++rep_)
#define SEAM(k) do { if (IN(k) && IN((k) + 1)) xcd_barrier(bar); } while (0)

    if (IN(0)) REP(0) { phase0(F, p); } SEAM(0);
    if (IN(1)) REP(1) { phase_norm<0>(F, p); } SEAM(1);
    if (IN(2)) REP(2) {
        REP(20) {
            pg8::DenseSched Sd; Sd.init(T, 2304, F.G, F.bid, WS_H8, 1024, WS_W1D8, 1024);
            EpiProj<false> E{(bf16_t*)(F.ws + WS_PROJ), (bf16_t*)(F.ws + WS_GATES), (const bf16_t*)(F.ws + WS_ROPE), p.in[I_QG], p.in[I_KG], 0};
            pg8::gemm_phase<EpiProj<false>, pg8::DenseSched, true>(F.lds, 1024, Sd, E, rsw);
        }
        REP(21) {
            pg8::DenseSched Sd; Sd.init(T, 768, F.G, F.bid, WS_H, 2048, WS_W1 + (size_t)2304 * 2048, 2048);
            EpiProj<false> E{(bf16_t*)(F.ws + WS_PROJ), (bf16_t*)(F.ws + WS_GATES), (const bf16_t*)(F.ws + WS_ROPE), p.in[I_QG], p.in[I_KG], 9};
            pg8::gemm_phase<EpiProj<false>, pg8::DenseSched, false>(F.lds, 1024, Sd, E, rsw);
        }
        REP(22) {
            pg8::DenseSched Sd; Sd.init(T, 2048, F.G, F.bid, WS_H8, 1024, WS_WG8, 1024);
            EpiProj<true> E{(bf16_t*)(F.ws + WS_PROJ), (bf16_t*)(F.ws + WS_GATES), (const bf16_t*)(F.ws + WS_ROPE), p.in[I_QG], p.in[I_KG], 0};
            pg8::gemm_phase<EpiProj<true>, pg8::DenseSched, true>(F.lds, 1024, Sd, E, rsw);
        }
    } SEAM(2);
    if (IN(3)) REP(3) { phase_attn(F, p); } SEAM(3);
    if (IN(4)) REP(4) {
        pg8::DiagSched Sd; Sd.init(T, 2048, F.G, F.bid, WS_OCAT, 512, WS_WB, 512);
        EpiBranch E{(const unsigned char*)(F.ws + WS_GATES), F.ws + WS_MERGED};
        pg8::gemm_phase<EpiBranch, pg8::DiagSched, true>(F.lds, 512, Sd, E, rsw);
    } SEAM(4);
    if (IN(5)) REP(5) {
        pg8::DenseSched Sd; Sd.init(T, 1024, F.G, F.bid, WS_MERGED, 1024, WS_WO, 1024);
        EpiOut E{(bf16_t*)(F.ws + WS_UPD1), (const float*)(F.ws + WS_MOD)};
        pg8::gemm_phase<EpiOut, pg8::DenseSched, true>(F.lds, 1024, Sd, E, rsw);
        if (rep_ + 1 == ((PROBE_PH) == 5 ? 2 : 1)) router_weights_to_lds(F, p);
    } SEAM(5);
    if (IN(6)) REP(6) { phase_norm2_route(F, p); }
    if (IN(6) && IN(8)) xcd_barrier(bar);
    if (IN(8)) REP(8) { phase_slots(F, p); } SEAM(8);
    if (IN(9) || IN(10)) {
        LAS int* cst = (LAS int*)(F.lds + LDS_CTLO) + 16;
        __syncthreads();
        { const int ftid = fresh_tid(); if (ftid < 34) cst[ftid] = ((const int*)(F.ws + WS_ETAB))[64 + ftid]; }
        __syncthreads();
    }
    if (IN(9)) REP(9) {
        const LAS int* cst = (const LAS int*)(F.lds + LDS_CTLO) + 16;
        MoeSchedUp Sm; Sm.G = F.G; Sm.c = (F.G == 256) ? ((F.bid & 7) * 32 + (F.bid >> 3)) : F.bid; Sm.nc = __builtin_amdgcn_readfirstlane(cst[33]); Sm.pa = 1024; Sm.pb = 1024; Sm.A = (unsigned)WS_H28; Sm.B = (unsigned)WS_WGU; Sm.cstart = cst;
        Sm.slot_tok = (const int*)(F.ws + WS_SLOTTOK); Sm.estride = 1024u * 1024u; Sm.pnstride = 256u * 1024u;
        EpiSwiglu E{F.ws + WS_HMID};
        pg8::gemm_phase<EpiSwiglu, MoeSchedUp, true>(F.lds, 1024, Sm, E, rsw);
    } SEAM(9);
    if (IN(10)) REP(10) {
        const LAS int* cst = (const LAS int*)(F.lds + LDS_CTLO) + 16;
        MoeSchedDn Sm; Sm.G = F.G; Sm.c = (F.G == 256) ? ((F.bid & 7) * 32 + (F.bid >> 3)) : F.bid; Sm.nc = __builtin_amdgcn_readfirstlane(cst[33]); Sm.pa = 512; Sm.pb = 512; Sm.A = (unsigned)WS_HMID; Sm.B = (unsigned)WS_WDN; Sm.cstart = cst;
        Sm.slot_tok = (const int*)(F.ws + WS_SLOTTOK); Sm.estride = 1024u * 512u; Sm.pnstride = 256u * 512u;
        EpiDown E{F.ws + WS_Y};
        pg8::gemm_phase<EpiDown, MoeSchedDn, true>(F.lds, 512, Sm, E, rsw);
    } SEAM(10);
    if (IN(11)) { phase_combine(F, p); }
#undef IN
#undef SEAM
}

extern "C" void kernel_launch(void* const* d_in, const int* in_sizes, int n_in, void* d_out, int out_size, void* d_ws, size_t ws_size, hipStream_t stream) {
    static int grid = 0;
    if (grid == 0) {
        if (n_in != 21 || in_sizes[0] != T * D || out_size != T * D || ws_size < WS_END) { fprintf(stderr, "kernel_launch: unexpected problem (n_in %d, ws %zu)\n", n_in, ws_size); grid = -1; return; }
        int dev = 0, cus = 0, per_cu = 0;
        if (hipGetDevice(&dev) != hipSuccess || hipDeviceGetAttribute(&cus, hipDeviceAttributeMultiprocessorCount, dev) != hipSuccess) { grid = -1; return; }
        if (hipFuncSetAttribute((const void*)fwd, hipFuncAttributeMaxDynamicSharedMemorySize, LDS_BYTES) != hipSuccess) { fprintf(stderr, "kernel_launch: hipFuncSetAttribute failed\n"); grid = -1; return; }
        if (hipOccupancyMaxActiveBlocksPerMultiprocessor(&per_cu, (const void*)fwd, 512, LDS_BYTES) != hipSuccess || per_cu < 1) { fprintf(stderr, "kernel_launch: occupancy query says %d\n", per_cu); (void)hipGetLastError(); grid = -1; return; }
        grid = cus;
    }
    if (grid < 0) return;
    (void)hipMemsetAsync((char*)d_ws + WS_CTL, 0, CTL_ZERO_BYTES, stream);
    Params p{};
    for (int i = 0; i < 21; ++i) p.in[i] = (const float*)d_in[i];
    p.out = (float*)d_out; p.ws = (unsigned char*)d_ws;
    if (MK_N_LAUNCHES == 1) { p.ph_lo = 0; p.ph_hi = NPH; hipLaunchKernelGGL(fwd, dim3(grid), dim3(512), LDS_BYTES, stream, p); }
    else { for (int k = 0; k < NPH; ++k) { p.ph_lo = k; p.ph_hi = k + 1; hipLaunchKernelGGL(fwd, dim3(grid), dim3(512), LDS_BYTES, stream, p); } }
}
```
